# Optimizing an MI355X kernel written in HIP

```python
import math
import jax, jax.numpy as jnp
from jax import lax
import numpy as np

D_MODEL = 2048
BATCH = 1
SEQ = 8192
DEPTH = 4

BRANCH_WIDTH = 1024
N_BRANCH = 3
DIL_PAIRS = ((128, 1), (512, 4), (2048, 16))
N_DIL_GROUPS = 3
A_HEADS = 8
A_HEAD_DIM = 128
HY_BANDS = 16
HY_EMB_DIM = 1 + 2 * HY_BANDS
HY_FFN = 64
HY_ORDER = 2
HY_SHORT = 3
HY_TARGET = 1e-2
HY_FAST_PCT = 0.3
HY_SLOW_PCT = 1.5
C_HEADS = 8
C_QK_DIM = 64
C_V_DIM = 128
Q_BLOCK = 128
N_BUCKETS = 32
REL_MAX_DIST = 1024
N_BIAS_HEADS = N_DIL_GROUPS * A_HEADS + C_HEADS
NORM_EPS = 1e-6
NEG = -1e30

A_QKV_COLS = N_DIL_GROUPS * 3 * A_HEADS * A_HEAD_DIM
B_IN_COLS = (HY_ORDER + 1) * BRANCH_WIDTH
C_QKV_COLS = 2 * 2 * C_HEADS * C_QK_DIM + C_HEADS * C_V_DIM
MERGE_COLS = N_BRANCH * D_MODEL
COL_SIZES = (A_QKV_COLS, BRANCH_WIDTH, B_IN_COLS, BRANCH_WIDTH, C_QKV_COLS, BRANCH_WIDTH, MERGE_COLS)
IN_COLS = int(sum(COL_SIZES))
SPLITS = [int(s) for s in np.cumsum(COL_SIZES)[:-1]]

kernel_name = "hybrid_dilated_hyena_diffattn_encoder"


def rms_norm(x, g):
    xf = x.astype(jnp.float32)
    y = xf * lax.rsqrt(jnp.mean(xf * xf, axis=-1, keepdims=True) + NORM_EPS)
    return (y * g.astype(jnp.float32)).astype(x.dtype)


def t5_bucket(rel):
    nb = N_BUCKETS // 2
    max_exact = nb // 2
    ret = (rel > 0).astype(jnp.int32) * nb
    n = jnp.abs(rel)
    nf = jnp.maximum(n, 1).astype(jnp.float32)
    large = max_exact + (jnp.log(nf / max_exact) / math.log(REL_MAX_DIST / max_exact) * (nb - max_exact)).astype(jnp.int32)
    large = jnp.minimum(large, nb - 1)
    return ret + jnp.where(n < max_exact, n, large)


def dilated_group(q, k, v, bias_tab, dil, reach):
    B, S, H, hd = q.shape
    n = S // dil
    blk = reach
    nb = -(-n // blk)
    n_pad = nb * blk

    def split_res(t):
        return t.reshape(B, n, dil, H, hd).transpose(0, 2, 3, 1, 4)

    qs, ks, vs = split_res(q), split_res(k), split_res(v)
    qb = jnp.pad(qs, ((0, 0), (0, 0), (0, 0), (0, n_pad - n), (0, 0))).reshape(B, dil, H, nb, blk, hd)

    def band(t):
        tp = jnp.pad(t, ((0, 0), (0, 0), (0, 0), (blk, n_pad - n + blk), (0, 0)))
        tb = tp.reshape(B, dil, H, nb + 2, blk, hd)
        return jnp.concatenate([tb[:, :, :, :-2], tb[:, :, :, 1:-1], tb[:, :, :, 2:]], axis=4)

    kb, vb = band(ks), band(vs)
    t_idx = jnp.arange(blk)[:, None]
    u_idx = jnp.arange(3 * blk)[None, :]
    rel = u_idx - blk - t_idx
    m_k = jnp.arange(nb)[:, None, None] * blk - blk + u_idx
    valid = (jnp.abs(rel) <= reach)[None] & (m_k >= 0) & (m_k < n)
    bias = bias_tab[t5_bucket(rel * dil)].astype(jnp.float32).transpose(2, 0, 1)
    scale = 1.0 / math.sqrt(hd)
    logits = jnp.einsum('bdhnqc,bdhnkc->bdhnqk', qb, kb, preferred_element_type=jnp.float32) * scale
    logits = jnp.where(valid[None, None, None], logits + bias[None, None, :, None], NEG)
    lse = jax.nn.logsumexp(logits, axis=-1)
    p = jnp.exp(logits - lse[..., None])
    o = jnp.einsum('bdhnqk,bdhnkc->bdhnqc', p.astype(v.dtype), vb)
    o = o.reshape(B, dil, H, n_pad, hd)[:, :, :, :n].transpose(0, 3, 1, 2, 4).reshape(B, S, H, hd)
    lse = lse.reshape(B, dil, H, n_pad)[..., :n].transpose(0, 3, 1, 2).reshape(B, S, H)
    return o, lse


def diff_attention(q, k, v, lam, bias_tab):
    B, S, H, _, dq = q.shape
    nqb = S // Q_BLOCK
    qb = q.reshape(B, nqb, Q_BLOCK, H, 2, dq).transpose(1, 0, 2, 3, 4, 5)
    kpos = jnp.arange(S)
    scale = 1.0 / math.sqrt(dq)

    def one_block(args):
        qblk, bi = args
        qpos = bi * Q_BLOCK + jnp.arange(Q_BLOCK)
        bias = bias_tab[t5_bucket(kpos[None, :] - qpos[:, None])].astype(jnp.float32).transpose(2, 0, 1)
        logits = jnp.einsum('bqhcd,bkhcd->bhcqk', qblk, k, preferred_element_type=jnp.float32) * scale
        p = jax.nn.softmax(logits + bias[None, :, None], axis=-1)
        a = p[:, :, 0] - lam * p[:, :, 1]
        return jnp.einsum('bhqk,bkhd->bqhd', a.astype(v.dtype), v)

    o = lax.map(one_block, (qb, jnp.arange(nqb)))
    return o.transpose(1, 0, 2, 3, 4).reshape(B, S, H, v.shape[-1])


def short_conv(u, w):
    C = u.shape[-1]
    pad = HY_SHORT // 2
    return lax.conv_general_dilated(u, w[:, None, :].astype(u.dtype), window_strides=(1,), padding=((pad, pad),),
                                    dimension_numbers=('NWC', 'WIO', 'NWC'), feature_group_count=C)


def hyena_filters(L, w1, b1, freq, w2, b2, w3):
    f32 = jnp.float32
    t = jnp.linspace(0.0, 1.0, L, dtype=f32)[:, None]
    w = 2.0 * math.pi * jnp.arange(L, dtype=f32)[:, None] / L
    fb = jnp.linspace(1e-4, HY_BANDS - 1, HY_BANDS, dtype=f32)[None]
    z = jnp.concatenate([t, jnp.cos(fb * w), -jnp.sin(fb * w)], axis=-1)
    freq = freq.astype(f32)
    hid = jnp.sin(freq[0] * (z @ w1.astype(f32) + b1.astype(f32)))
    hid = jnp.sin(freq[1] * (hid @ w2.astype(f32) + b2.astype(f32)))
    h = (hid @ w3.astype(f32)).reshape(L, HY_ORDER, 2, BRANCH_WIDTH)
    max_decay = math.log(HY_TARGET) / HY_FAST_PCT
    min_decay = math.log(HY_TARGET) / HY_SLOW_PCT
    deltas = jnp.linspace(min_decay, max_decay, BRANCH_WIDTH, dtype=f32)
    decay = jnp.exp(-t * jnp.abs(deltas)[None])
    return h * decay[:, None, None, :]


def fft_conv(z, h):
    L = z.shape[1]
    n = 2 * L
    Z = jnp.fft.rfft(z, n=n, axis=1)
    Hf = jnp.fft.rfft(h, n=n, axis=0)
    return jnp.fft.irfft(Z * Hf[None], n=n, axis=1)[:, :L]


def bidir_long_conv(z, h_fwd, h_bwd, skip):
    zf = z.astype(jnp.float32)
    y = fft_conv(zf, h_fwd) + jnp.flip(fft_conv(jnp.flip(zf, 1), h_bwd), 1) + skip.astype(jnp.float32) * zf
    return y.astype(z.dtype)


def setup_inputs(seed: int = 0) -> dict:
    key = jax.random.key(seed)
    ks = jax.random.split(key, 20)
    f32 = jnp.float32
    nrm = lambda k, shape, s: jax.random.normal(k, shape, f32) * s
    return {
        "x": nrm(ks[0], (BATCH, SEQ, D_MODEL), 1.0),
        "norm_g": 1.0 + nrm(ks[1], (DEPTH, D_MODEL), 0.02),
        "final_g": 1.0 + nrm(ks[2], (D_MODEL,), 0.02),
        "w_in": nrm(ks[3], (DEPTH, D_MODEL, IN_COLS), D_MODEL ** -0.5),
        "merge_b": nrm(ks[4], (DEPTH, N_BRANCH, D_MODEL), 0.02),
        "rel_bias": nrm(ks[5], (N_BUCKETS, N_BIAS_HEADS), 0.2),
        "hy_conv": nrm(ks[6], (DEPTH, HY_SHORT, B_IN_COLS), HY_SHORT ** -0.5),
        "hy_w1": nrm(ks[7], (DEPTH, HY_EMB_DIM, HY_FFN), HY_EMB_DIM ** -0.5),
        "hy_b1": nrm(ks[8], (DEPTH, HY_FFN), 0.1),
        "hy_freq": 1.0 + nrm(ks[9], (DEPTH, 2, HY_FFN), 0.05),
        "hy_w2": nrm(ks[10], (DEPTH, HY_FFN, HY_FFN), HY_FFN ** -0.5),
        "hy_b2": nrm(ks[11], (DEPTH, HY_FFN), 0.1),
        "hy_w3": nrm(ks[12], (DEPTH, HY_FFN, HY_ORDER * 2 * BRANCH_WIDTH), 0.05 * HY_FFN ** -0.5),
        "hy_skip": nrm(ks[13], (DEPTH, HY_ORDER, BRANCH_WIDTH), 0.5),
        "diff_lam": nrm(ks[14], (DEPTH, 4, C_QK_DIM), 0.1),
        "diff_g": 1.0 + nrm(ks[15], (DEPTH, C_V_DIM), 0.02),
        "w_proj": nrm(ks[16], (DEPTH, N_BRANCH, BRANCH_WIDTH, D_MODEL), BRANCH_WIDTH ** -0.5),
        "w_out": nrm(ks[17], (DEPTH, D_MODEL, D_MODEL), D_MODEL ** -0.5),
    }


def reference(x, norm_g, final_g, w_in, merge_b, rel_bias, hy_conv, hy_w1, hy_b1, hy_freq, hy_w2, hy_b2, hy_w3,
              hy_skip, diff_lam, diff_g, w_proj, w_out):
    B, S, _ = x.shape
    W = BRANCH_WIDTH
    for l in range(DEPTH):
        h = rms_norm(x, norm_g[l])
        proj = h @ w_in[l]
        a_qkv, a_gate, b_in, b_gate, c_qkv, c_gate, merge = jnp.split(proj, SPLITS, axis=-1)

        a_qkv = a_qkv.reshape(B, S, N_DIL_GROUPS, 3, A_HEADS, A_HEAD_DIM)
        outs, lses = [], []
        for g, (win, dil) in enumerate(DIL_PAIRS):
            o_g, lse_g = dilated_group(a_qkv[:, :, g, 0], a_qkv[:, :, g, 1], a_qkv[:, :, g, 2],
                                       rel_bias[:, g * A_HEADS:(g + 1) * A_HEADS], dil, win // (2 * dil))
            outs.append(o_g)
            lses.append(lse_g)
        wts = jax.nn.softmax(jnp.stack(lses), axis=0)
        a_out = jnp.einsum('gbsh,gbshd->bshd', wts, jnp.stack(outs).astype(jnp.float32)).astype(x.dtype)
        a_out = a_out.reshape(B, S, W) * jax.nn.silu(a_gate)

        u = short_conv(b_in, hy_conv[l])
        v, x1, x2 = jnp.split(u, 3, axis=-1)
        filt = hyena_filters(S, hy_w1[l], hy_b1[l], hy_freq[l], hy_w2[l], hy_b2[l], hy_w3[l])
        z = v
        for o, gate in enumerate((x1, x2)):
            z = gate * bidir_long_conv(z, filt[:, o, 0], filt[:, o, 1], hy_skip[l, o])
        b_out = z * jax.nn.silu(b_gate)

        qk_w = 2 * C_HEADS * C_QK_DIM
        cq = c_qkv[..., :qk_w].reshape(B, S, C_HEADS, 2, C_QK_DIM)
        ck = c_qkv[..., qk_w:2 * qk_w].reshape(B, S, C_HEADS, 2, C_QK_DIM)
        cv = c_qkv[..., 2 * qk_w:].reshape(B, S, C_HEADS, C_V_DIM)
        lam_init = 0.8 - 0.6 * math.exp(-0.3 * l)
        dl = diff_lam[l].astype(jnp.float32)
        lam = jnp.exp(jnp.sum(dl[0] * dl[1])) - jnp.exp(jnp.sum(dl[2] * dl[3])) + lam_init
        c_o = diff_attention(cq, ck, cv, lam, rel_bias[:, N_DIL_GROUPS * A_HEADS:])
        c_o = rms_norm(c_o, diff_g[l]) * (1.0 - lam_init)
        c_out = c_o.reshape(B, S, W) * jax.nn.silu(c_gate)

        branches = jnp.stack([a_out, b_out, c_out], axis=2)
        proj_b = jnp.einsum('bsnw,nwd->bsnd', branches, w_proj[l])
        gates = jax.nn.sigmoid(merge.reshape(B, S, N_BRANCH, D_MODEL) + merge_b[l])
        y = jnp.sum(gates * proj_b, axis=2)
        x = x + y @ w_out[l]
    return rms_norm(x, final_g)
```

```cpp
#include <hip/hip_runtime.h>
#include <hip/hip_cooperative_groups.h>
#include <cstdio>
namespace cg = cooperative_groups;
#define DI __device__ __forceinline__
#define LAS __attribute__((address_space(3)))
typedef unsigned short bf16_t;
typedef short bf16x8 __attribute__((ext_vector_type(8)));
typedef short s16x4 __attribute__((ext_vector_type(4)));
typedef float f32x4 __attribute__((ext_vector_type(4)));
typedef float f32x16 __attribute__((ext_vector_type(16)));
typedef float f32x2 __attribute__((ext_vector_type(2)));
typedef float cf __attribute__((ext_vector_type(2)));
typedef __bf16 bf16x2n __attribute__((ext_vector_type(2)));
typedef unsigned u32x2 __attribute__((ext_vector_type(2)));
typedef unsigned u32x4 __attribute__((ext_vector_type(4)));

DI unsigned pk2(float lo, float hi) { f32x2 v = {lo, hi}; return __builtin_bit_cast(unsigned, __builtin_convertvector(v, bf16x2n)); }
DI float bflo(unsigned u) { return __uint_as_float(u << 16); }
DI float bfhi(unsigned u) { return __uint_as_float(u & 0xffff0000u); }
DI float silu_f(float x) { return x / (1.0f + __expf(-x)); }
DI float sigm_f(float x) { return 1.0f / (1.0f + __expf(-x)); }

DI int tidx() { int t = threadIdx.x; asm volatile("" : "+v"(t)); return t; }

constexpr int S = 8192, D = 2048, NIN = 24576, DEPTH = 4;
constexpr int C_AGATE = 9216, C_BIN = 10240, C_BGATE = 13312, C_CQKV = 14336, C_CGATE = 17408, C_MERGE = 18432;
constexpr float LOG2E = 1.4426950408889634f;
constexpr int NTHR = 512, NWAVES = 8;
constexpr int LDS_MAIN = 131072, LDS_AUX = 16384, LDS_BYTES = LDS_MAIN + LDS_AUX;

constexpr size_t WS_WIN  = 0;
constexpr size_t WS_WPR  = WS_WIN  + (size_t)DEPTH * NIN * D * 2;
constexpr size_t WS_WOUT = WS_WPR  + (size_t)DEPTH * 3 * D * 1024 * 2;
constexpr size_t WS_SPEC = WS_WOUT + (size_t)DEPTH * D * D * 2;
constexpr size_t WS_HID2 = WS_SPEC + (size_t)DEPTH * 2 * 512 * 8208 * 16;
constexpr size_t WS_BIAS = WS_HID2 + (size_t)DEPTH * S * 64 * 4;
constexpr size_t WS_X    = WS_BIAS + 524288;
constexpr size_t WS_H    = WS_X    + (size_t)S * D * 4;
constexpr size_t WS_PROJ = WS_H    + (size_t)S * D * 2;
constexpr size_t WS_BINT = WS_PROJ + (size_t)S * NIN * 2;
constexpr size_t WS_VTA  = WS_BINT + (size_t)3072 * S * 4;
constexpr size_t WS_VTC  = WS_VTA  + (size_t)3 * 1024 * S * 2;
constexpr size_t WS_OA   = WS_VTC  + (size_t)1024 * S * 2;
constexpr size_t WS_LSEA = WS_OA   + (size_t)3 * S * 1024 * 4;
constexpr size_t WS_Z2T  = WS_LSEA + (size_t)3 * S * 8 * 4;
constexpr size_t WS_BR   = WS_Z2T  + (size_t)1024 * S * 4;
constexpr size_t WS_YF   = WS_BR   + (size_t)3 * S * 1024 * 2;
constexpr size_t WS_YB   = WS_YF   + (size_t)S * D * 4;
constexpr size_t WS_CTMP = WS_YB   + (size_t)S * D * 2;
constexpr size_t WS_END  = WS_CTMP + (size_t)S * 1024 * 4;

struct Params {
    const float* in[18];
    float* out;
    unsigned char* ws;
    int ph_lo, ph_hi;
};
enum { I_X = 0, I_NORMG, I_FINALG, I_WIN, I_MERGEB, I_RELB, I_HYCONV, I_HYW1, I_HYB1, I_HYFREQ, I_HYW2, I_HYB2, I_HYW3, I_HYSKIP, I_DLAM, I_DG, I_WPROJ, I_WOUT };

namespace pg8 {
constexpr int BM = 256, BK = 64, HALF = 128, HTB = HALF * BK * 2, NXCD = 8, WGM = 8;
DI int lds_byte(int r, int c) { const int st = (r >> 4) * 2 + (c >> 5), rr = r & 15, cc = c & 31, ob = rr * 64 + cc * 2; return st * 1024 + (ob ^ (((ob >> 9) & 1) << 5)); }
DI void stage_rc(int b, int& R, int& C) { const int st = b / 1024, sb = b % 1024, swz = sb ^ (((sb >> 9) & 1) << 5); R = (st >> 1) * 16 + swz / 64; C = (st & 1) * 32 + (swz % 64) / 2; }
struct Unit { int pm, pn; };
struct Gemm { const bf16_t* A; const bf16_t* Bt; int M, N, K; };
struct StaticOrder {
    int nM, nN, nwg, G, c;
    DI void init(int M, int N, int G_, int c_) { nM = M / BM; nN = N / BM; nwg = nM * nN; G = G_; c = c_; }
    DI bool next(int i, Unit& u) const {
        const long L = (long)i * G + c; if (L >= nwg) return false;
        int wgid = (int)L; { const int q = nwg / NXCD, r = nwg % NXCD, xcd = wgid % NXCD, off = wgid / NXCD; wgid = (xcd < r ? xcd * (q + 1) : r * (q + 1) + (xcd - r) * q) + off; }
        const int nig = WGM * nN, gid = wgid / nig, fm = gid * WGM, gsz = (nM - fm) < WGM ? (nM - fm) : WGM;
        u.pm = fm + ((wgid % nig) % gsz); u.pn = (wgid % nig) / gsz; return true;
    }
};
template <class Epi, class Sched>
DI void gemm_phase(LAS unsigned char* lds, const Gemm g, const Sched& S, const Epi& E) {
    const int tid = tidx(), wid = __builtin_amdgcn_readfirstlane(tid >> 6), lane = tid & 63, wr = wid >> 2, wc = wid & 3, fr = lane & 15, fq = lane >> 4;
    const int K = g.K, nt = K / BK;
    unsigned voffA[2], voffB[2];
#pragma unroll
    for (int i = 0; i < 2; ++i) { int R, C; stage_rc(tid * 16 + i * 8192, R, C); voffA[i] = (unsigned)(R * K + C) * 2u; voffB[i] = (unsigned)(R * K + C) * 2u; }
    const size_t kstep = (size_t)(BK * 2);
    const size_t hstep = (size_t)HALF * K * 2;
    const size_t tstep = 2 * hstep;
    const unsigned ldsw = (unsigned)wid * 1024u;
    const int aoff = lds_byte(wr * 64 + fr, fq * 8), boff = lds_byte(wc * 32 + fr, fq * 8);
#define PG8_SA(b, h) (((b) * 2 + (h)) * HTB)
#define PG8_SB(b, h) ((4 + (b) * 2 + (h)) * HTB)
#define PG8_STAGE(bufoff, gbase, voff) do { _Pragma("unroll") for (int _i = 0; _i < 2; ++_i) \
        __builtin_amdgcn_global_load_lds((const unsigned*)((const char*)(gbase) + (voff)[_i]), (LAS unsigned*)(lds + (bufoff) + ldsw + _i * 8192), 16, 0, 0); } while (0)
#define PG8_LDA(dst, b, h) do { _Pragma("unroll") for (int m = 0; m < 4; ++m) _Pragma("unroll") for (int k = 0; k < 2; ++k) dst[m][k] = *(const LAS bf16x8*)(lds + PG8_SA(b, h) + aoff + m * 2048 + k * 1024); } while (0)
#define PG8_LDB(dst, b, h) do { _Pragma("unroll") for (int n = 0; n < 2; ++n) _Pragma("unroll") for (int k = 0; k < 2; ++k) dst[n][k] = *(const LAS bf16x8*)(lds + PG8_SB(b, h) + boff + n * 2048 + k * 1024); } while (0)
#define PG8_MMA(ai, bj, At, Bt) do { __builtin_amdgcn_s_setprio(1); _Pragma("unroll") for (int m = 0; m < 4; ++m) _Pragma("unroll") for (int n = 0; n < 2; ++n) _Pragma("unroll") for (int k = 0; k < 2; ++k) \
        acc[ai][bj][m][n] = __builtin_amdgcn_mfma_f32_16x16x32_bf16(Bt[n][k], At[m][k], acc[ai][bj][m][n], 0, 0, 0); __builtin_amdgcn_s_setprio(0); } while (0)
#define PG8_WAIT_V(n) asm volatile("s_waitcnt vmcnt(" #n ")" ::: "memory")
#define PG8_WAIT_L(n) asm volatile("s_waitcnt lgkmcnt(" #n ")" ::: "memory")
#define PG8_BAR __builtin_amdgcn_s_barrier()
#define PG8_SCHED __builtin_amdgcn_sched_barrier(0)
    Unit cur, nxt; int ui = 0;
    if (!S.next(0, cur)) return;
    f32x4 acc[2][2][4][2];
#pragma unroll
    for (int a = 0; a < 2; ++a)
#pragma unroll
        for (int b = 0; b < 2; ++b)
#pragma unroll
            for (int m = 0; m < 4; ++m)
#pragma unroll
                for (int n = 0; n < 2; ++n) acc[a][b][m][n] = (f32x4){0.f, 0.f, 0.f, 0.f};
    bf16x8 At[4][2], B0[2][2], B1[2][2];
    const char* cA = (const char*)g.A + (size_t)cur.pm * tstep; const char* cB = (const char*)g.Bt + (size_t)cur.pn * tstep;
    PG8_STAGE(PG8_SB(0, 0), cB, voffB); PG8_STAGE(PG8_SA(0, 0), cA, voffA); PG8_STAGE(PG8_SB(0, 1), cB + hstep, voffB); PG8_STAGE(PG8_SA(0, 1), cA + hstep, voffA);
    if (wr == 1) PG8_BAR;
    PG8_WAIT_V(4); PG8_BAR;
    PG8_STAGE(PG8_SB(1, 0), cB + kstep, voffB); PG8_STAGE(PG8_SA(1, 0), cA + kstep, voffA); PG8_STAGE(PG8_SB(1, 1), cB + hstep + kstep, voffB);
    PG8_WAIT_V(6); PG8_BAR;
    for (;;) {
        const bool has_next = S.next(ui + 1, nxt);
        const char* nA = has_next ? (const char*)g.A + (size_t)nxt.pm * tstep : cA; const char* nB = has_next ? (const char*)g.Bt + (size_t)nxt.pn * tstep : cB;
        for (int t = 0; t < nt; t += 2) {
            const bool last = (t == nt - 2);
            const char* a1 = cA + (size_t)(t + 1) * kstep;
            const char* a2 = last ? nA : cA + (size_t)(t + 2) * kstep; const char* b2 = last ? nB : cB + (size_t)(t + 2) * kstep;
            const char* a3 = a2 + kstep; const char* b3 = b2 + kstep;
            PG8_LDB(B0, 0, 0); PG8_SCHED; PG8_LDA(At, 0, 0); PG8_STAGE(PG8_SA(1, 1), a1 + hstep, voffA);
            PG8_WAIT_L(8); PG8_BAR; PG8_WAIT_L(0); PG8_MMA(0, 0, At, B0); PG8_BAR; PG8_SCHED;
            PG8_LDB(B1, 0, 1); PG8_STAGE(PG8_SB(0, 0), b2, voffB);
            PG8_BAR; PG8_WAIT_L(0); PG8_MMA(0, 1, At, B1); PG8_BAR;
            PG8_LDA(At, 0, 1); PG8_STAGE(PG8_SA(0, 0), a2, voffA);
            PG8_BAR; PG8_WAIT_L(0); PG8_MMA(1, 0, At, B0); PG8_BAR; PG8_SCHED;
            PG8_STAGE(PG8_SB(0, 1), b2 + hstep, voffB);
            PG8_WAIT_V(6); PG8_BAR; PG8_MMA(1, 1, At, B1); PG8_BAR;
            PG8_LDB(B0, 1, 0); PG8_SCHED; PG8_LDA(At, 1, 0); PG8_STAGE(PG8_SA(0, 1), a2 + hstep, voffA);
            PG8_WAIT_L(8); PG8_BAR; PG8_WAIT_L(0); PG8_MMA(0, 0, At, B0); PG8_BAR; PG8_SCHED;
            PG8_LDB(B1, 1, 1); PG8_STAGE(PG8_SB(1, 0), b3, voffB);
            PG8_BAR; PG8_WAIT_L(0); PG8_MMA(0, 1, At, B1); PG8_BAR;
            PG8_LDA(At, 1, 1); PG8_STAGE(PG8_SA(1, 0), a3, voffA);
            PG8_BAR; PG8_WAIT_L(0); PG8_MMA(1, 0, At, B0); PG8_BAR; PG8_SCHED;
            PG8_STAGE(PG8_SB(1, 1), b3 + hstep, voffB);
            PG8_WAIT_V(6); PG8_BAR; PG8_MMA(1, 1, At, B1); PG8_BAR;
        }
        E(acc, cur, wr, wc, fr, fq);
        if (!has_next) break;
#pragma unroll
        for (int a = 0; a < 2; ++a)
#pragma unroll
            for (int b = 0; b < 2; ++b)
#pragma unroll
                for (int m = 0; m < 4; ++m)
#pragma unroll
                    for (int n = 0; n < 2; ++n) acc[a][b][m][n] = (f32x4){0.f, 0.f, 0.f, 0.f};
        cur = nxt; cA = nA; cB = nB; ++ui;
    }
    PG8_WAIT_V(0);
    if (wr == 0) PG8_BAR;
    PG8_BAR;
#undef PG8_SA
#undef PG8_SB
#undef PG8_STAGE
#undef PG8_LDA
#undef PG8_LDB
#undef PG8_MMA
#undef PG8_WAIT_V
#undef PG8_WAIT_L
#undef PG8_BAR
#undef PG8_SCHED
}
}

struct EpiIn {
    bf16_t* proj; bf16_t* vta; bf16_t* vtc; float* bint;
    DI void operator()(const f32x4 (&acc)[2][2][4][2], const pg8::Unit& u, int wr, int wc, int fr, int fq) const {
        const int colt = u.pn * 256;
        int kind = 0;
        if (colt < C_AGATE) { if ((colt % 3072) >= 2048) kind = 1; }
        else if (colt >= C_BIN && colt < C_BGATE) kind = 2;
        else if (colt >= C_CQKV + 2048 && colt < C_CGATE) kind = 3;
        const int row0 = u.pm * 256 + wr * 64 + fr, col0 = colt + wc * 32 + 4 * fq;
        if (kind == 0) {
#pragma unroll
            for (int ai = 0; ai < 2; ++ai)
#pragma unroll
                for (int m = 0; m < 4; ++m) { bf16_t* rp = proj + (size_t)(row0 + ai * 128 + m * 16) * NIN + col0;
#pragma unroll
                    for (int bj = 0; bj < 2; ++bj)
#pragma unroll
                        for (int n = 0; n < 2; ++n) { const f32x4 a = acc[ai][bj][m][n]; u32x2 o = {pk2(a[0], a[1]), pk2(a[2], a[3])}; *(u32x2*)(rp + bj * 128 + n * 16) = o; } }
        } else if (kind == 2) {
#pragma unroll
            for (int ai = 0; ai < 2; ++ai)
#pragma unroll
                for (int m = 0; m < 4; ++m) { const int row = row0 + ai * 128 + m * 16;
#pragma unroll
                    for (int bj = 0; bj < 2; ++bj)
#pragma unroll
                        for (int n = 0; n < 2; ++n) { const f32x4 a = acc[ai][bj][m][n]; float* bp = bint + (size_t)(col0 + bj * 128 + n * 16 - C_BIN) * S + row;
#pragma unroll
                            for (int e = 0; e < 4; ++e) bp[(size_t)e * S] = a[e]; } }
        } else {
            int sh = 0; bf16_t* base;
            if (kind == 1) { const int g = colt / 3072; sh = 2 * g; base = vta + (ptrdiff_t)(g * 1024 - g * 3072 - 2048) * (ptrdiff_t)S; }
            else base = vtc - (ptrdiff_t)(C_CQKV + 2048) * (ptrdiff_t)S;
#pragma unroll
            for (int ai = 0; ai < 2; ++ai)
#pragma unroll
                for (int m = 0; m < 4; ++m) { const int row = row0 + ai * 128 + m * 16; const int prow = ((row & ((1 << sh) - 1)) * (S >> sh)) + (row >> sh);
#pragma unroll
                    for (int bj = 0; bj < 2; ++bj)
#pragma unroll
                        for (int n = 0; n < 2; ++n) { const f32x4 a = acc[ai][bj][m][n]; bf16_t* bp = base + (ptrdiff_t)(col0 + bj * 128 + n * 16) * (ptrdiff_t)S + prow;
                            const unsigned p0 = pk2(a[0], a[1]), p1 = pk2(a[2], a[3]);
                            bp[0] = (bf16_t)(p0 & 0xffff); bp[(size_t)S] = (bf16_t)(p0 >> 16); bp[(size_t)2 * S] = (bf16_t)(p1 & 0xffff); bp[(size_t)3 * S] = (bf16_t)(p1 >> 16); } }
        }
    }
};
struct EpiProj {
    const bf16_t* proj; const float* mb; float* yf; bf16_t* yb; int nb;
    DI void operator()(const f32x4 (&acc)[2][2][4][2], const pg8::Unit& u, int wr, int wc, int fr, int fq) const {
        const int row0 = u.pm * 256 + wr * 64 + fr, col0 = u.pn * 256 + wc * 32 + 4 * fq;
#pragma unroll
        for (int ai = 0; ai < 2; ++ai)
#pragma unroll
            for (int m = 0; m < 4; ++m) { const int row = row0 + ai * 128 + m * 16;
#pragma unroll
                for (int bj = 0; bj < 2; ++bj)
#pragma unroll
                    for (int n = 0; n < 2; ++n) { const int col = col0 + bj * 128 + n * 16; const f32x4 a = acc[ai][bj][m][n];
                        const u32x2 mg = *(const u32x2*)(proj + (size_t)row * NIN + C_MERGE + nb * D + col);
                        const f32x4 b4 = *(const f32x4*)(mb + nb * D + col);
                        f32x4 v;
                        v[0] = a[0] * sigm_f(bflo(mg[0]) + b4[0]); v[1] = a[1] * sigm_f(bfhi(mg[0]) + b4[1]);
                        v[2] = a[2] * sigm_f(bflo(mg[1]) + b4[2]); v[3] = a[3] * sigm_f(bfhi(mg[1]) + b4[3]);
                        float* yp = yf + (size_t)row * D + col;
                        if (nb > 0) v += *(const f32x4*)yp;
                        if (nb < 2) *(f32x4*)yp = v;
                        else { u32x2 o = {pk2(v[0], v[1]), pk2(v[2], v[3])}; *(u32x2*)(yb + (size_t)row * D + col) = o; } } }
    }
};
struct EpiOut {
    const float* xold; float* xnew;
    DI void operator()(const f32x4 (&acc)[2][2][4][2], const pg8::Unit& u, int wr, int wc, int fr, int fq) const {
        const int row0 = u.pm * 256 + wr * 64 + fr, col0 = u.pn * 256 + wc * 32 + 4 * fq;
#pragma unroll
        for (int ai = 0; ai < 2; ++ai)
#pragma unroll
            for (int m = 0; m < 4; ++m) { const int row = row0 + ai * 128 + m * 16;
#pragma unroll
                for (int bj = 0; bj < 2; ++bj)
#pragma unroll
                    for (int n = 0; n < 2; ++n) { const size_t o = (size_t)row * D + col0 + bj * 128 + n * 16;
                        *(f32x4*)(xnew + o) = *(const f32x4*)(xold + o) + acc[ai][bj][m][n]; } }
    }
};
DI float wave_sum(float v) {
#pragma unroll
    for (int o = 1; o < 64; o <<= 1) v += __shfl_xor(v, o);
    return v;
}
DI int crow(int reg, int h) { return (reg & 3) + 8 * (reg >> 2) + 4 * h; }
DI bf16x8 pack8(const f32x16& x, const int s) {
    u32x4 p;
    p[0] = pk2(x[8 * s + 0], x[8 * s + 1]); p[1] = pk2(x[8 * s + 2], x[8 * s + 3]);
    p[2] = pk2(x[8 * s + 4], x[8 * s + 5]); p[3] = pk2(x[8 * s + 6], x[8 * s + 7]);
    return __builtin_bit_cast(bf16x8, p);
}
#define MFMA32(a, b, c) __builtin_amdgcn_mfma_f32_32x32x16_bf16((a), (b), (c), 0, 0, 0)

DI void transpose_item(const float* Wsrc, int K, int N, bf16_t* WT, LAS float* scr, int item, int lane) {
    const int nblk = N / 32, kb = item / nblk, nb = item % nblk, k0 = 64 * kb, n0 = 32 * nb;
#pragma unroll 8
    for (int i = 0; i < 32; ++i) { const int kk = 2 * i + (lane >> 5); scr[kk * 33 + (lane & 31)] = Wsrc[(size_t)(k0 + kk) * N + n0 + (lane & 31)]; }
    __builtin_amdgcn_wave_barrier();
    const int c = lane & 7;
#pragma unroll
    for (int j = 0; j < 4; ++j) { const int n = (lane >> 3) + 8 * j; const LAS float* s = scr + (8 * c) * 33 + n;
        u32x4 o; o[0] = pk2(s[0 * 33], s[1 * 33]); o[1] = pk2(s[2 * 33], s[3 * 33]); o[2] = pk2(s[4 * 33], s[5 * 33]); o[3] = pk2(s[6 * 33], s[7 * 33]);
        *(u32x4*)(WT + (size_t)(n0 + n) * K + k0 + 8 * c) = o; }
    __builtin_amdgcn_wave_barrier();
}
DI int t5_bucket(int rel) {
    const int ret = rel > 0 ? 16 : 0; const int n = rel < 0 ? -rel : rel;
    const float nf = (float)(n > 1 ? n : 1);
    int large = 8 + (int)(logf(nf / 8.0f) / 4.852030263919617f * 8.0f);
    large = large < 15 ? large : 15;
    return ret + (n < 8 ? n : large);
}
DI void phase_prologue(const Params& p, LAS unsigned char* lds) {
    const int tid = tidx(), wave = tid >> 6, lane = tid & 63;
    const int gw = blockIdx.x * NWAVES + wave, NGW = gridDim.x * NWAVES;
    LAS float* scr = (LAS float*)(lds + wave * 8704);
    bf16_t* win_t = (bf16_t*)(p.ws + WS_WIN); bf16_t* wpr_t = (bf16_t*)(p.ws + WS_WPR); bf16_t* wout_t = (bf16_t*)(p.ws + WS_WOUT);
    constexpr int IT_IN = (D / 64) * (NIN / 32), IT_PR = (1024 / 64) * (D / 32), IT_OUT = (D / 64) * (D / 32);
    constexpr int TOT = DEPTH * IT_IN + DEPTH * 3 * IT_PR + DEPTH * IT_OUT;
    for (int it = gw; it < TOT; it += NGW) {
        int r = it;
        if (r < DEPTH * IT_IN) { const int l = r / IT_IN; transpose_item(p.in[I_WIN] + (size_t)l * D * NIN, D, NIN, win_t + (size_t)l * NIN * D, scr, r % IT_IN, lane); continue; }
        r -= DEPTH * IT_IN;
        if (r < DEPTH * 3 * IT_PR) { const int l = r / IT_PR; transpose_item(p.in[I_WPROJ] + (size_t)l * 1024 * D, 1024, D, wpr_t + (size_t)l * D * 1024, scr, r % IT_PR, lane); continue; }
        r -= DEPTH * 3 * IT_PR;
        { const int l = r / IT_OUT; transpose_item(p.in[I_WOUT] + (size_t)l * D * D, D, D, wout_t + (size_t)l * D * D, scr, r % IT_OUT, lane); }
    }
    float* bias = (float*)(p.ws + WS_BIAS);
    for (int i = blockIdx.x * NTHR + tid; i < 32 * 2049; i += gridDim.x * NTHR) {
        const int hd = i / 2049, rel = (i % 2049) - 1024;
        bias[i] = p.in[I_RELB][t5_bucket(rel) * 32 + hd] * LOG2E;
    }
    __syncthreads();
    LAS float* zemb = (LAS float*)lds;
    LAS float* h1 = (LAS float*)(lds + 2048);
    float* hid2 = (float*)(p.ws + WS_HID2);
    for (int rb = blockIdx.x; rb < S / 8; rb += gridDim.x) {
        const int rl = tid >> 6, j = tid & 63, i = rb * 8 + rl;
        if (j < 33) {
            float z;
            if (j == 0) z = (float)i / 8191.0f;
            else { const int k = (j - 1) & 15; const float fb = 1e-4f + (float)k * ((15.0f - 1e-4f) / 15.0f); const float w = 6.283185307179586f * (float)i / 8192.0f; const float a = fb * w; z = (j <= 16) ? cosf(a) : -sinf(a); }
            zemb[rl * 36 + j] = z;
        }
        __syncthreads();
        for (int l = 0; l < DEPTH; ++l) {
            float a1 = p.in[I_HYB1][l * 64 + j];
            for (int e = 0; e < 33; ++e) a1 += zemb[rl * 36 + e] * p.in[I_HYW1][(l * 33 + e) * 64 + j];
            h1[rl * 64 + j] = sinf(p.in[I_HYFREQ][(l * 2 + 0) * 64 + j] * a1);
            __syncthreads();
            float a2 = p.in[I_HYB2][l * 64 + j];
            for (int e = 0; e < 64; ++e) a2 += h1[rl * 64 + e] * p.in[I_HYW2][(l * 64 + e) * 64 + j];
            hid2[((size_t)l * S + i) * 64 + j] = sinf(p.in[I_HYFREQ][(l * 2 + 1) * 64 + j] * a2);
            __syncthreads();
        }
    }
}

DI cf cmul(cf a, cf b) { return (cf){a.x * b.x - a.y * b.y, a.x * b.y + a.y * b.x}; }
DI cf twid(float frac) { return (cf){__builtin_amdgcn_cosf(frac), -__builtin_amdgcn_sinf(frac)}; }
DI cf twidc(float frac) { return (cf){__builtin_amdgcn_cosf(frac), __builtin_amdgcn_sinf(frac)}; }
DI void fwd4(cf& a0, cf& a1, cf& a2, cf& a3) {
    const cf s02 = a0 + a2, d02 = a0 - a2, s13 = a1 + a3, d13 = a1 - a3;
    a0 = s02 + s13; a2 = s02 - s13;
    a1 = (cf){d02.x + d13.y, d02.y - d13.x};
    a3 = (cf){d02.x - d13.y, d02.y + d13.x};
}
DI void inv4(cf& b0, cf& b1, cf& b2, cf& b3) {
    const cf s02 = b0 + b2, d02 = b0 - b2, s13 = b1 + b3, d13 = b1 - b3;
    b0 = s02 + s13; b2 = s02 - s13;
    b1 = (cf){d02.x - d13.y, d02.y + d13.x};
    b3 = (cf){d02.x + d13.y, d02.y - d13.x};
}
template <int LOGM> DI void fwd_r4_pass(LAS cf* X, int tid) {
    asm volatile("" : "+v"(tid));
    constexpr int M = 1 << LOGM, q = M >> 2;
#pragma unroll 2
    for (int t = tid; t < 4096; t += NTHR) {
        const int j = t & (q - 1), base = (t >> (LOGM - 2)) * M + j;
        cf a0 = X[base], a1 = X[base + q], a2 = X[base + 2 * q], a3 = X[base + 3 * q];
        fwd4(a0, a1, a2, a3);
        const cf w1 = twid((float)j * (1.0f / M)), w2 = cmul(w1, w1), w3 = cmul(w2, w1);
        X[base] = a0; X[base + q] = cmul(a1, w1); X[base + 2 * q] = cmul(a2, w2); X[base + 3 * q] = cmul(a3, w3);
    }
}
template <int LOGM> DI void inv_r4_pass(LAS cf* X, int tid) {
    asm volatile("" : "+v"(tid));
    constexpr int M = 1 << LOGM, q = M >> 2;
#pragma unroll 2
    for (int t = tid; t < 4096; t += NTHR) {
        const int j = t & (q - 1), base = (t >> (LOGM - 2)) * M + j;
        const cf w1 = twidc((float)j * (1.0f / M)), w2 = cmul(w1, w1), w3 = cmul(w2, w1);
        cf b0 = X[base], b1 = cmul(X[base + q], w1), b2 = cmul(X[base + 2 * q], w2), b3 = cmul(X[base + 3 * q], w3);
        inv4(b0, b1, b2, b3);
        X[base] = b0; X[base + q] = b1; X[base + 2 * q] = b2; X[base + 3 * q] = b3;
    }
}
template <int LOGM> DI void fwd16(cf (&v)[16], int j) {
    constexpr int M = 1 << LOGM, q = M >> 4;
#pragma unroll
    for (int n = 0; n < 4; ++n) {
        fwd4(v[n], v[n + 4], v[n + 8], v[n + 12]);
        const cf w1 = twid((float)(j + n * q) * (1.0f / M)), w2 = cmul(w1, w1), w3 = cmul(w2, w1);
        v[n + 4] = cmul(v[n + 4], w1); v[n + 8] = cmul(v[n + 8], w2); v[n + 12] = cmul(v[n + 12], w3);
    }
    const cf u1 = twid((float)j * (4.0f / M)), u2 = cmul(u1, u1), u3 = cmul(u2, u1);
#pragma unroll
    for (int m = 0; m < 4; ++m) {
        fwd4(v[4 * m], v[4 * m + 1], v[4 * m + 2], v[4 * m + 3]);
        v[4 * m + 1] = cmul(v[4 * m + 1], u1); v[4 * m + 2] = cmul(v[4 * m + 2], u2); v[4 * m + 3] = cmul(v[4 * m + 3], u3);
    }
}
template <int LOGM> DI void inv16(cf (&v)[16], int j) {
    constexpr int M = 1 << LOGM, q = M >> 4;
    const cf u1 = twidc((float)j * (4.0f / M)), u2 = cmul(u1, u1), u3 = cmul(u2, u1);
#pragma unroll
    for (int m = 0; m < 4; ++m) {
        v[4 * m + 1] = cmul(v[4 * m + 1], u1); v[4 * m + 2] = cmul(v[4 * m + 2], u2); v[4 * m + 3] = cmul(v[4 * m + 3], u3);
        inv4(v[4 * m], v[4 * m + 1], v[4 * m + 2], v[4 * m + 3]);
    }
#pragma unroll
    for (int n = 0; n < 4; ++n) {
        const cf w1 = twidc((float)(j + n * q) * (1.0f / M)), w2 = cmul(w1, w1), w3 = cmul(w2, w1);
        v[n + 4] = cmul(v[n + 4], w1); v[n + 8] = cmul(v[n + 8], w2); v[n + 12] = cmul(v[n + 12], w3);
        inv4(v[n], v[n + 4], v[n + 8], v[n + 12]);
    }
}
template <int LOGM> DI void fwd_r16_pass(LAS cf* X, int tid) {
    asm volatile("" : "+v"(tid));
    constexpr int M = 1 << LOGM, q = M >> 4;
#pragma unroll 1
    for (int t = tid; t < 1024; t += NTHR) {
        const int j = t & (q - 1), base = (t >> (LOGM - 4)) * M + j;
        cf v[16];
#pragma unroll
        for (int n = 0; n < 16; ++n) v[n] = X[base + n * q];
        fwd16<LOGM>(v, j);
#pragma unroll
        for (int n = 0; n < 16; ++n) X[base + n * q] = v[n];
    }
}
template <int LOGM> DI void inv_r16_pass(LAS cf* X, int tid) {
    asm volatile("" : "+v"(tid));
    constexpr int M = 1 << LOGM, q = M >> 4;
#pragma unroll 1
    for (int t = tid; t < 1024; t += NTHR) {
        const int j = t & (q - 1), base = (t >> (LOGM - 4)) * M + j;
        cf v[16];
#pragma unroll
        for (int n = 0; n < 16; ++n) v[n] = X[base + n * q];
        inv16<LOGM>(v, j);
#pragma unroll
        for (int n = 0; n < 16; ++n) X[base + n * q] = v[n];
    }
}
DI int rev4(int pp) { const unsigned br = __brev((unsigned)pp) >> 18; return (int)(((br & 0x2AAAu) >> 1) | ((br & 0x1555u) << 1)); }
DI void fft_forward(LAS cf* X, int tid) {
    fwd_r4_pass<14>(X, tid); __syncthreads();
    fwd_r16_pass<12>(X, tid); __syncthreads();
    fwd_r16_pass<8>(X, tid); __syncthreads();
    fwd_r16_pass<4>(X, tid); __syncthreads();
}
constexpr int SPEC_STRIDE = 8208;
DI void fft_conv(LAS cf* X, const f32x4* spec, int tid) {
    fft_forward(X, tid);
#pragma unroll 2
    for (int r = 0; r < 16; ++r) {
        const int k = tid + NTHR * r; const int pp = rev4(k);
        const f32x4 sp = spec[k]; const cf P = (cf){sp[0], sp[1]}, Mq = (cf){sp[2], sp[3]};
        const cf z = X[pp];
        if (k == 0) { X[pp] = cmul(z, P) + cmul((cf){z.x, -z.y}, Mq); }
        else { const int pm = rev4(16384 - k); const cf zm = X[pm];
            const cf y = cmul(z, P) + cmul((cf){zm.x, -zm.y}, Mq);
            const cf t = cmul((cf){zm.x, -zm.y}, P) + cmul(z, Mq);
            X[pp] = y; X[pm] = (cf){t.x, -t.y}; }
    }
    if (tid == 0) { const int pp = rev4(8192); const f32x4 sp = spec[8192]; const cf z = X[pp]; X[pp] = cmul(z, (cf){sp[0], sp[1]}) + cmul((cf){z.x, -z.y}, (cf){sp[2], sp[3]}); }
    __syncthreads();
    inv_r16_pass<4>(X, tid); __syncthreads();
    inv_r16_pass<8>(X, tid); __syncthreads();
    inv_r16_pass<12>(X, tid); __syncthreads();
    inv_r4_pass<14>(X, tid); __syncthreads();
}

DI void spectra_item(const Params& p, int item, LAS unsigned char* lds) {
    int tid = tidx(); asm volatile("" : "+v"(tid));
    const int l = item >> 10, o = (item >> 9) & 1, pr = item & 511, a = 2 * pr;
    LAS cf* X = (LAS cf*)lds; LAS float* aux = (LAS float*)(lds + LDS_MAIN);
    if (tid < 256) { const int j = tid >> 2, e = tid & 3; aux[tid] = p.in[I_HYW3][(size_t)(l * 64 + j) * 4096 + (o * 2 + (e >> 1)) * 1024 + a + (e & 1)]; }
    __syncthreads();
    const float mind = -3.0701134573253943f, maxd = -15.350567286626972f;
    const float da = fabsf(mind + (float)a * ((maxd - mind) / 1023.0f)), db = fabsf(mind + (float)(a + 1) * ((maxd - mind) / 1023.0f));
    const float* hid2 = (const float*)(p.ws + WS_HID2) + (size_t)l * S * 64;
    const float ska = p.in[I_HYSKIP][(l * 2 + o) * 1024 + a], skb = p.in[I_HYSKIP][(l * 2 + o) * 1024 + a + 1];
#pragma unroll 1
    for (int r = 0; r < 16; ++r) {
        const int i = tid + NTHR * r;
        const f32x4* hr = (const f32x4*)(hid2 + (size_t)i * 64);
        float d0 = 0.f, d1 = 0.f, d2 = 0.f, d3 = 0.f;
#pragma unroll
        for (int jj = 0; jj < 16; ++jj) { const f32x4 hv = hr[jj];
#pragma unroll
            for (int e = 0; e < 4; ++e) { const f32x4 wv = *(const LAS f32x4*)(aux + (jj * 4 + e) * 4); d0 += hv[e] * wv[0]; d1 += hv[e] * wv[1]; d2 += hv[e] * wv[2]; d3 += hv[e] * wv[3]; } }
        const float ti = (float)i / 8191.0f; const float ea = __expf(-ti * da), eb = __expf(-ti * db);
        const float fa = d0 * ea, fb = d1 * eb, ba = d2 * ea, bb = d3 * eb;
        if (i == 0) { X[0] = (cf){fa + ba + ska, fb + bb + skb}; X[8192] = (cf){0.f, 0.f}; }
        else { X[i] = (cf){fa, fb}; X[16384 - i] = (cf){ba, bb}; }
    }
    __syncthreads();
    fft_forward(X, tid);
    f32x4* spec = (f32x4*)(p.ws + WS_SPEC) + (size_t)item * SPEC_STRIDE;
    const float sc = 0.5f / 16384.0f;
    for (int r = 0; r < 17; ++r) {
        const int k = tid + NTHR * r; if (k > 8192) break;
        const cf F = X[rev4(k)], Fm = X[rev4((16384 - k) & 16383)];
        const cf Fc = (cf){Fm.x, -Fm.y};
        const cf Ha = (F + Fc) * 0.5f, tt = (F - Fc) * 0.5f; const cf Hb = (cf){tt.y, -tt.x};
        const cf P = (Ha + Hb) * sc, Mq = (Ha - Hb) * sc;
        spec[k] = (f32x4){P.x, P.y, Mq.x, Mq.y};
    }
    __syncthreads();
}

DI float conv3(const float* row, int t, float w0, float w1, float w2) {
    const float c = row[t]; const float pv = t > 0 ? row[t - 1] : 0.f; const float nx = t < S - 1 ? row[t + 1] : 0.f;
    return w0 * pv + w1 * c + w2 * nx;
}
DI void hyena_item(const Params& p, int l, int pr, LAS unsigned char* lds) {
    int tid = tidx(); asm volatile("" : "+v"(tid)); const int a = 2 * pr;
    LAS cf* X = (LAS cf*)lds;
    const float* bint = (const float*)(p.ws + WS_BINT);
    const float* cw = p.in[I_HYCONV] + (size_t)l * 3 * 3072;
    float w[3][2][3];
#pragma unroll
    for (int wh = 0; wh < 3; ++wh)
#pragma unroll
        for (int c = 0; c < 2; ++c)
#pragma unroll
            for (int k = 0; k < 3; ++k) w[wh][c][k] = cw[k * 3072 + wh * 1024 + a + c];
    const f32x4* spec = (const f32x4*)(p.ws + WS_SPEC);
#pragma unroll 2
    for (int r = 0; r < 16; ++r) { const int t = tid + NTHR * r;
        X[t] = (cf){conv3(bint + (size_t)a * S, t, w[0][0][0], w[0][0][1], w[0][0][2]), conv3(bint + (size_t)(a + 1) * S, t, w[0][1][0], w[0][1][1], w[0][1][2])};
        X[t + 8192] = (cf){0.f, 0.f}; }
    __syncthreads();
    fft_conv(X, spec + (size_t)((l * 2 + 0) * 512 + pr) * SPEC_STRIDE, tid);
#pragma unroll 2
    for (int r = 0; r < 16; ++r) { const int t = tid + NTHR * r; const cf y = X[t];
        X[t] = (cf){y.x * conv3(bint + (size_t)(1024 + a) * S, t, w[1][0][0], w[1][0][1], w[1][0][2]), y.y * conv3(bint + (size_t)(1024 + a + 1) * S, t, w[1][1][0], w[1][1][1], w[1][1][2])};
        X[t + 8192] = (cf){0.f, 0.f}; }
    __syncthreads();
    fft_conv(X, spec + (size_t)((l * 2 + 1) * 512 + pr) * SPEC_STRIDE, tid);
    float* z2t = (float*)(p.ws + WS_Z2T);
#pragma unroll 2
    for (int r = 0; r < 16; ++r) { const int t = tid + NTHR * r; const cf y = X[t];
        z2t[(size_t)a * S + t] = y.x * conv3(bint + (size_t)(2048 + a) * S, t, w[2][0][0], w[2][0][1], w[2][0][2]);
        z2t[(size_t)(a + 1) * S + t] = y.y * conv3(bint + (size_t)(2048 + a + 1) * S, t, w[2][1][0], w[2][1][1], w[2][1][2]); }
    __syncthreads();
}
DI void phase_rmsnorm(const float* x, const float* g, bf16_t* hout, float* fout) {
    const int tid = tidx(), wave = tid >> 6, lane = tid & 63;
    for (int row = blockIdx.x * NWAVES + wave; row < S; row += gridDim.x * NWAVES) {
        const f32x4* xr = (const f32x4*)(x + (size_t)row * D) + lane;
        f32x4 v[8]; float s = 0.f;
#pragma unroll
        for (int j = 0; j < 8; ++j) { v[j] = xr[64 * j]; s += (v[j][0] * v[j][0] + v[j][1] * v[j][1]) + (v[j][2] * v[j][2] + v[j][3] * v[j][3]); }
        const float rstd = rsqrtf(wave_sum(s) * (1.0f / D) + 1e-6f);
#pragma unroll
        for (int j = 0; j < 8; ++j) { const f32x4 gg = ((const f32x4*)g)[lane + 64 * j]; const f32x4 y = v[j] * rstd * gg;
            if (hout) { u32x2 o = {pk2(y[0], y[1]), pk2(y[2], y[3])}; ((u32x2*)(hout + (size_t)row * D))[lane + 64 * j] = o; }
            else ((f32x4*)(fout + (size_t)row * D))[lane + 64 * j] = y; }
    }
}

constexpr int KROW = 144, KBUF = 64 * KROW, VBUF = 128 * KROW;
DI void diff_flash(const bf16_t* proj, const bf16_t* vtc, int h, int c, int q0w, LAS unsigned char* lds, const LAS float* btab, f32x16 (&O)[4]) {
    int tid = tidx(); asm volatile("" : "+v"(tid)); const int lane = tid & 63, r = lane & 31, hh = lane >> 5;
    bf16x8 qf[4];
    { const bf16_t* qp = proj + (size_t)(q0w + r) * NIN + C_CQKV + h * 128 + c * 64 + 8 * hh;
#pragma unroll
      for (int ks = 0; ks < 4; ++ks) qf[ks] = *(const bf16x8*)(qp + 16 * ks); }
#pragma unroll
    for (int db = 0; db < 4; ++db)
#pragma unroll
        for (int i = 0; i < 16; ++i) O[db][i] = 0.f;
    float m = -1e30f, lsum = 0.f;
    const float cs = 0.125f * LOG2E;
    const bf16_t* kg = proj + C_CQKV + 1024 + h * 128 + c * 64 + (size_t)(tid >> 3) * NIN + (tid & 7) * 8;
    const bf16_t* vg = vtc + (size_t)(h * 128 + (tid >> 3)) * S + (tid & 7) * 8;
    const int kst = (tid >> 3) * KROW + (tid & 7) * 16;
    LAS unsigned char* Kb = lds; LAS unsigned char* Vb = lds + 2 * KBUF;
    u32x4 kr = *(const u32x4*)kg, v0 = *(const u32x4*)vg, v1 = *(const u32x4*)(vg + (size_t)64 * S);
    __syncthreads();
    *(LAS u32x4*)(Kb + kst) = kr; *(LAS u32x4*)(Vb + kst) = v0; *(LAS u32x4*)(Vb + 64 * KROW + kst) = v1;
    __syncthreads();
    for (int kt = 0; kt < S / 64; ++kt) {
        const int buf = kt & 1;
        if (kt + 1 < S / 64) { kr = *(const u32x4*)(kg + (size_t)(kt + 1) * 64 * NIN); v0 = *(const u32x4*)(vg + (kt + 1) * 64); v1 = *(const u32x4*)(vg + (size_t)64 * S + (kt + 1) * 64); }
        const LAS unsigned char* kb_ = Kb + buf * KBUF; const LAS unsigned char* vb_ = Vb + buf * VBUF;
        f32x16 s0, s1;
#pragma unroll
        for (int i = 0; i < 16; ++i) { s0[i] = 0.f; s1[i] = 0.f; }
#pragma unroll
        for (int ks = 0; ks < 4; ++ks) { const bf16x8 a = *(const LAS bf16x8*)(kb_ + r * KROW + 32 * ks + 16 * hh); s0 = MFMA32(a, qf[ks], s0); }
#pragma unroll
        for (int ks = 0; ks < 4; ++ks) { const bf16x8 a = *(const LAS bf16x8*)(kb_ + (32 + r) * KROW + 32 * ks + 16 * hh); s1 = MFMA32(a, qf[ks], s1); }
        const int k0 = kt * 64, q = q0w + r;
        const int relmin = k0 - q0w - 31, relmax = k0 + 63 - q0w;
        if (relmin >= 1024 || relmax <= -1024) {
            const float bc = btab[relmin >= 1024 ? 2048 : 0];
#pragma unroll
            for (int i = 0; i < 16; ++i) { s0[i] = s0[i] * cs + bc; s1[i] = s1[i] * cs + bc; }
        } else {
#pragma unroll
            for (int i = 0; i < 16; ++i) { int rel = k0 + crow(i, hh) - q; int i0 = min(max(rel, -1024), 1024) + 1024; int i1 = min(max(rel + 32, -1024), 1024) + 1024;
                s0[i] = s0[i] * cs + btab[i0]; s1[i] = s1[i] * cs + btab[i1]; }
        }
        float mx = s0[0];
#pragma unroll
        for (int i = 1; i < 16; ++i) mx = fmaxf(mx, s0[i]);
#pragma unroll
        for (int i = 0; i < 16; ++i) mx = fmaxf(mx, s1[i]);
        mx = fmaxf(mx, __shfl_xor(mx, 32));
        const float mnew = fmaxf(m, mx), alpha = __builtin_amdgcn_exp2f(m - mnew);
        m = mnew;
        float rs = 0.f;
#pragma unroll
        for (int i = 0; i < 16; ++i) { s0[i] = __builtin_amdgcn_exp2f(s0[i] - mnew); s1[i] = __builtin_amdgcn_exp2f(s1[i] - mnew); rs += s0[i] + s1[i]; }
        lsum = lsum * alpha + rs;
#pragma unroll
        for (int db = 0; db < 4; ++db) O[db] *= alpha;
#pragma unroll
        for (int s = 0; s < 4; ++s) {
            const bf16x8 pf = (s < 2) ? pack8(s0, s & 1) : pack8(s1, s & 1);
#pragma unroll
            for (int db = 0; db < 4; ++db) {
                const LAS unsigned char* vp = vb_ + (32 * db + r) * KROW + (16 * s + 4 * hh) * 2;
                const s16x4 lo = *(const LAS s16x4*)vp, hi = *(const LAS s16x4*)(vp + 16);
                const bf16x8 vf = __builtin_shufflevector(lo, hi, 0, 1, 2, 3, 4, 5, 6, 7);
                O[db] = MFMA32(vf, pf, O[db]);
            }
        }
        if (kt + 1 < S / 64) {
            LAS unsigned char* kn = Kb + (buf ^ 1) * KBUF; LAS unsigned char* vn = Vb + (buf ^ 1) * VBUF;
            *(LAS u32x4*)(kn + kst) = kr; *(LAS u32x4*)(vn + kst) = v0; *(LAS u32x4*)(vn + 64 * KROW + kst) = v1;
        }
        __syncthreads();
    }
    const float lt = lsum + __shfl_xor(lsum, 32), inv = 1.0f / lt;
#pragma unroll
    for (int db = 0; db < 4; ++db) O[db] *= inv;
}
DI void diffattn_item(const Params& p, int l, int item, LAS unsigned char* lds) {
    int tid = tidx(); asm volatile("" : "+v"(tid)); const int wave = __builtin_amdgcn_readfirstlane(tid >> 6), lane = tid & 63, r = lane & 31, hh = lane >> 5;
    const int qt = item >> 3, h = item & 7, q0w = qt * 256 + wave * 32;
    LAS float* btab = (LAS float*)(lds + LDS_MAIN);
    const float* bias = (const float*)(p.ws + WS_BIAS) + (24 + h) * 2049;
    for (int i = tid; i < 2049; i += NTHR) btab[i] = bias[i];
    const float* dl = p.in[I_DLAM] + l * 256;
    float d01 = 0.f, d23 = 0.f;
    for (int i = 0; i < 64; ++i) { d01 += dl[i] * dl[64 + i]; d23 += dl[128 + i] * dl[192 + i]; }
    const float lam_init = 0.8f - 0.6f * expf(-0.3f * (float)l);
    const float lam = expf(d01) - expf(d23) + lam_init;
    const bf16_t* proj = (const bf16_t*)(p.ws + WS_PROJ); const bf16_t* vtc = (const bf16_t*)(p.ws + WS_VTC);
    f32x16 O0[4];
    const int q = q0w + r;
    float* ctmp = (float*)(p.ws + WS_CTMP) + (size_t)q * 1024 + h * 128 + 4 * hh;
    diff_flash(proj, vtc, h, 0, q0w, lds, btab, O0);
#pragma unroll
    for (int db = 0; db < 4; ++db)
#pragma unroll
        for (int i4 = 0; i4 < 4; ++i4) { f32x4 o = {O0[db][4 * i4], O0[db][4 * i4 + 1], O0[db][4 * i4 + 2], O0[db][4 * i4 + 3]}; *(f32x4*)(ctmp + 32 * db + 8 * i4) = o; }
    diff_flash(proj, vtc, h, 1, q0w, lds, btab, O0);
    float ss = 0.f;
#pragma unroll
    for (int db = 0; db < 4; ++db)
#pragma unroll
        for (int i4 = 0; i4 < 4; ++i4) { const f32x4 o0 = *(const f32x4*)(ctmp + 32 * db + 8 * i4);
#pragma unroll
            for (int e = 0; e < 4; ++e) { const float o = o0[e] - lam * O0[db][4 * i4 + e]; O0[db][4 * i4 + e] = o; ss += o * o; } }
    ss += __shfl_xor(ss, 32);
    const float rn = rsqrtf(ss * (1.0f / 128.0f) + 1e-6f) * (1.0f - lam_init);
    const float* dg = p.in[I_DG] + l * 128;
    bf16_t* cout = (bf16_t*)(p.ws + WS_BR) + (size_t)2 * S * 1024;
#pragma unroll
    for (int db = 0; db < 4; ++db)
#pragma unroll
        for (int i4 = 0; i4 < 4; ++i4) {
            const int d0 = 32 * db + 8 * i4 + 4 * hh;
            const f32x4 g4 = *(const f32x4*)(dg + d0);
            const u32x2 gt = *(const u32x2*)(proj + (size_t)q * NIN + C_CGATE + h * 128 + d0);
            const float y0 = O0[db][4 * i4 + 0] * rn * g4[0] * silu_f(bflo(gt[0])), y1 = O0[db][4 * i4 + 1] * rn * g4[1] * silu_f(bfhi(gt[0]));
            const float y2 = O0[db][4 * i4 + 2] * rn * g4[2] * silu_f(bflo(gt[1])), y3 = O0[db][4 * i4 + 3] * rn * g4[3] * silu_f(bfhi(gt[1]));
            u32x2 o = {pk2(y0, y1), pk2(y2, y3)};
            *(u32x2*)(cout + (size_t)q * 1024 + h * 128 + d0) = o;
        }
    __syncthreads();
}

DI void mixA_wave_item(const Params& p, int wi, int lane) {
    asm volatile("" : "+v"(lane));
    const int g = wi >> 11, rem = wi & 2047, h = rem >> 8, qb = rem & 255;
    const int sh = 2 * g, n = S >> sh, nbq = 256 >> sh, res = qb / nbq, m0 = (qb % nbq) * 32;
    const int r = lane & 31, hh = lane >> 5;
    const bf16_t* proj = (const bf16_t*)(p.ws + WS_PROJ);
    const int qpos = ((m0 + r) << sh) + res;
    bf16x8 qf[8];
    { const bf16_t* qp = proj + (size_t)qpos * NIN + g * 3072 + h * 128 + 8 * hh;
#pragma unroll
      for (int ks = 0; ks < 8; ++ks) qf[ks] = *(const bf16x8*)(qp + 16 * ks); }
    f32x16 O[4];
#pragma unroll
    for (int db = 0; db < 4; ++db)
#pragma unroll
        for (int i = 0; i < 16; ++i) O[db][i] = 0.f;
    float m = -1e30f, lsum = 0.f;
    const float cs = 0.08838834764831845f * LOG2E;
    const float* bias = (const float*)(p.ws + WS_BIAS) + (g * 8 + h) * 2049 + 1024;
    const bf16_t* vt = (const bf16_t*)(p.ws + WS_VTA) + (size_t)((g * 8 + h) * 128) * S + res * n;
    for (int kb = 0; kb < 5; ++kb) {
        const int mk0 = m0 - 64 + 32 * kb;
        if (mk0 < 0 || mk0 >= n) continue;
        const int kpos = ((mk0 + r) << sh) + res;
        const bf16_t* kp = proj + (size_t)kpos * NIN + g * 3072 + 1024 + h * 128 + 8 * hh;
        f32x16 s;
#pragma unroll
        for (int i = 0; i < 16; ++i) s[i] = 0.f;
#pragma unroll
        for (int ks = 0; ks < 8; ++ks) { const bf16x8 a = *(const bf16x8*)(kp + 16 * ks); s = MFMA32(a, qf[ks], s); }
        float mx = -INFINITY;
#pragma unroll
        for (int i = 0; i < 16; ++i) { const int rel = mk0 + crow(i, hh) - (m0 + r); const bool valid = (rel <= 64) && (rel >= -64);
            const int bi = min(max(rel << sh, -1024), 1024);
            const float v = valid ? (s[i] * cs + bias[bi]) : -INFINITY; s[i] = v; mx = fmaxf(mx, v); }
        mx = fmaxf(mx, __shfl_xor(mx, 32));
        const float mnew = fmaxf(m, mx), alpha = __builtin_amdgcn_exp2f(m - mnew);
        m = mnew;
        float rs = 0.f;
#pragma unroll
        for (int i = 0; i < 16; ++i) { s[i] = __builtin_amdgcn_exp2f(s[i] - mnew); rs += s[i]; }
        lsum = lsum * alpha + rs;
#pragma unroll
        for (int db = 0; db < 4; ++db) O[db] *= alpha;
#pragma unroll
        for (int sidx = 0; sidx < 2; ++sidx) {
            const bf16x8 pf = pack8(s, sidx);
#pragma unroll
            for (int db = 0; db < 4; ++db) {
                const bf16_t* vp = vt + (size_t)(32 * db + r) * S + mk0 + 16 * sidx + 4 * hh;
                const s16x4 lo = *(const s16x4*)vp, hi = *(const s16x4*)(vp + 8);
                const bf16x8 vf = __builtin_shufflevector(lo, hi, 0, 1, 2, 3, 4, 5, 6, 7);
                O[db] = MFMA32(vf, pf, O[db]);
            }
        }
    }
    const float lt = lsum + __shfl_xor(lsum, 32), inv = 1.0f / lt;
    float* oa = (float*)(p.ws + WS_OA) + ((size_t)g * S + qpos) * 1024 + h * 128;
#pragma unroll
    for (int db = 0; db < 4; ++db)
#pragma unroll
        for (int i4 = 0; i4 < 4; ++i4) {
            const int d0 = 32 * db + 8 * i4 + 4 * hh;
            f32x4 o = {O[db][4 * i4] * inv, O[db][4 * i4 + 1] * inv, O[db][4 * i4 + 2] * inv, O[db][4 * i4 + 3] * inv};
            *(f32x4*)(oa + d0) = o;
        }
    if (hh == 0) ((float*)(p.ws + WS_LSEA))[((size_t)g * S + qpos) * 8 + h] = m + __log2f(lt);
}

DI void phase_post(const Params& p, LAS unsigned char* lds) {
    const int tid = tidx();
    const bf16_t* proj = (const bf16_t*)(p.ws + WS_PROJ);
    bf16_t* aout = (bf16_t*)(p.ws + WS_BR); bf16_t* bout = aout + (size_t)S * 1024;
    const float* oa = (const float*)(p.ws + WS_OA); const float* lse = (const float*)(p.ws + WS_LSEA);
    for (int idx = blockIdx.x * NTHR + tid; idx < S * 256; idx += gridDim.x * NTHR) {
        const int pos = idx >> 8, c4 = idx & 255, h = c4 >> 5, col = c4 * 4;
        const float l0 = lse[((size_t)0 * S + pos) * 8 + h], l1 = lse[((size_t)1 * S + pos) * 8 + h], l2 = lse[((size_t)2 * S + pos) * 8 + h];
        const float mx = fmaxf(l0, fmaxf(l1, l2));
        const float w0 = __builtin_amdgcn_exp2f(l0 - mx), w1 = __builtin_amdgcn_exp2f(l1 - mx), w2 = __builtin_amdgcn_exp2f(l2 - mx);
        const float inv = 1.0f / (w0 + w1 + w2);
        const f32x4 o0 = *(const f32x4*)(oa + ((size_t)0 * S + pos) * 1024 + col), o1 = *(const f32x4*)(oa + ((size_t)1 * S + pos) * 1024 + col), o2 = *(const f32x4*)(oa + ((size_t)2 * S + pos) * 1024 + col);
        const f32x4 o = (o0 * w0 + o1 * w1 + o2 * w2) * inv;
        const u32x2 gt = *(const u32x2*)(proj + (size_t)pos * NIN + C_AGATE + col);
        u32x2 ov = {pk2(o[0] * silu_f(bflo(gt[0])), o[1] * silu_f(bfhi(gt[0]))), pk2(o[2] * silu_f(bflo(gt[1])), o[3] * silu_f(bfhi(gt[1])))};
        *(u32x2*)(aout + (size_t)pos * 1024 + col) = ov;
    }
    LAS float* tile = (LAS float*)lds;
    const float* z2t = (const float*)(p.ws + WS_Z2T);
    for (int it = blockIdx.x; it < 128 * 16; it += gridDim.x) {
        const int t0 = (it >> 4) * 64, c0 = (it & 15) * 64;
        __syncthreads();
#pragma unroll
        for (int k = 0; k < 2; ++k) { const int e = tid + NTHR * k; const int ci = e >> 4, t4 = (e & 15) * 4;
            const f32x4 v = *(const f32x4*)(z2t + (size_t)(c0 + ci) * S + t0 + t4);
            tile[ci * 65 + t4] = v[0]; tile[ci * 65 + t4 + 1] = v[1]; tile[ci * 65 + t4 + 2] = v[2]; tile[ci * 65 + t4 + 3] = v[3]; }
        __syncthreads();
#pragma unroll
        for (int k = 0; k < 2; ++k) { const int e = tid + NTHR * k; const int ti = e >> 4, cc = (e & 15) * 4;
            const u32x2 gt = *(const u32x2*)(proj + (size_t)(t0 + ti) * NIN + C_BGATE + c0 + cc);
            const float y0 = tile[(cc + 0) * 65 + ti] * silu_f(bflo(gt[0])), y1 = tile[(cc + 1) * 65 + ti] * silu_f(bfhi(gt[0]));
            const float y2 = tile[(cc + 2) * 65 + ti] * silu_f(bflo(gt[1])), y3 = tile[(cc + 3) * 65 + ti] * silu_f(bfhi(gt[1]));
            u32x2 ov = {pk2(y0, y1), pk2(y2, y3)};
            *(u32x2*)(bout + (size_t)(t0 + ti) * 1024 + c0 + cc) = ov; }
    }
    __syncthreads();
}

constexpr int NPH = 2 + 6 * DEPTH + 1;
typedef const Params __attribute__((address_space(4)))* ParamsK;
DI Params ldp(ParamsK pc) {
    asm volatile("" : "+s"(pc));
    Params q;
#pragma unroll
    for (int i = 0; i < 18; ++i) q.in[i] = pc->in[i];
    q.out = pc->out; q.ws = pc->ws; q.ph_lo = pc->ph_lo; q.ph_hi = pc->ph_hi;
    return q;
}
DI void run_phase(ParamsK pc, int ph, LAS unsigned char* lds) {
    if (ph == 0) { const Params p = ldp(pc); phase_prologue(p, lds); return; }
    if (ph == 1) { const Params p = ldp(pc); for (int it = blockIdx.x; it < DEPTH * 2 * 512; it += gridDim.x) spectra_item(p, it, lds); return; }
    if (ph == NPH - 1) { const Params p = ldp(pc); phase_rmsnorm((const float*)(p.ws + WS_X), p.in[I_FINALG], nullptr, p.out); return; }
    const int l = (ph - 2) / 6, sp = (ph - 2) % 6;
    if (sp == 0) { const Params p = ldp(pc); phase_rmsnorm((l == 0) ? p.in[I_X] : (const float*)(p.ws + WS_X), p.in[I_NORMG] + l * D, (bf16_t*)(p.ws + WS_H), nullptr); return; }
    if (sp == 1) {
        const Params p = ldp(pc);
        pg8::Gemm g{(const bf16_t*)(p.ws + WS_H), (const bf16_t*)(p.ws + WS_WIN) + (size_t)l * NIN * D, S, NIN, D};
        pg8::StaticOrder so; so.init(S, NIN, gridDim.x, blockIdx.x);
        EpiIn e{(bf16_t*)(p.ws + WS_PROJ), (bf16_t*)(p.ws + WS_VTA), (bf16_t*)(p.ws + WS_VTC), (float*)(p.ws + WS_BINT)};
        pg8::gemm_phase(lds, g, so, e); return;
    }
    if (sp == 2) {
#pragma unroll 1
        for (int it = blockIdx.x; it < 256 + 512 + 768; it += gridDim.x) {
            int l2 = l; asm volatile("" : "+s"(l2));
            const Params p = ldp(pc);
            if (it < 256) diffattn_item(p, l2, it, lds);
            else if (it < 768) hyena_item(p, l2, it - 256, lds);
            else mixA_wave_item(p, (it - 768) * NWAVES + (tidx() >> 6), tidx() & 63);
        }
        return;
    }
    if (sp == 3) { const Params p = ldp(pc); phase_post(p, lds); return; }
    if (sp == 4) {
#pragma unroll 1
        for (int nb = 0; nb < 3; ++nb) {
            const Params p = ldp(pc);
            pg8::Gemm g{(const bf16_t*)(p.ws + WS_BR) + (size_t)nb * S * 1024, (const bf16_t*)(p.ws + WS_WPR) + (size_t)(l * 3 + nb) * D * 1024, S, D, 1024};
            pg8::StaticOrder so; so.init(S, D, gridDim.x, blockIdx.x);
            EpiProj e{(const bf16_t*)(p.ws + WS_PROJ), p.in[I_MERGEB] + (size_t)l * 3 * D, (float*)(p.ws + WS_YF), (bf16_t*)(p.ws + WS_YB), nb};
            pg8::gemm_phase(lds, g, so, e);
            __syncthreads();
        }
        return;
    }
    {
        const Params p = ldp(pc);
        pg8::Gemm g{(const bf16_t*)(p.ws + WS_YB), (const bf16_t*)(p.ws + WS_WOUT) + (size_t)l * D * D, S, D, D};
        pg8::StaticOrder so; so.init(S, D, gridDim.x, blockIdx.x);
        EpiOut e{(l == 0) ? p.in[I_X] : (const float*)(p.ws + WS_X), (float*)(p.ws + WS_X)};
        pg8::gemm_phase(lds, g, so, e);
    }
}

__global__ void __launch_bounds__(512, 2) mega_kernel(Params p) {
#if defined(__HIP_DEVICE_COMPILE__)
    extern __shared__ __attribute__((aligned(16))) unsigned char shm[];
    LAS unsigned char* lds = (LAS unsigned char*)shm;
    cg::grid_group grid = cg::this_grid();
    const int ph_lo = p.ph_lo, ph_hi = p.ph_hi;
#pragma unroll 1
    for (int ph = ph_lo; ph < ph_hi; ++ph) {
        ParamsK pc = (ParamsK)__builtin_amdgcn_kernarg_segment_ptr();
        run_phase(pc, ph, lds);
        if (ph + 1 < ph_hi) grid.sync();
    }
#endif
}

#ifndef N_LAUNCH_MODE
#define N_LAUNCH_MODE 0
#endif
extern "C" void kernel_launch(void* const* d_in, const int* in_sizes, int n_in, void* d_out, int out_size, void* d_ws, size_t ws_size, hipStream_t stream) {
    static int grid = 0;
    if (grid == 0) {
        int dev = 0, cus = 0;
        if (hipGetDevice(&dev) != hipSuccess || hipDeviceGetAttribute(&cus, hipDeviceAttributeMultiprocessorCount, dev) != hipSuccess) { fprintf(stderr, "kernel_launch: device query failed\n"); grid = -1; return; }
        if (hipFuncSetAttribute((const void*)mega_kernel, hipFuncAttributeMaxDynamicSharedMemorySize, LDS_BYTES) != hipSuccess) { fprintf(stderr, "kernel_launch: hipFuncSetAttribute failed\n"); grid = -1; return; }
        int per_cu = 0;
        if (hipOccupancyMaxActiveBlocksPerMultiprocessor(&per_cu, (const void*)mega_kernel, NTHR, LDS_BYTES) != hipSuccess || per_cu < 1) { fprintf(stderr, "kernel_launch: occupancy query says %d\n", per_cu); (void)hipGetLastError(); }
        if (n_in != 18 || ws_size < WS_END) { fprintf(stderr, "kernel_launch: n_in %d ws %zu (need %zu)\n", n_in, ws_size, (size_t)WS_END); grid = -1; return; }
        grid = cus;
    }
    if (grid < 0) return;
    Params p{};
    for (int i = 0; i < 18; ++i) p.in[i] = (const float*)d_in[i];
    p.out = (float*)d_out; p.ws = (unsigned char*)d_ws;
#if N_LAUNCH_MODE == 1
    p.ph_lo = 0; p.ph_hi = NPH;
    void* args[] = {&p};
    hipError_t e = hipLaunchCooperativeKernel((const void*)mega_kernel, dim3(grid), dim3(NTHR), args, LDS_BYTES, stream);
    if (e != hipSuccess) fprintf(stderr, "cooperative launch failed: %s (grid %d)\n", hipGetErrorString(e), grid);
#else
    for (int ph = 0; ph < NPH; ++ph) {
        p.ph_lo = ph; p.ph_hi = ph + 1;
        hipLaunchKernelGGL(mega_kernel, dim3(grid), dim3(NTHR), LDS_BYTES, stream, p);
    }
#endif
}
```

```cpp
#include <hip/hip_runtime.h>
#include <hip/hip_cooperative_groups.h>
#include <cstdio>
namespace cg = cooperative_groups;
#define DI __device__ __forceinline__
#define LAS __attribute__((address_space(3)))
typedef unsigned short bf16_t;
typedef short bf16x8 __attribute__((ext_vector_type(8)));
typedef short s16x4 __attribute__((ext_vector_type(4)));
typedef float f32x4 __attribute__((ext_vector_type(4)));
typedef float f32x16 __attribute__((ext_vector_type(16)));
typedef float f32x2 __attribute__((ext_vector_type(2)));
typedef float cf __attribute__((ext_vector_type(2)));
typedef __bf16 bf16x2n __attribute__((ext_vector_type(2)));
typedef unsigned u32x2 __attribute__((ext_vector_type(2)));
typedef unsigned u32x4 __attribute__((ext_vector_type(4)));

DI unsigned pk2(float lo, float hi) { f32x2 v = {lo, hi}; return __builtin_bit_cast(unsigned, __builtin_convertvector(v, bf16x2n)); }
DI float bflo(unsigned u) { return __uint_as_float(u << 16); }
DI float bfhi(unsigned u) { return __uint_as_float(u & 0xffff0000u); }
DI float silu_f(float x) { return x / (1.0f + __expf(-x)); }
DI float sigm_f(float x) { return 1.0f / (1.0f + __expf(-x)); }

DI int tidx() { int t = threadIdx.x; asm volatile("" : "+v"(t)); return t; }

constexpr int S = 8192, D = 2048, NIN = 24576, DEPTH = 4;
constexpr int C_AGATE = 9216, C_BIN = 10240, C_BGATE = 13312, C_CQKV = 14336, C_CGATE = 17408, C_MERGE = 18432;
constexpr float LOG2E = 1.4426950408889634f;
constexpr int NTHR = 512, NWAVES = 8;
constexpr int LDS_MAIN = 131072, LDS_AUX = 16384, LDS_BYTES = LDS_MAIN + LDS_AUX;

constexpr size_t WS_WIN  = 0;
constexpr size_t WS_WPR  = WS_WIN  + (size_t)DEPTH * NIN * D * 2;
constexpr size_t WS_WOUT = WS_WPR  + (size_t)DEPTH * 3 * D * 1024 * 2;
constexpr size_t WS_SPEC = WS_WOUT + (size_t)DEPTH * D * D * 2;
constexpr size_t WS_HID2 = WS_SPEC + (size_t)DEPTH * 2 * 512 * 8208 * 16;
constexpr size_t WS_BIAS = WS_HID2 + (size_t)DEPTH * S * 64 * 4;
constexpr size_t WS_X    = WS_BIAS + 524288;
constexpr size_t WS_H    = WS_X    + (size_t)S * D * 4;
constexpr size_t WS_PROJ = WS_H    + (size_t)S * D * 2;
constexpr size_t WS_BINT = WS_PROJ + (size_t)S * NIN * 2;
constexpr size_t WS_VTA  = WS_BINT + (size_t)3072 * S * 4;
constexpr size_t WS_VTC  = WS_VTA  + (size_t)3 * 1024 * S * 2;
constexpr size_t WS_OA   = WS_VTC  + (size_t)1024 * S * 2;
constexpr size_t WS_LSEA = WS_OA   + (size_t)3 * S * 1024 * 4;
constexpr size_t WS_Z2T  = WS_LSEA + (size_t)3 * S * 8 * 4;
constexpr size_t WS_BR   = WS_Z2T  + (size_t)1024 * S * 4;
constexpr size_t WS_YF   = WS_BR   + (size_t)3 * S * 1024 * 2;
constexpr size_t WS_YB   = WS_YF   + (size_t)S * D * 4;
constexpr size_t WS_CTMP = WS_YB   + (size_t)S * D * 2;
constexpr size_t WS_END  = WS_CTMP + (size_t)S * 1024 * 4;

struct Params {
    const float* in[18];
    float* out;
    unsigned char* ws;
    int ph_lo, ph_hi;
};
enum { I_X = 0, I_NORMG, I_FINALG, I_WIN, I_MERGEB, I_RELB, I_HYCONV, I_HYW1, I_HYB1, I_HYFREQ, I_HYW2, I_HYB2, I_HYW3, I_HYSKIP, I_DLAM, I_DG, I_WPROJ, I_WOUT };

namespace pg8 {
constexpr int BM = 256, BK = 64, HALF = 128, HTB = HALF * BK * 2, NXCD = 8, WGM = 8;
DI int lds_byte(int r, int c) { const int st = (r >> 4) * 2 + (c >> 5), rr = r & 15, cc = c & 31, ob = rr * 64 + cc * 2; return st * 1024 + (ob ^ (((ob >> 9) & 1) << 5)); }
DI void stage_rc(int b, int& R, int& C) { const int st = b / 1024, sb = b % 1024, swz = sb ^ (((sb >> 9) & 1) << 5); R = (st >> 1) * 16 + swz / 64; C = (st & 1) * 32 + (swz % 64) / 2; }
struct Unit { int pm, pn; };
struct Gemm { const bf16_t* A; const bf16_t* Bt; int M, N, K; };
struct StaticOrder {
    int nM, nN, nwg, G, c;
    DI void init(int M, int N, int G_, int c_) { nM = M / BM; nN = N / BM; nwg = nM * nN; G = G_; c = c_; }
    DI bool next(int i, Unit& u) const {
        const long L = (long)i * G + c; if (L >= nwg) return false;
        int wgid = (int)L; { const int q = nwg / NXCD, r = nwg % NXCD, xcd = wgid % NXCD, off = wgid / NXCD; wgid = (xcd < r ? xcd * (q + 1) : r * (q + 1) + (xcd - r) * q) + off; }
        const int nig = WGM * nN, gid = wgid / nig, fm = gid * WGM, gsz = (nM - fm) < WGM ? (nM - fm) : WGM;
        u.pm = fm + ((wgid % nig) % gsz); u.pn = (wgid % nig) / gsz; return true;
    }
};
template <class Epi, class Sched>
DI void gemm_phase(LAS unsigned char* lds, const Gemm g, const Sched& S, const Epi& E) {
    const int tid = tidx(), wid = __builtin_amdgcn_readfirstlane(tid >> 6), lane = tid & 63, wr = wid >> 2, wc = wid & 3, fr = lane & 15, fq = lane >> 4;
    const int K = g.K, nt = K / BK;
    unsigned voffA[2], voffB[2];
#pragma unroll
    for (int i = 0; i < 2; ++i) { int R, C; stage_rc(tid * 16 + i * 8192, R, C); voffA[i] = (unsigned)(R * K + C) * 2u; voffB[i] = (unsigned)(R * K + C) * 2u; }
    const size_t kstep = (size_t)(BK * 2);
    const size_t hstep = (size_t)HALF * K * 2;
    const size_t tstep = 2 * hstep;
    const unsigned ldsw = (unsigned)wid * 1024u;
    const int aoff = lds_byte(wr * 64 + fr, fq * 8), boff = lds_byte(wc * 32 + fr, fq * 8);
#define PG8_SA(b, h) (((b) * 2 + (h)) * HTB)
#define PG8_SB(b, h) ((4 + (b) * 2 + (h)) * HTB)
#define PG8_STAGE(bufoff, gbase, voff) do { _Pragma("unroll") for (int _i = 0; _i < 2; ++_i) \
        __builtin_amdgcn_global_load_lds((const unsigned*)((const char*)(gbase) + (voff)[_i]), (LAS unsigned*)(lds + (bufoff) + ldsw + _i * 8192), 16, 0, 0); } while (0)
#define PG8_LDA(dst, b, h) do { _Pragma("unroll") for (int m = 0; m < 4; ++m) _Pragma("unroll") for (int k = 0; k < 2; ++k) dst[m][k] = *(const LAS bf16x8*)(lds + PG8_SA(b, h) + aoff + m * 2048 + k * 1024); } while (0)
#define PG8_LDB(dst, b, h) do { _Pragma("unroll") for (int n = 0; n < 2; ++n) _Pragma("unroll") for (int k = 0; k < 2; ++k) dst[n][k] = *(const LAS bf16x8*)(lds + PG8_SB(b, h) + boff + n * 2048 + k * 1024); } while (0)
#define PG8_MMA(ai, bj, At, Bt) do { __builtin_amdgcn_s_setprio(1); _Pragma("unroll") for (int m = 0; m < 4; ++m) _Pragma("unroll") for (int n = 0; n < 2; ++n) _Pragma("unroll") for (int k = 0; k < 2; ++k) \
        acc[ai][bj][m][n] = __builtin_amdgcn_mfma_f32_16x16x32_bf16(Bt[n][k], At[m][k], acc[ai][bj][m][n], 0, 0, 0); __builtin_amdgcn_s_setprio(0); } while (0)
#define PG8_WAIT_V(n) asm volatile("s_waitcnt vmcnt(" #n ")" ::: "memory")
#define PG8_WAIT_L(n) asm volatile("s_waitcnt lgkmcnt(" #n ")" ::: "memory")
#define PG8_BAR __builtin_amdgcn_s_barrier()
#define PG8_SCHED __builtin_amdgcn_sched_barrier(0)
    Unit cur, nxt; int ui = 0;
    if (!S.next(0, cur)) return;
    f32x4 acc[2][2][4][2];
#pragma unroll
    for (int a = 0; a < 2; ++a)
#pragma unroll
        for (int b = 0; b < 2; ++b)
#pragma unroll
            for (int m = 0; m < 4; ++m)
#pragma unroll
                for (int n = 0; n < 2; ++n) acc[a][b][m][n] = (f32x4){0.f, 0.f, 0.f, 0.f};
    bf16x8 At[4][2], B0[2][2], B1[2][2];
    const char* cA = (const char*)g.A + (size_t)cur.pm * tstep; const char* cB = (const char*)g.Bt + (size_t)cur.pn * tstep;
    PG8_STAGE(PG8_SB(0, 0), cB, voffB); PG8_STAGE(PG8_SA(0, 0), cA, voffA); PG8_STAGE(PG8_SB(0, 1), cB + hstep, voffB); PG8_STAGE(PG8_SA(0, 1), cA + hstep, voffA);
    if (wr == 1) PG8_BAR;
    PG8_WAIT_V(4); PG8_BAR;
    PG8_STAGE(PG8_SB(1, 0), cB + kstep, voffB); PG8_STAGE(PG8_SA(1, 0), cA + kstep, voffA); PG8_STAGE(PG8_SB(1, 1), cB + hstep + kstep, voffB);
    PG8_WAIT_V(6); PG8_BAR;
    for (;;) {
        const bool has_next = S.next(ui + 1, nxt);
        const char* nA = has_next ? (const char*)g.A + (size_t)nxt.pm * tstep : cA; const char* nB = has_next ? (const char*)g.Bt + (size_t)nxt.pn * tstep : cB;
        for (int t = 0; t < nt; t += 2) {
            const bool last = (t == nt - 2);
            const char* a1 = cA + (size_t)(t + 1) * kstep;
            const char* a2 = last ? nA : cA + (size_t)(t + 2) * kstep; const char* b2 = last ? nB : cB + (size_t)(t + 2) * kstep;
            const char* a3 = a2 + kstep; const char* b3 = b2 + kstep;
            PG8_LDB(B0, 0, 0); PG8_SCHED; PG8_LDA(At, 0, 0); PG8_STAGE(PG8_SA(1, 1), a1 + hstep, voffA);
            PG8_WAIT_L(8); PG8_BAR; PG8_WAIT_L(0); PG8_MMA(0, 0, At, B0); PG8_BAR; PG8_SCHED;
            PG8_LDB(B1, 0, 1); PG8_STAGE(PG8_SB(0, 0), b2, voffB);
            PG8_BAR; PG8_WAIT_L(0); PG8_MMA(0, 1, At, B1); PG8_BAR;
            PG8_LDA(At, 0, 1); PG8_STAGE(PG8_SA(0, 0), a2, voffA);
            PG8_BAR; PG8_WAIT_L(0); PG8_MMA(1, 0, At, B0); PG8_BAR; PG8_SCHED;
            PG8_STAGE(PG8_SB(0, 1), b2 + hstep, voffB);
            PG8_WAIT_V(6); PG8_BAR; PG8_MMA(1, 1, At, B1); PG8_BAR;
            PG8_LDB(B0, 1, 0); PG8_SCHED; PG8_LDA(At, 1, 0); PG8_STAGE(PG8_SA(0, 1), a2 + hstep, voffA);
            PG8_WAIT_L(8); PG8_BAR; PG8_WAIT_L(0); PG8_MMA(0, 0, At, B0); PG8_BAR; PG8_SCHED;
            PG8_LDB(B1, 1, 1); PG8_STAGE(PG8_SB(1, 0), b3, voffB);
            PG8_BAR; PG8_WAIT_L(0); PG8_MMA(0, 1, At, B1); PG8_BAR;
            PG8_LDA(At, 1, 1); PG8_STAGE(PG8_SA(1, 0), a3, voffA);
            PG8_BAR; PG8_WAIT_L(0); PG8_MMA(1, 0, At, B0); PG8_BAR; PG8_SCHED;
            PG8_STAGE(PG8_SB(1, 1), b3 + hstep, voffB);
            PG8_WAIT_V(6); PG8_BAR; PG8_MMA(1, 1, At, B1); PG8_BAR;
        }
        E(acc, cur, wr, wc, fr, fq);
        if (!has_next) break;
#pragma unroll
        for (int a = 0; a < 2; ++a)
#pragma unroll
            for (int b = 0; b < 2; ++b)
#pragma unroll
                for (int m = 0; m < 4; ++m)
#pragma unroll
                    for (int n = 0; n < 2; ++n) acc[a][b][m][n] = (f32x4){0.f, 0.f, 0.f, 0.f};
        cur = nxt; cA = nA; cB = nB; ++ui;
    }
    PG8_WAIT_V(0);
    if (wr == 0) PG8_BAR;
    PG8_BAR;
#undef PG8_SA
#undef PG8_SB
#undef PG8_STAGE
#undef PG8_LDA
#undef PG8_LDB
#undef PG8_MMA
#undef PG8_WAIT_V
#undef PG8_WAIT_L
#undef PG8_BAR
#undef PG8_SCHED
}
}

struct EpiIn {
    bf16_t* proj; bf16_t* vta; bf16_t* vtc; float* bint;
    DI void operator()(const f32x4 (&acc)[2][2][4][2], const pg8::Unit& u, int wr, int wc, int fr, int fq) const {
        const int colt = u.pn * 256;
        int kind = 0;
        if (colt < C_AGATE) { if ((colt % 3072) >= 2048) kind = 1; }
        else if (colt >= C_BIN && colt < C_BGATE) kind = 2;
        else if (colt >= C_CQKV + 2048 && colt < C_CGATE) kind = 3;
        const int row0 = u.pm * 256 + wr * 64 + fr, col0 = colt + wc * 32 + 4 * fq;
        if (kind == 0) {
#pragma unroll
            for (int ai = 0; ai < 2; ++ai)
#pragma unroll
                for (int m = 0; m < 4; ++m) { bf16_t* rp = proj + (size_t)(row0 + ai * 128 + m * 16) * NIN + col0;
#pragma unroll
                    for (int bj = 0; bj < 2; ++bj)
#pragma unroll
                        for (int n = 0; n < 2; ++n) { const f32x4 a = acc[ai][bj][m][n]; u32x2 o = {pk2(a[0], a[1]), pk2(a[2], a[3])}; *(u32x2*)(rp + bj * 128 + n * 16) = o; } }
        } else if (kind == 2) {
#pragma unroll
            for (int ai = 0; ai < 2; ++ai)
#pragma unroll
                for (int m = 0; m < 4; ++m) { const int row = row0 + ai * 128 + m * 16;
#pragma unroll
                    for (int bj = 0; bj < 2; ++bj)
#pragma unroll
                        for (int n = 0; n < 2; ++n) { const f32x4 a = acc[ai][bj][m][n]; float* bp = bint + (size_t)(col0 + bj * 128 + n * 16 - C_BIN) * S + row;
#pragma unroll
                            for (int e = 0; e < 4; ++e) bp[(size_t)e * S] = a[e]; } }
        } else {
            int sh = 0; bf16_t* base;
            if (kind == 1) { const int g = colt / 3072; sh = 2 * g; base = vta + (ptrdiff_t)(g * 1024 - g * 3072 - 2048) * (ptrdiff_t)S; }
            else base = vtc - (ptrdiff_t)(C_CQKV + 2048) * (ptrdiff_t)S;
#pragma unroll
            for (int ai = 0; ai < 2; ++ai)
#pragma unroll
                for (int m = 0; m < 4; ++m) { const int row = row0 + ai * 128 + m * 16; const int prow = ((row & ((1 << sh) - 1)) * (S >> sh)) + (row >> sh);
#pragma unroll
                    for (int bj = 0; bj < 2; ++bj)
#pragma unroll
                        for (int n = 0; n < 2; ++n) { const f32x4 a = acc[ai][bj][m][n]; bf16_t* bp = base + (ptrdiff_t)(col0 + bj * 128 + n * 16) * (ptrdiff_t)S + prow;
                            const unsigned p0 = pk2(a[0], a[1]), p1 = pk2(a[2], a[3]);
                            bp[0] = (bf16_t)(p0 & 0xffff); bp[(size_t)S] = (bf16_t)(p0 >> 16); bp[(size_t)2 * S] = (bf16_t)(p1 & 0xffff); bp[(size_t)3 * S] = (bf16_t)(p1 >> 16); } }
        }
    }
};
struct EpiProj {
    const bf16_t* proj; const float* mb; float* yf; bf16_t* yb; int nb;
    DI void operator()(const f32x4 (&acc)[2][2][4][2], const pg8::Unit& u, int wr, int wc, int fr, int fq) const {
        const int row0 = u.pm * 256 + wr * 64 + fr, col0 = u.pn * 256 + wc * 32 + 4 * fq;
#pragma unroll
        for (int ai = 0; ai < 2; ++ai)
#pragma unroll
            for (int m = 0; m < 4; ++m) { const int row = row0 + ai * 128 + m * 16;
#pragma unroll
                for (int bj = 0; bj < 2; ++bj)
#pragma unroll
                    for (int n = 0; n < 2; ++n) { const int col = col0 + bj * 128 + n * 16; const f32x4 a = acc[ai][bj][m][n];
                        const u32x2 mg = *(const u32x2*)(proj + (size_t)row * NIN + C_MERGE + nb * D + col);
                        const f32x4 b4 = *(const f32x4*)(mb + nb * D + col);
                        f32x4 v;
                        v[0] = a[0] * sigm_f(bflo(mg[0]) + b4[0]); v[1] = a[1] * sigm_f(bfhi(mg[0]) + b4[1]);
                        v[2] = a[2] * sigm_f(bflo(mg[1]) + b4[2]); v[3] = a[3] * sigm_f(bfhi(mg[1]) + b4[3]);
                        float* yp = yf + (size_t)row * D + col;
                        if (nb > 0) v += *(const f32x4*)yp;
                        if (nb < 2) *(f32x4*)yp = v;
                        else { u32x2 o = {pk2(v[0], v[1]), pk2(v[2], v[3])}; *(u32x2*)(yb + (size_t)row * D + col) = o; } } }
    }
};
struct EpiOut {
    const float* xold; float* xnew;
    DI void operator()(const f32x4 (&acc)[2][2][4][2], const pg8::Unit& u, int wr, int wc, int fr, int fq) const {
        const int row0 = u.pm * 256 + wr * 64 + fr, col0 = u.pn * 256 + wc * 32 + 4 * fq;
#pragma unroll
        for (int ai = 0; ai < 2; ++ai)
#pragma unroll
            for (int m = 0; m < 4; ++m) { const int row = row0 + ai * 128 + m * 16;
#pragma unroll
                for (int bj = 0; bj < 2; ++bj)
#pragma unroll
                    for (int n = 0; n < 2; ++n) { const size_t o = (size_t)row * D + col0 + bj * 128 + n * 16;
                        *(f32x4*)(xnew + o) = *(const f32x4*)(xold + o) + acc[ai][bj][m][n]; } }
    }
};
DI float wave_sum(float v) {
#pragma unroll
    for (int o = 1; o < 64; o <<= 1) v += __shfl_xor(v, o);
    return v;
}
DI int crow(int reg, int h) { return (reg & 3) + 8 * (reg >> 2) + 4 * h; }
DI bf16x8 pack8(const f32x16& x, const int s) {
    u32x4 p;
    p[0] = pk2(x[8 * s + 0], x[8 * s + 1]); p[1] = pk2(x[8 * s + 2], x[8 * s + 3]);
    p[2] = pk2(x[8 * s + 4], x[8 * s + 5]); p[3] = pk2(x[8 * s + 6], x[8 * s + 7]);
    return __builtin_bit_cast(bf16x8, p);
}
#define MFMA32(a, b, c) __builtin_amdgcn_mfma_f32_32x32x16_bf16((a), (b), (c), 0, 0, 0)

DI void transpose_item(const float* Wsrc, int K, int N, bf16_t* WT, LAS float* scr, int item, int lane) {
    const int nblk = N / 32, kb = item / nblk, nb = item % nblk, k0 = 64 * kb, n0 = 32 * nb;
#pragma unroll 8
    for (int i = 0; i < 32; ++i) { const int kk = 2 * i + (lane >> 5); scr[kk * 33 + (lane & 31)] = Wsrc[(size_t)(k0 + kk) * N + n0 + (lane & 31)]; }
    __builtin_amdgcn_wave_barrier();
    const int c = lane & 7;
#pragma unroll
    for (int j = 0; j < 4; ++j) { const int n = (lane >> 3) + 8 * j; const LAS float* s = scr + (8 * c) * 33 + n;
        u32x4 o; o[0] = pk2(s[0 * 33], s[1 * 33]); o[1] = pk2(s[2 * 33], s[3 * 33]); o[2] = pk2(s[4 * 33], s[5 * 33]); o[3] = pk2(s[6 * 33], s[7 * 33]);
        *(u32x4*)(WT + (size_t)(n0 + n) * K + k0 + 8 * c) = o; }
    __builtin_amdgcn_wave_barrier();
}
DI int t5_bucket(int rel) {
    const int ret = rel > 0 ? 16 : 0; const int n = rel < 0 ? -rel : rel;
    const float nf = (float)(n > 1 ? n : 1);
    int large = 8 + (int)(logf(nf / 8.0f) / 4.852030263919617f * 8.0f);
    large = large < 15 ? large : 15;
    return ret + (n < 8 ? n : large);
}
DI void phase_prologue(const Params& p, LAS unsigned char* lds) {
    const int tid = tidx(), wave = tid >> 6, lane = tid & 63;
    const int gw = blockIdx.x * NWAVES + wave, NGW = gridDim.x * NWAVES;
    LAS float* scr = (LAS float*)(lds + wave * 8704);
    bf16_t* win_t = (bf16_t*)(p.ws + WS_WIN); bf16_t* wpr_t = (bf16_t*)(p.ws + WS_WPR); bf16_t* wout_t = (bf16_t*)(p.ws + WS_WOUT);
    constexpr int IT_IN = (D / 64) * (NIN / 32), IT_PR = (1024 / 64) * (D / 32), IT_OUT = (D / 64) * (D / 32);
    constexpr int TOT = DEPTH * IT_IN + DEPTH * 3 * IT_PR + DEPTH * IT_OUT;
    for (int it = gw; it < TOT; it += NGW) {
        int r = it;
        if (r < DEPTH * IT_IN) { const int l = r / IT_IN; transpose_item(p.in[I_WIN] + (size_t)l * D * NIN, D, NIN, win_t + (size_t)l * NIN * D, scr, r % IT_IN, lane); continue; }
        r -= DEPTH * IT_IN;
        if (r < DEPTH * 3 * IT_PR) { const int l = r / IT_PR; transpose_item(p.in[I_WPROJ] + (size_t)l * 1024 * D, 1024, D, wpr_t + (size_t)l * D * 1024, scr, r % IT_PR, lane); continue; }
        r -= DEPTH * 3 * IT_PR;
        { const int l = r / IT_OUT; transpose_item(p.in[I_WOUT] + (size_t)l * D * D, D, D, wout_t + (size_t)l * D * D, scr, r % IT_OUT, lane); }
    }
    float* bias = (float*)(p.ws + WS_BIAS);
    for (int i = blockIdx.x * NTHR + tid; i < 32 * 2049; i += gridDim.x * NTHR) {
        const int hd = i / 2049, rel = (i % 2049) - 1024;
        bias[i] = p.in[I_RELB][t5_bucket(rel) * 32 + hd] * LOG2E;
    }
    __syncthreads();
    LAS float* zemb = (LAS float*)lds;
    LAS float* h1 = (LAS float*)(lds + 2048);
    float* hid2 = (float*)(p.ws + WS_HID2);
    for (int rb = blockIdx.x; rb < S / 8; rb += gridDim.x) {
        const int rl = tid >> 6, j = tid & 63, i = rb * 8 + rl;
        if (j < 33) {
            float z;
            if (j == 0) z = (float)i / 8191.0f;
            else { const int k = (j - 1) & 15; const float fb = 1e-4f + (float)k * ((15.0f - 1e-4f) / 15.0f); const float w = 6.283185307179586f * (float)i / 8192.0f; const float a = fb * w; z = (j <= 16) ? cosf(a) : -sinf(a); }
            zemb[rl * 36 + j] = z;
        }
        __syncthreads();
        for (int l = 0; l < DEPTH; ++l) {
            float a1 = p.in[I_HYB1][l * 64 + j];
            for (int e = 0; e < 33; ++e) a1 += zemb[rl * 36 + e] * p.in[I_HYW1][(l * 33 + e) * 64 + j];
            h1[rl * 64 + j] = sinf(p.in[I_HYFREQ][(l * 2 + 0) * 64 + j] * a1);
            __syncthreads();
            float a2 = p.in[I_HYB2][l * 64 + j];
            for (int e = 0; e < 64; ++e) a2 += h1[rl * 64 + e] * p.in[I_HYW2][(l * 64 + e) * 64 + j];
            hid2[((size_t)l * S + i) * 64 + j] = sinf(p.in[I_HYFREQ][(l * 2 + 1) * 64 + j] * a2);
            __syncthreads();
        }
    }
}

DI cf cmul(cf a, cf b) { return (cf){a.x * b.x - a.y * b.y, a.x * b.y + a.y * b.x}; }
DI cf twid(float frac) { return (cf){__builtin_amdgcn_cosf(frac), -__builtin_amdgcn_sinf(frac)}; }
DI cf twidc(float frac) { return (cf){__builtin_amdgcn_cosf(frac), __builtin_amdgcn_sinf(frac)}; }
DI void fwd4(cf& a0, cf& a1, cf& a2, cf& a3) {
    const cf s02 = a0 + a2, d02 = a0 - a2, s13 = a1 + a3, d13 = a1 - a3;
    a0 = s02 + s13; a2 = s02 - s13;
    a1 = (cf){d02.x + d13.y, d02.y - d13.x};
    a3 = (cf){d02.x - d13.y, d02.y + d13.x};
}
DI void inv4(cf& b0, cf& b1, cf& b2, cf& b3) {
    const cf s02 = b0 + b2, d02 = b0 - b2, s13 = b1 + b3, d13 = b1 - b3;
    b0 = s02 + s13; b2 = s02 - s13;
    b1 = (cf){d02.x - d13.y, d02.y + d13.x};
    b3 = (cf){d02.x + d13.y, d02.y - d13.x};
}
template <int LOGM> DI void fwd_r4_pass(LAS cf* X, int tid) {
    asm volatile("" : "+v"(tid));
    constexpr int M = 1 << LOGM, q = M >> 2;
#pragma unroll 2
    for (int t = tid; t < 4096; t += NTHR) {
        const int j = t & (q - 1), base = (t >> (LOGM - 2)) * M + j;
        cf a0 = X[base], a1 = X[base + q], a2 = X[base + 2 * q], a3 = X[base + 3 * q];
        fwd4(a0, a1, a2, a3);
        const cf w1 = twid((float)j * (1.0f / M)), w2 = cmul(w1, w1), w3 = cmul(w2, w1);
        X[base] = a0; X[base + q] = cmul(a1, w1); X[base + 2 * q] = cmul(a2, w2); X[base + 3 * q] = cmul(a3, w3);
    }
}
template <int LOGM> DI void inv_r4_pass(LAS cf* X, int tid) {
    asm volatile("" : "+v"(tid));
    constexpr int M = 1 << LOGM, q = M >> 2;
#pragma unroll 2
    for (int t = tid; t < 4096; t += NTHR) {
        const int j = t & (q - 1), base = (t >> (LOGM - 2)) * M + j;
        const cf w1 = twidc((float)j * (1.0f / M)), w2 = cmul(w1, w1), w3 = cmul(w2, w1);
        cf b0 = X[base], b1 = cmul(X[base + q], w1), b2 = cmul(X[base + 2 * q], w2), b3 = cmul(X[base + 3 * q], w3);
        inv4(b0, b1, b2, b3);
        X[base] = b0; X[base + q] = b1; X[base + 2 * q] = b2; X[base + 3 * q] = b3;
    }
}
template <int LOGM> DI void fwd16(cf (&v)[16], int j) {
    constexpr int M = 1 << LOGM, q = M >> 4;
#pragma unroll
    for (int n = 0; n < 4; ++n) {
        fwd4(v[n], v[n + 4], v[n + 8], v[n + 12]);
        const cf w1 = twid((float)(j + n * q) * (1.0f / M)), w2 = cmul(w1, w1), w3 = cmul(w2, w1);
        v[n + 4] = cmul(v[n + 4], w1); v[n + 8] = cmul(v[n + 8], w2); v[n + 12] = cmul(v[n + 12], w3);
    }
    const cf u1 = twid((float)j * (4.0f / M)), u2 = cmul(u1, u1), u3 = cmul(u2, u1);
#pragma unroll
    for (int m = 0; m < 4; ++m) {
        fwd4(v[4 * m], v[4 * m + 1], v[4 * m + 2], v[4 * m + 3]);
        v[4 * m + 1] = cmul(v[4 * m + 1], u1); v[4 * m + 2] = cmul(v[4 * m + 2], u2); v[4 * m + 3] = cmul(v[4 * m + 3], u3);
    }
}
template <int LOGM> DI void inv16(cf (&v)[16], int j) {
    constexpr int M = 1 << LOGM, q = M >> 4;
    const cf u1 = twidc((float)j * (4.0f / M)), u2 = cmul(u1, u1), u3 = cmul(u2, u1);
#pragma unroll
    for (int m = 0; m < 4; ++m) {
        v[4 * m + 1] = cmul(v[4 * m + 1], u1); v[4 * m + 2] = cmul(v[4 * m + 2], u2); v[4 * m + 3] = cmul(v[4 * m + 3], u3);
        inv4(v[4 * m], v[4 * m + 1], v[4 * m + 2], v[4 * m + 3]);
    }
#pragma unroll
    for (int n = 0; n < 4; ++n) {
        const cf w1 = twidc((float)(j + n * q) * (1.0f / M)), w2 = cmul(w1, w1), w3 = cmul(w2, w1);
        v[n + 4] = cmul(v[n + 4], w1); v[n + 8] = cmul(v[n + 8], w2); v[n + 12] = cmul(v[n + 12], w3);
        inv4(v[n], v[n + 4], v[n + 8], v[n + 12]);
    }
}
template <int LOGM> DI void fwd_r16_pass(LAS cf* X, int tid) {
    asm volatile("" : "+v"(tid));
    constexpr int M = 1 << LOGM, q = M >> 4;
#pragma unroll 1
    for (int t = tid; t < 1024; t += NTHR) {
        const int j = t & (q - 1), base = (t >> (LOGM - 4)) * M + j;
        cf v[16];
#pragma unroll
        for (int n = 0; n < 16; ++n) v[n] = X[base + n * q];
        fwd16<LOGM>(v, j);
#pragma unroll
        for (int n = 0; n < 16; ++n) X[base + n * q] = v[n];
    }
}
template <int LOGM> DI void inv_r16_pass(LAS cf* X, int tid) {
    asm volatile("" : "+v"(tid));
    constexpr int M = 1 << LOGM, q = M >> 4;
#pragma unroll 1
    for (int t = tid; t < 1024; t += NTHR) {
        const int j = t & (q - 1), base = (t >> (LOGM - 4)) * M + j;
        cf v[16];
#pragma unroll
        for (int n = 0; n < 16; ++n) v[n] = X[base + n * q];
        inv16<LOGM>(v, j);
#pragma unroll
        for (int n = 0; n < 16; ++n) X[base + n * q] = v[n];
    }
}
DI int rev4(int pp) { const unsigned br = __brev((unsigned)pp) >> 18; return (int)(((br & 0x2AAAu) >> 1) | ((br & 0x1555u) << 1)); }
DI void fft_forward(LAS cf* X, int tid) {
    fwd_r4_pass<14>(X, tid); __syncthreads();
    fwd_r16_pass<12>(X, tid); __syncthreads();
    fwd_r16_pass<8>(X, tid); __syncthreads();
    fwd_r16_pass<4>(X, tid); __syncthreads();
}
constexpr int SPEC_STRIDE = 8208;
DI void fft_conv(LAS cf* X, const f32x4* spec, int tid) {
    fft_forward(X, tid);
#pragma unroll 2
    for (int r = 0; r < 16; ++r) {
        const int k = tid + NTHR * r; const int pp = rev4(k);
        const f32x4 sp = spec[k]; const cf P = (cf){sp[0], sp[1]}, Mq = (cf){sp[2], sp[3]};
        const cf z = X[pp];
        if (k == 0) { X[pp] = cmul(z, P) + cmul((cf){z.x, -z.y}, Mq); }
        else { const int pm = rev4(16384 - k); const cf zm = X[pm];
            const cf y = cmul(z, P) + cmul((cf){zm.x, -zm.y}, Mq);
            const cf t = cmul((cf){zm.x, -zm.y}, P) + cmul(z, Mq);
            X[pp] = y; X[pm] = (cf){t.x, -t.y}; }
    }
    if (tid == 0) { const int pp = rev4(8192); const f32x4 sp = spec[8192]; const cf z = X[pp]; X[pp] = cmul(z, (cf){sp[0], sp[1]}) + cmul((cf){z.x, -z.y}, (cf){sp[2], sp[3]}); }
    __syncthreads();
    inv_r16_pass<4>(X, tid); __syncthreads();
    inv_r16_pass<8>(X, tid); __syncthreads();
    inv_r16_pass<12>(X, tid); __syncthreads();
    inv_r4_pass<14>(X, tid); __syncthreads();
}

DI void spectra_item(const Params& p, int item, LAS unsigned char* lds) {
    int tid = tidx(); asm volatile("" : "+v"(tid));
    const int l = item >> 10, o = (item >> 9) & 1, pr = item & 511, a = 2 * pr;
    LAS cf* X = (LAS cf*)lds; LAS float* aux = (LAS float*)(lds + LDS_MAIN);
    if (tid < 256) { const int j = tid >> 2, e = tid & 3; aux[tid] = p.in[I_HYW3][(size_t)(l * 64 + j) * 4096 + (o * 2 + (e >> 1)) * 1024 + a + (e & 1)]; }
    __syncthreads();
    const float mind = -3.0701134573253943f, maxd = -15.350567286626972f;
    const float da = fabsf(mind + (float)a * ((maxd - mind) / 1023.0f)), db = fabsf(mind + (float)(a + 1) * ((maxd - mind) / 1023.0f));
    const float* hid2 = (const float*)(p.ws + WS_HID2) + (size_t)l * S * 64;
    const float ska = p.in[I_HYSKIP][(l * 2 + o) * 1024 + a], skb = p.in[I_HYSKIP][(l * 2 + o) * 1024 + a + 1];
#pragma unroll 1
    for (int r = 0; r < 16; ++r) {
        const int i = tid + NTHR * r;
        const f32x4* hr = (const f32x4*)(hid2 + (size_t)i * 64);
        float d0 = 0.f, d1 = 0.f, d2 = 0.f, d3 = 0.f;
#pragma unroll
        for (int jj = 0; jj < 16; ++jj) { const f32x4 hv = hr[jj];
#pragma unroll
            for (int e = 0; e < 4; ++e) { const f32x4 wv = *(const LAS f32x4*)(aux + (jj * 4 + e) * 4); d0 += hv[e] * wv[0]; d1 += hv[e] * wv[1]; d2 += hv[e] * wv[2]; d3 += hv[e] * wv[3]; } }
        const float ti = (float)i / 8191.0f; const float ea = __expf(-ti * da), eb = __expf(-ti * db);
        const float fa = d0 * ea, fb = d1 * eb, ba = d2 * ea, bb = d3 * eb;
        if (i == 0) { X[0] = (cf){fa + ba + ska, fb + bb + skb}; X[8192] = (cf){0.f, 0.f}; }
        else { X[i] = (cf){fa, fb}; X[16384 - i] = (cf){ba, bb}; }
    }
    __syncthreads();
    fft_forward(X, tid);
    f32x4* spec = (f32x4*)(p.ws + WS_SPEC) + (size_t)item * SPEC_STRIDE;
    const float sc = 0.5f / 16384.0f;
    for (int r = 0; r < 17; ++r) {
        const int k = tid + NTHR * r; if (k > 8192) break;
        const cf F = X[rev4(k)], Fm = X[rev4((16384 - k) & 16383)];
        const cf Fc = (cf){Fm.x, -Fm.y};
        const cf Ha = (F + Fc) * 0.5f, tt = (F - Fc) * 0.5f; const cf Hb = (cf){tt.y, -tt.x};
        const cf P = (Ha + Hb) * sc, Mq = (Ha - Hb) * sc;
        spec[k] = (f32x4){P.x, P.y, Mq.x, Mq.y};
    }
    __syncthreads();
}

DI float conv3(const float* row, int t, float w0, float w1, float w2) {
    const float c = row[t]; const float pv = t > 0 ? row[t - 1] : 0.f; const float nx = t < S - 1 ? row[t + 1] : 0.f;
    return w0 * pv + w1 * c + w2 * nx;
}
DI void hyena_item(const Params& p, int l, int pr, LAS unsigned char* lds) {
    int tid = tidx(); asm volatile("" : "+v"(tid)); const int a = 2 * pr;
    LAS cf* X = (LAS cf*)lds;
    const float* bint = (const float*)(p.ws + WS_BINT);
    const float* cw = p.in[I_HYCONV] + (size_t)l * 3 * 3072;
    float w[3][2][3];
#pragma unroll
    for (int wh = 0; wh < 3; ++wh)
#pragma unroll
        for (int c = 0; c < 2; ++c)
#pragma unroll
            for (int k = 0; k < 3; ++k) w[wh][c][k] = cw[k * 3072 + wh * 1024 + a + c];
    const f32x4* spec = (const f32x4*)(p.ws + WS_SPEC);
#pragma unroll 2
    for (int r = 0; r < 16; ++r) { const int t = tid + NTHR * r;
        X[t] = (cf){conv3(bint + (size_t)a * S, t, w[0][0][0], w[0][0][1], w[0][0][2]), conv3(bint + (size_t)(a + 1) * S, t, w[0][1][0], w[0][1][1], w[0][1][2])};
        X[t + 8192] = (cf){0.f, 0.f}; }
    __syncthreads();
    fft_conv(X, spec + (size_t)((l * 2 + 0) * 512 + pr) * SPEC_STRIDE, tid);
#pragma unroll 2
    for (int r = 0; r < 16; ++r) { const int t = tid + NTHR * r; const cf y = X[t];
        X[t] = (cf){y.x * conv3(bint + (size_t)(1024 + a) * S, t, w[1][0][0], w[1][0][1], w[1][0][2]), y.y * conv3(bint + (size_t)(1024 + a + 1) * S, t, w[1][1][0], w[1][1][1], w[1][1][2])};
        X[t + 8192] = (cf){0.f, 0.f}; }
    __syncthreads();
    fft_conv(X, spec + (size_t)((l * 2 + 1) * 512 + pr) * SPEC_STRIDE, tid);
    float* z2t = (float*)(p.ws + WS_Z2T);
#pragma unroll 2
    for (int r = 0; r < 16; ++r) { const int t = tid + NTHR * r; const cf y = X[t];
        z2t[(size_t)a * S + t] = y.x * conv3(bint + (size_t)(2048 + a) * S, t, w[2][0][0], w[2][0][1], w[2][0][2]);
        z2t[(size_t)(a + 1) * S + t] = y.y * conv3(bint + (size_t)(2048 + a + 1) * S, t, w[2][1][0], w[2][1][1], w[2][1][2]); }
    __syncthreads();
}
DI void phase_rmsnorm(const float* x, const float* g, bf16_t* hout, float* fout) {
    const int tid = tidx(), wave = tid >> 6, lane = tid & 63;
    for (int row = blockIdx.x * NWAVES + wave; row < S; row += gridDim.x * NWAVES) {
        const f32x4* xr = (const f32x4*)(x + (size_t)row * D) + lane;
        f32x4 v[8]; float s = 0.f;
#pragma unroll
        for (int j = 0; j < 8; ++j) { v[j] = xr[64 * j]; s += (v[j][0] * v[j][0] + v[j][1] * v[j][1]) + (v[j][2] * v[j][2] + v[j][3] * v[j][3]); }
        const float rstd = rsqrtf(wave_sum(s) * (1.0f / D) + 1e-6f);
#pragma unroll
        for (int j = 0; j < 8; ++j) { const f32x4 gg = ((const f32x4*)g)[lane + 64 * j]; const f32x4 y = v[j] * rstd * gg;
            if (hout) { u32x2 o = {pk2(y[0], y[1]), pk2(y[2], y[3])}; ((u32x2*)(hout + (size_t)row * D))[lane + 64 * j] = o; }
            else ((f32x4*)(fout + (size_t)row * D))[lane + 64 * j] = y; }
    }
}

constexpr int KROW = 144, KBUF = 64 * KROW, VBUF = 128 * KROW;
DI void diff_flash(const bf16_t* proj, const bf16_t* vtc, int h, int c, int q0w, LAS unsigned char* lds, const LAS float* btab, f32x16 (&O)[4]) {
    int tid = tidx(); asm volatile("" : "+v"(tid)); const int lane = tid & 63, r = lane & 31, hh = lane >> 5;
    bf16x8 qf[4];
    { const bf16_t* qp = proj + (size_t)(q0w + r) * NIN + C_CQKV + h * 128 + c * 64 + 8 * hh;
#pragma unroll
      for (int ks = 0; ks < 4; ++ks) qf[ks] = *(const bf16x8*)(qp + 16 * ks); }
#pragma unroll
    for (int db = 0; db < 4; ++db)
#pragma unroll
        for (int i = 0; i < 16; ++i) O[db][i] = 0.f;
    float m = -1e30f, lsum = 0.f;
    const float cs = 0.125f * LOG2E;
    const bf16_t* kg = proj + C_CQKV + 1024 + h * 128 + c * 64 + (size_t)(tid >> 3) * NIN + (tid & 7) * 8;
    const bf16_t* vg = vtc + (size_t)(h * 128 + (tid >> 3)) * S + (tid & 7) * 8;
    const int kst = (tid >> 3) * KROW + (tid & 7) * 16;
    LAS unsigned char* Kb = lds; LAS unsigned char* Vb = lds + 2 * KBUF;
    u32x4 kr = *(const u32x4*)kg, v0 = *(const u32x4*)vg, v1 = *(const u32x4*)(vg + (size_t)64 * S);
    __syncthreads();
    *(LAS u32x4*)(Kb + kst) = kr; *(LAS u32x4*)(Vb + kst) = v0; *(LAS u32x4*)(Vb + 64 * KROW + kst) = v1;
    __syncthreads();
    for (int kt = 0; kt < S / 64; ++kt) {
        const int buf = kt & 1;
        if (kt + 1 < S / 64) { kr = *(const u32x4*)(kg + (size_t)(kt + 1) * 64 * NIN); v0 = *(const u32x4*)(vg + (kt + 1) * 64); v1 = *(const u32x4*)(vg + (size_t)64 * S + (kt + 1) * 64); }
        const LAS unsigned char* kb_ = Kb + buf * KBUF; const LAS unsigned char* vb_ = Vb + buf * VBUF;
        f32x16 s0, s1;
#pragma unroll
        for (int i = 0; i < 16; ++i) { s0[i] = 0.f; s1[i] = 0.f; }
#pragma unroll
        for (int ks = 0; ks < 4; ++ks) { const bf16x8 a = *(const LAS bf16x8*)(kb_ + r * KROW + 32 * ks + 16 * hh); s0 = MFMA32(a, qf[ks], s0); }
#pragma unroll
        for (int ks = 0; ks < 4; ++ks) { const bf16x8 a = *(const LAS bf16x8*)(kb_ + (32 + r) * KROW + 32 * ks + 16 * hh); s1 = MFMA32(a, qf[ks], s1); }
        const int k0 = kt * 64, q = q0w + r;
        const int relmin = k0 - q0w - 31, relmax = k0 + 63 - q0w;
        if (relmin >= 1024 || relmax <= -1024) {
            const float bc = btab[relmin >= 1024 ? 2048 : 0];
#pragma unroll
            for (int i = 0; i < 16; ++i) { s0[i] = s0[i] * cs + bc; s1[i] = s1[i] * cs + bc; }
        } else {
#pragma unroll
            for (int i = 0; i < 16; ++i) { int rel = k0 + crow(i, hh) - q; int i0 = min(max(rel, -1024), 1024) + 1024; int i1 = min(max(rel + 32, -1024), 1024) + 1024;
                s0[i] = s0[i] * cs + btab[i0]; s1[i] = s1[i] * cs + btab[i1]; }
        }
        float mx = s0[0];
#pragma unroll
        for (int i = 1; i < 16; ++i) mx = fmaxf(mx, s0[i]);
#pragma unroll
        for (int i = 0; i < 16; ++i) mx = fmaxf(mx, s1[i]);
        mx = fmaxf(mx, __shfl_xor(mx, 32));
        const float mnew = fmaxf(m, mx), alpha = __builtin_amdgcn_exp2f(m - mnew);
        m = mnew;
        float rs = 0.f;
#pragma unroll
        for (int i = 0; i < 16; ++i) { s0[i] = __builtin_amdgcn_exp2f(s0[i] - mnew); s1[i] = __builtin_amdgcn_exp2f(s1[i] - mnew); rs += s0[i] + s1[i]; }
        lsum = lsum * alpha + rs;
#pragma unroll
        for (int db = 0; db < 4; ++db) O[db] *= alpha;
#pragma unroll
        for (int s = 0; s < 4; ++s) {
            const bf16x8 pf = (s < 2) ? pack8(s0, s & 1) : pack8(s1, s & 1);
#pragma unroll
            for (int db = 0; db < 4; ++db) {
                const LAS unsigned char* vp = vb_ + (32 * db + r) * KROW + (16 * s + 4 * hh) * 2;
                const s16x4 lo = *(const LAS s16x4*)vp, hi = *(const LAS s16x4*)(vp + 16);
                const bf16x8 vf = __builtin_shufflevector(lo, hi, 0, 1, 2, 3, 4, 5, 6, 7);
                O[db] = MFMA32(vf, pf, O[db]);
            }
        }
        if (kt + 1 < S / 64) {
            LAS unsigned char* kn = Kb + (buf ^ 1) * KBUF; LAS unsigned char* vn = Vb + (buf ^ 1) * VBUF;
            *(LAS u32x4*)(kn + kst) = kr; *(LAS u32x4*)(vn + kst) = v0; *(LAS u32x4*)(vn + 64 * KROW + kst) = v1;
        }
        __syncthreads();
    }
    const float lt = lsum + __shfl_xor(lsum, 32), inv = 1.0f / lt;
#pragma unroll
    for (int db = 0; db < 4; ++db) O[db] *= inv;
}
DI void diffattn_item(const Params& p, int l, int item, LAS unsigned char* lds) {
    int tid = tidx(); asm volatile("" : "+v"(tid)); const int wave = __builtin_amdgcn_readfirstlane(tid >> 6), lane = tid & 63, r = lane & 31, hh = lane >> 5;
    const int qt = item >> 3, h = item & 7, q0w = qt * 256 + wave * 32;
    LAS float* btab = (LAS float*)(lds + LDS_MAIN);
    const float* bias = (const float*)(p.ws + WS_BIAS) + (24 + h) * 2049;
    for (int i = tid; i < 2049; i += NTHR) btab[i] = bias[i];
    const float* dl = p.in[I_DLAM] + l * 256;
    float d01 = 0.f, d23 = 0.f;
    for (int i = 0; i < 64; ++i) { d01 += dl[i] * dl[64 + i]; d23 += dl[128 + i] * dl[192 + i]; }
    const float lam_init = 0.8f - 0.6f * expf(-0.3f * (float)l);
    const float lam = expf(d01) - expf(d23) + lam_init;
    const bf16_t* proj = (const bf16_t*)(p.ws + WS_PROJ); const bf16_t* vtc = (const bf16_t*)(p.ws + WS_VTC);
    f32x16 O0[4];
    const int q = q0w + r;
    float* ctmp = (float*)(p.ws + WS_CTMP) + (size_t)q * 1024 + h * 128 + 4 * hh;
    diff_flash(proj, vtc, h, 0, q0w, lds, btab, O0);
#pragma unroll
    for (int db = 0; db < 4; ++db)
#pragma unroll
        for (int i4 = 0; i4 < 4; ++i4) { f32x4 o = {O0[db][4 * i4], O0[db][4 * i4 + 1], O0[db][4 * i4 + 2], O0[db][4 * i4 + 3]}; *(f32x4*)(ctmp + 32 * db + 8 * i4) = o; }
    diff_flash(proj, vtc, h, 1, q0w, lds, btab, O0);
    float ss = 0.f;
#pragma unroll
    for (int db = 0; db < 4; ++db)
#pragma unroll
        for (int i4 = 0; i4 < 4; ++i4) { const f32x4 o0 = *(const f32x4*)(ctmp + 32 * db + 8 * i4);
#pragma unroll
            for (int e = 0; e < 4; ++e) { const float o = o0[e] - lam * O0[db][4 * i4 + e]; O0[db][4 * i4 + e] = o; ss += o * o; } }
    ss += __shfl_xor(ss, 32);
    const float rn = rsqrtf(ss * (1.0f / 128.0f) + 1e-6f) * (1.0f - lam_init);
    const float* dg = p.in[I_DG] + l * 128;
    bf16_t* cout = (bf16_t*)(p.ws + WS_BR) + (size_t)2 * S * 1024;
#pragma unroll
    for (int db = 0; db < 4; ++db)
#pragma unroll
        for (int i4 = 0; i4 < 4; ++i4) {
            const int d0 = 32 * db + 8 * i4 + 4 * hh;
            const f32x4 g4 = *(const f32x4*)(dg + d0);
            const u32x2 gt = *(const u32x2*)(proj + (size_t)q * NIN + C_CGATE + h * 128 + d0);
            const float y0 = O0[db][4 * i4 + 0] * rn * g4[0] * silu_f(bflo(gt[0])), y1 = O0[db][4 * i4 + 1] * rn * g4[1] * silu_f(bfhi(gt[0]));
            const float y2 = O0[db][4 * i4 + 2] * rn * g4[2] * silu_f(bflo(gt[1])), y3 = O0[db][4 * i4 + 3] * rn * g4[3] * silu_f(bfhi(gt[1]));
            u32x2 o = {pk2(y0, y1), pk2(y2, y3)};
            *(u32x2*)(cout + (size_t)q * 1024 + h * 128 + d0) = o;
        }
    __syncthreads();
}

DI void mixA_wave_item(const Params& p, int wi, int lane) {
    asm volatile("" : "+v"(lane));
    const int g = wi >> 11, rem = wi & 2047, h = rem >> 8, qb = rem & 255;
    const int sh = 2 * g, n = S >> sh, nbq = 256 >> sh, res = qb / nbq, m0 = (qb % nbq) * 32;
    const int r = lane & 31, hh = lane >> 5;
    const bf16_t* proj = (const bf16_t*)(p.ws + WS_PROJ);
    const int qpos = ((m0 + r) << sh) + res;
    bf16x8 qf[8];
    { const bf16_t* qp = proj + (size_t)qpos * NIN + g * 3072 + h * 128 + 8 * hh;
#pragma unroll
      for (int ks = 0; ks < 8; ++ks) qf[ks] = *(const bf16x8*)(qp + 16 * ks); }
    f32x16 O[4];
#pragma unroll
    for (int db = 0; db < 4; ++db)
#pragma unroll
        for (int i = 0; i < 16; ++i) O[db][i] = 0.f;
    float m = -1e30f, lsum = 0.f;
    const float cs = 0.08838834764831845f * LOG2E;
    const float* bias = (const float*)(p.ws + WS_BIAS) + (g * 8 + h) * 2049 + 1024;
    const bf16_t* vt = (const bf16_t*)(p.ws + WS_VTA) + (size_t)((g * 8 + h) * 128) * S + res * n;
    for (int kb = 0; kb < 5; ++kb) {
        const int mk0 = m0 - 64 + 32 * kb;
        if (mk0 < 0 || mk0 >= n) continue;
        const int kpos = ((mk0 + r) << sh) + res;
        const bf16_t* kp = proj + (size_t)kpos * NIN + g * 3072 + 1024 + h * 128 + 8 * hh;
        f32x16 s;
#pragma unroll
        for (int i = 0; i < 16; ++i) s[i] = 0.f;
#pragma unroll
        for (int ks = 0; ks < 8; ++ks) { const bf16x8 a = *(const bf16x8*)(kp + 16 * ks); s = MFMA32(a, qf[ks], s); }
        float mx = -INFINITY;
#pragma unroll
        for (int i = 0; i < 16; ++i) { const int rel = mk0 + crow(i, hh) - (m0 + r); const bool valid = (rel <= 64) && (rel >= -64);
            const int bi = min(max(rel << sh, -1024), 1024);
            const float v = valid ? (s[i] * cs + bias[bi]) : -INFINITY; s[i] = v; mx = fmaxf(mx, v); }
        mx = fmaxf(mx, __shfl_xor(mx, 32));
        const float mnew = fmaxf(m, mx), alpha = __builtin_amdgcn_exp2f(m - mnew);
        m = mnew;
        float rs = 0.f;
#pragma unroll
        for (int i = 0; i < 16; ++i) { s[i] = __builtin_amdgcn_exp2f(s[i] - mnew); rs += s[i]; }
        lsum = lsum * alpha + rs;
#pragma unroll
        for (int db = 0; db < 4; ++db) O[db] *= alpha;
#pragma unroll
        for (int sidx = 0; sidx < 2; ++sidx) {
            const bf16x8 pf = pack8(s, sidx);
#pragma unroll
            for (int db = 0; db < 4; ++db) {
                const bf16_t* vp = vt + (size_t)(32 * db + r) * S + mk0 + 16 * sidx + 4 * hh;
                const s16x4 lo = *(const s16x4*)vp, hi = *(const s16x4*)(vp + 8);
                const bf16x8 vf = __builtin_shufflevector(lo, hi, 0, 1, 2, 3, 4, 5, 6, 7);
                O[db] = MFMA32(vf, pf, O[db]);
            }
        }
    }
    const float lt = lsum + __shfl_xor(lsum, 32), inv = 1.0f / lt;
    float* oa = (float*)(p.ws + WS_OA) + ((size_t)g * S + qpos) * 1024 + h * 128;
#pragma unroll
    for (int db = 0; db < 4; ++db)
#pragma unroll
        for (int i4 = 0; i4 < 4; ++i4) {
            const int d0 = 32 * db + 8 * i4 + 4 * hh;
            f32x4 o = {O[db][4 * i4] * inv, O[db][4 * i4 + 1] * inv, O[db][4 * i4 + 2] * inv, O[db][4 * i4 + 3] * inv};
            *(f32x4*)(oa + d0) = o;
        }
    if (hh == 0) ((float*)(p.ws + WS_LSEA))[((size_t)g * S + qpos) * 8 + h] = m + __log2f(lt);
}

DI void phase_post(const Params& p, LAS unsigned char* lds) {
    const int tid = tidx();
    const bf16_t* proj = (const bf16_t*)(p.ws + WS_PROJ);
    bf16_t* aout = (bf16_t*)(p.ws + WS_BR); bf16_t* bout = aout + (size_t)S * 1024;
    const float* oa = (const float*)(p.ws + WS_OA); const float* lse = (const float*)(p.ws + WS_LSEA);
    for (int idx = blockIdx.x * NTHR + tid; idx < S * 256; idx += gridDim.x * NTHR) {
        const int pos = idx >> 8, c4 = idx & 255, h = c4 >> 5, col = c4 * 4;
        const float l0 = lse[((size_t)0 * S + pos) * 8 + h], l1 = lse[((size_t)1 * S + pos) * 8 + h], l2 = lse[((size_t)2 * S + pos) * 8 + h];
        const float mx = fmaxf(l0, fmaxf(l1, l2));
        const float w0 = __builtin_amdgcn_exp2f(l0 - mx), w1 = __builtin_amdgcn_exp2f(l1 - mx), w2 = __builtin_amdgcn_exp2f(l2 - mx);
        const float inv = 1.0f / (w0 + w1 + w2);
        const f32x4 o0 = *(const f32x4*)(oa + ((size_t)0 * S + pos) * 1024 + col), o1 = *(const f32x4*)(oa + ((size_t)1 * S + pos) * 1024 + col), o2 = *(const f32x4*)(oa + ((size_t)2 * S + pos) * 1024 + col);
        const f32x4 o = (o0 * w0 + o1 * w1 + o2 * w2) * inv;
        const u32x2 gt = *(const u32x2*)(proj + (size_t)pos * NIN + C_AGATE + col);
        u32x2 ov = {pk2(o[0] * silu_f(bflo(gt[0])), o[1] * silu_f(bfhi(gt[0]))), pk2(o[2] * silu_f(bflo(gt[1])), o[3] * silu_f(bfhi(gt[1])))};
        *(u32x2*)(aout + (size_t)pos * 1024 + col) = ov;
    }
    LAS float* tile = (LAS float*)lds;
    const float* z2t = (const float*)(p.ws + WS_Z2T);
    for (int it = blockIdx.x; it < 128 * 16; it += gridDim.x) {
        const int t0 = (it >> 4) * 64, c0 = (it & 15) * 64;
        __syncthreads();
#pragma unroll
        for (int k = 0; k < 2; ++k) { const int e = tid + NTHR * k; const int ci = e >> 4, t4 = (e & 15) * 4;
            const f32x4 v = *(const f32x4*)(z2t + (size_t)(c0 + ci) * S + t0 + t4);
            tile[ci * 65 + t4] = v[0]; tile[ci * 65 + t4 + 1] = v[1]; tile[ci * 65 + t4 + 2] = v[2]; tile[ci * 65 + t4 + 3] = v[3]; }
        __syncthreads();
#pragma unroll
        for (int k = 0; k < 2; ++k) { const int e = tid + NTHR * k; const int ti = e >> 4, cc = (e & 15) * 4;
            const u32x2 gt = *(const u32x2*)(proj + (size_t)(t0 + ti) * NIN + C_BGATE + c0 + cc);
            const float y0 = tile[(cc + 0) * 65 + ti] * silu_f(bflo(gt[0])), y1 = tile[(cc + 1) * 65 + ti] * silu_f(bfhi(gt[0]));
            const float y2 = tile[(cc + 2) * 65 + ti] * silu_f(bflo(gt[1])), y3 = tile[(cc + 3) * 65 + ti] * silu_f(bfhi(gt[1]));
            u32x2 ov = {pk2(y0, y1), pk2(y2, y3)};
            *(u32x2*)(bout + (size_t)(t0 + ti) * 1024 + c0 + cc) = ov; }
    }
    __syncthreads();
}

constexpr int NPH = 2 + 6 * DEPTH + 1;
typedef const Params __attribute__((address_space(4)))* ParamsK;
DI Params ldp(ParamsK pc) {
    asm volatile("" : "+s"(pc));
    Params q;
#pragma unroll
    for (int i = 0; i < 18; ++i) q.in[i] = pc->in[i];
    q.out = pc->out; q.ws = pc->ws; q.ph_lo = pc->ph_lo; q.ph_hi = pc->ph_hi;
    return q;
}
DI void run_phase(ParamsK pc, int ph, LAS unsigned char* lds) {
    if (ph == 0) { const Params p = ldp(pc); phase_prologue(p, lds); return; }
    if (ph == 1) { const Params p = ldp(pc); for (int it = blockIdx.x; it < DEPTH * 2 * 512; it += gridDim.x) spectra_item(p, it, lds); return; }
    if (ph == NPH - 1) { const Params p = ldp(pc); phase_rmsnorm((const float*)(p.ws + WS_X), p.in[I_FINALG], nullptr, p.out); return; }
    const int l = (ph - 2) / 6, sp = (ph - 2) % 6;
    if (sp == 0) { const Params p = ldp(pc); phase_rmsnorm((l == 0) ? p.in[I_X] : (const float*)(p.ws + WS_X), p.in[I_NORMG] + l * D, (bf16_t*)(p.ws + WS_H), nullptr); return; }
    if (sp == 1) {
        const Params p = ldp(pc);
        pg8::Gemm g{(const bf16_t*)(p.ws + WS_H), (const bf16_t*)(p.ws + WS_WIN) + (size_t)l * NIN * D, S, NIN, D};
        pg8::StaticOrder so; so.init(S, NIN, gridDim.x, blockIdx.x);
        EpiIn e{(bf16_t*)(p.ws + WS_PROJ), (bf16_t*)(p.ws + WS_VTA), (bf16_t*)(p.ws + WS_VTC), (float*)(p.ws + WS_BINT)};
        pg8::gemm_phase(lds, g, so, e); return;
    }
    if (sp == 2) {
#pragma unroll 1
        for (int it = blockIdx.x; it < 256 + 512 + 768; it += gridDim.x) {
            int l2 = l; asm volatile("" : "+s"(l2));
            const Params p = ldp(pc);
            if (it < 256) diffattn_item(p, l2, it, lds);
            else if (it < 768) hyena_item(p, l2, it - 256, lds);
            else mixA_wave_item(p, (it - 768) * NWAVES + (tidx() >> 6), tidx() & 63);
        }
        return;
    }
    if (sp == 3) { const Params p = ldp(pc); phase_post(p, lds); return; }
    if (sp == 4) {
#pragma unroll 1
        for (int nb = 0; nb < 3; ++nb) {
            const Params p = ldp(pc);
            pg8::Gemm g{(const bf16_t*)(p.ws + WS_BR) + (size_t)nb * S * 1024, (const bf16_t*)(p.ws + WS_WPR) + (size_t)(l * 3 + nb) * D * 1024, S, D, 1024};
            pg8::StaticOrder so; so.init(S, D, gridDim.x, blockIdx.x);
            EpiProj e{(const bf16_t*)(p.ws + WS_PROJ), p.in[I_MERGEB] + (size_t)l * 3 * D, (float*)(p.ws + WS_YF), (bf16_t*)(p.ws + WS_YB), nb};
            pg8::gemm_phase(lds, g, so, e);
            __syncthreads();
        }
        return;
    }
    {
        const Params p = ldp(pc);
        pg8::Gemm g{(const bf16_t*)(p.ws + WS_YB), (const bf16_t*)(p.ws + WS_WOUT) + (size_t)l * D * D, S, D, D};
        pg8::StaticOrder so; so.init(S, D, gridDim.x, blockIdx.x);
        EpiOut e{(l == 0) ? p.in[I_X] : (const float*)(p.ws + WS_X), (float*)(p.ws + WS_X)};
        pg8::gemm_phase(lds, g, so, e);
    }
}

__global__ void __launch_bounds__(512, 2) mega_kernel(Params p) {
#if defined(__HIP_DEVICE_COMPILE__)
    extern __shared__ __attribute__((aligned(16))) unsigned char shm[];
    LAS unsigned char* lds = (LAS unsigned char*)shm;
    cg::grid_group grid = cg::this_grid();
    const int ph_lo = p.ph_lo, ph_hi = p.ph_hi;
#pragma unroll 1
    for (int ph = ph_lo; ph < ph_hi; ++ph) {
        ParamsK pc = (ParamsK)__builtin_amdgcn_kernarg_segment_ptr();
        run_phase(pc, ph, lds);
        if (ph + 1 < ph_hi) grid.sync();
    }
#endif
}

#ifndef N_LAUNCH_MODE
#define N_LAUNCH_MODE 1
#endif
extern "C" void kernel_launch(void* const* d_in, const int* in_sizes, int n_in, void* d_out, int out_size, void* d_ws, size_t ws_size, hipStream_t stream) {
    static int grid = 0;
    if (grid == 0) {
        int dev = 0, cus = 0;
        if (hipGetDevice(&dev) != hipSuccess || hipDeviceGetAttribute(&cus, hipDeviceAttributeMultiprocessorCount, dev) != hipSuccess) { fprintf(stderr, "kernel_launch: device query failed\n"); grid = -1; return; }
        if (hipFuncSetAttribute((const void*)mega_kernel, hipFuncAttributeMaxDynamicSharedMemorySize, LDS_BYTES) != hipSuccess) { fprintf(stderr, "kernel_launch: hipFuncSetAttribute failed\n"); grid = -1; return; }
        int per_cu = 0;
        if (hipOccupancyMaxActiveBlocksPerMultiprocessor(&per_cu, (const void*)mega_kernel, NTHR, LDS_BYTES) != hipSuccess || per_cu < 1) { fprintf(stderr, "kernel_launch: occupancy query says %d\n", per_cu); (void)hipGetLastError(); }
        if (n_in != 18 || ws_size < WS_END) { fprintf(stderr, "kernel_launch: n_in %d ws %zu (need %zu)\n", n_in, ws_size, (size_t)WS_END); grid = -1; return; }
        grid = cus;
    }
    if (grid < 0) return;
    Params p{};
    for (int i = 0; i < 18; ++i) p.in[i] = (const float*)d_in[i];
    p.out = (float*)d_out; p.ws = (unsigned char*)d_ws;
#if N_LAUNCH_MODE == 1
    p.ph_lo = 0; p.ph_hi = NPH;
    void* args[] = {&p};
    hipError_t e = hipLaunchCooperativeKernel((const void*)mega_kernel, dim3(grid), dim3(NTHR), args, LDS_BYTES, stream);
    if (e != hipSuccess) fprintf(stderr, "cooperative launch failed: %s (grid %d)\n", hipGetErrorString(e), grid);
#else
    for (int ph = 0; ph < NPH; ++ph) {
        p.ph_lo = ph; p.ph_hi = ph + 1;
        hipLaunchKernelGGL(mega_kernel, dim3(grid), dim3(NTHR), LDS_BYTES, stream, p);
    }
#endif
}
```

```cpp
#include <hip/hip_runtime.h>
#include <hip/hip_cooperative_groups.h>
#include <cstdio>
namespace cg = cooperative_groups;
#define DI __device__ __forceinline__
#define LAS __attribute__((address_space(3)))
typedef unsigned short bf16_t;
typedef short bf16x8 __attribute__((ext_vector_type(8)));
typedef short s16x4 __attribute__((ext_vector_type(4)));
typedef float f32x4 __attribute__((ext_vector_type(4)));
typedef float f32x16 __attribute__((ext_vector_type(16)));
typedef float f32x2 __attribute__((ext_vector_type(2)));
typedef float cf __attribute__((ext_vector_type(2)));
typedef __bf16 bf16x2n __attribute__((ext_vector_type(2)));
typedef unsigned u32x2 __attribute__((ext_vector_type(2)));
typedef unsigned u32x4 __attribute__((ext_vector_type(4)));

DI unsigned pk2(float lo, float hi) { f32x2 v = {lo, hi}; return __builtin_bit_cast(unsigned, __builtin_convertvector(v, bf16x2n)); }
DI float bflo(unsigned u) { return __uint_as_float(u << 16); }
DI float bfhi(unsigned u) { return __uint_as_float(u & 0xffff0000u); }
DI float silu_f(float x) { return x / (1.0f + __expf(-x)); }
DI float sigm_f(float x) { return 1.0f / (1.0f + __expf(-x)); }

DI int tidx() { int t = threadIdx.x; asm volatile("" : "+v"(t)); return t; }

constexpr int S = 8192, D = 2048, NIN = 24576, DEPTH = 4;
constexpr int C_AGATE = 9216, C_BIN = 10240, C_BGATE = 13312, C_CQKV = 14336, C_CGATE = 17408, C_MERGE = 18432;
constexpr float LOG2E = 1.4426950408889634f;
constexpr int NTHR = 512, NWAVES = 8;
constexpr int LDS_MAIN = 143360, LDS_AUX = 16384, LDS_BYTES = LDS_MAIN + LDS_AUX;

constexpr size_t WS_WIN  = 0;
constexpr size_t WS_WPR  = WS_WIN  + (size_t)DEPTH * NIN * D * 2;
constexpr size_t WS_WOUT = WS_WPR  + (size_t)DEPTH * 3 * D * 1024 * 2;
constexpr size_t WS_SPEC = WS_WOUT + (size_t)DEPTH * D * D * 2;
constexpr size_t WS_HID2 = WS_SPEC + (size_t)DEPTH * 2 * 512 * 8208 * 16;
constexpr size_t WS_BIAS = WS_HID2 + (size_t)DEPTH * S * 64 * 4;
constexpr size_t WS_X    = WS_BIAS + 524288;
constexpr size_t WS_H    = WS_X    + (size_t)S * D * 4;
constexpr size_t WS_PROJ = WS_H    + (size_t)S * D * 2;
constexpr size_t WS_BINT = WS_PROJ + (size_t)S * NIN * 2;
constexpr size_t WS_VTA  = WS_BINT + (size_t)3072 * S * 4;
constexpr size_t WS_VTC  = WS_VTA  + (size_t)3 * 1024 * S * 2;
constexpr size_t WS_OA   = WS_VTC  + (size_t)1024 * S * 2;
constexpr size_t WS_LSEA = WS_OA   + (size_t)3 * S * 1024 * 4;
constexpr size_t WS_Z2T  = WS_LSEA + (size_t)3 * S * 8 * 4;
constexpr size_t WS_BR   = WS_Z2T  + (size_t)1024 * S * 4;
constexpr size_t WS_YF   = WS_BR   + (size_t)3 * S * 1024 * 2;
constexpr size_t WS_YB   = WS_YF   + (size_t)S * D * 4;
constexpr size_t WS_CTMP = WS_YB   + (size_t)S * D * 2;
constexpr size_t WS_BAR  = WS_CTMP + (size_t)S * 1024 * 4;
constexpr size_t WS_END  = WS_BAR + 16384;

struct Params {
    const float* in[18];
    float* out;
    unsigned char* ws;
    int ph_lo, ph_hi;
};
enum { I_X = 0, I_NORMG, I_FINALG, I_WIN, I_MERGEB, I_RELB, I_HYCONV, I_HYW1, I_HYB1, I_HYFREQ, I_HYW2, I_HYB2, I_HYW3, I_HYSKIP, I_DLAM, I_DG, I_WPROJ, I_WOUT };

namespace pg8 {
constexpr int BM = 256, BK = 64, HALF = 128, HTB = HALF * BK * 2, NXCD = 8, WGM = 8;
DI int lds_byte(int r, int c) { const int st = (r >> 4) * 2 + (c >> 5), rr = r & 15, cc = c & 31, ob = rr * 64 + cc * 2; return st * 1024 + (ob ^ (((ob >> 9) & 1) << 5)); }
DI void stage_rc(int b, int& R, int& C) { const int st = b / 1024, sb = b % 1024, swz = sb ^ (((sb >> 9) & 1) << 5); R = (st >> 1) * 16 + swz / 64; C = (st & 1) * 32 + (swz % 64) / 2; }
struct Unit { int pm, pn; };
struct Gemm { const bf16_t* A; const bf16_t* Bt; int M, N, K; };
struct StaticOrder {
    int nM, nN, nwg, G, c;
    DI void init(int M, int N, int G_, int c_) { nM = M / BM; nN = N / BM; nwg = nM * nN; G = G_; c = c_; }
    DI bool next(int i, Unit& u) const {
        const long L = (long)i * G + c; if (L >= nwg) return false;
        int wgid = (int)L; { const int q = nwg / NXCD, r = nwg % NXCD, xcd = wgid % NXCD, off = wgid / NXCD; wgid = (xcd < r ? xcd * (q + 1) : r * (q + 1) + (xcd - r) * q) + off; }
        const int nig = WGM * nN, gid = wgid / nig, fm = gid * WGM, gsz = (nM - fm) < WGM ? (nM - fm) : WGM;
        u.pm = fm + ((wgid % nig) % gsz); u.pn = (wgid % nig) / gsz; return true;
    }
};
template <class Epi, class Sched>
DI void gemm_phase(LAS unsigned char* lds, const Gemm g, const Sched& S, const Epi& E) {
    const int tid = tidx(), wid = __builtin_amdgcn_readfirstlane(tid >> 6), lane = tid & 63, wr = wid >> 2, wc = wid & 3, fr = lane & 15, fq = lane >> 4;
    const int K = g.K, nt = K / BK;
    unsigned voffA[2], voffB[2];
#pragma unroll
    for (int i = 0; i < 2; ++i) { int R, C; stage_rc(tid * 16 + i * 8192, R, C); voffA[i] = (unsigned)(R * K + C) * 2u; voffB[i] = (unsigned)(R * K + C) * 2u; }
    const size_t kstep = (size_t)(BK * 2);
    const size_t hstep = (size_t)HALF * K * 2;
    const size_t tstep = 2 * hstep;
    const unsigned ldsw = (unsigned)wid * 1024u;
    const int aoff = lds_byte(wr * 64 + fr, fq * 8), boff = lds_byte(wc * 32 + fr, fq * 8);
#define PG8_SA(b, h) (((b) * 2 + (h)) * HTB)
#define PG8_SB(b, h) ((4 + (b) * 2 + (h)) * HTB)
#define PG8_STAGE(bufoff, gbase, voff) do { _Pragma("unroll") for (int _i = 0; _i < 2; ++_i) \
        __builtin_amdgcn_global_load_lds((const unsigned*)((const char*)(gbase) + (voff)[_i]), (LAS unsigned*)(lds + (bufoff) + ldsw + _i * 8192), 16, 0, 0); } while (0)
#define PG8_LDA(dst, b, h) do { _Pragma("unroll") for (int m = 0; m < 4; ++m) _Pragma("unroll") for (int k = 0; k < 2; ++k) dst[m][k] = *(const LAS bf16x8*)(lds + PG8_SA(b, h) + aoff + m * 2048 + k * 1024); } while (0)
#define PG8_LDB(dst, b, h) do { _Pragma("unroll") for (int n = 0; n < 2; ++n) _Pragma("unroll") for (int k = 0; k < 2; ++k) dst[n][k] = *(const LAS bf16x8*)(lds + PG8_SB(b, h) + boff + n * 2048 + k * 1024); } while (0)
#define PG8_MMA(ai, bj, At, Bt) do { __builtin_amdgcn_s_setprio(1); _Pragma("unroll") for (int m = 0; m < 4; ++m) _Pragma("unroll") for (int n = 0; n < 2; ++n) _Pragma("unroll") for (int k = 0; k < 2; ++k) \
        acc[ai][bj][m][n] = __builtin_amdgcn_mfma_f32_16x16x32_bf16(Bt[n][k], At[m][k], acc[ai][bj][m][n], 0, 0, 0); __builtin_amdgcn_s_setprio(0); } while (0)
#define PG8_WAIT_V(n) asm volatile("s_waitcnt vmcnt(" #n ")" ::: "memory")
#define PG8_WAIT_L(n) asm volatile("s_waitcnt lgkmcnt(" #n ")" ::: "memory")
#define PG8_BAR __builtin_amdgcn_s_barrier()
#define PG8_SCHED __builtin_amdgcn_sched_barrier(0)
    Unit cur, nxt; int ui = 0;
    if (!S.next(0, cur)) return;
    f32x4 acc[2][2][4][2];
#pragma unroll
    for (int a = 0; a < 2; ++a)
#pragma unroll
        for (int b = 0; b < 2; ++b)
#pragma unroll
            for (int m = 0; m < 4; ++m)
#pragma unroll
                for (int n = 0; n < 2; ++n) acc[a][b][m][n] = (f32x4){0.f, 0.f, 0.f, 0.f};
    bf16x8 At[4][2], B0[2][2], B1[2][2];
    const char* cA = (const char*)g.A + (size_t)cur.pm * tstep; const char* cB = (const char*)g.Bt + (size_t)cur.pn * tstep;
    PG8_STAGE(PG8_SB(0, 0), cB, voffB); PG8_STAGE(PG8_SA(0, 0), cA, voffA); PG8_STAGE(PG8_SB(0, 1), cB + hstep, voffB); PG8_STAGE(PG8_SA(0, 1), cA + hstep, voffA);
    if (wr == 1) PG8_BAR;
    PG8_WAIT_V(4); PG8_BAR;
    PG8_STAGE(PG8_SB(1, 0), cB + kstep, voffB); PG8_STAGE(PG8_SA(1, 0), cA + kstep, voffA); PG8_STAGE(PG8_SB(1, 1), cB + hstep + kstep, voffB);
    PG8_WAIT_V(6); PG8_BAR;
    for (;;) {
        const bool has_next = S.next(ui + 1, nxt);
        const char* nA = has_next ? (const char*)g.A + (size_t)nxt.pm * tstep : cA; const char* nB = has_next ? (const char*)g.Bt + (size_t)nxt.pn * tstep : cB;
        for (int t = 0; t < nt; t += 2) {
            const bool last = (t == nt - 2);
            const char* a1 = cA + (size_t)(t + 1) * kstep;
            const char* a2 = last ? nA : cA + (size_t)(t + 2) * kstep; const char* b2 = last ? nB : cB + (size_t)(t + 2) * kstep;
            const char* a3 = a2 + kstep; const char* b3 = b2 + kstep;
            PG8_LDB(B0, 0, 0); PG8_SCHED; PG8_LDA(At, 0, 0); PG8_STAGE(PG8_SA(1, 1), a1 + hstep, voffA);
            PG8_WAIT_L(8); PG8_BAR; PG8_WAIT_L(0); PG8_MMA(0, 0, At, B0); PG8_BAR; PG8_SCHED;
            PG8_LDB(B1, 0, 1); PG8_STAGE(PG8_SB(0, 0), b2, voffB);
            PG8_BAR; PG8_WAIT_L(0); PG8_MMA(0, 1, At, B1); PG8_BAR;
            PG8_LDA(At, 0, 1); PG8_STAGE(PG8_SA(0, 0), a2, voffA);
            PG8_BAR; PG8_WAIT_L(0); PG8_MMA(1, 0, At, B0); PG8_BAR; PG8_SCHED;
            PG8_STAGE(PG8_SB(0, 1), b2 + hstep, voffB);
            PG8_WAIT_V(6); PG8_BAR; PG8_MMA(1, 1, At, B1); PG8_BAR;
            PG8_LDB(B0, 1, 0); PG8_SCHED; PG8_LDA(At, 1, 0); PG8_STAGE(PG8_SA(0, 1), a2 + hstep, voffA);
            PG8_WAIT_L(8); PG8_BAR; PG8_WAIT_L(0); PG8_MMA(0, 0, At, B0); PG8_BAR; PG8_SCHED;
            PG8_LDB(B1, 1, 1); PG8_STAGE(PG8_SB(1, 0), b3, voffB);
            PG8_BAR; PG8_WAIT_L(0); PG8_MMA(0, 1, At, B1); PG8_BAR;
            PG8_LDA(At, 1, 1); PG8_STAGE(PG8_SA(1, 0), a3, voffA);
            PG8_BAR; PG8_WAIT_L(0); PG8_MMA(1, 0, At, B0); PG8_BAR; PG8_SCHED;
            PG8_STAGE(PG8_SB(1, 1), b3 + hstep, voffB);
            PG8_WAIT_V(6); PG8_BAR; PG8_MMA(1, 1, At, B1); PG8_BAR;
        }
        E(acc, cur, wr, wc, fr, fq);
        if (!has_next) break;
#pragma unroll
        for (int a = 0; a < 2; ++a)
#pragma unroll
            for (int b = 0; b < 2; ++b)
#pragma unroll
                for (int m = 0; m < 4; ++m)
#pragma unroll
                    for (int n = 0; n < 2; ++n) acc[a][b][m][n] = (f32x4){0.f, 0.f, 0.f, 0.f};
        cur = nxt; cA = nA; cB = nB; ++ui;
    }
    PG8_WAIT_V(0);
    if (wr == 0) PG8_BAR;
    PG8_BAR;
#undef PG8_SA
#undef PG8_SB
#undef PG8_STAGE
#undef PG8_LDA
#undef PG8_LDB
#undef PG8_MMA
#undef PG8_WAIT_V
#undef PG8_WAIT_L
#undef PG8_BAR
#undef PG8_SCHED
}
}

struct EpiIn {
    bf16_t* proj; bf16_t* vta; bf16_t* vtc; float* bint;
    DI void operator()(const f32x4 (&acc)[2][2][4][2], const pg8::Unit& u, int wr, int wc, int fr, int fq) const {
        const int colt = u.pn * 256;
        int kind = 0;
        if (colt < C_AGATE) { if ((colt % 3072) >= 2048) kind = 1; }
        else if (colt >= C_BIN && colt < C_BGATE) kind = 2;
        else if (colt >= C_CQKV + 2048 && colt < C_CGATE) kind = 3;
        const int row0 = u.pm * 256 + wr * 64 + fr, col0 = colt + wc * 32 + 4 * fq;
        if (kind == 0) {
#pragma unroll
            for (int ai = 0; ai < 2; ++ai)
#pragma unroll
                for (int m = 0; m < 4; ++m) { bf16_t* rp = proj + (size_t)(row0 + ai * 128 + m * 16) * NIN + col0;
#pragma unroll
                    for (int bj = 0; bj < 2; ++bj)
#pragma unroll
                        for (int n = 0; n < 2; ++n) { const f32x4 a = acc[ai][bj][m][n]; u32x2 o = {pk2(a[0], a[1]), pk2(a[2], a[3])}; *(u32x2*)(rp + bj * 128 + n * 16) = o; } }
        } else if (kind == 2) {
#pragma unroll
            for (int ai = 0; ai < 2; ++ai)
#pragma unroll
                for (int m = 0; m < 4; ++m) { const int row = row0 + ai * 128 + m * 16;
#pragma unroll
                    for (int bj = 0; bj < 2; ++bj)
#pragma unroll
                        for (int n = 0; n < 2; ++n) { const f32x4 a = acc[ai][bj][m][n]; float* bp = bint + (size_t)(col0 + bj * 128 + n * 16 - C_BIN) * S + row;
#pragma unroll
                            for (int e = 0; e < 4; ++e) bp[(size_t)e * S] = a[e]; } }
        } else {
            int sh = 0; bf16_t* base;
            if (kind == 1) { const int g = colt / 3072; sh = 2 * g; base = vta + (ptrdiff_t)(g * 1024 - g * 3072 - 2048) * (ptrdiff_t)S; }
            else base = vtc - (ptrdiff_t)(C_CQKV + 2048) * (ptrdiff_t)S;
#pragma unroll
            for (int ai = 0; ai < 2; ++ai)
#pragma unroll
                for (int m = 0; m < 4; ++m) { const int row = row0 + ai * 128 + m * 16; const int prow = (kind == 3) ? ((row & ~12) | ((row & 4) << 1) | ((row & 8) >> 1)) : (((row & ((1 << sh) - 1)) * (S >> sh)) + (row >> sh));
#pragma unroll
                    for (int bj = 0; bj < 2; ++bj)
#pragma unroll
                        for (int n = 0; n < 2; ++n) { const f32x4 a = acc[ai][bj][m][n]; bf16_t* bp = base + (ptrdiff_t)(col0 + bj * 128 + n * 16) * (ptrdiff_t)S + prow;
                            const unsigned p0 = pk2(a[0], a[1]), p1 = pk2(a[2], a[3]);
                            bp[0] = (bf16_t)(p0 & 0xffff); bp[(size_t)S] = (bf16_t)(p0 >> 16); bp[(size_t)2 * S] = (bf16_t)(p1 & 0xffff); bp[(size_t)3 * S] = (bf16_t)(p1 >> 16); } }
        }
    }
};
struct ProjOrder {
    pg8::StaticOrder so;
    DI bool next(int i, pg8::Unit& u) const { pg8::Unit b; if (!so.next(i / 3, b)) return false; const int nb = i % 3; u.pm = b.pm + 32 * nb; u.pn = b.pn + 8 * nb; return true; }
};
struct EpiProj {
    const bf16_t* proj; const float* mb; float* yf; bf16_t* yb;
    DI void operator()(const f32x4 (&acc)[2][2][4][2], const pg8::Unit& u, int wr, int wc, int fr, int fq) const {
        const int nb = u.pm >> 5;
        const int row0 = (u.pm & 31) * 256 + wr * 64 + fr, col0 = (u.pn & 7) * 256 + wc * 32 + 4 * fq;
#pragma unroll
        for (int ai = 0; ai < 2; ++ai)
#pragma unroll
            for (int m = 0; m < 4; ++m) { const int row = row0 + ai * 128 + m * 16;
#pragma unroll
                for (int bj = 0; bj < 2; ++bj)
#pragma unroll
                    for (int n = 0; n < 2; ++n) { const int col = col0 + bj * 128 + n * 16; const f32x4 a = acc[ai][bj][m][n];
                        const u32x2 mg = *(const u32x2*)(proj + (size_t)row * NIN + C_MERGE + nb * D + col);
                        const f32x4 b4 = *(const f32x4*)(mb + nb * D + col);
                        f32x4 v;
                        v[0] = a[0] * sigm_f(bflo(mg[0]) + b4[0]); v[1] = a[1] * sigm_f(bfhi(mg[0]) + b4[1]);
                        v[2] = a[2] * sigm_f(bflo(mg[1]) + b4[2]); v[3] = a[3] * sigm_f(bfhi(mg[1]) + b4[3]);
                        float* yp = yf + (size_t)row * D + col;
                        if (nb > 0) v += *(const f32x4*)yp;
                        if (nb < 2) *(f32x4*)yp = v;
                        else { u32x2 o = {pk2(v[0], v[1]), pk2(v[2], v[3])}; *(u32x2*)(yb + (size_t)row * D + col) = o; } } }
    }
};
struct EpiOut {
    const float* xold; float* xnew;
    DI void operator()(const f32x4 (&acc)[2][2][4][2], const pg8::Unit& u, int wr, int wc, int fr, int fq) const {
        const int row0 = u.pm * 256 + wr * 64 + fr, col0 = u.pn * 256 + wc * 32 + 4 * fq;
#pragma unroll
        for (int ai = 0; ai < 2; ++ai)
#pragma unroll
            for (int m = 0; m < 4; ++m) { const int row = row0 + ai * 128 + m * 16;
#pragma unroll
                for (int bj = 0; bj < 2; ++bj)
#pragma unroll
                    for (int n = 0; n < 2; ++n) { const size_t o = (size_t)row * D + col0 + bj * 128 + n * 16;
                        *(f32x4*)(xnew + o) = *(const f32x4*)(xold + o) + acc[ai][bj][m][n]; } }
    }
};
DI float wave_sum(float v) {
#pragma unroll
    for (int o = 1; o < 64; o <<= 1) v += __shfl_xor(v, o);
    return v;
}
DI int crow(int reg, int h) { return (reg & 3) + 8 * (reg >> 2) + 4 * h; }
DI bf16x8 pack8(const f32x16& x, const int s) {
    u32x4 p;
    p[0] = pk2(x[8 * s + 0], x[8 * s + 1]); p[1] = pk2(x[8 * s + 2], x[8 * s + 3]);
    p[2] = pk2(x[8 * s + 4], x[8 * s + 5]); p[3] = pk2(x[8 * s + 6], x[8 * s + 7]);
    return __builtin_bit_cast(bf16x8, p);
}
#define MFMA32(a, b, c) __builtin_amdgcn_mfma_f32_32x32x16_bf16((a), (b), (c), 0, 0, 0)

DI void transpose_item(const float* Wsrc, int K, int N, bf16_t* WT, LAS float* scr, int item, int lane) {
    const int nblk = N / 64, kb = item / nblk, nb = item % nblk, k0 = 64 * kb, n0 = 64 * nb;
    const int lr = lane >> 4, lc = (lane & 15) * 4;
    f32x4 v[16];
#pragma unroll
    for (int i = 0; i < 16; ++i) v[i] = *(const f32x4*)(Wsrc + (size_t)(k0 + 4 * i + lr) * N + n0 + lc);
#pragma unroll
    for (int i = 0; i < 16; ++i) { LAS float* d = scr + (4 * i + lr) * 65 + lc; d[0] = v[i][0]; d[1] = v[i][1]; d[2] = v[i][2]; d[3] = v[i][3]; }
    __builtin_amdgcn_wave_barrier();
    const int c = lane & 7;
#pragma unroll
    for (int j = 0; j < 8; ++j) { const int n = (lane >> 3) + 8 * j; const LAS float* s = scr + (8 * c) * 65 + n;
        u32x4 o; o[0] = pk2(s[0 * 65], s[1 * 65]); o[1] = pk2(s[2 * 65], s[3 * 65]); o[2] = pk2(s[4 * 65], s[5 * 65]); o[3] = pk2(s[6 * 65], s[7 * 65]);
        *(u32x4*)(WT + (size_t)(n0 + n) * K + k0 + 8 * c) = o; }
    __builtin_amdgcn_wave_barrier();
}
DI int t5_bucket(int rel) {
    const int ret = rel > 0 ? 16 : 0; const int n = rel < 0 ? -rel : rel;
    const float nf = (float)(n > 1 ? n : 1);
    int large = 8 + (int)(logf(nf / 8.0f) / 4.852030263919617f * 8.0f);
    large = large < 15 ? large : 15;
    return ret + (n < 8 ? n : large);
}
DI void phase_prologue(const Params& p, LAS unsigned char* lds) {
    const int tid = tidx(), wave = tid >> 6, lane = tid & 63;
    const int gw = blockIdx.x * NWAVES + wave, NGW = gridDim.x * NWAVES;
    LAS float* scr = (LAS float*)(lds + wave * 16640);
    bf16_t* win_t = (bf16_t*)(p.ws + WS_WIN); bf16_t* wpr_t = (bf16_t*)(p.ws + WS_WPR); bf16_t* wout_t = (bf16_t*)(p.ws + WS_WOUT);
    constexpr int IT_IN = (D / 64) * (NIN / 64), IT_PR = (1024 / 64) * (D / 64), IT_OUT = (D / 64) * (D / 64);
    constexpr int TOT = DEPTH * IT_IN + DEPTH * 3 * IT_PR + DEPTH * IT_OUT;
    for (int it = gw; it < TOT; it += NGW) {
        int r = it;
        if (r < DEPTH * IT_IN) { const int l = r / IT_IN; transpose_item(p.in[I_WIN] + (size_t)l * D * NIN, D, NIN, win_t + (size_t)l * NIN * D, scr, r % IT_IN, lane); continue; }
        r -= DEPTH * IT_IN;
        if (r < DEPTH * 3 * IT_PR) { const int l = r / IT_PR; transpose_item(p.in[I_WPROJ] + (size_t)l * 1024 * D, 1024, D, wpr_t + (size_t)l * D * 1024, scr, r % IT_PR, lane); continue; }
        r -= DEPTH * 3 * IT_PR;
        { const int l = r / IT_OUT; transpose_item(p.in[I_WOUT] + (size_t)l * D * D, D, D, wout_t + (size_t)l * D * D, scr, r % IT_OUT, lane); }
    }
    float* bias = (float*)(p.ws + WS_BIAS);
    for (int i = blockIdx.x * NTHR + tid; i < 32 * 2049; i += gridDim.x * NTHR) {
        const int hd = i / 2049, rel = (i % 2049) - 1024;
        bias[i] = p.in[I_RELB][t5_bucket(rel) * 32 + hd] * LOG2E;
    }
    __syncthreads();
    LAS float* zemb = (LAS float*)lds;
    LAS float* h1 = (LAS float*)(lds + 2048);
    float* hid2 = (float*)(p.ws + WS_HID2);
    for (int rb = blockIdx.x; rb < S / 8; rb += gridDim.x) {
        const int rl = tid >> 6, j = tid & 63, i = rb * 8 + rl;
        if (j < 33) {
            float z;
            if (j == 0) z = (float)i / 8191.0f;
            else { const int k = (j - 1) & 15; const float fb = 1e-4f + (float)k * ((15.0f - 1e-4f) / 15.0f); const float w = 6.283185307179586f * (float)i / 8192.0f; const float a = fb * w; z = (j <= 16) ? cosf(a) : -sinf(a); }
            zemb[rl * 36 + j] = z;
        }
        __syncthreads();
        for (int l = 0; l < DEPTH; ++l) {
            float a1 = p.in[I_HYB1][l * 64 + j];
            for (int e = 0; e < 33; ++e) a1 += zemb[rl * 36 + e] * p.in[I_HYW1][(l * 33 + e) * 64 + j];
            h1[rl * 64 + j] = sinf(p.in[I_HYFREQ][(l * 2 + 0) * 64 + j] * a1);
            __syncthreads();
            float a2 = p.in[I_HYB2][l * 64 + j];
            for (int e = 0; e < 64; ++e) a2 += h1[rl * 64 + e] * p.in[I_HYW2][(l * 64 + e) * 64 + j];
            hid2[((size_t)l * S + i) * 64 + j] = sinf(p.in[I_HYFREQ][(l * 2 + 1) * 64 + j] * a2);
            __syncthreads();
        }
    }
}

#define XI(i) ((i) + ((i) >> 4) + ((i) >> 8))
DI cf cmul(cf a, cf b) { return (cf){a.x * b.x - a.y * b.y, a.x * b.y + a.y * b.x}; }
DI cf twid(float frac) { return (cf){__builtin_amdgcn_cosf(frac), -__builtin_amdgcn_sinf(frac)}; }
DI cf twidc(float frac) { return (cf){__builtin_amdgcn_cosf(frac), __builtin_amdgcn_sinf(frac)}; }
DI void fwd4(cf& a0, cf& a1, cf& a2, cf& a3) {
    const cf s02 = a0 + a2, d02 = a0 - a2, s13 = a1 + a3, d13 = a1 - a3;
    a0 = s02 + s13; a2 = s02 - s13;
    a1 = (cf){d02.x + d13.y, d02.y - d13.x};
    a3 = (cf){d02.x - d13.y, d02.y + d13.x};
}
DI void inv4(cf& b0, cf& b1, cf& b2, cf& b3) {
    const cf s02 = b0 + b2, d02 = b0 - b2, s13 = b1 + b3, d13 = b1 - b3;
    b0 = s02 + s13; b2 = s02 - s13;
    b1 = (cf){d02.x - d13.y, d02.y + d13.x};
    b3 = (cf){d02.x + d13.y, d02.y - d13.x};
}
template <int LOGM> DI void fwd_r4_pass(LAS cf* X, int tid) {
    asm volatile("" : "+v"(tid));
    constexpr int M = 1 << LOGM, q = M >> 2;
#pragma unroll 2
    for (int t = tid; t < 4096; t += NTHR) {
        const int j = t & (q - 1), base = (t >> (LOGM - 2)) * M + j;
        cf a0 = X[XI(base)], a1 = X[XI(base + q)], a2 = X[XI(base + 2 * q)], a3 = X[XI(base + 3 * q)];
        fwd4(a0, a1, a2, a3);
        const cf w1 = twid((float)j * (1.0f / M)), w2 = cmul(w1, w1), w3 = cmul(w2, w1);
        X[XI(base)] = a0; X[XI(base + q)] = cmul(a1, w1); X[XI(base + 2 * q)] = cmul(a2, w2); X[XI(base + 3 * q)] = cmul(a3, w3);
    }
}
template <int LOGM> DI void inv_r4_pass(LAS cf* X, int tid) {
    asm volatile("" : "+v"(tid));
    constexpr int M = 1 << LOGM, q = M >> 2;
#pragma unroll 2
    for (int t = tid; t < 4096; t += NTHR) {
        const int j = t & (q - 1), base = (t >> (LOGM - 2)) * M + j;
        const cf w1 = twidc((float)j * (1.0f / M)), w2 = cmul(w1, w1), w3 = cmul(w2, w1);
        cf b0 = X[XI(base)], b1 = cmul(X[XI(base + q)], w1), b2 = cmul(X[XI(base + 2 * q)], w2), b3 = cmul(X[XI(base + 3 * q)], w3);
        inv4(b0, b1, b2, b3);
        X[XI(base)] = b0; X[XI(base + q)] = b1; X[XI(base + 2 * q)] = b2; X[XI(base + 3 * q)] = b3;
    }
}
template <int LOGM> DI void fwd16(cf (&v)[16], int j) {
    constexpr int M = 1 << LOGM, q = M >> 4;
#pragma unroll
    for (int n = 0; n < 4; ++n) {
        fwd4(v[n], v[n + 4], v[n + 8], v[n + 12]);
        const cf w1 = twid((float)(j + n * q) * (1.0f / M)), w2 = cmul(w1, w1), w3 = cmul(w2, w1);
        v[n + 4] = cmul(v[n + 4], w1); v[n + 8] = cmul(v[n + 8], w2); v[n + 12] = cmul(v[n + 12], w3);
    }
    const cf u1 = twid((float)j * (4.0f / M)), u2 = cmul(u1, u1), u3 = cmul(u2, u1);
#pragma unroll
    for (int m = 0; m < 4; ++m) {
        fwd4(v[4 * m], v[4 * m + 1], v[4 * m + 2], v[4 * m + 3]);
        v[4 * m + 1] = cmul(v[4 * m + 1], u1); v[4 * m + 2] = cmul(v[4 * m + 2], u2); v[4 * m + 3] = cmul(v[4 * m + 3], u3);
    }
}
template <int LOGM> DI void inv16(cf (&v)[16], int j) {
    constexpr int M = 1 << LOGM, q = M >> 4;
    const cf u1 = twidc((float)j * (4.0f / M)), u2 = cmul(u1, u1), u3 = cmul(u2, u1);
#pragma unroll
    for (int m = 0; m < 4; ++m) {
        v[4 * m + 1] = cmul(v[4 * m + 1], u1); v[4 * m + 2] = cmul(v[4 * m + 2], u2); v[4 * m + 3] = cmul(v[4 * m + 3], u3);
        inv4(v[4 * m], v[4 * m + 1], v[4 * m + 2], v[4 * m + 3]);
    }
#pragma unroll
    for (int n = 0; n < 4; ++n) {
        const cf w1 = twidc((float)(j + n * q) * (1.0f / M)), w2 = cmul(w1, w1), w3 = cmul(w2, w1);
        v[n + 4] = cmul(v[n + 4], w1); v[n + 8] = cmul(v[n + 8], w2); v[n + 12] = cmul(v[n + 12], w3);
        inv4(v[n], v[n + 4], v[n + 8], v[n + 12]);
    }
}
template <int LOGM> DI void fwd_r16_pass(LAS cf* X, int tid) {
    asm volatile("" : "+v"(tid));
    constexpr int M = 1 << LOGM, q = M >> 4;
#pragma unroll 1
    for (int t = tid; t < 1024; t += NTHR) {
        const int j = t & (q - 1), base = (t >> (LOGM - 4)) * M + j;
        cf v[16];
#pragma unroll
        for (int n = 0; n < 16; ++n) v[n] = X[XI(base + n * q)];
        fwd16<LOGM>(v, j);
#pragma unroll
        for (int n = 0; n < 16; ++n) X[XI(base + n * q)] = v[n];
    }
}
template <int LOGM> DI void inv_r16_pass(LAS cf* X, int tid) {
    asm volatile("" : "+v"(tid));
    constexpr int M = 1 << LOGM, q = M >> 4;
#pragma unroll 1
    for (int t = tid; t < 1024; t += NTHR) {
        const int j = t & (q - 1), base = (t >> (LOGM - 4)) * M + j;
        cf v[16];
#pragma unroll
        for (int n = 0; n < 16; ++n) v[n] = X[XI(base + n * q)];
        inv16<LOGM>(v, j);
#pragma unroll
        for (int n = 0; n < 16; ++n) X[XI(base + n * q)] = v[n];
    }
}
DI int rev4(int pp) { const unsigned br = __brev((unsigned)pp) >> 18; return (int)(((br & 0x2AAAu) >> 1) | ((br & 0x1555u) << 1)); }
DI void fft_forward(LAS cf* X, int tid) {
    fwd_r4_pass<14>(X, tid); __syncthreads();
    fwd_r16_pass<12>(X, tid); __syncthreads();
    fwd_r16_pass<8>(X, tid); __syncthreads();
    fwd_r16_pass<4>(X, tid); __syncthreads();
}
constexpr int SPEC_STRIDE = 8208;
DI void fft_conv(LAS cf* X, const f32x4* spec, int tid) {
    fft_forward(X, tid);
#pragma unroll 2
    for (int r = 0; r < 16; ++r) {
        const int k = tid + NTHR * r; const int pp = rev4(k);
        const f32x4 sp = spec[k]; const cf P = (cf){sp[0], sp[1]}, Mq = (cf){sp[2], sp[3]};
        const cf z = X[XI(pp)];
        if (k == 0) { X[XI(pp)] = cmul(z, P) + cmul((cf){z.x, -z.y}, Mq); }
        else { const int pm = rev4(16384 - k); const cf zm = X[XI(pm)];
            const cf y = cmul(z, P) + cmul((cf){zm.x, -zm.y}, Mq);
            const cf t = cmul((cf){zm.x, -zm.y}, P) + cmul(z, Mq);
            X[XI(pp)] = y; X[XI(pm)] = (cf){t.x, -t.y}; }
    }
    if (tid == 0) { const int pp = rev4(8192); const f32x4 sp = spec[8192]; const cf z = X[XI(pp)]; X[XI(pp)] = cmul(z, (cf){sp[0], sp[1]}) + cmul((cf){z.x, -z.y}, (cf){sp[2], sp[3]}); }
    __syncthreads();
    inv_r16_pass<4>(X, tid); __syncthreads();
    inv_r16_pass<8>(X, tid); __syncthreads();
    inv_r16_pass<12>(X, tid); __syncthreads();
    inv_r4_pass<14>(X, tid); __syncthreads();
}

DI void spectra_item(const Params& p, int item, LAS unsigned char* lds) {
    int tid = tidx(); asm volatile("" : "+v"(tid));
    const int l = item >> 10, o = (item >> 9) & 1, pr = item & 511, a = 2 * pr;
    LAS cf* X = (LAS cf*)lds; LAS float* aux = (LAS float*)(lds + LDS_MAIN);
    if (tid < 256) { const int j = tid >> 2, e = tid & 3; aux[tid] = p.in[I_HYW3][(size_t)(l * 64 + j) * 4096 + (o * 2 + (e >> 1)) * 1024 + a + (e & 1)]; }
    __syncthreads();
    const float mind = -3.0701134573253943f, maxd = -15.350567286626972f;
    const float da = fabsf(mind + (float)a * ((maxd - mind) / 1023.0f)), db = fabsf(mind + (float)(a + 1) * ((maxd - mind) / 1023.0f));
    const float* hid2 = (const float*)(p.ws + WS_HID2) + (size_t)l * S * 64;
    const float ska = p.in[I_HYSKIP][(l * 2 + o) * 1024 + a], skb = p.in[I_HYSKIP][(l * 2 + o) * 1024 + a + 1];
#pragma unroll 1
    for (int r = 0; r < 16; ++r) {
        const int i = tid + NTHR * r;
        const f32x4* hr = (const f32x4*)(hid2 + (size_t)i * 64);
        float d0 = 0.f, d1 = 0.f, d2 = 0.f, d3 = 0.f;
#pragma unroll
        for (int jj = 0; jj < 16; ++jj) { const f32x4 hv = hr[jj];
#pragma unroll
            for (int e = 0; e < 4; ++e) { const f32x4 wv = *(const LAS f32x4*)(aux + (jj * 4 + e) * 4); d0 += hv[e] * wv[0]; d1 += hv[e] * wv[1]; d2 += hv[e] * wv[2]; d3 += hv[e] * wv[3]; } }
        const float ti = (float)i / 8191.0f; const float ea = __expf(-ti * da), eb = __expf(-ti * db);
        const float fa = d0 * ea, fb = d1 * eb, ba = d2 * ea, bb = d3 * eb;
        if (i == 0) { X[XI(0)] = (cf){fa + ba + ska, fb + bb + skb}; X[XI(8192)] = (cf){0.f, 0.f}; }
        else { X[XI(i)] = (cf){fa, fb}; X[XI(16384 - i)] = (cf){ba, bb}; }
    }
    __syncthreads();
    fft_forward(X, tid);
    f32x4* spec = (f32x4*)(p.ws + WS_SPEC) + (size_t)item * SPEC_STRIDE;
    const float sc = 0.5f / 16384.0f;
    for (int r = 0; r < 17; ++r) {
        const int k = tid + NTHR * r; if (k > 8192) break;
        const cf F = X[XI(rev4(k))], Fm = X[XI(rev4((16384 - k) & 16383))];
        const cf Fc = (cf){Fm.x, -Fm.y};
        const cf Ha = (F + Fc) * 0.5f, tt = (F - Fc) * 0.5f; const cf Hb = (cf){tt.y, -tt.x};
        const cf P = (Ha + Hb) * sc, Mq = (Ha - Hb) * sc;
        spec[k] = (f32x4){P.x, P.y, Mq.x, Mq.y};
    }
    __syncthreads();
}

DI float conv3(const float* row, int t, float w0, float w1, float w2) {
    const float c = row[t]; const float pv = t > 0 ? row[t - 1] : 0.f; const float nx = t < S - 1 ? row[t + 1] : 0.f;
    return w0 * pv + w1 * c + w2 * nx;
}
DI void hyena_item(const Params& p, int l, int pr, LAS unsigned char* lds) {
    int tid = tidx(); asm volatile("" : "+v"(tid)); const int a = 2 * pr;
    LAS cf* X = (LAS cf*)lds;
    const float* bint = (const float*)(p.ws + WS_BINT);
    const float* cw = p.in[I_HYCONV] + (size_t)l * 3 * 3072;
    float w[3][2][3];
#pragma unroll
    for (int wh = 0; wh < 3; ++wh)
#pragma unroll
        for (int c = 0; c < 2; ++c)
#pragma unroll
            for (int k = 0; k < 3; ++k) w[wh][c][k] = cw[k * 3072 + wh * 1024 + a + c];
    const f32x4* spec = (const f32x4*)(p.ws + WS_SPEC);
#pragma unroll 2
    for (int r = 0; r < 16; ++r) { const int t = tid + NTHR * r;
        X[XI(t)] = (cf){conv3(bint + (size_t)a * S, t, w[0][0][0], w[0][0][1], w[0][0][2]), conv3(bint + (size_t)(a + 1) * S, t, w[0][1][0], w[0][1][1], w[0][1][2])};
        X[XI(t + 8192)] = (cf){0.f, 0.f}; }
    __syncthreads();
    fft_conv(X, spec + (size_t)((l * 2 + 0) * 512 + pr) * SPEC_STRIDE, tid);
#pragma unroll 2
    for (int r = 0; r < 16; ++r) { const int t = tid + NTHR * r; const cf y = X[XI(t)];
        X[XI(t)] = (cf){y.x * conv3(bint + (size_t)(1024 + a) * S, t, w[1][0][0], w[1][0][1], w[1][0][2]), y.y * conv3(bint + (size_t)(1024 + a + 1) * S, t, w[1][1][0], w[1][1][1], w[1][1][2])};
        X[XI(t + 8192)] = (cf){0.f, 0.f}; }
    __syncthreads();
    fft_conv(X, spec + (size_t)((l * 2 + 1) * 512 + pr) * SPEC_STRIDE, tid);
    float* z2t = (float*)(p.ws + WS_Z2T);
#pragma unroll 2
    for (int r = 0; r < 16; ++r) { const int t = tid + NTHR * r; const cf y = X[XI(t)];
        z2t[(size_t)a * S + t] = y.x * conv3(bint + (size_t)(2048 + a) * S, t, w[2][0][0], w[2][0][1], w[2][0][2]);
        z2t[(size_t)(a + 1) * S + t] = y.y * conv3(bint + (size_t)(2048 + a + 1) * S, t, w[2][1][0], w[2][1][1], w[2][1][2]); }
    __syncthreads();
}
DI void phase_rmsnorm(const float* x, const float* g, bf16_t* hout, float* fout) {
    const int tid = tidx(), wave = tid >> 6, lane = tid & 63;
    for (int row = blockIdx.x * NWAVES + wave; row < S; row += gridDim.x * NWAVES) {
        const f32x4* xr = (const f32x4*)(x + (size_t)row * D) + lane;
        f32x4 v[8]; float s = 0.f;
#pragma unroll
        for (int j = 0; j < 8; ++j) { v[j] = xr[64 * j]; s += (v[j][0] * v[j][0] + v[j][1] * v[j][1]) + (v[j][2] * v[j][2] + v[j][3] * v[j][3]); }
        const float rstd = rsqrtf(wave_sum(s) * (1.0f / D) + 1e-6f);
#pragma unroll
        for (int j = 0; j < 8; ++j) { const f32x4 gg = ((const f32x4*)g)[lane + 64 * j]; const f32x4 y = v[j] * rstd * gg;
            if (hout) { u32x2 o = {pk2(y[0], y[1]), pk2(y[2], y[3])}; ((u32x2*)(hout + (size_t)row * D))[lane + 64 * j] = o; }
            else ((f32x4*)(fout + (size_t)row * D))[lane + 64 * j] = y; }
    }
}

constexpr int KROW = 144, KBUF = 64 * KROW, VBUF = 128 * KROW;
DI void qk_half(const LAS unsigned char* kb_, const bf16x8 (&qf)[4], int r, int hh, f32x16& s) {
#pragma unroll
    for (int i = 0; i < 16; ++i) s[i] = 0.f;
#pragma unroll
    for (int ks = 0; ks < 4; ++ks) { const bf16x8 a = *(const LAS bf16x8*)(kb_ + r * KROW + 32 * ks + 16 * hh); s = MFMA32(a, qf[ks], s); }
}
DI void softmax_pv_half(f32x16& s, const LAS unsigned char* vb_, const LAS float* btab, int k0, int q0w, int r, int hh, float cs, float& m, float& lsum, f32x16 (&O)[4]) {
    const int q = q0w + r;
    const int relmin = k0 - q0w - 31, relmax = k0 + 31 - q0w;
    const bool far = (relmin >= 1024 || relmax <= -1024);
    float bc = 0.f, csx = cs;
    if (far) { bc = btab[relmin >= 1024 ? 2048 : 0]; }
    else {
        if (relmin >= -1024 && relmax <= 1024) {
            const LAS float* bp = btab + (k0 - q + 1024 + 4 * hh);
#pragma unroll
            for (int i = 0; i < 16; ++i) s[i] = s[i] * cs + bp[(i & 3) + 8 * (i >> 2)];
        } else {
#pragma unroll
            for (int i = 0; i < 16; ++i) { const int rel = k0 + crow(i, hh) - q; const int i0 = min(max(rel, -1024), 1024) + 1024; s[i] = s[i] * cs + btab[i0]; }
        }
        csx = 1.0f;
    }
    float mx = s[0];
#pragma unroll
    for (int i = 1; i < 16; ++i) mx = fmaxf(mx, s[i]);
    mx = mx * csx + bc;
    mx = fmaxf(mx, __shfl_xor(mx, 32));
    if (__any(mx > m + 8.0f)) {
        const float mnew = fmaxf(m, mx), alpha = __builtin_amdgcn_exp2f(m - mnew);
        m = mnew; lsum *= alpha;
#pragma unroll
        for (int db = 0; db < 4; ++db) O[db] *= alpha;
    }
    const float c2 = bc - m;
    float rs0 = 0.f, rs1 = 0.f;
#pragma unroll
    for (int i = 0; i < 16; i += 2) { s[i] = __builtin_amdgcn_exp2f(s[i] * csx + c2); s[i + 1] = __builtin_amdgcn_exp2f(s[i + 1] * csx + c2); rs0 += s[i]; rs1 += s[i + 1]; }
    lsum += rs0 + rs1;
#pragma unroll
    for (int ss = 0; ss < 2; ++ss) {
        const bf16x8 pf = pack8(s, ss);
#pragma unroll
        for (int db = 0; db < 4; ++db) {
            const bf16x8 vf = *(const LAS bf16x8*)(vb_ + (32 * db + r) * KROW + (16 * ss + 8 * hh) * 2);
            O[db] = MFMA32(vf, pf, O[db]);
        }
    }
}
DI void diff_flash(const bf16_t* proj, const bf16_t* vtc, int h, int c, int q0w, LAS unsigned char* lds, const LAS float* btab, f32x16 (&O)[4]) {
    int tid = tidx(); asm volatile("" : "+v"(tid)); const int lane = tid & 63, r = lane & 31, hh = lane >> 5;
    constexpr int NT = S / 64;
    bf16x8 qf[4];
    { const bf16_t* qp = proj + (size_t)(q0w + r) * NIN + C_CQKV + h * 128 + c * 64 + 8 * hh;
#pragma unroll
      for (int ks = 0; ks < 4; ++ks) qf[ks] = *(const bf16x8*)(qp + 16 * ks); }
#pragma unroll
    for (int db = 0; db < 4; ++db)
#pragma unroll
        for (int i = 0; i < 16; ++i) O[db][i] = 0.f;
    float m = -1e30f, lsum = 0.f;
    const float cs = 0.125f * LOG2E;
    const bf16_t* kg = proj + C_CQKV + 1024 + h * 128 + c * 64 + (size_t)(tid >> 3) * NIN + (tid & 7) * 8;
    const bf16_t* vg = vtc + (size_t)(h * 128 + (tid >> 3)) * S + (tid & 7) * 8;
    const int kst = (tid >> 3) * KROW + (tid & 7) * 16;
    LAS unsigned char* Kb = lds; LAS unsigned char* Vb = lds + 3 * KBUF;
    u32x4 kr = *(const u32x4*)kg, v0 = *(const u32x4*)vg, v1 = *(const u32x4*)(vg + (size_t)64 * S);
    __syncthreads();
    *(LAS u32x4*)(Kb + kst) = kr; *(LAS u32x4*)(Vb + kst) = v0; *(LAS u32x4*)(Vb + 64 * KROW + kst) = v1;
    kr = *(const u32x4*)(kg + (size_t)64 * NIN);
    *(LAS u32x4*)(Kb + KBUF + kst) = kr;
    __syncthreads();
    f32x16 sA, sB;
    qk_half(Kb, qf, r, hh, sA);
    int kc = 0, kn = KBUF, kw = 2 * KBUF;
#pragma unroll 1
    for (int t = 0; t < NT; ++t) {
        if (t + 2 < NT) kr = *(const u32x4*)(kg + (size_t)(t + 2) * 64 * NIN);
        if (t + 1 < NT) { v0 = *(const u32x4*)(vg + (t + 1) * 64); v1 = *(const u32x4*)(vg + (size_t)64 * S + (t + 1) * 64); }
        const LAS unsigned char* vb_ = Vb + (t & 1) * VBUF;
        qk_half(Kb + kc + 32 * KROW, qf, r, hh, sB);
        softmax_pv_half(sA, vb_, btab, t * 64, q0w, r, hh, cs, m, lsum, O);
        if (t + 1 < NT) qk_half(Kb + kn, qf, r, hh, sA);
        softmax_pv_half(sB, vb_ + 64, btab, t * 64 + 32, q0w, r, hh, cs, m, lsum, O);
        if (t + 2 < NT) *(LAS u32x4*)(Kb + kw + kst) = kr;
        if (t + 1 < NT) { LAS unsigned char* vn = Vb + ((t + 1) & 1) * VBUF; *(LAS u32x4*)(vn + kst) = v0; *(LAS u32x4*)(vn + 64 * KROW + kst) = v1; }
        __syncthreads();
        const int tmp = kc; kc = kn; kn = kw; kw = tmp;
    }
    const float lt = lsum + __shfl_xor(lsum, 32), inv = 1.0f / lt;
#pragma unroll
    for (int db = 0; db < 4; ++db) O[db] *= inv;
}
DI void diffattn_item(const Params& p, int l, int item, LAS unsigned char* lds) {
    int tid = tidx(); asm volatile("" : "+v"(tid)); const int wave = __builtin_amdgcn_readfirstlane(tid >> 6), lane = tid & 63, r = lane & 31, hh = lane >> 5;
    const int qt = item >> 3, h = item & 7, q0w = qt * 256 + wave * 32;
    LAS float* btab = (LAS float*)(lds + LDS_MAIN);
    const float* bias = (const float*)(p.ws + WS_BIAS) + (24 + h) * 2049;
    for (int i = tid; i < 2049; i += NTHR) btab[i] = bias[i];
    const float* dl = p.in[I_DLAM] + l * 256;
    float d01 = 0.f, d23 = 0.f;
    for (int i = 0; i < 64; ++i) { d01 += dl[i] * dl[64 + i]; d23 += dl[128 + i] * dl[192 + i]; }
    const float lam_init = 0.8f - 0.6f * expf(-0.3f * (float)l);
    const float lam = expf(d01) - expf(d23) + lam_init;
    const bf16_t* proj = (const bf16_t*)(p.ws + WS_PROJ); const bf16_t* vtc = (const bf16_t*)(p.ws + WS_VTC);
    f32x16 O0[4];
    const int q = q0w + r;
    float* ctmp = (float*)(p.ws + WS_CTMP) + (size_t)q * 1024 + h * 128 + 4 * hh;
    diff_flash(proj, vtc, h, 0, q0w, lds, btab, O0);
#pragma unroll
    for (int db = 0; db < 4; ++db)
#pragma unroll
        for (int i4 = 0; i4 < 4; ++i4) { f32x4 o = {O0[db][4 * i4], O0[db][4 * i4 + 1], O0[db][4 * i4 + 2], O0[db][4 * i4 + 3]}; *(f32x4*)(ctmp + 32 * db + 8 * i4) = o; }
    diff_flash(proj, vtc, h, 1, q0w, lds, btab, O0);
    float ss = 0.f;
#pragma unroll
    for (int db = 0; db < 4; ++db)
#pragma unroll
        for (int i4 = 0; i4 < 4; ++i4) { const f32x4 o0 = *(const f32x4*)(ctmp + 32 * db + 8 * i4);
#pragma unroll
            for (int e = 0; e < 4; ++e) { const float o = o0[e] - lam * O0[db][4 * i4 + e]; O0[db][4 * i4 + e] = o; ss += o * o; } }
    ss += __shfl_xor(ss, 32);
    const float rn = rsqrtf(ss * (1.0f / 128.0f) + 1e-6f) * (1.0f - lam_init);
    const float* dg = p.in[I_DG] + l * 128;
    bf16_t* cout = (bf16_t*)(p.ws + WS_BR) + (size_t)2 * S * 1024;
#pragma unroll
    for (int db = 0; db < 4; ++db)
#pragma unroll
        for (int i4 = 0; i4 < 4; ++i4) {
            const int d0 = 32 * db + 8 * i4 + 4 * hh;
            const f32x4 g4 = *(const f32x4*)(dg + d0);
            const u32x2 gt = *(const u32x2*)(proj + (size_t)q * NIN + C_CGATE + h * 128 + d0);
            const float y0 = O0[db][4 * i4 + 0] * rn * g4[0] * silu_f(bflo(gt[0])), y1 = O0[db][4 * i4 + 1] * rn * g4[1] * silu_f(bfhi(gt[0]));
            const float y2 = O0[db][4 * i4 + 2] * rn * g4[2] * silu_f(bflo(gt[1])), y3 = O0[db][4 * i4 + 3] * rn * g4[3] * silu_f(bfhi(gt[1]));
            u32x2 o = {pk2(y0, y1), pk2(y2, y3)};
            *(u32x2*)(cout + (size_t)q * 1024 + h * 128 + d0) = o;
        }
    __syncthreads();
}

DI void mixA_wave_item(const Params& p, int wi, int lane) {
    asm volatile("" : "+v"(lane));
    const int g = wi >> 11, rem = wi & 2047, h = rem >> 8, qb = rem & 255;
    const int sh = 2 * g, n = S >> sh, nbq = 256 >> sh, res = qb / nbq, m0 = (qb % nbq) * 32;
    const int r = lane & 31, hh = lane >> 5;
    const bf16_t* proj = (const bf16_t*)(p.ws + WS_PROJ);
    const int qpos = ((m0 + r) << sh) + res;
    bf16x8 qf[8];
    { const bf16_t* qp = proj + (size_t)qpos * NIN + g * 3072 + h * 128 + 8 * hh;
#pragma unroll
      for (int ks = 0; ks < 8; ++ks) qf[ks] = *(const bf16x8*)(qp + 16 * ks); }
    f32x16 O[4];
#pragma unroll
    for (int db = 0; db < 4; ++db)
#pragma unroll
        for (int i = 0; i < 16; ++i) O[db][i] = 0.f;
    float m = -1e30f, lsum = 0.f;
    const float cs = 0.08838834764831845f * LOG2E;
    const float* bias = (const float*)(p.ws + WS_BIAS) + (g * 8 + h) * 2049 + 1024;
    const bf16_t* vt = (const bf16_t*)(p.ws + WS_VTA) + (size_t)((g * 8 + h) * 128) * S + res * n;
#pragma unroll
    for (int kb = 0; kb < 5; ++kb) {
        const int mk0r = m0 - 64 + 32 * kb;
        const bool blk_ok = (mk0r >= 0) && (mk0r < n);
        const int mk0 = blk_ok ? mk0r : m0;
        const int kpos = ((mk0 + r) << sh) + res;
        const bf16_t* kp = proj + (size_t)kpos * NIN + g * 3072 + 1024 + h * 128 + 8 * hh;
        f32x16 s;
#pragma unroll
        for (int i = 0; i < 16; ++i) s[i] = 0.f;
#pragma unroll
        for (int ks = 0; ks < 8; ++ks) { const bf16x8 a = *(const bf16x8*)(kp + 16 * ks); s = MFMA32(a, qf[ks], s); }
        float mx = -INFINITY;
#pragma unroll
        for (int i = 0; i < 16; ++i) { const int rel = mk0r + crow(i, hh) - (m0 + r); const bool valid = blk_ok && (rel <= 64) && (rel >= -64);
            const int bi = min(max(rel << sh, -1024), 1024);
            const float v = valid ? (s[i] * cs + bias[bi]) : -INFINITY; s[i] = v; mx = fmaxf(mx, v); }
        mx = fmaxf(mx, __shfl_xor(mx, 32));
        const float mnew = fmaxf(m, mx), alpha = __builtin_amdgcn_exp2f(m - mnew);
        m = mnew;
        float rs = 0.f;
#pragma unroll
        for (int i = 0; i < 16; ++i) { s[i] = __builtin_amdgcn_exp2f(s[i] - mnew); rs += s[i]; }
        lsum = lsum * alpha + rs;
#pragma unroll
        for (int db = 0; db < 4; ++db) O[db] *= alpha;
#pragma unroll
        for (int sidx = 0; sidx < 2; ++sidx) {
            const bf16x8 pf = pack8(s, sidx);
#pragma unroll
            for (int db = 0; db < 4; ++db) {
                const bf16_t* vp = vt + (size_t)(32 * db + r) * S + mk0 + 16 * sidx + 4 * hh;
                const s16x4 lo = *(const s16x4*)vp, hi = *(const s16x4*)(vp + 8);
                const bf16x8 vf = __builtin_shufflevector(lo, hi, 0, 1, 2, 3, 4, 5, 6, 7);
                O[db] = MFMA32(vf, pf, O[db]);
            }
        }
    }
    const float lt = lsum + __shfl_xor(lsum, 32), inv = 1.0f / lt;
    float* oa = (float*)(p.ws + WS_OA) + ((size_t)g * S + qpos) * 1024 + h * 128;
#pragma unroll
    for (int db = 0; db < 4; ++db)
#pragma unroll
        for (int i4 = 0; i4 < 4; ++i4) {
            const int d0 = 32 * db + 8 * i4 + 4 * hh;
            f32x4 o = {O[db][4 * i4] * inv, O[db][4 * i4 + 1] * inv, O[db][4 * i4 + 2] * inv, O[db][4 * i4 + 3] * inv};
            *(f32x4*)(oa + d0) = o;
        }
    if (hh == 0) ((float*)(p.ws + WS_LSEA))[((size_t)g * S + qpos) * 8 + h] = m + __log2f(lt);
}

DI void phase_post(const Params& p, LAS unsigned char* lds) {
    const int tid = tidx();
    const bf16_t* proj = (const bf16_t*)(p.ws + WS_PROJ);
    bf16_t* aout = (bf16_t*)(p.ws + WS_BR); bf16_t* bout = aout + (size_t)S * 1024;
    const float* oa = (const float*)(p.ws + WS_OA); const float* lse = (const float*)(p.ws + WS_LSEA);
    for (int idx = blockIdx.x * NTHR + tid; idx < S * 256; idx += gridDim.x * NTHR) {
        const int pos = idx >> 8, c4 = idx & 255, h = c4 >> 5, col = c4 * 4;
        const float l0 = lse[((size_t)0 * S + pos) * 8 + h], l1 = lse[((size_t)1 * S + pos) * 8 + h], l2 = lse[((size_t)2 * S + pos) * 8 + h];
        const float mx = fmaxf(l0, fmaxf(l1, l2));
        const float w0 = __builtin_amdgcn_exp2f(l0 - mx), w1 = __builtin_amdgcn_exp2f(l1 - mx), w2 = __builtin_amdgcn_exp2f(l2 - mx);
        const float inv = 1.0f / (w0 + w1 + w2);
        const f32x4 o0 = *(const f32x4*)(oa + ((size_t)0 * S + pos) * 1024 + col), o1 = *(const f32x4*)(oa + ((size_t)1 * S + pos) * 1024 + col), o2 = *(const f32x4*)(oa + ((size_t)2 * S + pos) * 1024 + col);
        const f32x4 o = (o0 * w0 + o1 * w1 + o2 * w2) * inv;
        const u32x2 gt = *(const u32x2*)(proj + (size_t)pos * NIN + C_AGATE + col);
        u32x2 ov = {pk2(o[0] * silu_f(bflo(gt[0])), o[1] * silu_f(bfhi(gt[0]))), pk2(o[2] * silu_f(bflo(gt[1])), o[3] * silu_f(bfhi(gt[1])))};
        *(u32x2*)(aout + (size_t)pos * 1024 + col) = ov;
    }
    LAS float* tile = (LAS float*)lds;
    const float* z2t = (const float*)(p.ws + WS_Z2T);
    for (int it = blockIdx.x; it < 128 * 16; it += gridDim.x) {
        const int t0 = (it >> 4) * 64, c0 = (it & 15) * 64;
        __syncthreads();
#pragma unroll
        for (int k = 0; k < 2; ++k) { const int e = tid + NTHR * k; const int ci = e >> 4, t4 = (e & 15) * 4;
            const f32x4 v = *(const f32x4*)(z2t + (size_t)(c0 + ci) * S + t0 + t4);
            tile[ci * 65 + t4] = v[0]; tile[ci * 65 + t4 + 1] = v[1]; tile[ci * 65 + t4 + 2] = v[2]; tile[ci * 65 + t4 + 3] = v[3]; }
        __syncthreads();
#pragma unroll
        for (int k = 0; k < 2; ++k) { const int e = tid + NTHR * k; const int ti = e >> 4, cc = (e & 15) * 4;
            const u32x2 gt = *(const u32x2*)(proj + (size_t)(t0 + ti) * NIN + C_BGATE + c0 + cc);
            const float y0 = tile[(cc + 0) * 65 + ti] * silu_f(bflo(gt[0])), y1 = tile[(cc + 1) * 65 + ti] * silu_f(bfhi(gt[0]));
            const float y2 = tile[(cc + 2) * 65 + ti] * silu_f(bflo(gt[1])), y3 = tile[(cc + 3) * 65 + ti] * silu_f(bfhi(gt[1]));
            u32x2 ov = {pk2(y0, y1), pk2(y2, y3)};
            *(u32x2*)(bout + (size_t)(t0 + ti) * 1024 + c0 + cc) = ov; }
    }
    __syncthreads();
}

#ifndef REP_GEMMIN
#define REP_GEMMIN 1
#endif
#ifndef REP_DIFF
#define REP_DIFF 1
#endif
#ifndef REP_HYENA
#define REP_HYENA 1
#endif
#ifndef REP_MIXA
#define REP_MIXA 1
#endif
#ifndef REP_PRO
#define REP_PRO 1
#endif
#ifndef REP_SPEC
#define REP_SPEC 1
#endif
#ifndef REP_PROJ
#define REP_PROJ 1
#endif
constexpr int NPH = 2 + 6 * DEPTH + 1;
typedef const Params __attribute__((address_space(4)))* ParamsK;
DI Params ldp(ParamsK pc) {
    asm volatile("" : "+s"(pc));
    Params q;
#pragma unroll
    for (int i = 0; i < 18; ++i) q.in[i] = pc->in[i];
    q.out = pc->out; q.ws = pc->ws; q.ph_lo = pc->ph_lo; q.ph_hi = pc->ph_hi;
    return q;
}
DI void run_phase(ParamsK pc, int ph, LAS unsigned char* lds) {
    if (ph == 0) { for (int rep = 0; rep < REP_PRO; ++rep) { const Params p = ldp(pc); phase_prologue(p, lds); __syncthreads(); } return; }
    if (ph == 1) { for (int rep = 0; rep < REP_SPEC; ++rep) { const Params p = ldp(pc); for (int it = blockIdx.x; it < DEPTH * 2 * 512; it += gridDim.x) spectra_item(p, it, lds); } return; }
    if (ph == NPH - 1) { const Params p = ldp(pc); phase_rmsnorm((const float*)(p.ws + WS_X), p.in[I_FINALG], nullptr, p.out); return; }
    const int l = (ph - 2) / 6, sp = (ph - 2) % 6;
    if (sp == 0) { const Params p = ldp(pc); phase_rmsnorm((l == 0) ? p.in[I_X] : (const float*)(p.ws + WS_X), p.in[I_NORMG] + l * D, (bf16_t*)(p.ws + WS_H), nullptr); return; }
    if (sp == 1) {
        const Params p = ldp(pc);
        pg8::Gemm g{(const bf16_t*)(p.ws + WS_H), (const bf16_t*)(p.ws + WS_WIN) + (size_t)l * NIN * D, S, NIN, D};
        pg8::StaticOrder so; so.init(S, NIN, gridDim.x, blockIdx.x);
        EpiIn e{(bf16_t*)(p.ws + WS_PROJ), (bf16_t*)(p.ws + WS_VTA), (bf16_t*)(p.ws + WS_VTC), (float*)(p.ws + WS_BINT)};
#pragma unroll 1
        for (int rep = 0; rep < REP_GEMMIN; ++rep) { pg8::gemm_phase(lds, g, so, e); __syncthreads(); }
        return;
    }
    if (sp == 2) {
#pragma unroll 1
        for (int it = blockIdx.x; it < 256 + 512 + 768; it += gridDim.x) {
            int l2 = l; asm volatile("" : "+s"(l2));
            const Params p = ldp(pc);
            if (it < 256) { for (int rep = 0; rep < REP_DIFF; ++rep) diffattn_item(p, l2, it, lds); }
            else if (it < 768) { for (int rep = 0; rep < REP_HYENA; ++rep) hyena_item(p, l2, it - 256, lds); }
            else { for (int rep = 0; rep < REP_MIXA; ++rep) mixA_wave_item(p, (it - 768) * NWAVES + (tidx() >> 6), tidx() & 63); }
        }
        return;
    }
    if (sp == 3) { const Params p = ldp(pc); phase_post(p, lds); return; }
    if (sp == 4) {
#pragma unroll 1
        for (int rep = 0; rep < REP_PROJ; ++rep) {
            const Params p = ldp(pc);
            pg8::Gemm g{(const bf16_t*)(p.ws + WS_BR), (const bf16_t*)(p.ws + WS_WPR) + (size_t)(l * 3) * D * 1024, 3 * S, 3 * D, 1024};
            ProjOrder po; po.so.init(S, D, gridDim.x, blockIdx.x);
            EpiProj e{(const bf16_t*)(p.ws + WS_PROJ), p.in[I_MERGEB] + (size_t)l * 3 * D, (float*)(p.ws + WS_YF), (bf16_t*)(p.ws + WS_YB)};
            pg8::gemm_phase(lds, g, po, e);
            __syncthreads();
        }
        return;
    }
    {
        const Params p = ldp(pc);
        pg8::Gemm g{(const bf16_t*)(p.ws + WS_YB), (const bf16_t*)(p.ws + WS_WOUT) + (size_t)l * D * D, S, D, D};
        pg8::StaticOrder so; so.init(S, D, gridDim.x, blockIdx.x);
        EpiOut e{(l == 0) ? p.in[I_X] : (const float*)(p.ws + WS_X), (float*)(p.ws + WS_X)};
        pg8::gemm_phase(lds, g, so, e);
    }
}


#define XB_TMO      128
#define XB_XCNT(j)  (256  + 64 * (j))
#define XB_XSUB(j)  (1280 + 64 * (j))
#define XB_XGEN(j)  (2304 + 64 * (j))
#define XB_TOP      3328
#define XB_TOPGEN   3392
#define XCD_BAR_WORDS 3456
#define XB_SPIN_CAP (1u << 18)
DI unsigned xb_ld(unsigned* p)              { return __hip_atomic_load(p, __ATOMIC_RELAXED, __HIP_MEMORY_SCOPE_AGENT); }
DI unsigned xb_add(unsigned* p, unsigned v) { return __hip_atomic_fetch_add(p, v, __ATOMIC_RELAXED, __HIP_MEMORY_SCOPE_AGENT); }
DI unsigned xb_xcc_id() { return (unsigned)__builtin_amdgcn_s_getreg((3 << 11) | 20) & 0xFu; }
#define XB_SPIN(cond, bar) do { unsigned _sp = 0; while (cond) { __builtin_amdgcn_s_sleep(1); \
    if ((++_sp & 255u) == 0u) { if (xb_ld(&(bar)[XB_TMO])) break; if (_sp > XB_SPIN_CAP) { atomicAdd(&(bar)[XB_TMO], 1u); break; } } } } while (0)
struct XcdBarrier { unsigned* bar; unsigned x; volatile LAS unsigned* st; };
DI XcdBarrier xcd_barrier_post(unsigned* bar, volatile LAS unsigned* st) {
    XcdBarrier b; b.bar = bar; b.x = xb_xcc_id(); b.st = st;
    if (threadIdx.x == 0) (void)xb_add(&bar[XB_XCNT(b.x)], 1u);
    return b;
}
DI void xcd_barrier_complete(unsigned* bar, unsigned x, unsigned& nloc, unsigned& nx) {
    const unsigned G = gridDim.x * gridDim.y * gridDim.z;
    unsigned sum, cnt, mine, sp = 0u;
    for (;;) {
        sum = 0u; cnt = 0u; mine = 0u;
#pragma unroll
        for (unsigned j = 0; j < 16; ++j) { const unsigned c = xb_ld(&bar[XB_XCNT(j)]); sum += c; cnt += (c > 0u) ? 1u : 0u; mine = (j == x) ? c : mine; }
        if (sum == G) break;
        __builtin_amdgcn_s_sleep(1);
        if ((++sp & 255u) == 0u) { if (xb_ld(&bar[XB_TMO])) break; if (sp > XB_SPIN_CAP) { atomicAdd(&bar[XB_TMO], 1u); break; } }
    }
    nloc = mine > 0u ? mine : 1u; nx = cnt > 0u ? cnt : 1u;
}
DI void xcd_barrier(const XcdBarrier& b) {
    asm volatile("s_waitcnt vmcnt(0)" ::: "memory");
    __syncthreads();
    if (threadIdx.x == 0) {
        unsigned* bar = b.bar;
        __builtin_amdgcn_s_waitcnt(0);
        unsigned nloc = b.st[0], nx = b.st[1];
        if (nloc == 0u) { xcd_barrier_complete(bar, b.x, nloc, nx); b.st[0] = nloc; b.st[1] = nx; }
        const unsigned old = xb_add(&bar[XB_XSUB(b.x)], 1u);
        const unsigned gen = old / nloc;
        if (old + 1u == (gen + 1u) * nloc) {
            __builtin_amdgcn_fence(__ATOMIC_RELEASE, "agent");
            asm volatile("s_waitcnt vmcnt(0)" ::: "memory");
            const unsigned og = xb_add(&bar[XB_TOP], 1u);
            const unsigned tg = og / nx;
            if (og + 1u == (tg + 1u) * nx) xb_add(&bar[XB_TOPGEN], 1u);
            else XB_SPIN(xb_ld(&bar[XB_TOPGEN]) == tg, bar);
            __builtin_amdgcn_fence(__ATOMIC_ACQUIRE, "agent");
            xb_add(&bar[XB_XGEN(b.x)], 1u);
            asm volatile("s_waitcnt vmcnt(0)" ::: "memory");
        } else {
            XB_SPIN(xb_ld(&bar[XB_XGEN(b.x)]) == gen, bar);
            __builtin_amdgcn_fence(__ATOMIC_ACQUIRE, "agent");
            asm volatile("s_waitcnt vmcnt(0)" ::: "memory");
        }
    }
    __syncthreads();
}

__global__ void __launch_bounds__(512, 2) mega_kernel(Params p) {
#if defined(__HIP_DEVICE_COMPILE__)
    extern __shared__ __attribute__((aligned(16))) unsigned char shm[];
    LAS unsigned char* lds = (LAS unsigned char*)shm;
    cg::grid_group grid = cg::this_grid();
    const int ph_lo = p.ph_lo, ph_hi = p.ph_hi;
    volatile LAS unsigned* st = (volatile LAS unsigned*)(lds + LDS_BYTES - 16);
    if (threadIdx.x == 0) { st[0] = 0u; st[1] = 0u; }
    __syncthreads();
    const XcdBarrier xb = xcd_barrier_post((unsigned*)(p.ws + WS_BAR), st);
#pragma unroll 1
    for (int ph = ph_lo; ph < ph_hi; ++ph) {
        ParamsK pc = (ParamsK)__builtin_amdgcn_kernarg_segment_ptr();
        run_phase(pc, ph, lds);
        if (ph + 1 < ph_hi) { if (ph == ph_lo) grid.sync(); else xcd_barrier(xb); }
    }
#endif
}

#ifndef N_LAUNCH_MODE
#define N_LAUNCH_MODE 1
#endif
extern "C" void kernel_launch(void* const* d_in, const int* in_sizes, int n_in, void* d_out, int out_size, void* d_ws, size_t ws_size, hipStream_t stream) {
    static int grid = 0;
    if (grid == 0) {
        int dev = 0, cus = 0;
        if (hipGetDevice(&dev) != hipSuccess || hipDeviceGetAttribute(&cus, hipDeviceAttributeMultiprocessorCount, dev) != hipSuccess) { fprintf(stderr, "kernel_launch: device query failed\n"); grid = -1; return; }
        if (hipFuncSetAttribute((const void*)mega_kernel, hipFuncAttributeMaxDynamicSharedMemorySize, LDS_BYTES) != hipSuccess) { fprintf(stderr, "kernel_launch: hipFuncSetAttribute failed\n"); grid = -1; return; }
        int per_cu = 0;
        if (hipOccupancyMaxActiveBlocksPerMultiprocessor(&per_cu, (const void*)mega_kernel, NTHR, LDS_BYTES) != hipSuccess || per_cu < 1) { fprintf(stderr, "kernel_launch: occupancy query says %d\n", per_cu); (void)hipGetLastError(); }
        if (n_in != 18 || ws_size < WS_END) { fprintf(stderr, "kernel_launch: n_in %d ws %zu (need %zu)\n", n_in, ws_size, (size_t)WS_END); grid = -1; return; }
        grid = cus;
    }
    if (grid < 0) return;
    Params p{};
    for (int i = 0; i < 18; ++i) p.in[i] = (const float*)d_in[i];
    p.out = (float*)d_out; p.ws = (unsigned char*)d_ws;
    if (hipMemsetAsync((unsigned char*)d_ws + WS_BAR, 0, 16384, stream) != hipSuccess) { fprintf(stderr, "kernel_launch: memset of barrier words failed\n"); return; }
#if N_LAUNCH_MODE == 1
    p.ph_lo = 0; p.ph_hi = NPH;
    void* args[] = {&p};
    hipError_t e = hipLaunchCooperativeKernel((const void*)mega_kernel, dim3(grid), dim3(NTHR), args, LDS_BYTES, stream);
    if (e != hipSuccess) fprintf(stderr, "cooperative launch failed: %s (grid %d)\n", hipGetErrorString(e), grid);
#else
    for (int ph = 0; ph < NPH; ++ph) {
        p.ph_lo = ph; p.ph_hi = ph + 1;
        hipLaunchKernelGGL(mega_kernel, dim3(grid), dim3(NTHR), LDS_BYTES, stream, p);
    }
#endif
}
```

```cpp
#include <hip/hip_runtime.h>
#include <hip/hip_cooperative_groups.h>
#include <cstdio>
namespace cg = cooperative_groups;
#define DI __device__ __forceinline__
#define LAS __attribute__((address_space(3)))
typedef unsigned short bf16_t;
typedef short bf16x8 __attribute__((ext_vector_type(8)));
typedef short s16x4 __attribute__((ext_vector_type(4)));
typedef float f32x4 __attribute__((ext_vector_type(4)));
typedef float f32x16 __attribute__((ext_vector_type(16)));
typedef float f32x2 __attribute__((ext_vector_type(2)));
typedef float cf __attribute__((ext_vector_type(2)));
typedef __bf16 bf16x2n __attribute__((ext_vector_type(2)));
typedef unsigned u32x2 __attribute__((ext_vector_type(2)));
typedef unsigned u32x4 __attribute__((ext_vector_type(4)));

DI unsigned pk2(float lo, float hi) { f32x2 v = {lo, hi}; return __builtin_bit_cast(unsigned, __builtin_convertvector(v, bf16x2n)); }
DI float bflo(unsigned u) { return __uint_as_float(u << 16); }
DI float bfhi(unsigned u) { return __uint_as_float(u & 0xffff0000u); }
DI float silu_f(float x) { return x / (1.0f + __expf(-x)); }
DI float sigm_f(float x) { return 1.0f / (1.0f + __expf(-x)); }

DI int tidx() { int t = threadIdx.x; asm volatile("" : "+v"(t)); return t; }

constexpr int S = 8192, D = 2048, NIN = 24576, DEPTH = 4;
constexpr int C_AGATE = 9216, C_BIN = 10240, C_BGATE = 13312, C_CQKV = 14336, C_CGATE = 17408, C_MERGE = 18432;
constexpr float LOG2E = 1.4426950408889634f;
constexpr int NTHR = 512, NWAVES = 8;
constexpr int LDS_MAIN = 143360, LDS_AUX = 16384, LDS_BYTES = LDS_MAIN + LDS_AUX;

constexpr size_t WS_WIN  = 0;
constexpr size_t WS_WPR  = WS_WIN  + (size_t)DEPTH * NIN * D * 2;
constexpr size_t WS_WOUT = WS_WPR  + (size_t)DEPTH * 3 * D * 1024 * 2;
constexpr size_t WS_SPEC = WS_WOUT + (size_t)DEPTH * D * D * 2;
constexpr size_t WS_HID2 = WS_SPEC + (size_t)DEPTH * 2 * 512 * 8208 * 16;
constexpr size_t WS_BIAS = WS_HID2 + (size_t)DEPTH * S * 64 * 4;
constexpr size_t WS_X    = WS_BIAS + 524288;
constexpr size_t WS_H    = WS_X    + (size_t)S * D * 4;
constexpr size_t WS_PROJ = WS_H    + (size_t)S * D * 2;
constexpr size_t WS_BINT = WS_PROJ + (size_t)S * NIN * 2;
constexpr size_t WS_VTA  = WS_BINT + (size_t)3072 * S * 4;
constexpr size_t WS_VTC  = WS_VTA  + (size_t)3 * 1024 * S * 2;
constexpr size_t WS_OA   = WS_VTC  + (size_t)1024 * S * 2;
constexpr size_t WS_LSEA = WS_OA   + (size_t)3 * S * 1024 * 4;
constexpr size_t WS_Z2T  = WS_LSEA + (size_t)3 * S * 8 * 4;
constexpr size_t WS_BR   = WS_Z2T  + (size_t)1024 * S * 4;
constexpr size_t WS_YF   = WS_BR   + (size_t)3 * S * 1024 * 2;
constexpr size_t WS_YB   = WS_YF   + (size_t)S * D * 4;
constexpr size_t WS_CTMP = WS_YB   + (size_t)S * D * 2;
constexpr size_t WS_BAR  = WS_CTMP + (size_t)S * 1024 * 4;
constexpr size_t WS_TT   = WS_BAR + 16384;
constexpr size_t WS_END  = WS_TT + (size_t)DEPTH * 4096 * S * 4;

struct Params {
    const float* in[18];
    float* out;
    unsigned char* ws;
    int ph_lo, ph_hi;
};
enum { I_X = 0, I_NORMG, I_FINALG, I_WIN, I_MERGEB, I_RELB, I_HYCONV, I_HYW1, I_HYB1, I_HYFREQ, I_HYW2, I_HYB2, I_HYW3, I_HYSKIP, I_DLAM, I_DG, I_WPROJ, I_WOUT };

namespace pg8 {
constexpr int BM = 256, BK = 64, HALF = 128, HTB = HALF * BK * 2, NXCD = 8, WGM = 8;
DI int lds_byte(int r, int c) { const int st = (r >> 4) * 2 + (c >> 5), rr = r & 15, cc = c & 31, ob = rr * 64 + cc * 2; return st * 1024 + (ob ^ (((ob >> 9) & 1) << 5)); }
DI void stage_rc(int b, int& R, int& C) { const int st = b / 1024, sb = b % 1024, swz = sb ^ (((sb >> 9) & 1) << 5); R = (st >> 1) * 16 + swz / 64; C = (st & 1) * 32 + (swz % 64) / 2; }
DI int perm32(int rho) { const int n = rho >> 4, i = rho & 15; return 8 * (i >> 2) + 4 * n + (i & 3); }
struct Unit { int pm, pn; };
struct Gemm { const bf16_t* A; const bf16_t* Bt; int M, N, K; };
struct StaticOrder {
    int nM, nN, nwg, G, c;
    DI void init(int M, int N, int G_, int c_) { nM = M / BM; nN = N / BM; nwg = nM * nN; G = G_; c = c_; }
    DI bool next(int i, Unit& u) const {
        const long L = (long)i * G + c; if (L >= nwg) return false;
        int wgid = (int)L; { const int q = nwg / NXCD, r = nwg % NXCD, xcd = wgid % NXCD, off = wgid / NXCD; wgid = (xcd < r ? xcd * (q + 1) : r * (q + 1) + (xcd - r) * q) + off; }
        const int nig = WGM * nN, gid = wgid / nig, fm = gid * WGM, gsz = (nM - fm) < WGM ? (nM - fm) : WGM;
        u.pm = fm + ((wgid % nig) % gsz); u.pn = (wgid % nig) / gsz; return true;
    }
};
template <class Epi, class Sched>
DI void gemm_phase(LAS unsigned char* lds, const Gemm g, const Sched& S, const Epi& E) {
    const int tid = tidx(), wid = __builtin_amdgcn_readfirstlane(tid >> 6), lane = tid & 63, wr = wid >> 2, wc = wid & 3, fr = lane & 15, fq = lane >> 4;
    const int K = g.K, nt = K / BK;
    unsigned voffA[2], voffB[2];
#pragma unroll
    for (int i = 0; i < 2; ++i) { int R, C; stage_rc(tid * 16 + i * 8192, R, C); const int Rb = Epi::PERM ? ((R & ~31) + perm32(R & 31)) : R; voffA[i] = (unsigned)(R * K + C) * 2u; voffB[i] = (unsigned)(Rb * K + C) * 2u; }
    const size_t kstep = (size_t)(BK * 2);
    const size_t hstep = (size_t)HALF * K * 2;
    const size_t tstep = 2 * hstep;
    const unsigned ldsw = (unsigned)wid * 1024u;
    const int aoff = lds_byte(wr * 64 + fr, fq * 8), boff = lds_byte(wc * 32 + fr, fq * 8);
#define PG8_SA(b, h) (((b) * 2 + (h)) * HTB)
#define PG8_SB(b, h) ((4 + (b) * 2 + (h)) * HTB)
#define PG8_STAGE(bufoff, gbase, voff) do { _Pragma("unroll") for (int _i = 0; _i < 2; ++_i) \
        __builtin_amdgcn_global_load_lds((const unsigned*)((const char*)(gbase) + (voff)[_i]), (LAS unsigned*)(lds + (bufoff) + ldsw + _i * 8192), 16, 0, 0); } while (0)
#define PG8_LDA(dst, b, h) do { _Pragma("unroll") for (int m = 0; m < 4; ++m) _Pragma("unroll") for (int k = 0; k < 2; ++k) dst[m][k] = *(const LAS bf16x8*)(lds + PG8_SA(b, h) + aoff + m * 2048 + k * 1024); } while (0)
#define PG8_LDB(dst, b, h) do { _Pragma("unroll") for (int n = 0; n < 2; ++n) _Pragma("unroll") for (int k = 0; k < 2; ++k) dst[n][k] = *(const LAS bf16x8*)(lds + PG8_SB(b, h) + boff + n * 2048 + k * 1024); } while (0)
#define PG8_MMA(ai, bj, At, Bt) do { __builtin_amdgcn_s_setprio(1); _Pragma("unroll") for (int m = 0; m < 4; ++m) _Pragma("unroll") for (int n = 0; n < 2; ++n) _Pragma("unroll") for (int k = 0; k < 2; ++k) \
        acc[ai][bj][m][n] = __builtin_amdgcn_mfma_f32_16x16x32_bf16(Bt[n][k], At[m][k], acc[ai][bj][m][n], 0, 0, 0); __builtin_amdgcn_s_setprio(0); } while (0)
#define PG8_WAIT_V(n) asm volatile("s_waitcnt vmcnt(" #n ")" ::: "memory")
#define PG8_WAIT_L(n) asm volatile("s_waitcnt lgkmcnt(" #n ")" ::: "memory")
#define PG8_BAR __builtin_amdgcn_s_barrier()
#define PG8_SCHED __builtin_amdgcn_sched_barrier(0)
    Unit cur, nxt; int ui = 0;
    if (!S.next(0, cur)) return;
    f32x4 acc[2][2][4][2];
#pragma unroll
    for (int a = 0; a < 2; ++a)
#pragma unroll
        for (int b = 0; b < 2; ++b)
#pragma unroll
            for (int m = 0; m < 4; ++m)
#pragma unroll
                for (int n = 0; n < 2; ++n) acc[a][b][m][n] = (f32x4){0.f, 0.f, 0.f, 0.f};
    bf16x8 At[4][2], B0[2][2], B1[2][2];
    const char* cA = (const char*)g.A + (size_t)cur.pm * tstep; const char* cB = (const char*)g.Bt + (size_t)cur.pn * tstep;
    PG8_STAGE(PG8_SB(0, 0), cB, voffB); PG8_STAGE(PG8_SA(0, 0), cA, voffA); PG8_STAGE(PG8_SB(0, 1), cB + hstep, voffB); PG8_STAGE(PG8_SA(0, 1), cA + hstep, voffA);
    if (wr == 1) PG8_BAR;
    PG8_WAIT_V(4); PG8_BAR;
    PG8_STAGE(PG8_SB(1, 0), cB + kstep, voffB); PG8_STAGE(PG8_SA(1, 0), cA + kstep, voffA); PG8_STAGE(PG8_SB(1, 1), cB + hstep + kstep, voffB);
    PG8_WAIT_V(6); PG8_BAR;
    for (;;) {
        const bool has_next = S.next(ui + 1, nxt);
        const char* nA = has_next ? (const char*)g.A + (size_t)nxt.pm * tstep : cA; const char* nB = has_next ? (const char*)g.Bt + (size_t)nxt.pn * tstep : cB;
        for (int t = 0; t < nt; t += 2) {
            const bool last = (t == nt - 2);
            const char* a1 = cA + (size_t)(t + 1) * kstep;
            const char* a2 = last ? nA : cA + (size_t)(t + 2) * kstep; const char* b2 = last ? nB : cB + (size_t)(t + 2) * kstep;
            const char* a3 = a2 + kstep; const char* b3 = b2 + kstep;
            PG8_LDB(B0, 0, 0); PG8_SCHED; PG8_LDA(At, 0, 0); PG8_STAGE(PG8_SA(1, 1), a1 + hstep, voffA);
            PG8_WAIT_L(8); PG8_BAR; PG8_WAIT_L(0); PG8_MMA(0, 0, At, B0); PG8_BAR; PG8_SCHED;
            PG8_LDB(B1, 0, 1); PG8_STAGE(PG8_SB(0, 0), b2, voffB);
            PG8_BAR; PG8_WAIT_L(0); PG8_MMA(0, 1, At, B1); PG8_BAR;
            PG8_LDA(At, 0, 1); PG8_STAGE(PG8_SA(0, 0), a2, voffA);
            PG8_BAR; PG8_WAIT_L(0); PG8_MMA(1, 0, At, B0); PG8_BAR; PG8_SCHED;
            PG8_STAGE(PG8_SB(0, 1), b2 + hstep, voffB);
            PG8_WAIT_V(6); PG8_BAR; PG8_MMA(1, 1, At, B1); PG8_BAR;
            PG8_LDB(B0, 1, 0); PG8_SCHED; PG8_LDA(At, 1, 0); PG8_STAGE(PG8_SA(0, 1), a2 + hstep, voffA);
            PG8_WAIT_L(8); PG8_BAR; PG8_WAIT_L(0); PG8_MMA(0, 0, At, B0); PG8_BAR; PG8_SCHED;
            PG8_LDB(B1, 1, 1); PG8_STAGE(PG8_SB(1, 0), b3, voffB);
            PG8_BAR; PG8_WAIT_L(0); PG8_MMA(0, 1, At, B1); PG8_BAR;
            PG8_LDA(At, 1, 1); PG8_STAGE(PG8_SA(1, 0), a3, voffA);
            PG8_BAR; PG8_WAIT_L(0); PG8_MMA(1, 0, At, B0); PG8_BAR; PG8_SCHED;
            PG8_STAGE(PG8_SB(1, 1), b3 + hstep, voffB);
            PG8_WAIT_V(6); PG8_BAR; PG8_MMA(1, 1, At, B1); PG8_BAR;
        }
        E(acc, cur, wr, wc, fr, fq);
        if (!has_next) break;
#pragma unroll
        for (int a = 0; a < 2; ++a)
#pragma unroll
            for (int b = 0; b < 2; ++b)
#pragma unroll
                for (int m = 0; m < 4; ++m)
#pragma unroll
                    for (int n = 0; n < 2; ++n) acc[a][b][m][n] = (f32x4){0.f, 0.f, 0.f, 0.f};
        cur = nxt; cA = nA; cB = nB; ++ui;
    }
    PG8_WAIT_V(0);
    if (wr == 0) PG8_BAR;
    PG8_BAR;
#undef PG8_SA
#undef PG8_SB
#undef PG8_STAGE
#undef PG8_LDA
#undef PG8_LDB
#undef PG8_MMA
#undef PG8_WAIT_V
#undef PG8_WAIT_L
#undef PG8_BAR
#undef PG8_SCHED
}
}

struct EpiIn {
    static constexpr bool PERM = true;
    bf16_t* proj; bf16_t* vta; bf16_t* vtc; float* bint; LAS unsigned char* tlds;
    DI void operator()(const f32x4 (&acc)[2][2][4][2], const pg8::Unit& u, int wr, int wc, int fr, int fq) const {
        const int colt = u.pn * 256;
        int kind = 0;
        if (colt < C_AGATE) { if ((colt % 3072) >= 2048) kind = 1; }
        else if (colt >= C_BIN && colt < C_BGATE) kind = 2;
        else if (colt >= C_CQKV + 2048 && colt < C_CGATE) kind = 3;
        const int row0 = u.pm * 256 + wr * 64 + fr, col0 = colt + wc * 32 + 8 * fq;
        if (kind == 0) {
#pragma unroll
            for (int ai = 0; ai < 2; ++ai)
#pragma unroll
                for (int m = 0; m < 4; ++m) { bf16_t* rp = proj + (size_t)(row0 + ai * 128 + m * 16) * NIN + col0;
#pragma unroll
                    for (int bj = 0; bj < 2; ++bj) { const f32x4 a = acc[ai][bj][m][0], b = acc[ai][bj][m][1];
                        u32x4 o = {pk2(a[0], a[1]), pk2(a[2], a[3]), pk2(b[0], b[1]), pk2(b[2], b[3])}; *(u32x4*)(rp + bj * 128) = o; } }
        } else if (kind == 1 && colt >= 2 * 3072) {
            bf16_t* base = vta + (ptrdiff_t)(2 * 1024 - 2 * 3072 - 2048) * (ptrdiff_t)S;
#pragma unroll
            for (int ai = 0; ai < 2; ++ai) { const int prow = fr * (S >> 4) + ((u.pm * 256 + ai * 128 + wr * 64) >> 4);
#pragma unroll
                for (int bj = 0; bj < 2; ++bj)
#pragma unroll
                    for (int n = 0; n < 2; ++n)
#pragma unroll
                        for (int e = 0; e < 4; ++e) { u32x2 o = {pk2(acc[ai][bj][0][n][e], acc[ai][bj][1][n][e]), pk2(acc[ai][bj][2][n][e], acc[ai][bj][3][n][e])};
                            *(u32x2*)(base + (ptrdiff_t)(col0 + bj * 128 + n * 4 + e) * (ptrdiff_t)S + prow) = o; } }
        } else {
            const int lane = fr + 16 * fq, wave = wr * 4 + wc;
            LAS float* tl = (LAS float*)(tlds + wave * 2304);
            const int cl = lane >> 1, hs = lane & 1;
            const int colg = colt + wc * 32 + cl;
#pragma unroll
            for (int ai = 0; ai < 2; ++ai)
#pragma unroll
                for (int bj = 0; bj < 2; ++bj)
#pragma unroll
                    for (int m = 0; m < 4; ++m) {
                        const int rowb = u.pm * 256 + ai * 128 + wr * 64 + m * 16;
#pragma unroll
                        for (int n = 0; n < 2; ++n)
#pragma unroll
                            for (int e = 0; e < 4; ++e) tl[(8 * fq + 4 * n + e) * 17 + fr] = acc[ai][bj][m][n][e];
                        __builtin_amdgcn_wave_barrier();
                        const LAS float* tc = tl + cl * 17;
                        const int col = colg + bj * 128;
                        if (kind == 2) {
                            f32x4 o0 = {tc[8 * hs], tc[8 * hs + 1], tc[8 * hs + 2], tc[8 * hs + 3]}, o1 = {tc[8 * hs + 4], tc[8 * hs + 5], tc[8 * hs + 6], tc[8 * hs + 7]};
                            float* bp = bint + (size_t)(col - C_BIN) * S + rowb + 8 * hs;
                            *(f32x4*)bp = o0; *(f32x4*)(bp + 4) = o1;
                        } else if (kind == 3) {
                            u32x4 o = {pk2(tc[4 * hs], tc[4 * hs + 1]), pk2(tc[4 * hs + 2], tc[4 * hs + 3]), pk2(tc[8 + 4 * hs], tc[9 + 4 * hs]), pk2(tc[10 + 4 * hs], tc[11 + 4 * hs])};
                            *(u32x4*)(vtc + (size_t)(col - (C_CQKV + 2048)) * S + rowb + 8 * hs) = o;
                        } else if (colt < 3072) {
                            u32x4 o = {pk2(tc[8 * hs], tc[8 * hs + 1]), pk2(tc[8 * hs + 2], tc[8 * hs + 3]), pk2(tc[8 * hs + 4], tc[8 * hs + 5]), pk2(tc[8 * hs + 6], tc[8 * hs + 7])};
                            *(u32x4*)(vta + (size_t)(col - 2048) * S + rowb + 8 * hs) = o;
                        } else {
#pragma unroll
                            for (int k = 0; k < 2; ++k) { const int res = 2 * hs + k;
                                u32x2 o = {pk2(tc[res], tc[res + 4]), pk2(tc[res + 8], tc[res + 12])};
                                *(u32x2*)(vta + (size_t)(1024 + col - 3072 - 2048) * S + res * (S >> 2) + (rowb >> 2)) = o; }
                        }
                        __builtin_amdgcn_wave_barrier();
                    }
        }
    }
};
struct ProjOrder {
    pg8::StaticOrder so;
    DI bool next(int i, pg8::Unit& u) const { pg8::Unit b; if (!so.next(i / 3, b)) return false; const int nb = i % 3; u.pm = b.pm + 32 * nb; u.pn = b.pn + 8 * nb; return true; }
};
struct EpiProj {   static constexpr bool PERM = false;
    const bf16_t* proj; const float* mb; float* yf; bf16_t* yb;
    DI void operator()(const f32x4 (&acc)[2][2][4][2], const pg8::Unit& u, int wr, int wc, int fr, int fq) const {
        const int nb = u.pm >> 5;
        const int row0 = (u.pm & 31) * 256 + wr * 64 + fr, col0 = (u.pn & 7) * 256 + wc * 32 + 4 * fq;
        f32x4 b4[2][2];
#pragma unroll
        for (int bj = 0; bj < 2; ++bj)
#pragma unroll
            for (int n = 0; n < 2; ++n) b4[bj][n] = *(const f32x4*)(mb + nb * D + col0 + bj * 128 + n * 16);
#pragma unroll
        for (int ai = 0; ai < 2; ++ai)
#pragma unroll
            for (int mp = 0; mp < 2; ++mp) {
                u32x2 mg[2][2][2]; f32x4 yv[2][2][2];
#pragma unroll
                for (int mi = 0; mi < 2; ++mi) { const int row = row0 + ai * 128 + (2 * mp + mi) * 16;
#pragma unroll
                    for (int bj = 0; bj < 2; ++bj)
#pragma unroll
                        for (int n = 0; n < 2; ++n) { const int col = col0 + bj * 128 + n * 16;
                            mg[mi][bj][n] = *(const u32x2*)(proj + (size_t)row * NIN + C_MERGE + nb * D + col);
                            if (nb > 0) yv[mi][bj][n] = *(const f32x4*)(yf + (size_t)row * D + col); else yv[mi][bj][n] = (f32x4){0.f, 0.f, 0.f, 0.f}; } }
#pragma unroll
                for (int mi = 0; mi < 2; ++mi) { const int m = 2 * mp + mi; const int row = row0 + ai * 128 + m * 16;
#pragma unroll
                    for (int bj = 0; bj < 2; ++bj)
#pragma unroll
                        for (int n = 0; n < 2; ++n) { const int col = col0 + bj * 128 + n * 16; const f32x4 a = acc[ai][bj][m][n]; const u32x2 g2 = mg[mi][bj][n]; const f32x4 bb = b4[bj][n];
                            f32x4 v = yv[mi][bj][n];
                            v[0] += a[0] * sigm_f(bflo(g2[0]) + bb[0]); v[1] += a[1] * sigm_f(bfhi(g2[0]) + bb[1]);
                            v[2] += a[2] * sigm_f(bflo(g2[1]) + bb[2]); v[3] += a[3] * sigm_f(bfhi(g2[1]) + bb[3]);
                            if (nb < 2) *(f32x4*)(yf + (size_t)row * D + col) = v;
                            else { u32x2 o = {pk2(v[0], v[1]), pk2(v[2], v[3])}; *(u32x2*)(yb + (size_t)row * D + col) = o; } } }
            }
    }
};
struct EpiOut {   static constexpr bool PERM = false;
    const float* xold; float* xnew;
    DI void operator()(const f32x4 (&acc)[2][2][4][2], const pg8::Unit& u, int wr, int wc, int fr, int fq) const {
        const int row0 = u.pm * 256 + wr * 64 + fr, col0 = u.pn * 256 + wc * 32 + 4 * fq;
#pragma unroll
        for (int ai = 0; ai < 2; ++ai)
#pragma unroll
            for (int mp = 0; mp < 2; ++mp) {
                f32x4 xv[2][2][2];
#pragma unroll
                for (int mi = 0; mi < 2; ++mi)
#pragma unroll
                    for (int bj = 0; bj < 2; ++bj)
#pragma unroll
                        for (int n = 0; n < 2; ++n) xv[mi][bj][n] = *(const f32x4*)(xold + (size_t)(row0 + ai * 128 + (2 * mp + mi) * 16) * D + col0 + bj * 128 + n * 16);
#pragma unroll
                for (int mi = 0; mi < 2; ++mi)
#pragma unroll
                    for (int bj = 0; bj < 2; ++bj)
#pragma unroll
                        for (int n = 0; n < 2; ++n) *(f32x4*)(xnew + (size_t)(row0 + ai * 128 + (2 * mp + mi) * 16) * D + col0 + bj * 128 + n * 16) = xv[mi][bj][n] + acc[ai][bj][2 * mp + mi][n];
            }
    }
};
DI float wave_sum(float v) {
#pragma unroll
    for (int o = 1; o < 64; o <<= 1) v += __shfl_xor(v, o);
    return v;
}
DI int crow(int reg, int h) { return (reg & 3) + 8 * (reg >> 2) + 4 * h; }
DI bf16x8 pack8(const f32x16& x, const int s) {
    u32x4 p;
    p[0] = pk2(x[8 * s + 0], x[8 * s + 1]); p[1] = pk2(x[8 * s + 2], x[8 * s + 3]);
    p[2] = pk2(x[8 * s + 4], x[8 * s + 5]); p[3] = pk2(x[8 * s + 6], x[8 * s + 7]);
    return __builtin_bit_cast(bf16x8, p);
}
#define MFMA32(a, b, c) __builtin_amdgcn_mfma_f32_32x32x16_bf16((a), (b), (c), 0, 0, 0)

DI void transpose_item(const float* Wsrc, int K, int N, bf16_t* WT, LAS float* scr, int item, int lane) {
    const int nblk = N / 64, kb = item / nblk, nb = item % nblk, k0 = 64 * kb, n0 = 64 * nb;
    const int lr = lane >> 4, lc = (lane & 15) * 4;
    f32x4 v[16];
#pragma unroll
    for (int i = 0; i < 16; ++i) v[i] = *(const f32x4*)(Wsrc + (size_t)(k0 + 4 * i + lr) * N + n0 + lc);
#pragma unroll
    for (int i = 0; i < 16; ++i) { LAS float* d = scr + (4 * i + lr) * 65 + lc; d[0] = v[i][0]; d[1] = v[i][1]; d[2] = v[i][2]; d[3] = v[i][3]; }
    __builtin_amdgcn_wave_barrier();
    const int c = lane & 7;
#pragma unroll
    for (int j = 0; j < 8; ++j) { const int n = (lane >> 3) + 8 * j; const LAS float* s = scr + (8 * c) * 65 + n;
        u32x4 o; o[0] = pk2(s[0 * 65], s[1 * 65]); o[1] = pk2(s[2 * 65], s[3 * 65]); o[2] = pk2(s[4 * 65], s[5 * 65]); o[3] = pk2(s[6 * 65], s[7 * 65]);
        *(u32x4*)(WT + (size_t)(n0 + n) * K + k0 + 8 * c) = o; }
    __builtin_amdgcn_wave_barrier();
}
DI int t5_bucket(int rel) {
    const int ret = rel > 0 ? 16 : 0; const int n = rel < 0 ? -rel : rel;
    const float nf = (float)(n > 1 ? n : 1);
    int large = 8 + (int)(logf(nf / 8.0f) / 4.852030263919617f * 8.0f);
    large = large < 15 ? large : 15;
    return ret + (n < 8 ? n : large);
}
DI void phase_prologue(const Params& p, LAS unsigned char* lds) {
    const int tid = tidx(), wave = tid >> 6, lane = tid & 63;
    const int gw = blockIdx.x * NWAVES + wave, NGW = gridDim.x * NWAVES;
    LAS float* scr = (LAS float*)(lds + wave * 16640);
    bf16_t* win_t = (bf16_t*)(p.ws + WS_WIN); bf16_t* wpr_t = (bf16_t*)(p.ws + WS_WPR); bf16_t* wout_t = (bf16_t*)(p.ws + WS_WOUT);
    constexpr int IT_IN = (D / 64) * (NIN / 64), IT_PR = (1024 / 64) * (D / 64), IT_OUT = (D / 64) * (D / 64);
    constexpr int TOT = DEPTH * IT_IN + DEPTH * 3 * IT_PR + DEPTH * IT_OUT;
    for (int it = gw; it < TOT; it += NGW) {
        int r = it;
        if (r < DEPTH * IT_IN) { const int l = r / IT_IN; transpose_item(p.in[I_WIN] + (size_t)l * D * NIN, D, NIN, win_t + (size_t)l * NIN * D, scr, r % IT_IN, lane); continue; }
        r -= DEPTH * IT_IN;
        if (r < DEPTH * 3 * IT_PR) { const int l = r / IT_PR; transpose_item(p.in[I_WPROJ] + (size_t)l * 1024 * D, 1024, D, wpr_t + (size_t)l * D * 1024, scr, r % IT_PR, lane); continue; }
        r -= DEPTH * 3 * IT_PR;
        { const int l = r / IT_OUT; transpose_item(p.in[I_WOUT] + (size_t)l * D * D, D, D, wout_t + (size_t)l * D * D, scr, r % IT_OUT, lane); }
    }
    float* bias = (float*)(p.ws + WS_BIAS);
    for (int i = blockIdx.x * NTHR + tid; i < 32 * 2049; i += gridDim.x * NTHR) {
        const int hd = i / 2049, rel = (i % 2049) - 1024;
        bias[i] = p.in[I_RELB][t5_bucket(rel) * 32 + hd] * LOG2E;
    }
    __syncthreads();
    LAS float* zemb = (LAS float*)lds;
    LAS float* h1 = (LAS float*)(lds + 2048);
    float* hid2 = (float*)(p.ws + WS_HID2);
    for (int rb = blockIdx.x; rb < S / 8; rb += gridDim.x) {
        const int rl = tid >> 6, j = tid & 63, i = rb * 8 + rl;
        if (j < 33) {
            float z;
            if (j == 0) z = (float)i / 8191.0f;
            else { const int k = (j - 1) & 15; const float fb = 1e-4f + (float)k * ((15.0f - 1e-4f) / 15.0f); const float w = 6.283185307179586f * (float)i / 8192.0f; const float a = fb * w; z = (j <= 16) ? cosf(a) : -sinf(a); }
            zemb[rl * 36 + j] = z;
        }
        __syncthreads();
        for (int l = 0; l < DEPTH; ++l) {
            float a1 = p.in[I_HYB1][l * 64 + j];
            for (int e = 0; e < 33; ++e) a1 += zemb[rl * 36 + e] * p.in[I_HYW1][(l * 33 + e) * 64 + j];
            h1[rl * 64 + j] = sinf(p.in[I_HYFREQ][(l * 2 + 0) * 64 + j] * a1);
            __syncthreads();
            float a2 = p.in[I_HYB2][l * 64 + j];
            for (int e = 0; e < 64; ++e) a2 += h1[rl * 64 + e] * p.in[I_HYW2][(l * 64 + e) * 64 + j];
            hid2[((size_t)l * S + i) * 64 + j] = sinf(p.in[I_HYFREQ][(l * 2 + 1) * 64 + j] * a2);
            __syncthreads();
        }
    }
}


DI void split8(const f32x4 a, const f32x4 b, bf16x8& hi, bf16x8& lo) {
    u32x4 h, l2;
    h[0] = pk2(a[0], a[1]); h[1] = pk2(a[2], a[3]); h[2] = pk2(b[0], b[1]); h[3] = pk2(b[2], b[3]);
    l2[0] = pk2(a[0] - bflo(h[0]), a[1] - bfhi(h[0])); l2[1] = pk2(a[2] - bflo(h[1]), a[3] - bfhi(h[1]));
    l2[2] = pk2(b[0] - bflo(h[2]), b[1] - bfhi(h[2])); l2[3] = pk2(b[2] - bflo(h[3]), b[3] - bfhi(h[3]));
    hi = __builtin_bit_cast(bf16x8, h); lo = __builtin_bit_cast(bf16x8, l2);
}
DI void phase_tgen(const Params& p) {
    const int tid = tidx(), wave = tid >> 6, lane = tid & 63, r = lane & 31, hh = lane >> 5;
    float* tt = (float*)(p.ws + WS_TT);
    for (int it = blockIdx.x * NWAVES + wave; it < DEPTH * 128 * 4; it += gridDim.x * NWAVES) {
        const int l = it >> 9, cb = (it >> 2) & 127, rc = it & 3;
        const float* w3 = p.in[I_HYW3] + (size_t)l * 64 * 4096 + cb * 32 + r;
        bf16x8 ahi[4], alo[4];
#pragma unroll
        for (int ks = 0; ks < 4; ++ks) {
            f32x4 a, b;
#pragma unroll
            for (int j = 0; j < 4; ++j) { a[j] = w3[(size_t)(16 * ks + 8 * hh + j) * 4096]; b[j] = w3[(size_t)(16 * ks + 8 * hh + 4 + j) * 4096]; }
            split8(a, b, ahi[ks], alo[ks]);
        }
        const float* hid2 = (const float*)(p.ws + WS_HID2) + (size_t)l * S * 64;
#pragma unroll 1
        for (int rb = 0; rb < 64; ++rb) {
            const int i0 = rc * 2048 + rb * 32;
            const float* hr = hid2 + (size_t)(i0 + r) * 64 + 8 * hh;
            f32x16 acc;
#pragma unroll
            for (int i = 0; i < 16; ++i) acc[i] = 0.f;
#pragma unroll
            for (int ks = 0; ks < 4; ++ks) {
                const f32x4 a = *(const f32x4*)(hr + 16 * ks), b = *(const f32x4*)(hr + 16 * ks + 4);
                bf16x8 bhi, blo; split8(a, b, bhi, blo);
                acc = MFMA32(ahi[ks], bhi, acc); acc = MFMA32(ahi[ks], blo, acc); acc = MFMA32(alo[ks], bhi, acc);
            }
            float* tp = tt + ((size_t)l * 4096 + cb * 32) * S + i0 + r;
#pragma unroll
            for (int reg = 0; reg < 16; ++reg) tp[(size_t)crow(reg, hh) * S] = acc[reg];
        }
    }
}

#define XI(i) ((i) + ((i) >> 4) + ((i) >> 8))
DI cf cmul(cf a, cf b) { return (cf){a.x * b.x - a.y * b.y, a.x * b.y + a.y * b.x}; }
DI cf twid(float frac) { return (cf){__builtin_amdgcn_cosf(frac), -__builtin_amdgcn_sinf(frac)}; }
DI cf twidc(float frac) { return (cf){__builtin_amdgcn_cosf(frac), __builtin_amdgcn_sinf(frac)}; }
DI void fwd4(cf& a0, cf& a1, cf& a2, cf& a3) {
    const cf s02 = a0 + a2, d02 = a0 - a2, s13 = a1 + a3, d13 = a1 - a3;
    a0 = s02 + s13; a2 = s02 - s13;
    a1 = (cf){d02.x + d13.y, d02.y - d13.x};
    a3 = (cf){d02.x - d13.y, d02.y + d13.x};
}
DI void inv4(cf& b0, cf& b1, cf& b2, cf& b3) {
    const cf s02 = b0 + b2, d02 = b0 - b2, s13 = b1 + b3, d13 = b1 - b3;
    b0 = s02 + s13; b2 = s02 - s13;
    b1 = (cf){d02.x - d13.y, d02.y + d13.x};
    b3 = (cf){d02.x + d13.y, d02.y - d13.x};
}
template <int LOGM> DI void fwd_r4_pass(LAS cf* X, int tid) {
    asm volatile("" : "+v"(tid));
    constexpr int M = 1 << LOGM, q = M >> 2;
#pragma unroll 2
    for (int t = tid; t < 4096; t += NTHR) {
        const int j = t & (q - 1), base = (t >> (LOGM - 2)) * M + j;
        constexpr int QP = (q >= 256) ? (q + (q >> 4) + (q >> 8)) : ((q == 16) ? 17 : 1);
        LAS cf* xp = X + XI(base);
        cf a0 = xp[0], a1 = xp[QP], a2 = xp[2 * QP], a3 = xp[3 * QP];
        fwd4(a0, a1, a2, a3);
        const cf w1 = twid((float)j * (1.0f / M)), w2 = cmul(w1, w1), w3 = cmul(w2, w1);
        xp[0] = a0; xp[QP] = cmul(a1, w1); xp[2 * QP] = cmul(a2, w2); xp[3 * QP] = cmul(a3, w3);
    }
}
template <int LOGM> DI void inv_r4_pass(LAS cf* X, int tid) {
    asm volatile("" : "+v"(tid));
    constexpr int M = 1 << LOGM, q = M >> 2;
#pragma unroll 2
    for (int t = tid; t < 4096; t += NTHR) {
        const int j = t & (q - 1), base = (t >> (LOGM - 2)) * M + j;
        const cf w1 = twidc((float)j * (1.0f / M)), w2 = cmul(w1, w1), w3 = cmul(w2, w1);
        constexpr int QP = (q >= 256) ? (q + (q >> 4) + (q >> 8)) : ((q == 16) ? 17 : 1);
        LAS cf* xp = X + XI(base);
        cf b0 = xp[0], b1 = cmul(xp[QP], w1), b2 = cmul(xp[2 * QP], w2), b3 = cmul(xp[3 * QP], w3);
        inv4(b0, b1, b2, b3);
        xp[0] = b0; xp[QP] = b1; xp[2 * QP] = b2; xp[3 * QP] = b3;
    }
}
template <int LOGM> DI void fwd16(cf (&v)[16], int j) {
    constexpr int M = 1 << LOGM, q = M >> 4;
#pragma unroll
    for (int n = 0; n < 4; ++n) {
        fwd4(v[n], v[n + 4], v[n + 8], v[n + 12]);
        const cf w1 = twid((float)(j + n * q) * (1.0f / M)), w2 = cmul(w1, w1), w3 = cmul(w2, w1);
        v[n + 4] = cmul(v[n + 4], w1); v[n + 8] = cmul(v[n + 8], w2); v[n + 12] = cmul(v[n + 12], w3);
    }
    const cf u1 = twid((float)j * (4.0f / M)), u2 = cmul(u1, u1), u3 = cmul(u2, u1);
#pragma unroll
    for (int m = 0; m < 4; ++m) {
        fwd4(v[4 * m], v[4 * m + 1], v[4 * m + 2], v[4 * m + 3]);
        v[4 * m + 1] = cmul(v[4 * m + 1], u1); v[4 * m + 2] = cmul(v[4 * m + 2], u2); v[4 * m + 3] = cmul(v[4 * m + 3], u3);
    }
}
template <int LOGM> DI void inv16(cf (&v)[16], int j) {
    constexpr int M = 1 << LOGM, q = M >> 4;
    const cf u1 = twidc((float)j * (4.0f / M)), u2 = cmul(u1, u1), u3 = cmul(u2, u1);
#pragma unroll
    for (int m = 0; m < 4; ++m) {
        v[4 * m + 1] = cmul(v[4 * m + 1], u1); v[4 * m + 2] = cmul(v[4 * m + 2], u2); v[4 * m + 3] = cmul(v[4 * m + 3], u3);
        inv4(v[4 * m], v[4 * m + 1], v[4 * m + 2], v[4 * m + 3]);
    }
#pragma unroll
    for (int n = 0; n < 4; ++n) {
        const cf w1 = twidc((float)(j + n * q) * (1.0f / M)), w2 = cmul(w1, w1), w3 = cmul(w2, w1);
        v[n + 4] = cmul(v[n + 4], w1); v[n + 8] = cmul(v[n + 8], w2); v[n + 12] = cmul(v[n + 12], w3);
        inv4(v[n], v[n + 4], v[n + 8], v[n + 12]);
    }
}
template <int LOGM> DI void fwd_r16_pass(LAS cf* X, int tid) {
    asm volatile("" : "+v"(tid));
    constexpr int M = 1 << LOGM, q = M >> 4;
#pragma unroll 1
    for (int t = tid; t < 1024; t += NTHR) {
        const int j = t & (q - 1), base = (t >> (LOGM - 4)) * M + j;
        constexpr int QP = (q >= 256) ? (q + (q >> 4) + (q >> 8)) : ((q == 16) ? 17 : 1);
        LAS cf* xp = X + XI(base);
        cf v[16];
#pragma unroll
        for (int n = 0; n < 16; ++n) v[n] = xp[n * QP];
        fwd16<LOGM>(v, j);
#pragma unroll
        for (int n = 0; n < 16; ++n) xp[n * QP] = v[n];
    }
}
template <int LOGM> DI void inv_r16_pass(LAS cf* X, int tid) {
    asm volatile("" : "+v"(tid));
    constexpr int M = 1 << LOGM, q = M >> 4;
#pragma unroll 1
    for (int t = tid; t < 1024; t += NTHR) {
        const int j = t & (q - 1), base = (t >> (LOGM - 4)) * M + j;
        constexpr int QP = (q >= 256) ? (q + (q >> 4) + (q >> 8)) : ((q == 16) ? 17 : 1);
        LAS cf* xp = X + XI(base);
        cf v[16];
#pragma unroll
        for (int n = 0; n < 16; ++n) v[n] = xp[n * QP];
        inv16<LOGM>(v, j);
#pragma unroll
        for (int n = 0; n < 16; ++n) xp[n * QP] = v[n];
    }
}
DI int rev4(int pp) { const unsigned br = __brev((unsigned)pp) >> 18; return (int)(((br & 0x2AAAu) >> 1) | ((br & 0x1555u) << 1)); }
DI void fft_forward(LAS cf* X, int tid) {
    fwd_r4_pass<14>(X, tid); __syncthreads();
    fwd_r16_pass<12>(X, tid); __syncthreads();
    fwd_r16_pass<8>(X, tid); __syncthreads();
    fwd_r16_pass<4>(X, tid); __syncthreads();
}
constexpr int SPEC_STRIDE = 8208;
DI void fft_conv(LAS cf* X, const f32x4* spec, int tid) {
    fft_forward(X, tid);
#pragma unroll 8
    for (int r = 0; r < 16; ++r) {
        const int k = tid + NTHR * r; const int pp = rev4(k);
        const f32x4 sp = spec[k]; const cf P = (cf){sp[0], sp[1]}, Mq = (cf){sp[2], sp[3]};
        const cf z = X[XI(pp)];
        if (k == 0) { X[XI(pp)] = cmul(z, P) + cmul((cf){z.x, -z.y}, Mq); }
        else { const int pm = rev4(16384 - k); const cf zm = X[XI(pm)];
            const cf y = cmul(z, P) + cmul((cf){zm.x, -zm.y}, Mq);
            const cf t = cmul((cf){zm.x, -zm.y}, P) + cmul(z, Mq);
            X[XI(pp)] = y; X[XI(pm)] = (cf){t.x, -t.y}; }
    }
    if (tid == 0) { const int pp = rev4(8192); const f32x4 sp = spec[8192]; const cf z = X[XI(pp)]; X[XI(pp)] = cmul(z, (cf){sp[0], sp[1]}) + cmul((cf){z.x, -z.y}, (cf){sp[2], sp[3]}); }
    __syncthreads();
    inv_r16_pass<4>(X, tid); __syncthreads();
    inv_r16_pass<8>(X, tid); __syncthreads();
    inv_r16_pass<12>(X, tid); __syncthreads();
    inv_r4_pass<14>(X, tid); __syncthreads();
}

DI void spectra_item(const Params& p, int item, LAS unsigned char* lds) {
    int tid = tidx(); asm volatile("" : "+v"(tid));
    const int l = item >> 10, o = (item >> 9) & 1, pr = item & 511, a = 2 * pr;
    LAS cf* X = (LAS cf*)lds; LAS float* aux = (LAS float*)(lds + LDS_MAIN);
    const float mind = -3.0701134573253943f, maxd = -15.350567286626972f;
    const float da = fabsf(mind + (float)a * ((maxd - mind) / 1023.0f)), db = fabsf(mind + (float)(a + 1) * ((maxd - mind) / 1023.0f));
    const float ska = p.in[I_HYSKIP][(l * 2 + o) * 1024 + a], skb = p.in[I_HYSKIP][(l * 2 + o) * 1024 + a + 1];
    const float* tf = (const float*)(p.ws + WS_TT) + ((size_t)l * 4096 + (o * 2 + 0) * 1024 + a) * S;
    const float* tb = (const float*)(p.ws + WS_TT) + ((size_t)l * 4096 + (o * 2 + 1) * 1024 + a) * S;
#pragma unroll 16
    for (int rr = 0; rr < 16; ++rr) {
        const int i = tid + NTHR * rr;
        const float ti = (float)i / 8191.0f; const float ea = __expf(-ti * da), eb = __expf(-ti * db);
        const float fa = tf[i] * ea, fb = tf[S + i] * eb, ba = tb[i] * ea, bb = tb[S + i] * eb;
        if (i == 0) { X[XI(0)] = (cf){fa + ba + ska, fb + bb + skb}; X[XI(8192)] = (cf){0.f, 0.f}; }
        else { X[XI(i)] = (cf){fa, fb}; X[XI(16384 - i)] = (cf){ba, bb}; }
    }
    __syncthreads();
    fft_forward(X, tid);
    f32x4* spec = (f32x4*)(p.ws + WS_SPEC) + (size_t)item * SPEC_STRIDE;
    const float sc = 0.5f / 16384.0f;
    for (int r = 0; r < 17; ++r) {
        const int k = tid + NTHR * r; if (k > 8192) break;
        const cf F = X[XI(rev4(k))], Fm = X[XI(rev4((16384 - k) & 16383))];
        const cf Fc = (cf){Fm.x, -Fm.y};
        const cf Ha = (F + Fc) * 0.5f, tt = (F - Fc) * 0.5f; const cf Hb = (cf){tt.y, -tt.x};
        const cf P = (Ha + Hb) * sc, Mq = (Ha - Hb) * sc;
        spec[k] = (f32x4){P.x, P.y, Mq.x, Mq.y};
    }
    __syncthreads();
}

DI float conv3(const float* row, int t, float w0, float w1, float w2) {
    const float c = row[t]; const float pv = t > 0 ? row[t - 1] : 0.f; const float nx = t < S - 1 ? row[t + 1] : 0.f;
    return w0 * pv + w1 * c + w2 * nx;
}
DI void hyena_item(const Params& p, int l, int pr, LAS unsigned char* lds) {
    int tid = tidx(); asm volatile("" : "+v"(tid)); const int a = 2 * pr;
    LAS cf* X = (LAS cf*)lds;
    const float* bint = (const float*)(p.ws + WS_BINT);
    const float* cw = p.in[I_HYCONV] + (size_t)l * 3 * 3072;
    float w[3][2][3];
#pragma unroll
    for (int wh = 0; wh < 3; ++wh)
#pragma unroll
        for (int c = 0; c < 2; ++c)
#pragma unroll
            for (int k = 0; k < 3; ++k) w[wh][c][k] = cw[k * 3072 + wh * 1024 + a + c];
    const f32x4* spec = (const f32x4*)(p.ws + WS_SPEC);
#pragma unroll 8
    for (int r = 0; r < 16; ++r) { const int t = tid + NTHR * r;
        X[XI(t)] = (cf){conv3(bint + (size_t)a * S, t, w[0][0][0], w[0][0][1], w[0][0][2]), conv3(bint + (size_t)(a + 1) * S, t, w[0][1][0], w[0][1][1], w[0][1][2])};
        X[XI(t + 8192)] = (cf){0.f, 0.f}; }
    __syncthreads();
    fft_conv(X, spec + (size_t)((l * 2 + 0) * 512 + pr) * SPEC_STRIDE, tid);
#pragma unroll 8
    for (int r = 0; r < 16; ++r) { const int t = tid + NTHR * r; const cf y = X[XI(t)];
        X[XI(t)] = (cf){y.x * conv3(bint + (size_t)(1024 + a) * S, t, w[1][0][0], w[1][0][1], w[1][0][2]), y.y * conv3(bint + (size_t)(1024 + a + 1) * S, t, w[1][1][0], w[1][1][1], w[1][1][2])};
        X[XI(t + 8192)] = (cf){0.f, 0.f}; }
    __syncthreads();
    fft_conv(X, spec + (size_t)((l * 2 + 1) * 512 + pr) * SPEC_STRIDE, tid);
    float* z2t = (float*)(p.ws + WS_Z2T);
#pragma unroll 8
    for (int r = 0; r < 16; ++r) { const int t = tid + NTHR * r; const cf y = X[XI(t)];
        z2t[(size_t)a * S + t] = y.x * conv3(bint + (size_t)(2048 + a) * S, t, w[2][0][0], w[2][0][1], w[2][0][2]);
        z2t[(size_t)(a + 1) * S + t] = y.y * conv3(bint + (size_t)(2048 + a + 1) * S, t, w[2][1][0], w[2][1][1], w[2][1][2]); }
    __syncthreads();
}
DI void phase_rmsnorm(const float* x, const float* g, bf16_t* hout, float* fout) {
    const int tid = tidx(), wave = tid >> 6, lane = tid & 63;
    for (int row = blockIdx.x * NWAVES + wave; row < S; row += gridDim.x * NWAVES) {
        const f32x4* xr = (const f32x4*)(x + (size_t)row * D) + lane;
        f32x4 v[8]; float s = 0.f;
#pragma unroll
        for (int j = 0; j < 8; ++j) { v[j] = xr[64 * j]; s += (v[j][0] * v[j][0] + v[j][1] * v[j][1]) + (v[j][2] * v[j][2] + v[j][3] * v[j][3]); }
        const float rstd = rsqrtf(wave_sum(s) * (1.0f / D) + 1e-6f);
#pragma unroll
        for (int j = 0; j < 8; ++j) { const f32x4 gg = ((const f32x4*)g)[lane + 64 * j]; const f32x4 y = v[j] * rstd * gg;
            if (hout) { u32x2 o = {pk2(y[0], y[1]), pk2(y[2], y[3])}; ((u32x2*)(hout + (size_t)row * D))[lane + 64 * j] = o; }
            else ((f32x4*)(fout + (size_t)row * D))[lane + 64 * j] = y; }
    }
}

constexpr int KROW = 144, KBUF = 64 * KROW, VBUF = 128 * KROW;
DI void qk_half(const LAS unsigned char* kb_, const bf16x8 (&qf)[4], int r, int hh, f32x16& s) {
#pragma unroll
    for (int i = 0; i < 16; ++i) s[i] = 0.f;
#pragma unroll
    for (int ks = 0; ks < 4; ++ks) { const bf16x8 a = *(const LAS bf16x8*)(kb_ + r * KROW + 32 * ks + 16 * hh); s = MFMA32(a, qf[ks], s); }
}
DI void softmax_pv_half(f32x16& s, const LAS unsigned char* vb_, const LAS float* btab, int k0, int q0w, int r, int hh, float cs, float& m, float& lsum, f32x16 (&O)[4]) {
    const int q = q0w + r;
    const int relmin = k0 - q0w - 31, relmax = k0 + 31 - q0w;
    const bool far = (relmin >= 1024 || relmax <= -1024);
    float bc = 0.f, csx = cs;
    if (far) { bc = btab[relmin >= 1024 ? 2048 : 0]; }
    else {
        if (relmin >= -1024 && relmax <= 1024) {
            const LAS float* bp = btab + (k0 - q + 1024 + 4 * hh);
#pragma unroll
            for (int i = 0; i < 16; ++i) s[i] = s[i] * cs + bp[(i & 3) + 8 * (i >> 2)];
        } else {
#pragma unroll
            for (int i = 0; i < 16; ++i) { const int rel = k0 + crow(i, hh) - q; const int i0 = min(max(rel, -1024), 1024) + 1024; s[i] = s[i] * cs + btab[i0]; }
        }
        csx = 1.0f;
    }
    float mx = s[0];
#pragma unroll
    for (int i = 1; i < 16; ++i) mx = fmaxf(mx, s[i]);
    mx = mx * csx + bc;
    mx = fmaxf(mx, __shfl_xor(mx, 32));
    if (__any(mx > m + 8.0f)) {
        const float mnew = fmaxf(m, mx), alpha = __builtin_amdgcn_exp2f(m - mnew);
        m = mnew; lsum *= alpha;
#pragma unroll
        for (int db = 0; db < 4; ++db) O[db] *= alpha;
    }
    const float c2 = bc - m;
    float rs0 = 0.f, rs1 = 0.f;
#pragma unroll
    for (int i = 0; i < 16; i += 2) { s[i] = __builtin_amdgcn_exp2f(s[i] * csx + c2); s[i + 1] = __builtin_amdgcn_exp2f(s[i + 1] * csx + c2); rs0 += s[i]; rs1 += s[i + 1]; }
    lsum += rs0 + rs1;
#pragma unroll
    for (int ss = 0; ss < 2; ++ss) {
        const bf16x8 pf = pack8(s, ss);
#pragma unroll
        for (int db = 0; db < 4; ++db) {
            const bf16x8 vf = *(const LAS bf16x8*)(vb_ + (32 * db + r) * KROW + (16 * ss + 8 * hh) * 2);
            O[db] = MFMA32(vf, pf, O[db]);
        }
    }
}
DI void diff_flash(const bf16_t* proj, const bf16_t* vtc, int h, int c, int q0w, LAS unsigned char* lds, const LAS float* btab, f32x16 (&O)[4]) {
    int tid = tidx(); asm volatile("" : "+v"(tid)); const int lane = tid & 63, r = lane & 31, hh = lane >> 5;
    constexpr int NT = S / 64;
    bf16x8 qf[4];
    { const bf16_t* qp = proj + (size_t)(q0w + r) * NIN + C_CQKV + h * 128 + c * 64 + 8 * hh;
#pragma unroll
      for (int ks = 0; ks < 4; ++ks) qf[ks] = *(const bf16x8*)(qp + 16 * ks); }
#pragma unroll
    for (int db = 0; db < 4; ++db)
#pragma unroll
        for (int i = 0; i < 16; ++i) O[db][i] = 0.f;
    float m = -1e30f, lsum = 0.f;
    const float cs = 0.125f * LOG2E;
    const bf16_t* kg = proj + C_CQKV + 1024 + h * 128 + c * 64 + (size_t)(tid >> 3) * NIN + (tid & 7) * 8;
    const bf16_t* vg = vtc + (size_t)(h * 128 + (tid >> 3)) * S + (tid & 7) * 8;
    const int kst = (tid >> 3) * KROW + (tid & 7) * 16;
    LAS unsigned char* Kb = lds; LAS unsigned char* Vb = lds + 3 * KBUF;
    u32x4 kr = *(const u32x4*)kg, v0 = *(const u32x4*)vg, v1 = *(const u32x4*)(vg + (size_t)64 * S);
    __syncthreads();
    *(LAS u32x4*)(Kb + kst) = kr; *(LAS u32x4*)(Vb + kst) = v0; *(LAS u32x4*)(Vb + 64 * KROW + kst) = v1;
    kr = *(const u32x4*)(kg + (size_t)64 * NIN);
    *(LAS u32x4*)(Kb + KBUF + kst) = kr;
    __syncthreads();
    f32x16 sA, sB;
    qk_half(Kb, qf, r, hh, sA);
    int kc = 0, kn = KBUF, kw = 2 * KBUF;
#pragma unroll 1
    for (int t = 0; t < NT; ++t) {
        if (t + 2 < NT) kr = *(const u32x4*)(kg + (size_t)(t + 2) * 64 * NIN);
        if (t + 1 < NT) { v0 = *(const u32x4*)(vg + (t + 1) * 64); v1 = *(const u32x4*)(vg + (size_t)64 * S + (t + 1) * 64); }
        const LAS unsigned char* vb_ = Vb + (t & 1) * VBUF;
        qk_half(Kb + kc + 32 * KROW, qf, r, hh, sB);
        softmax_pv_half(sA, vb_, btab, t * 64, q0w, r, hh, cs, m, lsum, O);
        if (t + 1 < NT) qk_half(Kb + kn, qf, r, hh, sA);
        softmax_pv_half(sB, vb_ + 64, btab, t * 64 + 32, q0w, r, hh, cs, m, lsum, O);
        if (t + 2 < NT) *(LAS u32x4*)(Kb + kw + kst) = kr;
        if (t + 1 < NT) { LAS unsigned char* vn = Vb + ((t + 1) & 1) * VBUF; *(LAS u32x4*)(vn + kst) = v0; *(LAS u32x4*)(vn + 64 * KROW + kst) = v1; }
        __syncthreads();
        const int tmp = kc; kc = kn; kn = kw; kw = tmp;
    }
    const float lt = lsum + __shfl_xor(lsum, 32), inv = 1.0f / lt;
#pragma unroll
    for (int db = 0; db < 4; ++db) O[db] *= inv;
}
DI void diffattn_item(const Params& p, int l, int item, LAS unsigned char* lds) {
    int tid = tidx(); asm volatile("" : "+v"(tid)); const int wave = __builtin_amdgcn_readfirstlane(tid >> 6), lane = tid & 63, r = lane & 31, hh = lane >> 5;
    const int qt = item >> 3, h = item & 7, q0w = qt * 256 + wave * 32;
    LAS float* btab = (LAS float*)(lds + LDS_MAIN);
    const float* bias = (const float*)(p.ws + WS_BIAS) + (24 + h) * 2049;
    for (int i = tid; i < 2049; i += NTHR) btab[i] = bias[i];
    const float* dl = p.in[I_DLAM] + l * 256;
    float d01 = 0.f, d23 = 0.f;
    for (int i = 0; i < 64; ++i) { d01 += dl[i] * dl[64 + i]; d23 += dl[128 + i] * dl[192 + i]; }
    const float lam_init = 0.8f - 0.6f * expf(-0.3f * (float)l);
    const float lam = expf(d01) - expf(d23) + lam_init;
    const bf16_t* proj = (const bf16_t*)(p.ws + WS_PROJ); const bf16_t* vtc = (const bf16_t*)(p.ws + WS_VTC);
    f32x16 O0[4];
    const int q = q0w + r;
    float* ctmp = (float*)(p.ws + WS_CTMP) + (size_t)q * 1024 + h * 128 + 4 * hh;
    diff_flash(proj, vtc, h, 0, q0w, lds, btab, O0);
#pragma unroll
    for (int db = 0; db < 4; ++db)
#pragma unroll
        for (int i4 = 0; i4 < 4; ++i4) { f32x4 o = {O0[db][4 * i4], O0[db][4 * i4 + 1], O0[db][4 * i4 + 2], O0[db][4 * i4 + 3]}; *(f32x4*)(ctmp + 32 * db + 8 * i4) = o; }
    diff_flash(proj, vtc, h, 1, q0w, lds, btab, O0);
    float ss = 0.f;
#pragma unroll
    for (int db = 0; db < 4; ++db)
#pragma unroll
        for (int i4 = 0; i4 < 4; ++i4) { const f32x4 o0 = *(const f32x4*)(ctmp + 32 * db + 8 * i4);
#pragma unroll
            for (int e = 0; e < 4; ++e) { const float o = o0[e] - lam * O0[db][4 * i4 + e]; O0[db][4 * i4 + e] = o; ss += o * o; } }
    ss += __shfl_xor(ss, 32);
    const float rn = rsqrtf(ss * (1.0f / 128.0f) + 1e-6f) * (1.0f - lam_init);
    const float* dg = p.in[I_DG] + l * 128;
    bf16_t* cout = (bf16_t*)(p.ws + WS_BR) + (size_t)2 * S * 1024;
#pragma unroll
    for (int db = 0; db < 4; ++db)
#pragma unroll
        for (int i4 = 0; i4 < 4; ++i4) {
            const int d0 = 32 * db + 8 * i4 + 4 * hh;
            const f32x4 g4 = *(const f32x4*)(dg + d0);
            const u32x2 gt = *(const u32x2*)(proj + (size_t)q * NIN + C_CGATE + h * 128 + d0);
            const float y0 = O0[db][4 * i4 + 0] * rn * g4[0] * silu_f(bflo(gt[0])), y1 = O0[db][4 * i4 + 1] * rn * g4[1] * silu_f(bfhi(gt[0]));
            const float y2 = O0[db][4 * i4 + 2] * rn * g4[2] * silu_f(bflo(gt[1])), y3 = O0[db][4 * i4 + 3] * rn * g4[3] * silu_f(bfhi(gt[1]));
            u32x2 o = {pk2(y0, y1), pk2(y2, y3)};
            *(u32x2*)(cout + (size_t)q * 1024 + h * 128 + d0) = o;
        }
    __syncthreads();
}

DI void mixA_wave_item(const Params& p, int wi, int lane) {
    asm volatile("" : "+v"(lane));
    const int g = wi >> 11, rem = wi & 2047, h = rem >> 8, qb = rem & 255;
    const int sh = 2 * g, n = S >> sh, nbq = 256 >> sh, res = qb / nbq, m0 = (qb % nbq) * 32;
    const int r = lane & 31, hh = lane >> 5;
    const bf16_t* proj = (const bf16_t*)(p.ws + WS_PROJ);
    const int qpos = ((m0 + r) << sh) + res;
    bf16x8 qf[8];
    { const bf16_t* qp = proj + (size_t)qpos * NIN + g * 3072 + h * 128 + 8 * hh;
#pragma unroll
      for (int ks = 0; ks < 8; ++ks) qf[ks] = *(const bf16x8*)(qp + 16 * ks); }
    f32x16 O[4];
#pragma unroll
    for (int db = 0; db < 4; ++db)
#pragma unroll
        for (int i = 0; i < 16; ++i) O[db][i] = 0.f;
    float m = -1e30f, lsum = 0.f;
    const float cs = 0.08838834764831845f * LOG2E;
    const float* bias = (const float*)(p.ws + WS_BIAS) + (g * 8 + h) * 2049 + 1024;
    const bf16_t* vt = (const bf16_t*)(p.ws + WS_VTA) + (size_t)((g * 8 + h) * 128) * S + res * n;
#pragma unroll
    for (int kb = 0; kb < 5; ++kb) {
        const int mk0r = m0 - 64 + 32 * kb;
        const bool blk_ok = (mk0r >= 0) && (mk0r < n);
        const int mk0 = blk_ok ? mk0r : m0;
        const int kpos = ((mk0 + r) << sh) + res;
        const bf16_t* kp = proj + (size_t)kpos * NIN + g * 3072 + 1024 + h * 128 + 8 * hh;
        f32x16 s;
#pragma unroll
        for (int i = 0; i < 16; ++i) s[i] = 0.f;
#pragma unroll
        for (int ks = 0; ks < 8; ++ks) { const bf16x8 a = *(const bf16x8*)(kp + 16 * ks); s = MFMA32(a, qf[ks], s); }
        float mx = -INFINITY;
#pragma unroll
        for (int i = 0; i < 16; ++i) { const int rel = mk0r + crow(i, hh) - (m0 + r); const bool valid = blk_ok && (rel <= 64) && (rel >= -64);
            const int bi = min(max(rel << sh, -1024), 1024);
            const float v = valid ? (s[i] * cs + bias[bi]) : -INFINITY; s[i] = v; mx = fmaxf(mx, v); }
        mx = fmaxf(mx, __shfl_xor(mx, 32));
        const float mnew = fmaxf(m, mx), alpha = __builtin_amdgcn_exp2f(m - mnew);
        m = mnew;
        float rs = 0.f;
#pragma unroll
        for (int i = 0; i < 16; ++i) { s[i] = __builtin_amdgcn_exp2f(s[i] - mnew); rs += s[i]; }
        lsum = lsum * alpha + rs;
#pragma unroll
        for (int db = 0; db < 4; ++db) O[db] *= alpha;
#pragma unroll
        for (int sidx = 0; sidx < 2; ++sidx) {
            const bf16x8 pf = pack8(s, sidx);
#pragma unroll
            for (int db = 0; db < 4; ++db) {
                const bf16_t* vp = vt + (size_t)(32 * db + r) * S + mk0 + 16 * sidx + 4 * hh;
                const s16x4 lo = *(const s16x4*)vp, hi = *(const s16x4*)(vp + 8);
                const bf16x8 vf = __builtin_shufflevector(lo, hi, 0, 1, 2, 3, 4, 5, 6, 7);
                O[db] = MFMA32(vf, pf, O[db]);
            }
        }
    }
    const float lt = lsum + __shfl_xor(lsum, 32), inv = 1.0f / lt;
    float* oa = (float*)(p.ws + WS_OA) + ((size_t)g * S + qpos) * 1024 + h * 128;
#pragma unroll
    for (int db = 0; db < 4; ++db)
#pragma unroll
        for (int i4 = 0; i4 < 4; ++i4) {
            const int d0 = 32 * db + 8 * i4 + 4 * hh;
            f32x4 o = {O[db][4 * i4] * inv, O[db][4 * i4 + 1] * inv, O[db][4 * i4 + 2] * inv, O[db][4 * i4 + 3] * inv};
            *(f32x4*)(oa + d0) = o;
        }
    if (hh == 0) ((float*)(p.ws + WS_LSEA))[((size_t)g * S + qpos) * 8 + h] = m + __log2f(lt);
}

DI void phase_post(const Params& p, LAS unsigned char* lds) {
    const int tid = tidx();
    const bf16_t* proj = (const bf16_t*)(p.ws + WS_PROJ);
    bf16_t* aout = (bf16_t*)(p.ws + WS_BR); bf16_t* bout = aout + (size_t)S * 1024;
    const float* oa = (const float*)(p.ws + WS_OA); const float* lse = (const float*)(p.ws + WS_LSEA);
    for (int idx = blockIdx.x * NTHR + tid; idx < S * 256; idx += gridDim.x * NTHR) {
        const int pos = idx >> 8, c4 = idx & 255, h = c4 >> 5, col = c4 * 4;
        const float l0 = lse[((size_t)0 * S + pos) * 8 + h], l1 = lse[((size_t)1 * S + pos) * 8 + h], l2 = lse[((size_t)2 * S + pos) * 8 + h];
        const float mx = fmaxf(l0, fmaxf(l1, l2));
        const float w0 = __builtin_amdgcn_exp2f(l0 - mx), w1 = __builtin_amdgcn_exp2f(l1 - mx), w2 = __builtin_amdgcn_exp2f(l2 - mx);
        const float inv = 1.0f / (w0 + w1 + w2);
        const f32x4 o0 = *(const f32x4*)(oa + ((size_t)0 * S + pos) * 1024 + col), o1 = *(const f32x4*)(oa + ((size_t)1 * S + pos) * 1024 + col), o2 = *(const f32x4*)(oa + ((size_t)2 * S + pos) * 1024 + col);
        const f32x4 o = (o0 * w0 + o1 * w1 + o2 * w2) * inv;
        const u32x2 gt = *(const u32x2*)(proj + (size_t)pos * NIN + C_AGATE + col);
        u32x2 ov = {pk2(o[0] * silu_f(bflo(gt[0])), o[1] * silu_f(bfhi(gt[0]))), pk2(o[2] * silu_f(bflo(gt[1])), o[3] * silu_f(bfhi(gt[1])))};
        *(u32x2*)(aout + (size_t)pos * 1024 + col) = ov;
    }
    LAS float* tile = (LAS float*)lds;
    const float* z2t = (const float*)(p.ws + WS_Z2T);
    for (int it = blockIdx.x; it < 128 * 16; it += gridDim.x) {
        const int t0 = (it >> 4) * 64, c0 = (it & 15) * 64;
        __syncthreads();
#pragma unroll
        for (int k = 0; k < 2; ++k) { const int e = tid + NTHR * k; const int ci = e >> 4, t4 = (e & 15) * 4;
            const f32x4 v = *(const f32x4*)(z2t + (size_t)(c0 + ci) * S + t0 + t4);
            tile[ci * 65 + t4] = v[0]; tile[ci * 65 + t4 + 1] = v[1]; tile[ci * 65 + t4 + 2] = v[2]; tile[ci * 65 + t4 + 3] = v[3]; }
        __syncthreads();
#pragma unroll
        for (int k = 0; k < 2; ++k) { const int e = tid + NTHR * k; const int ti = e >> 4, cc = (e & 15) * 4;
            const u32x2 gt = *(const u32x2*)(proj + (size_t)(t0 + ti) * NIN + C_BGATE + c0 + cc);
            const float y0 = tile[(cc + 0) * 65 + ti] * silu_f(bflo(gt[0])), y1 = tile[(cc + 1) * 65 + ti] * silu_f(bfhi(gt[0]));
            const float y2 = tile[(cc + 2) * 65 + ti] * silu_f(bflo(gt[1])), y3 = tile[(cc + 3) * 65 + ti] * silu_f(bfhi(gt[1]));
            u32x2 ov = {pk2(y0, y1), pk2(y2, y3)};
            *(u32x2*)(bout + (size_t)(t0 + ti) * 1024 + c0 + cc) = ov; }
    }
    __syncthreads();
}

#ifndef REP_GEMMIN
#define REP_GEMMIN 1
#endif
#ifndef REP_DIFF
#define REP_DIFF 1
#endif
#ifndef REP_HYENA
#define REP_HYENA 1
#endif
#ifndef REP_MIXA
#define REP_MIXA 1
#endif
#ifndef REP_PRO
#define REP_PRO 1
#endif
#ifndef REP_SPEC
#define REP_SPEC 1
#endif
#ifndef REP_MISC
#define REP_MISC 1
#endif
#ifndef REP_PROJ
#define REP_PROJ 1
#endif
constexpr int NPH = 3 + 6 * DEPTH + 1;
typedef const Params __attribute__((address_space(4)))* ParamsK;
DI Params ldp(ParamsK pc) {
    asm volatile("" : "+s"(pc));
    Params q;
#pragma unroll
    for (int i = 0; i < 18; ++i) q.in[i] = pc->in[i];
    q.out = pc->out; q.ws = pc->ws; q.ph_lo = pc->ph_lo; q.ph_hi = pc->ph_hi;
    return q;
}
DI void run_phase(ParamsK pc, int ph, LAS unsigned char* lds) {
    if (ph == 0) { for (int rep = 0; rep < REP_PRO; ++rep) { const Params p = ldp(pc); phase_prologue(p, lds); __syncthreads(); } return; }
    if (ph == 1) { const Params p = ldp(pc); phase_tgen(p); return; }
    if (ph == 2) { for (int rep = 0; rep < REP_SPEC; ++rep) { const Params p = ldp(pc); for (int it = blockIdx.x; it < DEPTH * 2 * 512; it += gridDim.x) spectra_item(p, it, lds); } return; }
    if (ph == NPH - 1) { const Params p = ldp(pc); phase_rmsnorm((const float*)(p.ws + WS_X), p.in[I_FINALG], nullptr, p.out); return; }
    const int l = (ph - 3) / 6, sp = (ph - 3) % 6;
    if (sp == 0) { for (int rep = 0; rep < REP_MISC; ++rep) { const Params p = ldp(pc); phase_rmsnorm((l == 0) ? p.in[I_X] : (const float*)(p.ws + WS_X), p.in[I_NORMG] + l * D, (bf16_t*)(p.ws + WS_H), nullptr); } return; }
    if (sp == 1) {
        const Params p = ldp(pc);
        pg8::Gemm g{(const bf16_t*)(p.ws + WS_H), (const bf16_t*)(p.ws + WS_WIN) + (size_t)l * NIN * D, S, NIN, D};
        pg8::StaticOrder so; so.init(S, NIN, gridDim.x, blockIdx.x);
        EpiIn e{(bf16_t*)(p.ws + WS_PROJ), (bf16_t*)(p.ws + WS_VTA), (bf16_t*)(p.ws + WS_VTC), (float*)(p.ws + WS_BINT), lds + 131072};
#pragma unroll 1
        for (int rep = 0; rep < REP_GEMMIN; ++rep) { pg8::gemm_phase(lds, g, so, e); __syncthreads(); }
        return;
    }
    if (sp == 2) {
#pragma unroll 1
        for (int it = blockIdx.x; it < 256 + 512 + 768; it += gridDim.x) {
            int l2 = l; asm volatile("" : "+s"(l2));
            const Params p = ldp(pc);
            if (it < 256) { for (int rep = 0; rep < REP_DIFF; ++rep) diffattn_item(p, l2, it, lds); }
            else if (it < 768) { for (int rep = 0; rep < REP_HYENA; ++rep) hyena_item(p, l2, it - 256, lds); }
            else { for (int rep = 0; rep < REP_MIXA; ++rep) mixA_wave_item(p, (it - 768) * NWAVES + (tidx() >> 6), tidx() & 63); }
        }
        return;
    }
    if (sp == 3) { for (int rep = 0; rep < REP_MISC; ++rep) { const Params p = ldp(pc); phase_post(p, lds); } return; }
    if (sp == 4) {
#pragma unroll 1
        for (int rep = 0; rep < REP_PROJ; ++rep) {
            const Params p = ldp(pc);
            pg8::Gemm g{(const bf16_t*)(p.ws + WS_BR), (const bf16_t*)(p.ws + WS_WPR) + (size_t)(l * 3) * D * 1024, 3 * S, 3 * D, 1024};
            ProjOrder po; po.so.init(S, D, gridDim.x, blockIdx.x);
            EpiProj e{(const bf16_t*)(p.ws + WS_PROJ), p.in[I_MERGEB] + (size_t)l * 3 * D, (float*)(p.ws + WS_YF), (bf16_t*)(p.ws + WS_YB)};
            pg8::gemm_phase(lds, g, po, e);
            __syncthreads();
        }
        return;
    }
    {
        const Params p = ldp(pc);
        pg8::Gemm g{(const bf16_t*)(p.ws + WS_YB), (const bf16_t*)(p.ws + WS_WOUT) + (size_t)l * D * D, S, D, D};
        pg8::StaticOrder so; so.init(S, D, gridDim.x, blockIdx.x);
        EpiOut e{(l == 0) ? p.in[I_X] : (const float*)(p.ws + WS_X), (float*)(p.ws + WS_X)};
#pragma unroll 1
        for (int rep = 0; rep < ((l == 0) ? REP_MISC : 1); ++rep) { pg8::gemm_phase(lds, g, so, e); __syncthreads(); }
    }
}


#define XB_TMO      128
#define XB_XCNT(j)  (256  + 64 * (j))
#define XB_XSUB(j)  (1280 + 64 * (j))
#define XB_XGEN(j)  (2304 + 64 * (j))
#define XB_TOP      3328
#define XB_TOPGEN   3392
#define XCD_BAR_WORDS 3456
#define XB_SPIN_CAP (1u << 18)
DI unsigned xb_ld(unsigned* p)              { return __hip_atomic_load(p, __ATOMIC_RELAXED, __HIP_MEMORY_SCOPE_AGENT); }
DI unsigned xb_add(unsigned* p, unsigned v) { return __hip_atomic_fetch_add(p, v, __ATOMIC_RELAXED, __HIP_MEMORY_SCOPE_AGENT); }
DI unsigned xb_xcc_id() { return (unsigned)__builtin_amdgcn_s_getreg((3 << 11) | 20) & 0xFu; }
#define XB_SPIN(cond, bar) do { unsigned _sp = 0; while (cond) { __builtin_amdgcn_s_sleep(1); \
    if ((++_sp & 255u) == 0u) { if (xb_ld(&(bar)[XB_TMO])) break; if (_sp > XB_SPIN_CAP) { atomicAdd(&(bar)[XB_TMO], 1u); break; } } } } while (0)
struct XcdBarrier { unsigned* bar; unsigned x; volatile LAS unsigned* st; };
DI XcdBarrier xcd_barrier_post(unsigned* bar, volatile LAS unsigned* st) {
    XcdBarrier b; b.bar = bar; b.x = xb_xcc_id(); b.st = st;
    if (threadIdx.x == 0) (void)xb_add(&bar[XB_XCNT(b.x)], 1u);
    return b;
}
DI void xcd_barrier_complete(unsigned* bar, unsigned x, unsigned& nloc, unsigned& nx) {
    const unsigned G = gridDim.x * gridDim.y * gridDim.z;
    unsigned sum, cnt, mine, sp = 0u;
    for (;;) {
        sum = 0u; cnt = 0u; mine = 0u;
#pragma unroll
        for (unsigned j = 0; j < 16; ++j) { const unsigned c = xb_ld(&bar[XB_XCNT(j)]); sum += c; cnt += (c > 0u) ? 1u : 0u; mine = (j == x) ? c : mine; }
        if (sum == G) break;
        __builtin_amdgcn_s_sleep(1);
        if ((++sp & 255u) == 0u) { if (xb_ld(&bar[XB_TMO])) break; if (sp > XB_SPIN_CAP) { atomicAdd(&bar[XB_TMO], 1u); break; } }
    }
    nloc = mine > 0u ? mine : 1u; nx = cnt > 0u ? cnt : 1u;
}
DI void xcd_barrier(const XcdBarrier& b) {
    asm volatile("s_waitcnt vmcnt(0)" ::: "memory");
    __syncthreads();
    if (threadIdx.x == 0) {
        unsigned* bar = b.bar;
        __builtin_amdgcn_s_waitcnt(0);
        unsigned nloc = b.st[0], nx = b.st[1];
        if (nloc == 0u) { xcd_barrier_complete(bar, b.x, nloc, nx); b.st[0] = nloc; b.st[1] = nx; }
        const unsigned old = xb_add(&bar[XB_XSUB(b.x)], 1u);
        const unsigned gen = old / nloc;
        if (old + 1u == (gen + 1u) * nloc) {
            __builtin_amdgcn_fence(__ATOMIC_RELEASE, "agent");
            asm volatile("s_waitcnt vmcnt(0)" ::: "memory");
            const unsigned og = xb_add(&bar[XB_TOP], 1u);
            const unsigned tg = og / nx;
            if (og + 1u == (tg + 1u) * nx) xb_add(&bar[XB_TOPGEN], 1u);
            else XB_SPIN(xb_ld(&bar[XB_TOPGEN]) == tg, bar);
            __builtin_amdgcn_fence(__ATOMIC_ACQUIRE, "agent");
            xb_add(&bar[XB_XGEN(b.x)], 1u);
            asm volatile("s_waitcnt vmcnt(0)" ::: "memory");
        } else {
            XB_SPIN(xb_ld(&bar[XB_XGEN(b.x)]) == gen, bar);
            __builtin_amdgcn_fence(__ATOMIC_ACQUIRE, "agent");
            asm volatile("s_waitcnt vmcnt(0)" ::: "memory");
        }
    }
    __syncthreads();
}

__global__ void __launch_bounds__(512, 2) mega_kernel(Params p) {
#if defined(__HIP_DEVICE_COMPILE__)
    extern __shared__ __attribute__((aligned(16))) unsigned char shm[];
    LAS unsigned char* lds = (LAS unsigned char*)shm;
    cg::grid_group grid = cg::this_grid();
    const int ph_lo = p.ph_lo, ph_hi = p.ph_hi;
    volatile LAS unsigned* st = (volatile LAS unsigned*)(lds + LDS_BYTES - 16);
    if (threadIdx.x == 0) { st[0] = 0u; st[1] = 0u; }
    __syncthreads();
    const XcdBarrier xb = xcd_barrier_post((unsigned*)(p.ws + WS_BAR), st);
#pragma unroll 1
    for (int ph = ph_lo; ph < ph_hi; ++ph) {
        ParamsK pc = (ParamsK)__builtin_amdgcn_kernarg_segment_ptr();
        run_phase(pc, ph, lds);
        if (ph + 1 < ph_hi) { if (ph == ph_lo) grid.sync(); else xcd_barrier(xb); }
    }
#endif
}

#ifndef N_LAUNCH_MODE
#define N_LAUNCH_MODE 1
#endif
extern "C" void kernel_launch(void* const* d_in, const int* in_sizes, int n_in, void* d_out, int out_size, void* d_ws, size_t ws_size, hipStream_t stream) {
    static int grid = 0;
    if (grid == 0) {
        int dev = 0, cus = 0;
        if (hipGetDevice(&dev) != hipSuccess || hipDeviceGetAttribute(&cus, hipDeviceAttributeMultiprocessorCount, dev) != hipSuccess) { fprintf(stderr, "kernel_launch: device query failed\n"); grid = -1; return; }
        if (hipFuncSetAttribute((const void*)mega_kernel, hipFuncAttributeMaxDynamicSharedMemorySize, LDS_BYTES) != hipSuccess) { fprintf(stderr, "kernel_launch: hipFuncSetAttribute failed\n"); grid = -1; return; }
        int per_cu = 0;
        if (hipOccupancyMaxActiveBlocksPerMultiprocessor(&per_cu, (const void*)mega_kernel, NTHR, LDS_BYTES) != hipSuccess || per_cu < 1) { fprintf(stderr, "kernel_launch: occupancy query says %d\n", per_cu); (void)hipGetLastError(); }
        if (n_in != 18 || ws_size < WS_END) { fprintf(stderr, "kernel_launch: n_in %d ws %zu (need %zu)\n", n_in, ws_size, (size_t)WS_END); grid = -1; return; }
        grid = cus;
    }
    if (grid < 0) return;
    Params p{};
    for (int i = 0; i < 18; ++i) p.in[i] = (const float*)d_in[i];
    p.out = (float*)d_out; p.ws = (unsigned char*)d_ws;
    if (hipMemsetAsync((unsigned char*)d_ws + WS_BAR, 0, 16384, stream) != hipSuccess) { fprintf(stderr, "kernel_launch: memset of barrier words failed\n"); return; }
#if N_LAUNCH_MODE == 1
    p.ph_lo = 0; p.ph_hi = NPH;
    void* args[] = {&p};
    hipError_t e = hipLaunchCooperativeKernel((const void*)mega_kernel, dim3(grid), dim3(NTHR), args, LDS_BYTES, stream);
    if (e != hipSuccess) fprintf(stderr, "cooperative launch failed: %s (grid %d)\n", hipGetErrorString(e), grid);
#else
    for (int ph = 0; ph < NPH; ++ph) {
        p.ph_lo = ph; p.ph_hi = ph + 1;
        hipLaunchKernelGGL(mega_kernel, dim3(grid), dim3(NTHR), LDS_BYTES, stream, p);
    }
#endif
}
```

```cpp
#include <hip/hip_runtime.h>
#include <hip/hip_cooperative_groups.h>
#include <cstdio>
namespace cg = cooperative_groups;
#define DI __device__ __forceinline__
#define LAS __attribute__((address_space(3)))
typedef unsigned short bf16_t;
typedef short bf16x8 __attribute__((ext_vector_type(8)));
typedef short s16x4 __attribute__((ext_vector_type(4)));
typedef float f32x4 __attribute__((ext_vector_type(4)));
typedef float f32x16 __attribute__((ext_vector_type(16)));
typedef float f32x2 __attribute__((ext_vector_type(2)));
typedef float cf __attribute__((ext_vector_type(2)));
typedef __bf16 bf16x2n __attribute__((ext_vector_type(2)));
typedef unsigned u32x2 __attribute__((ext_vector_type(2)));
typedef unsigned u32x4 __attribute__((ext_vector_type(4)));

DI unsigned pk2(float lo, float hi) { f32x2 v = {lo, hi}; return __builtin_bit_cast(unsigned, __builtin_convertvector(v, bf16x2n)); }
DI float bflo(unsigned u) { return __uint_as_float(u << 16); }
DI float bfhi(unsigned u) { return __uint_as_float(u & 0xffff0000u); }
DI float silu_f(float x) { return x / (1.0f + __expf(-x)); }
DI float sigm_f(float x) { return 1.0f / (1.0f + __expf(-x)); }

DI int tidx() { int t = threadIdx.x; asm volatile("" : "+v"(t)); return t; }

constexpr int S = 8192, D = 2048, NIN = 24576, DEPTH = 4;
constexpr int C_AGATE = 9216, C_BIN = 10240, C_BGATE = 13312, C_CQKV = 14336, C_CGATE = 17408, C_MERGE = 18432;
constexpr float LOG2E = 1.4426950408889634f;
constexpr int NTHR = 512, NWAVES = 8;
constexpr int LDS_MAIN = 143360, LDS_AUX = 16384, LDS_BYTES = LDS_MAIN + LDS_AUX;

constexpr size_t WS_WIN  = 0;
constexpr size_t WS_WPR  = WS_WIN  + (size_t)DEPTH * NIN * D * 2;
constexpr size_t WS_WOUT = WS_WPR  + (size_t)DEPTH * 3 * D * 1024 * 2;
constexpr size_t WS_SPEC = WS_WOUT + (size_t)DEPTH * D * D * 2;
constexpr size_t WS_HID2 = WS_SPEC + (size_t)DEPTH * 2 * 512 * 8208 * 16;
constexpr size_t WS_BIAS = WS_HID2 + (size_t)DEPTH * S * 64 * 4;
constexpr size_t WS_X    = WS_BIAS + 524288;
constexpr size_t WS_H    = WS_X    + (size_t)S * D * 4;
constexpr size_t WS_PROJ = WS_H    + (size_t)S * D * 2;
constexpr size_t WS_BINT = WS_PROJ + (size_t)S * NIN * 2;
constexpr size_t WS_VTA  = WS_BINT + (size_t)3072 * S * 4;
constexpr size_t WS_VTC  = WS_VTA  + (size_t)3 * 1024 * S * 2;
constexpr size_t WS_OA   = WS_VTC  + (size_t)1024 * S * 2;
constexpr size_t WS_LSEA = WS_OA   + (size_t)3 * S * 1024 * 4;
constexpr size_t WS_Z2T  = WS_LSEA + (size_t)3 * S * 8 * 4;
constexpr size_t WS_BR   = WS_Z2T  + (size_t)1024 * S * 4;
constexpr size_t WS_YF   = WS_BR   + (size_t)3 * S * 1024 * 2;
constexpr size_t WS_YB   = WS_YF   + (size_t)S * D * 4;
constexpr size_t WS_CTMP = WS_YB   + (size_t)S * D * 2;
constexpr size_t WS_BAR  = WS_CTMP + (size_t)S * 1024 * 4;
constexpr size_t WS_TT   = WS_BAR + 16384;
constexpr size_t WS_END  = WS_TT + (size_t)DEPTH * 4096 * S * 4;

struct Params {
    const float* in[18];
    float* out;
    unsigned char* ws;
    int ph_lo, ph_hi;
};
enum { I_X = 0, I_NORMG, I_FINALG, I_WIN, I_MERGEB, I_RELB, I_HYCONV, I_HYW1, I_HYB1, I_HYFREQ, I_HYW2, I_HYB2, I_HYW3, I_HYSKIP, I_DLAM, I_DG, I_WPROJ, I_WOUT };

namespace pg8 {
constexpr int BM = 256, BK = 64, HALF = 128, HTB = HALF * BK * 2, NXCD = 8, WGM = 8;
DI int lds_byte(int r, int c) { const int st = (r >> 4) * 2 + (c >> 5), rr = r & 15, cc = c & 31, ob = rr * 64 + cc * 2; return st * 1024 + (ob ^ (((ob >> 9) & 1) << 5)); }
DI void stage_rc(int b, int& R, int& C) { const int st = b / 1024, sb = b % 1024, swz = sb ^ (((sb >> 9) & 1) << 5); R = (st >> 1) * 16 + swz / 64; C = (st & 1) * 32 + (swz % 64) / 2; }
DI int perm32(int rho) { const int n = rho >> 4, i = rho & 15; return 8 * (i >> 2) + 4 * n + (i & 3); }
struct Unit { int pm, pn; };
struct Gemm { const bf16_t* A; const bf16_t* Bt; int M, N, K; };
struct StaticOrder {
    int nM, nN, nwg, G, c;
    DI void init(int M, int N, int G_, int c_) { nM = M / BM; nN = N / BM; nwg = nM * nN; G = G_; c = c_; }
    DI bool next(int i, Unit& u) const {
        const long L = (long)i * G + c; if (L >= nwg) return false;
        int wgid = (int)L; { const int q = nwg / NXCD, r = nwg % NXCD, xcd = wgid % NXCD, off = wgid / NXCD; wgid = (xcd < r ? xcd * (q + 1) : r * (q + 1) + (xcd - r) * q) + off; }
        const int nig = WGM * nN, gid = wgid / nig, fm = gid * WGM, gsz = (nM - fm) < WGM ? (nM - fm) : WGM;
        u.pm = fm + ((wgid % nig) % gsz); u.pn = (wgid % nig) / gsz; return true;
    }
};
template <class Epi, class Sched>
DI void gemm_phase(LAS unsigned char* lds, const Gemm g, const Sched& S, const Epi& E) {
    const int tid = tidx(), wid = __builtin_amdgcn_readfirstlane(tid >> 6), lane = tid & 63, wr = wid >> 2, wc = wid & 3, fr = lane & 15, fq = lane >> 4;
    const int K = g.K, nt = K / BK;
    unsigned voffA[2], voffB[2];
#pragma unroll
    for (int i = 0; i < 2; ++i) { int R, C; stage_rc(tid * 16 + i * 8192, R, C); const int Rb = Epi::PERM ? ((R & ~31) + perm32(R & 31)) : R; voffA[i] = (unsigned)(R * K + C) * 2u; voffB[i] = (unsigned)(Rb * K + C) * 2u; }
    const size_t kstep = (size_t)(BK * 2);
    const size_t hstep = (size_t)HALF * K * 2;
    const size_t tstep = 2 * hstep;
    const unsigned ldsw = (unsigned)wid * 1024u;
    const int aoff = lds_byte(wr * 64 + fr, fq * 8), boff = lds_byte(wc * 32 + fr, fq * 8);
#define PG8_SA(b, h) (((b) * 2 + (h)) * HTB)
#define PG8_SB(b, h) ((4 + (b) * 2 + (h)) * HTB)
#define PG8_STAGE(bufoff, gbase, voff) do { _Pragma("unroll") for (int _i = 0; _i < 2; ++_i) \
        __builtin_amdgcn_global_load_lds((const unsigned*)((const char*)(gbase) + (voff)[_i]), (LAS unsigned*)(lds + (bufoff) + ldsw + _i * 8192), 16, 0, 0); } while (0)
#define PG8_LDA(dst, b, h) do { _Pragma("unroll") for (int m = 0; m < 4; ++m) _Pragma("unroll") for (int k = 0; k < 2; ++k) dst[m][k] = *(const LAS bf16x8*)(lds + PG8_SA(b, h) + aoff + m * 2048 + k * 1024); } while (0)
#define PG8_LDB(dst, b, h) do { _Pragma("unroll") for (int n = 0; n < 2; ++n) _Pragma("unroll") for (int k = 0; k < 2; ++k) dst[n][k] = *(const LAS bf16x8*)(lds + PG8_SB(b, h) + boff + n * 2048 + k * 1024); } while (0)
#define PG8_MMA(ai, bj, At, Bt) do { __builtin_amdgcn_s_setprio(1); _Pragma("unroll") for (int m = 0; m < 4; ++m) _Pragma("unroll") for (int n = 0; n < 2; ++n) _Pragma("unroll") for (int k = 0; k < 2; ++k) \
        acc[ai][bj][m][n] = __builtin_amdgcn_mfma_f32_16x16x32_bf16(Bt[n][k], At[m][k], acc[ai][bj][m][n], 0, 0, 0); __builtin_amdgcn_s_setprio(0); } while (0)
#define PG8_WAIT_V(n) asm volatile("s_waitcnt vmcnt(" #n ")" ::: "memory")
#define PG8_WAIT_L(n) asm volatile("s_waitcnt lgkmcnt(" #n ")" ::: "memory")
#define PG8_BAR __builtin_amdgcn_s_barrier()
#define PG8_SCHED __builtin_amdgcn_sched_barrier(0)
    Unit cur, nxt; int ui = 0;
    if (!S.next(0, cur)) return;
    f32x4 acc[2][2][4][2];
#pragma unroll
    for (int a = 0; a < 2; ++a)
#pragma unroll
        for (int b = 0; b < 2; ++b)
#pragma unroll
            for (int m = 0; m < 4; ++m)
#pragma unroll
                for (int n = 0; n < 2; ++n) acc[a][b][m][n] = (f32x4){0.f, 0.f, 0.f, 0.f};
    bf16x8 At[4][2], B0[2][2], B1[2][2];
    const char* cA = (const char*)g.A + (size_t)cur.pm * tstep; const char* cB = (const char*)g.Bt + (size_t)cur.pn * tstep;
    PG8_STAGE(PG8_SB(0, 0), cB, voffB); PG8_STAGE(PG8_SA(0, 0), cA, voffA); PG8_STAGE(PG8_SB(0, 1), cB + hstep, voffB); PG8_STAGE(PG8_SA(0, 1), cA + hstep, voffA);
    if (wr == 1) PG8_BAR;
    PG8_WAIT_V(4); PG8_BAR;
    PG8_STAGE(PG8_SB(1, 0), cB + kstep, voffB); PG8_STAGE(PG8_SA(1, 0), cA + kstep, voffA); PG8_STAGE(PG8_SB(1, 1), cB + hstep + kstep, voffB);
    PG8_WAIT_V(6); PG8_BAR;
    for (;;) {
        const bool has_next = S.next(ui + 1, nxt);
        const char* nA = has_next ? (const char*)g.A + (size_t)nxt.pm * tstep : cA; const char* nB = has_next ? (const char*)g.Bt + (size_t)nxt.pn * tstep : cB;
        for (int t = 0; t < nt; t += 2) {
            const bool last = (t == nt - 2);
            const char* a1 = cA + (size_t)(t + 1) * kstep;
            const char* a2 = last ? nA : cA + (size_t)(t + 2) * kstep; const char* b2 = last ? nB : cB + (size_t)(t + 2) * kstep;
            const char* a3 = a2 + kstep; const char* b3 = b2 + kstep;
            PG8_LDB(B0, 0, 0); PG8_SCHED; PG8_LDA(At, 0, 0); PG8_STAGE(PG8_SA(1, 1), a1 + hstep, voffA);
            PG8_WAIT_L(8); PG8_BAR; PG8_WAIT_L(0); PG8_MMA(0, 0, At, B0); PG8_BAR; PG8_SCHED;
            PG8_LDB(B1, 0, 1); PG8_STAGE(PG8_SB(0, 0), b2, voffB);
            PG8_BAR; PG8_WAIT_L(0); PG8_MMA(0, 1, At, B1); PG8_BAR;
            PG8_LDA(At, 0, 1); PG8_STAGE(PG8_SA(0, 0), a2, voffA);
            PG8_BAR; PG8_WAIT_L(0); PG8_MMA(1, 0, At, B0); PG8_BAR; PG8_SCHED;
            PG8_STAGE(PG8_SB(0, 1), b2 + hstep, voffB);
            PG8_WAIT_V(6); PG8_BAR; PG8_MMA(1, 1, At, B1); PG8_BAR;
            PG8_LDB(B0, 1, 0); PG8_SCHED; PG8_LDA(At, 1, 0); PG8_STAGE(PG8_SA(0, 1), a2 + hstep, voffA);
            PG8_WAIT_L(8); PG8_BAR; PG8_WAIT_L(0); PG8_MMA(0, 0, At, B0); PG8_BAR; PG8_SCHED;
            PG8_LDB(B1, 1, 1); PG8_STAGE(PG8_SB(1, 0), b3, voffB);
            PG8_BAR; PG8_WAIT_L(0); PG8_MMA(0, 1, At, B1); PG8_BAR;
            PG8_LDA(At, 1, 1); PG8_STAGE(PG8_SA(1, 0), a3, voffA);
            PG8_BAR; PG8_WAIT_L(0); PG8_MMA(1, 0, At, B0); PG8_BAR; PG8_SCHED;
            PG8_STAGE(PG8_SB(1, 1), b3 + hstep, voffB);
            PG8_WAIT_V(6); PG8_BAR; PG8_MMA(1, 1, At, B1); PG8_BAR;
        }
        E(acc, cur, wr, wc, fr, fq);
        if (!has_next) break;
#pragma unroll
        for (int a = 0; a < 2; ++a)
#pragma unroll
            for (int b = 0; b < 2; ++b)
#pragma unroll
                for (int m = 0; m < 4; ++m)
#pragma unroll
                    for (int n = 0; n < 2; ++n) acc[a][b][m][n] = (f32x4){0.f, 0.f, 0.f, 0.f};
        cur = nxt; cA = nA; cB = nB; ++ui;
    }
    PG8_WAIT_V(0);
    if (wr == 0) PG8_BAR;
    PG8_BAR;
#undef PG8_SA
#undef PG8_SB
#undef PG8_STAGE
#undef PG8_LDA
#undef PG8_LDB
#undef PG8_MMA
#undef PG8_WAIT_V
#undef PG8_WAIT_L
#undef PG8_BAR
#undef PG8_SCHED
}
}

struct EpiIn {
    static constexpr bool PERM = true;
    bf16_t* proj; bf16_t* vta; bf16_t* vtc; float* bint; LAS unsigned char* tlds;
    DI void operator()(const f32x4 (&acc)[2][2][4][2], const pg8::Unit& u, int wr, int wc, int fr, int fq) const {
        const int colt = u.pn * 256;
        int kind = 0;
        if (colt < C_AGATE) { if ((colt % 3072) >= 2048) kind = 1; }
        else if (colt >= C_BIN && colt < C_BGATE) kind = 2;
        else if (colt >= C_CQKV + 2048 && colt < C_CGATE) kind = 3;
        const int row0 = u.pm * 256 + wr * 64 + fr, col0 = colt + wc * 32 + 8 * fq;
        if (kind == 0) {
#pragma unroll
            for (int ai = 0; ai < 2; ++ai)
#pragma unroll
                for (int m = 0; m < 4; ++m) { bf16_t* rp = proj + (size_t)(row0 + ai * 128 + m * 16) * NIN + col0;
#pragma unroll
                    for (int bj = 0; bj < 2; ++bj) { const f32x4 a = acc[ai][bj][m][0], b = acc[ai][bj][m][1];
                        u32x4 o = {pk2(a[0], a[1]), pk2(a[2], a[3]), pk2(b[0], b[1]), pk2(b[2], b[3])}; *(u32x4*)(rp + bj * 128) = o; } }
        } else if (kind == 1 && colt >= 2 * 3072) {
            bf16_t* base = vta + (ptrdiff_t)(2 * 1024 - 2 * 3072 - 2048) * (ptrdiff_t)S;
#pragma unroll
            for (int ai = 0; ai < 2; ++ai) { const int prow = fr * (S >> 4) + ((u.pm * 256 + ai * 128 + wr * 64) >> 4);
#pragma unroll
                for (int bj = 0; bj < 2; ++bj)
#pragma unroll
                    for (int n = 0; n < 2; ++n)
#pragma unroll
                        for (int e = 0; e < 4; ++e) { u32x2 o = {pk2(acc[ai][bj][0][n][e], acc[ai][bj][1][n][e]), pk2(acc[ai][bj][2][n][e], acc[ai][bj][3][n][e])};
                            *(u32x2*)(base + (ptrdiff_t)(col0 + bj * 128 + n * 4 + e) * (ptrdiff_t)S + prow) = o; } }
        } else {
            const int lane = fr + 16 * fq, wave = wr * 4 + wc;
            LAS float* tl = (LAS float*)(tlds + wave * 2304);
            const int cl = lane >> 1, hs = lane & 1;
            const int colg = colt + wc * 32 + cl;
#pragma unroll
            for (int ai = 0; ai < 2; ++ai)
#pragma unroll
                for (int bj = 0; bj < 2; ++bj)
#pragma unroll
                    for (int m = 0; m < 4; ++m) {
                        const int rowb = u.pm * 256 + ai * 128 + wr * 64 + m * 16;
#pragma unroll
                        for (int n = 0; n < 2; ++n)
#pragma unroll
                            for (int e = 0; e < 4; ++e) tl[(8 * fq + 4 * n + e) * 17 + fr] = acc[ai][bj][m][n][e];
                        __builtin_amdgcn_wave_barrier();
                        const LAS float* tc = tl + cl * 17;
                        const int col = colg + bj * 128;
                        if (kind == 2) {
                            f32x4 o0 = {tc[8 * hs], tc[8 * hs + 1], tc[8 * hs + 2], tc[8 * hs + 3]}, o1 = {tc[8 * hs + 4], tc[8 * hs + 5], tc[8 * hs + 6], tc[8 * hs + 7]};
                            float* bp = bint + (size_t)(col - C_BIN) * S + rowb + 8 * hs;
                            *(f32x4*)bp = o0; *(f32x4*)(bp + 4) = o1;
                        } else if (kind == 3) {
                            u32x4 o = {pk2(tc[4 * hs], tc[4 * hs + 1]), pk2(tc[4 * hs + 2], tc[4 * hs + 3]), pk2(tc[8 + 4 * hs], tc[9 + 4 * hs]), pk2(tc[10 + 4 * hs], tc[11 + 4 * hs])};
                            *(u32x4*)(vtc + (size_t)(col - (C_CQKV + 2048)) * S + rowb + 8 * hs) = o;
                        } else if (colt < 3072) {
                            u32x4 o = {pk2(tc[8 * hs], tc[8 * hs + 1]), pk2(tc[8 * hs + 2], tc[8 * hs + 3]), pk2(tc[8 * hs + 4], tc[8 * hs + 5]), pk2(tc[8 * hs + 6], tc[8 * hs + 7])};
                            *(u32x4*)(vta + (size_t)(col - 2048) * S + rowb + 8 * hs) = o;
                        } else {
#pragma unroll
                            for (int k = 0; k < 2; ++k) { const int res = 2 * hs + k;
                                u32x2 o = {pk2(tc[res], tc[res + 4]), pk2(tc[res + 8], tc[res + 12])};
                                *(u32x2*)(vta + (size_t)(1024 + col - 3072 - 2048) * S + res * (S >> 2) + (rowb >> 2)) = o; }
                        }
                        __builtin_amdgcn_wave_barrier();
                    }
        }
    }
};
struct ProjOrder {
    pg8::StaticOrder so;
    DI bool next(int i, pg8::Unit& u) const { pg8::Unit b; if (!so.next(i / 3, b)) return false; const int nb = i % 3; u.pm = b.pm + 32 * nb; u.pn = b.pn + 8 * nb; return true; }
};
struct EpiProj {   static constexpr bool PERM = false;
    const bf16_t* proj; const float* mb; float* yf; bf16_t* yb;
    DI void operator()(const f32x4 (&acc)[2][2][4][2], const pg8::Unit& u, int wr, int wc, int fr, int fq) const {
        const int nb = u.pm >> 5;
        const int row0 = (u.pm & 31) * 256 + wr * 64 + fr, col0 = (u.pn & 7) * 256 + wc * 32 + 4 * fq;
        f32x4 b4[2][2];
#pragma unroll
        for (int bj = 0; bj < 2; ++bj)
#pragma unroll
            for (int n = 0; n < 2; ++n) b4[bj][n] = *(const f32x4*)(mb + nb * D + col0 + bj * 128 + n * 16);
#pragma unroll
        for (int ai = 0; ai < 2; ++ai)
#pragma unroll
            for (int mp = 0; mp < 2; ++mp) {
                u32x2 mg[2][2][2]; f32x4 yv[2][2][2];
#pragma unroll
                for (int mi = 0; mi < 2; ++mi) { const int row = row0 + ai * 128 + (2 * mp + mi) * 16;
#pragma unroll
                    for (int bj = 0; bj < 2; ++bj)
#pragma unroll
                        for (int n = 0; n < 2; ++n) { const int col = col0 + bj * 128 + n * 16;
                            mg[mi][bj][n] = *(const u32x2*)(proj + (size_t)row * NIN + C_MERGE + nb * D + col);
                            if (nb > 0) yv[mi][bj][n] = *(const f32x4*)(yf + (size_t)row * D + col); else yv[mi][bj][n] = (f32x4){0.f, 0.f, 0.f, 0.f}; } }
#pragma unroll
                for (int mi = 0; mi < 2; ++mi) { const int m = 2 * mp + mi; const int row = row0 + ai * 128 + m * 16;
#pragma unroll
                    for (int bj = 0; bj < 2; ++bj)
#pragma unroll
                        for (int n = 0; n < 2; ++n) { const int col = col0 + bj * 128 + n * 16; const f32x4 a = acc[ai][bj][m][n]; const u32x2 g2 = mg[mi][bj][n]; const f32x4 bb = b4[bj][n];
                            f32x4 v = yv[mi][bj][n];
                            v[0] += a[0] * sigm_f(bflo(g2[0]) + bb[0]); v[1] += a[1] * sigm_f(bfhi(g2[0]) + bb[1]);
                            v[2] += a[2] * sigm_f(bflo(g2[1]) + bb[2]); v[3] += a[3] * sigm_f(bfhi(g2[1]) + bb[3]);
                            if (nb < 2) *(f32x4*)(yf + (size_t)row * D + col) = v;
                            else { u32x2 o = {pk2(v[0], v[1]), pk2(v[2], v[3])}; *(u32x2*)(yb + (size_t)row * D + col) = o; } } }
            }
    }
};
struct EpiOut {   static constexpr bool PERM = false;
    const float* xold; float* xnew;
    DI void operator()(const f32x4 (&acc)[2][2][4][2], const pg8::Unit& u, int wr, int wc, int fr, int fq) const {
        const int row0 = u.pm * 256 + wr * 64 + fr, col0 = u.pn * 256 + wc * 32 + 4 * fq;
#pragma unroll
        for (int ai = 0; ai < 2; ++ai)
#pragma unroll
            for (int mp = 0; mp < 2; ++mp) {
                f32x4 xv[2][2][2];
#pragma unroll
                for (int mi = 0; mi < 2; ++mi)
#pragma unroll
                    for (int bj = 0; bj < 2; ++bj)
#pragma unroll
                        for (int n = 0; n < 2; ++n) xv[mi][bj][n] = *(const f32x4*)(xold + (size_t)(row0 + ai * 128 + (2 * mp + mi) * 16) * D + col0 + bj * 128 + n * 16);
#pragma unroll
                for (int mi = 0; mi < 2; ++mi)
#pragma unroll
                    for (int bj = 0; bj < 2; ++bj)
#pragma unroll
                        for (int n = 0; n < 2; ++n) *(f32x4*)(xnew + (size_t)(row0 + ai * 128 + (2 * mp + mi) * 16) * D + col0 + bj * 128 + n * 16) = xv[mi][bj][n] + acc[ai][bj][2 * mp + mi][n];
            }
    }
};
DI float wave_sum(float v) {
#pragma unroll
    for (int o = 1; o < 64; o <<= 1) v += __shfl_xor(v, o);
    return v;
}
DI int crow(int reg, int h) { return (reg & 3) + 8 * (reg >> 2) + 4 * h; }
DI bf16x8 pack8(const f32x16& x, const int s) {
    u32x4 p;
    p[0] = pk2(x[8 * s + 0], x[8 * s + 1]); p[1] = pk2(x[8 * s + 2], x[8 * s + 3]);
    p[2] = pk2(x[8 * s + 4], x[8 * s + 5]); p[3] = pk2(x[8 * s + 6], x[8 * s + 7]);
    return __builtin_bit_cast(bf16x8, p);
}
#define MFMA32(a, b, c) __builtin_amdgcn_mfma_f32_32x32x16_bf16((a), (b), (c), 0, 0, 0)

DI void transpose_item(const float* Wsrc, int K, int N, bf16_t* WT, LAS float* scr, int item, int lane) {
    const int nblk = N / 64, kb = item / nblk, nb = item % nblk, k0 = 64 * kb, n0 = 64 * nb;
    const int lr = lane >> 4, lc = (lane & 15) * 4;
    f32x4 v[16];
#pragma unroll
    for (int i = 0; i < 16; ++i) v[i] = *(const f32x4*)(Wsrc + (size_t)(k0 + 4 * i + lr) * N + n0 + lc);
#pragma unroll
    for (int i = 0; i < 16; ++i) { LAS float* d = scr + (4 * i + lr) * 65 + lc; d[0] = v[i][0]; d[1] = v[i][1]; d[2] = v[i][2]; d[3] = v[i][3]; }
    __builtin_amdgcn_wave_barrier();
    const int c = lane & 7;
#pragma unroll
    for (int j = 0; j < 8; ++j) { const int n = (lane >> 3) + 8 * j; const LAS float* s = scr + (8 * c) * 65 + n;
        u32x4 o; o[0] = pk2(s[0 * 65], s[1 * 65]); o[1] = pk2(s[2 * 65], s[3 * 65]); o[2] = pk2(s[4 * 65], s[5 * 65]); o[3] = pk2(s[6 * 65], s[7 * 65]);
        *(u32x4*)(WT + (size_t)(n0 + n) * K + k0 + 8 * c) = o; }
    __builtin_amdgcn_wave_barrier();
}
DI int t5_bucket(int rel) {
    const int ret = rel > 0 ? 16 : 0; const int n = rel < 0 ? -rel : rel;
    const float nf = (float)(n > 1 ? n : 1);
    int large = 8 + (int)(logf(nf / 8.0f) / 4.852030263919617f * 8.0f);
    large = large < 15 ? large : 15;
    return ret + (n < 8 ? n : large);
}
DI void phase_prologue(const Params& p, LAS unsigned char* lds) {
    const int tid = tidx(), wave = tid >> 6, lane = tid & 63;
    const int gw = blockIdx.x * NWAVES + wave, NGW = gridDim.x * NWAVES;
    LAS float* scr = (LAS float*)(lds + wave * 16640);
    bf16_t* win_t = (bf16_t*)(p.ws + WS_WIN); bf16_t* wpr_t = (bf16_t*)(p.ws + WS_WPR); bf16_t* wout_t = (bf16_t*)(p.ws + WS_WOUT);
    constexpr int IT_IN = (D / 64) * (NIN / 64), IT_PR = (1024 / 64) * (D / 64), IT_OUT = (D / 64) * (D / 64);
    constexpr int TOT = DEPTH * IT_IN + DEPTH * 3 * IT_PR + DEPTH * IT_OUT;
    for (int it = gw; it < TOT; it += NGW) {
        int r = it;
        if (r < DEPTH * IT_IN) { const int l = r / IT_IN; transpose_item(p.in[I_WIN] + (size_t)l * D * NIN, D, NIN, win_t + (size_t)l * NIN * D, scr, r % IT_IN, lane); continue; }
        r -= DEPTH * IT_IN;
        if (r < DEPTH * 3 * IT_PR) { const int l = r / IT_PR; transpose_item(p.in[I_WPROJ] + (size_t)l * 1024 * D, 1024, D, wpr_t + (size_t)l * D * 1024, scr, r % IT_PR, lane); continue; }
        r -= DEPTH * 3 * IT_PR;
        { const int l = r / IT_OUT; transpose_item(p.in[I_WOUT] + (size_t)l * D * D, D, D, wout_t + (size_t)l * D * D, scr, r % IT_OUT, lane); }
    }
    float* bias = (float*)(p.ws + WS_BIAS);
    for (int i = blockIdx.x * NTHR + tid; i < 32 * 2049; i += gridDim.x * NTHR) {
        const int hd = i / 2049, rel = (i % 2049) - 1024;
        bias[i] = p.in[I_RELB][t5_bucket(rel) * 32 + hd] * LOG2E;
    }
    __syncthreads();
    LAS float* zemb = (LAS float*)lds;
    LAS float* h1 = (LAS float*)(lds + 2048);
    float* hid2 = (float*)(p.ws + WS_HID2);
    for (int rb = blockIdx.x; rb < S / 8; rb += gridDim.x) {
        const int rl = tid >> 6, j = tid & 63, i = rb * 8 + rl;
        if (j < 33) {
            float z;
            if (j == 0) z = (float)i / 8191.0f;
            else { const int k = (j - 1) & 15; const float fb = 1e-4f + (float)k * ((15.0f - 1e-4f) / 15.0f); const float w = 6.283185307179586f * (float)i / 8192.0f; const float a = fb * w; z = (j <= 16) ? cosf(a) : -sinf(a); }
            zemb[rl * 36 + j] = z;
        }
        __syncthreads();
        for (int l = 0; l < DEPTH; ++l) {
            float a1 = p.in[I_HYB1][l * 64 + j];
            for (int e = 0; e < 33; ++e) a1 += zemb[rl * 36 + e] * p.in[I_HYW1][(l * 33 + e) * 64 + j];
            h1[rl * 64 + j] = sinf(p.in[I_HYFREQ][(l * 2 + 0) * 64 + j] * a1);
            __syncthreads();
            float a2 = p.in[I_HYB2][l * 64 + j];
            for (int e = 0; e < 64; ++e) a2 += h1[rl * 64 + e] * p.in[I_HYW2][(l * 64 + e) * 64 + j];
            hid2[((size_t)l * S + i) * 64 + j] = sinf(p.in[I_HYFREQ][(l * 2 + 1) * 64 + j] * a2);
            __syncthreads();
        }
    }
}


DI void split8(const f32x4 a, const f32x4 b, bf16x8& hi, bf16x8& lo) {
    u32x4 h, l2;
    h[0] = pk2(a[0], a[1]); h[1] = pk2(a[2], a[3]); h[2] = pk2(b[0], b[1]); h[3] = pk2(b[2], b[3]);
    l2[0] = pk2(a[0] - bflo(h[0]), a[1] - bfhi(h[0])); l2[1] = pk2(a[2] - bflo(h[1]), a[3] - bfhi(h[1]));
    l2[2] = pk2(b[0] - bflo(h[2]), b[1] - bfhi(h[2])); l2[3] = pk2(b[2] - bflo(h[3]), b[3] - bfhi(h[3]));
    hi = __builtin_bit_cast(bf16x8, h); lo = __builtin_bit_cast(bf16x8, l2);
}
DI void phase_tgen(const Params& p) {
    const int tid = tidx(), wave = tid >> 6, lane = tid & 63, r = lane & 31, hh = lane >> 5;
    float* tt = (float*)(p.ws + WS_TT);
    for (int it = blockIdx.x * NWAVES + wave; it < DEPTH * 128 * 4; it += gridDim.x * NWAVES) {
        const int l = it >> 9, cb = (it >> 2) & 127, rc = it & 3;
        const float* w3 = p.in[I_HYW3] + (size_t)l * 64 * 4096 + cb * 32 + r;
        bf16x8 ahi[4], alo[4];
#pragma unroll
        for (int ks = 0; ks < 4; ++ks) {
            f32x4 a, b;
#pragma unroll
            for (int j = 0; j < 4; ++j) { a[j] = w3[(size_t)(16 * ks + 8 * hh + j) * 4096]; b[j] = w3[(size_t)(16 * ks + 8 * hh + 4 + j) * 4096]; }
            split8(a, b, ahi[ks], alo[ks]);
        }
        const float* hid2 = (const float*)(p.ws + WS_HID2) + (size_t)l * S * 64;
        f32x4 ha[4], hb[4];
        { const float* hr = hid2 + (size_t)(rc * 2048 + r) * 64 + 8 * hh;
#pragma unroll
          for (int ks = 0; ks < 4; ++ks) { ha[ks] = *(const f32x4*)(hr + 16 * ks); hb[ks] = *(const f32x4*)(hr + 16 * ks + 4); } }
#pragma unroll 1
        for (int rb = 0; rb < 64; ++rb) {
            const int i0 = rc * 2048 + rb * 32;
            bf16x8 bhi[4], blo[4];
#pragma unroll
            for (int ks = 0; ks < 4; ++ks) split8(ha[ks], hb[ks], bhi[ks], blo[ks]);
            if (rb + 1 < 64) { const float* hr = hid2 + (size_t)(i0 + 32 + r) * 64 + 8 * hh;
#pragma unroll
                for (int ks = 0; ks < 4; ++ks) { ha[ks] = *(const f32x4*)(hr + 16 * ks); hb[ks] = *(const f32x4*)(hr + 16 * ks + 4); } }
            f32x16 acc;
#pragma unroll
            for (int i = 0; i < 16; ++i) acc[i] = 0.f;
#pragma unroll
            for (int ks = 0; ks < 4; ++ks) { acc = MFMA32(ahi[ks], bhi[ks], acc); acc = MFMA32(ahi[ks], blo[ks], acc); acc = MFMA32(alo[ks], bhi[ks], acc); }
            float* tp = tt + ((size_t)l * 4096 + cb * 32) * S + i0 + r;
#pragma unroll
            for (int reg = 0; reg < 16; ++reg) tp[(size_t)crow(reg, hh) * S] = acc[reg];
        }
    }
}

#define XI(i) ((i) + ((i) >> 4) + ((i) >> 8))
DI cf cmul(cf a, cf b) {
    cf t, r;
    asm("v_pk_mul_f32 %0, %1, %2 op_sel:[0,0] op_sel_hi:[0,1]" : "=v"(t) : "v"(a), "v"(b));
    asm("v_pk_fma_f32 %0, %1, %2, %3 op_sel:[1,1,0] op_sel_hi:[1,0,1] neg_lo:[0,1,0]" : "=v"(r) : "v"(a), "v"(b), "v"(t));
    return r;
}
DI cf twid(float frac) { float c = __builtin_amdgcn_cosf(frac), s = __builtin_amdgcn_sinf(frac); asm volatile("s_nop 1" : "+v"(c), "+v"(s)); return (cf){c, -s}; }
DI cf twidc(float frac) { float c = __builtin_amdgcn_cosf(frac), s = __builtin_amdgcn_sinf(frac); asm volatile("s_nop 1" : "+v"(c), "+v"(s)); return (cf){c, s}; }
DI void fwd4(cf& a0, cf& a1, cf& a2, cf& a3) {
    const cf s02 = a0 + a2, d02 = a0 - a2, s13 = a1 + a3, d13 = a1 - a3;
    a0 = s02 + s13; a2 = s02 - s13;
    a1 = (cf){d02.x + d13.y, d02.y - d13.x};
    a3 = (cf){d02.x - d13.y, d02.y + d13.x};
}
DI void inv4(cf& b0, cf& b1, cf& b2, cf& b3) {
    const cf s02 = b0 + b2, d02 = b0 - b2, s13 = b1 + b3, d13 = b1 - b3;
    b0 = s02 + s13; b2 = s02 - s13;
    b1 = (cf){d02.x - d13.y, d02.y + d13.x};
    b3 = (cf){d02.x + d13.y, d02.y - d13.x};
}
template <int LOGM> DI void fwd_r4_pass(LAS cf* X, int tid) {
    asm volatile("" : "+v"(tid));
    constexpr int M = 1 << LOGM, q = M >> 2;
#pragma unroll 2
    for (int t = tid; t < 4096; t += NTHR) {
        const int j = t & (q - 1), base = (t >> (LOGM - 2)) * M + j;
        constexpr int QP = (q >= 256) ? (q + (q >> 4) + (q >> 8)) : ((q == 16) ? 17 : 1);
        LAS cf* xp = X + XI(base);
        cf a0 = xp[0], a1 = xp[QP], a2 = xp[2 * QP], a3 = xp[3 * QP];
        fwd4(a0, a1, a2, a3);
        const cf w1 = twid((float)j * (1.0f / M)), w2 = cmul(w1, w1), w3 = cmul(w2, w1);
        xp[0] = a0; xp[QP] = cmul(a1, w1); xp[2 * QP] = cmul(a2, w2); xp[3 * QP] = cmul(a3, w3);
    }
}
template <int LOGM> DI void inv_r4_pass(LAS cf* X, int tid) {
    asm volatile("" : "+v"(tid));
    constexpr int M = 1 << LOGM, q = M >> 2;
#pragma unroll 2
    for (int t = tid; t < 4096; t += NTHR) {
        const int j = t & (q - 1), base = (t >> (LOGM - 2)) * M + j;
        const cf w1 = twidc((float)j * (1.0f / M)), w2 = cmul(w1, w1), w3 = cmul(w2, w1);
        constexpr int QP = (q >= 256) ? (q + (q >> 4) + (q >> 8)) : ((q == 16) ? 17 : 1);
        LAS cf* xp = X + XI(base);
        cf b0 = xp[0], b1 = cmul(xp[QP], w1), b2 = cmul(xp[2 * QP], w2), b3 = cmul(xp[3 * QP], w3);
        inv4(b0, b1, b2, b3);
        xp[0] = b0; xp[QP] = b1; xp[2 * QP] = b2; xp[3 * QP] = b3;
    }
}
template <int LOGM> DI void fwd16(cf (&v)[16], int j) {
    constexpr int M = 1 << LOGM, q = M >> 4;
#pragma unroll
    for (int n = 0; n < 4; ++n) {
        fwd4(v[n], v[n + 4], v[n + 8], v[n + 12]);
        const cf w1 = twid((float)(j + n * q) * (1.0f / M)), w2 = cmul(w1, w1), w3 = cmul(w2, w1);
        v[n + 4] = cmul(v[n + 4], w1); v[n + 8] = cmul(v[n + 8], w2); v[n + 12] = cmul(v[n + 12], w3);
    }
    const cf u1 = twid((float)j * (4.0f / M)), u2 = cmul(u1, u1), u3 = cmul(u2, u1);
#pragma unroll
    for (int m = 0; m < 4; ++m) {
        fwd4(v[4 * m], v[4 * m + 1], v[4 * m + 2], v[4 * m + 3]);
        v[4 * m + 1] = cmul(v[4 * m + 1], u1); v[4 * m + 2] = cmul(v[4 * m + 2], u2); v[4 * m + 3] = cmul(v[4 * m + 3], u3);
    }
}
template <int LOGM> DI void inv16(cf (&v)[16], int j) {
    constexpr int M = 1 << LOGM, q = M >> 4;
    const cf u1 = twidc((float)j * (4.0f / M)), u2 = cmul(u1, u1), u3 = cmul(u2, u1);
#pragma unroll
    for (int m = 0; m < 4; ++m) {
        v[4 * m + 1] = cmul(v[4 * m + 1], u1); v[4 * m + 2] = cmul(v[4 * m + 2], u2); v[4 * m + 3] = cmul(v[4 * m + 3], u3);
        inv4(v[4 * m], v[4 * m + 1], v[4 * m + 2], v[4 * m + 3]);
    }
#pragma unroll
    for (int n = 0; n < 4; ++n) {
        const cf w1 = twidc((float)(j + n * q) * (1.0f / M)), w2 = cmul(w1, w1), w3 = cmul(w2, w1);
        v[n + 4] = cmul(v[n + 4], w1); v[n + 8] = cmul(v[n + 8], w2); v[n + 12] = cmul(v[n + 12], w3);
        inv4(v[n], v[n + 4], v[n + 8], v[n + 12]);
    }
}
template <int LOGM> DI void fwd_r16_pass(LAS cf* X, int tid) {
    asm volatile("" : "+v"(tid));
    constexpr int M = 1 << LOGM, q = M >> 4;
#pragma unroll 1
    for (int t = tid; t < 1024; t += NTHR) {
        const int j = t & (q - 1), base = (t >> (LOGM - 4)) * M + j;
        constexpr int QP = (q >= 256) ? (q + (q >> 4) + (q >> 8)) : ((q == 16) ? 17 : 1);
        LAS cf* xp = X + XI(base);
        cf v[16];
#pragma unroll
        for (int n = 0; n < 16; ++n) v[n] = xp[n * QP];
        fwd16<LOGM>(v, j);
#pragma unroll
        for (int n = 0; n < 16; ++n) xp[n * QP] = v[n];
    }
}
template <int LOGM> DI void inv_r16_pass(LAS cf* X, int tid) {
    asm volatile("" : "+v"(tid));
    constexpr int M = 1 << LOGM, q = M >> 4;
#pragma unroll 1
    for (int t = tid; t < 1024; t += NTHR) {
        const int j = t & (q - 1), base = (t >> (LOGM - 4)) * M + j;
        constexpr int QP = (q >= 256) ? (q + (q >> 4) + (q >> 8)) : ((q == 16) ? 17 : 1);
        LAS cf* xp = X + XI(base);
        cf v[16];
#pragma unroll
        for (int n = 0; n < 16; ++n) v[n] = xp[n * QP];
        inv16<LOGM>(v, j);
#pragma unroll
        for (int n = 0; n < 16; ++n) xp[n * QP] = v[n];
    }
}
DI int rev4(int pp) { const unsigned br = __brev((unsigned)pp) >> 18; return (int)(((br & 0x2AAAu) >> 1) | ((br & 0x1555u) << 1)); }
DI void fft_forward(LAS cf* X, int tid) {
    fwd_r4_pass<14>(X, tid); __syncthreads();
    fwd_r16_pass<12>(X, tid); __syncthreads();
    fwd_r16_pass<8>(X, tid); __syncthreads();
    fwd_r16_pass<4>(X, tid); __syncthreads();
}
constexpr int SPEC_STRIDE = 8208;
DI void fft_conv(LAS cf* X, const f32x4* spec, int tid) {
    fft_forward(X, tid);
#pragma unroll 8
    for (int r = 0; r < 16; ++r) {
        const int k = tid + NTHR * r; const int pp = rev4(k);
        const f32x4 sp = spec[k]; const cf P = (cf){sp[0], sp[1]}, Mq = (cf){sp[2], sp[3]};
        const cf z = X[XI(pp)];
        if (k == 0) { X[XI(pp)] = cmul(z, P) + cmul((cf){z.x, -z.y}, Mq); }
        else { const int pm = rev4(16384 - k); const cf zm = X[XI(pm)];
            const cf y = cmul(z, P) + cmul((cf){zm.x, -zm.y}, Mq);
            const cf t = cmul((cf){zm.x, -zm.y}, P) + cmul(z, Mq);
            X[XI(pp)] = y; X[XI(pm)] = (cf){t.x, -t.y}; }
    }
    if (tid == 0) { const int pp = rev4(8192); const f32x4 sp = spec[8192]; const cf z = X[XI(pp)]; X[XI(pp)] = cmul(z, (cf){sp[0], sp[1]}) + cmul((cf){z.x, -z.y}, (cf){sp[2], sp[3]}); }
    __syncthreads();
    inv_r16_pass<4>(X, tid); __syncthreads();
    inv_r16_pass<8>(X, tid); __syncthreads();
    inv_r16_pass<12>(X, tid); __syncthreads();
    inv_r4_pass<14>(X, tid); __syncthreads();
}


typedef _Float16 hc __attribute__((ext_vector_type(2)));
DI hc hcmul(hc a, hc b) { hc t, r;
    asm("v_pk_mul_f16 %0, %1, %2 op_sel:[0,0] op_sel_hi:[0,1]" : "=v"(t) : "v"(a), "v"(b));
    asm("v_pk_fma_f16 %0, %1, %2, %3 op_sel:[1,1,0] op_sel_hi:[1,0,1] neg_lo:[0,1,0]" : "=v"(r) : "v"(a), "v"(b), "v"(t)); return r; }
DI hc hadd_mi(hc a, hc b) { hc r; asm("v_pk_add_f16 %0, %1, %2 op_sel:[0,1] op_sel_hi:[1,0] neg_hi:[0,1]" : "=v"(r) : "v"(a), "v"(b)); return r; }
DI hc hadd_pi(hc a, hc b) { hc r; asm("v_pk_add_f16 %0, %1, %2 op_sel:[0,1] op_sel_hi:[1,0] neg_lo:[0,1]" : "=v"(r) : "v"(a), "v"(b)); return r; }
DI hc htwid(float frac) { float c = __builtin_amdgcn_cosf(frac), s = __builtin_amdgcn_sinf(frac); asm volatile("s_nop 1" : "+v"(c), "+v"(s)); return (hc){(_Float16)c, (_Float16)(-s)}; }
DI hc htwidc(float frac) { float c = __builtin_amdgcn_cosf(frac), s = __builtin_amdgcn_sinf(frac); asm volatile("s_nop 1" : "+v"(c), "+v"(s)); return (hc){(_Float16)c, (_Float16)s}; }
DI void hfwd4(hc& a0, hc& a1, hc& a2, hc& a3) {
    const hc s02 = a0 + a2, d02 = a0 - a2, s13 = a1 + a3, d13 = a1 - a3;
    a0 = s02 + s13; a2 = s02 - s13; a1 = hadd_mi(d02, d13); a3 = hadd_pi(d02, d13);
}
DI void hinv4(hc& b0, hc& b1, hc& b2, hc& b3) {
    const hc s02 = b0 + b2, d02 = b0 - b2, s13 = b1 + b3, d13 = b1 - b3;
    b0 = s02 + s13; b2 = s02 - s13; b1 = hadd_pi(d02, d13); b3 = hadd_mi(d02, d13);
}
template <int LOGM> DI void hfwd_r4_pass(LAS hc* X, int tid) {
    asm volatile("" : "+v"(tid));
    constexpr int M = 1 << LOGM, q = M >> 2;
#pragma unroll 8
    for (int t = tid; t < 4096; t += NTHR) {
        const int j = t & (q - 1), base = (t >> (LOGM - 2)) * M + j;
        constexpr int QP = (q >= 256) ? (q + (q >> 4) + (q >> 8)) : ((q == 16) ? 17 : 1);
        LAS hc* xp = X + XI(base);
        hc a0 = xp[0], a1 = xp[QP], a2 = xp[2 * QP], a3 = xp[3 * QP];
        hfwd4(a0, a1, a2, a3);
        const hc w1 = htwid((float)j * (1.0f / M)), w2 = hcmul(w1, w1), w3 = hcmul(w2, w1);
        xp[0] = a0; xp[QP] = hcmul(a1, w1); xp[2 * QP] = hcmul(a2, w2); xp[3 * QP] = hcmul(a3, w3);
    }
}
template <int LOGM> DI void hinv_r4_pass(LAS hc* X, int tid) {
    asm volatile("" : "+v"(tid));
    constexpr int M = 1 << LOGM, q = M >> 2;
#pragma unroll 8
    for (int t = tid; t < 4096; t += NTHR) {
        const int j = t & (q - 1), base = (t >> (LOGM - 2)) * M + j;
        const hc w1 = htwidc((float)j * (1.0f / M)), w2 = hcmul(w1, w1), w3 = hcmul(w2, w1);
        constexpr int QP = (q >= 256) ? (q + (q >> 4) + (q >> 8)) : ((q == 16) ? 17 : 1);
        LAS hc* xp = X + XI(base);
        hc b0 = xp[0], b1 = hcmul(xp[QP], w1), b2 = hcmul(xp[2 * QP], w2), b3 = hcmul(xp[3 * QP], w3);
        hinv4(b0, b1, b2, b3);
        xp[0] = b0; xp[QP] = b1; xp[2 * QP] = b2; xp[3 * QP] = b3;
    }
}
template <int LOGM> DI void hfwd16(hc (&v)[16], int j) {
    constexpr int M = 1 << LOGM, q = M >> 4;
#pragma unroll
    for (int n = 0; n < 4; ++n) {
        hfwd4(v[n], v[n + 4], v[n + 8], v[n + 12]);
        const hc w1 = htwid((float)(j + n * q) * (1.0f / M)), w2 = hcmul(w1, w1), w3 = hcmul(w2, w1);
        v[n + 4] = hcmul(v[n + 4], w1); v[n + 8] = hcmul(v[n + 8], w2); v[n + 12] = hcmul(v[n + 12], w3);
    }
    const hc u1 = htwid((float)j * (4.0f / M)), u2 = hcmul(u1, u1), u3 = hcmul(u2, u1);
#pragma unroll
    for (int m = 0; m < 4; ++m) {
        hfwd4(v[4 * m], v[4 * m + 1], v[4 * m + 2], v[4 * m + 3]);
        v[4 * m + 1] = hcmul(v[4 * m + 1], u1); v[4 * m + 2] = hcmul(v[4 * m + 2], u2); v[4 * m + 3] = hcmul(v[4 * m + 3], u3);
    }
}
template <int LOGM> DI void hinv16(hc (&v)[16], int j) {
    constexpr int M = 1 << LOGM, q = M >> 4;
    const hc u1 = htwidc((float)j * (4.0f / M)), u2 = hcmul(u1, u1), u3 = hcmul(u2, u1);
#pragma unroll
    for (int m = 0; m < 4; ++m) {
        v[4 * m + 1] = hcmul(v[4 * m + 1], u1); v[4 * m + 2] = hcmul(v[4 * m + 2], u2); v[4 * m + 3] = hcmul(v[4 * m + 3], u3);
        hinv4(v[4 * m], v[4 * m + 1], v[4 * m + 2], v[4 * m + 3]);
    }
#pragma unroll
    for (int n = 0; n < 4; ++n) {
        const hc w1 = htwidc((float)(j + n * q) * (1.0f / M)), w2 = hcmul(w1, w1), w3 = hcmul(w2, w1);
        v[n + 4] = hcmul(v[n + 4], w1); v[n + 8] = hcmul(v[n + 8], w2); v[n + 12] = hcmul(v[n + 12], w3);
        hinv4(v[n], v[n + 4], v[n + 8], v[n + 12]);
    }
}
template <int LOGM, bool FWD> DI void h_r16_pass(LAS hc* X, int tid) {
    asm volatile("" : "+v"(tid));
    constexpr int M = 1 << LOGM, q = M >> 4;
#pragma unroll
    for (int t = tid; t < 1024; t += NTHR) {
        const int j = t & (q - 1), base = (t >> (LOGM - 4)) * M + j;
        constexpr int QP = (q >= 256) ? (q + (q >> 4) + (q >> 8)) : ((q == 16) ? 17 : 1);
        LAS hc* xp = X + XI(base);
        hc v[16];
#pragma unroll
        for (int n = 0; n < 16; ++n) v[n] = xp[n * QP];
        if (FWD) hfwd16<LOGM>(v, j); else hinv16<LOGM>(v, j);
#pragma unroll
        for (int n = 0; n < 16; ++n) xp[n * QP] = v[n];
    }
}
DI void fft_conv_h(LAS hc* X, const f32x4* spec, int tid) {
    hfwd_r4_pass<14>(X, tid); __syncthreads();
    h_r16_pass<12, true>(X, tid); __syncthreads();
    h_r16_pass<8, true>(X, tid); __syncthreads();
    h_r16_pass<4, true>(X, tid); __syncthreads();
#pragma unroll 8
    for (int r = 0; r < 16; ++r) {
        const int k = tid + NTHR * r; const int pp = rev4(k);
        const f32x4 sp = spec[k]; const cf P = (cf){sp[0], sp[1]} * 256.0f, Mq = (cf){sp[2], sp[3]} * 256.0f;
        const hc zh = X[XI(pp)]; const cf z = (cf){(float)zh.x, (float)zh.y};
        if (k == 0) { const cf y = cmul(z, P) + cmul((cf){z.x, -z.y}, Mq); X[XI(pp)] = (hc){(_Float16)y.x, (_Float16)y.y}; }
        else { const int pm = rev4(16384 - k); const hc zmh = X[XI(pm)]; const cf zm = (cf){(float)zmh.x, (float)zmh.y};
            const cf y = cmul(z, P) + cmul((cf){zm.x, -zm.y}, Mq);
            const cf t = cmul((cf){zm.x, -zm.y}, P) + cmul(z, Mq);
            X[XI(pp)] = (hc){(_Float16)y.x, (_Float16)y.y}; X[XI(pm)] = (hc){(_Float16)t.x, (_Float16)(-t.y)}; }
    }
    if (tid == 0) { const int pp = rev4(8192); const f32x4 sp = spec[8192]; const hc zh = X[XI(pp)]; const cf z = (cf){(float)zh.x, (float)zh.y};
        const cf y = (cmul(z, (cf){sp[0], sp[1]}) + cmul((cf){z.x, -z.y}, (cf){sp[2], sp[3]})) * 256.0f; X[XI(pp)] = (hc){(_Float16)y.x, (_Float16)y.y}; }
    __syncthreads();
    h_r16_pass<4, false>(X, tid); __syncthreads();
    h_r16_pass<8, false>(X, tid); __syncthreads();
    h_r16_pass<12, false>(X, tid); __syncthreads();
    hinv_r4_pass<14>(X, tid); __syncthreads();
}

DI void spectra_item(const Params& p, int item, LAS unsigned char* lds) {
    int tid = tidx(); asm volatile("" : "+v"(tid));
    const int l = item >> 10, o = (item >> 9) & 1, pr = item & 511, a = 2 * pr;
    LAS cf* X = (LAS cf*)lds; LAS float* aux = (LAS float*)(lds + LDS_MAIN);
    const float mind = -3.0701134573253943f, maxd = -15.350567286626972f;
    const float da = fabsf(mind + (float)a * ((maxd - mind) / 1023.0f)), db = fabsf(mind + (float)(a + 1) * ((maxd - mind) / 1023.0f));
    const float ska = p.in[I_HYSKIP][(l * 2 + o) * 1024 + a], skb = p.in[I_HYSKIP][(l * 2 + o) * 1024 + a + 1];
    const float* tf = (const float*)(p.ws + WS_TT) + ((size_t)l * 4096 + (o * 2 + 0) * 1024 + a) * S;
    const float* tb = (const float*)(p.ws + WS_TT) + ((size_t)l * 4096 + (o * 2 + 1) * 1024 + a) * S;
#pragma unroll 16
    for (int rr = 0; rr < 16; ++rr) {
        const int i = tid + NTHR * rr;
        const float ti = (float)i / 8191.0f; const float ea = __expf(-ti * da), eb = __expf(-ti * db);
        const float fa = tf[i] * ea, fb = tf[S + i] * eb, ba = tb[i] * ea, bb = tb[S + i] * eb;
        if (i == 0) { X[XI(0)] = (cf){fa + ba + ska, fb + bb + skb}; X[XI(8192)] = (cf){0.f, 0.f}; }
        else { X[XI(i)] = (cf){fa, fb}; X[XI(16384 - i)] = (cf){ba, bb}; }
    }
    __syncthreads();
    fft_forward(X, tid);
    f32x4* spec = (f32x4*)(p.ws + WS_SPEC) + (size_t)item * SPEC_STRIDE;
    const float sc = 0.5f / 16384.0f;
    for (int r = 0; r < 17; ++r) {
        const int k = tid + NTHR * r; if (k > 8192) break;
        const cf F = X[XI(rev4(k))], Fm = X[XI(rev4((16384 - k) & 16383))];
        const cf Fc = (cf){Fm.x, -Fm.y};
        const cf Ha = (F + Fc) * 0.5f, tt = (F - Fc) * 0.5f; const cf Hb = (cf){tt.y, -tt.x};
        const cf P = (Ha + Hb) * sc, Mq = (Ha - Hb) * sc;
        spec[k] = (f32x4){P.x, P.y, Mq.x, Mq.y};
    }
    __syncthreads();
}

DI float conv3(const float* row, int t, float w0, float w1, float w2) {
    const float c = row[t]; float pv = row[t > 0 ? t - 1 : 0], nx = row[t < S - 1 ? t + 1 : S - 1];
    pv = t > 0 ? pv : 0.f; nx = t < S - 1 ? nx : 0.f;
    return w0 * pv + w1 * c + w2 * nx;
}
DI void hyena_item(const Params& p, int l, int pr, LAS unsigned char* lds) {
    int tid = tidx(); asm volatile("" : "+v"(tid)); const int a = 2 * pr;
    LAS hc* X = (LAS hc*)lds;
    const float* bint = (const float*)(p.ws + WS_BINT);
    const float* cw = p.in[I_HYCONV] + (size_t)l * 3 * 3072;
    float w[3][2][3];
#pragma unroll
    for (int wh = 0; wh < 3; ++wh)
#pragma unroll
        for (int c = 0; c < 2; ++c)
#pragma unroll
            for (int k = 0; k < 3; ++k) w[wh][c][k] = cw[k * 3072 + wh * 1024 + a + c];
    const f32x4* spec = (const f32x4*)(p.ws + WS_SPEC);
    const hc hzero = (hc){(_Float16)0.f, (_Float16)0.f};
#pragma unroll 8
    for (int r = 0; r < 16; ++r) { const int t = tid + NTHR * r;
        const float va = conv3(bint + (size_t)a * S, t, w[0][0][0], w[0][0][1], w[0][0][2]), vb = conv3(bint + (size_t)(a + 1) * S, t, w[0][1][0], w[0][1][1], w[0][1][2]);
        X[XI(t)] = (hc){(_Float16)(va * 0.25f), (_Float16)(vb * 0.25f)};
        X[XI(t + 8192)] = hzero; }
    __syncthreads();
    fft_conv_h(X, spec + (size_t)((l * 2 + 0) * 512 + pr) * SPEC_STRIDE, tid);
#pragma unroll 8
    for (int r = 0; r < 16; ++r) { const int t = tid + NTHR * r; const hc y = X[XI(t)];
        const float za = (float)y.x * (1.0f / 64.0f) * conv3(bint + (size_t)(1024 + a) * S, t, w[1][0][0], w[1][0][1], w[1][0][2]);
        const float zb = (float)y.y * (1.0f / 64.0f) * conv3(bint + (size_t)(1024 + a + 1) * S, t, w[1][1][0], w[1][1][1], w[1][1][2]);
        X[XI(t)] = (hc){(_Float16)(za * 0.25f), (_Float16)(zb * 0.25f)};
        X[XI(t + 8192)] = hzero; }
    __syncthreads();
    fft_conv_h(X, spec + (size_t)((l * 2 + 1) * 512 + pr) * SPEC_STRIDE, tid);
    float* z2t = (float*)(p.ws + WS_Z2T);
#pragma unroll 8
    for (int r = 0; r < 16; ++r) { const int t = tid + NTHR * r; const hc y = X[XI(t)];
        z2t[(size_t)a * S + t] = (float)y.x * (1.0f / 64.0f) * conv3(bint + (size_t)(2048 + a) * S, t, w[2][0][0], w[2][0][1], w[2][0][2]);
        z2t[(size_t)(a + 1) * S + t] = (float)y.y * (1.0f / 64.0f) * conv3(bint + (size_t)(2048 + a + 1) * S, t, w[2][1][0], w[2][1][1], w[2][1][2]); }
    __syncthreads();
}
DI void phase_rmsnorm(const float* x, const float* g, bf16_t* hout, float* fout) {
    const int tid = tidx(), wave = tid >> 6, lane = tid & 63;
    for (int row = blockIdx.x * NWAVES + wave; row < S; row += gridDim.x * NWAVES) {
        const f32x4* xr = (const f32x4*)(x + (size_t)row * D) + lane;
        f32x4 v[8]; float s = 0.f;
#pragma unroll
        for (int j = 0; j < 8; ++j) { v[j] = xr[64 * j]; s += (v[j][0] * v[j][0] + v[j][1] * v[j][1]) + (v[j][2] * v[j][2] + v[j][3] * v[j][3]); }
        const float rstd = rsqrtf(wave_sum(s) * (1.0f / D) + 1e-6f);
#pragma unroll
        for (int j = 0; j < 8; ++j) { const f32x4 gg = ((const f32x4*)g)[lane + 64 * j]; const f32x4 y = v[j] * rstd * gg;
            if (hout) { u32x2 o = {pk2(y[0], y[1]), pk2(y[2], y[3])}; ((u32x2*)(hout + (size_t)row * D))[lane + 64 * j] = o; }
            else ((f32x4*)(fout + (size_t)row * D))[lane + 64 * j] = y; }
    }
}

constexpr int KROW = 144, KBUF = 64 * KROW, VBUF = 128 * KROW;
DI void qk_half(const LAS unsigned char* kb_, const bf16x8 (&qf)[4], int r, int hh, f32x16& s) {
#pragma unroll
    for (int i = 0; i < 16; ++i) s[i] = 0.f;
#pragma unroll
    for (int ks = 0; ks < 4; ++ks) { const bf16x8 a = *(const LAS bf16x8*)(kb_ + r * KROW + 32 * ks + 16 * hh); s = MFMA32(a, qf[ks], s); }
}
DI void softmax_pv_half(f32x16& s, const LAS unsigned char* vb_, const LAS float* btab, int k0, int q0w, int r, int hh, float cs, float& m, float& lsum, f32x16 (&O)[4]) {
    const int q = q0w + r;
    const int relmin = k0 - q0w - 31, relmax = k0 + 31 - q0w;
    const bool far = (relmin >= 1024 || relmax <= -1024);
    float bc = 0.f, csx = cs;
    if (far) { bc = btab[relmin >= 1024 ? 2048 : 0]; }
    else {
        if (relmin >= -1024 && relmax <= 1024) {
            const LAS float* bp = btab + (k0 - q + 1024 + 4 * hh);
#pragma unroll
            for (int i = 0; i < 16; ++i) s[i] = s[i] * cs + bp[(i & 3) + 8 * (i >> 2)];
        } else {
#pragma unroll
            for (int i = 0; i < 16; ++i) { const int rel = k0 + crow(i, hh) - q; const int i0 = min(max(rel, -1024), 1024) + 1024; s[i] = s[i] * cs + btab[i0]; }
        }
        csx = 1.0f;
    }
    float mx = s[0];
#pragma unroll
    for (int i = 1; i < 16; ++i) mx = fmaxf(mx, s[i]);
    mx = mx * csx + bc;
    mx = fmaxf(mx, __shfl_xor(mx, 32));
    if (__any(mx > m + 8.0f)) {
        const float mnew = fmaxf(m, mx), alpha = __builtin_amdgcn_exp2f(m - mnew);
        m = mnew; lsum *= alpha;
#pragma unroll
        for (int db = 0; db < 4; ++db) O[db] *= alpha;
    }
    const float c2 = bc - m;
    float rs0 = 0.f, rs1 = 0.f;
#pragma unroll
    for (int i = 0; i < 16; i += 2) { s[i] = __builtin_amdgcn_exp2f(s[i] * csx + c2); s[i + 1] = __builtin_amdgcn_exp2f(s[i + 1] * csx + c2); rs0 += s[i]; rs1 += s[i + 1]; }
    lsum += rs0 + rs1;
#pragma unroll
    for (int ss = 0; ss < 2; ++ss) {
        const bf16x8 pf = pack8(s, ss);
#pragma unroll
        for (int db = 0; db < 4; ++db) {
            const bf16x8 vf = *(const LAS bf16x8*)(vb_ + (32 * db + r) * KROW + (16 * ss + 8 * hh) * 2);
            O[db] = MFMA32(vf, pf, O[db]);
        }
    }
}
DI void diff_flash(const bf16_t* proj, const bf16_t* vtc, int h, int c, int q0w, LAS unsigned char* lds, const LAS float* btab, f32x16 (&O)[4]) {
    int tid = tidx(); asm volatile("" : "+v"(tid)); const int lane = tid & 63, r = lane & 31, hh = lane >> 5;
    constexpr int NT = S / 64;
    bf16x8 qf[4];
    { const bf16_t* qp = proj + (size_t)(q0w + r) * NIN + C_CQKV + h * 128 + c * 64 + 8 * hh;
#pragma unroll
      for (int ks = 0; ks < 4; ++ks) qf[ks] = *(const bf16x8*)(qp + 16 * ks); }
#pragma unroll
    for (int db = 0; db < 4; ++db)
#pragma unroll
        for (int i = 0; i < 16; ++i) O[db][i] = 0.f;
    float m = -1e30f, lsum = 0.f;
    const float cs = 0.125f * LOG2E;
    const bf16_t* kg = proj + C_CQKV + 1024 + h * 128 + c * 64 + (size_t)(tid >> 3) * NIN + (tid & 7) * 8;
    const bf16_t* vg = vtc + (size_t)(h * 128 + (tid >> 3)) * S + (tid & 7) * 8;
    const int kst = (tid >> 3) * KROW + (tid & 7) * 16;
    LAS unsigned char* Kb = lds; LAS unsigned char* Vb = lds + 3 * KBUF;
    u32x4 kr = *(const u32x4*)kg, v0 = *(const u32x4*)vg, v1 = *(const u32x4*)(vg + (size_t)64 * S);
    __syncthreads();
    *(LAS u32x4*)(Kb + kst) = kr; *(LAS u32x4*)(Vb + kst) = v0; *(LAS u32x4*)(Vb + 64 * KROW + kst) = v1;
    kr = *(const u32x4*)(kg + (size_t)64 * NIN);
    *(LAS u32x4*)(Kb + KBUF + kst) = kr;
    __syncthreads();
    f32x16 sA, sB;
    qk_half(Kb, qf, r, hh, sA);
    int kc = 0, kn = KBUF, kw = 2 * KBUF;
#pragma unroll 1
    for (int t = 0; t < NT; ++t) {
        if (t + 2 < NT) kr = *(const u32x4*)(kg + (size_t)(t + 2) * 64 * NIN);
        if (t + 1 < NT) { v0 = *(const u32x4*)(vg + (t + 1) * 64); v1 = *(const u32x4*)(vg + (size_t)64 * S + (t + 1) * 64); }
        const LAS unsigned char* vb_ = Vb + (t & 1) * VBUF;
        qk_half(Kb + kc + 32 * KROW, qf, r, hh, sB);
        softmax_pv_half(sA, vb_, btab, t * 64, q0w, r, hh, cs, m, lsum, O);
        if (t + 1 < NT) qk_half(Kb + kn, qf, r, hh, sA);
        softmax_pv_half(sB, vb_ + 64, btab, t * 64 + 32, q0w, r, hh, cs, m, lsum, O);
        if (t + 2 < NT) *(LAS u32x4*)(Kb + kw + kst) = kr;
        if (t + 1 < NT) { LAS unsigned char* vn = Vb + ((t + 1) & 1) * VBUF; *(LAS u32x4*)(vn + kst) = v0; *(LAS u32x4*)(vn + 64 * KROW + kst) = v1; }
        __syncthreads();
        const int tmp = kc; kc = kn; kn = kw; kw = tmp;
    }
    const float lt = lsum + __shfl_xor(lsum, 32), inv = 1.0f / lt;
#pragma unroll
    for (int db = 0; db < 4; ++db) O[db] *= inv;
}
DI void diffattn_item(const Params& p, int l, int item, LAS unsigned char* lds) {
    int tid = tidx(); asm volatile("" : "+v"(tid)); const int wave = __builtin_amdgcn_readfirstlane(tid >> 6), lane = tid & 63, r = lane & 31, hh = lane >> 5;
    const int qt = item >> 3, h = item & 7, q0w = qt * 256 + wave * 32;
    LAS float* btab = (LAS float*)(lds + LDS_MAIN);
    const float* bias = (const float*)(p.ws + WS_BIAS) + (24 + h) * 2049;
    for (int i = tid; i < 2049; i += NTHR) btab[i] = bias[i];
    const float* dl = p.in[I_DLAM] + l * 256;
    float d01 = 0.f, d23 = 0.f;
    for (int i = 0; i < 64; ++i) { d01 += dl[i] * dl[64 + i]; d23 += dl[128 + i] * dl[192 + i]; }
    const float lam_init = 0.8f - 0.6f * expf(-0.3f * (float)l);
    const float lam = expf(d01) - expf(d23) + lam_init;
    const bf16_t* proj = (const bf16_t*)(p.ws + WS_PROJ); const bf16_t* vtc = (const bf16_t*)(p.ws + WS_VTC);
    f32x16 O0[4];
    const int q = q0w + r;
    float* ctmp = (float*)(p.ws + WS_CTMP) + (size_t)q * 1024 + h * 128 + 4 * hh;
    diff_flash(proj, vtc, h, 0, q0w, lds, btab, O0);
#pragma unroll
    for (int db = 0; db < 4; ++db)
#pragma unroll
        for (int i4 = 0; i4 < 4; ++i4) { f32x4 o = {O0[db][4 * i4], O0[db][4 * i4 + 1], O0[db][4 * i4 + 2], O0[db][4 * i4 + 3]}; *(f32x4*)(ctmp + 32 * db + 8 * i4) = o; }
    diff_flash(proj, vtc, h, 1, q0w, lds, btab, O0);
    float ss = 0.f;
#pragma unroll
    for (int db = 0; db < 4; ++db)
#pragma unroll
        for (int i4 = 0; i4 < 4; ++i4) { const f32x4 o0 = *(const f32x4*)(ctmp + 32 * db + 8 * i4);
#pragma unroll
            for (int e = 0; e < 4; ++e) { const float o = o0[e] - lam * O0[db][4 * i4 + e]; O0[db][4 * i4 + e] = o; ss += o * o; } }
    ss += __shfl_xor(ss, 32);
    const float rn = rsqrtf(ss * (1.0f / 128.0f) + 1e-6f) * (1.0f - lam_init);
    const float* dg = p.in[I_DG] + l * 128;
    bf16_t* cout = (bf16_t*)(p.ws + WS_BR) + (size_t)2 * S * 1024;
#pragma unroll
    for (int db = 0; db < 4; ++db)
#pragma unroll
        for (int i4 = 0; i4 < 4; ++i4) {
            const int d0 = 32 * db + 8 * i4 + 4 * hh;
            const f32x4 g4 = *(const f32x4*)(dg + d0);
            const u32x2 gt = *(const u32x2*)(proj + (size_t)q * NIN + C_CGATE + h * 128 + d0);
            const float y0 = O0[db][4 * i4 + 0] * rn * g4[0] * silu_f(bflo(gt[0])), y1 = O0[db][4 * i4 + 1] * rn * g4[1] * silu_f(bfhi(gt[0]));
            const float y2 = O0[db][4 * i4 + 2] * rn * g4[2] * silu_f(bflo(gt[1])), y3 = O0[db][4 * i4 + 3] * rn * g4[3] * silu_f(bfhi(gt[1]));
            u32x2 o = {pk2(y0, y1), pk2(y2, y3)};
            *(u32x2*)(cout + (size_t)q * 1024 + h * 128 + d0) = o;
        }
    __syncthreads();
}

DI void mixA_wave_item(const Params& p, int wi, int lane, const LAS float* tb) {
    asm volatile("" : "+v"(lane));
    const int g = wi >> 11, rem = wi & 2047, h = rem >> 8, qb = rem & 255;
    const int sh = 2 * g, n = S >> sh, nbq = 256 >> sh, res = qb / nbq, m0 = (qb % nbq) * 32;
    const int r = lane & 31, hh = lane >> 5;
    const bf16_t* proj = (const bf16_t*)(p.ws + WS_PROJ);
    const int qpos = ((m0 + r) << sh) + res;
    bf16x8 qf[8];
    { const bf16_t* qp = proj + (size_t)qpos * NIN + g * 3072 + h * 128 + 8 * hh;
#pragma unroll
      for (int ks = 0; ks < 8; ++ks) qf[ks] = *(const bf16x8*)(qp + 16 * ks); }
    f32x16 O[4];
#pragma unroll
    for (int db = 0; db < 4; ++db)
#pragma unroll
        for (int i = 0; i < 16; ++i) O[db][i] = 0.f;
    float m = -1e30f, lsum = 0.f;
    const float cs = 0.08838834764831845f * LOG2E;
    const LAS float* tbl = tb + 31 - r + 4 * hh;
    const bf16_t* vt = (const bf16_t*)(p.ws + WS_VTA) + (size_t)((g * 8 + h) * 128) * S + res * n;
    bf16x8 kf[8];
    { const int mk0r = m0 - 64; const int mk0 = (mk0r >= 0 && mk0r < n) ? mk0r : m0;
      const bf16_t* kp = proj + (size_t)(((mk0 + r) << sh) + res) * NIN + g * 3072 + 1024 + h * 128 + 8 * hh;
#pragma unroll
      for (int ks = 0; ks < 8; ++ks) kf[ks] = *(const bf16x8*)(kp + 16 * ks); }
#pragma unroll 1
    for (int kb = 0; kb < 5; ++kb) {
        const int mk0r = m0 - 64 + 32 * kb;
        const bool blk_ok = (mk0r >= 0) && (mk0r < n);
        const int mk0 = blk_ok ? mk0r : m0;
        bf16x8 vfr[2][4];
#pragma unroll
        for (int sidx = 0; sidx < 2; ++sidx)
#pragma unroll
            for (int db = 0; db < 4; ++db) {
                const bf16_t* vp = vt + (size_t)(32 * db + r) * S + mk0 + 16 * sidx + 4 * hh;
                const s16x4 lo = *(const s16x4*)vp, hi = *(const s16x4*)(vp + 8);
                vfr[sidx][db] = __builtin_shufflevector(lo, hi, 0, 1, 2, 3, 4, 5, 6, 7);
            }
        __builtin_amdgcn_sched_barrier(0);
        f32x16 s;
#pragma unroll
        for (int i = 0; i < 16; ++i) s[i] = 0.f;
#pragma unroll
        for (int ks = 0; ks < 8; ++ks) s = MFMA32(kf[ks], qf[ks], s);
        if (kb < 4) {
            const int nk0r = m0 - 64 + 32 * (kb + 1); const int nk0 = (nk0r >= 0 && nk0r < n) ? nk0r : m0;
            const bf16_t* kp = proj + (size_t)(((nk0 + r) << sh) + res) * NIN + g * 3072 + 1024 + h * 128 + 8 * hh;
#pragma unroll
            for (int ks = 0; ks < 8; ++ks) kf[ks] = *(const bf16x8*)(kp + 16 * ks);
        }
        __builtin_amdgcn_sched_barrier(0);
        float mx = -INFINITY;
#pragma unroll
        for (int i = 0; i < 16; ++i) { const int rel = mk0r + crow(i, hh) - (m0 + r); const bool valid = blk_ok && (rel <= 64) && (rel >= -64);
            const float bv = tbl[32 * kb + (i & 3) + 8 * (i >> 2)];
            const float v = valid ? (s[i] * cs + bv) : -INFINITY; s[i] = v; mx = fmaxf(mx, v); }
        mx = fmaxf(mx, __shfl_xor(mx, 32));
        const float mnew = fmaxf(m, mx), alpha = __builtin_amdgcn_exp2f(m - mnew);
        m = mnew;
        float rs = 0.f;
#pragma unroll
        for (int i = 0; i < 16; ++i) { s[i] = __builtin_amdgcn_exp2f(s[i] - mnew); rs += s[i]; }
        lsum = lsum * alpha + rs;
#pragma unroll
        for (int db = 0; db < 4; ++db) O[db] *= alpha;
#pragma unroll
        for (int sidx = 0; sidx < 2; ++sidx) {
            const bf16x8 pf = pack8(s, sidx);
#pragma unroll
            for (int db = 0; db < 4; ++db) O[db] = MFMA32(vfr[sidx][db], pf, O[db]);
        }
    }
    const float lt = lsum + __shfl_xor(lsum, 32), inv = 1.0f / lt;
    float* oa = (float*)(p.ws + WS_OA) + ((size_t)g * S + qpos) * 1024 + h * 128;
#pragma unroll
    for (int db = 0; db < 4; ++db)
#pragma unroll
        for (int i4 = 0; i4 < 4; ++i4) {
            const int d0 = 32 * db + 8 * i4 + 4 * hh;
            f32x4 o = {O[db][4 * i4] * inv, O[db][4 * i4 + 1] * inv, O[db][4 * i4 + 2] * inv, O[db][4 * i4 + 3] * inv};
            *(f32x4*)(oa + d0) = o;
        }
    if (hh == 0) ((float*)(p.ws + WS_LSEA))[((size_t)g * S + qpos) * 8 + h] = m + __log2f(lt);
}

DI void phase_post(const Params& p, LAS unsigned char* lds) {
    const int tid = tidx();
    const bf16_t* proj = (const bf16_t*)(p.ws + WS_PROJ);
    bf16_t* aout = (bf16_t*)(p.ws + WS_BR); bf16_t* bout = aout + (size_t)S * 1024;
    const float* oa = (const float*)(p.ws + WS_OA); const float* lse = (const float*)(p.ws + WS_LSEA);
    for (int idx = blockIdx.x * NTHR + tid; idx < S * 256; idx += gridDim.x * NTHR) {
        const int pos = idx >> 8, c4 = idx & 255, h = c4 >> 5, col = c4 * 4;
        const float l0 = lse[((size_t)0 * S + pos) * 8 + h], l1 = lse[((size_t)1 * S + pos) * 8 + h], l2 = lse[((size_t)2 * S + pos) * 8 + h];
        const float mx = fmaxf(l0, fmaxf(l1, l2));
        const float w0 = __builtin_amdgcn_exp2f(l0 - mx), w1 = __builtin_amdgcn_exp2f(l1 - mx), w2 = __builtin_amdgcn_exp2f(l2 - mx);
        const float inv = 1.0f / (w0 + w1 + w2);
        const f32x4 o0 = *(const f32x4*)(oa + ((size_t)0 * S + pos) * 1024 + col), o1 = *(const f32x4*)(oa + ((size_t)1 * S + pos) * 1024 + col), o2 = *(const f32x4*)(oa + ((size_t)2 * S + pos) * 1024 + col);
        const f32x4 o = (o0 * w0 + o1 * w1 + o2 * w2) * inv;
        const u32x2 gt = *(const u32x2*)(proj + (size_t)pos * NIN + C_AGATE + col);
        u32x2 ov = {pk2(o[0] * silu_f(bflo(gt[0])), o[1] * silu_f(bfhi(gt[0]))), pk2(o[2] * silu_f(bflo(gt[1])), o[3] * silu_f(bfhi(gt[1])))};
        *(u32x2*)(aout + (size_t)pos * 1024 + col) = ov;
    }
    LAS float* tile = (LAS float*)lds;
    const float* z2t = (const float*)(p.ws + WS_Z2T);
    for (int it = blockIdx.x; it < 128 * 16; it += gridDim.x) {
        const int t0 = (it >> 4) * 64, c0 = (it & 15) * 64;
        __syncthreads();
#pragma unroll
        for (int k = 0; k < 2; ++k) { const int e = tid + NTHR * k; const int ci = e >> 4, t4 = (e & 15) * 4;
            const f32x4 v = *(const f32x4*)(z2t + (size_t)(c0 + ci) * S + t0 + t4);
            tile[ci * 65 + t4] = v[0]; tile[ci * 65 + t4 + 1] = v[1]; tile[ci * 65 + t4 + 2] = v[2]; tile[ci * 65 + t4 + 3] = v[3]; }
        __syncthreads();
#pragma unroll
        for (int k = 0; k < 2; ++k) { const int e = tid + NTHR * k; const int ti = e >> 4, cc = (e & 15) * 4;
            const u32x2 gt = *(const u32x2*)(proj + (size_t)(t0 + ti) * NIN + C_BGATE + c0 + cc);
            const float y0 = tile[(cc + 0) * 65 + ti] * silu_f(bflo(gt[0])), y1 = tile[(cc + 1) * 65 + ti] * silu_f(bfhi(gt[0]));
            const float y2 = tile[(cc + 2) * 65 + ti] * silu_f(bflo(gt[1])), y3 = tile[(cc + 3) * 65 + ti] * silu_f(bfhi(gt[1]));
            u32x2 ov = {pk2(y0, y1), pk2(y2, y3)};
            *(u32x2*)(bout + (size_t)(t0 + ti) * 1024 + c0 + cc) = ov; }
    }
    __syncthreads();
}

#ifndef REP_GEMMIN
#define REP_GEMMIN 1
#endif
#ifndef REP_DIFF
#define REP_DIFF 1
#endif
#ifndef REP_HYENA
#define REP_HYENA 1
#endif
#ifndef REP_MIXA
#define REP_MIXA 1
#endif
#ifndef REP_PRO
#define REP_PRO 1
#endif
#ifndef REP_SPEC
#define REP_SPEC 1
#endif
#ifndef REP_MISC
#define REP_MISC 1
#endif
#ifndef REP_PROJ
#define REP_PROJ 1
#endif
constexpr int NPH = 3 + 6 * DEPTH + 1;
typedef const Params __attribute__((address_space(4)))* ParamsK;
DI Params ldp(ParamsK pc) {
    asm volatile("" : "+s"(pc));
    Params q;
#pragma unroll
    for (int i = 0; i < 18; ++i) q.in[i] = pc->in[i];
    q.out = pc->out; q.ws = pc->ws; q.ph_lo = pc->ph_lo; q.ph_hi = pc->ph_hi;
    return q;
}
DI void run_phase(ParamsK pc, int ph, LAS unsigned char* lds) {
    if (ph == 0) { for (int rep = 0; rep < REP_PRO; ++rep) { const Params p = ldp(pc); phase_prologue(p, lds); __syncthreads(); } return; }
    if (ph == 1) { const Params p = ldp(pc); phase_tgen(p); return; }
    if (ph == 2) { for (int rep = 0; rep < REP_SPEC; ++rep) { const Params p = ldp(pc); for (int it = blockIdx.x; it < DEPTH * 2 * 512; it += gridDim.x) spectra_item(p, it, lds); } return; }
    if (ph == NPH - 1) { const Params p = ldp(pc); phase_rmsnorm((const float*)(p.ws + WS_X), p.in[I_FINALG], nullptr, p.out); return; }
    const int l = (ph - 3) / 6, sp = (ph - 3) % 6;
    if (sp == 0) { for (int rep = 0; rep < REP_MISC; ++rep) { const Params p = ldp(pc); phase_rmsnorm((l == 0) ? p.in[I_X] : (const float*)(p.ws + WS_X), p.in[I_NORMG] + l * D, (bf16_t*)(p.ws + WS_H), nullptr); } return; }
    if (sp == 1) {
        const Params p = ldp(pc);
        pg8::Gemm g{(const bf16_t*)(p.ws + WS_H), (const bf16_t*)(p.ws + WS_WIN) + (size_t)l * NIN * D, S, NIN, D};
        pg8::StaticOrder so; so.init(S, NIN, gridDim.x, blockIdx.x);
        EpiIn e{(bf16_t*)(p.ws + WS_PROJ), (bf16_t*)(p.ws + WS_VTA), (bf16_t*)(p.ws + WS_VTC), (float*)(p.ws + WS_BINT), lds + 131072};
#pragma unroll 1
        for (int rep = 0; rep < REP_GEMMIN; ++rep) { pg8::gemm_phase(lds, g, so, e); __syncthreads(); }
        return;
    }
    if (sp == 2) {
#pragma unroll 1
        for (int it = blockIdx.x; it < 256 + 512 + 768; it += gridDim.x) {
            int l2 = l; asm volatile("" : "+s"(l2));
            const Params p = ldp(pc);
            if (it < 256) { for (int rep = 0; rep < REP_DIFF; ++rep) diffattn_item(p, l2, it, lds); }
            else if (it < 768) { for (int rep = 0; rep < REP_HYENA; ++rep) hyena_item(p, l2, it - 256, lds); }
            else {
                const int tid2 = tidx(), wi0 = (it - 768) * NWAVES, g = wi0 >> 11, h = (wi0 & 2047) >> 8;
                LAS float* tb = (LAS float*)lds;
                __syncthreads();
                if (tid2 < 192) { const int rel = tid2 - 95; float v = 0.f;
                    if (rel >= -64 && rel <= 64) v = ((const float*)(p.ws + WS_BIAS))[(g * 8 + h) * 2049 + min(max(rel << (2 * g), -1024), 1024) + 1024];
                    tb[tid2] = v; }
                __syncthreads();
                for (int rep = 0; rep < REP_MIXA; ++rep) mixA_wave_item(p, wi0 + (tid2 >> 6), tid2 & 63, tb);
            }
        }
        return;
    }
    if (sp == 3) { for (int rep = 0; rep < REP_MISC; ++rep) { const Params p = ldp(pc); phase_post(p, lds); } return; }
    if (sp == 4) {
#pragma unroll 1
        for (int rep = 0; rep < REP_PROJ; ++rep) {
            const Params p = ldp(pc);
            pg8::Gemm g{(const bf16_t*)(p.ws + WS_BR), (const bf16_t*)(p.ws + WS_WPR) + (size_t)(l * 3) * D * 1024, 3 * S, 3 * D, 1024};
            ProjOrder po; po.so.init(S, D, gridDim.x, blockIdx.x);
            EpiProj e{(const bf16_t*)(p.ws + WS_PROJ), p.in[I_MERGEB] + (size_t)l * 3 * D, (float*)(p.ws + WS_YF), (bf16_t*)(p.ws + WS_YB)};
            pg8::gemm_phase(lds, g, po, e);
            __syncthreads();
        }
        return;
    }
    {
        const Params p = ldp(pc);
        pg8::Gemm g{(const bf16_t*)(p.ws + WS_YB), (const bf16_t*)(p.ws + WS_WOUT) + (size_t)l * D * D, S, D, D};
        pg8::StaticOrder so; so.init(S, D, gridDim.x, blockIdx.x);
        EpiOut e{(l == 0) ? p.in[I_X] : (const float*)(p.ws + WS_X), (float*)(p.ws + WS_X)};
#pragma unroll 1
        for (int rep = 0; rep < ((l == 0) ? REP_MISC : 1); ++rep) { pg8::gemm_phase(lds, g, so, e); __syncthreads(); }
    }
}


#define XB_TMO      128
#define XB_XCNT(j)  (256  + 64 * (j))
#define XB_XSUB(j)  (1280 + 64 * (j))
#define XB_XGEN(j)  (2304 + 64 * (j))
#define XB_TOP      3328
#define XB_TOPGEN   3392
#define XCD_BAR_WORDS 3456
#define XB_SPIN_CAP (1u << 18)
DI unsigned xb_ld(unsigned* p)              { return __hip_atomic_load(p, __ATOMIC_RELAXED, __HIP_MEMORY_SCOPE_AGENT); }
DI unsigned xb_add(unsigned* p, unsigned v) { return __hip_atomic_fetch_add(p, v, __ATOMIC_RELAXED, __HIP_MEMORY_SCOPE_AGENT); }
DI unsigned xb_xcc_id() { return (unsigned)__builtin_amdgcn_s_getreg((3 << 11) | 20) & 0xFu; }
#define XB_SPIN(cond, bar) do { unsigned _sp = 0; while (cond) { __builtin_amdgcn_s_sleep(1); \
    if ((++_sp & 255u) == 0u) { if (xb_ld(&(bar)[XB_TMO])) break; if (_sp > XB_SPIN_CAP) { atomicAdd(&(bar)[XB_TMO], 1u); break; } } } } while (0)
struct XcdBarrier { unsigned* bar; unsigned x; volatile LAS unsigned* st; };
DI XcdBarrier xcd_barrier_post(unsigned* bar, volatile LAS unsigned* st) {
    XcdBarrier b; b.bar = bar; b.x = xb_xcc_id(); b.st = st;
    if (threadIdx.x == 0) (void)xb_add(&bar[XB_XCNT(b.x)], 1u);
    return b;
}
DI void xcd_barrier_complete(unsigned* bar, unsigned x, unsigned& nloc, unsigned& nx) {
    const unsigned G = gridDim.x * gridDim.y * gridDim.z;
    unsigned sum, cnt, mine, sp = 0u;
    for (;;) {
        sum = 0u; cnt = 0u; mine = 0u;
#pragma unroll
        for (unsigned j = 0; j < 16; ++j) { const unsigned c = xb_ld(&bar[XB_XCNT(j)]); sum += c; cnt += (c > 0u) ? 1u : 0u; mine = (j == x) ? c : mine; }
        if (sum == G) break;
        __builtin_amdgcn_s_sleep(1);
        if ((++sp & 255u) == 0u) { if (xb_ld(&bar[XB_TMO])) break; if (sp > XB_SPIN_CAP) { atomicAdd(&bar[XB_TMO], 1u); break; } }
    }
    nloc = mine > 0u ? mine : 1u; nx = cnt > 0u ? cnt : 1u;
}
DI void xcd_barrier(const XcdBarrier& b) {
    asm volatile("s_waitcnt vmcnt(0)" ::: "memory");
    __syncthreads();
    if (threadIdx.x == 0) {
        unsigned* bar = b.bar;
        __builtin_amdgcn_s_waitcnt(0);
        unsigned nloc = b.st[0], nx = b.st[1];
        if (nloc == 0u) { xcd_barrier_complete(bar, b.x, nloc, nx); b.st[0] = nloc; b.st[1] = nx; }
        const unsigned old = xb_add(&bar[XB_XSUB(b.x)], 1u);
        const unsigned gen = old / nloc;
        if (old + 1u == (gen + 1u) * nloc) {
            __builtin_amdgcn_fence(__ATOMIC_RELEASE, "agent");
            asm volatile("s_waitcnt vmcnt(0)" ::: "memory");
            const unsigned og = xb_add(&bar[XB_TOP], 1u);
            const unsigned tg = og / nx;
            if (og + 1u == (tg + 1u) * nx) xb_add(&bar[XB_TOPGEN], 1u);
            else XB_SPIN(xb_ld(&bar[XB_TOPGEN]) == tg, bar);
            __builtin_amdgcn_fence(__ATOMIC_ACQUIRE, "agent");
            xb_add(&bar[XB_XGEN(b.x)], 1u);
            asm volatile("s_waitcnt vmcnt(0)" ::: "memory");
        } else {
            XB_SPIN(xb_ld(&bar[XB_XGEN(b.x)]) == gen, bar);
            __builtin_amdgcn_fence(__ATOMIC_ACQUIRE, "agent");
            asm volatile("s_waitcnt vmcnt(0)" ::: "memory");
        }
    }
    __syncthreads();
}

__global__ void __launch_bounds__(512, 2) mega_kernel(Params p) {
#if defined(__HIP_DEVICE_COMPILE__)
    extern __shared__ __attribute__((aligned(16))) unsigned char shm[];
    LAS unsigned char* lds = (LAS unsigned char*)shm;
    cg::grid_group grid = cg::this_grid();
    const int ph_lo = p.ph_lo, ph_hi = p.ph_hi;
    volatile LAS unsigned* st = (volatile LAS unsigned*)(lds + LDS_BYTES - 16);
    if (threadIdx.x == 0) { st[0] = 0u; st[1] = 0u; }
    __syncthreads();
    const XcdBarrier xb = xcd_barrier_post((unsigned*)(p.ws + WS_BAR), st);
#pragma unroll 1
    for (int ph = ph_lo; ph < ph_hi; ++ph) {
        ParamsK pc = (ParamsK)__builtin_amdgcn_kernarg_segment_ptr();
        run_phase(pc, ph, lds);
        if (ph + 1 < ph_hi) { if (ph == ph_lo) grid.sync(); else xcd_barrier(xb); }
    }
#endif
}

#ifndef N_LAUNCH_MODE
#define N_LAUNCH_MODE 1
#endif
extern "C" void kernel_launch(void* const* d_in, const int* in_sizes, int n_in, void* d_out, int out_size, void* d_ws, size_t ws_size, hipStream_t stream) {
    static int grid = 0;
    if (grid == 0) {
        int dev = 0, cus = 0;
        if (hipGetDevice(&dev) != hipSuccess || hipDeviceGetAttribute(&cus, hipDeviceAttributeMultiprocessorCount, dev) != hipSuccess) { fprintf(stderr, "kernel_launch: device query failed\n"); grid = -1; return; }
        if (hipFuncSetAttribute((const void*)mega_kernel, hipFuncAttributeMaxDynamicSharedMemorySize, LDS_BYTES) != hipSuccess) { fprintf(stderr, "kernel_launch: hipFuncSetAttribute failed\n"); grid = -1; return; }
        int per_cu = 0;
        if (hipOccupancyMaxActiveBlocksPerMultiprocessor(&per_cu, (const void*)mega_kernel, NTHR, LDS_BYTES) != hipSuccess || per_cu < 1) { fprintf(stderr, "kernel_launch: occupancy query says %d\n", per_cu); (void)hipGetLastError(); }
        if (n_in != 18 || ws_size < WS_END) { fprintf(stderr, "kernel_launch: n_in %d ws %zu (need %zu)\n", n_in, ws_size, (size_t)WS_END); grid = -1; return; }
        grid = cus;
    }
    if (grid < 0) return;
    Params p{};
    for (int i = 0; i < 18; ++i) p.in[i] = (const float*)d_in[i];
    p.out = (float*)d_out; p.ws = (unsigned char*)d_ws;
    if (hipMemsetAsync((unsigned char*)d_ws + WS_BAR, 0, 16384, stream) != hipSuccess) { fprintf(stderr, "kernel_launch: memset of barrier words failed\n"); return; }
#if N_LAUNCH_MODE == 1
    p.ph_lo = 0; p.ph_hi = NPH;
    void* args[] = {&p};
    hipError_t e = hipLaunchCooperativeKernel((const void*)mega_kernel, dim3(grid), dim3(NTHR), args, LDS_BYTES, stream);
    if (e != hipSuccess) fprintf(stderr, "cooperative launch failed: %s (grid %d)\n", hipGetErrorString(e), grid);
#else
    for (int ph = 0; ph < NPH; ++ph) {
        p.ph_lo = ph; p.ph_hi = ph + 1;
        hipLaunchKernelGGL(mega_kernel, dim3(grid), dim3(NTHR), LDS_BYTES, stream, p);
    }
#endif
}
```

```cpp
#include <hip/hip_runtime.h>
#include <hip/hip_cooperative_groups.h>
#include <cstdio>
namespace cg = cooperative_groups;
#define DI __device__ __forceinline__
#define LAS __attribute__((address_space(3)))
typedef unsigned short bf16_t;
typedef short bf16x8 __attribute__((ext_vector_type(8)));
typedef short s16x4 __attribute__((ext_vector_type(4)));
typedef float f32x4 __attribute__((ext_vector_type(4)));
typedef float f32x16 __attribute__((ext_vector_type(16)));
typedef float f32x2 __attribute__((ext_vector_type(2)));
typedef float cf __attribute__((ext_vector_type(2)));
typedef __bf16 bf16x2n __attribute__((ext_vector_type(2)));
typedef unsigned u32x2 __attribute__((ext_vector_type(2)));
typedef unsigned u32x4 __attribute__((ext_vector_type(4)));

DI unsigned pk2(float lo, float hi) { f32x2 v = {lo, hi}; return __builtin_bit_cast(unsigned, __builtin_convertvector(v, bf16x2n)); }
DI float bflo(unsigned u) { return __uint_as_float(u << 16); }
DI float bfhi(unsigned u) { return __uint_as_float(u & 0xffff0000u); }
DI float silu_f(float x) { return x * __builtin_amdgcn_rcpf(1.0f + __expf(-x)); }
DI float sigm_f(float x) { return __builtin_amdgcn_rcpf(1.0f + __expf(-x)); }

DI int tidx() { int t = threadIdx.x; asm volatile("" : "+v"(t)); return t; }

constexpr int S = 8192, D = 2048, NIN = 24576, DEPTH = 4;
constexpr int C_AGATE = 9216, C_BIN = 10240, C_BGATE = 13312, C_CQKV = 14336, C_CGATE = 17408, C_MERGE = 18432;
constexpr float LOG2E = 1.4426950408889634f;
constexpr int NTHR = 512, NWAVES = 8;
constexpr int LDS_MAIN = 143360, LDS_AUX = 16384, LDS_BYTES = LDS_MAIN + LDS_AUX;

constexpr size_t WS_WIN  = 0;
constexpr size_t WS_WPR  = WS_WIN  + (size_t)DEPTH * NIN * D * 2;
constexpr size_t WS_WOUT = WS_WPR  + (size_t)DEPTH * 3 * D * 1024 * 2;
constexpr size_t WS_SPEC = WS_WOUT + (size_t)DEPTH * D * D * 2;
constexpr size_t WS_HID2 = WS_SPEC + (size_t)DEPTH * 2 * 512 * 8208 * 16;
constexpr size_t WS_BIAS = WS_HID2 + (size_t)DEPTH * S * 64 * 4;
constexpr size_t WS_X    = WS_BIAS + 524288;
constexpr size_t WS_H    = WS_X    + (size_t)S * D * 4;
constexpr size_t WS_PROJ = WS_H    + (size_t)S * D * 2;
constexpr size_t WS_BINT = WS_PROJ + (size_t)S * NIN * 2;
constexpr size_t WS_VTA  = WS_BINT + (size_t)3072 * S * 4;
constexpr size_t WS_VTC  = WS_VTA  + (size_t)3 * 1024 * S * 2;
constexpr size_t WS_OA   = WS_VTC  + (size_t)1024 * S * 2;
constexpr size_t WS_LSEA = WS_OA   + (size_t)3 * S * 1024 * 4;
constexpr size_t WS_Z2T  = WS_LSEA + (size_t)3 * S * 8 * 4;
constexpr size_t WS_BR   = WS_Z2T  + (size_t)1024 * S * 4;
constexpr size_t WS_YF   = WS_BR   + (size_t)3 * S * 1024 * 2;
constexpr size_t WS_YB   = WS_YF   + (size_t)S * D * 4;
constexpr size_t WS_CTMP = WS_YB   + (size_t)S * D * 2;
constexpr size_t WS_BAR  = WS_CTMP + (size_t)S * 1024 * 4;
constexpr size_t WS_TT   = WS_BAR + 16384;
constexpr size_t WS_END  = WS_TT + (size_t)DEPTH * 4096 * S * 4;

struct Params {
    const float* in[18];
    float* out;
    unsigned char* ws;
    int ph_lo, ph_hi;
};
enum { I_X = 0, I_NORMG, I_FINALG, I_WIN, I_MERGEB, I_RELB, I_HYCONV, I_HYW1, I_HYB1, I_HYFREQ, I_HYW2, I_HYB2, I_HYW3, I_HYSKIP, I_DLAM, I_DG, I_WPROJ, I_WOUT };

namespace pg8 {
constexpr int BM = 256, BK = 64, HALF = 128, HTB = HALF * BK * 2, NXCD = 8, WGM = 8;
DI int lds_byte(int r, int c) { const int st = (r >> 4) * 2 + (c >> 5), rr = r & 15, cc = c & 31, ob = rr * 64 + cc * 2; return st * 1024 + (ob ^ (((ob >> 9) & 1) << 5)); }
DI void stage_rc(int b, int& R, int& C) { const int st = b / 1024, sb = b % 1024, swz = sb ^ (((sb >> 9) & 1) << 5); R = (st >> 1) * 16 + swz / 64; C = (st & 1) * 32 + (swz % 64) / 2; }
DI int perm32(int rho) { const int n = rho >> 4, i = rho & 15; return 8 * (i >> 2) + 4 * n + (i & 3); }
struct Unit { int pm, pn; };
struct Gemm { const bf16_t* A; const bf16_t* Bt; int M, N, K; };
struct StaticOrder {
    int nM, nN, nwg, G, c;
    DI void init(int M, int N, int G_, int c_) { nM = M / BM; nN = N / BM; nwg = nM * nN; G = G_; c = c_; }
    DI bool next(int i, Unit& u) const {
        const long L = (long)i * G + c; if (L >= nwg) return false;
        int wgid = (int)L; { const int q = nwg / NXCD, r = nwg % NXCD, xcd = wgid % NXCD, off = wgid / NXCD; wgid = (xcd < r ? xcd * (q + 1) : r * (q + 1) + (xcd - r) * q) + off; }
        const int nig = WGM * nN, gid = wgid / nig, fm = gid * WGM, gsz = (nM - fm) < WGM ? (nM - fm) : WGM;
        u.pm = fm + ((wgid % nig) % gsz); u.pn = (wgid % nig) / gsz; return true;
    }
};
template <class Epi, class Sched>
DI void gemm_phase(LAS unsigned char* lds, const Gemm g, const Sched& S, const Epi& E) {
    const int tid = tidx(), wid = __builtin_amdgcn_readfirstlane(tid >> 6), lane = tid & 63, wr = wid >> 2, wc = wid & 3, fr = lane & 15, fq = lane >> 4;
    const int K = g.K, nt = K / BK;
    unsigned voffA[2], voffB[2];
#pragma unroll
    for (int i = 0; i < 2; ++i) { int R, C; stage_rc(tid * 16 + i * 8192, R, C); const int Rb = Epi::PERM ? ((R & ~31) + perm32(R & 31)) : R; voffA[i] = (unsigned)(R * K + C) * 2u; voffB[i] = (unsigned)(Rb * K + C) * 2u; }
    const size_t kstep = (size_t)(BK * 2);
    const size_t hstep = (size_t)HALF * K * 2;
    const size_t tstep = 2 * hstep;
    const unsigned ldsw = (unsigned)wid * 1024u;
    const int aoff = lds_byte(wr * 64 + fr, fq * 8), boff = lds_byte(wc * 32 + fr, fq * 8);
#define PG8_SA(b, h) (((b) * 2 + (h)) * HTB)
#define PG8_SB(b, h) ((4 + (b) * 2 + (h)) * HTB)
#define PG8_STAGE(bufoff, gbase, voff) do { _Pragma("unroll") for (int _i = 0; _i < 2; ++_i) \
        __builtin_amdgcn_global_load_lds((const unsigned*)((const char*)(gbase) + (voff)[_i]), (LAS unsigned*)(lds + (bufoff) + ldsw + _i * 8192), 16, 0, 0); } while (0)
#define PG8_LDA(dst, b, h) do { _Pragma("unroll") for (int m = 0; m < 4; ++m) _Pragma("unroll") for (int k = 0; k < 2; ++k) dst[m][k] = *(const LAS bf16x8*)(lds + PG8_SA(b, h) + aoff + m * 2048 + k * 1024); } while (0)
#define PG8_LDB(dst, b, h) do { _Pragma("unroll") for (int n = 0; n < 2; ++n) _Pragma("unroll") for (int k = 0; k < 2; ++k) dst[n][k] = *(const LAS bf16x8*)(lds + PG8_SB(b, h) + boff + n * 2048 + k * 1024); } while (0)
#define PG8_MMA(ai, bj, At, Bt) do { __builtin_amdgcn_s_setprio(1); _Pragma("unroll") for (int m = 0; m < 4; ++m) _Pragma("unroll") for (int n = 0; n < 2; ++n) _Pragma("unroll") for (int k = 0; k < 2; ++k) \
        acc[ai][bj][m][n] = __builtin_amdgcn_mfma_f32_16x16x32_bf16(Bt[n][k], At[m][k], acc[ai][bj][m][n], 0, 0, 0); __builtin_amdgcn_s_setprio(0); } while (0)
#define PG8_WAIT_V(n) asm volatile("s_waitcnt vmcnt(" #n ")" ::: "memory")
#define PG8_WAIT_L(n) asm volatile("s_waitcnt lgkmcnt(" #n ")" ::: "memory")
#define PG8_BAR __builtin_amdgcn_s_barrier()
#define PG8_SCHED __builtin_amdgcn_sched_barrier(0)
    Unit cur, nxt; int ui = 0;
    if (!S.next(0, cur)) return;
    f32x4 acc[2][2][4][2];
#pragma unroll
    for (int a = 0; a < 2; ++a)
#pragma unroll
        for (int b = 0; b < 2; ++b)
#pragma unroll
            for (int m = 0; m < 4; ++m)
#pragma unroll
                for (int n = 0; n < 2; ++n) acc[a][b][m][n] = (f32x4){0.f, 0.f, 0.f, 0.f};
    bf16x8 At[4][2], B0[2][2], B1[2][2];
    const char* cA = (const char*)g.A + (size_t)cur.pm * tstep; const char* cB = (const char*)g.Bt + (size_t)cur.pn * tstep;
    PG8_STAGE(PG8_SB(0, 0), cB, voffB); PG8_STAGE(PG8_SA(0, 0), cA, voffA); PG8_STAGE(PG8_SB(0, 1), cB + hstep, voffB); PG8_STAGE(PG8_SA(0, 1), cA + hstep, voffA);
    if (wr == 1) PG8_BAR;
    PG8_WAIT_V(4); PG8_BAR;
    PG8_STAGE(PG8_SB(1, 0), cB + kstep, voffB); PG8_STAGE(PG8_SA(1, 0), cA + kstep, voffA); PG8_STAGE(PG8_SB(1, 1), cB + hstep + kstep, voffB);
    PG8_WAIT_V(6); PG8_BAR;
    for (;;) {
        const bool has_next = S.next(ui + 1, nxt);
        const char* nA = has_next ? (const char*)g.A + (size_t)nxt.pm * tstep : cA; const char* nB = has_next ? (const char*)g.Bt + (size_t)nxt.pn * tstep : cB;
        for (int t = 0; t < nt; t += 2) {
            const bool last = (t == nt - 2);
            const char* a1 = cA + (size_t)(t + 1) * kstep;
            const char* a2 = last ? nA : cA + (size_t)(t + 2) * kstep; const char* b2 = last ? nB : cB + (size_t)(t + 2) * kstep;
            const char* a3 = a2 + kstep; const char* b3 = b2 + kstep;
            PG8_LDB(B0, 0, 0); PG8_SCHED; PG8_LDA(At, 0, 0); PG8_STAGE(PG8_SA(1, 1), a1 + hstep, voffA);
            PG8_WAIT_L(8); PG8_BAR; PG8_WAIT_L(0); PG8_MMA(0, 0, At, B0); PG8_BAR; PG8_SCHED;
            PG8_LDB(B1, 0, 1); PG8_STAGE(PG8_SB(0, 0), b2, voffB);
            PG8_BAR; PG8_WAIT_L(0); PG8_MMA(0, 1, At, B1); PG8_BAR;
            PG8_LDA(At, 0, 1); PG8_STAGE(PG8_SA(0, 0), a2, voffA);
            PG8_BAR; PG8_WAIT_L(0); PG8_MMA(1, 0, At, B0); PG8_BAR; PG8_SCHED;
            PG8_STAGE(PG8_SB(0, 1), b2 + hstep, voffB);
            PG8_WAIT_V(6); PG8_BAR; PG8_MMA(1, 1, At, B1); PG8_BAR;
            PG8_LDB(B0, 1, 0); PG8_SCHED; PG8_LDA(At, 1, 0); PG8_STAGE(PG8_SA(0, 1), a2 + hstep, voffA);
            PG8_WAIT_L(8); PG8_BAR; PG8_WAIT_L(0); PG8_MMA(0, 0, At, B0); PG8_BAR; PG8_SCHED;
            PG8_LDB(B1, 1, 1); PG8_STAGE(PG8_SB(1, 0), b3, voffB);
            PG8_BAR; PG8_WAIT_L(0); PG8_MMA(0, 1, At, B1); PG8_BAR;
            PG8_LDA(At, 1, 1); PG8_STAGE(PG8_SA(1, 0), a3, voffA);
            PG8_BAR; PG8_WAIT_L(0); PG8_MMA(1, 0, At, B0); PG8_BAR; PG8_SCHED;
            PG8_STAGE(PG8_SB(1, 1), b3 + hstep, voffB);
            PG8_WAIT_V(6); PG8_BAR; PG8_MMA(1, 1, At, B1); PG8_BAR;
        }
        E(acc, cur, wr, wc, fr, fq);
        if (!has_next) break;
#pragma unroll
        for (int a = 0; a < 2; ++a)
#pragma unroll
            for (int b = 0; b < 2; ++b)
#pragma unroll
                for (int m = 0; m < 4; ++m)
#pragma unroll
                    for (int n = 0; n < 2; ++n) acc[a][b][m][n] = (f32x4){0.f, 0.f, 0.f, 0.f};
        cur = nxt; cA = nA; cB = nB; ++ui;
    }
    PG8_WAIT_V(0);
    if (wr == 0) PG8_BAR;
    PG8_BAR;
#undef PG8_SA
#undef PG8_SB
#undef PG8_STAGE
#undef PG8_LDA
#undef PG8_LDB
#undef PG8_MMA
#undef PG8_WAIT_V
#undef PG8_WAIT_L
#undef PG8_BAR
#undef PG8_SCHED
}
}

struct EpiIn {
    static constexpr bool PERM = true;
    bf16_t* proj; bf16_t* vta; bf16_t* vtc; float* bint; LAS unsigned char* tlds;
    DI void operator()(const f32x4 (&acc)[2][2][4][2], const pg8::Unit& u, int wr, int wc, int fr, int fq) const {
        const int colt = u.pn * 256;
        int kind = 0;
        if (colt < C_AGATE) { if ((colt % 3072) >= 2048) kind = 1; }
        else if (colt >= C_BIN && colt < C_BGATE) kind = 2;
        else if (colt >= C_CQKV + 2048 && colt < C_CGATE) kind = 3;
        const int row0 = u.pm * 256 + wr * 64 + fr, col0 = colt + wc * 32 + 8 * fq;
        if (kind == 0) {
#pragma unroll
            for (int ai = 0; ai < 2; ++ai)
#pragma unroll
                for (int m = 0; m < 4; ++m) { bf16_t* rp = proj + (size_t)(row0 + ai * 128 + m * 16) * NIN + col0;
#pragma unroll
                    for (int bj = 0; bj < 2; ++bj) { const f32x4 a = acc[ai][bj][m][0], b = acc[ai][bj][m][1];
                        u32x4 o = {pk2(a[0], a[1]), pk2(a[2], a[3]), pk2(b[0], b[1]), pk2(b[2], b[3])}; *(u32x4*)(rp + bj * 128) = o; } }
        } else if (kind == 1 && colt >= 2 * 3072) {
            bf16_t* base = vta + (ptrdiff_t)(2 * 1024 - 2 * 3072 - 2048) * (ptrdiff_t)S;
#pragma unroll
            for (int ai = 0; ai < 2; ++ai) { const int prow = fr * (S >> 4) + ((u.pm * 256 + ai * 128 + wr * 64) >> 4);
#pragma unroll
                for (int bj = 0; bj < 2; ++bj)
#pragma unroll
                    for (int n = 0; n < 2; ++n)
#pragma unroll
                        for (int e = 0; e < 4; ++e) { u32x2 o = {pk2(acc[ai][bj][0][n][e], acc[ai][bj][1][n][e]), pk2(acc[ai][bj][2][n][e], acc[ai][bj][3][n][e])};
                            *(u32x2*)(base + (ptrdiff_t)(col0 + bj * 128 + n * 4 + e) * (ptrdiff_t)S + prow) = o; } }
        } else {
            const int lane = fr + 16 * fq, wave = wr * 4 + wc;
            LAS float* tl = (LAS float*)(tlds + wave * 2304);
            const int cl = lane >> 1, hs = lane & 1;
            const int colg = colt + wc * 32 + cl;
#pragma unroll
            for (int ai = 0; ai < 2; ++ai)
#pragma unroll
                for (int bj = 0; bj < 2; ++bj)
#pragma unroll
                    for (int m = 0; m < 4; ++m) {
                        const int rowb = u.pm * 256 + ai * 128 + wr * 64 + m * 16;
#pragma unroll
                        for (int n = 0; n < 2; ++n)
#pragma unroll
                            for (int e = 0; e < 4; ++e) tl[(8 * fq + 4 * n + e) * 17 + fr] = acc[ai][bj][m][n][e];
                        __builtin_amdgcn_wave_barrier();
                        const LAS float* tc = tl + cl * 17;
                        const int col = colg + bj * 128;
                        if (kind == 2) {
                            f32x4 o0 = {tc[8 * hs], tc[8 * hs + 1], tc[8 * hs + 2], tc[8 * hs + 3]}, o1 = {tc[8 * hs + 4], tc[8 * hs + 5], tc[8 * hs + 6], tc[8 * hs + 7]};
                            float* bp = bint + (size_t)(col - C_BIN) * S + rowb + 8 * hs;
                            *(f32x4*)bp = o0; *(f32x4*)(bp + 4) = o1;
                        } else if (kind == 3) {
                            u32x4 o = {pk2(tc[4 * hs], tc[4 * hs + 1]), pk2(tc[4 * hs + 2], tc[4 * hs + 3]), pk2(tc[8 + 4 * hs], tc[9 + 4 * hs]), pk2(tc[10 + 4 * hs], tc[11 + 4 * hs])};
                            *(u32x4*)(vtc + (size_t)(col - (C_CQKV + 2048)) * S + rowb + 8 * hs) = o;
                        } else if (colt < 3072) {
                            u32x4 o = {pk2(tc[8 * hs], tc[8 * hs + 1]), pk2(tc[8 * hs + 2], tc[8 * hs + 3]), pk2(tc[8 * hs + 4], tc[8 * hs + 5]), pk2(tc[8 * hs + 6], tc[8 * hs + 7])};
                            *(u32x4*)(vta + (size_t)(col - 2048) * S + rowb + 8 * hs) = o;
                        } else {
#pragma unroll
                            for (int k = 0; k < 2; ++k) { const int res = 2 * hs + k;
                                u32x2 o = {pk2(tc[res], tc[res + 4]), pk2(tc[res + 8], tc[res + 12])};
                                *(u32x2*)(vta + (size_t)(1024 + col - 3072 - 2048) * S + res * (S >> 2) + (rowb >> 2)) = o; }
                        }
                        __builtin_amdgcn_wave_barrier();
                    }
        }
    }
};
struct ProjOrder {
    pg8::StaticOrder so;
    DI bool next(int i, pg8::Unit& u) const { pg8::Unit b; if (!so.next(i / 3, b)) return false; const int nb = i % 3; u.pm = b.pm + 32 * nb; u.pn = b.pn + 8 * nb; return true; }
};
struct EpiProj {   static constexpr bool PERM = false;
    const bf16_t* proj; const float* mb; float* yf; bf16_t* yb;
    DI void operator()(const f32x4 (&acc)[2][2][4][2], const pg8::Unit& u, int wr, int wc, int fr, int fq) const {
        const int nb = u.pm >> 5;
        const int row0 = (u.pm & 31) * 256 + wr * 64 + fr, col0 = (u.pn & 7) * 256 + wc * 32 + 4 * fq;
        f32x4 b4[2][2];
#pragma unroll
        for (int bj = 0; bj < 2; ++bj)
#pragma unroll
            for (int n = 0; n < 2; ++n) b4[bj][n] = *(const f32x4*)(mb + nb * D + col0 + bj * 128 + n * 16);
#pragma unroll
        for (int ai = 0; ai < 2; ++ai)
#pragma unroll
            for (int mp = 0; mp < 2; ++mp) {
                u32x2 mg[2][2][2]; f32x4 yv[2][2][2];
#pragma unroll
                for (int mi = 0; mi < 2; ++mi) { const int row = row0 + ai * 128 + (2 * mp + mi) * 16;
#pragma unroll
                    for (int bj = 0; bj < 2; ++bj)
#pragma unroll
                        for (int n = 0; n < 2; ++n) { const int col = col0 + bj * 128 + n * 16;
                            mg[mi][bj][n] = *(const u32x2*)(proj + (size_t)row * NIN + C_MERGE + nb * D + col);
                            if (nb > 0) yv[mi][bj][n] = *(const f32x4*)(yf + (size_t)row * D + col); else yv[mi][bj][n] = (f32x4){0.f, 0.f, 0.f, 0.f}; } }
#pragma unroll
                for (int mi = 0; mi < 2; ++mi) { const int m = 2 * mp + mi; const int row = row0 + ai * 128 + m * 16;
#pragma unroll
                    for (int bj = 0; bj < 2; ++bj)
#pragma unroll
                        for (int n = 0; n < 2; ++n) { const int col = col0 + bj * 128 + n * 16; const f32x4 a = acc[ai][bj][m][n]; const u32x2 g2 = mg[mi][bj][n]; const f32x4 bb = b4[bj][n];
                            f32x4 v = yv[mi][bj][n];
                            v[0] += a[0] * sigm_f(bflo(g2[0]) + bb[0]); v[1] += a[1] * sigm_f(bfhi(g2[0]) + bb[1]);
                            v[2] += a[2] * sigm_f(bflo(g2[1]) + bb[2]); v[3] += a[3] * sigm_f(bfhi(g2[1]) + bb[3]);
                            if (nb < 2) *(f32x4*)(yf + (size_t)row * D + col) = v;
                            else { u32x2 o = {pk2(v[0], v[1]), pk2(v[2], v[3])}; *(u32x2*)(yb + (size_t)row * D + col) = o; } } }
            }
    }
};
struct EpiOut {   static constexpr bool PERM = false;
    const float* xold; float* xnew;
    DI void operator()(const f32x4 (&acc)[2][2][4][2], const pg8::Unit& u, int wr, int wc, int fr, int fq) const {
        const int row0 = u.pm * 256 + wr * 64 + fr, col0 = u.pn * 256 + wc * 32 + 4 * fq;
#pragma unroll
        for (int ai = 0; ai < 2; ++ai)
#pragma unroll
            for (int mp = 0; mp < 2; ++mp) {
                f32x4 xv[2][2][2];
#pragma unroll
                for (int mi = 0; mi < 2; ++mi)
#pragma unroll
                    for (int bj = 0; bj < 2; ++bj)
#pragma unroll
                        for (int n = 0; n < 2; ++n) xv[mi][bj][n] = *(const f32x4*)(xold + (size_t)(row0 + ai * 128 + (2 * mp + mi) * 16) * D + col0 + bj * 128 + n * 16);
#pragma unroll
                for (int mi = 0; mi < 2; ++mi)
#pragma unroll
                    for (int bj = 0; bj < 2; ++bj)
#pragma unroll
                        for (int n = 0; n < 2; ++n) *(f32x4*)(xnew + (size_t)(row0 + ai * 128 + (2 * mp + mi) * 16) * D + col0 + bj * 128 + n * 16) = xv[mi][bj][n] + acc[ai][bj][2 * mp + mi][n];
            }
    }
};
DI float wave_sum(float v) {
#pragma unroll
    for (int o = 1; o < 64; o <<= 1) v += __shfl_xor(v, o);
    return v;
}
DI int crow(int reg, int h) { return (reg & 3) + 8 * (reg >> 2) + 4 * h; }
DI bf16x8 pack8(const f32x16& x, const int s) {
    u32x4 p;
    p[0] = pk2(x[8 * s + 0], x[8 * s + 1]); p[1] = pk2(x[8 * s + 2], x[8 * s + 3]);
    p[2] = pk2(x[8 * s + 4], x[8 * s + 5]); p[3] = pk2(x[8 * s + 6], x[8 * s + 7]);
    return __builtin_bit_cast(bf16x8, p);
}
#define MFMA32(a, b, c) __builtin_amdgcn_mfma_f32_32x32x16_bf16((a), (b), (c), 0, 0, 0)

DI void transpose_item(const float* Wsrc, int K, int N, bf16_t* WT, LAS float* scr, int item, int lane) {
    const int nblk = N / 64, kb = item / nblk, nb = item % nblk, k0 = 64 * kb, n0 = 64 * nb;
    const int lr = lane >> 4, lc = (lane & 15) * 4;
    f32x4 v[16];
#pragma unroll
    for (int i = 0; i < 16; ++i) v[i] = *(const f32x4*)(Wsrc + (size_t)(k0 + 4 * i + lr) * N + n0 + lc);
#pragma unroll
    for (int i = 0; i < 16; ++i) { LAS float* d = scr + (4 * i + lr) * 65 + lc; d[0] = v[i][0]; d[1] = v[i][1]; d[2] = v[i][2]; d[3] = v[i][3]; }
    __builtin_amdgcn_wave_barrier();
    const int c = lane & 7;
#pragma unroll
    for (int j = 0; j < 8; ++j) { const int n = (lane >> 3) + 8 * j; const LAS float* s = scr + (8 * c) * 65 + n;
        u32x4 o; o[0] = pk2(s[0 * 65], s[1 * 65]); o[1] = pk2(s[2 * 65], s[3 * 65]); o[2] = pk2(s[4 * 65], s[5 * 65]); o[3] = pk2(s[6 * 65], s[7 * 65]);
        *(u32x4*)(WT + (size_t)(n0 + n) * K + k0 + 8 * c) = o; }
    __builtin_amdgcn_wave_barrier();
}
DI int t5_bucket(int rel) {
    const int ret = rel > 0 ? 16 : 0; const int n = rel < 0 ? -rel : rel;
    const float nf = (float)(n > 1 ? n : 1);
    int large = 8 + (int)(logf(nf / 8.0f) / 4.852030263919617f * 8.0f);
    large = large < 15 ? large : 15;
    return ret + (n < 8 ? n : large);
}
DI void phase_prologue(const Params& p, LAS unsigned char* lds) {
    const int tid = tidx(), wave = tid >> 6, lane = tid & 63;
    const int gw = blockIdx.x * NWAVES + wave, NGW = gridDim.x * NWAVES;
    LAS float* scr = (LAS float*)(lds + wave * 16640);
    bf16_t* win_t = (bf16_t*)(p.ws + WS_WIN); bf16_t* wpr_t = (bf16_t*)(p.ws + WS_WPR); bf16_t* wout_t = (bf16_t*)(p.ws + WS_WOUT);
    constexpr int IT_IN = (D / 64) * (NIN / 64), IT_PR = (1024 / 64) * (D / 64), IT_OUT = (D / 64) * (D / 64);
    constexpr int TOT = DEPTH * IT_IN + DEPTH * 3 * IT_PR + DEPTH * IT_OUT;
    for (int it = gw; it < TOT; it += NGW) {
        int r = it;
        if (r < DEPTH * IT_IN) { const int l = r / IT_IN; transpose_item(p.in[I_WIN] + (size_t)l * D * NIN, D, NIN, win_t + (size_t)l * NIN * D, scr, r % IT_IN, lane); continue; }
        r -= DEPTH * IT_IN;
        if (r < DEPTH * 3 * IT_PR) { const int l = r / IT_PR; transpose_item(p.in[I_WPROJ] + (size_t)l * 1024 * D, 1024, D, wpr_t + (size_t)l * D * 1024, scr, r % IT_PR, lane); continue; }
        r -= DEPTH * 3 * IT_PR;
        { const int l = r / IT_OUT; transpose_item(p.in[I_WOUT] + (size_t)l * D * D, D, D, wout_t + (size_t)l * D * D, scr, r % IT_OUT, lane); }
    }
    float* bias = (float*)(p.ws + WS_BIAS);
    for (int i = blockIdx.x * NTHR + tid; i < 32 * 2049; i += gridDim.x * NTHR) {
        const int hd = i / 2049, rel = (i % 2049) - 1024;
        bias[i] = p.in[I_RELB][t5_bucket(rel) * 32 + hd] * LOG2E;
    }
    __syncthreads();
    LAS float* zemb = (LAS float*)lds;
    LAS float* h1 = (LAS float*)(lds + 2048);
    float* hid2 = (float*)(p.ws + WS_HID2);
    for (int rb = blockIdx.x; rb < S / 8; rb += gridDim.x) {
        const int rl = tid >> 6, j = tid & 63, i = rb * 8 + rl;
        if (j < 33) {
            float z;
            if (j == 0) z = (float)i / 8191.0f;
            else { const int k = (j - 1) & 15; const float fb = 1e-4f + (float)k * ((15.0f - 1e-4f) / 15.0f); const float w = 6.283185307179586f * (float)i / 8192.0f; const float a = fb * w; z = (j <= 16) ? cosf(a) : -sinf(a); }
            zemb[rl * 36 + j] = z;
        }
        __syncthreads();
        for (int l = 0; l < DEPTH; ++l) {
            float a1 = p.in[I_HYB1][l * 64 + j];
            for (int e = 0; e < 33; ++e) a1 += zemb[rl * 36 + e] * p.in[I_HYW1][(l * 33 + e) * 64 + j];
            h1[rl * 64 + j] = sinf(p.in[I_HYFREQ][(l * 2 + 0) * 64 + j] * a1);
            __syncthreads();
            float a2 = p.in[I_HYB2][l * 64 + j];
            for (int e = 0; e < 64; ++e) a2 += h1[rl * 64 + e] * p.in[I_HYW2][(l * 64 + e) * 64 + j];
            hid2[((size_t)l * S + i) * 64 + j] = sinf(p.in[I_HYFREQ][(l * 2 + 1) * 64 + j] * a2);
            __syncthreads();
        }
    }
}


DI void split8(const f32x4 a, const f32x4 b, bf16x8& hi, bf16x8& lo) {
    u32x4 h, l2;
    h[0] = pk2(a[0], a[1]); h[1] = pk2(a[2], a[3]); h[2] = pk2(b[0], b[1]); h[3] = pk2(b[2], b[3]);
    l2[0] = pk2(a[0] - bflo(h[0]), a[1] - bfhi(h[0])); l2[1] = pk2(a[2] - bflo(h[1]), a[3] - bfhi(h[1]));
    l2[2] = pk2(b[0] - bflo(h[2]), b[1] - bfhi(h[2])); l2[3] = pk2(b[2] - bflo(h[3]), b[3] - bfhi(h[3]));
    hi = __builtin_bit_cast(bf16x8, h); lo = __builtin_bit_cast(bf16x8, l2);
}
DI void phase_tgen(const Params& p) {
    const int tid = tidx(), wave = tid >> 6, lane = tid & 63, r = lane & 31, hh = lane >> 5;
    float* tt = (float*)(p.ws + WS_TT);
    for (int it = blockIdx.x * NWAVES + wave; it < DEPTH * 128 * 4; it += gridDim.x * NWAVES) {
        const int l = it >> 9, cb = (it >> 2) & 127, rc = it & 3;
        const float* w3 = p.in[I_HYW3] + (size_t)l * 64 * 4096 + cb * 32 + r;
        bf16x8 ahi[4], alo[4];
#pragma unroll
        for (int ks = 0; ks < 4; ++ks) {
            f32x4 a, b;
#pragma unroll
            for (int j = 0; j < 4; ++j) { a[j] = w3[(size_t)(16 * ks + 8 * hh + j) * 4096]; b[j] = w3[(size_t)(16 * ks + 8 * hh + 4 + j) * 4096]; }
            split8(a, b, ahi[ks], alo[ks]);
        }
        const float* hid2 = (const float*)(p.ws + WS_HID2) + (size_t)l * S * 64;
        f32x4 ha[4], hb[4];
        { const float* hr = hid2 + (size_t)(rc * 2048 + r) * 64 + 8 * hh;
#pragma unroll
          for (int ks = 0; ks < 4; ++ks) { ha[ks] = *(const f32x4*)(hr + 16 * ks); hb[ks] = *(const f32x4*)(hr + 16 * ks + 4); } }
#pragma unroll 1
        for (int rb = 0; rb < 64; ++rb) {
            const int i0 = rc * 2048 + rb * 32;
            bf16x8 bhi[4], blo[4];
#pragma unroll
            for (int ks = 0; ks < 4; ++ks) split8(ha[ks], hb[ks], bhi[ks], blo[ks]);
            if (rb + 1 < 64) { const float* hr = hid2 + (size_t)(i0 + 32 + r) * 64 + 8 * hh;
#pragma unroll
                for (int ks = 0; ks < 4; ++ks) { ha[ks] = *(const f32x4*)(hr + 16 * ks); hb[ks] = *(const f32x4*)(hr + 16 * ks + 4); } }
            f32x16 acc;
#pragma unroll
            for (int i = 0; i < 16; ++i) acc[i] = 0.f;
#pragma unroll
            for (int ks = 0; ks < 4; ++ks) { acc = MFMA32(ahi[ks], bhi[ks], acc); acc = MFMA32(ahi[ks], blo[ks], acc); acc = MFMA32(alo[ks], bhi[ks], acc); }
            float* tp = tt + ((size_t)l * 4096 + cb * 32) * S + i0 + r;
#pragma unroll
            for (int reg = 0; reg < 16; ++reg) tp[(size_t)crow(reg, hh) * S] = acc[reg];
        }
    }
}

#define XI(i) ((i) + ((i) >> 4) + ((i) >> 8))
DI cf cmul(cf a, cf b) {
    cf t, r;
    asm("v_pk_mul_f32 %0, %1, %2 op_sel:[0,0] op_sel_hi:[0,1]" : "=v"(t) : "v"(a), "v"(b));
    asm("v_pk_fma_f32 %0, %1, %2, %3 op_sel:[1,1,0] op_sel_hi:[1,0,1] neg_lo:[0,1,0]" : "=v"(r) : "v"(a), "v"(b), "v"(t));
    return r;
}
DI cf twid(float frac) { float c = __builtin_amdgcn_cosf(frac), s = __builtin_amdgcn_sinf(frac); asm volatile("s_nop 1" : "+v"(c), "+v"(s)); return (cf){c, -s}; }
DI cf twidc(float frac) { float c = __builtin_amdgcn_cosf(frac), s = __builtin_amdgcn_sinf(frac); asm volatile("s_nop 1" : "+v"(c), "+v"(s)); return (cf){c, s}; }
DI void fwd4(cf& a0, cf& a1, cf& a2, cf& a3) {
    const cf s02 = a0 + a2, d02 = a0 - a2, s13 = a1 + a3, d13 = a1 - a3;
    a0 = s02 + s13; a2 = s02 - s13;
    a1 = (cf){d02.x + d13.y, d02.y - d13.x};
    a3 = (cf){d02.x - d13.y, d02.y + d13.x};
}
DI void inv4(cf& b0, cf& b1, cf& b2, cf& b3) {
    const cf s02 = b0 + b2, d02 = b0 - b2, s13 = b1 + b3, d13 = b1 - b3;
    b0 = s02 + s13; b2 = s02 - s13;
    b1 = (cf){d02.x - d13.y, d02.y + d13.x};
    b3 = (cf){d02.x + d13.y, d02.y - d13.x};
}
template <int LOGM> DI void fwd_r4_pass(LAS cf* X, int tid) {
    asm volatile("" : "+v"(tid));
    constexpr int M = 1 << LOGM, q = M >> 2;
#pragma unroll 2
    for (int t = tid; t < 4096; t += NTHR) {
        const int j = t & (q - 1), base = (t >> (LOGM - 2)) * M + j;
        constexpr int QP = (q >= 256) ? (q + (q >> 4) + (q >> 8)) : ((q == 16) ? 17 : 1);
        LAS cf* xp = X + XI(base);
        cf a0 = xp[0], a1 = xp[QP], a2 = xp[2 * QP], a3 = xp[3 * QP];
        fwd4(a0, a1, a2, a3);
        const cf w1 = twid((float)j * (1.0f / M)), w2 = cmul(w1, w1), w3 = cmul(w2, w1);
        xp[0] = a0; xp[QP] = cmul(a1, w1); xp[2 * QP] = cmul(a2, w2); xp[3 * QP] = cmul(a3, w3);
    }
}
template <int LOGM> DI void inv_r4_pass(LAS cf* X, int tid) {
    asm volatile("" : "+v"(tid));
    constexpr int M = 1 << LOGM, q = M >> 2;
#pragma unroll 2
    for (int t = tid; t < 4096; t += NTHR) {
        const int j = t & (q - 1), base = (t >> (LOGM - 2)) * M + j;
        const cf w1 = twidc((float)j * (1.0f / M)), w2 = cmul(w1, w1), w3 = cmul(w2, w1);
        constexpr int QP = (q >= 256) ? (q + (q >> 4) + (q >> 8)) : ((q == 16) ? 17 : 1);
        LAS cf* xp = X + XI(base);
        cf b0 = xp[0], b1 = cmul(xp[QP], w1), b2 = cmul(xp[2 * QP], w2), b3 = cmul(xp[3 * QP], w3);
        inv4(b0, b1, b2, b3);
        xp[0] = b0; xp[QP] = b1; xp[2 * QP] = b2; xp[3 * QP] = b3;
    }
}
template <int LOGM> DI void fwd16(cf (&v)[16], int j) {
    constexpr int M = 1 << LOGM, q = M >> 4;
#pragma unroll
    for (int n = 0; n < 4; ++n) {
        fwd4(v[n], v[n + 4], v[n + 8], v[n + 12]);
        const cf w1 = twid((float)(j + n * q) * (1.0f / M)), w2 = cmul(w1, w1), w3 = cmul(w2, w1);
        v[n + 4] = cmul(v[n + 4], w1); v[n + 8] = cmul(v[n + 8], w2); v[n + 12] = cmul(v[n + 12], w3);
    }
    const cf u1 = twid((float)j * (4.0f / M)), u2 = cmul(u1, u1), u3 = cmul(u2, u1);
#pragma unroll
    for (int m = 0; m < 4; ++m) {
        fwd4(v[4 * m], v[4 * m + 1], v[4 * m + 2], v[4 * m + 3]);
        v[4 * m + 1] = cmul(v[4 * m + 1], u1); v[4 * m + 2] = cmul(v[4 * m + 2], u2); v[4 * m + 3] = cmul(v[4 * m + 3], u3);
    }
}
template <int LOGM> DI void inv16(cf (&v)[16], int j) {
    constexpr int M = 1 << LOGM, q = M >> 4;
    const cf u1 = twidc((float)j * (4.0f / M)), u2 = cmul(u1, u1), u3 = cmul(u2, u1);
#pragma unroll
    for (int m = 0; m < 4; ++m) {
        v[4 * m + 1] = cmul(v[4 * m + 1], u1); v[4 * m + 2] = cmul(v[4 * m + 2], u2); v[4 * m + 3] = cmul(v[4 * m + 3], u3);
        inv4(v[4 * m], v[4 * m + 1], v[4 * m + 2], v[4 * m + 3]);
    }
#pragma unroll
    for (int n = 0; n < 4; ++n) {
        const cf w1 = twidc((float)(j + n * q) * (1.0f / M)), w2 = cmul(w1, w1), w3 = cmul(w2, w1);
        v[n + 4] = cmul(v[n + 4], w1); v[n + 8] = cmul(v[n + 8], w2); v[n + 12] = cmul(v[n + 12], w3);
        inv4(v[n], v[n + 4], v[n + 8], v[n + 12]);
    }
}
template <int LOGM> DI void fwd_r16_pass(LAS cf* X, int tid) {
    asm volatile("" : "+v"(tid));
    constexpr int M = 1 << LOGM, q = M >> 4;
#pragma unroll 1
    for (int t = tid; t < 1024; t += NTHR) {
        const int j = t & (q - 1), base = (t >> (LOGM - 4)) * M + j;
        constexpr int QP = (q >= 256) ? (q + (q >> 4) + (q >> 8)) : ((q == 16) ? 17 : 1);
        LAS cf* xp = X + XI(base);
        cf v[16];
#pragma unroll
        for (int n = 0; n < 16; ++n) v[n] = xp[n * QP];
        fwd16<LOGM>(v, j);
#pragma unroll
        for (int n = 0; n < 16; ++n) xp[n * QP] = v[n];
    }
}
template <int LOGM> DI void inv_r16_pass(LAS cf* X, int tid) {
    asm volatile("" : "+v"(tid));
    constexpr int M = 1 << LOGM, q = M >> 4;
#pragma unroll 1
    for (int t = tid; t < 1024; t += NTHR) {
        const int j = t & (q - 1), base = (t >> (LOGM - 4)) * M + j;
        constexpr int QP = (q >= 256) ? (q + (q >> 4) + (q >> 8)) : ((q == 16) ? 17 : 1);
        LAS cf* xp = X + XI(base);
        cf v[16];
#pragma unroll
        for (int n = 0; n < 16; ++n) v[n] = xp[n * QP];
        inv16<LOGM>(v, j);
#pragma unroll
        for (int n = 0; n < 16; ++n) xp[n * QP] = v[n];
    }
}
DI int rev4(int pp) { const unsigned br = __brev((unsigned)pp) >> 18; return (int)(((br & 0x2AAAu) >> 1) | ((br & 0x1555u) << 1)); }
DI void fft_forward(LAS cf* X, int tid) {
    fwd_r4_pass<14>(X, tid); __syncthreads();
    fwd_r16_pass<12>(X, tid); __syncthreads();
    fwd_r16_pass<8>(X, tid); __syncthreads();
    fwd_r16_pass<4>(X, tid); __syncthreads();
}
constexpr int SPEC_STRIDE = 8208;
DI void fft_conv(LAS cf* X, const f32x4* spec, int tid) {
    fft_forward(X, tid);
#pragma unroll 8
    for (int r = 0; r < 16; ++r) {
        const int k = tid + NTHR * r; const int pp = rev4(k);
        const f32x4 sp = spec[k]; const cf P = (cf){sp[0], sp[1]}, Mq = (cf){sp[2], sp[3]};
        const cf z = X[XI(pp)];
        if (k == 0) { X[XI(pp)] = cmul(z, P) + cmul((cf){z.x, -z.y}, Mq); }
        else { const int pm = rev4(16384 - k); const cf zm = X[XI(pm)];
            const cf y = cmul(z, P) + cmul((cf){zm.x, -zm.y}, Mq);
            const cf t = cmul((cf){zm.x, -zm.y}, P) + cmul(z, Mq);
            X[XI(pp)] = y; X[XI(pm)] = (cf){t.x, -t.y}; }
    }
    if (tid == 0) { const int pp = rev4(8192); const f32x4 sp = spec[8192]; const cf z = X[XI(pp)]; X[XI(pp)] = cmul(z, (cf){sp[0], sp[1]}) + cmul((cf){z.x, -z.y}, (cf){sp[2], sp[3]}); }
    __syncthreads();
    inv_r16_pass<4>(X, tid); __syncthreads();
    inv_r16_pass<8>(X, tid); __syncthreads();
    inv_r16_pass<12>(X, tid); __syncthreads();
    inv_r4_pass<14>(X, tid); __syncthreads();
}


typedef _Float16 hc __attribute__((ext_vector_type(2)));
DI hc hcmul(hc a, hc b) { hc t, r;
    asm("v_pk_mul_f16 %0, %1, %2 op_sel:[0,0] op_sel_hi:[0,1]" : "=v"(t) : "v"(a), "v"(b));
    asm("v_pk_fma_f16 %0, %1, %2, %3 op_sel:[1,1,0] op_sel_hi:[1,0,1] neg_lo:[0,1,0]" : "=v"(r) : "v"(a), "v"(b), "v"(t)); return r; }
DI hc hadd_mi(hc a, hc b) { hc r; asm("v_pk_add_f16 %0, %1, %2 op_sel:[0,1] op_sel_hi:[1,0] neg_hi:[0,1]" : "=v"(r) : "v"(a), "v"(b)); return r; }
DI hc hadd_pi(hc a, hc b) { hc r; asm("v_pk_add_f16 %0, %1, %2 op_sel:[0,1] op_sel_hi:[1,0] neg_lo:[0,1]" : "=v"(r) : "v"(a), "v"(b)); return r; }
DI hc htwid(float frac) { float c = __builtin_amdgcn_cosf(frac), s = __builtin_amdgcn_sinf(frac); asm volatile("s_nop 1" : "+v"(c), "+v"(s)); return (hc){(_Float16)c, (_Float16)(-s)}; }
DI hc htwidc(float frac) { float c = __builtin_amdgcn_cosf(frac), s = __builtin_amdgcn_sinf(frac); asm volatile("s_nop 1" : "+v"(c), "+v"(s)); return (hc){(_Float16)c, (_Float16)s}; }
DI void hfwd4(hc& a0, hc& a1, hc& a2, hc& a3) {
    const hc s02 = a0 + a2, d02 = a0 - a2, s13 = a1 + a3, d13 = a1 - a3;
    a0 = s02 + s13; a2 = s02 - s13; a1 = hadd_mi(d02, d13); a3 = hadd_pi(d02, d13);
}
DI void hinv4(hc& b0, hc& b1, hc& b2, hc& b3) {
    const hc s02 = b0 + b2, d02 = b0 - b2, s13 = b1 + b3, d13 = b1 - b3;
    b0 = s02 + s13; b2 = s02 - s13; b1 = hadd_pi(d02, d13); b3 = hadd_mi(d02, d13);
}
template <int LOGM> DI void hfwd_r4_pass(LAS hc* X, int tid) {
    asm volatile("" : "+v"(tid));
    constexpr int M = 1 << LOGM, q = M >> 2;
#pragma unroll 8
    for (int t = tid; t < 4096; t += NTHR) {
        const int j = t & (q - 1), base = (t >> (LOGM - 2)) * M + j;
        constexpr int QP = (q >= 256) ? (q + (q >> 4) + (q >> 8)) : ((q == 16) ? 17 : 1);
        LAS hc* xp = X + XI(base);
        hc a0 = xp[0], a1 = xp[QP], a2 = xp[2 * QP], a3 = xp[3 * QP];
        hfwd4(a0, a1, a2, a3);
        const hc w1 = htwid((float)j * (1.0f / M)), w2 = hcmul(w1, w1), w3 = hcmul(w2, w1);
        xp[0] = a0; xp[QP] = hcmul(a1, w1); xp[2 * QP] = hcmul(a2, w2); xp[3 * QP] = hcmul(a3, w3);
    }
}
template <int LOGM> DI void hinv_r4_pass(LAS hc* X, int tid) {
    asm volatile("" : "+v"(tid));
    constexpr int M = 1 << LOGM, q = M >> 2;
#pragma unroll 8
    for (int t = tid; t < 4096; t += NTHR) {
        const int j = t & (q - 1), base = (t >> (LOGM - 2)) * M + j;
        const hc w1 = htwidc((float)j * (1.0f / M)), w2 = hcmul(w1, w1), w3 = hcmul(w2, w1);
        constexpr int QP = (q >= 256) ? (q + (q >> 4) + (q >> 8)) : ((q == 16) ? 17 : 1);
        LAS hc* xp = X + XI(base);
        hc b0 = xp[0], b1 = hcmul(xp[QP], w1), b2 = hcmul(xp[2 * QP], w2), b3 = hcmul(xp[3 * QP], w3);
        hinv4(b0, b1, b2, b3);
        xp[0] = b0; xp[QP] = b1; xp[2 * QP] = b2; xp[3 * QP] = b3;
    }
}
template <int LOGM> DI void hfwd16(hc (&v)[16], int j) {
    constexpr int M = 1 << LOGM, q = M >> 4;
#pragma unroll
    for (int n = 0; n < 4; ++n) {
        hfwd4(v[n], v[n + 4], v[n + 8], v[n + 12]);
        const hc w1 = htwid((float)(j + n * q) * (1.0f / M)), w2 = hcmul(w1, w1), w3 = hcmul(w2, w1);
        v[n + 4] = hcmul(v[n + 4], w1); v[n + 8] = hcmul(v[n + 8], w2); v[n + 12] = hcmul(v[n + 12], w3);
    }
    const hc u1 = htwid((float)j * (4.0f / M)), u2 = hcmul(u1, u1), u3 = hcmul(u2, u1);
#pragma unroll
    for (int m = 0; m < 4; ++m) {
        hfwd4(v[4 * m], v[4 * m + 1], v[4 * m + 2], v[4 * m + 3]);
        v[4 * m + 1] = hcmul(v[4 * m + 1], u1); v[4 * m + 2] = hcmul(v[4 * m + 2], u2); v[4 * m + 3] = hcmul(v[4 * m + 3], u3);
    }
}
template <int LOGM> DI void hinv16(hc (&v)[16], int j) {
    constexpr int M = 1 << LOGM, q = M >> 4;
    const hc u1 = htwidc((float)j * (4.0f / M)), u2 = hcmul(u1, u1), u3 = hcmul(u2, u1);
#pragma unroll
    for (int m = 0; m < 4; ++m) {
        v[4 * m + 1] = hcmul(v[4 * m + 1], u1); v[4 * m + 2] = hcmul(v[4 * m + 2], u2); v[4 * m + 3] = hcmul(v[4 * m + 3], u3);
        hinv4(v[4 * m], v[4 * m + 1], v[4 * m + 2], v[4 * m + 3]);
    }
#pragma unroll
    for (int n = 0; n < 4; ++n) {
        const hc w1 = htwidc((float)(j + n * q) * (1.0f / M)), w2 = hcmul(w1, w1), w3 = hcmul(w2, w1);
        v[n + 4] = hcmul(v[n + 4], w1); v[n + 8] = hcmul(v[n + 8], w2); v[n + 12] = hcmul(v[n + 12], w3);
        hinv4(v[n], v[n + 4], v[n + 8], v[n + 12]);
    }
}
template <int LOGM, bool FWD> DI void h_r16_pass(LAS hc* X, int tid) {
    asm volatile("" : "+v"(tid));
    constexpr int M = 1 << LOGM, q = M >> 4;
#pragma unroll
    for (int t = tid; t < 1024; t += NTHR) {
        const int j = t & (q - 1), base = (t >> (LOGM - 4)) * M + j;
        constexpr int QP = (q >= 256) ? (q + (q >> 4) + (q >> 8)) : ((q == 16) ? 17 : 1);
        LAS hc* xp = X + XI(base);
        hc v[16];
#pragma unroll
        for (int n = 0; n < 16; ++n) v[n] = xp[n * QP];
        if (FWD) hfwd16<LOGM>(v, j); else hinv16<LOGM>(v, j);
#pragma unroll
        for (int n = 0; n < 16; ++n) xp[n * QP] = v[n];
    }
}
DI void fft_conv_h(LAS hc* X, const f32x4* spec, int tid) {
    hfwd_r4_pass<14>(X, tid); __syncthreads();
    h_r16_pass<12, true>(X, tid); __syncthreads();
    h_r16_pass<8, true>(X, tid); __syncthreads();
    h_r16_pass<4, true>(X, tid); __syncthreads();
#pragma unroll 8
    for (int r = 0; r < 16; ++r) {
        const int k = tid + NTHR * r; const int pp = rev4(k);
        const f32x4 sp = spec[k]; const cf P = (cf){sp[0], sp[1]} * 256.0f, Mq = (cf){sp[2], sp[3]} * 256.0f;
        const hc zh = X[XI(pp)]; const cf z = (cf){(float)zh.x, (float)zh.y};
        if (k == 0) { const cf y = cmul(z, P) + cmul((cf){z.x, -z.y}, Mq); X[XI(pp)] = (hc){(_Float16)y.x, (_Float16)y.y}; }
        else { const int pm = rev4(16384 - k); const hc zmh = X[XI(pm)]; const cf zm = (cf){(float)zmh.x, (float)zmh.y};
            const cf y = cmul(z, P) + cmul((cf){zm.x, -zm.y}, Mq);
            const cf t = cmul((cf){zm.x, -zm.y}, P) + cmul(z, Mq);
            X[XI(pp)] = (hc){(_Float16)y.x, (_Float16)y.y}; X[XI(pm)] = (hc){(_Float16)t.x, (_Float16)(-t.y)}; }
    }
    if (tid == 0) { const int pp = rev4(8192); const f32x4 sp = spec[8192]; const hc zh = X[XI(pp)]; const cf z = (cf){(float)zh.x, (float)zh.y};
        const cf y = (cmul(z, (cf){sp[0], sp[1]}) + cmul((cf){z.x, -z.y}, (cf){sp[2], sp[3]})) * 256.0f; X[XI(pp)] = (hc){(_Float16)y.x, (_Float16)y.y}; }
    __syncthreads();
    h_r16_pass<4, false>(X, tid); __syncthreads();
    h_r16_pass<8, false>(X, tid); __syncthreads();
    h_r16_pass<12, false>(X, tid); __syncthreads();
    hinv_r4_pass<14>(X, tid); __syncthreads();
}

DI void spectra_item(const Params& p, int item, LAS unsigned char* lds) {
    int tid = tidx(); asm volatile("" : "+v"(tid));
    const int l = item >> 10, o = (item >> 9) & 1, pr = item & 511, a = 2 * pr;
    LAS hc* X = (LAS hc*)lds; LAS float* aux = (LAS float*)(lds + LDS_MAIN);
    const float mind = -3.0701134573253943f, maxd = -15.350567286626972f;
    const float da = fabsf(mind + (float)a * ((maxd - mind) / 1023.0f)), db = fabsf(mind + (float)(a + 1) * ((maxd - mind) / 1023.0f));
    const float ska = p.in[I_HYSKIP][(l * 2 + o) * 1024 + a], skb = p.in[I_HYSKIP][(l * 2 + o) * 1024 + a + 1];
    const float* tf = (const float*)(p.ws + WS_TT) + ((size_t)l * 4096 + (o * 2 + 0) * 1024 + a) * S;
    const float* tb = (const float*)(p.ws + WS_TT) + ((size_t)l * 4096 + (o * 2 + 1) * 1024 + a) * S;
#pragma unroll 16
    for (int rr = 0; rr < 16; ++rr) {
        const int i = tid + NTHR * rr;
        const float ti = (float)i / 8191.0f; const float ea = __expf(-ti * da), eb = __expf(-ti * db);
        const float fa = tf[i] * ea, fb = tf[S + i] * eb, ba = tb[i] * ea, bb = tb[S + i] * eb;
        if (i == 0) { X[XI(0)] = (hc){(_Float16)((fa + ba + ska) * 256.0f), (_Float16)((fb + bb + skb) * 256.0f)}; X[XI(8192)] = (hc){(_Float16)0.f, (_Float16)0.f}; }
        else { X[XI(i)] = (hc){(_Float16)(fa * 256.0f), (_Float16)(fb * 256.0f)}; X[XI(16384 - i)] = (hc){(_Float16)(ba * 256.0f), (_Float16)(bb * 256.0f)}; }
    }
    __syncthreads();
    hfwd_r4_pass<14>(X, tid); __syncthreads();
    h_r16_pass<12, true>(X, tid); __syncthreads();
    h_r16_pass<8, true>(X, tid); __syncthreads();
    h_r16_pass<4, true>(X, tid); __syncthreads();
    f32x4* spec = (f32x4*)(p.ws + WS_SPEC) + (size_t)item * SPEC_STRIDE;
    const float sc = 0.5f / 16384.0f / 256.0f;
    for (int r = 0; r < 17; ++r) {
        const int k = tid + NTHR * r; if (k > 8192) break;
        const hc Fh = X[XI(rev4(k))], Fmh = X[XI(rev4((16384 - k) & 16383))]; const cf F = (cf){(float)Fh.x, (float)Fh.y}, Fm = (cf){(float)Fmh.x, (float)Fmh.y};
        const cf Fc = (cf){Fm.x, -Fm.y};
        const cf Ha = (F + Fc) * 0.5f, tt = (F - Fc) * 0.5f; const cf Hb = (cf){tt.y, -tt.x};
        const cf P = (Ha + Hb) * sc, Mq = (Ha - Hb) * sc;
        spec[k] = (f32x4){P.x, P.y, Mq.x, Mq.y};
    }
    __syncthreads();
}

DI float conv3(const float* row, int t, float w0, float w1, float w2) {
    const float c = row[t]; float pv = row[t > 0 ? t - 1 : 0], nx = row[t < S - 1 ? t + 1 : S - 1];
    pv = t > 0 ? pv : 0.f; nx = t < S - 1 ? nx : 0.f;
    return w0 * pv + w1 * c + w2 * nx;
}
DI void hyena_item(const Params& p, int l, int pr, LAS unsigned char* lds) {
    int tid = tidx(); asm volatile("" : "+v"(tid)); const int a = 2 * pr;
    LAS hc* X = (LAS hc*)lds;
    const float* bint = (const float*)(p.ws + WS_BINT);
    const float* cw = p.in[I_HYCONV] + (size_t)l * 3 * 3072;
    float w[3][2][3];
#pragma unroll
    for (int wh = 0; wh < 3; ++wh)
#pragma unroll
        for (int c = 0; c < 2; ++c)
#pragma unroll
            for (int k = 0; k < 3; ++k) w[wh][c][k] = cw[k * 3072 + wh * 1024 + a + c];
    const f32x4* spec = (const f32x4*)(p.ws + WS_SPEC);
    const hc hzero = (hc){(_Float16)0.f, (_Float16)0.f};
#pragma unroll 8
    for (int r = 0; r < 16; ++r) { const int t = tid + NTHR * r;
        const float va = conv3(bint + (size_t)a * S, t, w[0][0][0], w[0][0][1], w[0][0][2]), vb = conv3(bint + (size_t)(a + 1) * S, t, w[0][1][0], w[0][1][1], w[0][1][2]);
        X[XI(t)] = (hc){(_Float16)(va * 0.25f), (_Float16)(vb * 0.25f)};
        X[XI(t + 8192)] = hzero; }
    __syncthreads();
    fft_conv_h(X, spec + (size_t)((l * 2 + 0) * 512 + pr) * SPEC_STRIDE, tid);
#pragma unroll 8
    for (int r = 0; r < 16; ++r) { const int t = tid + NTHR * r; const hc y = X[XI(t)];
        const float za = (float)y.x * (1.0f / 64.0f) * conv3(bint + (size_t)(1024 + a) * S, t, w[1][0][0], w[1][0][1], w[1][0][2]);
        const float zb = (float)y.y * (1.0f / 64.0f) * conv3(bint + (size_t)(1024 + a + 1) * S, t, w[1][1][0], w[1][1][1], w[1][1][2]);
        X[XI(t)] = (hc){(_Float16)(za * 0.25f), (_Float16)(zb * 0.25f)};
        X[XI(t + 8192)] = hzero; }
    __syncthreads();
    fft_conv_h(X, spec + (size_t)((l * 2 + 1) * 512 + pr) * SPEC_STRIDE, tid);
    float* z2t = (float*)(p.ws + WS_Z2T);
#pragma unroll 8
    for (int r = 0; r < 16; ++r) { const int t = tid + NTHR * r; const hc y = X[XI(t)];
        z2t[(size_t)a * S + t] = (float)y.x * (1.0f / 64.0f) * conv3(bint + (size_t)(2048 + a) * S, t, w[2][0][0], w[2][0][1], w[2][0][2]);
        z2t[(size_t)(a + 1) * S + t] = (float)y.y * (1.0f / 64.0f) * conv3(bint + (size_t)(2048 + a + 1) * S, t, w[2][1][0], w[2][1][1], w[2][1][2]); }
    __syncthreads();
}
DI void phase_rmsnorm(const float* x, const float* g, bf16_t* hout, float* fout) {
    const int tid = tidx(), wave = tid >> 6, lane = tid & 63;
    for (int row = blockIdx.x * NWAVES + wave; row < S; row += gridDim.x * NWAVES) {
        const f32x4* xr = (const f32x4*)(x + (size_t)row * D) + lane;
        f32x4 v[8]; float s = 0.f;
#pragma unroll
        for (int j = 0; j < 8; ++j) { v[j] = xr[64 * j]; s += (v[j][0] * v[j][0] + v[j][1] * v[j][1]) + (v[j][2] * v[j][2] + v[j][3] * v[j][3]); }
        const float rstd = rsqrtf(wave_sum(s) * (1.0f / D) + 1e-6f);
#pragma unroll
        for (int j = 0; j < 8; ++j) { const f32x4 gg = ((const f32x4*)g)[lane + 64 * j]; const f32x4 y = v[j] * rstd * gg;
            if (hout) { u32x2 o = {pk2(y[0], y[1]), pk2(y[2], y[3])}; ((u32x2*)(hout + (size_t)row * D))[lane + 64 * j] = o; }
            else ((f32x4*)(fout + (size_t)row * D))[lane + 64 * j] = y; }
    }
}

constexpr int KROW = 144, KBUF = 64 * KROW, VBUF = 128 * KROW;
DI void qk_half(const LAS unsigned char* kb_, const bf16x8 (&qf)[4], int r, int hh, f32x16& s) {
#pragma unroll
    for (int i = 0; i < 16; ++i) s[i] = 0.f;
#pragma unroll
    for (int ks = 0; ks < 4; ++ks) { const bf16x8 a = *(const LAS bf16x8*)(kb_ + r * KROW + 32 * ks + 16 * hh); s = MFMA32(a, qf[ks], s); }
}
DI void softmax_pv_half(f32x16& s, const LAS unsigned char* vb_, const LAS float* btab, int k0, int q0w, int r, int hh, float cs, float& m, float& lsum, f32x16 (&O)[4]) {
    const int q = q0w + r;
    const int relmin = k0 - q0w - 31, relmax = k0 + 31 - q0w;
    const bool far = (relmin >= 1024 || relmax <= -1024);
    float bc = 0.f, csx = cs;
    if (far) { bc = btab[relmin >= 1024 ? 2048 : 0]; }
    else {
        if (relmin >= -1024 && relmax <= 1024) {
            const LAS float* bp = btab + (k0 - q + 1024 + 4 * hh);
#pragma unroll
            for (int i = 0; i < 16; ++i) s[i] = s[i] * cs + bp[(i & 3) + 8 * (i >> 2)];
        } else {
#pragma unroll
            for (int i = 0; i < 16; ++i) { const int rel = k0 + crow(i, hh) - q; const int i0 = min(max(rel, -1024), 1024) + 1024; s[i] = s[i] * cs + btab[i0]; }
        }
        csx = 1.0f;
    }
    float mx = s[0];
#pragma unroll
    for (int i = 1; i < 16; ++i) mx = fmaxf(mx, s[i]);
    mx = mx * csx + bc;
    mx = fmaxf(mx, __shfl_xor(mx, 32));
    if (__any(mx > m + 8.0f)) {
        const float mnew = fmaxf(m, mx), alpha = __builtin_amdgcn_exp2f(m - mnew);
        m = mnew; lsum *= alpha;
#pragma unroll
        for (int db = 0; db < 4; ++db) O[db] *= alpha;
    }
    const float c2 = bc - m;
    float rs0 = 0.f, rs1 = 0.f;
#pragma unroll
    for (int i = 0; i < 16; i += 2) { s[i] = __builtin_amdgcn_exp2f(s[i] * csx + c2); s[i + 1] = __builtin_amdgcn_exp2f(s[i + 1] * csx + c2); rs0 += s[i]; rs1 += s[i + 1]; }
    lsum += rs0 + rs1;
#pragma unroll
    for (int ss = 0; ss < 2; ++ss) {
        const bf16x8 pf = pack8(s, ss);
#pragma unroll
        for (int db = 0; db < 4; ++db) {
            const bf16x8 vf = *(const LAS bf16x8*)(vb_ + (32 * db + r) * KROW + (16 * ss + 8 * hh) * 2);
            O[db] = MFMA32(vf, pf, O[db]);
        }
    }
}
DI void diff_flash(const bf16_t* proj, const bf16_t* vtc, int h, int c, int q0w, LAS unsigned char* lds, const LAS float* btab, f32x16 (&O)[4]) {
    int tid = tidx(); asm volatile("" : "+v"(tid)); const int lane = tid & 63, r = lane & 31, hh = lane >> 5;
    constexpr int NT = S / 64;
    bf16x8 qf[4];
    { const bf16_t* qp = proj + (size_t)(q0w + r) * NIN + C_CQKV + h * 128 + c * 64 + 8 * hh;
#pragma unroll
      for (int ks = 0; ks < 4; ++ks) qf[ks] = *(const bf16x8*)(qp + 16 * ks); }
#pragma unroll
    for (int db = 0; db < 4; ++db)
#pragma unroll
        for (int i = 0; i < 16; ++i) O[db][i] = 0.f;
    float m = -1e30f, lsum = 0.f;
    const float cs = 0.125f * LOG2E;
    const bf16_t* kg = proj + C_CQKV + 1024 + h * 128 + c * 64 + (size_t)(tid >> 3) * NIN + (tid & 7) * 8;
    const bf16_t* vg = vtc + (size_t)(h * 128 + (tid >> 3)) * S + (tid & 7) * 8;
    const int kst = (tid >> 3) * KROW + (tid & 7) * 16;
    LAS unsigned char* Kb = lds; LAS unsigned char* Vb = lds + 3 * KBUF;
    u32x4 kr = *(const u32x4*)kg, v0 = *(const u32x4*)vg, v1 = *(const u32x4*)(vg + (size_t)64 * S);
    __syncthreads();
    *(LAS u32x4*)(Kb + kst) = kr; *(LAS u32x4*)(Vb + kst) = v0; *(LAS u32x4*)(Vb + 64 * KROW + kst) = v1;
    kr = *(const u32x4*)(kg + (size_t)64 * NIN);
    *(LAS u32x4*)(Kb + KBUF + kst) = kr;
    __syncthreads();
    f32x16 sA, sB;
    qk_half(Kb, qf, r, hh, sA);
    int kc = 0, kn = KBUF, kw = 2 * KBUF;
#pragma unroll 1
    for (int t = 0; t < NT; ++t) {
        if (t + 2 < NT) kr = *(const u32x4*)(kg + (size_t)(t + 2) * 64 * NIN);
        if (t + 1 < NT) { v0 = *(const u32x4*)(vg + (t + 1) * 64); v1 = *(const u32x4*)(vg + (size_t)64 * S + (t + 1) * 64); }
        const LAS unsigned char* vb_ = Vb + (t & 1) * VBUF;
        qk_half(Kb + kc + 32 * KROW, qf, r, hh, sB);
        softmax_pv_half(sA, vb_, btab, t * 64, q0w, r, hh, cs, m, lsum, O);
        if (t + 1 < NT) qk_half(Kb + kn, qf, r, hh, sA);
        softmax_pv_half(sB, vb_ + 64, btab, t * 64 + 32, q0w, r, hh, cs, m, lsum, O);
        if (t + 2 < NT) *(LAS u32x4*)(Kb + kw + kst) = kr;
        if (t + 1 < NT) { LAS unsigned char* vn = Vb + ((t + 1) & 1) * VBUF; *(LAS u32x4*)(vn + kst) = v0; *(LAS u32x4*)(vn + 64 * KROW + kst) = v1; }
        __syncthreads();
        const int tmp = kc; kc = kn; kn = kw; kw = tmp;
    }
    const float lt = lsum + __shfl_xor(lsum, 32), inv = 1.0f / lt;
#pragma unroll
    for (int db = 0; db < 4; ++db) O[db] *= inv;
}
DI void softmax_half(f32x16& s, const LAS float* btab, int k0, int q0w, int r, int hh, float cs, float& m, float& lsum, f32x16 (&O)[4]) {
    const int q = q0w + r;
    const int relmin = k0 - q0w - 31, relmax = k0 + 31 - q0w;
    float bc = 0.f, csx = cs;
    if (relmin >= 1024 || relmax <= -1024) { bc = btab[relmin >= 1024 ? 2048 : 0]; }
    else {
        if (relmin >= -1024 && relmax <= 1024) {
            const LAS float* bp = btab + (k0 - q + 1024 + 4 * hh);
#pragma unroll
            for (int i = 0; i < 16; ++i) s[i] = s[i] * cs + bp[(i & 3) + 8 * (i >> 2)];
        } else {
#pragma unroll
            for (int i = 0; i < 16; ++i) { const int rel = k0 + crow(i, hh) - q; const int i0 = min(max(rel, -1024), 1024) + 1024; s[i] = s[i] * cs + btab[i0]; }
        }
        csx = 1.0f;
    }
    float mx = s[0];
#pragma unroll
    for (int i = 1; i < 16; ++i) mx = fmaxf(mx, s[i]);
    mx = mx * csx + bc;
    mx = fmaxf(mx, __shfl_xor(mx, 32));
    if (__any(mx > m + 8.0f)) {
        const float mnew = fmaxf(m, mx), alpha = __builtin_amdgcn_exp2f(m - mnew);
        m = mnew; lsum *= alpha;
#pragma unroll
        for (int db = 0; db < 4; ++db) O[db] *= alpha;
    }
    const float c2 = bc - m;
    float rs0 = 0.f, rs1 = 0.f;
#pragma unroll
    for (int i = 0; i < 16; i += 2) { s[i] = __builtin_amdgcn_exp2f(s[i] * csx + c2); s[i + 1] = __builtin_amdgcn_exp2f(s[i + 1] * csx + c2); rs0 += s[i]; rs1 += s[i + 1]; }
    lsum += rs0 + rs1;
}
constexpr int K3BUF = 64 * 128, V3BUF = 128 * 128;
DI void dstage_k(const bf16_t* kgl, LAS unsigned char* dst, int wave, int lane) {
    const int row = 8 * wave + (lane >> 3), gseg = (lane & 7) ^ ((row >> 1) & 7);
    __builtin_amdgcn_global_load_lds((const unsigned*)(kgl + (size_t)row * NIN + gseg * 8), (LAS unsigned*)(dst + wave * 1024), 16, 0, 0);
}
DI void dstage_v(const bf16_t* vgl, LAS unsigned char* dst, int wave, int lane) {
#pragma unroll
    for (int k = 0; k < 2; ++k) { const int ii = 2 * wave + k, row = 8 * ii + (lane >> 3), gseg = (lane & 7) ^ ((row >> 1) & 7);
        __builtin_amdgcn_global_load_lds((const unsigned*)(vgl + (size_t)row * S + gseg * 8), (LAS unsigned*)(dst + ii * 1024), 16, 0, 0); }
}
DI void diff_flash2(const bf16_t* proj, const bf16_t* vtc, int h, int c, int q0w, LAS unsigned char* lds, const LAS float* btab, f32x16 (&O)[4]) {
    int tid = tidx(); asm volatile("" : "+v"(tid)); const int lane = tid & 63, r = lane & 31, hh = lane >> 5, wave = __builtin_amdgcn_readfirstlane(tid >> 6);
    constexpr int NT = S / 64;
    bf16x8 qf[4];
    { const bf16_t* qp = proj + (size_t)(q0w + r) * NIN + C_CQKV + h * 128 + c * 64 + 8 * hh;
#pragma unroll
      for (int ks = 0; ks < 4; ++ks) qf[ks] = *(const bf16x8*)(qp + 16 * ks); }
#pragma unroll
    for (int db = 0; db < 4; ++db)
#pragma unroll
        for (int i = 0; i < 16; ++i) O[db][i] = 0.f;
    float m = -1e30f, lsum = 0.f;
    const float cs = 0.125f * LOG2E;
    const bf16_t* kg = proj + C_CQKV + 1024 + h * 128 + c * 64;
    const bf16_t* vg = vtc + (size_t)(h * 128) * S;
    LAS unsigned char* Kb = lds; LAS unsigned char* Vb = lds + 3 * K3BUF;
    __syncthreads();
    dstage_k(kg, Kb, wave, lane); dstage_v(vg, Vb, wave, lane); dstage_k(kg + (size_t)64 * NIN, Kb + K3BUF, wave, lane);
    asm volatile("s_waitcnt vmcnt(0)" ::: "memory");
    __syncthreads();
    const int swz = (r >> 1) & 7, rowoff = r * 128;
    int kso[4], vso[2];
#pragma unroll
    for (int ks = 0; ks < 4; ++ks) kso[ks] = rowoff + (((2 * ks + hh) ^ swz) << 4);
    bf16x8 kf[4], vf[8];
#pragma unroll
    for (int ks = 0; ks < 4; ++ks) kf[ks] = *(const LAS bf16x8*)(Kb + kso[ks]);
    int kc = 0, kn = K3BUF, kw = 2 * K3BUF;
#pragma unroll 1
    for (int t = 0; t < NT; ++t) {
        if (t + 2 < NT) dstage_k(kg + (size_t)(t + 2) * 64 * NIN, Kb + kw, wave, lane);
        if (t + 1 < NT) dstage_v(vg + (t + 1) * 64, Vb + ((t + 1) & 1) * V3BUF, wave, lane);
        const LAS unsigned char* vb_ = Vb + (t & 1) * V3BUF;
#pragma unroll
        for (int half = 0; half < 2; ++half) {
            f32x16 s;
#pragma unroll
            for (int i = 0; i < 16; ++i) s[i] = 0.f;
#pragma unroll
            for (int ks = 0; ks < 4; ++ks) s = MFMA32(kf[ks], qf[ks], s);
#pragma unroll
            for (int ss = 0; ss < 2; ++ss) { const int vs = rowoff + (((4 * half + 2 * ss + hh) ^ swz) << 4);
#pragma unroll
                for (int db = 0; db < 4; ++db) vf[ss * 4 + db] = *(const LAS bf16x8*)(vb_ + vs + (32 * db) * 128); }
            __builtin_amdgcn_sched_barrier(0);
            softmax_half(s, btab, t * 64 + 32 * half, q0w, r, hh, cs, m, lsum, O);
            if (half == 0) {
#pragma unroll
                for (int ks = 0; ks < 4; ++ks) kf[ks] = *(const LAS bf16x8*)(Kb + kc + 32 * 128 + kso[ks]);
            } else if (t + 1 < NT) {
#pragma unroll
                for (int ks = 0; ks < 4; ++ks) kf[ks] = *(const LAS bf16x8*)(Kb + kn + kso[ks]);
            }
            __builtin_amdgcn_sched_barrier(0);
#pragma unroll
            for (int ss = 0; ss < 2; ++ss) {
                const bf16x8 pf = pack8(s, ss);
#pragma unroll
                for (int db = 0; db < 4; ++db) O[db] = MFMA32(vf[ss * 4 + db], pf, O[db]);
            }
        }
        asm volatile("s_waitcnt vmcnt(0)" ::: "memory");
        __syncthreads();
        const int tmp = kc; kc = kn; kn = kw; kw = tmp;
    }
    const float lt = lsum + __shfl_xor(lsum, 32), inv = 1.0f / lt;
#pragma unroll
    for (int db = 0; db < 4; ++db) O[db] *= inv;
}
DI void diffattn_item(const Params& p, int l, int item, LAS unsigned char* lds) {
    int tid = tidx(); asm volatile("" : "+v"(tid)); const int wave = __builtin_amdgcn_readfirstlane(tid >> 6), lane = tid & 63, r = lane & 31, hh = lane >> 5;
    const int qt = item >> 3, h = item & 7, q0w = qt * 256 + wave * 32;
    LAS float* btab = (LAS float*)(lds + LDS_MAIN);
    const float* bias = (const float*)(p.ws + WS_BIAS) + (24 + h) * 2049;
    for (int i = tid; i < 2049; i += NTHR) btab[i] = bias[i];
    const float* dl = p.in[I_DLAM] + l * 256;
    float d01 = 0.f, d23 = 0.f;
    for (int i = 0; i < 64; ++i) { d01 += dl[i] * dl[64 + i]; d23 += dl[128 + i] * dl[192 + i]; }
    const float lam_init = 0.8f - 0.6f * expf(-0.3f * (float)l);
    const float lam = expf(d01) - expf(d23) + lam_init;
    const bf16_t* proj = (const bf16_t*)(p.ws + WS_PROJ); const bf16_t* vtc = (const bf16_t*)(p.ws + WS_VTC);
    f32x16 O0[4];
    const int q = q0w + r;
    float* ctmp = (float*)(p.ws + WS_CTMP) + (size_t)q * 1024 + h * 128 + 4 * hh;
    diff_flash2(proj, vtc, h, 0, q0w, lds, btab, O0);
#pragma unroll
    for (int db = 0; db < 4; ++db)
#pragma unroll
        for (int i4 = 0; i4 < 4; ++i4) { f32x4 o = {O0[db][4 * i4], O0[db][4 * i4 + 1], O0[db][4 * i4 + 2], O0[db][4 * i4 + 3]}; *(f32x4*)(ctmp + 32 * db + 8 * i4) = o; }
    diff_flash2(proj, vtc, h, 1, q0w, lds, btab, O0);
    float ss = 0.f;
#pragma unroll
    for (int db = 0; db < 4; ++db)
#pragma unroll
        for (int i4 = 0; i4 < 4; ++i4) { const f32x4 o0 = *(const f32x4*)(ctmp + 32 * db + 8 * i4);
#pragma unroll
            for (int e = 0; e < 4; ++e) { const float o = o0[e] - lam * O0[db][4 * i4 + e]; O0[db][4 * i4 + e] = o; ss += o * o; } }
    ss += __shfl_xor(ss, 32);
    const float rn = rsqrtf(ss * (1.0f / 128.0f) + 1e-6f) * (1.0f - lam_init);
    const float* dg = p.in[I_DG] + l * 128;
    bf16_t* cout = (bf16_t*)(p.ws + WS_BR) + (size_t)2 * S * 1024;
#pragma unroll
    for (int db = 0; db < 4; ++db)
#pragma unroll
        for (int i4 = 0; i4 < 4; ++i4) {
            const int d0 = 32 * db + 8 * i4 + 4 * hh;
            const f32x4 g4 = *(const f32x4*)(dg + d0);
            const u32x2 gt = *(const u32x2*)(proj + (size_t)q * NIN + C_CGATE + h * 128 + d0);
            const float y0 = O0[db][4 * i4 + 0] * rn * g4[0] * silu_f(bflo(gt[0])), y1 = O0[db][4 * i4 + 1] * rn * g4[1] * silu_f(bfhi(gt[0]));
            const float y2 = O0[db][4 * i4 + 2] * rn * g4[2] * silu_f(bflo(gt[1])), y3 = O0[db][4 * i4 + 3] * rn * g4[3] * silu_f(bfhi(gt[1]));
            u32x2 o = {pk2(y0, y1), pk2(y2, y3)};
            *(u32x2*)(cout + (size_t)q * 1024 + h * 128 + d0) = o;
        }
    __syncthreads();
}

DI void mixA_wave_item(const Params& p, int wi, int lane, const LAS float* tb) {
    asm volatile("" : "+v"(lane));
    const int g = wi >> 11, rem = wi & 2047, h = rem >> 8, qb = rem & 255;
    const int sh = 2 * g, n = S >> sh, nbq = 256 >> sh, res = qb / nbq, m0 = (qb % nbq) * 32;
    const int r = lane & 31, hh = lane >> 5;
    const bf16_t* proj = (const bf16_t*)(p.ws + WS_PROJ);
    const int qpos = ((m0 + r) << sh) + res;
    bf16x8 qf[8];
    { const bf16_t* qp = proj + (size_t)qpos * NIN + g * 3072 + h * 128 + 8 * hh;
#pragma unroll
      for (int ks = 0; ks < 8; ++ks) qf[ks] = *(const bf16x8*)(qp + 16 * ks); }
    f32x16 O[4];
#pragma unroll
    for (int db = 0; db < 4; ++db)
#pragma unroll
        for (int i = 0; i < 16; ++i) O[db][i] = 0.f;
    float m = -1e30f, lsum = 0.f;
    const float cs = 0.08838834764831845f * LOG2E;
    const LAS float* tbl = tb + 31 - r + 4 * hh;
    const bf16_t* vt = (const bf16_t*)(p.ws + WS_VTA) + (size_t)((g * 8 + h) * 128) * S + res * n;
    bf16x8 kf[8];
    { const int mk0r = m0 - 64; const int mk0 = (mk0r >= 0 && mk0r < n) ? mk0r : m0;
      const bf16_t* kp = proj + (size_t)(((mk0 + r) << sh) + res) * NIN + g * 3072 + 1024 + h * 128 + 8 * hh;
#pragma unroll
      for (int ks = 0; ks < 8; ++ks) kf[ks] = *(const bf16x8*)(kp + 16 * ks); }
#pragma unroll 1
    for (int kb = 0; kb < 5; ++kb) {
        const int mk0r = m0 - 64 + 32 * kb;
        const bool blk_ok = (mk0r >= 0) && (mk0r < n);
        const int mk0 = blk_ok ? mk0r : m0;
        bf16x8 vfr[2][4];
#pragma unroll
        for (int sidx = 0; sidx < 2; ++sidx)
#pragma unroll
            for (int db = 0; db < 4; ++db) {
                const bf16_t* vp = vt + (size_t)(32 * db + r) * S + mk0 + 16 * sidx + 4 * hh;
                const s16x4 lo = *(const s16x4*)vp, hi = *(const s16x4*)(vp + 8);
                vfr[sidx][db] = __builtin_shufflevector(lo, hi, 0, 1, 2, 3, 4, 5, 6, 7);
            }
        __builtin_amdgcn_sched_barrier(0);
        f32x16 s;
#pragma unroll
        for (int i = 0; i < 16; ++i) s[i] = 0.f;
#pragma unroll
        for (int ks = 0; ks < 8; ++ks) s = MFMA32(kf[ks], qf[ks], s);
        if (kb < 4) {
            const int nk0r = m0 - 64 + 32 * (kb + 1); const int nk0 = (nk0r >= 0 && nk0r < n) ? nk0r : m0;
            const bf16_t* kp = proj + (size_t)(((nk0 + r) << sh) + res) * NIN + g * 3072 + 1024 + h * 128 + 8 * hh;
#pragma unroll
            for (int ks = 0; ks < 8; ++ks) kf[ks] = *(const bf16x8*)(kp + 16 * ks);
        }
        __builtin_amdgcn_sched_barrier(0);
        float mx = -INFINITY;
#pragma unroll
        for (int i = 0; i < 16; ++i) { const int rel = mk0r + crow(i, hh) - (m0 + r); const bool valid = blk_ok && (rel <= 64) && (rel >= -64);
            const float bv = tbl[32 * kb + (i & 3) + 8 * (i >> 2)];
            const float v = valid ? (s[i] * cs + bv) : -INFINITY; s[i] = v; mx = fmaxf(mx, v); }
        mx = fmaxf(mx, __shfl_xor(mx, 32));
        const float mnew = fmaxf(m, mx), alpha = __builtin_amdgcn_exp2f(m - mnew);
        m = mnew;
        float rs = 0.f;
#pragma unroll
        for (int i = 0; i < 16; ++i) { s[i] = __builtin_amdgcn_exp2f(s[i] - mnew); rs += s[i]; }
        lsum = lsum * alpha + rs;
#pragma unroll
        for (int db = 0; db < 4; ++db) O[db] *= alpha;
#pragma unroll
        for (int sidx = 0; sidx < 2; ++sidx) {
            const bf16x8 pf = pack8(s, sidx);
#pragma unroll
            for (int db = 0; db < 4; ++db) O[db] = MFMA32(vfr[sidx][db], pf, O[db]);
        }
    }
    const float lt = lsum + __shfl_xor(lsum, 32), inv = 1.0f / lt;
    float* oa = (float*)(p.ws + WS_OA) + ((size_t)g * S + qpos) * 1024 + h * 128;
#pragma unroll
    for (int db = 0; db < 4; ++db)
#pragma unroll
        for (int i4 = 0; i4 < 4; ++i4) {
            const int d0 = 32 * db + 8 * i4 + 4 * hh;
            f32x4 o = {O[db][4 * i4] * inv, O[db][4 * i4 + 1] * inv, O[db][4 * i4 + 2] * inv, O[db][4 * i4 + 3] * inv};
            *(f32x4*)(oa + d0) = o;
        }
    if (hh == 0) ((float*)(p.ws + WS_LSEA))[((size_t)g * S + qpos) * 8 + h] = m + __log2f(lt);
}

DI void phase_post(const Params& p, LAS unsigned char* lds) {
    const int tid = tidx();
    const bf16_t* proj = (const bf16_t*)(p.ws + WS_PROJ);
    bf16_t* aout = (bf16_t*)(p.ws + WS_BR); bf16_t* bout = aout + (size_t)S * 1024;
    const float* oa = (const float*)(p.ws + WS_OA); const float* lse = (const float*)(p.ws + WS_LSEA);
    for (int idx0 = blockIdx.x * NTHR + tid; idx0 < S * 256; idx0 += 4 * gridDim.x * NTHR) {
        float l0[4], l1[4], l2[4]; f32x4 o0[4], o1[4], o2[4]; u32x2 gt[4];
#pragma unroll
        for (int u = 0; u < 4; ++u) { const int idx = idx0 + u * gridDim.x * NTHR; const int pos = idx >> 8, c4 = idx & 255, h = c4 >> 5, col = c4 * 4;
            l0[u] = lse[((size_t)0 * S + pos) * 8 + h]; l1[u] = lse[((size_t)1 * S + pos) * 8 + h]; l2[u] = lse[((size_t)2 * S + pos) * 8 + h];
            o0[u] = *(const f32x4*)(oa + ((size_t)0 * S + pos) * 1024 + col); o1[u] = *(const f32x4*)(oa + ((size_t)1 * S + pos) * 1024 + col); o2[u] = *(const f32x4*)(oa + ((size_t)2 * S + pos) * 1024 + col);
            gt[u] = *(const u32x2*)(proj + (size_t)pos * NIN + C_AGATE + col); }
#pragma unroll
        for (int u = 0; u < 4; ++u) { const int idx = idx0 + u * gridDim.x * NTHR; const int pos = idx >> 8, c4 = idx & 255, col = c4 * 4;
            const float mx = fmaxf(l0[u], fmaxf(l1[u], l2[u]));
            const float w0 = __builtin_amdgcn_exp2f(l0[u] - mx), w1 = __builtin_amdgcn_exp2f(l1[u] - mx), w2 = __builtin_amdgcn_exp2f(l2[u] - mx);
            const float inv = __builtin_amdgcn_rcpf(w0 + w1 + w2);
            const f32x4 o = (o0[u] * w0 + o1[u] * w1 + o2[u] * w2) * inv;
            u32x2 ov = {pk2(o[0] * silu_f(bflo(gt[u][0])), o[1] * silu_f(bfhi(gt[u][0]))), pk2(o[2] * silu_f(bflo(gt[u][1])), o[3] * silu_f(bfhi(gt[u][1])))};
            *(u32x2*)(aout + (size_t)pos * 1024 + col) = ov; }
    }
    LAS float* tile = (LAS float*)lds;
    const float* z2t = (const float*)(p.ws + WS_Z2T);
    for (int it = blockIdx.x; it < 128 * 16; it += gridDim.x) {
        const int t0 = (it >> 4) * 64, c0 = (it & 15) * 64;
        __syncthreads();
#pragma unroll
        for (int k = 0; k < 2; ++k) { const int e = tid + NTHR * k; const int ci = e >> 4, t4 = (e & 15) * 4;
            const f32x4 v = *(const f32x4*)(z2t + (size_t)(c0 + ci) * S + t0 + t4);
            tile[ci * 65 + t4] = v[0]; tile[ci * 65 + t4 + 1] = v[1]; tile[ci * 65 + t4 + 2] = v[2]; tile[ci * 65 + t4 + 3] = v[3]; }
        __syncthreads();
#pragma unroll
        for (int k = 0; k < 2; ++k) { const int e = tid + NTHR * k; const int ti = e >> 4, cc = (e & 15) * 4;
            const u32x2 gt = *(const u32x2*)(proj + (size_t)(t0 + ti) * NIN + C_BGATE + c0 + cc);
            const float y0 = tile[(cc + 0) * 65 + ti] * silu_f(bflo(gt[0])), y1 = tile[(cc + 1) * 65 + ti] * silu_f(bfhi(gt[0]));
            const float y2 = tile[(cc + 2) * 65 + ti] * silu_f(bflo(gt[1])), y3 = tile[(cc + 3) * 65 + ti] * silu_f(bfhi(gt[1]));
            u32x2 ov = {pk2(y0, y1), pk2(y2, y3)};
            *(u32x2*)(bout + (size_t)(t0 + ti) * 1024 + c0 + cc) = ov; }
    }
    __syncthreads();
}

#ifndef REP_GEMMIN
#define REP_GEMMIN 1
#endif
#ifndef REP_DIFF
#define REP_DIFF 1
#endif
#ifndef REP_HYENA
#define REP_HYENA 1
#endif
#ifndef REP_MIXA
#define REP_MIXA 1
#endif
#ifndef REP_PRO
#define REP_PRO 1
#endif
#ifndef REP_SPEC
#define REP_SPEC 1
#endif
#ifndef REP_MISC
#define REP_MISC 1
#endif
#ifndef REP_PROJ
#define REP_PROJ 1
#endif
constexpr int NPH = 3 + 6 * DEPTH + 1;
typedef const Params __attribute__((address_space(4)))* ParamsK;
DI Params ldp(ParamsK pc) {
    asm volatile("" : "+s"(pc));
    Params q;
#pragma unroll
    for (int i = 0; i < 18; ++i) q.in[i] = pc->in[i];
    q.out = pc->out; q.ws = pc->ws; q.ph_lo = pc->ph_lo; q.ph_hi = pc->ph_hi;
    return q;
}
DI void run_phase(ParamsK pc, int ph, LAS unsigned char* lds) {
    if (ph == 0) { for (int rep = 0; rep < REP_PRO; ++rep) { const Params p = ldp(pc); phase_prologue(p, lds); __syncthreads(); } return; }
    if (ph == 1) { const Params p = ldp(pc); phase_tgen(p); return; }
    if (ph == 2) { for (int rep = 0; rep < REP_SPEC; ++rep) { const Params p = ldp(pc); for (int it = blockIdx.x; it < DEPTH * 2 * 512; it += gridDim.x) spectra_item(p, it, lds); } return; }
    if (ph == NPH - 1) { const Params p = ldp(pc); phase_rmsnorm((const float*)(p.ws + WS_X), p.in[I_FINALG], nullptr, p.out); return; }
    const int l = (ph - 3) / 6, sp = (ph - 3) % 6;
    if (sp == 0) { for (int rep = 0; rep < REP_MISC; ++rep) { const Params p = ldp(pc); phase_rmsnorm((l == 0) ? p.in[I_X] : (const float*)(p.ws + WS_X), p.in[I_NORMG] + l * D, (bf16_t*)(p.ws + WS_H), nullptr); } return; }
    if (sp == 1) {
        const Params p = ldp(pc);
        pg8::Gemm g{(const bf16_t*)(p.ws + WS_H), (const bf16_t*)(p.ws + WS_WIN) + (size_t)l * NIN * D, S, NIN, D};
        pg8::StaticOrder so; so.init(S, NIN, gridDim.x, blockIdx.x);
        EpiIn e{(bf16_t*)(p.ws + WS_PROJ), (bf16_t*)(p.ws + WS_VTA), (bf16_t*)(p.ws + WS_VTC), (float*)(p.ws + WS_BINT), lds + 131072};
#pragma unroll 1
        for (int rep = 0; rep < REP_GEMMIN; ++rep) { pg8::gemm_phase(lds, g, so, e); __syncthreads(); }
        return;
    }
    if (sp == 2) {
#pragma unroll 1
        for (int it = blockIdx.x; it < 256 + 512 + 768; it += gridDim.x) {
            int l2 = l; asm volatile("" : "+s"(l2));
            const Params p = ldp(pc);
            if (it < 256) { for (int rep = 0; rep < REP_DIFF; ++rep) diffattn_item(p, l2, it, lds); }
            else if (it < 768) { for (int rep = 0; rep < REP_HYENA; ++rep) hyena_item(p, l2, it - 256, lds); }
            else {
                const int tid2 = tidx(), wi0 = (it - 768) * NWAVES, g = wi0 >> 11, h = (wi0 & 2047) >> 8;
                LAS float* tb = (LAS float*)lds;
                __syncthreads();
                if (tid2 < 192) { const int rel = tid2 - 95; float v = 0.f;
                    if (rel >= -64 && rel <= 64) v = ((const float*)(p.ws + WS_BIAS))[(g * 8 + h) * 2049 + min(max(rel << (2 * g), -1024), 1024) + 1024];
                    tb[tid2] = v; }
                __syncthreads();
                for (int rep = 0; rep < REP_MIXA; ++rep) mixA_wave_item(p, wi0 + (tid2 >> 6), tid2 & 63, tb);
            }
        }
        return;
    }
    if (sp == 3) { for (int rep = 0; rep < REP_MISC; ++rep) { const Params p = ldp(pc); phase_post(p, lds); } return; }
    if (sp == 4) {
#pragma unroll 1
        for (int rep = 0; rep < REP_PROJ; ++rep) {
            const Params p = ldp(pc);
            pg8::Gemm g{(const bf16_t*)(p.ws + WS_BR), (const bf16_t*)(p.ws + WS_WPR) + (size_t)(l * 3) * D * 1024, 3 * S, 3 * D, 1024};
            ProjOrder po; po.so.init(S, D, gridDim.x, blockIdx.x);
            EpiProj e{(const bf16_t*)(p.ws + WS_PROJ), p.in[I_MERGEB] + (size_t)l * 3 * D, (float*)(p.ws + WS_YF), (bf16_t*)(p.ws + WS_YB)};
            pg8::gemm_phase(lds, g, po, e);
            __syncthreads();
        }
        return;
    }
    {
        const Params p = ldp(pc);
        pg8::Gemm g{(const bf16_t*)(p.ws + WS_YB), (const bf16_t*)(p.ws + WS_WOUT) + (size_t)l * D * D, S, D, D};
        pg8::StaticOrder so; so.init(S, D, gridDim.x, blockIdx.x);
        EpiOut e{(l == 0) ? p.in[I_X] : (const float*)(p.ws + WS_X), (float*)(p.ws + WS_X)};
#pragma unroll 1
        for (int rep = 0; rep < ((l == 0) ? REP_MISC : 1); ++rep) { pg8::gemm_phase(lds, g, so, e); __syncthreads(); }
    }
}


#define XB_TMO      128
#define XB_XCNT(j)  (256  + 64 * (j))
#define XB_XSUB(j)  (1280 + 64 * (j))
#define XB_XGEN(j)  (2304 + 64 * (j))
#define XB_TOP      3328
#define XB_TOPGEN   3392
#define XCD_BAR_WORDS 3456
#define XB_SPIN_CAP (1u << 18)
DI unsigned xb_ld(unsigned* p)              { return __hip_atomic_load(p, __ATOMIC_RELAXED, __HIP_MEMORY_SCOPE_AGENT); }
DI unsigned xb_add(unsigned* p, unsigned v) { return __hip_atomic_fetch_add(p, v, __ATOMIC_RELAXED, __HIP_MEMORY_SCOPE_AGENT); }
DI unsigned xb_xcc_id() { return (unsigned)__builtin_amdgcn_s_getreg((3 << 11) | 20) & 0xFu; }
#define XB_SPIN(cond, bar) do { unsigned _sp = 0; while (cond) { __builtin_amdgcn_s_sleep(1); \
    if ((++_sp & 255u) == 0u) { if (xb_ld(&(bar)[XB_TMO])) break; if (_sp > XB_SPIN_CAP) { atomicAdd(&(bar)[XB_TMO], 1u); break; } } } } while (0)
struct XcdBarrier { unsigned* bar; unsigned x; volatile LAS unsigned* st; };
DI XcdBarrier xcd_barrier_post(unsigned* bar, volatile LAS unsigned* st) {
    XcdBarrier b; b.bar = bar; b.x = xb_xcc_id(); b.st = st;
    if (threadIdx.x == 0) (void)xb_add(&bar[XB_XCNT(b.x)], 1u);
    return b;
}
DI void xcd_barrier_complete(unsigned* bar, unsigned x, unsigned& nloc, unsigned& nx) {
    const unsigned G = gridDim.x * gridDim.y * gridDim.z;
    unsigned sum, cnt, mine, sp = 0u;
    for (;;) {
        sum = 0u; cnt = 0u; mine = 0u;
#pragma unroll
        for (unsigned j = 0; j < 16; ++j) { const unsigned c = xb_ld(&bar[XB_XCNT(j)]); sum += c; cnt += (c > 0u) ? 1u : 0u; mine = (j == x) ? c : mine; }
        if (sum == G) break;
        __builtin_amdgcn_s_sleep(1);
        if ((++sp & 255u) == 0u) { if (xb_ld(&bar[XB_TMO])) break; if (sp > XB_SPIN_CAP) { atomicAdd(&bar[XB_TMO], 1u); break; } }
    }
    nloc = mine > 0u ? mine : 1u; nx = cnt > 0u ? cnt : 1u;
}
DI void xcd_barrier(const XcdBarrier& b) {
    asm volatile("s_waitcnt vmcnt(0)" ::: "memory");
    __syncthreads();
    if (threadIdx.x == 0) {
        unsigned* bar = b.bar;
        __builtin_amdgcn_s_waitcnt(0);
        unsigned nloc = b.st[0], nx = b.st[1];
        if (nloc == 0u) { xcd_barrier_complete(bar, b.x, nloc, nx); b.st[0] = nloc; b.st[1] = nx; }
        const unsigned old = xb_add(&bar[XB_XSUB(b.x)], 1u);
        const unsigned gen = old / nloc;
        if (old + 1u == (gen + 1u) * nloc) {
            __builtin_amdgcn_fence(__ATOMIC_RELEASE, "agent");
            asm volatile("s_waitcnt vmcnt(0)" ::: "memory");
            const unsigned og = xb_add(&bar[XB_TOP], 1u);
            const unsigned tg = og / nx;
            if (og + 1u == (tg + 1u) * nx) xb_add(&bar[XB_TOPGEN], 1u);
            else XB_SPIN(xb_ld(&bar[XB_TOPGEN]) == tg, bar);
            __builtin_amdgcn_fence(__ATOMIC_ACQUIRE, "agent");
            xb_add(&bar[XB_XGEN(b.x)], 1u);
            asm volatile("s_waitcnt vmcnt(0)" ::: "memory");
        } else {
            XB_SPIN(xb_ld(&bar[XB_XGEN(b.x)]) == gen, bar);
            __builtin_amdgcn_fence(__ATOMIC_ACQUIRE, "agent");
            asm volatile("s_waitcnt vmcnt(0)" ::: "memory");
        }
    }
    __syncthreads();
}

__global__ void __launch_bounds__(512, 2) mega_kernel(Params p) {
#if defined(__HIP_DEVICE_COMPILE__)
    extern __shared__ __attribute__((aligned(16))) unsigned char shm[];
    LAS unsigned char* lds = (LAS unsigned char*)shm;
    cg::grid_group grid = cg::this_grid();
    const int ph_lo = p.ph_lo, ph_hi = p.ph_hi;
    volatile LAS unsigned* st = (volatile LAS unsigned*)(lds + LDS_BYTES - 16);
    if (threadIdx.x == 0) { st[0] = 0u; st[1] = 0u; }
    __syncthreads();
    const XcdBarrier xb = xcd_barrier_post((unsigned*)(p.ws + WS_BAR), st);
#pragma unroll 1
    for (int ph = ph_lo; ph < ph_hi; ++ph) {
        ParamsK pc = (ParamsK)__builtin_amdgcn_kernarg_segment_ptr();
        run_phase(pc, ph, lds);
        if (ph + 1 < ph_hi) { if (ph == ph_lo) grid.sync(); else xcd_barrier(xb); }
    }
#endif
}

#ifndef N_LAUNCH_MODE
#define N_LAUNCH_MODE 1
#endif
extern "C" void kernel_launch(void* const* d_in, const int* in_sizes, int n_in, void* d_out, int out_size, void* d_ws, size_t ws_size, hipStream_t stream) {
    static int grid = 0;
    if (grid == 0) {
        int dev = 0, cus = 0;
        if (hipGetDevice(&dev) != hipSuccess || hipDeviceGetAttribute(&cus, hipDeviceAttributeMultiprocessorCount, dev) != hipSuccess) { fprintf(stderr, "kernel_launch: device query failed\n"); grid = -1; return; }
        if (hipFuncSetAttribute((const void*)mega_kernel, hipFuncAttributeMaxDynamicSharedMemorySize, LDS_BYTES) != hipSuccess) { fprintf(stderr, "kernel_launch: hipFuncSetAttribute failed\n"); grid = -1; return; }
        int per_cu = 0;
        if (hipOccupancyMaxActiveBlocksPerMultiprocessor(&per_cu, (const void*)mega_kernel, NTHR, LDS_BYTES) != hipSuccess || per_cu < 1) { fprintf(stderr, "kernel_launch: occupancy query says %d\n", per_cu); (void)hipGetLastError(); }
        if (n_in != 18 || ws_size < WS_END) { fprintf(stderr, "kernel_launch: n_in %d ws %zu (need %zu)\n", n_in, ws_size, (size_t)WS_END); grid = -1; return; }
        grid = cus;
    }
    if (grid < 0) return;
    Params p{};
    for (int i = 0; i < 18; ++i) p.in[i] = (const float*)d_in[i];
    p.out = (float*)d_out; p.ws = (unsigned char*)d_ws;
    if (hipMemsetAsync((unsigned char*)d_ws + WS_BAR, 0, 16384, stream) != hipSuccess) { fprintf(stderr, "kernel_launch: memset of barrier words failed\n"); return; }
#if N_LAUNCH_MODE == 1
    p.ph_lo = 0; p.ph_hi = NPH;
    void* args[] = {&p};
    hipError_t e = hipLaunchCooperativeKernel((const void*)mega_kernel, dim3(grid), dim3(NTHR), args, LDS_BYTES, stream);
    if (e != hipSuccess) fprintf(stderr, "cooperative launch failed: %s (grid %d)\n", hipGetErrorString(e), grid);
#else
    for (int ph = 0; ph < NPH; ++ph) {
        p.ph_lo = ph; p.ph_hi = ph + 1;
        hipLaunchKernelGGL(mega_kernel, dim3(grid), dim3(NTHR), LDS_BYTES, stream, p);
    }
#endif
}
```

```cpp
#include <hip/hip_runtime.h>
#include <hip/hip_cooperative_groups.h>
#include <cstdio>
namespace cg = cooperative_groups;
#define DI __device__ __forceinline__
#define LAS __attribute__((address_space(3)))
typedef unsigned short bf16_t;
typedef short bf16x8 __attribute__((ext_vector_type(8)));
typedef short s16x4 __attribute__((ext_vector_type(4)));
typedef float f32x4 __attribute__((ext_vector_type(4)));
typedef float f32x16 __attribute__((ext_vector_type(16)));
typedef float f32x2 __attribute__((ext_vector_type(2)));
typedef float cf __attribute__((ext_vector_type(2)));
typedef __bf16 bf16x2n __attribute__((ext_vector_type(2)));
typedef unsigned u32x2 __attribute__((ext_vector_type(2)));
typedef unsigned u32x4 __attribute__((ext_vector_type(4)));

DI unsigned pk2(float lo, float hi) { f32x2 v = {lo, hi}; return __builtin_bit_cast(unsigned, __builtin_convertvector(v, bf16x2n)); }
DI float bflo(unsigned u) { return __uint_as_float(u << 16); }
DI float bfhi(unsigned u) { return __uint_as_float(u & 0xffff0000u); }
DI float silu_f(float x) { return x * __builtin_amdgcn_rcpf(1.0f + __expf(-x)); }
DI float sigm_f(float x) { return __builtin_amdgcn_rcpf(1.0f + __expf(-x)); }

DI int tidx() { int t = threadIdx.x; asm volatile("" : "+v"(t)); return t; }

constexpr int S = 8192, D = 2048, NIN = 24576, DEPTH = 4;
constexpr int C_AGATE = 9216, C_BIN = 10240, C_BGATE = 13312, C_CQKV = 14336, C_CGATE = 17408, C_MERGE = 18432;
constexpr float LOG2E = 1.4426950408889634f;
constexpr int NTHR = 512, NWAVES = 8;
constexpr int LDS_MAIN = 143360, LDS_AUX = 16384, LDS_BYTES = LDS_MAIN + LDS_AUX;

constexpr size_t WS_WIN  = 0;
constexpr size_t WS_WPR  = WS_WIN  + (size_t)DEPTH * NIN * D * 2;
constexpr size_t WS_WOUT = WS_WPR  + (size_t)DEPTH * 3 * D * 1024 * 2;
constexpr size_t WS_SPEC = WS_WOUT + (size_t)DEPTH * D * D * 2;
constexpr size_t WS_HID2 = WS_SPEC + (size_t)DEPTH * 2 * 512 * 8208 * 16;
constexpr size_t WS_BIAS = WS_HID2 + (size_t)DEPTH * S * 64 * 4;
constexpr size_t WS_X    = WS_BIAS + 524288;
constexpr size_t WS_H    = WS_X    + (size_t)S * D * 4;
constexpr size_t WS_PROJ = WS_H    + (size_t)S * D * 2;
constexpr size_t WS_BINT = WS_PROJ + (size_t)S * NIN * 2;
constexpr size_t WS_VTA  = WS_BINT + (size_t)3072 * S * 4;
constexpr size_t WS_VTC  = WS_VTA  + (size_t)3 * 1024 * S * 2;
constexpr size_t WS_OA   = WS_VTC  + (size_t)1024 * S * 2;
constexpr size_t WS_LSEA = WS_OA   + (size_t)3 * S * 1024 * 4;
constexpr size_t WS_Z2T  = WS_LSEA + (size_t)3 * S * 8 * 4;
constexpr size_t WS_BR   = WS_Z2T  + (size_t)1024 * S * 4;
constexpr size_t WS_YF   = WS_BR   + (size_t)3 * S * 1024 * 2;
constexpr size_t WS_YB   = WS_YF   + (size_t)S * D * 4;
constexpr size_t WS_CTMP = WS_YB   + (size_t)S * D * 2;
constexpr size_t WS_BAR  = WS_CTMP + (size_t)S * 1024 * 4;
constexpr size_t WS_TT   = WS_BAR + 16384;
constexpr size_t WS_END  = WS_TT + (size_t)DEPTH * 4096 * S * 4;

DI size_t PIDX(int row, int col) { return ((size_t)(col >> 8) * S + row) * 256 + (col & 255); }

struct Params {
    const float* in[18];
    float* out;
    unsigned char* ws;
    int ph_lo, ph_hi;
};
enum { I_X = 0, I_NORMG, I_FINALG, I_WIN, I_MERGEB, I_RELB, I_HYCONV, I_HYW1, I_HYB1, I_HYFREQ, I_HYW2, I_HYB2, I_HYW3, I_HYSKIP, I_DLAM, I_DG, I_WPROJ, I_WOUT };

namespace pg8 {
constexpr int BM = 256, BK = 64, HALF = 128, HTB = HALF * BK * 2, NXCD = 8, WGM = 8;
DI int lds_byte(int r, int c) { const int st = (r >> 4) * 2 + (c >> 5), rr = r & 15, cc = c & 31, ob = rr * 64 + cc * 2; return st * 1024 + (ob ^ (((ob >> 9) & 1) << 5)); }
DI void stage_rc(int b, int& R, int& C) { const int st = b / 1024, sb = b % 1024, swz = sb ^ (((sb >> 9) & 1) << 5); R = (st >> 1) * 16 + swz / 64; C = (st & 1) * 32 + (swz % 64) / 2; }
DI int perm32(int rho) { const int n = rho >> 4, i = rho & 15; return 8 * (i >> 2) + 4 * n + (i & 3); }
struct Unit { int pm, pn; };
struct Gemm { const bf16_t* A; const bf16_t* Bt; int M, N, K; };
struct StaticOrder {
    int nM, nN, nwg, G, c;
    DI void init(int M, int N, int G_, int c_) { nM = M / BM; nN = N / BM; nwg = nM * nN; G = G_; c = c_; }
    DI bool next(int i, Unit& u) const {
        const long L = (long)i * G + c; if (L >= nwg) return false;
        int wgid = (int)L; { const int q = nwg / NXCD, r = nwg % NXCD, xcd = wgid % NXCD, off = wgid / NXCD; wgid = (xcd < r ? xcd * (q + 1) : r * (q + 1) + (xcd - r) * q) + off; }
        const int nig = WGM * nN, gid = wgid / nig, fm = gid * WGM, gsz = (nM - fm) < WGM ? (nM - fm) : WGM;
        u.pm = fm + ((wgid % nig) % gsz); u.pn = (wgid % nig) / gsz; return true;
    }
};
template <class Epi, class Sched>
DI void gemm_phase(LAS unsigned char* lds, const Gemm g, const Sched& S, const Epi& E) {
    const int tid = tidx(), wid = __builtin_amdgcn_readfirstlane(tid >> 6), lane = tid & 63, wr = wid >> 2, wc = wid & 3, fr = lane & 15, fq = lane >> 4;
    const int K = g.K, nt = K / BK;
    unsigned voffA[2], voffB[2];
#pragma unroll
    for (int i = 0; i < 2; ++i) { int R, C; stage_rc(tid * 16 + i * 8192, R, C); const int Rb = Epi::PERM ? ((R & ~31) + perm32(R & 31)) : R; voffA[i] = (unsigned)(R * K + C) * 2u; voffB[i] = (unsigned)(Rb * K + C) * 2u; }
    const size_t kstep = (size_t)(BK * 2);
    const size_t hstep = (size_t)HALF * K * 2;
    const size_t tstep = 2 * hstep;
    const unsigned ldsw = (unsigned)wid * 1024u;
    const int aoff = lds_byte(wr * 64 + fr, fq * 8), boff = lds_byte(wc * 32 + fr, fq * 8);
#define PG8_SA(b, h) (((b) * 2 + (h)) * HTB)
#define PG8_SB(b, h) ((4 + (b) * 2 + (h)) * HTB)
#define PG8_STAGE(bufoff, gbase, voff) do { _Pragma("unroll") for (int _i = 0; _i < 2; ++_i) \
        __builtin_amdgcn_global_load_lds((const unsigned*)((const char*)(gbase) + (voff)[_i]), (LAS unsigned*)(lds + (bufoff) + ldsw + _i * 8192), 16, 0, 0); } while (0)
#define PG8_LDA(dst, b, h) do { _Pragma("unroll") for (int m = 0; m < 4; ++m) _Pragma("unroll") for (int k = 0; k < 2; ++k) dst[m][k] = *(const LAS bf16x8*)(lds + PG8_SA(b, h) + aoff + m * 2048 + k * 1024); } while (0)
#define PG8_LDB(dst, b, h) do { _Pragma("unroll") for (int n = 0; n < 2; ++n) _Pragma("unroll") for (int k = 0; k < 2; ++k) dst[n][k] = *(const LAS bf16x8*)(lds + PG8_SB(b, h) + boff + n * 2048 + k * 1024); } while (0)
#define PG8_MMA(ai, bj, At, Bt) do { __builtin_amdgcn_s_setprio(1); _Pragma("unroll") for (int m = 0; m < 4; ++m) _Pragma("unroll") for (int n = 0; n < 2; ++n) _Pragma("unroll") for (int k = 0; k < 2; ++k) \
        acc[ai][bj][m][n] = __builtin_amdgcn_mfma_f32_16x16x32_bf16(Bt[n][k], At[m][k], acc[ai][bj][m][n], 0, 0, 0); __builtin_amdgcn_s_setprio(0); } while (0)
#define PG8_WAIT_V(n) asm volatile("s_waitcnt vmcnt(" #n ")" ::: "memory")
#define PG8_WAIT_L(n) asm volatile("s_waitcnt lgkmcnt(" #n ")" ::: "memory")
#define PG8_BAR __builtin_amdgcn_s_barrier()
#define PG8_SCHED __builtin_amdgcn_sched_barrier(0)
    Unit cur, nxt; int ui = 0;
    if (!S.next(0, cur)) return;
    f32x4 acc[2][2][4][2];
#pragma unroll
    for (int a = 0; a < 2; ++a)
#pragma unroll
        for (int b = 0; b < 2; ++b)
#pragma unroll
            for (int m = 0; m < 4; ++m)
#pragma unroll
                for (int n = 0; n < 2; ++n) acc[a][b][m][n] = (f32x4){0.f, 0.f, 0.f, 0.f};
    bf16x8 At[4][2], B0[2][2], B1[2][2];
    const char* cA = (const char*)g.A + (size_t)cur.pm * tstep; const char* cB = (const char*)g.Bt + (size_t)cur.pn * tstep;
    PG8_STAGE(PG8_SB(0, 0), cB, voffB); PG8_STAGE(PG8_SA(0, 0), cA, voffA); PG8_STAGE(PG8_SB(0, 1), cB + hstep, voffB); PG8_STAGE(PG8_SA(0, 1), cA + hstep, voffA);
    if (wr == 1) PG8_BAR;
    PG8_WAIT_V(4); PG8_BAR;
    PG8_STAGE(PG8_SB(1, 0), cB + kstep, voffB); PG8_STAGE(PG8_SA(1, 0), cA + kstep, voffA); PG8_STAGE(PG8_SB(1, 1), cB + hstep + kstep, voffB);
    PG8_WAIT_V(6); PG8_BAR;
    for (;;) {
        const bool has_next = S.next(ui + 1, nxt);
        const char* nA = has_next ? (const char*)g.A + (size_t)nxt.pm * tstep : cA; const char* nB = has_next ? (const char*)g.Bt + (size_t)nxt.pn * tstep : cB;
        for (int t = 0; t < nt; t += 2) {
            const bool last = (t == nt - 2);
            const char* a1 = cA + (size_t)(t + 1) * kstep;
            const char* a2 = last ? nA : cA + (size_t)(t + 2) * kstep; const char* b2 = last ? nB : cB + (size_t)(t + 2) * kstep;
            const char* a3 = a2 + kstep; const char* b3 = b2 + kstep;
            PG8_LDB(B0, 0, 0); PG8_SCHED; PG8_LDA(At, 0, 0); PG8_STAGE(PG8_SA(1, 1), a1 + hstep, voffA);
            PG8_WAIT_L(8); PG8_BAR; PG8_WAIT_L(0); PG8_MMA(0, 0, At, B0); PG8_BAR; PG8_SCHED;
            PG8_LDB(B1, 0, 1); PG8_STAGE(PG8_SB(0, 0), b2, voffB);
            PG8_BAR; PG8_WAIT_L(0); PG8_MMA(0, 1, At, B1); PG8_BAR;
            PG8_LDA(At, 0, 1); PG8_STAGE(PG8_SA(0, 0), a2, voffA);
            PG8_BAR; PG8_WAIT_L(0); PG8_MMA(1, 0, At, B0); PG8_BAR; PG8_SCHED;
            PG8_STAGE(PG8_SB(0, 1), b2 + hstep, voffB);
            PG8_WAIT_V(6); PG8_BAR; PG8_MMA(1, 1, At, B1); PG8_BAR;
            PG8_LDB(B0, 1, 0); PG8_SCHED; PG8_LDA(At, 1, 0); PG8_STAGE(PG8_SA(0, 1), a2 + hstep, voffA);
            PG8_WAIT_L(8); PG8_BAR; PG8_WAIT_L(0); PG8_MMA(0, 0, At, B0); PG8_BAR; PG8_SCHED;
            PG8_LDB(B1, 1, 1); PG8_STAGE(PG8_SB(1, 0), b3, voffB);
            PG8_BAR; PG8_WAIT_L(0); PG8_MMA(0, 1, At, B1); PG8_BAR;
            PG8_LDA(At, 1, 1); PG8_STAGE(PG8_SA(1, 0), a3, voffA);
            PG8_BAR; PG8_WAIT_L(0); PG8_MMA(1, 0, At, B0); PG8_BAR; PG8_SCHED;
            PG8_STAGE(PG8_SB(1, 1), b3 + hstep, voffB);
            PG8_WAIT_V(6); PG8_BAR; PG8_MMA(1, 1, At, B1); PG8_BAR;
        }
        E(acc, cur, wr, wc, fr, fq);
        if (!has_next) break;
#pragma unroll
        for (int a = 0; a < 2; ++a)
#pragma unroll
            for (int b = 0; b < 2; ++b)
#pragma unroll
                for (int m = 0; m < 4; ++m)
#pragma unroll
                    for (int n = 0; n < 2; ++n) acc[a][b][m][n] = (f32x4){0.f, 0.f, 0.f, 0.f};
        cur = nxt; cA = nA; cB = nB; ++ui;
    }
    PG8_WAIT_V(0);
    if (wr == 0) PG8_BAR;
    PG8_BAR;
#undef PG8_SA
#undef PG8_SB
#undef PG8_STAGE
#undef PG8_LDA
#undef PG8_LDB
#undef PG8_MMA
#undef PG8_WAIT_V
#undef PG8_WAIT_L
#undef PG8_BAR
#undef PG8_SCHED
}
}

struct EpiIn {
    static constexpr bool PERM = true;
    bf16_t* proj; bf16_t* vta; bf16_t* vtc; float* bint; LAS unsigned char* tlds;
    DI void operator()(const f32x4 (&acc)[2][2][4][2], const pg8::Unit& u, int wr, int wc, int fr, int fq) const {
        const int colt = u.pn * 256;
        int kind = 0;
        if (colt < C_AGATE) { if ((colt % 3072) >= 2048) kind = 1; }
        else if (colt >= C_BIN && colt < C_BGATE) kind = 2;
        else if (colt >= C_CQKV + 2048 && colt < C_CGATE) kind = 3;
        const int row0 = u.pm * 256 + wr * 64 + fr, col0 = colt + wc * 32 + 8 * fq;
        if (kind == 0) {
#pragma unroll
            for (int ai = 0; ai < 2; ++ai)
#pragma unroll
                for (int m = 0; m < 4; ++m) { bf16_t* rp = proj + PIDX(row0 + ai * 128 + m * 16, col0);
#pragma unroll
                    for (int bj = 0; bj < 2; ++bj) { const f32x4 a = acc[ai][bj][m][0], b = acc[ai][bj][m][1];
                        u32x4 o = {pk2(a[0], a[1]), pk2(a[2], a[3]), pk2(b[0], b[1]), pk2(b[2], b[3])}; *(u32x4*)(rp + bj * 128) = o; } }
        } else if (kind == 1 && colt >= 2 * 3072) {
            bf16_t* base = vta + (ptrdiff_t)(2 * 1024 - 2 * 3072 - 2048) * (ptrdiff_t)S;
#pragma unroll
            for (int ai = 0; ai < 2; ++ai) { const int prow = fr * (S >> 4) + ((u.pm * 256 + ai * 128 + wr * 64) >> 4);
#pragma unroll
                for (int bj = 0; bj < 2; ++bj)
#pragma unroll
                    for (int n = 0; n < 2; ++n)
#pragma unroll
                        for (int e = 0; e < 4; ++e) { u32x2 o = {pk2(acc[ai][bj][0][n][e], acc[ai][bj][1][n][e]), pk2(acc[ai][bj][2][n][e], acc[ai][bj][3][n][e])};
                            *(u32x2*)(base + (ptrdiff_t)(col0 + bj * 128 + n * 4 + e) * (ptrdiff_t)S + prow) = o; } }
        } else {
            const int lane = fr + 16 * fq, wave = wr * 4 + wc;
            LAS float* tl = (LAS float*)(tlds + wave * 2304);
            const int cl = lane >> 1, hs = lane & 1;
            const int colg = colt + wc * 32 + cl;
#pragma unroll
            for (int ai = 0; ai < 2; ++ai)
#pragma unroll
                for (int bj = 0; bj < 2; ++bj)
#pragma unroll
                    for (int m = 0; m < 4; ++m) {
                        const int rowb = u.pm * 256 + ai * 128 + wr * 64 + m * 16;
#pragma unroll
                        for (int n = 0; n < 2; ++n)
#pragma unroll
                            for (int e = 0; e < 4; ++e) tl[(8 * fq + 4 * n + e) * 17 + fr] = acc[ai][bj][m][n][e];
                        __builtin_amdgcn_wave_barrier();
                        const LAS float* tc = tl + cl * 17;
                        const int col = colg + bj * 128;
                        if (kind == 2) {
                            f32x4 o0 = {tc[8 * hs], tc[8 * hs + 1], tc[8 * hs + 2], tc[8 * hs + 3]}, o1 = {tc[8 * hs + 4], tc[8 * hs + 5], tc[8 * hs + 6], tc[8 * hs + 7]};
                            float* bp = bint + (size_t)(col - C_BIN) * S + rowb + 8 * hs;
                            *(f32x4*)bp = o0; *(f32x4*)(bp + 4) = o1;
                        } else if (kind == 3) {
                            u32x4 o = {pk2(tc[4 * hs], tc[4 * hs + 1]), pk2(tc[4 * hs + 2], tc[4 * hs + 3]), pk2(tc[8 + 4 * hs], tc[9 + 4 * hs]), pk2(tc[10 + 4 * hs], tc[11 + 4 * hs])};
                            *(u32x4*)(vtc + (size_t)(col - (C_CQKV + 2048)) * S + rowb + 8 * hs) = o;
                        } else if (colt < 3072) {
                            u32x4 o = {pk2(tc[8 * hs], tc[8 * hs + 1]), pk2(tc[8 * hs + 2], tc[8 * hs + 3]), pk2(tc[8 * hs + 4], tc[8 * hs + 5]), pk2(tc[8 * hs + 6], tc[8 * hs + 7])};
                            *(u32x4*)(vta + (size_t)(col - 2048) * S + rowb + 8 * hs) = o;
                        } else {
#pragma unroll
                            for (int k = 0; k < 2; ++k) { const int res = 2 * hs + k;
                                u32x2 o = {pk2(tc[res], tc[res + 4]), pk2(tc[res + 8], tc[res + 12])};
                                *(u32x2*)(vta + (size_t)(1024 + col - 3072 - 2048) * S + res * (S >> 2) + (rowb >> 2)) = o; }
                        }
                        __builtin_amdgcn_wave_barrier();
                    }
        }
    }
};
struct ProjOrder {
    pg8::StaticOrder so;
    DI bool next(int i, pg8::Unit& u) const { pg8::Unit b; if (!so.next(i / 3, b)) return false; const int nb = i % 3; u.pm = b.pm + 32 * nb; u.pn = b.pn + 8 * nb; return true; }
};
struct EpiProj {   static constexpr bool PERM = false;
    const bf16_t* proj; const float* mb; float* yf; bf16_t* yb;
    DI void operator()(const f32x4 (&acc)[2][2][4][2], const pg8::Unit& u, int wr, int wc, int fr, int fq) const {
        const int nb = u.pm >> 5;
        const int row0 = (u.pm & 31) * 256 + wr * 64 + fr, col0 = (u.pn & 7) * 256 + wc * 32 + 4 * fq;
        f32x4 b4[2][2];
#pragma unroll
        for (int bj = 0; bj < 2; ++bj)
#pragma unroll
            for (int n = 0; n < 2; ++n) b4[bj][n] = *(const f32x4*)(mb + nb * D + col0 + bj * 128 + n * 16);
#pragma unroll
        for (int ai = 0; ai < 2; ++ai)
#pragma unroll
            for (int mp = 0; mp < 2; ++mp) {
                u32x2 mg[2][2][2]; f32x4 yv[2][2][2];
#pragma unroll
                for (int mi = 0; mi < 2; ++mi) { const int row = row0 + ai * 128 + (2 * mp + mi) * 16;
#pragma unroll
                    for (int bj = 0; bj < 2; ++bj)
#pragma unroll
                        for (int n = 0; n < 2; ++n) { const int col = col0 + bj * 128 + n * 16;
                            mg[mi][bj][n] = *(const u32x2*)(proj + PIDX(row, C_MERGE + nb * D + col));
                            if (nb > 0) yv[mi][bj][n] = *(const f32x4*)(yf + (size_t)row * D + col); else yv[mi][bj][n] = (f32x4){0.f, 0.f, 0.f, 0.f}; } }
#pragma unroll
                for (int mi = 0; mi < 2; ++mi) { const int m = 2 * mp + mi; const int row = row0 + ai * 128 + m * 16;
#pragma unroll
                    for (int bj = 0; bj < 2; ++bj)
#pragma unroll
                        for (int n = 0; n < 2; ++n) { const int col = col0 + bj * 128 + n * 16; const f32x4 a = acc[ai][bj][m][n]; const u32x2 g2 = mg[mi][bj][n]; const f32x4 bb = b4[bj][n];
                            f32x4 v = yv[mi][bj][n];
                            v[0] += a[0] * sigm_f(bflo(g2[0]) + bb[0]); v[1] += a[1] * sigm_f(bfhi(g2[0]) + bb[1]);
                            v[2] += a[2] * sigm_f(bflo(g2[1]) + bb[2]); v[3] += a[3] * sigm_f(bfhi(g2[1]) + bb[3]);
                            if (nb < 2) *(f32x4*)(yf + (size_t)row * D + col) = v;
                            else { u32x2 o = {pk2(v[0], v[1]), pk2(v[2], v[3])}; *(u32x2*)(yb + (size_t)row * D + col) = o; } } }
            }
    }
};
struct EpiOut {   static constexpr bool PERM = false;
    const float* xold; float* xnew;
    DI void operator()(const f32x4 (&acc)[2][2][4][2], const pg8::Unit& u, int wr, int wc, int fr, int fq) const {
        const int row0 = u.pm * 256 + wr * 64 + fr, col0 = u.pn * 256 + wc * 32 + 4 * fq;
#pragma unroll
        for (int ai = 0; ai < 2; ++ai)
#pragma unroll
            for (int mp = 0; mp < 2; ++mp) {
                f32x4 xv[2][2][2];
#pragma unroll
                for (int mi = 0; mi < 2; ++mi)
#pragma unroll
                    for (int bj = 0; bj < 2; ++bj)
#pragma unroll
                        for (int n = 0; n < 2; ++n) xv[mi][bj][n] = *(const f32x4*)(xold + (size_t)(row0 + ai * 128 + (2 * mp + mi) * 16) * D + col0 + bj * 128 + n * 16);
#pragma unroll
                for (int mi = 0; mi < 2; ++mi)
#pragma unroll
                    for (int bj = 0; bj < 2; ++bj)
#pragma unroll
                        for (int n = 0; n < 2; ++n) *(f32x4*)(xnew + (size_t)(row0 + ai * 128 + (2 * mp + mi) * 16) * D + col0 + bj * 128 + n * 16) = xv[mi][bj][n] + acc[ai][bj][2 * mp + mi][n];
            }
    }
};
DI float wave_sum(float v) {
#pragma unroll
    for (int o = 1; o < 64; o <<= 1) v += __shfl_xor(v, o);
    return v;
}
DI int crow(int reg, int h) { return (reg & 3) + 8 * (reg >> 2) + 4 * h; }
DI bf16x8 pack8(const f32x16& x, const int s) {
    u32x4 p;
    p[0] = pk2(x[8 * s + 0], x[8 * s + 1]); p[1] = pk2(x[8 * s + 2], x[8 * s + 3]);
    p[2] = pk2(x[8 * s + 4], x[8 * s + 5]); p[3] = pk2(x[8 * s + 6], x[8 * s + 7]);
    return __builtin_bit_cast(bf16x8, p);
}
#define MFMA32(a, b, c) __builtin_amdgcn_mfma_f32_32x32x16_bf16((a), (b), (c), 0, 0, 0)

DI void transpose_item(const float* Wsrc, int K, int N, bf16_t* WT, LAS float* scr, int item, int lane) {
    const int nblk = N / 64, kb = item / nblk, nb = item % nblk, k0 = 64 * kb, n0 = 64 * nb;
    const int lr = lane >> 4, lc = (lane & 15) * 4;
    f32x4 v[16];
#pragma unroll
    for (int i = 0; i < 16; ++i) v[i] = *(const f32x4*)(Wsrc + (size_t)(k0 + 4 * i + lr) * N + n0 + lc);
#pragma unroll
    for (int i = 0; i < 16; ++i) { LAS float* d = scr + (4 * i + lr) * 65 + lc; d[0] = v[i][0]; d[1] = v[i][1]; d[2] = v[i][2]; d[3] = v[i][3]; }
    __builtin_amdgcn_wave_barrier();
    const int c = lane & 7;
#pragma unroll
    for (int j = 0; j < 8; ++j) { const int n = (lane >> 3) + 8 * j; const LAS float* s = scr + (8 * c) * 65 + n;
        u32x4 o; o[0] = pk2(s[0 * 65], s[1 * 65]); o[1] = pk2(s[2 * 65], s[3 * 65]); o[2] = pk2(s[4 * 65], s[5 * 65]); o[3] = pk2(s[6 * 65], s[7 * 65]);
        *(u32x4*)(WT + (size_t)(n0 + n) * K + k0 + 8 * c) = o; }
    __builtin_amdgcn_wave_barrier();
}
DI int t5_bucket(int rel) {
    const int ret = rel > 0 ? 16 : 0; const int n = rel < 0 ? -rel : rel;
    const float nf = (float)(n > 1 ? n : 1);
    int large = 8 + (int)(logf(nf / 8.0f) / 4.852030263919617f * 8.0f);
    large = large < 15 ? large : 15;
    return ret + (n < 8 ? n : large);
}
DI void phase_prologue(const Params& p, LAS unsigned char* lds) {
    const int tid = tidx(), wave = tid >> 6, lane = tid & 63;
    const int gw = blockIdx.x * NWAVES + wave, NGW = gridDim.x * NWAVES;
    LAS float* scr = (LAS float*)(lds + wave * 16640);
    bf16_t* win_t = (bf16_t*)(p.ws + WS_WIN); bf16_t* wpr_t = (bf16_t*)(p.ws + WS_WPR); bf16_t* wout_t = (bf16_t*)(p.ws + WS_WOUT);
    constexpr int IT_IN = (D / 64) * (NIN / 64), IT_PR = (1024 / 64) * (D / 64), IT_OUT = (D / 64) * (D / 64);
    constexpr int TOT = DEPTH * IT_IN + DEPTH * 3 * IT_PR + DEPTH * IT_OUT;
    for (int it = gw; it < TOT; it += NGW) {
        int r = it;
        if (r < DEPTH * IT_IN) { const int l = r / IT_IN; transpose_item(p.in[I_WIN] + (size_t)l * D * NIN, D, NIN, win_t + (size_t)l * NIN * D, scr, r % IT_IN, lane); continue; }
        r -= DEPTH * IT_IN;
        if (r < DEPTH * 3 * IT_PR) { const int l = r / IT_PR; transpose_item(p.in[I_WPROJ] + (size_t)l * 1024 * D, 1024, D, wpr_t + (size_t)l * D * 1024, scr, r % IT_PR, lane); continue; }
        r -= DEPTH * 3 * IT_PR;
        { const int l = r / IT_OUT; transpose_item(p.in[I_WOUT] + (size_t)l * D * D, D, D, wout_t + (size_t)l * D * D, scr, r % IT_OUT, lane); }
    }
    float* bias = (float*)(p.ws + WS_BIAS);
    for (int i = blockIdx.x * NTHR + tid; i < 32 * 2049; i += gridDim.x * NTHR) {
        const int hd = i / 2049, rel = (i % 2049) - 1024;
        bias[i] = p.in[I_RELB][t5_bucket(rel) * 32 + hd] * LOG2E;
    }
    __syncthreads();
    LAS float* zemb = (LAS float*)lds;
    LAS float* h1 = (LAS float*)(lds + 2048);
    float* hid2 = (float*)(p.ws + WS_HID2);
    for (int rb = blockIdx.x; rb < S / 8; rb += gridDim.x) {
        const int rl = tid >> 6, j = tid & 63, i = rb * 8 + rl;
        if (j < 33) {
            float z;
            if (j == 0) z = (float)i / 8191.0f;
            else { const int k = (j - 1) & 15; const float fb = 1e-4f + (float)k * ((15.0f - 1e-4f) / 15.0f); const float w = 6.283185307179586f * (float)i / 8192.0f; const float a = fb * w; z = (j <= 16) ? cosf(a) : -sinf(a); }
            zemb[rl * 36 + j] = z;
        }
        __syncthreads();
        for (int l = 0; l < DEPTH; ++l) {
            float a1 = p.in[I_HYB1][l * 64 + j];
            for (int e = 0; e < 33; ++e) a1 += zemb[rl * 36 + e] * p.in[I_HYW1][(l * 33 + e) * 64 + j];
            h1[rl * 64 + j] = sinf(p.in[I_HYFREQ][(l * 2 + 0) * 64 + j] * a1);
            __syncthreads();
            float a2 = p.in[I_HYB2][l * 64 + j];
            for (int e = 0; e < 64; ++e) a2 += h1[rl * 64 + e] * p.in[I_HYW2][(l * 64 + e) * 64 + j];
            hid2[((size_t)l * S + i) * 64 + j] = sinf(p.in[I_HYFREQ][(l * 2 + 1) * 64 + j] * a2);
            __syncthreads();
        }
    }
}


DI void split8(const f32x4 a, const f32x4 b, bf16x8& hi, bf16x8& lo) {
    u32x4 h, l2;
    h[0] = pk2(a[0], a[1]); h[1] = pk2(a[2], a[3]); h[2] = pk2(b[0], b[1]); h[3] = pk2(b[2], b[3]);
    l2[0] = pk2(a[0] - bflo(h[0]), a[1] - bfhi(h[0])); l2[1] = pk2(a[2] - bflo(h[1]), a[3] - bfhi(h[1]));
    l2[2] = pk2(b[0] - bflo(h[2]), b[1] - bfhi(h[2])); l2[3] = pk2(b[2] - bflo(h[3]), b[3] - bfhi(h[3]));
    hi = __builtin_bit_cast(bf16x8, h); lo = __builtin_bit_cast(bf16x8, l2);
}
DI void phase_tgen(const Params& p) {
    const int tid = tidx(), wave = tid >> 6, lane = tid & 63, r = lane & 31, hh = lane >> 5;
    float* tt = (float*)(p.ws + WS_TT);
    for (int it = blockIdx.x * NWAVES + wave; it < DEPTH * 128 * 4; it += gridDim.x * NWAVES) {
        const int l = it >> 9, cb = (it >> 2) & 127, rc = it & 3;
        const float* w3 = p.in[I_HYW3] + (size_t)l * 64 * 4096 + cb * 32 + r;
        bf16x8 ahi[4], alo[4];
#pragma unroll
        for (int ks = 0; ks < 4; ++ks) {
            f32x4 a, b;
#pragma unroll
            for (int j = 0; j < 4; ++j) { a[j] = w3[(size_t)(16 * ks + 8 * hh + j) * 4096]; b[j] = w3[(size_t)(16 * ks + 8 * hh + 4 + j) * 4096]; }
            split8(a, b, ahi[ks], alo[ks]);
        }
        const float* hid2 = (const float*)(p.ws + WS_HID2) + (size_t)l * S * 64;
        f32x4 ha[4], hb[4];
        { const float* hr = hid2 + (size_t)(rc * 2048 + r) * 64 + 8 * hh;
#pragma unroll
          for (int ks = 0; ks < 4; ++ks) { ha[ks] = *(const f32x4*)(hr + 16 * ks); hb[ks] = *(const f32x4*)(hr + 16 * ks + 4); } }
#pragma unroll 1
        for (int rb = 0; rb < 64; ++rb) {
            const int i0 = rc * 2048 + rb * 32;
            bf16x8 bhi[4], blo[4];
#pragma unroll
            for (int ks = 0; ks < 4; ++ks) split8(ha[ks], hb[ks], bhi[ks], blo[ks]);
            if (rb + 1 < 64) { const float* hr = hid2 + (size_t)(i0 + 32 + r) * 64 + 8 * hh;
#pragma unroll
                for (int ks = 0; ks < 4; ++ks) { ha[ks] = *(const f32x4*)(hr + 16 * ks); hb[ks] = *(const f32x4*)(hr + 16 * ks + 4); } }
            f32x16 acc;
#pragma unroll
            for (int i = 0; i < 16; ++i) acc[i] = 0.f;
#pragma unroll
            for (int ks = 0; ks < 4; ++ks) { acc = MFMA32(ahi[ks], bhi[ks], acc); acc = MFMA32(ahi[ks], blo[ks], acc); acc = MFMA32(alo[ks], bhi[ks], acc); }
            float* tp = tt + ((size_t)l * 4096 + cb * 32) * S + i0 + r;
#pragma unroll
            for (int reg = 0; reg < 16; ++reg) tp[(size_t)crow(reg, hh) * S] = acc[reg];
        }
    }
}

#define XI(i) ((i) + ((i) >> 4) + ((i) >> 8))
DI cf cmul(cf a, cf b) {
    cf t, r;
    asm("v_pk_mul_f32 %0, %1, %2 op_sel:[0,0] op_sel_hi:[0,1]" : "=v"(t) : "v"(a), "v"(b));
    asm("v_pk_fma_f32 %0, %1, %2, %3 op_sel:[1,1,0] op_sel_hi:[1,0,1] neg_lo:[0,1,0]" : "=v"(r) : "v"(a), "v"(b), "v"(t));
    return r;
}
DI cf twid(float frac) { float c = __builtin_amdgcn_cosf(frac), s = __builtin_amdgcn_sinf(frac); asm volatile("s_nop 1" : "+v"(c), "+v"(s)); return (cf){c, -s}; }
DI cf twidc(float frac) { float c = __builtin_amdgcn_cosf(frac), s = __builtin_amdgcn_sinf(frac); asm volatile("s_nop 1" : "+v"(c), "+v"(s)); return (cf){c, s}; }
DI void fwd4(cf& a0, cf& a1, cf& a2, cf& a3) {
    const cf s02 = a0 + a2, d02 = a0 - a2, s13 = a1 + a3, d13 = a1 - a3;
    a0 = s02 + s13; a2 = s02 - s13;
    a1 = (cf){d02.x + d13.y, d02.y - d13.x};
    a3 = (cf){d02.x - d13.y, d02.y + d13.x};
}
DI void inv4(cf& b0, cf& b1, cf& b2, cf& b3) {
    const cf s02 = b0 + b2, d02 = b0 - b2, s13 = b1 + b3, d13 = b1 - b3;
    b0 = s02 + s13; b2 = s02 - s13;
    b1 = (cf){d02.x - d13.y, d02.y + d13.x};
    b3 = (cf){d02.x + d13.y, d02.y - d13.x};
}
template <int LOGM> DI void fwd_r4_pass(LAS cf* X, int tid) {
    asm volatile("" : "+v"(tid));
    constexpr int M = 1 << LOGM, q = M >> 2;
#pragma unroll 2
    for (int t = tid; t < 4096; t += NTHR) {
        const int j = t & (q - 1), base = (t >> (LOGM - 2)) * M + j;
        constexpr int QP = (q >= 256) ? (q + (q >> 4) + (q >> 8)) : ((q == 16) ? 17 : 1);
        LAS cf* xp = X + XI(base);
        cf a0 = xp[0], a1 = xp[QP], a2 = xp[2 * QP], a3 = xp[3 * QP];
        fwd4(a0, a1, a2, a3);
        const cf w1 = twid((float)j * (1.0f / M)), w2 = cmul(w1, w1), w3 = cmul(w2, w1);
        xp[0] = a0; xp[QP] = cmul(a1, w1); xp[2 * QP] = cmul(a2, w2); xp[3 * QP] = cmul(a3, w3);
    }
}
template <int LOGM> DI void inv_r4_pass(LAS cf* X, int tid) {
    asm volatile("" : "+v"(tid));
    constexpr int M = 1 << LOGM, q = M >> 2;
#pragma unroll 2
    for (int t = tid; t < 4096; t += NTHR) {
        const int j = t & (q - 1), base = (t >> (LOGM - 2)) * M + j;
        const cf w1 = twidc((float)j * (1.0f / M)), w2 = cmul(w1, w1), w3 = cmul(w2, w1);
        constexpr int QP = (q >= 256) ? (q + (q >> 4) + (q >> 8)) : ((q == 16) ? 17 : 1);
        LAS cf* xp = X + XI(base);
        cf b0 = xp[0], b1 = cmul(xp[QP], w1), b2 = cmul(xp[2 * QP], w2), b3 = cmul(xp[3 * QP], w3);
        inv4(b0, b1, b2, b3);
        xp[0] = b0; xp[QP] = b1; xp[2 * QP] = b2; xp[3 * QP] = b3;
    }
}
template <int LOGM> DI void fwd16(cf (&v)[16], int j) {
    constexpr int M = 1 << LOGM, q = M >> 4;
#pragma unroll
    for (int n = 0; n < 4; ++n) {
        fwd4(v[n], v[n + 4], v[n + 8], v[n + 12]);
        const cf w1 = twid((float)(j + n * q) * (1.0f / M)), w2 = cmul(w1, w1), w3 = cmul(w2, w1);
        v[n + 4] = cmul(v[n + 4], w1); v[n + 8] = cmul(v[n + 8], w2); v[n + 12] = cmul(v[n + 12], w3);
    }
    const cf u1 = twid((float)j * (4.0f / M)), u2 = cmul(u1, u1), u3 = cmul(u2, u1);
#pragma unroll
    for (int m = 0; m < 4; ++m) {
        fwd4(v[4 * m], v[4 * m + 1], v[4 * m + 2], v[4 * m + 3]);
        v[4 * m + 1] = cmul(v[4 * m + 1], u1); v[4 * m + 2] = cmul(v[4 * m + 2], u2); v[4 * m + 3] = cmul(v[4 * m + 3], u3);
    }
}
template <int LOGM> DI void inv16(cf (&v)[16], int j) {
    constexpr int M = 1 << LOGM, q = M >> 4;
    const cf u1 = twidc((float)j * (4.0f / M)), u2 = cmul(u1, u1), u3 = cmul(u2, u1);
#pragma unroll
    for (int m = 0; m < 4; ++m) {
        v[4 * m + 1] = cmul(v[4 * m + 1], u1); v[4 * m + 2] = cmul(v[4 * m + 2], u2); v[4 * m + 3] = cmul(v[4 * m + 3], u3);
        inv4(v[4 * m], v[4 * m + 1], v[4 * m + 2], v[4 * m + 3]);
    }
#pragma unroll
    for (int n = 0; n < 4; ++n) {
        const cf w1 = twidc((float)(j + n * q) * (1.0f / M)), w2 = cmul(w1, w1), w3 = cmul(w2, w1);
        v[n + 4] = cmul(v[n + 4], w1); v[n + 8] = cmul(v[n + 8], w2); v[n + 12] = cmul(v[n + 12], w3);
        inv4(v[n], v[n + 4], v[n + 8], v[n + 12]);
    }
}
template <int LOGM> DI void fwd_r16_pass(LAS cf* X, int tid) {
    asm volatile("" : "+v"(tid));
    constexpr int M = 1 << LOGM, q = M >> 4;
#pragma unroll 1
    for (int t = tid; t < 1024; t += NTHR) {
        const int j = t & (q - 1), base = (t >> (LOGM - 4)) * M + j;
        constexpr int QP = (q >= 256) ? (q + (q >> 4) + (q >> 8)) : ((q == 16) ? 17 : 1);
        LAS cf* xp = X + XI(base);
        cf v[16];
#pragma unroll
        for (int n = 0; n < 16; ++n) v[n] = xp[n * QP];
        fwd16<LOGM>(v, j);
#pragma unroll
        for (int n = 0; n < 16; ++n) xp[n * QP] = v[n];
    }
}
template <int LOGM> DI void inv_r16_pass(LAS cf* X, int tid) {
    asm volatile("" : "+v"(tid));
    constexpr int M = 1 << LOGM, q = M >> 4;
#pragma unroll 1
    for (int t = tid; t < 1024; t += NTHR) {
        const int j = t & (q - 1), base = (t >> (LOGM - 4)) * M + j;
        constexpr int QP = (q >= 256) ? (q + (q >> 4) + (q >> 8)) : ((q == 16) ? 17 : 1);
        LAS cf* xp = X + XI(base);
        cf v[16];
#pragma unroll
        for (int n = 0; n < 16; ++n) v[n] = xp[n * QP];
        inv16<LOGM>(v, j);
#pragma unroll
        for (int n = 0; n < 16; ++n) xp[n * QP] = v[n];
    }
}
DI int rev4(int pp) { const unsigned br = __brev((unsigned)pp) >> 18; return (int)(((br & 0x2AAAu) >> 1) | ((br & 0x1555u) << 1)); }
DI void fft_forward(LAS cf* X, int tid) {
    fwd_r4_pass<14>(X, tid); __syncthreads();
    fwd_r16_pass<12>(X, tid); __syncthreads();
    fwd_r16_pass<8>(X, tid); __syncthreads();
    fwd_r16_pass<4>(X, tid); __syncthreads();
}
constexpr int SPEC_STRIDE = 8208;
DI void fft_conv(LAS cf* X, const f32x4* spec, int tid) {
    fft_forward(X, tid);
#pragma unroll 8
    for (int r = 0; r < 16; ++r) {
        const int k = tid + NTHR * r; const int pp = rev4(k);
        const f32x4 sp = spec[k]; const cf P = (cf){sp[0], sp[1]}, Mq = (cf){sp[2], sp[3]};
        const cf z = X[XI(pp)];
        if (k == 0) { X[XI(pp)] = cmul(z, P) + cmul((cf){z.x, -z.y}, Mq); }
        else { const int pm = rev4(16384 - k); const cf zm = X[XI(pm)];
            const cf y = cmul(z, P) + cmul((cf){zm.x, -zm.y}, Mq);
            const cf t = cmul((cf){zm.x, -zm.y}, P) + cmul(z, Mq);
            X[XI(pp)] = y; X[XI(pm)] = (cf){t.x, -t.y}; }
    }
    if (tid == 0) { const int pp = rev4(8192); const f32x4 sp = spec[8192]; const cf z = X[XI(pp)]; X[XI(pp)] = cmul(z, (cf){sp[0], sp[1]}) + cmul((cf){z.x, -z.y}, (cf){sp[2], sp[3]}); }
    __syncthreads();
    inv_r16_pass<4>(X, tid); __syncthreads();
    inv_r16_pass<8>(X, tid); __syncthreads();
    inv_r16_pass<12>(X, tid); __syncthreads();
    inv_r4_pass<14>(X, tid); __syncthreads();
}


typedef _Float16 hc __attribute__((ext_vector_type(2)));
DI hc hcmul(hc a, hc b) { hc t, r;
    asm("v_pk_mul_f16 %0, %1, %2 op_sel:[0,0] op_sel_hi:[0,1]" : "=v"(t) : "v"(a), "v"(b));
    asm("v_pk_fma_f16 %0, %1, %2, %3 op_sel:[1,1,0] op_sel_hi:[1,0,1] neg_lo:[0,1,0]" : "=v"(r) : "v"(a), "v"(b), "v"(t)); return r; }
DI hc hadd_mi(hc a, hc b) { hc r; asm("v_pk_add_f16 %0, %1, %2 op_sel:[0,1] op_sel_hi:[1,0] neg_hi:[0,1]" : "=v"(r) : "v"(a), "v"(b)); return r; }
DI hc hadd_pi(hc a, hc b) { hc r; asm("v_pk_add_f16 %0, %1, %2 op_sel:[0,1] op_sel_hi:[1,0] neg_lo:[0,1]" : "=v"(r) : "v"(a), "v"(b)); return r; }
DI hc htwid(float frac) { float c = __builtin_amdgcn_cosf(frac), s = __builtin_amdgcn_sinf(frac); asm volatile("s_nop 1" : "+v"(c), "+v"(s)); return (hc){(_Float16)c, (_Float16)(-s)}; }
DI hc htwidc(float frac) { float c = __builtin_amdgcn_cosf(frac), s = __builtin_amdgcn_sinf(frac); asm volatile("s_nop 1" : "+v"(c), "+v"(s)); return (hc){(_Float16)c, (_Float16)s}; }
DI void hfwd4(hc& a0, hc& a1, hc& a2, hc& a3) {
    const hc s02 = a0 + a2, d02 = a0 - a2, s13 = a1 + a3, d13 = a1 - a3;
    a0 = s02 + s13; a2 = s02 - s13; a1 = hadd_mi(d02, d13); a3 = hadd_pi(d02, d13);
}
DI void hinv4(hc& b0, hc& b1, hc& b2, hc& b3) {
    const hc s02 = b0 + b2, d02 = b0 - b2, s13 = b1 + b3, d13 = b1 - b3;
    b0 = s02 + s13; b2 = s02 - s13; b1 = hadd_pi(d02, d13); b3 = hadd_mi(d02, d13);
}
template <int LOGM> DI void hfwd_r4_pass(LAS hc* X, int tid) {
    asm volatile("" : "+v"(tid));
    constexpr int M = 1 << LOGM, q = M >> 2;
#pragma unroll 8
    for (int t = tid; t < 4096; t += NTHR) {
        const int j = t & (q - 1), base = (t >> (LOGM - 2)) * M + j;
        constexpr int QP = (q >= 256) ? (q + (q >> 4) + (q >> 8)) : ((q == 16) ? 17 : 1);
        LAS hc* xp = X + XI(base);
        hc a0 = xp[0], a1 = xp[QP], a2 = xp[2 * QP], a3 = xp[3 * QP];
        hfwd4(a0, a1, a2, a3);
        const hc w1 = htwid((float)j * (1.0f / M)), w2 = hcmul(w1, w1), w3 = hcmul(w2, w1);
        xp[0] = a0; xp[QP] = hcmul(a1, w1); xp[2 * QP] = hcmul(a2, w2); xp[3 * QP] = hcmul(a3, w3);
    }
}
template <int LOGM> DI void hinv_r4_pass(LAS hc* X, int tid) {
    asm volatile("" : "+v"(tid));
    constexpr int M = 1 << LOGM, q = M >> 2;
#pragma unroll 8
    for (int t = tid; t < 4096; t += NTHR) {
        const int j = t & (q - 1), base = (t >> (LOGM - 2)) * M + j;
        const hc w1 = htwidc((float)j * (1.0f / M)), w2 = hcmul(w1, w1), w3 = hcmul(w2, w1);
        constexpr int QP = (q >= 256) ? (q + (q >> 4) + (q >> 8)) : ((q == 16) ? 17 : 1);
        LAS hc* xp = X + XI(base);
        hc b0 = xp[0], b1 = hcmul(xp[QP], w1), b2 = hcmul(xp[2 * QP], w2), b3 = hcmul(xp[3 * QP], w3);
        hinv4(b0, b1, b2, b3);
        xp[0] = b0; xp[QP] = b1; xp[2 * QP] = b2; xp[3 * QP] = b3;
    }
}
template <int LOGM> DI void hfwd16(hc (&v)[16], int j) {
    constexpr int M = 1 << LOGM, q = M >> 4;
#pragma unroll
    for (int n = 0; n < 4; ++n) {
        hfwd4(v[n], v[n + 4], v[n + 8], v[n + 12]);
        const hc w1 = htwid((float)(j + n * q) * (1.0f / M)), w2 = hcmul(w1, w1), w3 = hcmul(w2, w1);
        v[n + 4] = hcmul(v[n + 4], w1); v[n + 8] = hcmul(v[n + 8], w2); v[n + 12] = hcmul(v[n + 12], w3);
    }
    const hc u1 = htwid((float)j * (4.0f / M)), u2 = hcmul(u1, u1), u3 = hcmul(u2, u1);
#pragma unroll
    for (int m = 0; m < 4; ++m) {
        hfwd4(v[4 * m], v[4 * m + 1], v[4 * m + 2], v[4 * m + 3]);
        v[4 * m + 1] = hcmul(v[4 * m + 1], u1); v[4 * m + 2] = hcmul(v[4 * m + 2], u2); v[4 * m + 3] = hcmul(v[4 * m + 3], u3);
    }
}
template <int LOGM> DI void hinv16(hc (&v)[16], int j) {
    constexpr int M = 1 << LOGM, q = M >> 4;
    const hc u1 = htwidc((float)j * (4.0f / M)), u2 = hcmul(u1, u1), u3 = hcmul(u2, u1);
#pragma unroll
    for (int m = 0; m < 4; ++m) {
        v[4 * m + 1] = hcmul(v[4 * m + 1], u1); v[4 * m + 2] = hcmul(v[4 * m + 2], u2); v[4 * m + 3] = hcmul(v[4 * m + 3], u3);
        hinv4(v[4 * m], v[4 * m + 1], v[4 * m + 2], v[4 * m + 3]);
    }
#pragma unroll
    for (int n = 0; n < 4; ++n) {
        const hc w1 = htwidc((float)(j + n * q) * (1.0f / M)), w2 = hcmul(w1, w1), w3 = hcmul(w2, w1);
        v[n + 4] = hcmul(v[n + 4], w1); v[n + 8] = hcmul(v[n + 8], w2); v[n + 12] = hcmul(v[n + 12], w3);
        hinv4(v[n], v[n + 4], v[n + 8], v[n + 12]);
    }
}
template <int LOGM, bool FWD> DI void h_r16_pass(LAS hc* X, int tid) {
    asm volatile("" : "+v"(tid));
    constexpr int M = 1 << LOGM, q = M >> 4;
#pragma unroll
    for (int t = tid; t < 1024; t += NTHR) {
        const int j = t & (q - 1), base = (t >> (LOGM - 4)) * M + j;
        constexpr int QP = (q >= 256) ? (q + (q >> 4) + (q >> 8)) : ((q == 16) ? 17 : 1);
        LAS hc* xp = X + XI(base);
        hc v[16];
#pragma unroll
        for (int n = 0; n < 16; ++n) v[n] = xp[n * QP];
        if (FWD) hfwd16<LOGM>(v, j); else hinv16<LOGM>(v, j);
#pragma unroll
        for (int n = 0; n < 16; ++n) xp[n * QP] = v[n];
    }
}
DI void fft_conv_h(LAS hc* X, const f32x4* spec, int tid) {
    hfwd_r4_pass<14>(X, tid); __syncthreads();
    h_r16_pass<12, true>(X, tid); __syncthreads();
    h_r16_pass<8, true>(X, tid); __syncthreads();
    h_r16_pass<4, true>(X, tid); __syncthreads();
#pragma unroll 8
    for (int r = 0; r < 16; ++r) {
        const int k = tid + NTHR * r; const int pp = rev4(k);
        const f32x4 sp = spec[k]; const cf P = (cf){sp[0], sp[1]} * 256.0f, Mq = (cf){sp[2], sp[3]} * 256.0f;
        const hc zh = X[XI(pp)]; const cf z = (cf){(float)zh.x, (float)zh.y};
        if (k == 0) { const cf y = cmul(z, P) + cmul((cf){z.x, -z.y}, Mq); X[XI(pp)] = (hc){(_Float16)y.x, (_Float16)y.y}; }
        else { const int pm = rev4(16384 - k); const hc zmh = X[XI(pm)]; const cf zm = (cf){(float)zmh.x, (float)zmh.y};
            const cf y = cmul(z, P) + cmul((cf){zm.x, -zm.y}, Mq);
            const cf t = cmul((cf){zm.x, -zm.y}, P) + cmul(z, Mq);
            X[XI(pp)] = (hc){(_Float16)y.x, (_Float16)y.y}; X[XI(pm)] = (hc){(_Float16)t.x, (_Float16)(-t.y)}; }
    }
    if (tid == 0) { const int pp = rev4(8192); const f32x4 sp = spec[8192]; const hc zh = X[XI(pp)]; const cf z = (cf){(float)zh.x, (float)zh.y};
        const cf y = (cmul(z, (cf){sp[0], sp[1]}) + cmul((cf){z.x, -z.y}, (cf){sp[2], sp[3]})) * 256.0f; X[XI(pp)] = (hc){(_Float16)y.x, (_Float16)y.y}; }
    __syncthreads();
    h_r16_pass<4, false>(X, tid); __syncthreads();
    h_r16_pass<8, false>(X, tid); __syncthreads();
    h_r16_pass<12, false>(X, tid); __syncthreads();
    hinv_r4_pass<14>(X, tid); __syncthreads();
}

DI void spectra_item(const Params& p, int item, LAS unsigned char* lds) {
    int tid = tidx(); asm volatile("" : "+v"(tid));
    const int l = item >> 10, o = (item >> 9) & 1, pr = item & 511, a = 2 * pr;
    LAS hc* X = (LAS hc*)lds; LAS float* aux = (LAS float*)(lds + LDS_MAIN);
    const float mind = -3.0701134573253943f, maxd = -15.350567286626972f;
    const float da = fabsf(mind + (float)a * ((maxd - mind) / 1023.0f)), db = fabsf(mind + (float)(a + 1) * ((maxd - mind) / 1023.0f));
    const float ska = p.in[I_HYSKIP][(l * 2 + o) * 1024 + a], skb = p.in[I_HYSKIP][(l * 2 + o) * 1024 + a + 1];
    const float* tf = (const float*)(p.ws + WS_TT) + ((size_t)l * 4096 + (o * 2 + 0) * 1024 + a) * S;
    const float* tb = (const float*)(p.ws + WS_TT) + ((size_t)l * 4096 + (o * 2 + 1) * 1024 + a) * S;
#pragma unroll 16
    for (int rr = 0; rr < 16; ++rr) {
        const int i = tid + NTHR * rr;
        const float ti = (float)i / 8191.0f; const float ea = __expf(-ti * da), eb = __expf(-ti * db);
        const float fa = tf[i] * ea, fb = tf[S + i] * eb, ba = tb[i] * ea, bb = tb[S + i] * eb;
        if (i == 0) { X[XI(0)] = (hc){(_Float16)((fa + ba + ska) * 256.0f), (_Float16)((fb + bb + skb) * 256.0f)}; X[XI(8192)] = (hc){(_Float16)0.f, (_Float16)0.f}; }
        else { X[XI(i)] = (hc){(_Float16)(fa * 256.0f), (_Float16)(fb * 256.0f)}; X[XI(16384 - i)] = (hc){(_Float16)(ba * 256.0f), (_Float16)(bb * 256.0f)}; }
    }
    __syncthreads();
    hfwd_r4_pass<14>(X, tid); __syncthreads();
    h_r16_pass<12, true>(X, tid); __syncthreads();
    h_r16_pass<8, true>(X, tid); __syncthreads();
    h_r16_pass<4, true>(X, tid); __syncthreads();
    f32x4* spec = (f32x4*)(p.ws + WS_SPEC) + (size_t)item * SPEC_STRIDE;
    const float sc = 0.5f / 16384.0f / 256.0f;
    for (int r = 0; r < 17; ++r) {
        const int k = tid + NTHR * r; if (k > 8192) break;
        const hc Fh = X[XI(rev4(k))], Fmh = X[XI(rev4((16384 - k) & 16383))]; const cf F = (cf){(float)Fh.x, (float)Fh.y}, Fm = (cf){(float)Fmh.x, (float)Fmh.y};
        const cf Fc = (cf){Fm.x, -Fm.y};
        const cf Ha = (F + Fc) * 0.5f, tt = (F - Fc) * 0.5f; const cf Hb = (cf){tt.y, -tt.x};
        const cf P = (Ha + Hb) * sc, Mq = (Ha - Hb) * sc;
        spec[k] = (f32x4){P.x, P.y, Mq.x, Mq.y};
    }
    __syncthreads();
}

DI float conv3(const float* row, int t, float w0, float w1, float w2) {
    const float c = row[t]; float pv = row[t > 0 ? t - 1 : 0], nx = row[t < S - 1 ? t + 1 : S - 1];
    pv = t > 0 ? pv : 0.f; nx = t < S - 1 ? nx : 0.f;
    return w0 * pv + w1 * c + w2 * nx;
}
DI void hyena_item(const Params& p, int l, int pr, LAS unsigned char* lds) {
    int tid = tidx(); asm volatile("" : "+v"(tid)); const int a = 2 * pr;
    LAS hc* X = (LAS hc*)lds;
    const float* bint = (const float*)(p.ws + WS_BINT);
    const float* cw = p.in[I_HYCONV] + (size_t)l * 3 * 3072;
    float w[3][2][3];
#pragma unroll
    for (int wh = 0; wh < 3; ++wh)
#pragma unroll
        for (int c = 0; c < 2; ++c)
#pragma unroll
            for (int k = 0; k < 3; ++k) w[wh][c][k] = cw[k * 3072 + wh * 1024 + a + c];
    const f32x4* spec = (const f32x4*)(p.ws + WS_SPEC);
    const hc hzero = (hc){(_Float16)0.f, (_Float16)0.f};
#pragma unroll 8
    for (int r = 0; r < 16; ++r) { const int t = tid + NTHR * r;
        const float va = conv3(bint + (size_t)a * S, t, w[0][0][0], w[0][0][1], w[0][0][2]), vb = conv3(bint + (size_t)(a + 1) * S, t, w[0][1][0], w[0][1][1], w[0][1][2]);
        X[XI(t)] = (hc){(_Float16)(va * 0.25f), (_Float16)(vb * 0.25f)};
        X[XI(t + 8192)] = hzero; }
    __syncthreads();
    fft_conv_h(X, spec + (size_t)((l * 2 + 0) * 512 + pr) * SPEC_STRIDE, tid);
#pragma unroll 8
    for (int r = 0; r < 16; ++r) { const int t = tid + NTHR * r; const hc y = X[XI(t)];
        const float za = (float)y.x * (1.0f / 64.0f) * conv3(bint + (size_t)(1024 + a) * S, t, w[1][0][0], w[1][0][1], w[1][0][2]);
        const float zb = (float)y.y * (1.0f / 64.0f) * conv3(bint + (size_t)(1024 + a + 1) * S, t, w[1][1][0], w[1][1][1], w[1][1][2]);
        X[XI(t)] = (hc){(_Float16)(za * 0.25f), (_Float16)(zb * 0.25f)};
        X[XI(t + 8192)] = hzero; }
    __syncthreads();
    fft_conv_h(X, spec + (size_t)((l * 2 + 1) * 512 + pr) * SPEC_STRIDE, tid);
    float* z2t = (float*)(p.ws + WS_Z2T);
#pragma unroll 8
    for (int r = 0; r < 16; ++r) { const int t = tid + NTHR * r; const hc y = X[XI(t)];
        z2t[(size_t)a * S + t] = (float)y.x * (1.0f / 64.0f) * conv3(bint + (size_t)(2048 + a) * S, t, w[2][0][0], w[2][0][1], w[2][0][2]);
        z2t[(size_t)(a + 1) * S + t] = (float)y.y * (1.0f / 64.0f) * conv3(bint + (size_t)(2048 + a + 1) * S, t, w[2][1][0], w[2][1][1], w[2][1][2]); }
    __syncthreads();
}
DI void phase_rmsnorm(const float* x, const float* g, bf16_t* hout, float* fout) {
    const int tid = tidx(), wave = tid >> 6, lane = tid & 63;
    const int gw = blockIdx.x * NWAVES + wave, ngw = gridDim.x * NWAVES;
    for (int row = gw; row < S; row += 2 * ngw) {
        const int row2 = row + ngw;
        const bool has2 = row2 < S;
        const f32x4* xr = (const f32x4*)(x + (size_t)row * D) + lane;
        const f32x4* xr2 = (const f32x4*)(x + (size_t)(has2 ? row2 : row) * D) + lane;
        f32x4 v[8], v2[8]; float s = 0.f, s2 = 0.f;
#pragma unroll
        for (int j = 0; j < 8; ++j) { v[j] = xr[64 * j]; v2[j] = xr2[64 * j]; }
#pragma unroll
        for (int j = 0; j < 8; ++j) { s += (v[j][0] * v[j][0] + v[j][1] * v[j][1]) + (v[j][2] * v[j][2] + v[j][3] * v[j][3]); s2 += (v2[j][0] * v2[j][0] + v2[j][1] * v2[j][1]) + (v2[j][2] * v2[j][2] + v2[j][3] * v2[j][3]); }
        const float rstd = rsqrtf(wave_sum(s) * (1.0f / D) + 1e-6f), rstd2 = rsqrtf(wave_sum(s2) * (1.0f / D) + 1e-6f);
#pragma unroll
        for (int j = 0; j < 8; ++j) { const f32x4 gg = ((const f32x4*)g)[lane + 64 * j]; const f32x4 y = v[j] * rstd * gg, y2 = v2[j] * rstd2 * gg;
            if (hout) { u32x2 o = {pk2(y[0], y[1]), pk2(y[2], y[3])}; ((u32x2*)(hout + (size_t)row * D))[lane + 64 * j] = o;
                if (has2) { u32x2 o2 = {pk2(y2[0], y2[1]), pk2(y2[2], y2[3])}; ((u32x2*)(hout + (size_t)row2 * D))[lane + 64 * j] = o2; } }
            else { ((f32x4*)(fout + (size_t)row * D))[lane + 64 * j] = y; if (has2) ((f32x4*)(fout + (size_t)row2 * D))[lane + 64 * j] = y2; } }
    }
}

constexpr int KROW = 144, KBUF = 64 * KROW, VBUF = 128 * KROW;
DI void softmax_half(f32x16& s, const LAS float* btab, int k0, int q0w, int r, int hh, float cs, float& m, float& lsum, f32x16 (&O)[4]) {
    const int q = q0w + r;
    const int relmin = k0 - q0w - 31, relmax = k0 + 31 - q0w;
    float bc = 0.f, csx = cs;
    if (relmin >= 1024 || relmax <= -1024) { bc = btab[relmin >= 1024 ? 2048 : 0]; }
    else {
        if (relmin >= -1024 && relmax <= 1024) {
            const LAS float* bp = btab + (k0 - q + 1024 + 4 * hh);
#pragma unroll
            for (int i = 0; i < 16; ++i) s[i] = s[i] * cs + bp[(i & 3) + 8 * (i >> 2)];
        } else {
#pragma unroll
            for (int i = 0; i < 16; ++i) { const int rel = k0 + crow(i, hh) - q; const int i0 = min(max(rel, -1024), 1024) + 1024; s[i] = s[i] * cs + btab[i0]; }
        }
        csx = 1.0f;
    }
    float mx = s[0];
#pragma unroll
    for (int i = 1; i < 16; ++i) mx = fmaxf(mx, s[i]);
    mx = mx * csx + bc;
    mx = fmaxf(mx, __shfl_xor(mx, 32));
    if (__any(mx > m + 8.0f)) {
        const float mnew = fmaxf(m, mx), alpha = __builtin_amdgcn_exp2f(m - mnew);
        m = mnew; lsum *= alpha;
#pragma unroll
        for (int db = 0; db < 4; ++db) O[db] *= alpha;
    }
    const float c2 = bc - m;
    float rs0 = 0.f, rs1 = 0.f;
#pragma unroll
    for (int i = 0; i < 16; i += 2) { s[i] = __builtin_amdgcn_exp2f(s[i] * csx + c2); s[i + 1] = __builtin_amdgcn_exp2f(s[i + 1] * csx + c2); rs0 += s[i]; rs1 += s[i + 1]; }
    lsum += rs0 + rs1;
}
constexpr int K3BUF = 64 * 128, V3BUF = 128 * 128;
DI void dstage_k(const bf16_t* kgl, LAS unsigned char* dst, int wave, int lane) {
    const int row = 8 * wave + (lane >> 3), gseg = (lane & 7) ^ ((row >> 1) & 7);
    __builtin_amdgcn_global_load_lds((const unsigned*)(kgl + (size_t)row * 256 + gseg * 8), (LAS unsigned*)(dst + wave * 1024), 16, 0, 0);
}
DI void dstage_v(const bf16_t* vgl, LAS unsigned char* dst, int wave, int lane) {
#pragma unroll
    for (int k = 0; k < 2; ++k) { const int ii = 2 * wave + k, row = 8 * ii + (lane >> 3), gseg = (lane & 7) ^ ((row >> 1) & 7);
        __builtin_amdgcn_global_load_lds((const unsigned*)(vgl + (size_t)row * S + gseg * 8), (LAS unsigned*)(dst + ii * 1024), 16, 0, 0); }
}
DI void sm_max_phase(f32x16& s, const LAS float* btab, int k0, int q0w, int r, int hh, float cs, float& m, float& lsum, f32x16 (&O)[4], float& csx, float& c2) {
    const int q = q0w + r;
    const int relmin = k0 - q0w - 31, relmax = k0 + 31 - q0w;
    float bc = 0.f; csx = cs;
    if (relmin >= 1024 || relmax <= -1024) { bc = btab[relmin >= 1024 ? 2048 : 0]; }
    else {
        if (relmin >= -1024 && relmax <= 1024) {
            const LAS float* bp = btab + (k0 - q + 1024 + 4 * hh);
#pragma unroll
            for (int i = 0; i < 16; ++i) s[i] = s[i] * cs + bp[(i & 3) + 8 * (i >> 2)];
        } else {
#pragma unroll
            for (int i = 0; i < 16; ++i) { const int rel = k0 + crow(i, hh) - q; const int i0 = min(max(rel, -1024), 1024) + 1024; s[i] = s[i] * cs + btab[i0]; }
        }
        csx = 1.0f;
    }
    float mx = s[0];
#pragma unroll
    for (int i = 1; i < 16; ++i) mx = fmaxf(mx, s[i]);
    mx = mx * csx + bc;
    mx = fmaxf(mx, __shfl_xor(mx, 32));
    if (__any(mx > m + 8.0f)) {
        const float mnew = fmaxf(m, mx), alpha = __builtin_amdgcn_exp2f(m - mnew);
        m = mnew; lsum *= alpha;
#pragma unroll
        for (int db = 0; db < 4; ++db) O[db] *= alpha;
    }
    c2 = bc - m;
}
#define DF_EXP2(i0) do { s[i0] = __builtin_amdgcn_exp2f(s[i0] * csx + c2); s[(i0) + 1] = __builtin_amdgcn_exp2f(s[(i0) + 1] * csx + c2); rs0 += s[i0]; rs1 += s[(i0) + 1]; } while (0)
#define DF_FENCE __builtin_amdgcn_sched_barrier(0)
DI void diff_flash2(const bf16_t* proj, const bf16_t* vtc, int h, int c, int q0w, LAS unsigned char* lds, const LAS float* btab, f32x16 (&O)[4]) {
    int tid = tidx(); asm volatile("" : "+v"(tid)); const int lane = tid & 63, r = lane & 31, hh = lane >> 5, wave = __builtin_amdgcn_readfirstlane(tid >> 6);
    constexpr int NT = S / 64;
    bf16x8 qf[4];
    { const bf16_t* qp = proj + PIDX(q0w + r, C_CQKV + h * 128 + c * 64 + 8 * hh);
#pragma unroll
      for (int ks = 0; ks < 4; ++ks) qf[ks] = *(const bf16x8*)(qp + 16 * ks); }
#pragma unroll
    for (int db = 0; db < 4; ++db)
#pragma unroll
        for (int i = 0; i < 16; ++i) O[db][i] = 0.f;
    float m = -1e30f, lsum = 0.f;
    const float cs = 0.125f * LOG2E;
    const bf16_t* kg = proj + PIDX(0, C_CQKV + 1024 + h * 128 + c * 64);
    const bf16_t* vg = vtc + (size_t)(h * 128) * S;
    LAS unsigned char* Kb = lds; LAS unsigned char* Vb = lds + 3 * K3BUF;
    __syncthreads();
    dstage_k(kg, Kb, wave, lane); dstage_v(vg, Vb, wave, lane); dstage_k(kg + (size_t)64 * 256, Kb + K3BUF, wave, lane);
    asm volatile("s_waitcnt vmcnt(0)" ::: "memory");
    __syncthreads();
    const int swz = (r >> 1) & 7, rowoff = r * 128;
    int kso[4];
#pragma unroll
    for (int ks = 0; ks < 4; ++ks) kso[ks] = rowoff + (((2 * ks + hh) ^ swz) << 4);
    bf16x8 kf[4], vf[8];
    f32x16 s, sn;
#pragma unroll
    for (int i = 0; i < 16; ++i) s[i] = 0.f;
#pragma unroll
    for (int ks = 0; ks < 4; ++ks) { kf[ks] = *(const LAS bf16x8*)(Kb + kso[ks]); }
#pragma unroll
    for (int ks = 0; ks < 4; ++ks) s = MFMA32(kf[ks], qf[ks], s);
    int kc = 0, kn = K3BUF, kw = 2 * K3BUF;
#pragma unroll 1
    for (int t = 0; t < NT; ++t) {
        if (t + 2 < NT) dstage_k(kg + (size_t)(t + 2) * 64 * 256, Kb + kw, wave, lane);
        if (t + 1 < NT) dstage_v(vg + (t + 1) * 64, Vb + ((t + 1) & 1) * V3BUF, wave, lane);
        const LAS unsigned char* vb_ = Vb + (t & 1) * V3BUF;
#pragma unroll
        for (int half = 0; half < 2; ++half) {
#pragma unroll
            for (int ss = 0; ss < 2; ++ss) { const int vs = rowoff + (((4 * half + 2 * ss + hh) ^ swz) << 4);
#pragma unroll
                for (int db = 0; db < 4; ++db) vf[ss * 4 + db] = *(const LAS bf16x8*)(vb_ + vs + (32 * db) * 128); }
            const bool have_next = (half == 0) || (t + 1 < NT);
            { const LAS unsigned char* kbase = (half == 0) ? (Kb + kc + 32 * 128) : (Kb + kn);
              if (have_next) {
#pragma unroll
                  for (int ks = 0; ks < 4; ++ks) kf[ks] = *(const LAS bf16x8*)(kbase + kso[ks]); } }
            float csx, c2;
            sm_max_phase(s, btab, t * 64 + 32 * half, q0w, r, hh, cs, m, lsum, O, csx, c2);
            float rs0 = 0.f, rs1 = 0.f;
#pragma unroll
            for (int i = 0; i < 16; ++i) sn[i] = 0.f;
            DF_FENCE;
            sn = MFMA32(kf[0], qf[0], sn); DF_EXP2(0); DF_FENCE;
            sn = MFMA32(kf[1], qf[1], sn); DF_EXP2(2); DF_FENCE;
            sn = MFMA32(kf[2], qf[2], sn); DF_EXP2(4); DF_FENCE;
            sn = MFMA32(kf[3], qf[3], sn); DF_EXP2(6); DF_FENCE;
            const bf16x8 pf0 = pack8(s, 0);
            O[0] = MFMA32(vf[0], pf0, O[0]); DF_EXP2(8); DF_FENCE;
            O[1] = MFMA32(vf[1], pf0, O[1]); DF_EXP2(10); DF_FENCE;
            O[2] = MFMA32(vf[2], pf0, O[2]); DF_EXP2(12); DF_FENCE;
            O[3] = MFMA32(vf[3], pf0, O[3]); DF_EXP2(14); DF_FENCE;
            const bf16x8 pf1 = pack8(s, 1);
            O[0] = MFMA32(vf[4], pf1, O[0]); O[1] = MFMA32(vf[5], pf1, O[1]); O[2] = MFMA32(vf[6], pf1, O[2]); O[3] = MFMA32(vf[7], pf1, O[3]);
            lsum += rs0 + rs1;
            s = sn;
        }
        asm volatile("s_waitcnt vmcnt(0)" ::: "memory");
        __syncthreads();
        const int tmp = kc; kc = kn; kn = kw; kw = tmp;
    }
    const float lt = lsum + __shfl_xor(lsum, 32), inv = 1.0f / lt;
#pragma unroll
    for (int db = 0; db < 4; ++db) O[db] *= inv;
}
#undef DF_EXP2
#undef DF_FENCE
DI void diffattn_item(const Params& p, int l, int item, LAS unsigned char* lds) {
    int tid = tidx(); asm volatile("" : "+v"(tid)); const int wave = __builtin_amdgcn_readfirstlane(tid >> 6), lane = tid & 63, r = lane & 31, hh = lane >> 5;
    const int qt = item >> 3, h = item & 7, q0w = qt * 256 + wave * 32;
    LAS float* btab = (LAS float*)(lds + LDS_MAIN);
    const float* bias = (const float*)(p.ws + WS_BIAS) + (24 + h) * 2049;
    for (int i = tid; i < 2049; i += NTHR) btab[i] = bias[i];
    const float* dl = p.in[I_DLAM] + l * 256;
    float d01 = 0.f, d23 = 0.f;
    for (int i = 0; i < 64; ++i) { d01 += dl[i] * dl[64 + i]; d23 += dl[128 + i] * dl[192 + i]; }
    const float lam_init = 0.8f - 0.6f * expf(-0.3f * (float)l);
    const float lam = expf(d01) - expf(d23) + lam_init;
    const bf16_t* proj = (const bf16_t*)(p.ws + WS_PROJ); const bf16_t* vtc = (const bf16_t*)(p.ws + WS_VTC);
    f32x16 O0[4];
    const int q = q0w + r;
    float* ctmp = (float*)(p.ws + WS_CTMP) + (size_t)q * 1024 + h * 128 + 4 * hh;
    diff_flash2(proj, vtc, h, 0, q0w, lds, btab, O0);
#pragma unroll
    for (int db = 0; db < 4; ++db)
#pragma unroll
        for (int i4 = 0; i4 < 4; ++i4) { f32x4 o = {O0[db][4 * i4], O0[db][4 * i4 + 1], O0[db][4 * i4 + 2], O0[db][4 * i4 + 3]}; *(f32x4*)(ctmp + 32 * db + 8 * i4) = o; }
    diff_flash2(proj, vtc, h, 1, q0w, lds, btab, O0);
    float ss = 0.f;
#pragma unroll
    for (int db = 0; db < 4; ++db)
#pragma unroll
        for (int i4 = 0; i4 < 4; ++i4) { const f32x4 o0 = *(const f32x4*)(ctmp + 32 * db + 8 * i4);
#pragma unroll
            for (int e = 0; e < 4; ++e) { const float o = o0[e] - lam * O0[db][4 * i4 + e]; O0[db][4 * i4 + e] = o; ss += o * o; } }
    ss += __shfl_xor(ss, 32);
    const float rn = rsqrtf(ss * (1.0f / 128.0f) + 1e-6f) * (1.0f - lam_init);
    const float* dg = p.in[I_DG] + l * 128;
    bf16_t* cout = (bf16_t*)(p.ws + WS_BR) + (size_t)2 * S * 1024;
#pragma unroll
    for (int db = 0; db < 4; ++db)
#pragma unroll
        for (int i4 = 0; i4 < 4; ++i4) {
            const int d0 = 32 * db + 8 * i4 + 4 * hh;
            const f32x4 g4 = *(const f32x4*)(dg + d0);
            const u32x2 gt = *(const u32x2*)(proj + PIDX(q, C_CGATE + h * 128 + d0));
            const float y0 = O0[db][4 * i4 + 0] * rn * g4[0] * silu_f(bflo(gt[0])), y1 = O0[db][4 * i4 + 1] * rn * g4[1] * silu_f(bfhi(gt[0]));
            const float y2 = O0[db][4 * i4 + 2] * rn * g4[2] * silu_f(bflo(gt[1])), y3 = O0[db][4 * i4 + 3] * rn * g4[3] * silu_f(bfhi(gt[1]));
            u32x2 o = {pk2(y0, y1), pk2(y2, y3)};
            *(u32x2*)(cout + (size_t)q * 1024 + h * 128 + d0) = o;
        }
    __syncthreads();
}

DI void mixA_wave_item(const Params& p, int wi, int lane, const LAS float* tb) {
    asm volatile("" : "+v"(lane));
    const int g = wi >> 11, rem = wi & 2047, h = rem >> 8, qb = rem & 255;
    const int sh = 2 * g, n = S >> sh, nbq = 256 >> sh, res = qb / nbq, m0 = (qb % nbq) * 32;
    const int r = lane & 31, hh = lane >> 5;
    const bf16_t* proj = (const bf16_t*)(p.ws + WS_PROJ);
    const int qpos = ((m0 + r) << sh) + res;
    bf16x8 qf[8];
    { const bf16_t* qp = proj + PIDX(qpos, g * 3072 + h * 128 + 8 * hh);
#pragma unroll
      for (int ks = 0; ks < 8; ++ks) qf[ks] = *(const bf16x8*)(qp + 16 * ks); }
    f32x16 O[4];
#pragma unroll
    for (int db = 0; db < 4; ++db)
#pragma unroll
        for (int i = 0; i < 16; ++i) O[db][i] = 0.f;
    float m = -1e30f, lsum = 0.f;
    const float cs = 0.08838834764831845f * LOG2E;
    const LAS float* tbl = tb + 31 - r + 4 * hh;
    const bf16_t* vt = (const bf16_t*)(p.ws + WS_VTA) + (size_t)((g * 8 + h) * 128) * S + res * n;
    bf16x8 kf[8];
    { const int mk0r = m0 - 64; const int mk0 = (mk0r >= 0 && mk0r < n) ? mk0r : m0;
      const bf16_t* kp = proj + PIDX(((mk0 + r) << sh) + res, g * 3072 + 1024 + h * 128 + 8 * hh);
#pragma unroll
      for (int ks = 0; ks < 8; ++ks) kf[ks] = *(const bf16x8*)(kp + 16 * ks); }
#pragma unroll 1
    for (int kb = 0; kb < 5; ++kb) {
        const int mk0r = m0 - 64 + 32 * kb;
        const bool blk_ok = (mk0r >= 0) && (mk0r < n);
        const int mk0 = blk_ok ? mk0r : m0;
        bf16x8 vfr[2][4];
#pragma unroll
        for (int sidx = 0; sidx < 2; ++sidx)
#pragma unroll
            for (int db = 0; db < 4; ++db) {
                const bf16_t* vp = vt + (size_t)(32 * db + r) * S + mk0 + 16 * sidx + 4 * hh;
                const s16x4 lo = *(const s16x4*)vp, hi = *(const s16x4*)(vp + 8);
                vfr[sidx][db] = __builtin_shufflevector(lo, hi, 0, 1, 2, 3, 4, 5, 6, 7);
            }
        __builtin_amdgcn_sched_barrier(0);
        f32x16 s;
#pragma unroll
        for (int i = 0; i < 16; ++i) s[i] = 0.f;
#pragma unroll
        for (int ks = 0; ks < 8; ++ks) s = MFMA32(kf[ks], qf[ks], s);
        if (kb < 4) {
            const int nk0r = m0 - 64 + 32 * (kb + 1); const int nk0 = (nk0r >= 0 && nk0r < n) ? nk0r : m0;
            const bf16_t* kp = proj + PIDX(((nk0 + r) << sh) + res, g * 3072 + 1024 + h * 128 + 8 * hh);
#pragma unroll
            for (int ks = 0; ks < 8; ++ks) kf[ks] = *(const bf16x8*)(kp + 16 * ks);
        }
        __builtin_amdgcn_sched_barrier(0);
        float mx = -INFINITY;
#pragma unroll
        for (int i = 0; i < 16; ++i) { const int rel = mk0r + crow(i, hh) - (m0 + r); const bool valid = blk_ok && (rel <= 64) && (rel >= -64);
            const float bv = tbl[32 * kb + (i & 3) + 8 * (i >> 2)];
            const float v = valid ? (s[i] * cs + bv) : -INFINITY; s[i] = v; mx = fmaxf(mx, v); }
        mx = fmaxf(mx, __shfl_xor(mx, 32));
        const float mnew = fmaxf(m, mx), alpha = __builtin_amdgcn_exp2f(m - mnew);
        m = mnew;
        float rs = 0.f;
#pragma unroll
        for (int i = 0; i < 16; ++i) { s[i] = __builtin_amdgcn_exp2f(s[i] - mnew); rs += s[i]; }
        lsum = lsum * alpha + rs;
#pragma unroll
        for (int db = 0; db < 4; ++db) O[db] *= alpha;
#pragma unroll
        for (int sidx = 0; sidx < 2; ++sidx) {
            const bf16x8 pf = pack8(s, sidx);
#pragma unroll
            for (int db = 0; db < 4; ++db) O[db] = MFMA32(vfr[sidx][db], pf, O[db]);
        }
    }
    const float lt = lsum + __shfl_xor(lsum, 32), inv = 1.0f / lt;
    float* oa = (float*)(p.ws + WS_OA) + ((size_t)g * S + qpos) * 1024 + h * 128;
#pragma unroll
    for (int db = 0; db < 4; ++db)
#pragma unroll
        for (int i4 = 0; i4 < 4; ++i4) {
            const int d0 = 32 * db + 8 * i4 + 4 * hh;
            f32x4 o = {O[db][4 * i4] * inv, O[db][4 * i4 + 1] * inv, O[db][4 * i4 + 2] * inv, O[db][4 * i4 + 3] * inv};
            *(f32x4*)(oa + d0) = o;
        }
    if (hh == 0) ((float*)(p.ws + WS_LSEA))[((size_t)g * S + qpos) * 8 + h] = m + __log2f(lt);
}

DI void phase_post(const Params& p, LAS unsigned char* lds) {
    const int tid = tidx();
    const bf16_t* proj = (const bf16_t*)(p.ws + WS_PROJ);
    bf16_t* aout = (bf16_t*)(p.ws + WS_BR); bf16_t* bout = aout + (size_t)S * 1024;
    const float* oa = (const float*)(p.ws + WS_OA); const float* lse = (const float*)(p.ws + WS_LSEA);
    for (int idx0 = blockIdx.x * NTHR + tid; idx0 < S * 256; idx0 += 4 * gridDim.x * NTHR) {
        float l0[4], l1[4], l2[4]; f32x4 o0[4], o1[4], o2[4]; u32x2 gt[4];
#pragma unroll
        for (int u = 0; u < 4; ++u) { const int idx = idx0 + u * gridDim.x * NTHR; const int pos = idx >> 8, c4 = idx & 255, h = c4 >> 5, col = c4 * 4;
            l0[u] = lse[((size_t)0 * S + pos) * 8 + h]; l1[u] = lse[((size_t)1 * S + pos) * 8 + h]; l2[u] = lse[((size_t)2 * S + pos) * 8 + h];
            o0[u] = *(const f32x4*)(oa + ((size_t)0 * S + pos) * 1024 + col); o1[u] = *(const f32x4*)(oa + ((size_t)1 * S + pos) * 1024 + col); o2[u] = *(const f32x4*)(oa + ((size_t)2 * S + pos) * 1024 + col);
            gt[u] = *(const u32x2*)(proj + PIDX(pos, C_AGATE + col)); }
#pragma unroll
        for (int u = 0; u < 4; ++u) { const int idx = idx0 + u * gridDim.x * NTHR; const int pos = idx >> 8, c4 = idx & 255, col = c4 * 4;
            const float mx = fmaxf(l0[u], fmaxf(l1[u], l2[u]));
            const float w0 = __builtin_amdgcn_exp2f(l0[u] - mx), w1 = __builtin_amdgcn_exp2f(l1[u] - mx), w2 = __builtin_amdgcn_exp2f(l2[u] - mx);
            const float inv = __builtin_amdgcn_rcpf(w0 + w1 + w2);
            const f32x4 o = (o0[u] * w0 + o1[u] * w1 + o2[u] * w2) * inv;
            u32x2 ov = {pk2(o[0] * silu_f(bflo(gt[u][0])), o[1] * silu_f(bfhi(gt[u][0]))), pk2(o[2] * silu_f(bflo(gt[u][1])), o[3] * silu_f(bfhi(gt[u][1])))};
            *(u32x2*)(aout + (size_t)pos * 1024 + col) = ov; }
    }
    LAS float* tile = (LAS float*)lds;
    const float* z2t = (const float*)(p.ws + WS_Z2T);
    for (int it0 = blockIdx.x * 4; it0 < 128 * 16; it0 += gridDim.x * 4) {
        __syncthreads();
        f32x4 v[4][2];
#pragma unroll
        for (int u = 0; u < 4; ++u) { const int it = it0 + u, t0 = (it >> 4) * 64, c0 = (it & 15) * 64;
#pragma unroll
            for (int k = 0; k < 2; ++k) { const int e = tid + NTHR * k; const int ci = e >> 4, t4 = (e & 15) * 4; v[u][k] = *(const f32x4*)(z2t + (size_t)(c0 + ci) * S + t0 + t4); } }
#pragma unroll
        for (int u = 0; u < 4; ++u)
#pragma unroll
            for (int k = 0; k < 2; ++k) { const int e = tid + NTHR * k; const int ci = e >> 4, t4 = (e & 15) * 4; LAS float* d = tile + u * 4160 + ci * 65 + t4;
                d[0] = v[u][k][0]; d[1] = v[u][k][1]; d[2] = v[u][k][2]; d[3] = v[u][k][3]; }
        __syncthreads();
        u32x2 gt[4][2];
#pragma unroll
        for (int u = 0; u < 4; ++u) { const int it = it0 + u, t0 = (it >> 4) * 64, c0 = (it & 15) * 64;
#pragma unroll
            for (int k = 0; k < 2; ++k) { const int e = tid + NTHR * k; const int ti = e >> 4, cc = (e & 15) * 4; gt[u][k] = *(const u32x2*)(proj + PIDX(t0 + ti, C_BGATE + c0 + cc)); } }
#pragma unroll
        for (int u = 0; u < 4; ++u) { const int it = it0 + u, t0 = (it >> 4) * 64, c0 = (it & 15) * 64;
#pragma unroll
            for (int k = 0; k < 2; ++k) { const int e = tid + NTHR * k; const int ti = e >> 4, cc = (e & 15) * 4; const LAS float* sp = tile + u * 4160 + cc * 65 + ti;
                const float y0 = sp[0] * silu_f(bflo(gt[u][k][0])), y1 = sp[65] * silu_f(bfhi(gt[u][k][0]));
                const float y2 = sp[130] * silu_f(bflo(gt[u][k][1])), y3 = sp[195] * silu_f(bfhi(gt[u][k][1]));
                u32x2 ov = {pk2(y0, y1), pk2(y2, y3)};
                *(u32x2*)(bout + (size_t)(t0 + ti) * 1024 + c0 + cc) = ov; } }
    }
    __syncthreads();
}

#ifndef REP_GEMMIN
#define REP_GEMMIN 1
#endif
#ifndef REP_DIFF
#define REP_DIFF 1
#endif
#ifndef REP_HYENA
#define REP_HYENA 1
#endif
#ifndef REP_MIXA
#define REP_MIXA 1
#endif
#ifndef REP_PRO
#define REP_PRO 1
#endif
#ifndef REP_SPEC
#define REP_SPEC 1
#endif
#ifndef REP_MISC
#define REP_MISC 1
#endif
#ifndef REP_PROJ
#define REP_PROJ 1
#endif
constexpr int NPH = 3 + 6 * DEPTH + 1;
typedef const Params __attribute__((address_space(4)))* ParamsK;
DI Params ldp(ParamsK pc) {
    asm volatile("" : "+s"(pc));
    Params q;
#pragma unroll
    for (int i = 0; i < 18; ++i) q.in[i] = pc->in[i];
    q.out = pc->out; q.ws = pc->ws; q.ph_lo = pc->ph_lo; q.ph_hi = pc->ph_hi;
    return q;
}
DI void run_phase(ParamsK pc, int ph, LAS unsigned char* lds) {
    if (ph == 0) { for (int rep = 0; rep < REP_PRO; ++rep) { const Params p = ldp(pc); phase_prologue(p, lds); __syncthreads(); } return; }
    if (ph == 1) { const Params p = ldp(pc); phase_tgen(p); return; }
    if (ph == 2) { for (int rep = 0; rep < REP_SPEC; ++rep) { const Params p = ldp(pc); for (int it = blockIdx.x; it < DEPTH * 2 * 512; it += gridDim.x) spectra_item(p, it, lds); } return; }
    if (ph == NPH - 1) { const Params p = ldp(pc); phase_rmsnorm((const float*)(p.ws + WS_X), p.in[I_FINALG], nullptr, p.out); return; }
    const int l = (ph - 3) / 6, sp = (ph - 3) % 6;
    if (sp == 0) { for (int rep = 0; rep < REP_MISC; ++rep) { const Params p = ldp(pc); phase_rmsnorm((l == 0) ? p.in[I_X] : (const float*)(p.ws + WS_X), p.in[I_NORMG] + l * D, (bf16_t*)(p.ws + WS_H), nullptr); } return; }
    if (sp == 1) {
        const Params p = ldp(pc);
        pg8::Gemm g{(const bf16_t*)(p.ws + WS_H), (const bf16_t*)(p.ws + WS_WIN) + (size_t)l * NIN * D, S, NIN, D};
        pg8::StaticOrder so; so.init(S, NIN, gridDim.x, blockIdx.x);
        EpiIn e{(bf16_t*)(p.ws + WS_PROJ), (bf16_t*)(p.ws + WS_VTA), (bf16_t*)(p.ws + WS_VTC), (float*)(p.ws + WS_BINT), lds + 131072};
#pragma unroll 1
        for (int rep = 0; rep < REP_GEMMIN; ++rep) { pg8::gemm_phase(lds, g, so, e); __syncthreads(); }
        return;
    }
    if (sp == 2) {
#pragma unroll 1
        for (int it = blockIdx.x; it < 256 + 512 + 768; it += gridDim.x) {
            int l2 = l; asm volatile("" : "+s"(l2));
            const Params p = ldp(pc);
            if (it < 256) { for (int rep = 0; rep < REP_DIFF; ++rep) diffattn_item(p, l2, it, lds); }
            else if (it < 768) { for (int rep = 0; rep < REP_HYENA; ++rep) hyena_item(p, l2, it - 256, lds); }
            else {
                const int tid2 = tidx(), wi0 = (it - 768) * NWAVES, g = wi0 >> 11, h = (wi0 & 2047) >> 8;
                LAS float* tb = (LAS float*)lds;
                __syncthreads();
                if (tid2 < 192) { const int rel = tid2 - 95; float v = 0.f;
                    if (rel >= -64 && rel <= 64) v = ((const float*)(p.ws + WS_BIAS))[(g * 8 + h) * 2049 + min(max(rel << (2 * g), -1024), 1024) + 1024];
                    tb[tid2] = v; }
                __syncthreads();
                for (int rep = 0; rep < REP_MIXA; ++rep) mixA_wave_item(p, wi0 + (tid2 >> 6), tid2 & 63, tb);
            }
        }
        return;
    }
    if (sp == 3) { for (int rep = 0; rep < REP_MISC; ++rep) { const Params p = ldp(pc); phase_post(p, lds); } return; }
    if (sp == 4) {
#pragma unroll 1
        for (int rep = 0; rep < REP_PROJ; ++rep) {
            const Params p = ldp(pc);
            pg8::Gemm g{(const bf16_t*)(p.ws + WS_BR), (const bf16_t*)(p.ws + WS_WPR) + (size_t)(l * 3) * D * 1024, 3 * S, 3 * D, 1024};
            ProjOrder po; po.so.init(S, D, gridDim.x, blockIdx.x);
            EpiProj e{(const bf16_t*)(p.ws + WS_PROJ), p.in[I_MERGEB] + (size_t)l * 3 * D, (float*)(p.ws + WS_YF), (bf16_t*)(p.ws + WS_YB)};
            pg8::gemm_phase(lds, g, po, e);
            __syncthreads();
        }
        return;
    }
    {
        const Params p = ldp(pc);
        pg8::Gemm g{(const bf16_t*)(p.ws + WS_YB), (const bf16_t*)(p.ws + WS_WOUT) + (size_t)l * D * D, S, D, D};
        pg8::StaticOrder so; so.init(S, D, gridDim.x, blockIdx.x);
        EpiOut e{(l == 0) ? p.in[I_X] : (const float*)(p.ws + WS_X), (float*)(p.ws + WS_X)};
#pragma unroll 1
        for (int rep = 0; rep < ((l == 0) ? REP_MISC : 1); ++rep) { pg8::gemm_phase(lds, g, so, e); __syncthreads(); }
    }
}


#define XB_TMO      128
#define XB_XCNT(j)  (256  + 64 * (j))
#define XB_XSUB(j)  (1280 + 64 * (j))
#define XB_XGEN(j)  (2304 + 64 * (j))
#define XB_TOP      3328
#define XB_TOPGEN   3392
#define XCD_BAR_WORDS 3456
#define XB_SPIN_CAP (1u << 18)
DI unsigned xb_ld(unsigned* p)              { return __hip_atomic_load(p, __ATOMIC_RELAXED, __HIP_MEMORY_SCOPE_AGENT); }
DI unsigned xb_add(unsigned* p, unsigned v) { return __hip_atomic_fetch_add(p, v, __ATOMIC_RELAXED, __HIP_MEMORY_SCOPE_AGENT); }
DI unsigned xb_xcc_id() { return (unsigned)__builtin_amdgcn_s_getreg((3 << 11) | 20) & 0xFu; }
#define XB_SPIN(cond, bar) do { unsigned _sp = 0; while (cond) { __builtin_amdgcn_s_sleep(1); \
    if ((++_sp & 255u) == 0u) { if (xb_ld(&(bar)[XB_TMO])) break; if (_sp > XB_SPIN_CAP) { atomicAdd(&(bar)[XB_TMO], 1u); break; } } } } while (0)
struct XcdBarrier { unsigned* bar; unsigned x; volatile LAS unsigned* st; };
DI XcdBarrier xcd_barrier_post(unsigned* bar, volatile LAS unsigned* st) {
    XcdBarrier b; b.bar = bar; b.x = xb_xcc_id(); b.st = st;
    if (threadIdx.x == 0) (void)xb_add(&bar[XB_XCNT(b.x)], 1u);
    return b;
}
DI void xcd_barrier_complete(unsigned* bar, unsigned x, unsigned& nloc, unsigned& nx) {
    const unsigned G = gridDim.x * gridDim.y * gridDim.z;
    unsigned sum, cnt, mine, sp = 0u;
    for (;;) {
        sum = 0u; cnt = 0u; mine = 0u;
#pragma unroll
        for (unsigned j = 0; j < 16; ++j) { const unsigned c = xb_ld(&bar[XB_XCNT(j)]); sum += c; cnt += (c > 0u) ? 1u : 0u; mine = (j == x) ? c : mine; }
        if (sum == G) break;
        __builtin_amdgcn_s_sleep(1);
        if ((++sp & 255u) == 0u) { if (xb_ld(&bar[XB_TMO])) break; if (sp > XB_SPIN_CAP) { atomicAdd(&bar[XB_TMO], 1u); break; } }
    }
    nloc = mine > 0u ? mine : 1u; nx = cnt > 0u ? cnt : 1u;
}
DI void xcd_barrier(const XcdBarrier& b) {
    asm volatile("s_waitcnt vmcnt(0)" ::: "memory");
    __syncthreads();
    if (threadIdx.x == 0) {
        unsigned* bar = b.bar;
        __builtin_amdgcn_s_waitcnt(0);
        unsigned nloc = b.st[0], nx = b.st[1];
        if (nloc == 0u) { xcd_barrier_complete(bar, b.x, nloc, nx); b.st[0] = nloc; b.st[1] = nx; }
        const unsigned old = xb_add(&bar[XB_XSUB(b.x)], 1u);
        const unsigned gen = old / nloc;
        if (old + 1u == (gen + 1u) * nloc) {
            __builtin_amdgcn_fence(__ATOMIC_RELEASE, "agent");
            asm volatile("s_waitcnt vmcnt(0)" ::: "memory");
            const unsigned og = xb_add(&bar[XB_TOP], 1u);
            const unsigned tg = og / nx;
            if (og + 1u == (tg + 1u) * nx) xb_add(&bar[XB_TOPGEN], 1u);
            else XB_SPIN(xb_ld(&bar[XB_TOPGEN]) == tg, bar);
            __builtin_amdgcn_fence(__ATOMIC_ACQUIRE, "agent");
            xb_add(&bar[XB_XGEN(b.x)], 1u);
            asm volatile("s_waitcnt vmcnt(0)" ::: "memory");
        } else {
            XB_SPIN(xb_ld(&bar[XB_XGEN(b.x)]) == gen, bar);
            __builtin_amdgcn_fence(__ATOMIC_ACQUIRE, "agent");
            asm volatile("s_waitcnt vmcnt(0)" ::: "memory");
        }
    }
    __syncthreads();
}

__global__ void __launch_bounds__(512, 2) mega_kernel(Params p) {
#if defined(__HIP_DEVICE_COMPILE__)
    extern __shared__ __attribute__((aligned(16))) unsigned char shm[];
    LAS unsigned char* lds = (LAS unsigned char*)shm;
    cg::grid_group grid = cg::this_grid();
    const int ph_lo = p.ph_lo, ph_hi = p.ph_hi;
    volatile LAS unsigned* st = (volatile LAS unsigned*)(lds + LDS_BYTES - 16);
    if (threadIdx.x == 0) { st[0] = 0u; st[1] = 0u; }
    __syncthreads();
    const XcdBarrier xb = xcd_barrier_post((unsigned*)(p.ws + WS_BAR), st);
#pragma unroll 1
    for (int ph = ph_lo; ph < ph_hi; ++ph) {
        ParamsK pc = (ParamsK)__builtin_amdgcn_kernarg_segment_ptr();
        run_phase(pc, ph, lds);
        if (ph + 1 < ph_hi) { if (ph == ph_lo) grid.sync(); else xcd_barrier(xb); }
    }
#endif
}

#ifndef N_LAUNCH_MODE
#define N_LAUNCH_MODE 1
#endif
extern "C" void kernel_launch(void* const* d_in, const int* in_sizes, int n_in, void* d_out, int out_size, void* d_ws, size_t ws_size, hipStream_t stream) {
    static int grid = 0;
    if (grid == 0) {
        int dev = 0, cus = 0;
        if (hipGetDevice(&dev) != hipSuccess || hipDeviceGetAttribute(&cus, hipDeviceAttributeMultiprocessorCount, dev) != hipSuccess) { fprintf(stderr, "kernel_launch: device query failed\n"); grid = -1; return; }
        if (hipFuncSetAttribute((const void*)mega_kernel, hipFuncAttributeMaxDynamicSharedMemorySize, LDS_BYTES) != hipSuccess) { fprintf(stderr, "kernel_launch: hipFuncSetAttribute failed\n"); grid = -1; return; }
        int per_cu = 0;
        if (hipOccupancyMaxActiveBlocksPerMultiprocessor(&per_cu, (const void*)mega_kernel, NTHR, LDS_BYTES) != hipSuccess || per_cu < 1) { fprintf(stderr, "kernel_launch: occupancy query says %d\n", per_cu); (void)hipGetLastError(); }
        if (n_in != 18 || ws_size < WS_END) { fprintf(stderr, "kernel_launch: n_in %d ws %zu (need %zu)\n", n_in, ws_size, (size_t)WS_END); grid = -1; return; }
        grid = cus;
    }
    if (grid < 0) return;
    Params p{};
    for (int i = 0; i < 18; ++i) p.in[i] = (const float*)d_in[i];
    p.out = (float*)d_out; p.ws = (unsigned char*)d_ws;
    if (hipMemsetAsync((unsigned char*)d_ws + WS_BAR, 0, 16384, stream) != hipSuccess) { fprintf(stderr, "kernel_launch: memset of barrier words failed\n"); return; }
#if N_LAUNCH_MODE == 1
    p.ph_lo = 0; p.ph_hi = NPH;
    void* args[] = {&p};
    hipError_t e = hipLaunchCooperativeKernel((const void*)mega_kernel, dim3(grid), dim3(NTHR), args, LDS_BYTES, stream);
    if (e != hipSuccess) fprintf(stderr, "cooperative launch failed: %s (grid %d)\n", hipGetErrorString(e), grid);
#else
    for (int ph = 0; ph < NPH; ++ph) {
        p.ph_lo = ph; p.ph_hi = ph + 1;
        hipLaunchKernelGGL(mega_kernel, dim3(grid), dim3(NTHR), LDS_BYTES, stream, p);
    }
#endif
}
```

```cpp
#include <hip/hip_runtime.h>
#include <hip/hip_cooperative_groups.h>
#include <cstdio>
namespace cg = cooperative_groups;
#define DI __device__ __forceinline__
#define LAS __attribute__((address_space(3)))
typedef unsigned short bf16_t;
typedef short bf16x8 __attribute__((ext_vector_type(8)));
typedef short s16x4 __attribute__((ext_vector_type(4)));
typedef float f32x4 __attribute__((ext_vector_type(4)));
typedef float f32x16 __attribute__((ext_vector_type(16)));
typedef float f32x2 __attribute__((ext_vector_type(2)));
typedef float cf __attribute__((ext_vector_type(2)));
typedef __bf16 bf16x2n __attribute__((ext_vector_type(2)));
typedef unsigned u32x2 __attribute__((ext_vector_type(2)));
typedef unsigned u32x4 __attribute__((ext_vector_type(4)));

DI unsigned pk2(float lo, float hi) { f32x2 v = {lo, hi}; return __builtin_bit_cast(unsigned, __builtin_convertvector(v, bf16x2n)); }
DI float bflo(unsigned u) { return __uint_as_float(u << 16); }
DI float bfhi(unsigned u) { return __uint_as_float(u & 0xffff0000u); }
DI float silu_f(float x) { return x * __builtin_amdgcn_rcpf(1.0f + __expf(-x)); }
DI float sigm_f(float x) { return __builtin_amdgcn_rcpf(1.0f + __expf(-x)); }

DI int tidx() { int t = threadIdx.x; asm volatile("" : "+v"(t)); return t; }

constexpr int S = 8192, D = 2048, NIN = 24576, DEPTH = 4;
constexpr int C_AGATE = 9216, C_BIN = 10240, C_BGATE = 13312, C_CQKV = 14336, C_CGATE = 17408, C_MERGE = 18432;
constexpr float LOG2E = 1.4426950408889634f;
constexpr int NTHR = 512, NWAVES = 8;
constexpr int LDS_MAIN = 143360, LDS_AUX = 16384, LDS_BYTES = LDS_MAIN + LDS_AUX;

constexpr size_t WS_WIN  = 0;
constexpr size_t WS_WPR  = WS_WIN  + (size_t)DEPTH * NIN * D * 2;
constexpr size_t WS_WOUT = WS_WPR  + (size_t)DEPTH * 3 * D * 1024 * 2;
constexpr size_t WS_SPEC = WS_WOUT + (size_t)DEPTH * D * D * 2;
constexpr size_t WS_HID2 = WS_SPEC + (size_t)DEPTH * 2 * 512 * 8208 * 16;
constexpr size_t WS_BIAS = WS_HID2 + (size_t)DEPTH * S * 64 * 4;
constexpr size_t WS_X    = WS_BIAS + 524288;
constexpr size_t WS_H    = WS_X    + (size_t)S * D * 4;
constexpr size_t WS_PROJ = WS_H    + (size_t)S * D * 2;
constexpr size_t WS_BINT = WS_PROJ + (size_t)S * NIN * 2;
constexpr size_t WS_VTA  = WS_BINT + (size_t)3072 * S * 4;
constexpr size_t WS_VTC  = WS_VTA  + (size_t)3 * 1024 * S * 2;
constexpr size_t WS_OA   = WS_VTC  + (size_t)1024 * S * 2;
constexpr size_t WS_LSEA = WS_OA   + (size_t)3 * S * 1024 * 4;
constexpr size_t WS_Z2T  = WS_LSEA + (size_t)3 * S * 8 * 4;
constexpr size_t WS_BR   = WS_Z2T  + (size_t)1024 * S * 4;
constexpr size_t WS_YF   = WS_BR   + (size_t)3 * S * 1024 * 2;
constexpr size_t WS_YB   = WS_YF   + (size_t)S * D * 4;
constexpr size_t WS_CTMP = WS_YB   + (size_t)S * D * 2;
constexpr size_t WS_BAR  = WS_CTMP + (size_t)S * 1024 * 4;
constexpr size_t WS_TT   = WS_BAR + 16384;
constexpr size_t WS_END  = WS_TT + (size_t)DEPTH * 4096 * S * 4;

DI size_t PIDX(int row, int col) { return ((size_t)(col >> 8) * S + row) * 256 + (col & 255); }

struct Params {
    const float* in[18];
    float* out;
    unsigned char* ws;
    int ph_lo, ph_hi;
};
enum { I_X = 0, I_NORMG, I_FINALG, I_WIN, I_MERGEB, I_RELB, I_HYCONV, I_HYW1, I_HYB1, I_HYFREQ, I_HYW2, I_HYB2, I_HYW3, I_HYSKIP, I_DLAM, I_DG, I_WPROJ, I_WOUT };

namespace pg8 {
constexpr int BM = 256, BK = 64, HALF = 128, HTB = HALF * BK * 2, NXCD = 8, WGM = 8;
DI int lds_byte(int r, int c) { const int st = (r >> 4) * 2 + (c >> 5), rr = r & 15, cc = c & 31, ob = rr * 64 + cc * 2; return st * 1024 + (ob ^ (((ob >> 9) & 1) << 5)); }
DI void stage_rc(int b, int& R, int& C) { const int st = b / 1024, sb = b % 1024, swz = sb ^ (((sb >> 9) & 1) << 5); R = (st >> 1) * 16 + swz / 64; C = (st & 1) * 32 + (swz % 64) / 2; }
DI int perm32(int rho) { const int n = rho >> 4, i = rho & 15; return 8 * (i >> 2) + 4 * n + (i & 3); }
struct Unit { int pm, pn; };
struct Gemm { const bf16_t* A; const bf16_t* Bt; int M, N, K; };
struct StaticOrder {
    int nM, nN, nwg, G, c;
    DI void init(int M, int N, int G_, int c_) { nM = M / BM; nN = N / BM; nwg = nM * nN; G = G_; c = c_; }
    DI bool next(int i, Unit& u) const {
        const long L = (long)i * G + c; if (L >= nwg) return false;
        int wgid = (int)L; { const int q = nwg / NXCD, r = nwg % NXCD, xcd = wgid % NXCD, off = wgid / NXCD; wgid = (xcd < r ? xcd * (q + 1) : r * (q + 1) + (xcd - r) * q) + off; }
        const int nig = WGM * nN, gid = wgid / nig, fm = gid * WGM, gsz = (nM - fm) < WGM ? (nM - fm) : WGM;
        u.pm = fm + ((wgid % nig) % gsz); u.pn = (wgid % nig) / gsz; return true;
    }
};
template <class Epi, class Sched>
DI void gemm_phase(LAS unsigned char* lds, const Gemm g, const Sched& S, const Epi& E) {
    const int tid = tidx(), wid = __builtin_amdgcn_readfirstlane(tid >> 6), lane = tid & 63, wr = wid >> 2, wc = wid & 3, fr = lane & 15, fq = lane >> 4;
    const int K = g.K, nt = K / BK;
    unsigned voffA[2], voffB[2];
#pragma unroll
    for (int i = 0; i < 2; ++i) { int R, C; stage_rc(tid * 16 + i * 8192, R, C); const int Rb = Epi::PERM ? ((R & ~31) + perm32(R & 31)) : R; voffA[i] = (unsigned)(R * K + C) * 2u; voffB[i] = (unsigned)(Rb * K + C) * 2u; }
    const size_t kstep = (size_t)(BK * 2);
    const size_t hstep = (size_t)HALF * K * 2;
    const size_t tstep = 2 * hstep;
    const unsigned ldsw = (unsigned)wid * 1024u;
    const int aoff = lds_byte(wr * 64 + fr, fq * 8), boff = lds_byte(wc * 32 + fr, fq * 8);
#define PG8_SA(b, h) (((b) * 2 + (h)) * HTB)
#define PG8_SB(b, h) ((4 + (b) * 2 + (h)) * HTB)
#define PG8_STAGE(bufoff, gbase, voff) do { _Pragma("unroll") for (int _i = 0; _i < 2; ++_i) \
        __builtin_amdgcn_global_load_lds((const unsigned*)((const char*)(gbase) + (voff)[_i]), (LAS unsigned*)(lds + (bufoff) + ldsw + _i * 8192), 16, 0, 0); } while (0)
#define PG8_LDA(dst, b, h) do { _Pragma("unroll") for (int m = 0; m < 4; ++m) _Pragma("unroll") for (int k = 0; k < 2; ++k) dst[m][k] = *(const LAS bf16x8*)(lds + PG8_SA(b, h) + aoff + m * 2048 + k * 1024); } while (0)
#define PG8_LDB(dst, b, h) do { _Pragma("unroll") for (int n = 0; n < 2; ++n) _Pragma("unroll") for (int k = 0; k < 2; ++k) dst[n][k] = *(const LAS bf16x8*)(lds + PG8_SB(b, h) + boff + n * 2048 + k * 1024); } while (0)
#define PG8_MMA(ai, bj, At, Bt) do { __builtin_amdgcn_s_setprio(1); _Pragma("unroll") for (int m = 0; m < 4; ++m) _Pragma("unroll") for (int n = 0; n < 2; ++n) _Pragma("unroll") for (int k = 0; k < 2; ++k) \
        acc[ai][bj][m][n] = __builtin_amdgcn_mfma_f32_16x16x32_bf16(Bt[n][k], At[m][k], acc[ai][bj][m][n], 0, 0, 0); __builtin_amdgcn_s_setprio(0); } while (0)
#define PG8_WAIT_V(n) asm volatile("s_waitcnt vmcnt(" #n ")" ::: "memory")
#define PG8_WAIT_L(n) asm volatile("s_waitcnt lgkmcnt(" #n ")" ::: "memory")
#define PG8_BAR __builtin_amdgcn_s_barrier()
#define PG8_SCHED __builtin_amdgcn_sched_barrier(0)
    Unit cur, nxt; int ui = 0;
    if (!S.next(0, cur)) return;
    f32x4 acc[2][2][4][2];
#pragma unroll
    for (int a = 0; a < 2; ++a)
#pragma unroll
        for (int b = 0; b < 2; ++b)
#pragma unroll
            for (int m = 0; m < 4; ++m)
#pragma unroll
                for (int n = 0; n < 2; ++n) acc[a][b][m][n] = (f32x4){0.f, 0.f, 0.f, 0.f};
    bf16x8 At[4][2], B0[2][2], B1[2][2];
    const char* cA = (const char*)g.A + (size_t)cur.pm * tstep; const char* cB = (const char*)g.Bt + (size_t)cur.pn * tstep;
    PG8_STAGE(PG8_SB(0, 0), cB, voffB); PG8_STAGE(PG8_SA(0, 0), cA, voffA); PG8_STAGE(PG8_SB(0, 1), cB + hstep, voffB); PG8_STAGE(PG8_SA(0, 1), cA + hstep, voffA);
    if (wr == 1) PG8_BAR;
    PG8_WAIT_V(4); PG8_BAR;
    PG8_STAGE(PG8_SB(1, 0), cB + kstep, voffB); PG8_STAGE(PG8_SA(1, 0), cA + kstep, voffA); PG8_STAGE(PG8_SB(1, 1), cB + hstep + kstep, voffB);
    PG8_WAIT_V(6); PG8_BAR;
    for (;;) {
        const bool has_next = S.next(ui + 1, nxt);
        const char* nA = has_next ? (const char*)g.A + (size_t)nxt.pm * tstep : cA; const char* nB = has_next ? (const char*)g.Bt + (size_t)nxt.pn * tstep : cB;
        for (int t = 0; t < nt; t += 2) {
            const bool last = (t == nt - 2);
            const char* a1 = cA + (size_t)(t + 1) * kstep;
            const char* a2 = last ? nA : cA + (size_t)(t + 2) * kstep; const char* b2 = last ? nB : cB + (size_t)(t + 2) * kstep;
            const char* a3 = a2 + kstep; const char* b3 = b2 + kstep;
            PG8_LDB(B0, 0, 0); PG8_SCHED; PG8_LDA(At, 0, 0); PG8_STAGE(PG8_SA(1, 1), a1 + hstep, voffA);
            PG8_WAIT_L(8); PG8_BAR; PG8_WAIT_L(0); PG8_MMA(0, 0, At, B0); PG8_BAR; PG8_SCHED;
            PG8_LDB(B1, 0, 1); PG8_STAGE(PG8_SB(0, 0), b2, voffB);
            PG8_BAR; PG8_WAIT_L(0); PG8_MMA(0, 1, At, B1); PG8_BAR;
            PG8_LDA(At, 0, 1); PG8_STAGE(PG8_SA(0, 0), a2, voffA);
            PG8_BAR; PG8_WAIT_L(0); PG8_MMA(1, 0, At, B0); PG8_BAR; PG8_SCHED;
            PG8_STAGE(PG8_SB(0, 1), b2 + hstep, voffB);
            PG8_WAIT_V(6); PG8_BAR; PG8_MMA(1, 1, At, B1); PG8_BAR;
            PG8_LDB(B0, 1, 0); PG8_SCHED; PG8_LDA(At, 1, 0); PG8_STAGE(PG8_SA(0, 1), a2 + hstep, voffA);
            PG8_WAIT_L(8); PG8_BAR; PG8_WAIT_L(0); PG8_MMA(0, 0, At, B0); PG8_BAR; PG8_SCHED;
            PG8_LDB(B1, 1, 1); PG8_STAGE(PG8_SB(1, 0), b3, voffB);
            PG8_BAR; PG8_WAIT_L(0); PG8_MMA(0, 1, At, B1); PG8_BAR;
            PG8_LDA(At, 1, 1); PG8_STAGE(PG8_SA(1, 0), a3, voffA);
            PG8_BAR; PG8_WAIT_L(0); PG8_MMA(1, 0, At, B0); PG8_BAR; PG8_SCHED;
            PG8_STAGE(PG8_SB(1, 1), b3 + hstep, voffB);
            PG8_WAIT_V(6); PG8_BAR; PG8_MMA(1, 1, At, B1); PG8_BAR;
        }
        E(acc, cur, wr, wc, fr, fq);
        if (!has_next) break;
#pragma unroll
        for (int a = 0; a < 2; ++a)
#pragma unroll
            for (int b = 0; b < 2; ++b)
#pragma unroll
                for (int m = 0; m < 4; ++m)
#pragma unroll
                    for (int n = 0; n < 2; ++n) acc[a][b][m][n] = (f32x4){0.f, 0.f, 0.f, 0.f};
        cur = nxt; cA = nA; cB = nB; ++ui;
    }
    PG8_WAIT_V(0);
    if (wr == 0) PG8_BAR;
    PG8_BAR;
#undef PG8_SA
#undef PG8_SB
#undef PG8_STAGE
#undef PG8_LDA
#undef PG8_LDB
#undef PG8_MMA
#undef PG8_WAIT_V
#undef PG8_WAIT_L
#undef PG8_BAR
#undef PG8_SCHED
}
}

struct EpiIn {
    static constexpr bool PERM = true;
    bf16_t* proj; bf16_t* vta; bf16_t* vtc; float* bint; LAS unsigned char* tlds;
    DI void operator()(const f32x4 (&acc)[2][2][4][2], const pg8::Unit& u, int wr, int wc, int fr, int fq) const {
        const int colt = u.pn * 256;
        int kind = 0;
        if (colt < C_AGATE) { if ((colt % 3072) >= 2048) kind = 1; }
        else if (colt >= C_BIN && colt < C_BGATE) kind = 2;
        else if (colt >= C_CQKV + 2048 && colt < C_CGATE) kind = 3;
        const int row0 = u.pm * 256 + wr * 64 + fr, col0 = colt + wc * 32 + 8 * fq;
        if (kind == 0) {
#pragma unroll
            for (int ai = 0; ai < 2; ++ai)
#pragma unroll
                for (int m = 0; m < 4; ++m) { bf16_t* rp = proj + PIDX(row0 + ai * 128 + m * 16, col0);
#pragma unroll
                    for (int bj = 0; bj < 2; ++bj) { const f32x4 a = acc[ai][bj][m][0], b = acc[ai][bj][m][1];
                        u32x4 o = {pk2(a[0], a[1]), pk2(a[2], a[3]), pk2(b[0], b[1]), pk2(b[2], b[3])}; *(u32x4*)(rp + bj * 128) = o; } }
        } else if (kind == 1 && colt >= 2 * 3072) {
            bf16_t* base = vta + (ptrdiff_t)(2 * 1024 - 2 * 3072 - 2048) * (ptrdiff_t)S;
#pragma unroll
            for (int ai = 0; ai < 2; ++ai) { const int prow = fr * (S >> 4) + ((u.pm * 256 + ai * 128 + wr * 64) >> 4);
#pragma unroll
                for (int bj = 0; bj < 2; ++bj)
#pragma unroll
                    for (int n = 0; n < 2; ++n)
#pragma unroll
                        for (int e = 0; e < 4; ++e) { u32x2 o = {pk2(acc[ai][bj][0][n][e], acc[ai][bj][1][n][e]), pk2(acc[ai][bj][2][n][e], acc[ai][bj][3][n][e])};
                            *(u32x2*)(base + (ptrdiff_t)(col0 + bj * 128 + n * 4 + e) * (ptrdiff_t)S + prow) = o; } }
        } else {
            const int lane = fr + 16 * fq, wave = wr * 4 + wc;
            LAS float* tl = (LAS float*)(tlds + wave * 2304);
            const int cl = lane >> 1, hs = lane & 1;
            const int colg = colt + wc * 32 + cl;
#pragma unroll
            for (int ai = 0; ai < 2; ++ai)
#pragma unroll
                for (int bj = 0; bj < 2; ++bj)
#pragma unroll
                    for (int m = 0; m < 4; ++m) {
                        const int rowb = u.pm * 256 + ai * 128 + wr * 64 + m * 16;
#pragma unroll
                        for (int n = 0; n < 2; ++n)
#pragma unroll
                            for (int e = 0; e < 4; ++e) tl[(8 * fq + 4 * n + e) * 17 + fr] = acc[ai][bj][m][n][e];
                        __builtin_amdgcn_wave_barrier();
                        const LAS float* tc = tl + cl * 17;
                        const int col = colg + bj * 128;
                        if (kind == 2) {
                            f32x4 o0 = {tc[8 * hs], tc[8 * hs + 1], tc[8 * hs + 2], tc[8 * hs + 3]}, o1 = {tc[8 * hs + 4], tc[8 * hs + 5], tc[8 * hs + 6], tc[8 * hs + 7]};
                            float* bp = bint + (size_t)(col - C_BIN) * S + rowb + 8 * hs;
                            *(f32x4*)bp = o0; *(f32x4*)(bp + 4) = o1;
                        } else if (kind == 3) {
                            u32x4 o = {pk2(tc[4 * hs], tc[4 * hs + 1]), pk2(tc[4 * hs + 2], tc[4 * hs + 3]), pk2(tc[8 + 4 * hs], tc[9 + 4 * hs]), pk2(tc[10 + 4 * hs], tc[11 + 4 * hs])};
                            *(u32x4*)(vtc + (size_t)(col - (C_CQKV + 2048)) * S + rowb + 8 * hs) = o;
                        } else if (colt < 3072) {
                            u32x4 o = {pk2(tc[8 * hs], tc[8 * hs + 1]), pk2(tc[8 * hs + 2], tc[8 * hs + 3]), pk2(tc[8 * hs + 4], tc[8 * hs + 5]), pk2(tc[8 * hs + 6], tc[8 * hs + 7])};
                            *(u32x4*)(vta + (size_t)(col - 2048) * S + rowb + 8 * hs) = o;
                        } else {
#pragma unroll
                            for (int k = 0; k < 2; ++k) { const int res = 2 * hs + k;
                                u32x2 o = {pk2(tc[res], tc[res + 4]), pk2(tc[res + 8], tc[res + 12])};
                                *(u32x2*)(vta + (size_t)(1024 + col - 3072 - 2048) * S + res * (S >> 2) + (rowb >> 2)) = o; }
                        }
                        __builtin_amdgcn_wave_barrier();
                    }
        }
    }
};
struct ProjOrder {
    pg8::StaticOrder so;
    DI bool next(int i, pg8::Unit& u) const { pg8::Unit b; if (!so.next(i / 3, b)) return false; const int nb = i % 3; u.pm = b.pm + 32 * nb; u.pn = b.pn + 8 * nb; return true; }
};
struct EpiProj {   static constexpr bool PERM = false;
    const bf16_t* proj; const float* mb; float* yf; bf16_t* yb;
    DI void operator()(const f32x4 (&acc)[2][2][4][2], const pg8::Unit& u, int wr, int wc, int fr, int fq) const {
        const int nb = u.pm >> 5;
        const int row0 = (u.pm & 31) * 256 + wr * 64 + fr, col0 = (u.pn & 7) * 256 + wc * 32 + 4 * fq;
        f32x4 b4[2][2];
#pragma unroll
        for (int bj = 0; bj < 2; ++bj)
#pragma unroll
            for (int n = 0; n < 2; ++n) b4[bj][n] = *(const f32x4*)(mb + nb * D + col0 + bj * 128 + n * 16);
#pragma unroll
        for (int ai = 0; ai < 2; ++ai)
#pragma unroll
            for (int mp = 0; mp < 2; ++mp) {
                u32x2 mg[2][2][2]; f32x4 yv[2][2][2];
#pragma unroll
                for (int mi = 0; mi < 2; ++mi) { const int row = row0 + ai * 128 + (2 * mp + mi) * 16;
#pragma unroll
                    for (int bj = 0; bj < 2; ++bj)
#pragma unroll
                        for (int n = 0; n < 2; ++n) { const int col = col0 + bj * 128 + n * 16;
                            mg[mi][bj][n] = *(const u32x2*)(proj + PIDX(row, C_MERGE + nb * D + col));
                            if (nb > 0) yv[mi][bj][n] = *(const f32x4*)(yf + (size_t)row * D + col); else yv[mi][bj][n] = (f32x4){0.f, 0.f, 0.f, 0.f}; } }
#pragma unroll
                for (int mi = 0; mi < 2; ++mi) { const int m = 2 * mp + mi; const int row = row0 + ai * 128 + m * 16;
#pragma unroll
                    for (int bj = 0; bj < 2; ++bj)
#pragma unroll
                        for (int n = 0; n < 2; ++n) { const int col = col0 + bj * 128 + n * 16; const f32x4 a = acc[ai][bj][m][n]; const u32x2 g2 = mg[mi][bj][n]; const f32x4 bb = b4[bj][n];
                            f32x4 v = yv[mi][bj][n];
                            v[0] += a[0] * sigm_f(bflo(g2[0]) + bb[0]); v[1] += a[1] * sigm_f(bfhi(g2[0]) + bb[1]);
                            v[2] += a[2] * sigm_f(bflo(g2[1]) + bb[2]); v[3] += a[3] * sigm_f(bfhi(g2[1]) + bb[3]);
                            if (nb < 2) *(f32x4*)(yf + (size_t)row * D + col) = v;
                            else { u32x2 o = {pk2(v[0], v[1]), pk2(v[2], v[3])}; *(u32x2*)(yb + (size_t)row * D + col) = o; } } }
            }
    }
};
struct EpiOut {   static constexpr bool PERM = false;
    const float* xold; float* xnew;
    DI void operator()(const f32x4 (&acc)[2][2][4][2], const pg8::Unit& u, int wr, int wc, int fr, int fq) const {
        const int row0 = u.pm * 256 + wr * 64 + fr, col0 = u.pn * 256 + wc * 32 + 4 * fq;
#pragma unroll
        for (int ai = 0; ai < 2; ++ai)
#pragma unroll
            for (int mp = 0; mp < 2; ++mp) {
                f32x4 xv[2][2][2];
#pragma unroll
                for (int mi = 0; mi < 2; ++mi)
#pragma unroll
                    for (int bj = 0; bj < 2; ++bj)
#pragma unroll
                        for (int n = 0; n < 2; ++n) xv[mi][bj][n] = *(const f32x4*)(xold + (size_t)(row0 + ai * 128 + (2 * mp + mi) * 16) * D + col0 + bj * 128 + n * 16);
#pragma unroll
                for (int mi = 0; mi < 2; ++mi)
#pragma unroll
                    for (int bj = 0; bj < 2; ++bj)
#pragma unroll
                        for (int n = 0; n < 2; ++n) *(f32x4*)(xnew + (size_t)(row0 + ai * 128 + (2 * mp + mi) * 16) * D + col0 + bj * 128 + n * 16) = xv[mi][bj][n] + acc[ai][bj][2 * mp + mi][n];
            }
    }
};
DI float wave_sum(float v) {
#pragma unroll
    for (int o = 1; o < 64; o <<= 1) v += __shfl_xor(v, o);
    return v;
}
DI int crow(int reg, int h) { return (reg & 3) + 8 * (reg >> 2) + 4 * h; }
DI bf16x8 pack8(const f32x16& x, const int s) {
    u32x4 p;
    p[0] = pk2(x[8 * s + 0], x[8 * s + 1]); p[1] = pk2(x[8 * s + 2], x[8 * s + 3]);
    p[2] = pk2(x[8 * s + 4], x[8 * s + 5]); p[3] = pk2(x[8 * s + 6], x[8 * s + 7]);
    return __builtin_bit_cast(bf16x8, p);
}
#define MFMA32(a, b, c) __builtin_amdgcn_mfma_f32_32x32x16_bf16((a), (b), (c), 0, 0, 0)

DI void transpose_item(const float* Wsrc, int K, int N, bf16_t* WT, LAS float* scr, int item, int lane) {
    const int nblk = N / 64, kb = item / nblk, nb = item % nblk, k0 = 64 * kb, n0 = 64 * nb;
    const int lr = lane >> 4, lc = (lane & 15) * 4;
    f32x4 v[16];
#pragma unroll
    for (int i = 0; i < 16; ++i) v[i] = *(const f32x4*)(Wsrc + (size_t)(k0 + 4 * i + lr) * N + n0 + lc);
#pragma unroll
    for (int i = 0; i < 16; ++i) { LAS float* d = scr + (4 * i + lr) * 65 + lc; d[0] = v[i][0]; d[1] = v[i][1]; d[2] = v[i][2]; d[3] = v[i][3]; }
    __builtin_amdgcn_wave_barrier();
    const int c = lane & 7;
#pragma unroll
    for (int j = 0; j < 8; ++j) { const int n = (lane >> 3) + 8 * j; const LAS float* s = scr + (8 * c) * 65 + n;
        u32x4 o; o[0] = pk2(s[0 * 65], s[1 * 65]); o[1] = pk2(s[2 * 65], s[3 * 65]); o[2] = pk2(s[4 * 65], s[5 * 65]); o[3] = pk2(s[6 * 65], s[7 * 65]);
        *(u32x4*)(WT + (size_t)(n0 + n) * K + k0 + 8 * c) = o; }
    __builtin_amdgcn_wave_barrier();
}
DI int t5_bucket(int rel) {
    const int ret = rel > 0 ? 16 : 0; const int n = rel < 0 ? -rel : rel;
    const float nf = (float)(n > 1 ? n : 1);
    int large = 8 + (int)(logf(nf / 8.0f) / 4.852030263919617f * 8.0f);
    large = large < 15 ? large : 15;
    return ret + (n < 8 ? n : large);
}
DI void phase_prologue(const Params& p, LAS unsigned char* lds) {
    const int tid = tidx(), wave = tid >> 6, lane = tid & 63;
    const int gw = blockIdx.x * NWAVES + wave, NGW = gridDim.x * NWAVES;
    LAS float* scr = (LAS float*)(lds + wave * 16640);
    bf16_t* win_t = (bf16_t*)(p.ws + WS_WIN); bf16_t* wpr_t = (bf16_t*)(p.ws + WS_WPR); bf16_t* wout_t = (bf16_t*)(p.ws + WS_WOUT);
    constexpr int IT_IN = (D / 64) * (NIN / 64), IT_PR = (1024 / 64) * (D / 64), IT_OUT = (D / 64) * (D / 64);
    constexpr int TOT = DEPTH * IT_IN + DEPTH * 3 * IT_PR + DEPTH * IT_OUT;
    for (int it = gw; it < TOT; it += NGW) {
        int r = it;
        if (r < DEPTH * IT_IN) { const int l = r / IT_IN; transpose_item(p.in[I_WIN] + (size_t)l * D * NIN, D, NIN, win_t + (size_t)l * NIN * D, scr, r % IT_IN, lane); continue; }
        r -= DEPTH * IT_IN;
        if (r < DEPTH * 3 * IT_PR) { const int l = r / IT_PR; transpose_item(p.in[I_WPROJ] + (size_t)l * 1024 * D, 1024, D, wpr_t + (size_t)l * D * 1024, scr, r % IT_PR, lane); continue; }
        r -= DEPTH * 3 * IT_PR;
        { const int l = r / IT_OUT; transpose_item(p.in[I_WOUT] + (size_t)l * D * D, D, D, wout_t + (size_t)l * D * D, scr, r % IT_OUT, lane); }
    }
    float* bias = (float*)(p.ws + WS_BIAS);
    for (int i = blockIdx.x * NTHR + tid; i < 32 * 2049; i += gridDim.x * NTHR) {
        const int hd = i / 2049, rel = (i % 2049) - 1024;
        bias[i] = p.in[I_RELB][t5_bucket(rel) * 32 + hd] * LOG2E;
    }
    __syncthreads();
    LAS float* zemb = (LAS float*)lds;
    LAS float* h1 = (LAS float*)(lds + 2048);
    float* hid2 = (float*)(p.ws + WS_HID2);
    for (int rb = blockIdx.x; rb < S / 8; rb += gridDim.x) {
        const int rl = tid >> 6, j = tid & 63, i = rb * 8 + rl;
        if (j < 33) {
            float z;
            if (j == 0) z = (float)i / 8191.0f;
            else { const int k = (j - 1) & 15; const float fb = 1e-4f + (float)k * ((15.0f - 1e-4f) / 15.0f); const float w = 6.283185307179586f * (float)i / 8192.0f; const float a = fb * w; z = (j <= 16) ? cosf(a) : -sinf(a); }
            zemb[rl * 36 + j] = z;
        }
        __syncthreads();
        for (int l = 0; l < DEPTH; ++l) {
            float a1 = p.in[I_HYB1][l * 64 + j];
            for (int e = 0; e < 33; ++e) a1 += zemb[rl * 36 + e] * p.in[I_HYW1][(l * 33 + e) * 64 + j];
            h1[rl * 64 + j] = sinf(p.in[I_HYFREQ][(l * 2 + 0) * 64 + j] * a1);
            __syncthreads();
            float a2 = p.in[I_HYB2][l * 64 + j];
            for (int e = 0; e < 64; ++e) a2 += h1[rl * 64 + e] * p.in[I_HYW2][(l * 64 + e) * 64 + j];
            hid2[((size_t)l * S + i) * 64 + j] = sinf(p.in[I_HYFREQ][(l * 2 + 1) * 64 + j] * a2);
            __syncthreads();
        }
    }
}


DI void split8(const f32x4 a, const f32x4 b, bf16x8& hi, bf16x8& lo) {
    u32x4 h, l2;
    h[0] = pk2(a[0], a[1]); h[1] = pk2(a[2], a[3]); h[2] = pk2(b[0], b[1]); h[3] = pk2(b[2], b[3]);
    l2[0] = pk2(a[0] - bflo(h[0]), a[1] - bfhi(h[0])); l2[1] = pk2(a[2] - bflo(h[1]), a[3] - bfhi(h[1]));
    l2[2] = pk2(b[0] - bflo(h[2]), b[1] - bfhi(h[2])); l2[3] = pk2(b[2] - bflo(h[3]), b[3] - bfhi(h[3]));
    hi = __builtin_bit_cast(bf16x8, h); lo = __builtin_bit_cast(bf16x8, l2);
}
DI void phase_tgen(const Params& p) {
    const int tid = tidx(), wave = tid >> 6, lane = tid & 63, r = lane & 31, hh = lane >> 5;
    float* tt = (float*)(p.ws + WS_TT);
    for (int it = blockIdx.x * NWAVES + wave; it < DEPTH * 128 * 4; it += gridDim.x * NWAVES) {
        const int l = it >> 9, cb = (it >> 2) & 127, rc = it & 3;
        const float* w3 = p.in[I_HYW3] + (size_t)l * 64 * 4096 + cb * 32 + r;
        bf16x8 ahi[4], alo[4];
#pragma unroll
        for (int ks = 0; ks < 4; ++ks) {
            f32x4 a, b;
#pragma unroll
            for (int j = 0; j < 4; ++j) { a[j] = w3[(size_t)(16 * ks + 8 * hh + j) * 4096]; b[j] = w3[(size_t)(16 * ks + 8 * hh + 4 + j) * 4096]; }
            split8(a, b, ahi[ks], alo[ks]);
        }
        const float* hid2 = (const float*)(p.ws + WS_HID2) + (size_t)l * S * 64;
        f32x4 ha[4], hb[4];
        { const float* hr = hid2 + (size_t)(rc * 2048 + r) * 64 + 8 * hh;
#pragma unroll
          for (int ks = 0; ks < 4; ++ks) { ha[ks] = *(const f32x4*)(hr + 16 * ks); hb[ks] = *(const f32x4*)(hr + 16 * ks + 4); } }
#pragma unroll 1
        for (int rb = 0; rb < 64; ++rb) {
            const int i0 = rc * 2048 + rb * 32;
            bf16x8 bhi[4], blo[4];
#pragma unroll
            for (int ks = 0; ks < 4; ++ks) split8(ha[ks], hb[ks], bhi[ks], blo[ks]);
            if (rb + 1 < 64) { const float* hr = hid2 + (size_t)(i0 + 32 + r) * 64 + 8 * hh;
#pragma unroll
                for (int ks = 0; ks < 4; ++ks) { ha[ks] = *(const f32x4*)(hr + 16 * ks); hb[ks] = *(const f32x4*)(hr + 16 * ks + 4); } }
            f32x16 acc;
#pragma unroll
            for (int i = 0; i < 16; ++i) acc[i] = 0.f;
#pragma unroll
            for (int ks = 0; ks < 4; ++ks) { acc = MFMA32(ahi[ks], bhi[ks], acc); acc = MFMA32(ahi[ks], blo[ks], acc); acc = MFMA32(alo[ks], bhi[ks], acc); }
            float* tp = tt + ((size_t)l * 4096 + cb * 32) * S + i0 + r;
#pragma unroll
            for (int reg = 0; reg < 16; ++reg) tp[(size_t)crow(reg, hh) * S] = acc[reg];
        }
    }
}

#define XI(i) ((i) + ((i) >> 4) + ((i) >> 8))
DI cf cmul(cf a, cf b) {
    cf t, r;
    asm("v_pk_mul_f32 %0, %1, %2 op_sel:[0,0] op_sel_hi:[0,1]" : "=v"(t) : "v"(a), "v"(b));
    asm("v_pk_fma_f32 %0, %1, %2, %3 op_sel:[1,1,0] op_sel_hi:[1,0,1] neg_lo:[0,1,0]" : "=v"(r) : "v"(a), "v"(b), "v"(t));
    return r;
}
DI cf twid(float frac) { float c = __builtin_amdgcn_cosf(frac), s = __builtin_amdgcn_sinf(frac); asm volatile("s_nop 1" : "+v"(c), "+v"(s)); return (cf){c, -s}; }
DI cf twidc(float frac) { float c = __builtin_amdgcn_cosf(frac), s = __builtin_amdgcn_sinf(frac); asm volatile("s_nop 1" : "+v"(c), "+v"(s)); return (cf){c, s}; }
DI void fwd4(cf& a0, cf& a1, cf& a2, cf& a3) {
    const cf s02 = a0 + a2, d02 = a0 - a2, s13 = a1 + a3, d13 = a1 - a3;
    a0 = s02 + s13; a2 = s02 - s13;
    a1 = (cf){d02.x + d13.y, d02.y - d13.x};
    a3 = (cf){d02.x - d13.y, d02.y + d13.x};
}
DI void inv4(cf& b0, cf& b1, cf& b2, cf& b3) {
    const cf s02 = b0 + b2, d02 = b0 - b2, s13 = b1 + b3, d13 = b1 - b3;
    b0 = s02 + s13; b2 = s02 - s13;
    b1 = (cf){d02.x - d13.y, d02.y + d13.x};
    b3 = (cf){d02.x + d13.y, d02.y - d13.x};
}
template <int LOGM> DI void fwd_r4_pass(LAS cf* X, int tid) {
    asm volatile("" : "+v"(tid));
    constexpr int M = 1 << LOGM, q = M >> 2;
#pragma unroll 2
    for (int t = tid; t < 4096; t += NTHR) {
        const int j = t & (q - 1), base = (t >> (LOGM - 2)) * M + j;
        constexpr int QP = (q >= 256) ? (q + (q >> 4) + (q >> 8)) : ((q == 16) ? 17 : 1);
        LAS cf* xp = X + XI(base);
        cf a0 = xp[0], a1 = xp[QP], a2 = xp[2 * QP], a3 = xp[3 * QP];
        fwd4(a0, a1, a2, a3);
        const cf w1 = twid((float)j * (1.0f / M)), w2 = cmul(w1, w1), w3 = cmul(w2, w1);
        xp[0] = a0; xp[QP] = cmul(a1, w1); xp[2 * QP] = cmul(a2, w2); xp[3 * QP] = cmul(a3, w3);
    }
}
template <int LOGM> DI void inv_r4_pass(LAS cf* X, int tid) {
    asm volatile("" : "+v"(tid));
    constexpr int M = 1 << LOGM, q = M >> 2;
#pragma unroll 2
    for (int t = tid; t < 4096; t += NTHR) {
        const int j = t & (q - 1), base = (t >> (LOGM - 2)) * M + j;
        const cf w1 = twidc((float)j * (1.0f / M)), w2 = cmul(w1, w1), w3 = cmul(w2, w1);
        constexpr int QP = (q >= 256) ? (q + (q >> 4) + (q >> 8)) : ((q == 16) ? 17 : 1);
        LAS cf* xp = X + XI(base);
        cf b0 = xp[0], b1 = cmul(xp[QP], w1), b2 = cmul(xp[2 * QP], w2), b3 = cmul(xp[3 * QP], w3);
        inv4(b0, b1, b2, b3);
        xp[0] = b0; xp[QP] = b1; xp[2 * QP] = b2; xp[3 * QP] = b3;
    }
}
template <int LOGM> DI void fwd16(cf (&v)[16], int j) {
    constexpr int M = 1 << LOGM, q = M >> 4;
#pragma unroll
    for (int n = 0; n < 4; ++n) {
        fwd4(v[n], v[n + 4], v[n + 8], v[n + 12]);
        const cf w1 = twid((float)(j + n * q) * (1.0f / M)), w2 = cmul(w1, w1), w3 = cmul(w2, w1);
        v[n + 4] = cmul(v[n + 4], w1); v[n + 8] = cmul(v[n + 8], w2); v[n + 12] = cmul(v[n + 12], w3);
    }
    const cf u1 = twid((float)j * (4.0f / M)), u2 = cmul(u1, u1), u3 = cmul(u2, u1);
#pragma unroll
    for (int m = 0; m < 4; ++m) {
        fwd4(v[4 * m], v[4 * m + 1], v[4 * m + 2], v[4 * m + 3]);
        v[4 * m + 1] = cmul(v[4 * m + 1], u1); v[4 * m + 2] = cmul(v[4 * m + 2], u2); v[4 * m + 3] = cmul(v[4 * m + 3], u3);
    }
}
template <int LOGM> DI void inv16(cf (&v)[16], int j) {
    constexpr int M = 1 << LOGM, q = M >> 4;
    const cf u1 = twidc((float)j * (4.0f / M)), u2 = cmul(u1, u1), u3 = cmul(u2, u1);
#pragma unroll
    for (int m = 0; m < 4; ++m) {
        v[4 * m + 1] = cmul(v[4 * m + 1], u1); v[4 * m + 2] = cmul(v[4 * m + 2], u2); v[4 * m + 3] = cmul(v[4 * m + 3], u3);
        inv4(v[4 * m], v[4 * m + 1], v[4 * m + 2], v[4 * m + 3]);
    }
#pragma unroll
    for (int n = 0; n < 4; ++n) {
        const cf w1 = twidc((float)(j + n * q) * (1.0f / M)), w2 = cmul(w1, w1), w3 = cmul(w2, w1);
        v[n + 4] = cmul(v[n + 4], w1); v[n + 8] = cmul(v[n + 8], w2); v[n + 12] = cmul(v[n + 12], w3);
        inv4(v[n], v[n + 4], v[n + 8], v[n + 12]);
    }
}
template <int LOGM> DI void fwd_r16_pass(LAS cf* X, int tid) {
    asm volatile("" : "+v"(tid));
    constexpr int M = 1 << LOGM, q = M >> 4;
#pragma unroll 1
    for (int t = tid; t < 1024; t += NTHR) {
        const int j = t & (q - 1), base = (t >> (LOGM - 4)) * M + j;
        constexpr int QP = (q >= 256) ? (q + (q >> 4) + (q >> 8)) : ((q == 16) ? 17 : 1);
        LAS cf* xp = X + XI(base);
        cf v[16];
#pragma unroll
        for (int n = 0; n < 16; ++n) v[n] = xp[n * QP];
        fwd16<LOGM>(v, j);
#pragma unroll
        for (int n = 0; n < 16; ++n) xp[n * QP] = v[n];
    }
}
template <int LOGM> DI void inv_r16_pass(LAS cf* X, int tid) {
    asm volatile("" : "+v"(tid));
    constexpr int M = 1 << LOGM, q = M >> 4;
#pragma unroll 1
    for (int t = tid; t < 1024; t += NTHR) {
        const int j = t & (q - 1), base = (t >> (LOGM - 4)) * M + j;
        constexpr int QP = (q >= 256) ? (q + (q >> 4) + (q >> 8)) : ((q == 16) ? 17 : 1);
        LAS cf* xp = X + XI(base);
        cf v[16];
#pragma unroll
        for (int n = 0; n < 16; ++n) v[n] = xp[n * QP];
        inv16<LOGM>(v, j);
#pragma unroll
        for (int n = 0; n < 16; ++n) xp[n * QP] = v[n];
    }
}
DI int rev4(int pp) { const unsigned br = __brev((unsigned)pp) >> 18; return (int)(((br & 0x2AAAu) >> 1) | ((br & 0x1555u) << 1)); }
DI void fft_forward(LAS cf* X, int tid) {
    fwd_r4_pass<14>(X, tid); __syncthreads();
    fwd_r16_pass<12>(X, tid); __syncthreads();
    fwd_r16_pass<8>(X, tid); __syncthreads();
    fwd_r16_pass<4>(X, tid); __syncthreads();
}
constexpr int SPEC_STRIDE = 8208;
DI void fft_conv(LAS cf* X, const f32x4* spec, int tid) {
    fft_forward(X, tid);
#pragma unroll 8
    for (int r = 0; r < 16; ++r) {
        const int k = tid + NTHR * r; const int pp = rev4(k);
        const f32x4 sp = spec[k]; const cf P = (cf){sp[0], sp[1]}, Mq = (cf){sp[2], sp[3]};
        const cf z = X[XI(pp)];
        if (k == 0) { X[XI(pp)] = cmul(z, P) + cmul((cf){z.x, -z.y}, Mq); }
        else { const int pm = rev4(16384 - k); const cf zm = X[XI(pm)];
            const cf y = cmul(z, P) + cmul((cf){zm.x, -zm.y}, Mq);
            const cf t = cmul((cf){zm.x, -zm.y}, P) + cmul(z, Mq);
            X[XI(pp)] = y; X[XI(pm)] = (cf){t.x, -t.y}; }
    }
    if (tid == 0) { const int pp = rev4(8192); const f32x4 sp = spec[8192]; const cf z = X[XI(pp)]; X[XI(pp)] = cmul(z, (cf){sp[0], sp[1]}) + cmul((cf){z.x, -z.y}, (cf){sp[2], sp[3]}); }
    __syncthreads();
    inv_r16_pass<4>(X, tid); __syncthreads();
    inv_r16_pass<8>(X, tid); __syncthreads();
    inv_r16_pass<12>(X, tid); __syncthreads();
    inv_r4_pass<14>(X, tid); __syncthreads();
}


typedef _Float16 hc __attribute__((ext_vector_type(2)));
DI hc hcmul(hc a, hc b) { hc t, r;
    asm("v_pk_mul_f16 %0, %1, %2 op_sel:[0,0] op_sel_hi:[0,1]" : "=v"(t) : "v"(a), "v"(b));
    asm("v_pk_fma_f16 %0, %1, %2, %3 op_sel:[1,1,0] op_sel_hi:[1,0,1] neg_lo:[0,1,0]" : "=v"(r) : "v"(a), "v"(b), "v"(t)); return r; }
DI hc hadd_mi(hc a, hc b) { hc r; asm("v_pk_add_f16 %0, %1, %2 op_sel:[0,1] op_sel_hi:[1,0] neg_hi:[0,1]" : "=v"(r) : "v"(a), "v"(b)); return r; }
DI hc hadd_pi(hc a, hc b) { hc r; asm("v_pk_add_f16 %0, %1, %2 op_sel:[0,1] op_sel_hi:[1,0] neg_lo:[0,1]" : "=v"(r) : "v"(a), "v"(b)); return r; }
DI hc htwid(float frac) { float c = __builtin_amdgcn_cosf(frac), s = __builtin_amdgcn_sinf(frac); asm volatile("s_nop 1" : "+v"(c), "+v"(s)); return (hc){(_Float16)c, (_Float16)(-s)}; }
DI hc htwidc(float frac) { float c = __builtin_amdgcn_cosf(frac), s = __builtin_amdgcn_sinf(frac); asm volatile("s_nop 1" : "+v"(c), "+v"(s)); return (hc){(_Float16)c, (_Float16)s}; }
DI void hfwd4(hc& a0, hc& a1, hc& a2, hc& a3) {
    const hc s02 = a0 + a2, d02 = a0 - a2, s13 = a1 + a3, d13 = a1 - a3;
    a0 = s02 + s13; a2 = s02 - s13; a1 = hadd_mi(d02, d13); a3 = hadd_pi(d02, d13);
}
DI void hinv4(hc& b0, hc& b1, hc& b2, hc& b3) {
    const hc s02 = b0 + b2, d02 = b0 - b2, s13 = b1 + b3, d13 = b1 - b3;
    b0 = s02 + s13; b2 = s02 - s13; b1 = hadd_pi(d02, d13); b3 = hadd_mi(d02, d13);
}
template <int LOGM> DI void hfwd_r4_pass(LAS hc* X, int tid) {
    asm volatile("" : "+v"(tid));
    constexpr int M = 1 << LOGM, q = M >> 2;
#pragma unroll 8
    for (int t = tid; t < 4096; t += NTHR) {
        const int j = t & (q - 1), base = (t >> (LOGM - 2)) * M + j;
        constexpr int QP = (q >= 256) ? (q + (q >> 4) + (q >> 8)) : ((q == 16) ? 17 : 1);
        LAS hc* xp = X + XI(base);
        hc a0 = xp[0], a1 = xp[QP], a2 = xp[2 * QP], a3 = xp[3 * QP];
        hfwd4(a0, a1, a2, a3);
        const hc w1 = htwid((float)j * (1.0f / M)), w2 = hcmul(w1, w1), w3 = hcmul(w2, w1);
        xp[0] = a0; xp[QP] = hcmul(a1, w1); xp[2 * QP] = hcmul(a2, w2); xp[3 * QP] = hcmul(a3, w3);
    }
}
template <int LOGM> DI void hinv_r4_pass(LAS hc* X, int tid) {
    asm volatile("" : "+v"(tid));
    constexpr int M = 1 << LOGM, q = M >> 2;
#pragma unroll 8
    for (int t = tid; t < 4096; t += NTHR) {
        const int j = t & (q - 1), base = (t >> (LOGM - 2)) * M + j;
        const hc w1 = htwidc((float)j * (1.0f / M)), w2 = hcmul(w1, w1), w3 = hcmul(w2, w1);
        constexpr int QP = (q >= 256) ? (q + (q >> 4) + (q >> 8)) : ((q == 16) ? 17 : 1);
        LAS hc* xp = X + XI(base);
        hc b0 = xp[0], b1 = hcmul(xp[QP], w1), b2 = hcmul(xp[2 * QP], w2), b3 = hcmul(xp[3 * QP], w3);
        hinv4(b0, b1, b2, b3);
        xp[0] = b0; xp[QP] = b1; xp[2 * QP] = b2; xp[3 * QP] = b3;
    }
}
template <int LOGM> DI void hfwd16(hc (&v)[16], int j) {
    constexpr int M = 1 << LOGM, q = M >> 4;
#pragma unroll
    for (int n = 0; n < 4; ++n) {
        hfwd4(v[n], v[n + 4], v[n + 8], v[n + 12]);
        const hc w1 = htwid((float)(j + n * q) * (1.0f / M)), w2 = hcmul(w1, w1), w3 = hcmul(w2, w1);
        v[n + 4] = hcmul(v[n + 4], w1); v[n + 8] = hcmul(v[n + 8], w2); v[n + 12] = hcmul(v[n + 12], w3);
    }
    const hc u1 = htwid((float)j * (4.0f / M)), u2 = hcmul(u1, u1), u3 = hcmul(u2, u1);
#pragma unroll
    for (int m = 0; m < 4; ++m) {
        hfwd4(v[4 * m], v[4 * m + 1], v[4 * m + 2], v[4 * m + 3]);
        v[4 * m + 1] = hcmul(v[4 * m + 1], u1); v[4 * m + 2] = hcmul(v[4 * m + 2], u2); v[4 * m + 3] = hcmul(v[4 * m + 3], u3);
    }
}
template <int LOGM> DI void hinv16(hc (&v)[16], int j) {
    constexpr int M = 1 << LOGM, q = M >> 4;
    const hc u1 = htwidc((float)j * (4.0f / M)), u2 = hcmul(u1, u1), u3 = hcmul(u2, u1);
#pragma unroll
    for (int m = 0; m < 4; ++m) {
        v[4 * m + 1] = hcmul(v[4 * m + 1], u1); v[4 * m + 2] = hcmul(v[4 * m + 2], u2); v[4 * m + 3] = hcmul(v[4 * m + 3], u3);
        hinv4(v[4 * m], v[4 * m + 1], v[4 * m + 2], v[4 * m + 3]);
    }
#pragma unroll
    for (int n = 0; n < 4; ++n) {
        const hc w1 = htwidc((float)(j + n * q) * (1.0f / M)), w2 = hcmul(w1, w1), w3 = hcmul(w2, w1);
        v[n + 4] = hcmul(v[n + 4], w1); v[n + 8] = hcmul(v[n + 8], w2); v[n + 12] = hcmul(v[n + 12], w3);
        hinv4(v[n], v[n + 4], v[n + 8], v[n + 12]);
    }
}
template <int LOGM, bool FWD> DI void h_r16_pass(LAS hc* X, int tid) {
    asm volatile("" : "+v"(tid));
    constexpr int M = 1 << LOGM, q = M >> 4;
#pragma unroll
    for (int t = tid; t < 1024; t += NTHR) {
        const int j = t & (q - 1), base = (t >> (LOGM - 4)) * M + j;
        constexpr int QP = (q >= 256) ? (q + (q >> 4) + (q >> 8)) : ((q == 16) ? 17 : 1);
        LAS hc* xp = X + XI(base);
        hc v[16];
#pragma unroll
        for (int n = 0; n < 16; ++n) v[n] = xp[n * QP];
        if (FWD) hfwd16<LOGM>(v, j); else hinv16<LOGM>(v, j);
#pragma unroll
        for (int n = 0; n < 16; ++n) xp[n * QP] = v[n];
    }
}
DI void fft_conv_h(LAS hc* X, const f32x4* spec, int tid) {
    hfwd_r4_pass<14>(X, tid); __syncthreads();
    h_r16_pass<12, true>(X, tid); __syncthreads();
    h_r16_pass<8, true>(X, tid); __syncthreads();
    h_r16_pass<4, true>(X, tid); __syncthreads();
#pragma unroll 8
    for (int r = 0; r < 16; ++r) {
        const int k = tid + NTHR * r; const int pp = rev4(k);
        const f32x4 sp = spec[k]; const cf P = (cf){sp[0], sp[1]} * 256.0f, Mq = (cf){sp[2], sp[3]} * 256.0f;
        const hc zh = X[XI(pp)]; const cf z = (cf){(float)zh.x, (float)zh.y};
        if (k == 0) { const cf y = cmul(z, P) + cmul((cf){z.x, -z.y}, Mq); X[XI(pp)] = (hc){(_Float16)y.x, (_Float16)y.y}; }
        else { const int pm = rev4(16384 - k); const hc zmh = X[XI(pm)]; const cf zm = (cf){(float)zmh.x, (float)zmh.y};
            const cf y = cmul(z, P) + cmul((cf){zm.x, -zm.y}, Mq);
            const cf t = cmul((cf){zm.x, -zm.y}, P) + cmul(z, Mq);
            X[XI(pp)] = (hc){(_Float16)y.x, (_Float16)y.y}; X[XI(pm)] = (hc){(_Float16)t.x, (_Float16)(-t.y)}; }
    }
    if (tid == 0) { const int pp = rev4(8192); const f32x4 sp = spec[8192]; const hc zh = X[XI(pp)]; const cf z = (cf){(float)zh.x, (float)zh.y};
        const cf y = (cmul(z, (cf){sp[0], sp[1]}) + cmul((cf){z.x, -z.y}, (cf){sp[2], sp[3]})) * 256.0f; X[XI(pp)] = (hc){(_Float16)y.x, (_Float16)y.y}; }
    __syncthreads();
    h_r16_pass<4, false>(X, tid); __syncthreads();
    h_r16_pass<8, false>(X, tid); __syncthreads();
    h_r16_pass<12, false>(X, tid); __syncthreads();
    hinv_r4_pass<14>(X, tid); __syncthreads();
}

template <int LOGM> DI void hfwd_r4_pass2(LAS hc* X0, LAS hc* X1, int tid) {
    asm volatile("" : "+v"(tid));
    constexpr int M = 1 << LOGM, q = M >> 2;
#pragma unroll 4
    for (int t = tid; t < 4096; t += NTHR) {
        const int j = t & (q - 1), base = (t >> (LOGM - 2)) * M + j;
        constexpr int QP = (q >= 256) ? (q + (q >> 4) + (q >> 8)) : ((q == 16) ? 17 : 1);
        const int xo = XI(base);
        LAS hc* xp = X0 + xo; LAS hc* yp = X1 + xo;
        hc a0 = xp[0], a1 = xp[QP], a2 = xp[2 * QP], a3 = xp[3 * QP], b0 = yp[0], b1 = yp[QP], b2 = yp[2 * QP], b3 = yp[3 * QP];
        hfwd4(a0, a1, a2, a3); hfwd4(b0, b1, b2, b3);
        const hc w1 = htwid((float)j * (1.0f / M)), w2 = hcmul(w1, w1), w3 = hcmul(w2, w1);
        xp[0] = a0; xp[QP] = hcmul(a1, w1); xp[2 * QP] = hcmul(a2, w2); xp[3 * QP] = hcmul(a3, w3);
        yp[0] = b0; yp[QP] = hcmul(b1, w1); yp[2 * QP] = hcmul(b2, w2); yp[3 * QP] = hcmul(b3, w3);
    }
}
template <int LOGM> DI void hinv_r4_pass2(LAS hc* X0, LAS hc* X1, int tid) {
    asm volatile("" : "+v"(tid));
    constexpr int M = 1 << LOGM, q = M >> 2;
#pragma unroll 4
    for (int t = tid; t < 4096; t += NTHR) {
        const int j = t & (q - 1), base = (t >> (LOGM - 2)) * M + j;
        const hc w1 = htwidc((float)j * (1.0f / M)), w2 = hcmul(w1, w1), w3 = hcmul(w2, w1);
        constexpr int QP = (q >= 256) ? (q + (q >> 4) + (q >> 8)) : ((q == 16) ? 17 : 1);
        const int xo = XI(base);
        LAS hc* xp = X0 + xo; LAS hc* yp = X1 + xo;
        hc a0 = xp[0], a1 = hcmul(xp[QP], w1), a2 = hcmul(xp[2 * QP], w2), a3 = hcmul(xp[3 * QP], w3);
        hc b0 = yp[0], b1 = hcmul(yp[QP], w1), b2 = hcmul(yp[2 * QP], w2), b3 = hcmul(yp[3 * QP], w3);
        hinv4(a0, a1, a2, a3); hinv4(b0, b1, b2, b3);
        xp[0] = a0; xp[QP] = a1; xp[2 * QP] = a2; xp[3 * QP] = a3;
        yp[0] = b0; yp[QP] = b1; yp[2 * QP] = b2; yp[3 * QP] = b3;
    }
}
template <int LOGM> DI void hfwd16x2(hc (&v)[16], hc (&u)[16], int j) {
    constexpr int M = 1 << LOGM, q = M >> 4;
#pragma unroll
    for (int n = 0; n < 4; ++n) {
        hfwd4(v[n], v[n + 4], v[n + 8], v[n + 12]); hfwd4(u[n], u[n + 4], u[n + 8], u[n + 12]);
        const hc w1 = htwid((float)(j + n * q) * (1.0f / M)), w2 = hcmul(w1, w1), w3 = hcmul(w2, w1);
        v[n + 4] = hcmul(v[n + 4], w1); v[n + 8] = hcmul(v[n + 8], w2); v[n + 12] = hcmul(v[n + 12], w3);
        u[n + 4] = hcmul(u[n + 4], w1); u[n + 8] = hcmul(u[n + 8], w2); u[n + 12] = hcmul(u[n + 12], w3);
    }
    const hc u1 = htwid((float)j * (4.0f / M)), u2 = hcmul(u1, u1), u3 = hcmul(u2, u1);
#pragma unroll
    for (int m = 0; m < 4; ++m) {
        hfwd4(v[4 * m], v[4 * m + 1], v[4 * m + 2], v[4 * m + 3]); hfwd4(u[4 * m], u[4 * m + 1], u[4 * m + 2], u[4 * m + 3]);
        v[4 * m + 1] = hcmul(v[4 * m + 1], u1); v[4 * m + 2] = hcmul(v[4 * m + 2], u2); v[4 * m + 3] = hcmul(v[4 * m + 3], u3);
        u[4 * m + 1] = hcmul(u[4 * m + 1], u1); u[4 * m + 2] = hcmul(u[4 * m + 2], u2); u[4 * m + 3] = hcmul(u[4 * m + 3], u3);
    }
}
template <int LOGM> DI void hinv16x2(hc (&v)[16], hc (&u)[16], int j) {
    constexpr int M = 1 << LOGM, q = M >> 4;
    const hc u1 = htwidc((float)j * (4.0f / M)), u2 = hcmul(u1, u1), u3 = hcmul(u2, u1);
#pragma unroll
    for (int m = 0; m < 4; ++m) {
        v[4 * m + 1] = hcmul(v[4 * m + 1], u1); v[4 * m + 2] = hcmul(v[4 * m + 2], u2); v[4 * m + 3] = hcmul(v[4 * m + 3], u3);
        u[4 * m + 1] = hcmul(u[4 * m + 1], u1); u[4 * m + 2] = hcmul(u[4 * m + 2], u2); u[4 * m + 3] = hcmul(u[4 * m + 3], u3);
        hinv4(v[4 * m], v[4 * m + 1], v[4 * m + 2], v[4 * m + 3]); hinv4(u[4 * m], u[4 * m + 1], u[4 * m + 2], u[4 * m + 3]);
    }
#pragma unroll
    for (int n = 0; n < 4; ++n) {
        const hc w1 = htwidc((float)(j + n * q) * (1.0f / M)), w2 = hcmul(w1, w1), w3 = hcmul(w2, w1);
        v[n + 4] = hcmul(v[n + 4], w1); v[n + 8] = hcmul(v[n + 8], w2); v[n + 12] = hcmul(v[n + 12], w3);
        u[n + 4] = hcmul(u[n + 4], w1); u[n + 8] = hcmul(u[n + 8], w2); u[n + 12] = hcmul(u[n + 12], w3);
        hinv4(v[n], v[n + 4], v[n + 8], v[n + 12]); hinv4(u[n], u[n + 4], u[n + 8], u[n + 12]);
    }
}
template <int LOGM, bool FWD> DI void h_r16_pass2(LAS hc* X0, LAS hc* X1, int tid) {
    asm volatile("" : "+v"(tid));
    constexpr int M = 1 << LOGM, q = M >> 4;
#pragma unroll 1
    for (int t = tid; t < 1024; t += NTHR) {
        const int j = t & (q - 1), base = (t >> (LOGM - 4)) * M + j;
        constexpr int QP = (q >= 256) ? (q + (q >> 4) + (q >> 8)) : ((q == 16) ? 17 : 1);
        const int xo = XI(base);
        LAS hc* xp = X0 + xo; LAS hc* yp = X1 + xo;
        hc v[16], u[16];
#pragma unroll
        for (int n = 0; n < 16; ++n) { v[n] = xp[n * QP]; u[n] = yp[n * QP]; }
        if (FWD) hfwd16x2<LOGM>(v, u, j); else hinv16x2<LOGM>(v, u, j);
#pragma unroll
        for (int n = 0; n < 16; ++n) { xp[n * QP] = v[n]; yp[n * QP] = u[n]; }
    }
}
DI void pw_h(LAS hc* X, const f32x4* spec, int tid) {
#pragma unroll 8
    for (int r = 0; r < 16; ++r) {
        const int k = tid + NTHR * r; const int pp = rev4(k);
        const f32x4 sp = spec[k]; const cf P = (cf){sp[0], sp[1]} * 256.0f, Mq = (cf){sp[2], sp[3]} * 256.0f;
        const hc zh = X[XI(pp)]; const cf z = (cf){(float)zh.x, (float)zh.y};
        if (k == 0) { const cf y = cmul(z, P) + cmul((cf){z.x, -z.y}, Mq); X[XI(pp)] = (hc){(_Float16)y.x, (_Float16)y.y}; }
        else { const int pm = rev4(16384 - k); const hc zmh = X[XI(pm)]; const cf zm = (cf){(float)zmh.x, (float)zmh.y};
            const cf y = cmul(z, P) + cmul((cf){zm.x, -zm.y}, Mq);
            const cf t = cmul((cf){zm.x, -zm.y}, P) + cmul(z, Mq);
            X[XI(pp)] = (hc){(_Float16)y.x, (_Float16)y.y}; X[XI(pm)] = (hc){(_Float16)t.x, (_Float16)(-t.y)}; }
    }
    if (tid == 0) { const int pp = rev4(8192); const f32x4 sp = spec[8192]; const hc zh = X[XI(pp)]; const cf z = (cf){(float)zh.x, (float)zh.y};
        const cf y = (cmul(z, (cf){sp[0], sp[1]}) + cmul((cf){z.x, -z.y}, (cf){sp[2], sp[3]})) * 256.0f; X[XI(pp)] = (hc){(_Float16)y.x, (_Float16)y.y}; }
}
DI void fft_conv_h2(LAS hc* X0, LAS hc* X1, const f32x4* spec0, const f32x4* spec1, int tid) {
    hfwd_r4_pass2<14>(X0, X1, tid); __syncthreads();
    h_r16_pass2<12, true>(X0, X1, tid); __syncthreads();
    h_r16_pass2<8, true>(X0, X1, tid); __syncthreads();
    h_r16_pass2<4, true>(X0, X1, tid); __syncthreads();
    pw_h(X0, spec0, tid); pw_h(X1, spec1, tid);
    __syncthreads();
    h_r16_pass2<4, false>(X0, X1, tid); __syncthreads();
    h_r16_pass2<8, false>(X0, X1, tid); __syncthreads();
    h_r16_pass2<12, false>(X0, X1, tid); __syncthreads();
    hinv_r4_pass2<14>(X0, X1, tid); __syncthreads();
}

DI void spectra_item(const Params& p, int ditem, LAS unsigned char* lds) {
    int tid = tidx(); asm volatile("" : "+v"(tid));
    const int l = ditem >> 9, o = (ditem >> 8) & 1, d = ditem & 255, a = 4 * d;
    LAS hc* X0 = (LAS hc*)lds; LAS hc* X1 = X0 + 17472;
    const float mind = -3.0701134573253943f, maxd = -15.350567286626972f;
    float dec[4], sk[4];
#pragma unroll
    for (int c = 0; c < 4; ++c) { dec[c] = fabsf(mind + (float)(a + c) * ((maxd - mind) / 1023.0f)); sk[c] = p.in[I_HYSKIP][(l * 2 + o) * 1024 + a + c]; }
    const float* tf = (const float*)(p.ws + WS_TT) + ((size_t)l * 4096 + (o * 2 + 0) * 1024 + a) * S;
    const float* tb = (const float*)(p.ws + WS_TT) + ((size_t)l * 4096 + (o * 2 + 1) * 1024 + a) * S;
#pragma unroll 8
    for (int rr = 0; rr < 16; ++rr) {
        const int i = tid + NTHR * rr;
        const float ti = (float)i / 8191.0f;
        float f[4], b[4];
#pragma unroll
        for (int c = 0; c < 4; ++c) { const float e = __expf(-ti * dec[c]) * 256.0f; f[c] = tf[(size_t)c * S + i] * e; b[c] = tb[(size_t)c * S + i] * e; }
        if (i == 0) {
            X0[XI(0)] = (hc){(_Float16)(f[0] + b[0] + sk[0] * 256.0f), (_Float16)(f[1] + b[1] + sk[1] * 256.0f)}; X1[XI(0)] = (hc){(_Float16)(f[2] + b[2] + sk[2] * 256.0f), (_Float16)(f[3] + b[3] + sk[3] * 256.0f)};
            X0[XI(8192)] = (hc){(_Float16)0.f, (_Float16)0.f}; X1[XI(8192)] = (hc){(_Float16)0.f, (_Float16)0.f};
        } else {
            X0[XI(i)] = (hc){(_Float16)f[0], (_Float16)f[1]}; X1[XI(i)] = (hc){(_Float16)f[2], (_Float16)f[3]};
            X0[XI(16384 - i)] = (hc){(_Float16)b[0], (_Float16)b[1]}; X1[XI(16384 - i)] = (hc){(_Float16)b[2], (_Float16)b[3]};
        }
    }
    __syncthreads();
    hfwd_r4_pass2<14>(X0, X1, tid); __syncthreads();
    h_r16_pass2<12, true>(X0, X1, tid); __syncthreads();
    h_r16_pass2<8, true>(X0, X1, tid); __syncthreads();
    h_r16_pass2<4, true>(X0, X1, tid); __syncthreads();
    const float sc = 0.5f / 16384.0f / 256.0f;
#pragma unroll
    for (int half = 0; half < 2; ++half) {
        LAS hc* X = half ? X1 : X0;
        f32x4* spec = (f32x4*)(p.ws + WS_SPEC) + (size_t)((l * 2 + o) * 512 + 2 * d + half) * SPEC_STRIDE;
        for (int r = 0; r < 17; ++r) {
            const int k = tid + NTHR * r; if (k > 8192) break;
            const hc Fh = X[XI(rev4(k))], Fmh = X[XI(rev4((16384 - k) & 16383))]; const cf F = (cf){(float)Fh.x, (float)Fh.y}, Fm = (cf){(float)Fmh.x, (float)Fmh.y};
            const cf Fc = (cf){Fm.x, -Fm.y};
            const cf Ha = (F + Fc) * 0.5f, tt = (F - Fc) * 0.5f; const cf Hb = (cf){tt.y, -tt.x};
            const cf P = (Ha + Hb) * sc, Mq = (Ha - Hb) * sc;
            spec[k] = (f32x4){P.x, P.y, Mq.x, Mq.y};
        }
    }
    __syncthreads();
}

DI float conv3(const float* row, int t, float w0, float w1, float w2) {
    const float c = row[t]; float pv = row[t > 0 ? t - 1 : 0], nx = row[t < S - 1 ? t + 1 : S - 1];
    pv = t > 0 ? pv : 0.f; nx = t < S - 1 ? nx : 0.f;
    return w0 * pv + w1 * c + w2 * nx;
}
DI void hyena_item(const Params& p, int l, int dpr, LAS unsigned char* lds) {
    int tid = tidx(); asm volatile("" : "+v"(tid)); const int a = 4 * dpr;
    LAS hc* X0 = (LAS hc*)lds; LAS hc* X1 = X0 + 17472;
    const float* bint = (const float*)(p.ws + WS_BINT);
    const float* cw = p.in[I_HYCONV] + (size_t)l * 3 * 3072;
    const f32x4* spec = (const f32x4*)(p.ws + WS_SPEC);
    const hc hzero = (hc){(_Float16)0.f, (_Float16)0.f};
    float w[4][3];
#pragma unroll
    for (int c = 0; c < 4; ++c)
#pragma unroll
        for (int k = 0; k < 3; ++k) w[c][k] = cw[k * 3072 + 0 * 1024 + a + c];
#pragma unroll 4
    for (int r = 0; r < 16; ++r) { const int t = tid + NTHR * r;
        float v[4];
#pragma unroll
        for (int c = 0; c < 4; ++c) v[c] = conv3(bint + (size_t)(a + c) * S, t, w[c][0], w[c][1], w[c][2]) * 0.25f;
        X0[XI(t)] = (hc){(_Float16)v[0], (_Float16)v[1]}; X1[XI(t)] = (hc){(_Float16)v[2], (_Float16)v[3]};
        X0[XI(t + 8192)] = hzero; X1[XI(t + 8192)] = hzero; }
    __syncthreads();
    fft_conv_h2(X0, X1, spec + (size_t)((l * 2 + 0) * 512 + 2 * dpr) * SPEC_STRIDE, spec + (size_t)((l * 2 + 0) * 512 + 2 * dpr + 1) * SPEC_STRIDE, tid);
#pragma unroll
    for (int c = 0; c < 4; ++c)
#pragma unroll
        for (int k = 0; k < 3; ++k) w[c][k] = cw[k * 3072 + 1 * 1024 + a + c];
#pragma unroll 4
    for (int r = 0; r < 16; ++r) { const int t = tid + NTHR * r; const hc y0 = X0[XI(t)], y1 = X1[XI(t)];
        const float yv[4] = {(float)y0.x, (float)y0.y, (float)y1.x, (float)y1.y};
        float z[4];
#pragma unroll
        for (int c = 0; c < 4; ++c) z[c] = yv[c] * (1.0f / 64.0f) * conv3(bint + (size_t)(1024 + a + c) * S, t, w[c][0], w[c][1], w[c][2]) * 0.25f;
        X0[XI(t)] = (hc){(_Float16)z[0], (_Float16)z[1]}; X1[XI(t)] = (hc){(_Float16)z[2], (_Float16)z[3]};
        X0[XI(t + 8192)] = hzero; X1[XI(t + 8192)] = hzero; }
    __syncthreads();
    fft_conv_h2(X0, X1, spec + (size_t)((l * 2 + 1) * 512 + 2 * dpr) * SPEC_STRIDE, spec + (size_t)((l * 2 + 1) * 512 + 2 * dpr + 1) * SPEC_STRIDE, tid);
#pragma unroll
    for (int c = 0; c < 4; ++c)
#pragma unroll
        for (int k = 0; k < 3; ++k) w[c][k] = cw[k * 3072 + 2 * 1024 + a + c];
    float* z2t = (float*)(p.ws + WS_Z2T);
#pragma unroll 4
    for (int r = 0; r < 16; ++r) { const int t = tid + NTHR * r; const hc y0 = X0[XI(t)], y1 = X1[XI(t)];
        const float yv[4] = {(float)y0.x, (float)y0.y, (float)y1.x, (float)y1.y};
#pragma unroll
        for (int c = 0; c < 4; ++c) z2t[(size_t)(a + c) * S + t] = yv[c] * (1.0f / 64.0f) * conv3(bint + (size_t)(2048 + a + c) * S, t, w[c][0], w[c][1], w[c][2]); }
    __syncthreads();
}
DI void phase_rmsnorm(const float* x, const float* g, bf16_t* hout, float* fout) {
    const int tid = tidx(), wave = tid >> 6, lane = tid & 63;
    const int gw = blockIdx.x * NWAVES + wave, ngw = gridDim.x * NWAVES;
    for (int row = gw; row < S; row += 2 * ngw) {
        const int row2 = row + ngw;
        const bool has2 = row2 < S;
        const f32x4* xr = (const f32x4*)(x + (size_t)row * D) + lane;
        const f32x4* xr2 = (const f32x4*)(x + (size_t)(has2 ? row2 : row) * D) + lane;
        f32x4 v[8], v2[8]; float s = 0.f, s2 = 0.f;
#pragma unroll
        for (int j = 0; j < 8; ++j) { v[j] = xr[64 * j]; v2[j] = xr2[64 * j]; }
#pragma unroll
        for (int j = 0; j < 8; ++j) { s += (v[j][0] * v[j][0] + v[j][1] * v[j][1]) + (v[j][2] * v[j][2] + v[j][3] * v[j][3]); s2 += (v2[j][0] * v2[j][0] + v2[j][1] * v2[j][1]) + (v2[j][2] * v2[j][2] + v2[j][3] * v2[j][3]); }
        const float rstd = rsqrtf(wave_sum(s) * (1.0f / D) + 1e-6f), rstd2 = rsqrtf(wave_sum(s2) * (1.0f / D) + 1e-6f);
#pragma unroll
        for (int j = 0; j < 8; ++j) { const f32x4 gg = ((const f32x4*)g)[lane + 64 * j]; const f32x4 y = v[j] * rstd * gg, y2 = v2[j] * rstd2 * gg;
            if (hout) { u32x2 o = {pk2(y[0], y[1]), pk2(y[2], y[3])}; ((u32x2*)(hout + (size_t)row * D))[lane + 64 * j] = o;
                if (has2) { u32x2 o2 = {pk2(y2[0], y2[1]), pk2(y2[2], y2[3])}; ((u32x2*)(hout + (size_t)row2 * D))[lane + 64 * j] = o2; } }
            else { ((f32x4*)(fout + (size_t)row * D))[lane + 64 * j] = y; if (has2) ((f32x4*)(fout + (size_t)row2 * D))[lane + 64 * j] = y2; } }
    }
}

constexpr int KROW = 144, KBUF = 64 * KROW, VBUF = 128 * KROW;
DI void softmax_half(f32x16& s, const LAS float* btab, int k0, int q0w, int r, int hh, float cs, float& m, float& lsum, f32x16 (&O)[4]) {
    const int q = q0w + r;
    const int relmin = k0 - q0w - 31, relmax = k0 + 31 - q0w;
    float bc = 0.f, csx = cs;
    if (relmin >= 1024 || relmax <= -1024) { bc = btab[relmin >= 1024 ? 2048 : 0]; }
    else {
        if (relmin >= -1024 && relmax <= 1024) {
            const LAS float* bp = btab + (k0 - q + 1024 + 4 * hh);
#pragma unroll
            for (int i = 0; i < 16; ++i) s[i] = s[i] * cs + bp[(i & 3) + 8 * (i >> 2)];
        } else {
#pragma unroll
            for (int i = 0; i < 16; ++i) { const int rel = k0 + crow(i, hh) - q; const int i0 = min(max(rel, -1024), 1024) + 1024; s[i] = s[i] * cs + btab[i0]; }
        }
        csx = 1.0f;
    }
    float mx = s[0];
#pragma unroll
    for (int i = 1; i < 16; ++i) mx = fmaxf(mx, s[i]);
    mx = mx * csx + bc;
    mx = fmaxf(mx, __shfl_xor(mx, 32));
    if (__any(mx > m + 8.0f)) {
        const float mnew = fmaxf(m, mx), alpha = __builtin_amdgcn_exp2f(m - mnew);
        m = mnew; lsum *= alpha;
#pragma unroll
        for (int db = 0; db < 4; ++db) O[db] *= alpha;
    }
    const float c2 = bc - m;
    float rs0 = 0.f, rs1 = 0.f;
#pragma unroll
    for (int i = 0; i < 16; i += 2) { s[i] = __builtin_amdgcn_exp2f(s[i] * csx + c2); s[i + 1] = __builtin_amdgcn_exp2f(s[i + 1] * csx + c2); rs0 += s[i]; rs1 += s[i + 1]; }
    lsum += rs0 + rs1;
}
constexpr int K3BUF = 64 * 128, V3BUF = 128 * 128;
DI void dstage_k(const bf16_t* kgl, LAS unsigned char* dst, int wave, int lane) {
    const int row = 8 * wave + (lane >> 3), gseg = (lane & 7) ^ ((row >> 1) & 7);
    __builtin_amdgcn_global_load_lds((const unsigned*)(kgl + (size_t)row * 256 + gseg * 8), (LAS unsigned*)(dst + wave * 1024), 16, 0, 0);
}
DI void dstage_v(const bf16_t* vgl, LAS unsigned char* dst, int wave, int lane) {
#pragma unroll
    for (int k = 0; k < 2; ++k) { const int ii = 2 * wave + k, row = 8 * ii + (lane >> 3), gseg = (lane & 7) ^ ((row >> 1) & 7);
        __builtin_amdgcn_global_load_lds((const unsigned*)(vgl + (size_t)row * S + gseg * 8), (LAS unsigned*)(dst + ii * 1024), 16, 0, 0); }
}
DI void sm_max_phase(f32x16& s, const LAS float* btab, int k0, int q0w, int r, int hh, float cs, float& m, float& lsum, f32x16 (&O)[4], float& csx, float& c2) {
    const int q = q0w + r;
    const int relmin = k0 - q0w - 31, relmax = k0 + 31 - q0w;
    float bc = 0.f; csx = cs;
    if (relmin >= 1024 || relmax <= -1024) { bc = btab[relmin >= 1024 ? 2048 : 0]; }
    else {
        if (relmin >= -1024 && relmax <= 1024) {
            const LAS float* bp = btab + (k0 - q + 1024 + 4 * hh);
#pragma unroll
            for (int i = 0; i < 16; ++i) s[i] = s[i] * cs + bp[(i & 3) + 8 * (i >> 2)];
        } else {
#pragma unroll
            for (int i = 0; i < 16; ++i) { const int rel = k0 + crow(i, hh) - q; const int i0 = min(max(rel, -1024), 1024) + 1024; s[i] = s[i] * cs + btab[i0]; }
        }
        csx = 1.0f;
    }
    float mx = s[0];
#pragma unroll
    for (int i = 1; i < 16; ++i) mx = fmaxf(mx, s[i]);
    mx = mx * csx + bc;
    mx = fmaxf(mx, __shfl_xor(mx, 32));
    if (__any(mx > m + 8.0f)) {
        const float mnew = fmaxf(m, mx), alpha = __builtin_amdgcn_exp2f(m - mnew);
        m = mnew; lsum *= alpha;
#pragma unroll
        for (int db = 0; db < 4; ++db) O[db] *= alpha;
    }
    c2 = bc - m;
}
#define DF_EXP2(i0) do { s[i0] = __builtin_amdgcn_exp2f(s[i0] * csx + c2); s[(i0) + 1] = __builtin_amdgcn_exp2f(s[(i0) + 1] * csx + c2); rs0 += s[i0]; rs1 += s[(i0) + 1]; } while (0)
#define DF_FENCE __builtin_amdgcn_sched_barrier(0)
DI void diff_flash2(const bf16_t* proj, const bf16_t* vtc, int h, int c, int q0w, LAS unsigned char* lds, const LAS float* btab, f32x16 (&O)[4]) {
    int tid = tidx(); asm volatile("" : "+v"(tid)); const int lane = tid & 63, r = lane & 31, hh = lane >> 5, wave = __builtin_amdgcn_readfirstlane(tid >> 6);
    constexpr int NT = S / 64;
    bf16x8 qf[4];
    { const bf16_t* qp = proj + PIDX(q0w + r, C_CQKV + h * 128 + c * 64 + 8 * hh);
#pragma unroll
      for (int ks = 0; ks < 4; ++ks) qf[ks] = *(const bf16x8*)(qp + 16 * ks); }
#pragma unroll
    for (int db = 0; db < 4; ++db)
#pragma unroll
        for (int i = 0; i < 16; ++i) O[db][i] = 0.f;
    float m = -1e30f, lsum = 0.f;
    const float cs = 0.125f * LOG2E;
    const bf16_t* kg = proj + PIDX(0, C_CQKV + 1024 + h * 128 + c * 64);
    const bf16_t* vg = vtc + (size_t)(h * 128) * S;
    LAS unsigned char* Kb = lds; LAS unsigned char* Vb = lds + 3 * K3BUF;
    __syncthreads();
    dstage_k(kg, Kb, wave, lane); dstage_v(vg, Vb, wave, lane); dstage_k(kg + (size_t)64 * 256, Kb + K3BUF, wave, lane);
    asm volatile("s_waitcnt vmcnt(0)" ::: "memory");
    __syncthreads();
    const int swz = (r >> 1) & 7, rowoff = r * 128;
    int kso[4];
#pragma unroll
    for (int ks = 0; ks < 4; ++ks) kso[ks] = rowoff + (((2 * ks + hh) ^ swz) << 4);
    bf16x8 kf[4], vf[8];
    f32x16 s, sn;
#pragma unroll
    for (int i = 0; i < 16; ++i) s[i] = 0.f;
#pragma unroll
    for (int ks = 0; ks < 4; ++ks) { kf[ks] = *(const LAS bf16x8*)(Kb + kso[ks]); }
#pragma unroll
    for (int ks = 0; ks < 4; ++ks) s = MFMA32(kf[ks], qf[ks], s);
    int kc = 0, kn = K3BUF, kw = 2 * K3BUF;
#pragma unroll 1
    for (int t = 0; t < NT; ++t) {
        if (t + 2 < NT) dstage_k(kg + (size_t)(t + 2) * 64 * 256, Kb + kw, wave, lane);
        if (t + 1 < NT) dstage_v(vg + (t + 1) * 64, Vb + ((t + 1) & 1) * V3BUF, wave, lane);
        const LAS unsigned char* vb_ = Vb + (t & 1) * V3BUF;
#pragma unroll
        for (int half = 0; half < 2; ++half) {
#pragma unroll
            for (int ss = 0; ss < 2; ++ss) { const int vs = rowoff + (((4 * half + 2 * ss + hh) ^ swz) << 4);
#pragma unroll
                for (int db = 0; db < 4; ++db) vf[ss * 4 + db] = *(const LAS bf16x8*)(vb_ + vs + (32 * db) * 128); }
            const bool have_next = (half == 0) || (t + 1 < NT);
            { const LAS unsigned char* kbase = (half == 0) ? (Kb + kc + 32 * 128) : (Kb + kn);
              if (have_next) {
#pragma unroll
                  for (int ks = 0; ks < 4; ++ks) kf[ks] = *(const LAS bf16x8*)(kbase + kso[ks]); } }
            float csx, c2;
            sm_max_phase(s, btab, t * 64 + 32 * half, q0w, r, hh, cs, m, lsum, O, csx, c2);
            float rs0 = 0.f, rs1 = 0.f;
#pragma unroll
            for (int i = 0; i < 16; ++i) sn[i] = 0.f;
            DF_FENCE;
            sn = MFMA32(kf[0], qf[0], sn); DF_EXP2(0); DF_FENCE;
            sn = MFMA32(kf[1], qf[1], sn); DF_EXP2(2); DF_FENCE;
            sn = MFMA32(kf[2], qf[2], sn); DF_EXP2(4); DF_FENCE;
            sn = MFMA32(kf[3], qf[3], sn); DF_EXP2(6); DF_FENCE;
            const bf16x8 pf0 = pack8(s, 0);
            O[0] = MFMA32(vf[0], pf0, O[0]); DF_EXP2(8); DF_FENCE;
            O[1] = MFMA32(vf[1], pf0, O[1]); DF_EXP2(10); DF_FENCE;
            O[2] = MFMA32(vf[2], pf0, O[2]); DF_EXP2(12); DF_FENCE;
            O[3] = MFMA32(vf[3], pf0, O[3]); DF_EXP2(14); DF_FENCE;
            const bf16x8 pf1 = pack8(s, 1);
            O[0] = MFMA32(vf[4], pf1, O[0]); O[1] = MFMA32(vf[5], pf1, O[1]); O[2] = MFMA32(vf[6], pf1, O[2]); O[3] = MFMA32(vf[7], pf1, O[3]);
            lsum += rs0 + rs1;
            s = sn;
        }
        asm volatile("s_waitcnt vmcnt(0)" ::: "memory");
        __syncthreads();
        const int tmp = kc; kc = kn; kn = kw; kw = tmp;
    }
    const float lt = lsum + __shfl_xor(lsum, 32), inv = 1.0f / lt;
#pragma unroll
    for (int db = 0; db < 4; ++db) O[db] *= inv;
}
#undef DF_EXP2
#undef DF_FENCE
DI void diffattn_item(const Params& p, int l, int item, LAS unsigned char* lds) {
    int tid = tidx(); asm volatile("" : "+v"(tid)); const int wave = __builtin_amdgcn_readfirstlane(tid >> 6), lane = tid & 63, r = lane & 31, hh = lane >> 5;
    const int qt = item >> 3, h = item & 7, q0w = qt * 256 + wave * 32;
    LAS float* btab = (LAS float*)(lds + LDS_MAIN);
    const float* bias = (const float*)(p.ws + WS_BIAS) + (24 + h) * 2049;
    for (int i = tid; i < 2049; i += NTHR) btab[i] = bias[i];
    const float* dl = p.in[I_DLAM] + l * 256;
    float d01 = 0.f, d23 = 0.f;
    for (int i = 0; i < 64; ++i) { d01 += dl[i] * dl[64 + i]; d23 += dl[128 + i] * dl[192 + i]; }
    const float lam_init = 0.8f - 0.6f * expf(-0.3f * (float)l);
    const float lam = expf(d01) - expf(d23) + lam_init;
    const bf16_t* proj = (const bf16_t*)(p.ws + WS_PROJ); const bf16_t* vtc = (const bf16_t*)(p.ws + WS_VTC);
    f32x16 O0[4];
    const int q = q0w + r;
    float* ctmp = (float*)(p.ws + WS_CTMP) + (size_t)q * 1024 + h * 128 + 4 * hh;
    diff_flash2(proj, vtc, h, 0, q0w, lds, btab, O0);
#pragma unroll
    for (int db = 0; db < 4; ++db)
#pragma unroll
        for (int i4 = 0; i4 < 4; ++i4) { f32x4 o = {O0[db][4 * i4], O0[db][4 * i4 + 1], O0[db][4 * i4 + 2], O0[db][4 * i4 + 3]}; *(f32x4*)(ctmp + 32 * db + 8 * i4) = o; }
    diff_flash2(proj, vtc, h, 1, q0w, lds, btab, O0);
    float ss = 0.f;
#pragma unroll
    for (int db = 0; db < 4; ++db)
#pragma unroll
        for (int i4 = 0; i4 < 4; ++i4) { const f32x4 o0 = *(const f32x4*)(ctmp + 32 * db + 8 * i4);
#pragma unroll
            for (int e = 0; e < 4; ++e) { const float o = o0[e] - lam * O0[db][4 * i4 + e]; O0[db][4 * i4 + e] = o; ss += o * o; } }
    ss += __shfl_xor(ss, 32);
    const float rn = rsqrtf(ss * (1.0f / 128.0f) + 1e-6f) * (1.0f - lam_init);
    const float* dg = p.in[I_DG] + l * 128;
    bf16_t* cout = (bf16_t*)(p.ws + WS_BR) + (size_t)2 * S * 1024;
#pragma unroll
    for (int db = 0; db < 4; ++db)
#pragma unroll
        for (int i4 = 0; i4 < 4; ++i4) {
            const int d0 = 32 * db + 8 * i4 + 4 * hh;
            const f32x4 g4 = *(const f32x4*)(dg + d0);
            const u32x2 gt = *(const u32x2*)(proj + PIDX(q, C_CGATE + h * 128 + d0));
            const float y0 = O0[db][4 * i4 + 0] * rn * g4[0] * silu_f(bflo(gt[0])), y1 = O0[db][4 * i4 + 1] * rn * g4[1] * silu_f(bfhi(gt[0]));
            const float y2 = O0[db][4 * i4 + 2] * rn * g4[2] * silu_f(bflo(gt[1])), y3 = O0[db][4 * i4 + 3] * rn * g4[3] * silu_f(bfhi(gt[1]));
            u32x2 o = {pk2(y0, y1), pk2(y2, y3)};
            *(u32x2*)(cout + (size_t)q * 1024 + h * 128 + d0) = o;
        }
    __syncthreads();
}

DI void mixA_wave_item(const Params& p, int wi, int lane, const LAS float* tb) {
    asm volatile("" : "+v"(lane));
    const int g = wi >> 11, rem = wi & 2047, h = rem >> 8, qb = rem & 255;
    const int sh = 2 * g, n = S >> sh, nbq = 256 >> sh, res = qb / nbq, m0 = (qb % nbq) * 32;
    const int r = lane & 31, hh = lane >> 5;
    const bf16_t* proj = (const bf16_t*)(p.ws + WS_PROJ);
    const int qpos = ((m0 + r) << sh) + res;
    bf16x8 qf[8];
    { const bf16_t* qp = proj + PIDX(qpos, g * 3072 + h * 128 + 8 * hh);
#pragma unroll
      for (int ks = 0; ks < 8; ++ks) qf[ks] = *(const bf16x8*)(qp + 16 * ks); }
    f32x16 O[4];
#pragma unroll
    for (int db = 0; db < 4; ++db)
#pragma unroll
        for (int i = 0; i < 16; ++i) O[db][i] = 0.f;
    float m = -1e30f, lsum = 0.f;
    const float cs = 0.08838834764831845f * LOG2E;
    const LAS float* tbl = tb + 31 - r + 4 * hh;
    const bf16_t* vt = (const bf16_t*)(p.ws + WS_VTA) + (size_t)((g * 8 + h) * 128) * S + res * n;
    bf16x8 kf[8];
    { const int mk0r = m0 - 64; const int mk0 = (mk0r >= 0 && mk0r < n) ? mk0r : m0;
      const bf16_t* kp = proj + PIDX(((mk0 + r) << sh) + res, g * 3072 + 1024 + h * 128 + 8 * hh);
#pragma unroll
      for (int ks = 0; ks < 8; ++ks) kf[ks] = *(const bf16x8*)(kp + 16 * ks); }
#pragma unroll 1
    for (int kb = 0; kb < 5; ++kb) {
        const int mk0r = m0 - 64 + 32 * kb;
        const bool blk_ok = (mk0r >= 0) && (mk0r < n);
        const int mk0 = blk_ok ? mk0r : m0;
        bf16x8 vfr[2][4];
#pragma unroll
        for (int sidx = 0; sidx < 2; ++sidx)
#pragma unroll
            for (int db = 0; db < 4; ++db) {
                const bf16_t* vp = vt + (size_t)(32 * db + r) * S + mk0 + 16 * sidx + 4 * hh;
                const s16x4 lo = *(const s16x4*)vp, hi = *(const s16x4*)(vp + 8);
                vfr[sidx][db] = __builtin_shufflevector(lo, hi, 0, 1, 2, 3, 4, 5, 6, 7);
            }
        __builtin_amdgcn_sched_barrier(0);
        f32x16 s;
#pragma unroll
        for (int i = 0; i < 16; ++i) s[i] = 0.f;
#pragma unroll
        for (int ks = 0; ks < 8; ++ks) s = MFMA32(kf[ks], qf[ks], s);
        if (kb < 4) {
            const int nk0r = m0 - 64 + 32 * (kb + 1); const int nk0 = (nk0r >= 0 && nk0r < n) ? nk0r : m0;
            const bf16_t* kp = proj + PIDX(((nk0 + r) << sh) + res, g * 3072 + 1024 + h * 128 + 8 * hh);
#pragma unroll
            for (int ks = 0; ks < 8; ++ks) kf[ks] = *(const bf16x8*)(kp + 16 * ks);
        }
        __builtin_amdgcn_sched_barrier(0);
        float mx = -INFINITY;
#pragma unroll
        for (int i = 0; i < 16; ++i) { const int rel = mk0r + crow(i, hh) - (m0 + r); const bool valid = blk_ok && (rel <= 64) && (rel >= -64);
            const float bv = tbl[32 * kb + (i & 3) + 8 * (i >> 2)];
            const float v = valid ? (s[i] * cs + bv) : -INFINITY; s[i] = v; mx = fmaxf(mx, v); }
        mx = fmaxf(mx, __shfl_xor(mx, 32));
        const float mnew = fmaxf(m, mx), alpha = __builtin_amdgcn_exp2f(m - mnew);
        m = mnew;
        float rs = 0.f;
#pragma unroll
        for (int i = 0; i < 16; ++i) { s[i] = __builtin_amdgcn_exp2f(s[i] - mnew); rs += s[i]; }
        lsum = lsum * alpha + rs;
#pragma unroll
        for (int db = 0; db < 4; ++db) O[db] *= alpha;
#pragma unroll
        for (int sidx = 0; sidx < 2; ++sidx) {
            const bf16x8 pf = pack8(s, sidx);
#pragma unroll
            for (int db = 0; db < 4; ++db) O[db] = MFMA32(vfr[sidx][db], pf, O[db]);
        }
    }
    const float lt = lsum + __shfl_xor(lsum, 32), inv = 1.0f / lt;
    float* oa = (float*)(p.ws + WS_OA) + ((size_t)g * S + qpos) * 1024 + h * 128;
#pragma unroll
    for (int db = 0; db < 4; ++db)
#pragma unroll
        for (int i4 = 0; i4 < 4; ++i4) {
            const int d0 = 32 * db + 8 * i4 + 4 * hh;
            f32x4 o = {O[db][4 * i4] * inv, O[db][4 * i4 + 1] * inv, O[db][4 * i4 + 2] * inv, O[db][4 * i4 + 3] * inv};
            *(f32x4*)(oa + d0) = o;
        }
    if (hh == 0) ((float*)(p.ws + WS_LSEA))[((size_t)g * S + qpos) * 8 + h] = m + __log2f(lt);
}

DI void phase_post(const Params& p, LAS unsigned char* lds) {
    const int tid = tidx();
    const bf16_t* proj = (const bf16_t*)(p.ws + WS_PROJ);
    bf16_t* aout = (bf16_t*)(p.ws + WS_BR); bf16_t* bout = aout + (size_t)S * 1024;
    const float* oa = (const float*)(p.ws + WS_OA); const float* lse = (const float*)(p.ws + WS_LSEA);
    for (int idx0 = blockIdx.x * NTHR + tid; idx0 < S * 256; idx0 += 4 * gridDim.x * NTHR) {
        float l0[4], l1[4], l2[4]; f32x4 o0[4], o1[4], o2[4]; u32x2 gt[4];
#pragma unroll
        for (int u = 0; u < 4; ++u) { const int idx = idx0 + u * gridDim.x * NTHR; const int pos = idx >> 8, c4 = idx & 255, h = c4 >> 5, col = c4 * 4;
            l0[u] = lse[((size_t)0 * S + pos) * 8 + h]; l1[u] = lse[((size_t)1 * S + pos) * 8 + h]; l2[u] = lse[((size_t)2 * S + pos) * 8 + h];
            o0[u] = *(const f32x4*)(oa + ((size_t)0 * S + pos) * 1024 + col); o1[u] = *(const f32x4*)(oa + ((size_t)1 * S + pos) * 1024 + col); o2[u] = *(const f32x4*)(oa + ((size_t)2 * S + pos) * 1024 + col);
            gt[u] = *(const u32x2*)(proj + PIDX(pos, C_AGATE + col)); }
#pragma unroll
        for (int u = 0; u < 4; ++u) { const int idx = idx0 + u * gridDim.x * NTHR; const int pos = idx >> 8, c4 = idx & 255, col = c4 * 4;
            const float mx = fmaxf(l0[u], fmaxf(l1[u], l2[u]));
            const float w0 = __builtin_amdgcn_exp2f(l0[u] - mx), w1 = __builtin_amdgcn_exp2f(l1[u] - mx), w2 = __builtin_amdgcn_exp2f(l2[u] - mx);
            const float inv = __builtin_amdgcn_rcpf(w0 + w1 + w2);
            const f32x4 o = (o0[u] * w0 + o1[u] * w1 + o2[u] * w2) * inv;
            u32x2 ov = {pk2(o[0] * silu_f(bflo(gt[u][0])), o[1] * silu_f(bfhi(gt[u][0]))), pk2(o[2] * silu_f(bflo(gt[u][1])), o[3] * silu_f(bfhi(gt[u][1])))};
            *(u32x2*)(aout + (size_t)pos * 1024 + col) = ov; }
    }
    LAS float* tile = (LAS float*)lds;
    const float* z2t = (const float*)(p.ws + WS_Z2T);
    for (int it0 = blockIdx.x * 4; it0 < 128 * 16; it0 += gridDim.x * 4) {
        __syncthreads();
        f32x4 v[4][2];
#pragma unroll
        for (int u = 0; u < 4; ++u) { const int it = it0 + u, t0 = (it >> 4) * 64, c0 = (it & 15) * 64;
#pragma unroll
            for (int k = 0; k < 2; ++k) { const int e = tid + NTHR * k; const int ci = e >> 4, t4 = (e & 15) * 4; v[u][k] = *(const f32x4*)(z2t + (size_t)(c0 + ci) * S + t0 + t4); } }
#pragma unroll
        for (int u = 0; u < 4; ++u)
#pragma unroll
            for (int k = 0; k < 2; ++k) { const int e = tid + NTHR * k; const int ci = e >> 4, t4 = (e & 15) * 4; LAS float* d = tile + u * 4160 + ci * 65 + t4;
                d[0] = v[u][k][0]; d[1] = v[u][k][1]; d[2] = v[u][k][2]; d[3] = v[u][k][3]; }
        __syncthreads();
        u32x2 gt[4][2];
#pragma unroll
        for (int u = 0; u < 4; ++u) { const int it = it0 + u, t0 = (it >> 4) * 64, c0 = (it & 15) * 64;
#pragma unroll
            for (int k = 0; k < 2; ++k) { const int e = tid + NTHR * k; const int ti = e >> 4, cc = (e & 15) * 4; gt[u][k] = *(const u32x2*)(proj + PIDX(t0 + ti, C_BGATE + c0 + cc)); } }
#pragma unroll
        for (int u = 0; u < 4; ++u) { const int it = it0 + u, t0 = (it >> 4) * 64, c0 = (it & 15) * 64;
#pragma unroll
            for (int k = 0; k < 2; ++k) { const int e = tid + NTHR * k; const int ti = e >> 4, cc = (e & 15) * 4; const LAS float* sp = tile + u * 4160 + cc * 65 + ti;
                const float y0 = sp[0] * silu_f(bflo(gt[u][k][0])), y1 = sp[65] * silu_f(bfhi(gt[u][k][0]));
                const float y2 = sp[130] * silu_f(bflo(gt[u][k][1])), y3 = sp[195] * silu_f(bfhi(gt[u][k][1]));
                u32x2 ov = {pk2(y0, y1), pk2(y2, y3)};
                *(u32x2*)(bout + (size_t)(t0 + ti) * 1024 + c0 + cc) = ov; } }
    }
    __syncthreads();
}

#ifndef REP_GEMMIN
#define REP_GEMMIN 1
#endif
#ifndef REP_DIFF
#define REP_DIFF 1
#endif
#ifndef REP_HYENA
#define REP_HYENA 1
#endif
#ifndef REP_MIXA
#define REP_MIXA 1
#endif
#ifndef REP_PRO
#define REP_PRO 1
#endif
#ifndef REP_SPEC
#define REP_SPEC 1
#endif
#ifndef REP_MISC
#define REP_MISC 1
#endif
#ifndef REP_PROJ
#define REP_PROJ 1
#endif
constexpr int NPH = 3 + 6 * DEPTH + 1;
typedef const Params __attribute__((address_space(4)))* ParamsK;
DI Params ldp(ParamsK pc) {
    asm volatile("" : "+s"(pc));
    Params q;
#pragma unroll
    for (int i = 0; i < 18; ++i) q.in[i] = pc->in[i];
    q.out = pc->out; q.ws = pc->ws; q.ph_lo = pc->ph_lo; q.ph_hi = pc->ph_hi;
    return q;
}
DI void run_phase(ParamsK pc, int ph, LAS unsigned char* lds) {
    if (ph == 0) { for (int rep = 0; rep < REP_PRO; ++rep) { const Params p = ldp(pc); phase_prologue(p, lds); __syncthreads(); } return; }
    if (ph == 1) { const Params p = ldp(pc); phase_tgen(p); return; }
    if (ph == 2) { for (int rep = 0; rep < REP_SPEC; ++rep) { const Params p = ldp(pc); for (int it = blockIdx.x; it < DEPTH * 2 * 256; it += gridDim.x) spectra_item(p, it, lds); } return; }
    if (ph == NPH - 1) { const Params p = ldp(pc); phase_rmsnorm((const float*)(p.ws + WS_X), p.in[I_FINALG], nullptr, p.out); return; }
    const int l = (ph - 3) / 6, sp = (ph - 3) % 6;
    if (sp == 0) { for (int rep = 0; rep < REP_MISC; ++rep) { const Params p = ldp(pc); phase_rmsnorm((l == 0) ? p.in[I_X] : (const float*)(p.ws + WS_X), p.in[I_NORMG] + l * D, (bf16_t*)(p.ws + WS_H), nullptr); } return; }
    if (sp == 1) {
        const Params p = ldp(pc);
        pg8::Gemm g{(const bf16_t*)(p.ws + WS_H), (const bf16_t*)(p.ws + WS_WIN) + (size_t)l * NIN * D, S, NIN, D};
        pg8::StaticOrder so; so.init(S, NIN, gridDim.x, blockIdx.x);
        EpiIn e{(bf16_t*)(p.ws + WS_PROJ), (bf16_t*)(p.ws + WS_VTA), (bf16_t*)(p.ws + WS_VTC), (float*)(p.ws + WS_BINT), lds + 131072};
#pragma unroll 1
        for (int rep = 0; rep < REP_GEMMIN; ++rep) { pg8::gemm_phase(lds, g, so, e); __syncthreads(); }
        return;
    }
    if (sp == 2) {
#pragma unroll 1
        for (int it = blockIdx.x; it < 256 + 256 + 768; it += gridDim.x) {
            int l2 = l; asm volatile("" : "+s"(l2));
            const Params p = ldp(pc);
            if (it < 256) { for (int rep = 0; rep < REP_DIFF; ++rep) diffattn_item(p, l2, it, lds); }
            else if (it < 512) { for (int rep = 0; rep < REP_HYENA; ++rep) hyena_item(p, l2, it - 256, lds); }
            else {
                const int tid2 = tidx(), wi0 = (it - 512) * NWAVES, g = wi0 >> 11, h = (wi0 & 2047) >> 8;
                LAS float* tb = (LAS float*)lds;
                __syncthreads();
                if (tid2 < 192) { const int rel = tid2 - 95; float v = 0.f;
                    if (rel >= -64 && rel <= 64) v = ((const float*)(p.ws + WS_BIAS))[(g * 8 + h) * 2049 + min(max(rel << (2 * g), -1024), 1024) + 1024];
                    tb[tid2] = v; }
                __syncthreads();
                for (int rep = 0; rep < REP_MIXA; ++rep) mixA_wave_item(p, wi0 + (tid2 >> 6), tid2 & 63, tb);
            }
        }
        return;
    }
    if (sp == 3) { for (int rep = 0; rep < REP_MISC; ++rep) { const Params p = ldp(pc); phase_post(p, lds); } return; }
    if (sp == 4) {
#pragma unroll 1
        for (int rep = 0; rep < REP_PROJ; ++rep) {
            const Params p = ldp(pc);
            pg8::Gemm g{(const bf16_t*)(p.ws + WS_BR), (const bf16_t*)(p.ws + WS_WPR) + (size_t)(l * 3) * D * 1024, 3 * S, 3 * D, 1024};
            ProjOrder po; po.so.init(S, D, gridDim.x, blockIdx.x);
            EpiProj e{(const bf16_t*)(p.ws + WS_PROJ), p.in[I_MERGEB] + (size_t)l * 3 * D, (float*)(p.ws + WS_YF), (bf16_t*)(p.ws + WS_YB)};
            pg8::gemm_phase(lds, g, po, e);
            __syncthreads();
        }
        return;
    }
    {
        const Params p = ldp(pc);
        pg8::Gemm g{(const bf16_t*)(p.ws + WS_YB), (const bf16_t*)(p.ws + WS_WOUT) + (size_t)l * D * D, S, D, D};
        pg8::StaticOrder so; so.init(S, D, gridDim.x, blockIdx.x);
        EpiOut e{(l == 0) ? p.in[I_X] : (const float*)(p.ws + WS_X), (float*)(p.ws + WS_X)};
#pragma unroll 1
        for (int rep = 0; rep < ((l == 0) ? REP_MISC : 1); ++rep) { pg8::gemm_phase(lds, g, so, e); __syncthreads(); }
    }
}


#define XB_TMO      128
#define XB_XCNT(j)  (256  + 64 * (j))
#define XB_XSUB(j)  (1280 + 64 * (j))
#define XB_XGEN(j)  (2304 + 64 * (j))
#define XB_TOP      3328
#define XB_TOPGEN   3392
#define XCD_BAR_WORDS 3456
#define XB_SPIN_CAP (1u << 18)
DI unsigned xb_ld(unsigned* p)              { return __hip_atomic_load(p, __ATOMIC_RELAXED, __HIP_MEMORY_SCOPE_AGENT); }
DI unsigned xb_add(unsigned* p, unsigned v) { return __hip_atomic_fetch_add(p, v, __ATOMIC_RELAXED, __HIP_MEMORY_SCOPE_AGENT); }
DI unsigned xb_xcc_id() { return (unsigned)__builtin_amdgcn_s_getreg((3 << 11) | 20) & 0xFu; }
#define XB_SPIN(cond, bar) do { unsigned _sp = 0; while (cond) { __builtin_amdgcn_s_sleep(1); \
    if ((++_sp & 255u) == 0u) { if (xb_ld(&(bar)[XB_TMO])) break; if (_sp > XB_SPIN_CAP) { atomicAdd(&(bar)[XB_TMO], 1u); break; } } } } while (0)
struct XcdBarrier { unsigned* bar; unsigned x; volatile LAS unsigned* st; };
DI XcdBarrier xcd_barrier_post(unsigned* bar, volatile LAS unsigned* st) {
    XcdBarrier b; b.bar = bar; b.x = xb_xcc_id(); b.st = st;
    if (threadIdx.x == 0) (void)xb_add(&bar[XB_XCNT(b.x)], 1u);
    return b;
}
DI void xcd_barrier_complete(unsigned* bar, unsigned x, unsigned& nloc, unsigned& nx) {
    const unsigned G = gridDim.x * gridDim.y * gridDim.z;
    unsigned sum, cnt, mine, sp = 0u;
    for (;;) {
        sum = 0u; cnt = 0u; mine = 0u;
#pragma unroll
        for (unsigned j = 0; j < 16; ++j) { const unsigned c = xb_ld(&bar[XB_XCNT(j)]); sum += c; cnt += (c > 0u) ? 1u : 0u; mine = (j == x) ? c : mine; }
        if (sum == G) break;
        __builtin_amdgcn_s_sleep(1);
        if ((++sp & 255u) == 0u) { if (xb_ld(&bar[XB_TMO])) break; if (sp > XB_SPIN_CAP) { atomicAdd(&bar[XB_TMO], 1u); break; } }
    }
    nloc = mine > 0u ? mine : 1u; nx = cnt > 0u ? cnt : 1u;
}
DI void xcd_barrier(const XcdBarrier& b) {
    asm volatile("s_waitcnt vmcnt(0)" ::: "memory");
    __syncthreads();
    if (threadIdx.x == 0) {
        unsigned* bar = b.bar;
        __builtin_amdgcn_s_waitcnt(0);
        unsigned nloc = b.st[0], nx = b.st[1];
        if (nloc == 0u) { xcd_barrier_complete(bar, b.x, nloc, nx); b.st[0] = nloc; b.st[1] = nx; }
        const unsigned old = xb_add(&bar[XB_XSUB(b.x)], 1u);
        const unsigned gen = old / nloc;
        if (old + 1u == (gen + 1u) * nloc) {
            __builtin_amdgcn_fence(__ATOMIC_RELEASE, "agent");
            asm volatile("s_waitcnt vmcnt(0)" ::: "memory");
            const unsigned og = xb_add(&bar[XB_TOP], 1u);
            const unsigned tg = og / nx;
            if (og + 1u == (tg + 1u) * nx) xb_add(&bar[XB_TOPGEN], 1u);
            else XB_SPIN(xb_ld(&bar[XB_TOPGEN]) == tg, bar);
            __builtin_amdgcn_fence(__ATOMIC_ACQUIRE, "agent");
            xb_add(&bar[XB_XGEN(b.x)], 1u);
            asm volatile("s_waitcnt vmcnt(0)" ::: "memory");
        } else {
            XB_SPIN(xb_ld(&bar[XB_XGEN(b.x)]) == gen, bar);
            __builtin_amdgcn_fence(__ATOMIC_ACQUIRE, "agent");
            asm volatile("s_waitcnt vmcnt(0)" ::: "memory");
        }
    }
    __syncthreads();
}

__global__ void __launch_bounds__(512, 2) mega_kernel(Params p) {
#if defined(__HIP_DEVICE_COMPILE__)
    extern __shared__ __attribute__((aligned(16))) unsigned char shm[];
    LAS unsigned char* lds = (LAS unsigned char*)shm;
    cg::grid_group grid = cg::this_grid();
    const int ph_lo = p.ph_lo, ph_hi = p.ph_hi;
    volatile LAS unsigned* st = (volatile LAS unsigned*)(lds + LDS_BYTES - 16);
    if (threadIdx.x == 0) { st[0] = 0u; st[1] = 0u; }
    __syncthreads();
    const XcdBarrier xb = xcd_barrier_post((unsigned*)(p.ws + WS_BAR), st);
#pragma unroll 1
    for (int ph = ph_lo; ph < ph_hi; ++ph) {
        ParamsK pc = (ParamsK)__builtin_amdgcn_kernarg_segment_ptr();
        run_phase(pc, ph, lds);
        if (ph + 1 < ph_hi) { if (ph == ph_lo) grid.sync(); else xcd_barrier(xb); }
    }
#endif
}

#ifndef N_LAUNCH_MODE
#define N_LAUNCH_MODE 1
#endif
extern "C" void kernel_launch(void* const* d_in, const int* in_sizes, int n_in, void* d_out, int out_size, void* d_ws, size_t ws_size, hipStream_t stream) {
    static int grid = 0;
    if (grid == 0) {
        int dev = 0, cus = 0;
        if (hipGetDevice(&dev) != hipSuccess || hipDeviceGetAttribute(&cus, hipDeviceAttributeMultiprocessorCount, dev) != hipSuccess) { fprintf(stderr, "kernel_launch: device query failed\n"); grid = -1; return; }
        if (hipFuncSetAttribute((const void*)mega_kernel, hipFuncAttributeMaxDynamicSharedMemorySize, LDS_BYTES) != hipSuccess) { fprintf(stderr, "kernel_launch: hipFuncSetAttribute failed\n"); grid = -1; return; }
        int per_cu = 0;
        if (hipOccupancyMaxActiveBlocksPerMultiprocessor(&per_cu, (const void*)mega_kernel, NTHR, LDS_BYTES) != hipSuccess || per_cu < 1) { fprintf(stderr, "kernel_launch: occupancy query says %d\n", per_cu); (void)hipGetLastError(); }
        if (n_in != 18 || ws_size < WS_END) { fprintf(stderr, "kernel_launch: n_in %d ws %zu (need %zu)\n", n_in, ws_size, (size_t)WS_END); grid = -1; return; }
        grid = cus;
    }
    if (grid < 0) return;
    Params p{};
    for (int i = 0; i < 18; ++i) p.in[i] = (const float*)d_in[i];
    p.out = (float*)d_out; p.ws = (unsigned char*)d_ws;
    if (hipMemsetAsync((unsigned char*)d_ws + WS_BAR, 0, 16384, stream) != hipSuccess) { fprintf(stderr, "kernel_launch: memset of barrier words failed\n"); return; }
#if N_LAUNCH_MODE == 1
    p.ph_lo = 0; p.ph_hi = NPH;
    void* args[] = {&p};
    hipError_t e = hipLaunchCooperativeKernel((const void*)mega_kernel, dim3(grid), dim3(NTHR), args, LDS_BYTES, stream);
    if (e != hipSuccess) fprintf(stderr, "cooperative launch failed: %s (grid %d)\n", hipGetErrorString(e), grid);
#else
    for (int ph = 0; ph < NPH; ++ph) {
        p.ph_lo = ph; p.ph_hi = ph + 1;
        hipLaunchKernelGGL(mega_kernel, dim3(grid), dim3(NTHR), LDS_BYTES, stream, p);
    }
#endif
}
```

```cpp
#include <hip/hip_runtime.h>
#include <hip/hip_cooperative_groups.h>
#include <cstdio>
namespace cg = cooperative_groups;
#define DI __device__ __forceinline__
#define LAS __attribute__((address_space(3)))
typedef unsigned short bf16_t;
typedef short bf16x8 __attribute__((ext_vector_type(8)));
typedef short s16x4 __attribute__((ext_vector_type(4)));
typedef float f32x4 __attribute__((ext_vector_type(4)));
typedef float f32x16 __attribute__((ext_vector_type(16)));
typedef float f32x2 __attribute__((ext_vector_type(2)));
typedef float cf __attribute__((ext_vector_type(2)));
typedef __bf16 bf16x2n __attribute__((ext_vector_type(2)));
typedef unsigned u32x2 __attribute__((ext_vector_type(2)));
typedef unsigned u32x4 __attribute__((ext_vector_type(4)));

DI unsigned pk2(float lo, float hi) { f32x2 v = {lo, hi}; return __builtin_bit_cast(unsigned, __builtin_convertvector(v, bf16x2n)); }
DI float bflo(unsigned u) { return __uint_as_float(u << 16); }
DI float bfhi(unsigned u) { return __uint_as_float(u & 0xffff0000u); }
DI float silu_f(float x) { return x * __builtin_amdgcn_rcpf(1.0f + __expf(-x)); }
DI float sigm_f(float x) { return __builtin_amdgcn_rcpf(1.0f + __expf(-x)); }

DI int tidx() { int t = threadIdx.x; asm volatile("" : "+v"(t)); return t; }

constexpr int S = 8192, D = 2048, NIN = 24576, DEPTH = 4;
constexpr int C_AGATE = 9216, C_BIN = 10240, C_BGATE = 13312, C_CQKV = 14336, C_CGATE = 17408, C_MERGE = 18432;
constexpr float LOG2E = 1.4426950408889634f;
constexpr int NTHR = 512, NWAVES = 8;
constexpr int LDS_MAIN = 143360, LDS_AUX = 16384, LDS_BYTES = LDS_MAIN + LDS_AUX;

constexpr size_t WS_WIN  = 0;
constexpr size_t WS_WPR  = WS_WIN  + (size_t)DEPTH * NIN * D * 2;
constexpr size_t WS_WOUT = WS_WPR  + (size_t)DEPTH * 3 * D * 1024 * 2;
constexpr size_t WS_SPEC = WS_WOUT + (size_t)DEPTH * D * D * 2;
constexpr size_t WS_HID2 = WS_SPEC + (size_t)DEPTH * 2 * 512 * 8208 * 16;
constexpr size_t WS_BIAS = WS_HID2 + (size_t)DEPTH * S * 64 * 4;
constexpr size_t WS_X    = WS_BIAS + 524288;
constexpr size_t WS_H    = WS_X    + (size_t)S * D * 4;
constexpr size_t WS_PROJ = WS_H    + (size_t)S * D * 2;
constexpr size_t WS_BINT = WS_PROJ + (size_t)S * NIN * 2;
constexpr size_t WS_VTA  = WS_BINT + (size_t)3072 * S * 4;
constexpr size_t WS_VTC  = WS_VTA  + (size_t)3 * 1024 * S * 2;
constexpr size_t WS_OA   = WS_VTC  + (size_t)1024 * S * 2;
constexpr size_t WS_LSEA = WS_OA   + (size_t)3 * S * 1024 * 4;
constexpr size_t WS_Z2T  = WS_LSEA + (size_t)3 * S * 8 * 4;
constexpr size_t WS_BR   = WS_Z2T  + (size_t)1024 * S * 4;
constexpr size_t WS_YF   = WS_BR   + (size_t)3 * S * 1024 * 2;
constexpr size_t WS_YB   = WS_YF   + (size_t)S * D * 4;
constexpr size_t WS_CTMP = WS_YB   + (size_t)S * D * 2;
constexpr size_t WS_BAR  = WS_CTMP + (size_t)S * 1024 * 4;
constexpr size_t WS_TT   = WS_BAR + 16384;
constexpr size_t WS_END  = WS_TT + (size_t)DEPTH * 4096 * S * 4;

DI size_t PIDX(int row, int col) { return ((size_t)(col >> 8) * S + row) * 256 + (col & 255); }

struct Params {
    const float* in[18];
    float* out;
    unsigned char* ws;
    int ph_lo, ph_hi;
};
enum { I_X = 0, I_NORMG, I_FINALG, I_WIN, I_MERGEB, I_RELB, I_HYCONV, I_HYW1, I_HYB1, I_HYFREQ, I_HYW2, I_HYB2, I_HYW3, I_HYSKIP, I_DLAM, I_DG, I_WPROJ, I_WOUT };

namespace pg8 {
constexpr int BM = 256, BK = 64, HALF = 128, HTB = HALF * BK * 2, NXCD = 8, WGM = 8;
DI int lds_byte(int r, int c) { const int st = (r >> 4) * 2 + (c >> 5), rr = r & 15, cc = c & 31, ob = rr * 64 + cc * 2; return st * 1024 + (ob ^ (((ob >> 9) & 1) << 5)); }
DI void stage_rc(int b, int& R, int& C) { const int st = b / 1024, sb = b % 1024, swz = sb ^ (((sb >> 9) & 1) << 5); R = (st >> 1) * 16 + swz / 64; C = (st & 1) * 32 + (swz % 64) / 2; }
DI int perm32(int rho) { const int n = rho >> 4, i = rho & 15; return 8 * (i >> 2) + 4 * n + (i & 3); }
struct Unit { int pm, pn; };
struct Gemm { const bf16_t* A; const bf16_t* Bt; int M, N, K; };
struct StaticOrder {
    int nM, nN, nwg, G, c;
    DI void init(int M, int N, int G_, int c_) { nM = M / BM; nN = N / BM; nwg = nM * nN; G = G_; c = c_; }
    DI bool next(int i, Unit& u) const {
        const long L = (long)i * G + c; if (L >= nwg) return false;
        int wgid = (int)L; { const int q = nwg / NXCD, r = nwg % NXCD, xcd = wgid % NXCD, off = wgid / NXCD; wgid = (xcd < r ? xcd * (q + 1) : r * (q + 1) + (xcd - r) * q) + off; }
        const int nig = WGM * nN, gid = wgid / nig, fm = gid * WGM, gsz = (nM - fm) < WGM ? (nM - fm) : WGM;
        u.pm = fm + ((wgid % nig) % gsz); u.pn = (wgid % nig) / gsz; return true;
    }
};
template <class Epi, class Sched>
DI void gemm_phase(LAS unsigned char* lds, const Gemm g, const Sched& S, const Epi& E) {
    const int tid = tidx(), wid = __builtin_amdgcn_readfirstlane(tid >> 6), lane = tid & 63, wr = wid >> 2, wc = wid & 3, fr = lane & 15, fq = lane >> 4;
    const int K = g.K, nt = K / BK;
    unsigned voffA[2], voffB[2];
#pragma unroll
    for (int i = 0; i < 2; ++i) { int R, C; stage_rc(tid * 16 + i * 8192, R, C); const int Rb = Epi::PERM ? ((R & ~31) + perm32(R & 31)) : R; voffA[i] = (unsigned)(R * K + C) * 2u; voffB[i] = (unsigned)(Rb * K + C) * 2u; }
    const size_t kstep = (size_t)(BK * 2);
    const size_t hstep = (size_t)HALF * K * 2;
    const size_t tstep = 2 * hstep;
    const unsigned ldsw = (unsigned)wid * 1024u;
    const int aoff = lds_byte(wr * 64 + fr, fq * 8), boff = lds_byte(wc * 32 + fr, fq * 8);
#define PG8_SA(b, h) (((b) * 2 + (h)) * HTB)
#define PG8_SB(b, h) ((4 + (b) * 2 + (h)) * HTB)
#define PG8_STAGE(bufoff, gbase, voff) do { _Pragma("unroll") for (int _i = 0; _i < 2; ++_i) \
        __builtin_amdgcn_global_load_lds((const unsigned*)((const char*)(gbase) + (voff)[_i]), (LAS unsigned*)(lds + (bufoff) + ldsw + _i * 8192), 16, 0, 0); } while (0)
#define PG8_LDA(dst, b, h) do { _Pragma("unroll") for (int m = 0; m < 4; ++m) _Pragma("unroll") for (int k = 0; k < 2; ++k) dst[m][k] = *(const LAS bf16x8*)(lds + PG8_SA(b, h) + aoff + m * 2048 + k * 1024); } while (0)
#define PG8_LDB(dst, b, h) do { _Pragma("unroll") for (int n = 0; n < 2; ++n) _Pragma("unroll") for (int k = 0; k < 2; ++k) dst[n][k] = *(const LAS bf16x8*)(lds + PG8_SB(b, h) + boff + n * 2048 + k * 1024); } while (0)
#define PG8_MMA(ai, bj, At, Bt) do { __builtin_amdgcn_s_setprio(1); _Pragma("unroll") for (int m = 0; m < 4; ++m) _Pragma("unroll") for (int n = 0; n < 2; ++n) _Pragma("unroll") for (int k = 0; k < 2; ++k) \
        acc[ai][bj][m][n] = __builtin_amdgcn_mfma_f32_16x16x32_bf16(Bt[n][k], At[m][k], acc[ai][bj][m][n], 0, 0, 0); __builtin_amdgcn_s_setprio(0); } while (0)
#define PG8_WAIT_V(n) asm volatile("s_waitcnt vmcnt(" #n ")" ::: "memory")
#define PG8_WAIT_L(n) asm volatile("s_waitcnt lgkmcnt(" #n ")" ::: "memory")
#define PG8_BAR __builtin_amdgcn_s_barrier()
#define PG8_SCHED __builtin_amdgcn_sched_barrier(0)
    Unit cur, nxt; int ui = 0;
    if (!S.next(0, cur)) return;
    f32x4 acc[2][2][4][2];
#pragma unroll
    for (int a = 0; a < 2; ++a)
#pragma unroll
        for (int b = 0; b < 2; ++b)
#pragma unroll
            for (int m = 0; m < 4; ++m)
#pragma unroll
                for (int n = 0; n < 2; ++n) acc[a][b][m][n] = (f32x4){0.f, 0.f, 0.f, 0.f};
    bf16x8 At[4][2], B0[2][2], B1[2][2];
    const char* cA = (const char*)g.A + (size_t)cur.pm * tstep; const char* cB = (const char*)g.Bt + (size_t)cur.pn * tstep;
    PG8_STAGE(PG8_SB(0, 0), cB, voffB); PG8_STAGE(PG8_SA(0, 0), cA, voffA); PG8_STAGE(PG8_SB(0, 1), cB + hstep, voffB); PG8_STAGE(PG8_SA(0, 1), cA + hstep, voffA);
    if (wr == 1) PG8_BAR;
    PG8_WAIT_V(4); PG8_BAR;
    PG8_STAGE(PG8_SB(1, 0), cB + kstep, voffB); PG8_STAGE(PG8_SA(1, 0), cA + kstep, voffA); PG8_STAGE(PG8_SB(1, 1), cB + hstep + kstep, voffB);
    PG8_WAIT_V(6); PG8_BAR;
    for (;;) {
        const bool has_next = S.next(ui + 1, nxt);
        const char* nA = has_next ? (const char*)g.A + (size_t)nxt.pm * tstep : cA; const char* nB = has_next ? (const char*)g.Bt + (size_t)nxt.pn * tstep : cB;
        for (int t = 0; t < nt; t += 2) {
            const bool last = (t == nt - 2);
            const char* a1 = cA + (size_t)(t + 1) * kstep;
            const char* a2 = last ? nA : cA + (size_t)(t + 2) * kstep; const char* b2 = last ? nB : cB + (size_t)(t + 2) * kstep;
            const char* a3 = a2 + kstep; const char* b3 = b2 + kstep;
            PG8_LDB(B0, 0, 0); PG8_SCHED; PG8_LDA(At, 0, 0); PG8_STAGE(PG8_SA(1, 1), a1 + hstep, voffA);
            PG8_WAIT_L(8); PG8_BAR; PG8_WAIT_L(0); PG8_MMA(0, 0, At, B0); PG8_BAR; PG8_SCHED;
            PG8_LDB(B1, 0, 1); PG8_STAGE(PG8_SB(0, 0), b2, voffB);
            PG8_BAR; PG8_WAIT_L(0); PG8_MMA(0, 1, At, B1); PG8_BAR;
            PG8_LDA(At, 0, 1); PG8_STAGE(PG8_SA(0, 0), a2, voffA);
            PG8_BAR; PG8_WAIT_L(0); PG8_MMA(1, 0, At, B0); PG8_BAR; PG8_SCHED;
            PG8_STAGE(PG8_SB(0, 1), b2 + hstep, voffB);
            PG8_WAIT_V(6); PG8_BAR; PG8_MMA(1, 1, At, B1); PG8_BAR;
            PG8_LDB(B0, 1, 0); PG8_SCHED; PG8_LDA(At, 1, 0); PG8_STAGE(PG8_SA(0, 1), a2 + hstep, voffA);
            PG8_WAIT_L(8); PG8_BAR; PG8_WAIT_L(0); PG8_MMA(0, 0, At, B0); PG8_BAR; PG8_SCHED;
            PG8_LDB(B1, 1, 1); PG8_STAGE(PG8_SB(1, 0), b3, voffB);
            PG8_BAR; PG8_WAIT_L(0); PG8_MMA(0, 1, At, B1); PG8_BAR;
            PG8_LDA(At, 1, 1); PG8_STAGE(PG8_SA(1, 0), a3, voffA);
            PG8_BAR; PG8_WAIT_L(0); PG8_MMA(1, 0, At, B0); PG8_BAR; PG8_SCHED;
            PG8_STAGE(PG8_SB(1, 1), b3 + hstep, voffB);
            PG8_WAIT_V(6); PG8_BAR; PG8_MMA(1, 1, At, B1); PG8_BAR;
        }
        E(acc, cur, wr, wc, fr, fq);
        if (!has_next) break;
#pragma unroll
        for (int a = 0; a < 2; ++a)
#pragma unroll
            for (int b = 0; b < 2; ++b)
#pragma unroll
                for (int m = 0; m < 4; ++m)
#pragma unroll
                    for (int n = 0; n < 2; ++n) acc[a][b][m][n] = (f32x4){0.f, 0.f, 0.f, 0.f};
        cur = nxt; cA = nA; cB = nB; ++ui;
    }
    PG8_WAIT_V(0);
    if (wr == 0) PG8_BAR;
    PG8_BAR;
#undef PG8_SA
#undef PG8_SB
#undef PG8_STAGE
#undef PG8_LDA
#undef PG8_LDB
#undef PG8_MMA
#undef PG8_WAIT_V
#undef PG8_WAIT_L
#undef PG8_BAR
#undef PG8_SCHED
}
}

struct EpiIn {
    static constexpr bool PERM = true;
    bf16_t* proj; bf16_t* vta; bf16_t* vtc; float* bint; LAS unsigned char* tlds;
    DI void operator()(const f32x4 (&acc)[2][2][4][2], const pg8::Unit& u, int wr, int wc, int fr, int fq) const {
        const int colt = u.pn * 256;
        int kind = 0;
        if (colt < C_AGATE) { if ((colt % 3072) >= 2048) kind = 1; }
        else if (colt >= C_BIN && colt < C_BGATE) kind = 2;
        else if (colt >= C_CQKV + 2048 && colt < C_CGATE) kind = 3;
        const int row0 = u.pm * 256 + wr * 64 + fr, col0 = colt + wc * 32 + 8 * fq;
        if (kind == 0) {
#pragma unroll
            for (int ai = 0; ai < 2; ++ai)
#pragma unroll
                for (int m = 0; m < 4; ++m) { bf16_t* rp = proj + PIDX(row0 + ai * 128 + m * 16, col0);
#pragma unroll
                    for (int bj = 0; bj < 2; ++bj) { const f32x4 a = acc[ai][bj][m][0], b = acc[ai][bj][m][1];
                        u32x4 o = {pk2(a[0], a[1]), pk2(a[2], a[3]), pk2(b[0], b[1]), pk2(b[2], b[3])}; *(u32x4*)(rp + bj * 128) = o; } }
        } else if (kind == 1 && colt >= 2 * 3072) {
            bf16_t* base = vta + (ptrdiff_t)(2 * 1024 - 2 * 3072 - 2048) * (ptrdiff_t)S;
#pragma unroll
            for (int ai = 0; ai < 2; ++ai) { const int prow = fr * (S >> 4) + ((u.pm * 256 + ai * 128 + wr * 64) >> 4);
#pragma unroll
                for (int bj = 0; bj < 2; ++bj)
#pragma unroll
                    for (int n = 0; n < 2; ++n)
#pragma unroll
                        for (int e = 0; e < 4; ++e) { u32x2 o = {pk2(acc[ai][bj][0][n][e], acc[ai][bj][1][n][e]), pk2(acc[ai][bj][2][n][e], acc[ai][bj][3][n][e])};
                            *(u32x2*)(base + (ptrdiff_t)(col0 + bj * 128 + n * 4 + e) * (ptrdiff_t)S + prow) = o; } }
        } else {
            const int lane = fr + 16 * fq, wave = wr * 4 + wc;
            LAS float* tl = (LAS float*)(tlds + wave * 2304);
            const int cl = lane >> 1, hs = lane & 1;
            const int colg = colt + wc * 32 + cl;
#pragma unroll
            for (int ai = 0; ai < 2; ++ai)
#pragma unroll
                for (int bj = 0; bj < 2; ++bj)
#pragma unroll
                    for (int m = 0; m < 4; ++m) {
                        const int rowb = u.pm * 256 + ai * 128 + wr * 64 + m * 16;
#pragma unroll
                        for (int n = 0; n < 2; ++n)
#pragma unroll
                            for (int e = 0; e < 4; ++e) tl[(8 * fq + 4 * n + e) * 17 + fr] = acc[ai][bj][m][n][e];
                        __builtin_amdgcn_wave_barrier();
                        const LAS float* tc = tl + cl * 17;
                        const int col = colg + bj * 128;
                        if (kind == 2) {
                            f32x4 o0 = {tc[8 * hs], tc[8 * hs + 1], tc[8 * hs + 2], tc[8 * hs + 3]}, o1 = {tc[8 * hs + 4], tc[8 * hs + 5], tc[8 * hs + 6], tc[8 * hs + 7]};
                            float* bp = bint + (size_t)(col - C_BIN) * S + rowb + 8 * hs;
                            *(f32x4*)bp = o0; *(f32x4*)(bp + 4) = o1;
                        } else if (kind == 3) {
                            u32x4 o = {pk2(tc[4 * hs], tc[4 * hs + 1]), pk2(tc[4 * hs + 2], tc[4 * hs + 3]), pk2(tc[8 + 4 * hs], tc[9 + 4 * hs]), pk2(tc[10 + 4 * hs], tc[11 + 4 * hs])};
                            *(u32x4*)(vtc + (size_t)(col - (C_CQKV + 2048)) * S + rowb + 8 * hs) = o;
                        } else if (colt < 3072) {
                            u32x4 o = {pk2(tc[8 * hs], tc[8 * hs + 1]), pk2(tc[8 * hs + 2], tc[8 * hs + 3]), pk2(tc[8 * hs + 4], tc[8 * hs + 5]), pk2(tc[8 * hs + 6], tc[8 * hs + 7])};
                            *(u32x4*)(vta + (size_t)(col - 2048) * S + rowb + 8 * hs) = o;
                        } else {
#pragma unroll
                            for (int k = 0; k < 2; ++k) { const int res = 2 * hs + k;
                                u32x2 o = {pk2(tc[res], tc[res + 4]), pk2(tc[res + 8], tc[res + 12])};
                                *(u32x2*)(vta + (size_t)(1024 + col - 3072 - 2048) * S + res * (S >> 2) + (rowb >> 2)) = o; }
                        }
                        __builtin_amdgcn_wave_barrier();
                    }
        }
    }
};
struct ProjOrder {
    pg8::StaticOrder so;
    DI bool next(int i, pg8::Unit& u) const { pg8::Unit b; if (!so.next(i / 3, b)) return false; const int nb = i % 3; u.pm = b.pm + 32 * nb; u.pn = b.pn + 8 * nb; return true; }
};
struct EpiProj {   static constexpr bool PERM = false;
    const bf16_t* proj; const float* mb; float* yf; bf16_t* yb;
    DI void operator()(const f32x4 (&acc)[2][2][4][2], const pg8::Unit& u, int wr, int wc, int fr, int fq) const {
        const int nb = u.pm >> 5;
        const int row0 = (u.pm & 31) * 256 + wr * 64 + fr, col0 = (u.pn & 7) * 256 + wc * 32 + 4 * fq;
        f32x4 b4[2][2];
#pragma unroll
        for (int bj = 0; bj < 2; ++bj)
#pragma unroll
            for (int n = 0; n < 2; ++n) b4[bj][n] = *(const f32x4*)(mb + nb * D + col0 + bj * 128 + n * 16);
#pragma unroll
        for (int ai = 0; ai < 2; ++ai)
#pragma unroll
            for (int mp = 0; mp < 2; ++mp) {
                u32x2 mg[2][2][2]; f32x4 yv[2][2][2];
#pragma unroll
                for (int mi = 0; mi < 2; ++mi) { const int row = row0 + ai * 128 + (2 * mp + mi) * 16;
#pragma unroll
                    for (int bj = 0; bj < 2; ++bj)
#pragma unroll
                        for (int n = 0; n < 2; ++n) { const int col = col0 + bj * 128 + n * 16;
                            mg[mi][bj][n] = *(const u32x2*)(proj + PIDX(row, C_MERGE + nb * D + col));
                            if (nb > 0) yv[mi][bj][n] = *(const f32x4*)(yf + (size_t)row * D + col); else yv[mi][bj][n] = (f32x4){0.f, 0.f, 0.f, 0.f}; } }
#pragma unroll
                for (int mi = 0; mi < 2; ++mi) { const int m = 2 * mp + mi; const int row = row0 + ai * 128 + m * 16;
#pragma unroll
                    for (int bj = 0; bj < 2; ++bj)
#pragma unroll
                        for (int n = 0; n < 2; ++n) { const int col = col0 + bj * 128 + n * 16; const f32x4 a = acc[ai][bj][m][n]; const u32x2 g2 = mg[mi][bj][n]; const f32x4 bb = b4[bj][n];
                            f32x4 v = yv[mi][bj][n];
                            v[0] += a[0] * sigm_f(bflo(g2[0]) + bb[0]); v[1] += a[1] * sigm_f(bfhi(g2[0]) + bb[1]);
                            v[2] += a[2] * sigm_f(bflo(g2[1]) + bb[2]); v[3] += a[3] * sigm_f(bfhi(g2[1]) + bb[3]);
                            if (nb < 2) *(f32x4*)(yf + (size_t)row * D + col) = v;
                            else { u32x2 o = {pk2(v[0], v[1]), pk2(v[2], v[3])}; *(u32x2*)(yb + (size_t)row * D + col) = o; } } }
            }
    }
};
struct EpiOut {   static constexpr bool PERM = false;
    const float* xold; float* xnew;
    DI void operator()(const f32x4 (&acc)[2][2][4][2], const pg8::Unit& u, int wr, int wc, int fr, int fq) const {
        const int row0 = u.pm * 256 + wr * 64 + fr, col0 = u.pn * 256 + wc * 32 + 4 * fq;
#pragma unroll
        for (int ai = 0; ai < 2; ++ai)
#pragma unroll
            for (int mp = 0; mp < 2; ++mp) {
                f32x4 xv[2][2][2];
#pragma unroll
                for (int mi = 0; mi < 2; ++mi)
#pragma unroll
                    for (int bj = 0; bj < 2; ++bj)
#pragma unroll
                        for (int n = 0; n < 2; ++n) xv[mi][bj][n] = *(const f32x4*)(xold + (size_t)(row0 + ai * 128 + (2 * mp + mi) * 16) * D + col0 + bj * 128 + n * 16);
#pragma unroll
                for (int mi = 0; mi < 2; ++mi)
#pragma unroll
                    for (int bj = 0; bj < 2; ++bj)
#pragma unroll
                        for (int n = 0; n < 2; ++n) *(f32x4*)(xnew + (size_t)(row0 + ai * 128 + (2 * mp + mi) * 16) * D + col0 + bj * 128 + n * 16) = xv[mi][bj][n] + acc[ai][bj][2 * mp + mi][n];
            }
    }
};
DI float wave_sum(float v) {
#pragma unroll
    for (int o = 1; o < 64; o <<= 1) v += __shfl_xor(v, o);
    return v;
}
typedef unsigned u32x2v __attribute__((ext_vector_type(2)));
DI float xhalf_max(float x) {
    const unsigned u = __float_as_uint(x);
    const u32x2v rr = __builtin_amdgcn_permlane32_swap(u, u, false, false);
    return fmaxf(__uint_as_float(rr[0]), __uint_as_float(rr[1]));
}
DI int crow(int reg, int h) { return (reg & 3) + 8 * (reg >> 2) + 4 * h; }
DI bf16x8 pack8(const f32x16& x, const int s) {
    u32x4 p;
    p[0] = pk2(x[8 * s + 0], x[8 * s + 1]); p[1] = pk2(x[8 * s + 2], x[8 * s + 3]);
    p[2] = pk2(x[8 * s + 4], x[8 * s + 5]); p[3] = pk2(x[8 * s + 6], x[8 * s + 7]);
    return __builtin_bit_cast(bf16x8, p);
}
#define MFMA32(a, b, c) __builtin_amdgcn_mfma_f32_32x32x16_bf16((a), (b), (c), 0, 0, 0)

DI void transpose_item(const float* Wsrc, int K, int N, bf16_t* WT, LAS float* scr, int item, int lane) {
    const int nblk = N / 64, kb = item / nblk, nb = item % nblk, k0 = 64 * kb, n0 = 64 * nb;
    const int lr = lane >> 4, lc = (lane & 15) * 4;
    f32x4 v[16];
#pragma unroll
    for (int i = 0; i < 16; ++i) v[i] = *(const f32x4*)(Wsrc + (size_t)(k0 + 4 * i + lr) * N + n0 + lc);
#pragma unroll
    for (int i = 0; i < 16; ++i) { LAS float* d = scr + (4 * i + lr) * 65 + lc; d[0] = v[i][0]; d[1] = v[i][1]; d[2] = v[i][2]; d[3] = v[i][3]; }
    __builtin_amdgcn_wave_barrier();
    const int c = lane & 7;
#pragma unroll
    for (int j = 0; j < 8; ++j) { const int n = (lane >> 3) + 8 * j; const LAS float* s = scr + (8 * c) * 65 + n;
        u32x4 o; o[0] = pk2(s[0 * 65], s[1 * 65]); o[1] = pk2(s[2 * 65], s[3 * 65]); o[2] = pk2(s[4 * 65], s[5 * 65]); o[3] = pk2(s[6 * 65], s[7 * 65]);
        *(u32x4*)(WT + (size_t)(n0 + n) * K + k0 + 8 * c) = o; }
    __builtin_amdgcn_wave_barrier();
}
DI int t5_bucket(int rel) {
    const int ret = rel > 0 ? 16 : 0; const int n = rel < 0 ? -rel : rel;
    const float nf = (float)(n > 1 ? n : 1);
    int large = 8 + (int)(logf(nf / 8.0f) / 4.852030263919617f * 8.0f);
    large = large < 15 ? large : 15;
    return ret + (n < 8 ? n : large);
}
DI void phase_prologue(const Params& p, LAS unsigned char* lds) {
    const int tid = tidx(), wave = tid >> 6, lane = tid & 63;
    const int gw = blockIdx.x * NWAVES + wave, NGW = gridDim.x * NWAVES;
    LAS float* scr = (LAS float*)(lds + wave * 16640);
    bf16_t* win_t = (bf16_t*)(p.ws + WS_WIN); bf16_t* wpr_t = (bf16_t*)(p.ws + WS_WPR); bf16_t* wout_t = (bf16_t*)(p.ws + WS_WOUT);
    constexpr int IT_IN = (D / 64) * (NIN / 64), IT_PR = (1024 / 64) * (D / 64), IT_OUT = (D / 64) * (D / 64);
    constexpr int TOT = DEPTH * IT_IN + DEPTH * 3 * IT_PR + DEPTH * IT_OUT;
    for (int it = gw; it < TOT; it += NGW) {
        int r = it;
        if (r < DEPTH * IT_IN) { const int l = r / IT_IN; transpose_item(p.in[I_WIN] + (size_t)l * D * NIN, D, NIN, win_t + (size_t)l * NIN * D, scr, r % IT_IN, lane); continue; }
        r -= DEPTH * IT_IN;
        if (r < DEPTH * 3 * IT_PR) { const int l = r / IT_PR; transpose_item(p.in[I_WPROJ] + (size_t)l * 1024 * D, 1024, D, wpr_t + (size_t)l * D * 1024, scr, r % IT_PR, lane); continue; }
        r -= DEPTH * 3 * IT_PR;
        { const int l = r / IT_OUT; transpose_item(p.in[I_WOUT] + (size_t)l * D * D, D, D, wout_t + (size_t)l * D * D, scr, r % IT_OUT, lane); }
    }
    float* bias = (float*)(p.ws + WS_BIAS);
    for (int i = blockIdx.x * NTHR + tid; i < 32 * 2049; i += gridDim.x * NTHR) {
        const int hd = i / 2049, rel = (i % 2049) - 1024;
        bias[i] = p.in[I_RELB][t5_bucket(rel) * 32 + hd] * LOG2E;
    }
    __syncthreads();
    LAS float* zemb = (LAS float*)lds;
    LAS float* h1 = (LAS float*)(lds + 2048);
    float* hid2 = (float*)(p.ws + WS_HID2);
    for (int rb = blockIdx.x; rb < S / 8; rb += gridDim.x) {
        const int rl = tid >> 6, j = tid & 63, i = rb * 8 + rl;
        if (j < 33) {
            float z;
            if (j == 0) z = (float)i / 8191.0f;
            else { const int k = (j - 1) & 15; const float fb = 1e-4f + (float)k * ((15.0f - 1e-4f) / 15.0f); const float w = 6.283185307179586f * (float)i / 8192.0f; const float a = fb * w; z = (j <= 16) ? cosf(a) : -sinf(a); }
            zemb[rl * 36 + j] = z;
        }
        __syncthreads();
        for (int l = 0; l < DEPTH; ++l) {
            float a1 = p.in[I_HYB1][l * 64 + j];
            for (int e = 0; e < 33; ++e) a1 += zemb[rl * 36 + e] * p.in[I_HYW1][(l * 33 + e) * 64 + j];
            h1[rl * 64 + j] = sinf(p.in[I_HYFREQ][(l * 2 + 0) * 64 + j] * a1);
            __syncthreads();
            float a2 = p.in[I_HYB2][l * 64 + j];
            for (int e = 0; e < 64; ++e) a2 += h1[rl * 64 + e] * p.in[I_HYW2][(l * 64 + e) * 64 + j];
            hid2[((size_t)l * S + i) * 64 + j] = sinf(p.in[I_HYFREQ][(l * 2 + 1) * 64 + j] * a2);
            __syncthreads();
        }
    }
}


DI void split8(const f32x4 a, const f32x4 b, bf16x8& hi, bf16x8& lo) {
    u32x4 h, l2;
    h[0] = pk2(a[0], a[1]); h[1] = pk2(a[2], a[3]); h[2] = pk2(b[0], b[1]); h[3] = pk2(b[2], b[3]);
    l2[0] = pk2(a[0] - bflo(h[0]), a[1] - bfhi(h[0])); l2[1] = pk2(a[2] - bflo(h[1]), a[3] - bfhi(h[1]));
    l2[2] = pk2(b[0] - bflo(h[2]), b[1] - bfhi(h[2])); l2[3] = pk2(b[2] - bflo(h[3]), b[3] - bfhi(h[3]));
    hi = __builtin_bit_cast(bf16x8, h); lo = __builtin_bit_cast(bf16x8, l2);
}
DI void phase_tgen(const Params& p) {
    const int tid = tidx(), wave = tid >> 6, lane = tid & 63, r = lane & 31, hh = lane >> 5;
    float* tt = (float*)(p.ws + WS_TT);
    for (int it = blockIdx.x * NWAVES + wave; it < DEPTH * 128 * 4; it += gridDim.x * NWAVES) {
        const int l = it >> 9, cb = (it >> 2) & 127, rc = it & 3;
        const float* w3 = p.in[I_HYW3] + (size_t)l * 64 * 4096 + cb * 32 + r;
        bf16x8 ahi[4], alo[4];
#pragma unroll
        for (int ks = 0; ks < 4; ++ks) {
            f32x4 a, b;
#pragma unroll
            for (int j = 0; j < 4; ++j) { a[j] = w3[(size_t)(16 * ks + 8 * hh + j) * 4096]; b[j] = w3[(size_t)(16 * ks + 8 * hh + 4 + j) * 4096]; }
            split8(a, b, ahi[ks], alo[ks]);
        }
        const float* hid2 = (const float*)(p.ws + WS_HID2) + (size_t)l * S * 64;
        f32x4 ha[4], hb[4];
        { const float* hr = hid2 + (size_t)(rc * 2048 + r) * 64 + 8 * hh;
#pragma unroll
          for (int ks = 0; ks < 4; ++ks) { ha[ks] = *(const f32x4*)(hr + 16 * ks); hb[ks] = *(const f32x4*)(hr + 16 * ks + 4); } }
#pragma unroll 1
        for (int rb = 0; rb < 64; ++rb) {
            const int i0 = rc * 2048 + rb * 32;
            bf16x8 bhi[4], blo[4];
#pragma unroll
            for (int ks = 0; ks < 4; ++ks) split8(ha[ks], hb[ks], bhi[ks], blo[ks]);
            if (rb + 1 < 64) { const float* hr = hid2 + (size_t)(i0 + 32 + r) * 64 + 8 * hh;
#pragma unroll
                for (int ks = 0; ks < 4; ++ks) { ha[ks] = *(const f32x4*)(hr + 16 * ks); hb[ks] = *(const f32x4*)(hr + 16 * ks + 4); } }
            f32x16 acc;
#pragma unroll
            for (int i = 0; i < 16; ++i) acc[i] = 0.f;
#pragma unroll
            for (int ks = 0; ks < 4; ++ks) { acc = MFMA32(ahi[ks], bhi[ks], acc); acc = MFMA32(ahi[ks], blo[ks], acc); acc = MFMA32(alo[ks], bhi[ks], acc); }
            float* tp = tt + ((size_t)l * 4096 + cb * 32) * S + i0 + r;
#pragma unroll
            for (int reg = 0; reg < 16; ++reg) tp[(size_t)crow(reg, hh) * S] = acc[reg];
        }
    }
}

#define XI(i) ((i) + ((i) >> 4) + ((i) >> 8))
DI cf cmul(cf a, cf b) {
    cf t, r;
    asm("v_pk_mul_f32 %0, %1, %2 op_sel:[0,0] op_sel_hi:[0,1]" : "=v"(t) : "v"(a), "v"(b));
    asm("v_pk_fma_f32 %0, %1, %2, %3 op_sel:[1,1,0] op_sel_hi:[1,0,1] neg_lo:[0,1,0]" : "=v"(r) : "v"(a), "v"(b), "v"(t));
    return r;
}
DI cf twid(float frac) { float c = __builtin_amdgcn_cosf(frac), s = __builtin_amdgcn_sinf(frac); asm volatile("s_nop 1" : "+v"(c), "+v"(s)); return (cf){c, -s}; }
DI cf twidc(float frac) { float c = __builtin_amdgcn_cosf(frac), s = __builtin_amdgcn_sinf(frac); asm volatile("s_nop 1" : "+v"(c), "+v"(s)); return (cf){c, s}; }
DI void fwd4(cf& a0, cf& a1, cf& a2, cf& a3) {
    const cf s02 = a0 + a2, d02 = a0 - a2, s13 = a1 + a3, d13 = a1 - a3;
    a0 = s02 + s13; a2 = s02 - s13;
    a1 = (cf){d02.x + d13.y, d02.y - d13.x};
    a3 = (cf){d02.x - d13.y, d02.y + d13.x};
}
DI void inv4(cf& b0, cf& b1, cf& b2, cf& b3) {
    const cf s02 = b0 + b2, d02 = b0 - b2, s13 = b1 + b3, d13 = b1 - b3;
    b0 = s02 + s13; b2 = s02 - s13;
    b1 = (cf){d02.x - d13.y, d02.y + d13.x};
    b3 = (cf){d02.x + d13.y, d02.y - d13.x};
}
template <int LOGM> DI void fwd_r4_pass(LAS cf* X, int tid) {
    asm volatile("" : "+v"(tid));
    constexpr int M = 1 << LOGM, q = M >> 2;
#pragma unroll 2
    for (int t = tid; t < 4096; t += NTHR) {
        const int j = t & (q - 1), base = (t >> (LOGM - 2)) * M + j;
        constexpr int QP = (q >= 256) ? (q + (q >> 4) + (q >> 8)) : ((q == 16) ? 17 : 1);
        LAS cf* xp = X + XI(base);
        cf a0 = xp[0], a1 = xp[QP], a2 = xp[2 * QP], a3 = xp[3 * QP];
        fwd4(a0, a1, a2, a3);
        const cf w1 = twid((float)j * (1.0f / M)), w2 = cmul(w1, w1), w3 = cmul(w2, w1);
        xp[0] = a0; xp[QP] = cmul(a1, w1); xp[2 * QP] = cmul(a2, w2); xp[3 * QP] = cmul(a3, w3);
    }
}
template <int LOGM> DI void inv_r4_pass(LAS cf* X, int tid) {
    asm volatile("" : "+v"(tid));
    constexpr int M = 1 << LOGM, q = M >> 2;
#pragma unroll 2
    for (int t = tid; t < 4096; t += NTHR) {
        const int j = t & (q - 1), base = (t >> (LOGM - 2)) * M + j;
        const cf w1 = twidc((float)j * (1.0f / M)), w2 = cmul(w1, w1), w3 = cmul(w2, w1);
        constexpr int QP = (q >= 256) ? (q + (q >> 4) + (q >> 8)) : ((q == 16) ? 17 : 1);
        LAS cf* xp = X + XI(base);
        cf b0 = xp[0], b1 = cmul(xp[QP], w1), b2 = cmul(xp[2 * QP], w2), b3 = cmul(xp[3 * QP], w3);
        inv4(b0, b1, b2, b3);
        xp[0] = b0; xp[QP] = b1; xp[2 * QP] = b2; xp[3 * QP] = b3;
    }
}
template <int LOGM> DI void fwd16(cf (&v)[16], int j) {
    constexpr int M = 1 << LOGM, q = M >> 4;
#pragma unroll
    for (int n = 0; n < 4; ++n) {
        fwd4(v[n], v[n + 4], v[n + 8], v[n + 12]);
        const cf w1 = twid((float)(j + n * q) * (1.0f / M)), w2 = cmul(w1, w1), w3 = cmul(w2, w1);
        v[n + 4] = cmul(v[n + 4], w1); v[n + 8] = cmul(v[n + 8], w2); v[n + 12] = cmul(v[n + 12], w3);
    }
    const cf u1 = twid((float)j * (4.0f / M)), u2 = cmul(u1, u1), u3 = cmul(u2, u1);
#pragma unroll
    for (int m = 0; m < 4; ++m) {
        fwd4(v[4 * m], v[4 * m + 1], v[4 * m + 2], v[4 * m + 3]);
        v[4 * m + 1] = cmul(v[4 * m + 1], u1); v[4 * m + 2] = cmul(v[4 * m + 2], u2); v[4 * m + 3] = cmul(v[4 * m + 3], u3);
    }
}
template <int LOGM> DI void inv16(cf (&v)[16], int j) {
    constexpr int M = 1 << LOGM, q = M >> 4;
    const cf u1 = twidc((float)j * (4.0f / M)), u2 = cmul(u1, u1), u3 = cmul(u2, u1);
#pragma unroll
    for (int m = 0; m < 4; ++m) {
        v[4 * m + 1] = cmul(v[4 * m + 1], u1); v[4 * m + 2] = cmul(v[4 * m + 2], u2); v[4 * m + 3] = cmul(v[4 * m + 3], u3);
        inv4(v[4 * m], v[4 * m + 1], v[4 * m + 2], v[4 * m + 3]);
    }
#pragma unroll
    for (int n = 0; n < 4; ++n) {
        const cf w1 = twidc((float)(j + n * q) * (1.0f / M)), w2 = cmul(w1, w1), w3 = cmul(w2, w1);
        v[n + 4] = cmul(v[n + 4], w1); v[n + 8] = cmul(v[n + 8], w2); v[n + 12] = cmul(v[n + 12], w3);
        inv4(v[n], v[n + 4], v[n + 8], v[n + 12]);
    }
}
template <int LOGM> DI void fwd_r16_pass(LAS cf* X, int tid) {
    asm volatile("" : "+v"(tid));
    constexpr int M = 1 << LOGM, q = M >> 4;
#pragma unroll 1
    for (int t = tid; t < 1024; t += NTHR) {
        const int j = t & (q - 1), base = (t >> (LOGM - 4)) * M + j;
        constexpr int QP = (q >= 256) ? (q + (q >> 4) + (q >> 8)) : ((q == 16) ? 17 : 1);
        LAS cf* xp = X + XI(base);
        cf v[16];
#pragma unroll
        for (int n = 0; n < 16; ++n) v[n] = xp[n * QP];
        fwd16<LOGM>(v, j);
#pragma unroll
        for (int n = 0; n < 16; ++n) xp[n * QP] = v[n];
    }
}
template <int LOGM> DI void inv_r16_pass(LAS cf* X, int tid) {
    asm volatile("" : "+v"(tid));
    constexpr int M = 1 << LOGM, q = M >> 4;
#pragma unroll 1
    for (int t = tid; t < 1024; t += NTHR) {
        const int j = t & (q - 1), base = (t >> (LOGM - 4)) * M + j;
        constexpr int QP = (q >= 256) ? (q + (q >> 4) + (q >> 8)) : ((q == 16) ? 17 : 1);
        LAS cf* xp = X + XI(base);
        cf v[16];
#pragma unroll
        for (int n = 0; n < 16; ++n) v[n] = xp[n * QP];
        inv16<LOGM>(v, j);
#pragma unroll
        for (int n = 0; n < 16; ++n) xp[n * QP] = v[n];
    }
}
DI int rev4(int pp) { const unsigned br = __brev((unsigned)pp) >> 18; return (int)(((br & 0x2AAAu) >> 1) | ((br & 0x1555u) << 1)); }
DI void fft_forward(LAS cf* X, int tid) {
    fwd_r4_pass<14>(X, tid); __syncthreads();
    fwd_r16_pass<12>(X, tid); __syncthreads();
    fwd_r16_pass<8>(X, tid); __syncthreads();
    fwd_r16_pass<4>(X, tid); __syncthreads();
}
constexpr int SPEC_STRIDE = 8208;
DI void fft_conv(LAS cf* X, const f32x4* spec, int tid) {
    fft_forward(X, tid);
#pragma unroll 8
    for (int r = 0; r < 16; ++r) {
        const int k = tid + NTHR * r; const int pp = rev4(k);
        const f32x4 sp = spec[k]; const cf P = (cf){sp[0], sp[1]}, Mq = (cf){sp[2], sp[3]};
        const cf z = X[XI(pp)];
        if (k == 0) { X[XI(pp)] = cmul(z, P) + cmul((cf){z.x, -z.y}, Mq); }
        else { const int pm = rev4(16384 - k); const cf zm = X[XI(pm)];
            const cf y = cmul(z, P) + cmul((cf){zm.x, -zm.y}, Mq);
            const cf t = cmul((cf){zm.x, -zm.y}, P) + cmul(z, Mq);
            X[XI(pp)] = y; X[XI(pm)] = (cf){t.x, -t.y}; }
    }
    if (tid == 0) { const int pp = rev4(8192); const f32x4 sp = spec[8192]; const cf z = X[XI(pp)]; X[XI(pp)] = cmul(z, (cf){sp[0], sp[1]}) + cmul((cf){z.x, -z.y}, (cf){sp[2], sp[3]}); }
    __syncthreads();
    inv_r16_pass<4>(X, tid); __syncthreads();
    inv_r16_pass<8>(X, tid); __syncthreads();
    inv_r16_pass<12>(X, tid); __syncthreads();
    inv_r4_pass<14>(X, tid); __syncthreads();
}


typedef _Float16 hc __attribute__((ext_vector_type(2)));
DI hc hcmul(hc a, hc b) { hc t, r;
    asm("v_pk_mul_f16 %0, %1, %2 op_sel:[0,0] op_sel_hi:[0,1]" : "=v"(t) : "v"(a), "v"(b));
    asm("v_pk_fma_f16 %0, %1, %2, %3 op_sel:[1,1,0] op_sel_hi:[1,0,1] neg_lo:[0,1,0]" : "=v"(r) : "v"(a), "v"(b), "v"(t)); return r; }
DI hc hadd_mi(hc a, hc b) { hc r; asm("v_pk_add_f16 %0, %1, %2 op_sel:[0,1] op_sel_hi:[1,0] neg_hi:[0,1]" : "=v"(r) : "v"(a), "v"(b)); return r; }
DI hc hadd_pi(hc a, hc b) { hc r; asm("v_pk_add_f16 %0, %1, %2 op_sel:[0,1] op_sel_hi:[1,0] neg_lo:[0,1]" : "=v"(r) : "v"(a), "v"(b)); return r; }
DI hc htwid(float frac) { float c = __builtin_amdgcn_cosf(frac), s = __builtin_amdgcn_sinf(frac); asm volatile("s_nop 1" : "+v"(c), "+v"(s)); return (hc){(_Float16)c, (_Float16)(-s)}; }
DI hc htwidc(float frac) { float c = __builtin_amdgcn_cosf(frac), s = __builtin_amdgcn_sinf(frac); asm volatile("s_nop 1" : "+v"(c), "+v"(s)); return (hc){(_Float16)c, (_Float16)s}; }
DI void hfwd4(hc& a0, hc& a1, hc& a2, hc& a3) {
    const hc s02 = a0 + a2, d02 = a0 - a2, s13 = a1 + a3, d13 = a1 - a3;
    a0 = s02 + s13; a2 = s02 - s13; a1 = hadd_mi(d02, d13); a3 = hadd_pi(d02, d13);
}
DI void hinv4(hc& b0, hc& b1, hc& b2, hc& b3) {
    const hc s02 = b0 + b2, d02 = b0 - b2, s13 = b1 + b3, d13 = b1 - b3;
    b0 = s02 + s13; b2 = s02 - s13; b1 = hadd_pi(d02, d13); b3 = hadd_mi(d02, d13);
}
template <int LOGM> DI void hfwd_r4_pass(LAS hc* X, int tid) {
    asm volatile("" : "+v"(tid));
    constexpr int M = 1 << LOGM, q = M >> 2;
#pragma unroll 8
    for (int t = tid; t < 4096; t += NTHR) {
        const int j = t & (q - 1), base = (t >> (LOGM - 2)) * M + j;
        constexpr int QP = (q >= 256) ? (q + (q >> 4) + (q >> 8)) : ((q == 16) ? 17 : 1);
        LAS hc* xp = X + XI(base);
        hc a0 = xp[0], a1 = xp[QP], a2 = xp[2 * QP], a3 = xp[3 * QP];
        hfwd4(a0, a1, a2, a3);
        const hc w1 = htwid((float)j * (1.0f / M)), w2 = hcmul(w1, w1), w3 = hcmul(w2, w1);
        xp[0] = a0; xp[QP] = hcmul(a1, w1); xp[2 * QP] = hcmul(a2, w2); xp[3 * QP] = hcmul(a3, w3);
    }
}
template <int LOGM> DI void hinv_r4_pass(LAS hc* X, int tid) {
    asm volatile("" : "+v"(tid));
    constexpr int M = 1 << LOGM, q = M >> 2;
#pragma unroll 8
    for (int t = tid; t < 4096; t += NTHR) {
        const int j = t & (q - 1), base = (t >> (LOGM - 2)) * M + j;
        const hc w1 = htwidc((float)j * (1.0f / M)), w2 = hcmul(w1, w1), w3 = hcmul(w2, w1);
        constexpr int QP = (q >= 256) ? (q + (q >> 4) + (q >> 8)) : ((q == 16) ? 17 : 1);
        LAS hc* xp = X + XI(base);
        hc b0 = xp[0], b1 = hcmul(xp[QP], w1), b2 = hcmul(xp[2 * QP], w2), b3 = hcmul(xp[3 * QP], w3);
        hinv4(b0, b1, b2, b3);
        xp[0] = b0; xp[QP] = b1; xp[2 * QP] = b2; xp[3 * QP] = b3;
    }
}
template <int LOGM> DI void hfwd16(hc (&v)[16], int j) {
    constexpr int M = 1 << LOGM, q = M >> 4;
#pragma unroll
    for (int n = 0; n < 4; ++n) {
        hfwd4(v[n], v[n + 4], v[n + 8], v[n + 12]);
        const hc w1 = htwid((float)(j + n * q) * (1.0f / M)), w2 = hcmul(w1, w1), w3 = hcmul(w2, w1);
        v[n + 4] = hcmul(v[n + 4], w1); v[n + 8] = hcmul(v[n + 8], w2); v[n + 12] = hcmul(v[n + 12], w3);
    }
    const hc u1 = htwid((float)j * (4.0f / M)), u2 = hcmul(u1, u1), u3 = hcmul(u2, u1);
#pragma unroll
    for (int m = 0; m < 4; ++m) {
        hfwd4(v[4 * m], v[4 * m + 1], v[4 * m + 2], v[4 * m + 3]);
        v[4 * m + 1] = hcmul(v[4 * m + 1], u1); v[4 * m + 2] = hcmul(v[4 * m + 2], u2); v[4 * m + 3] = hcmul(v[4 * m + 3], u3);
    }
}
template <int LOGM> DI void hinv16(hc (&v)[16], int j) {
    constexpr int M = 1 << LOGM, q = M >> 4;
    const hc u1 = htwidc((float)j * (4.0f / M)), u2 = hcmul(u1, u1), u3 = hcmul(u2, u1);
#pragma unroll
    for (int m = 0; m < 4; ++m) {
        v[4 * m + 1] = hcmul(v[4 * m + 1], u1); v[4 * m + 2] = hcmul(v[4 * m + 2], u2); v[4 * m + 3] = hcmul(v[4 * m + 3], u3);
        hinv4(v[4 * m], v[4 * m + 1], v[4 * m + 2], v[4 * m + 3]);
    }
#pragma unroll
    for (int n = 0; n < 4; ++n) {
        const hc w1 = htwidc((float)(j + n * q) * (1.0f / M)), w2 = hcmul(w1, w1), w3 = hcmul(w2, w1);
        v[n + 4] = hcmul(v[n + 4], w1); v[n + 8] = hcmul(v[n + 8], w2); v[n + 12] = hcmul(v[n + 12], w3);
        hinv4(v[n], v[n + 4], v[n + 8], v[n + 12]);
    }
}
template <int LOGM, bool FWD> DI void h_r16_pass(LAS hc* X, int tid) {
    asm volatile("" : "+v"(tid));
    constexpr int M = 1 << LOGM, q = M >> 4;
#pragma unroll
    for (int t = tid; t < 1024; t += NTHR) {
        const int j = t & (q - 1), base = (t >> (LOGM - 4)) * M + j;
        constexpr int QP = (q >= 256) ? (q + (q >> 4) + (q >> 8)) : ((q == 16) ? 17 : 1);
        LAS hc* xp = X + XI(base);
        hc v[16];
#pragma unroll
        for (int n = 0; n < 16; ++n) v[n] = xp[n * QP];
        if (FWD) hfwd16<LOGM>(v, j); else hinv16<LOGM>(v, j);
#pragma unroll
        for (int n = 0; n < 16; ++n) xp[n * QP] = v[n];
    }
}
DI void fft_conv_h(LAS hc* X, const f32x4* spec, int tid) {
    hfwd_r4_pass<14>(X, tid); __syncthreads();
    h_r16_pass<12, true>(X, tid); __syncthreads();
    h_r16_pass<8, true>(X, tid); __syncthreads();
    h_r16_pass<4, true>(X, tid); __syncthreads();
#pragma unroll 8
    for (int r = 0; r < 16; ++r) {
        const int k = tid + NTHR * r; const int pp = rev4(k);
        const f32x4 sp = spec[k]; const cf P = (cf){sp[0], sp[1]} * 256.0f, Mq = (cf){sp[2], sp[3]} * 256.0f;
        const hc zh = X[XI(pp)]; const cf z = (cf){(float)zh.x, (float)zh.y};
        if (k == 0) { const cf y = cmul(z, P) + cmul((cf){z.x, -z.y}, Mq); X[XI(pp)] = (hc){(_Float16)y.x, (_Float16)y.y}; }
        else { const int pm = rev4(16384 - k); const hc zmh = X[XI(pm)]; const cf zm = (cf){(float)zmh.x, (float)zmh.y};
            const cf y = cmul(z, P) + cmul((cf){zm.x, -zm.y}, Mq);
            const cf t = cmul((cf){zm.x, -zm.y}, P) + cmul(z, Mq);
            X[XI(pp)] = (hc){(_Float16)y.x, (_Float16)y.y}; X[XI(pm)] = (hc){(_Float16)t.x, (_Float16)(-t.y)}; }
    }
    if (tid == 0) { const int pp = rev4(8192); const f32x4 sp = spec[8192]; const hc zh = X[XI(pp)]; const cf z = (cf){(float)zh.x, (float)zh.y};
        const cf y = (cmul(z, (cf){sp[0], sp[1]}) + cmul((cf){z.x, -z.y}, (cf){sp[2], sp[3]})) * 256.0f; X[XI(pp)] = (hc){(_Float16)y.x, (_Float16)y.y}; }
    __syncthreads();
    h_r16_pass<4, false>(X, tid); __syncthreads();
    h_r16_pass<8, false>(X, tid); __syncthreads();
    h_r16_pass<12, false>(X, tid); __syncthreads();
    hinv_r4_pass<14>(X, tid); __syncthreads();
}

template <int LOGM> DI void hfwd_r4_pass2(LAS hc* X0, LAS hc* X1, int tid) {
    asm volatile("" : "+v"(tid));
    constexpr int M = 1 << LOGM, q = M >> 2;
#pragma unroll 4
    for (int t = tid; t < 4096; t += NTHR) {
        const int j = t & (q - 1), base = (t >> (LOGM - 2)) * M + j;
        constexpr int QP = (q >= 256) ? (q + (q >> 4) + (q >> 8)) : ((q == 16) ? 17 : 1);
        const int xo = XI(base);
        LAS hc* xp = X0 + xo; LAS hc* yp = X1 + xo;
        hc a0 = xp[0], a1 = xp[QP], a2 = xp[2 * QP], a3 = xp[3 * QP], b0 = yp[0], b1 = yp[QP], b2 = yp[2 * QP], b3 = yp[3 * QP];
        hfwd4(a0, a1, a2, a3); hfwd4(b0, b1, b2, b3);
        const hc w1 = htwid((float)j * (1.0f / M)), w2 = hcmul(w1, w1), w3 = hcmul(w2, w1);
        xp[0] = a0; xp[QP] = hcmul(a1, w1); xp[2 * QP] = hcmul(a2, w2); xp[3 * QP] = hcmul(a3, w3);
        yp[0] = b0; yp[QP] = hcmul(b1, w1); yp[2 * QP] = hcmul(b2, w2); yp[3 * QP] = hcmul(b3, w3);
    }
}
template <int LOGM> DI void hinv_r4_pass2(LAS hc* X0, LAS hc* X1, int tid) {
    asm volatile("" : "+v"(tid));
    constexpr int M = 1 << LOGM, q = M >> 2;
#pragma unroll 4
    for (int t = tid; t < 4096; t += NTHR) {
        const int j = t & (q - 1), base = (t >> (LOGM - 2)) * M + j;
        const hc w1 = htwidc((float)j * (1.0f / M)), w2 = hcmul(w1, w1), w3 = hcmul(w2, w1);
        constexpr int QP = (q >= 256) ? (q + (q >> 4) + (q >> 8)) : ((q == 16) ? 17 : 1);
        const int xo = XI(base);
        LAS hc* xp = X0 + xo; LAS hc* yp = X1 + xo;
        hc a0 = xp[0], a1 = hcmul(xp[QP], w1), a2 = hcmul(xp[2 * QP], w2), a3 = hcmul(xp[3 * QP], w3);
        hc b0 = yp[0], b1 = hcmul(yp[QP], w1), b2 = hcmul(yp[2 * QP], w2), b3 = hcmul(yp[3 * QP], w3);
        hinv4(a0, a1, a2, a3); hinv4(b0, b1, b2, b3);
        xp[0] = a0; xp[QP] = a1; xp[2 * QP] = a2; xp[3 * QP] = a3;
        yp[0] = b0; yp[QP] = b1; yp[2 * QP] = b2; yp[3 * QP] = b3;
    }
}
template <int LOGM> DI void hfwd16x2(hc (&v)[16], hc (&u)[16], int j) {
    constexpr int M = 1 << LOGM, q = M >> 4;
#pragma unroll
    for (int n = 0; n < 4; ++n) {
        hfwd4(v[n], v[n + 4], v[n + 8], v[n + 12]); hfwd4(u[n], u[n + 4], u[n + 8], u[n + 12]);
        const hc w1 = htwid((float)(j + n * q) * (1.0f / M)), w2 = hcmul(w1, w1), w3 = hcmul(w2, w1);
        v[n + 4] = hcmul(v[n + 4], w1); v[n + 8] = hcmul(v[n + 8], w2); v[n + 12] = hcmul(v[n + 12], w3);
        u[n + 4] = hcmul(u[n + 4], w1); u[n + 8] = hcmul(u[n + 8], w2); u[n + 12] = hcmul(u[n + 12], w3);
    }
    const hc u1 = htwid((float)j * (4.0f / M)), u2 = hcmul(u1, u1), u3 = hcmul(u2, u1);
#pragma unroll
    for (int m = 0; m < 4; ++m) {
        hfwd4(v[4 * m], v[4 * m + 1], v[4 * m + 2], v[4 * m + 3]); hfwd4(u[4 * m], u[4 * m + 1], u[4 * m + 2], u[4 * m + 3]);
        v[4 * m + 1] = hcmul(v[4 * m + 1], u1); v[4 * m + 2] = hcmul(v[4 * m + 2], u2); v[4 * m + 3] = hcmul(v[4 * m + 3], u3);
        u[4 * m + 1] = hcmul(u[4 * m + 1], u1); u[4 * m + 2] = hcmul(u[4 * m + 2], u2); u[4 * m + 3] = hcmul(u[4 * m + 3], u3);
    }
}
template <int LOGM> DI void hinv16x2(hc (&v)[16], hc (&u)[16], int j) {
    constexpr int M = 1 << LOGM, q = M >> 4;
    const hc u1 = htwidc((float)j * (4.0f / M)), u2 = hcmul(u1, u1), u3 = hcmul(u2, u1);
#pragma unroll
    for (int m = 0; m < 4; ++m) {
        v[4 * m + 1] = hcmul(v[4 * m + 1], u1); v[4 * m + 2] = hcmul(v[4 * m + 2], u2); v[4 * m + 3] = hcmul(v[4 * m + 3], u3);
        u[4 * m + 1] = hcmul(u[4 * m + 1], u1); u[4 * m + 2] = hcmul(u[4 * m + 2], u2); u[4 * m + 3] = hcmul(u[4 * m + 3], u3);
        hinv4(v[4 * m], v[4 * m + 1], v[4 * m + 2], v[4 * m + 3]); hinv4(u[4 * m], u[4 * m + 1], u[4 * m + 2], u[4 * m + 3]);
    }
#pragma unroll
    for (int n = 0; n < 4; ++n) {
        const hc w1 = htwidc((float)(j + n * q) * (1.0f / M)), w2 = hcmul(w1, w1), w3 = hcmul(w2, w1);
        v[n + 4] = hcmul(v[n + 4], w1); v[n + 8] = hcmul(v[n + 8], w2); v[n + 12] = hcmul(v[n + 12], w3);
        u[n + 4] = hcmul(u[n + 4], w1); u[n + 8] = hcmul(u[n + 8], w2); u[n + 12] = hcmul(u[n + 12], w3);
        hinv4(v[n], v[n + 4], v[n + 8], v[n + 12]); hinv4(u[n], u[n + 4], u[n + 8], u[n + 12]);
    }
}
template <int LOGM, bool FWD> DI void h_r16_pass2(LAS hc* X0, LAS hc* X1, int tid) {
    asm volatile("" : "+v"(tid));
    constexpr int M = 1 << LOGM, q = M >> 4;
#pragma unroll 1
    for (int t = tid; t < 1024; t += NTHR) {
        const int j = t & (q - 1), base = (t >> (LOGM - 4)) * M + j;
        constexpr int QP = (q >= 256) ? (q + (q >> 4) + (q >> 8)) : ((q == 16) ? 17 : 1);
        const int xo = XI(base);
        LAS hc* xp = X0 + xo; LAS hc* yp = X1 + xo;
        hc v[16], u[16];
#pragma unroll
        for (int n = 0; n < 16; ++n) { v[n] = xp[n * QP]; u[n] = yp[n * QP]; }
        if (FWD) hfwd16x2<LOGM>(v, u, j); else hinv16x2<LOGM>(v, u, j);
#pragma unroll
        for (int n = 0; n < 16; ++n) { xp[n * QP] = v[n]; yp[n * QP] = u[n]; }
    }
}
DI void pw_h(LAS hc* X, const f32x4* spec, int tid) {
#pragma unroll 8
    for (int r = 0; r < 16; ++r) {
        const int k = tid + NTHR * r; const int pp = rev4(k);
        const f32x4 sp = spec[k]; const cf P = (cf){sp[0], sp[1]} * 256.0f, Mq = (cf){sp[2], sp[3]} * 256.0f;
        const hc zh = X[XI(pp)]; const cf z = (cf){(float)zh.x, (float)zh.y};
        if (k == 0) { const cf y = cmul(z, P) + cmul((cf){z.x, -z.y}, Mq); X[XI(pp)] = (hc){(_Float16)y.x, (_Float16)y.y}; }
        else { const int pm = rev4(16384 - k); const hc zmh = X[XI(pm)]; const cf zm = (cf){(float)zmh.x, (float)zmh.y};
            const cf y = cmul(z, P) + cmul((cf){zm.x, -zm.y}, Mq);
            const cf t = cmul((cf){zm.x, -zm.y}, P) + cmul(z, Mq);
            X[XI(pp)] = (hc){(_Float16)y.x, (_Float16)y.y}; X[XI(pm)] = (hc){(_Float16)t.x, (_Float16)(-t.y)}; }
    }
    if (tid == 0) { const int pp = rev4(8192); const f32x4 sp = spec[8192]; const hc zh = X[XI(pp)]; const cf z = (cf){(float)zh.x, (float)zh.y};
        const cf y = (cmul(z, (cf){sp[0], sp[1]}) + cmul((cf){z.x, -z.y}, (cf){sp[2], sp[3]})) * 256.0f; X[XI(pp)] = (hc){(_Float16)y.x, (_Float16)y.y}; }
}
DI void fft_conv_h2(LAS hc* X0, LAS hc* X1, const f32x4* spec0, const f32x4* spec1, int tid) {
    hfwd_r4_pass2<14>(X0, X1, tid); __syncthreads();
    h_r16_pass2<12, true>(X0, X1, tid); __syncthreads();
    h_r16_pass2<8, true>(X0, X1, tid); __syncthreads();
    h_r16_pass2<4, true>(X0, X1, tid); __syncthreads();
    pw_h(X0, spec0, tid); pw_h(X1, spec1, tid);
    __syncthreads();
    h_r16_pass2<4, false>(X0, X1, tid); __syncthreads();
    h_r16_pass2<8, false>(X0, X1, tid); __syncthreads();
    h_r16_pass2<12, false>(X0, X1, tid); __syncthreads();
    hinv_r4_pass2<14>(X0, X1, tid); __syncthreads();
}

DI void spectra_item(const Params& p, int ditem, LAS unsigned char* lds) {
    int tid = tidx(); asm volatile("" : "+v"(tid));
    const int l = ditem >> 9, o = (ditem >> 8) & 1, d = ditem & 255, a = 4 * d;
    LAS hc* X0 = (LAS hc*)lds; LAS hc* X1 = X0 + 17472;
    const float mind = -3.0701134573253943f, maxd = -15.350567286626972f;
    float dec[4], sk[4];
#pragma unroll
    for (int c = 0; c < 4; ++c) { dec[c] = fabsf(mind + (float)(a + c) * ((maxd - mind) / 1023.0f)); sk[c] = p.in[I_HYSKIP][(l * 2 + o) * 1024 + a + c]; }
    const float* tf = (const float*)(p.ws + WS_TT) + ((size_t)l * 4096 + (o * 2 + 0) * 1024 + a) * S;
    const float* tb = (const float*)(p.ws + WS_TT) + ((size_t)l * 4096 + (o * 2 + 1) * 1024 + a) * S;
#pragma unroll 8
    for (int rr = 0; rr < 16; ++rr) {
        const int i = tid + NTHR * rr;
        const float ti = (float)i / 8191.0f;
        float f[4], b[4];
#pragma unroll
        for (int c = 0; c < 4; ++c) { const float e = __expf(-ti * dec[c]) * 256.0f; f[c] = tf[(size_t)c * S + i] * e; b[c] = tb[(size_t)c * S + i] * e; }
        if (i == 0) {
            X0[XI(0)] = (hc){(_Float16)(f[0] + b[0] + sk[0] * 256.0f), (_Float16)(f[1] + b[1] + sk[1] * 256.0f)}; X1[XI(0)] = (hc){(_Float16)(f[2] + b[2] + sk[2] * 256.0f), (_Float16)(f[3] + b[3] + sk[3] * 256.0f)};
            X0[XI(8192)] = (hc){(_Float16)0.f, (_Float16)0.f}; X1[XI(8192)] = (hc){(_Float16)0.f, (_Float16)0.f};
        } else {
            X0[XI(i)] = (hc){(_Float16)f[0], (_Float16)f[1]}; X1[XI(i)] = (hc){(_Float16)f[2], (_Float16)f[3]};
            X0[XI(16384 - i)] = (hc){(_Float16)b[0], (_Float16)b[1]}; X1[XI(16384 - i)] = (hc){(_Float16)b[2], (_Float16)b[3]};
        }
    }
    __syncthreads();
    hfwd_r4_pass2<14>(X0, X1, tid); __syncthreads();
    h_r16_pass2<12, true>(X0, X1, tid); __syncthreads();
    h_r16_pass2<8, true>(X0, X1, tid); __syncthreads();
    h_r16_pass2<4, true>(X0, X1, tid); __syncthreads();
    const float sc = 0.5f / 16384.0f / 256.0f;
#pragma unroll
    for (int half = 0; half < 2; ++half) {
        LAS hc* X = half ? X1 : X0;
        f32x4* spec = (f32x4*)(p.ws + WS_SPEC) + (size_t)((l * 2 + o) * 512 + 2 * d + half) * SPEC_STRIDE;
        for (int r = 0; r < 17; ++r) {
            const int k = tid + NTHR * r; if (k > 8192) break;
            const hc Fh = X[XI(rev4(k))], Fmh = X[XI(rev4((16384 - k) & 16383))]; const cf F = (cf){(float)Fh.x, (float)Fh.y}, Fm = (cf){(float)Fmh.x, (float)Fmh.y};
            const cf Fc = (cf){Fm.x, -Fm.y};
            const cf Ha = (F + Fc) * 0.5f, tt = (F - Fc) * 0.5f; const cf Hb = (cf){tt.y, -tt.x};
            const cf P = (Ha + Hb) * sc, Mq = (Ha - Hb) * sc;
            spec[k] = (f32x4){P.x, P.y, Mq.x, Mq.y};
        }
    }
    __syncthreads();
}

DI float conv3(const float* row, int t, float w0, float w1, float w2) {
    const float c = row[t]; float pv = row[t > 0 ? t - 1 : 0], nx = row[t < S - 1 ? t + 1 : S - 1];
    pv = t > 0 ? pv : 0.f; nx = t < S - 1 ? nx : 0.f;
    return w0 * pv + w1 * c + w2 * nx;
}
DI void hyena_item(const Params& p, int l, int dpr, LAS unsigned char* lds) {
    int tid = tidx(); asm volatile("" : "+v"(tid)); const int a = 4 * dpr;
    LAS hc* X0 = (LAS hc*)lds; LAS hc* X1 = X0 + 17472;
    const float* bint = (const float*)(p.ws + WS_BINT);
    const float* cw = p.in[I_HYCONV] + (size_t)l * 3 * 3072;
    const f32x4* spec = (const f32x4*)(p.ws + WS_SPEC);
    const hc hzero = (hc){(_Float16)0.f, (_Float16)0.f};
    float w[4][3];
#pragma unroll
    for (int c = 0; c < 4; ++c)
#pragma unroll
        for (int k = 0; k < 3; ++k) w[c][k] = cw[k * 3072 + 0 * 1024 + a + c];
#pragma unroll 4
    for (int r = 0; r < 16; ++r) { const int t = tid + NTHR * r;
        float v[4];
#pragma unroll
        for (int c = 0; c < 4; ++c) v[c] = conv3(bint + (size_t)(a + c) * S, t, w[c][0], w[c][1], w[c][2]) * 0.25f;
        X0[XI(t)] = (hc){(_Float16)v[0], (_Float16)v[1]}; X1[XI(t)] = (hc){(_Float16)v[2], (_Float16)v[3]};
        X0[XI(t + 8192)] = hzero; X1[XI(t + 8192)] = hzero; }
    __syncthreads();
    fft_conv_h2(X0, X1, spec + (size_t)((l * 2 + 0) * 512 + 2 * dpr) * SPEC_STRIDE, spec + (size_t)((l * 2 + 0) * 512 + 2 * dpr + 1) * SPEC_STRIDE, tid);
#pragma unroll
    for (int c = 0; c < 4; ++c)
#pragma unroll
        for (int k = 0; k < 3; ++k) w[c][k] = cw[k * 3072 + 1 * 1024 + a + c];
#pragma unroll 4
    for (int r = 0; r < 16; ++r) { const int t = tid + NTHR * r; const hc y0 = X0[XI(t)], y1 = X1[XI(t)];
        const float yv[4] = {(float)y0.x, (float)y0.y, (float)y1.x, (float)y1.y};
        float z[4];
#pragma unroll
        for (int c = 0; c < 4; ++c) z[c] = yv[c] * (1.0f / 64.0f) * conv3(bint + (size_t)(1024 + a + c) * S, t, w[c][0], w[c][1], w[c][2]) * 0.25f;
        X0[XI(t)] = (hc){(_Float16)z[0], (_Float16)z[1]}; X1[XI(t)] = (hc){(_Float16)z[2], (_Float16)z[3]};
        X0[XI(t + 8192)] = hzero; X1[XI(t + 8192)] = hzero; }
    __syncthreads();
    fft_conv_h2(X0, X1, spec + (size_t)((l * 2 + 1) * 512 + 2 * dpr) * SPEC_STRIDE, spec + (size_t)((l * 2 + 1) * 512 + 2 * dpr + 1) * SPEC_STRIDE, tid);
#pragma unroll
    for (int c = 0; c < 4; ++c)
#pragma unroll
        for (int k = 0; k < 3; ++k) w[c][k] = cw[k * 3072 + 2 * 1024 + a + c];
    float* z2t = (float*)(p.ws + WS_Z2T);
#pragma unroll 4
    for (int r = 0; r < 16; ++r) { const int t = tid + NTHR * r; const hc y0 = X0[XI(t)], y1 = X1[XI(t)];
        const float yv[4] = {(float)y0.x, (float)y0.y, (float)y1.x, (float)y1.y};
#pragma unroll
        for (int c = 0; c < 4; ++c) z2t[(size_t)(a + c) * S + t] = yv[c] * (1.0f / 64.0f) * conv3(bint + (size_t)(2048 + a + c) * S, t, w[c][0], w[c][1], w[c][2]); }
    __syncthreads();
}
DI void phase_rmsnorm(const float* x, const float* g, bf16_t* hout, float* fout) {
    const int tid = tidx(), wave = tid >> 6, lane = tid & 63;
    const int gw = blockIdx.x * NWAVES + wave, ngw = gridDim.x * NWAVES;
    for (int row = gw; row < S; row += 2 * ngw) {
        const int row2 = row + ngw;
        const bool has2 = row2 < S;
        const f32x4* xr = (const f32x4*)(x + (size_t)row * D) + lane;
        const f32x4* xr2 = (const f32x4*)(x + (size_t)(has2 ? row2 : row) * D) + lane;
        f32x4 v[8], v2[8]; float s = 0.f, s2 = 0.f;
#pragma unroll
        for (int j = 0; j < 8; ++j) { v[j] = xr[64 * j]; v2[j] = xr2[64 * j]; }
#pragma unroll
        for (int j = 0; j < 8; ++j) { s += (v[j][0] * v[j][0] + v[j][1] * v[j][1]) + (v[j][2] * v[j][2] + v[j][3] * v[j][3]); s2 += (v2[j][0] * v2[j][0] + v2[j][1] * v2[j][1]) + (v2[j][2] * v2[j][2] + v2[j][3] * v2[j][3]); }
        const float rstd = rsqrtf(wave_sum(s) * (1.0f / D) + 1e-6f), rstd2 = rsqrtf(wave_sum(s2) * (1.0f / D) + 1e-6f);
#pragma unroll
        for (int j = 0; j < 8; ++j) { const f32x4 gg = ((const f32x4*)g)[lane + 64 * j]; const f32x4 y = v[j] * rstd * gg, y2 = v2[j] * rstd2 * gg;
            if (hout) { u32x2 o = {pk2(y[0], y[1]), pk2(y[2], y[3])}; ((u32x2*)(hout + (size_t)row * D))[lane + 64 * j] = o;
                if (has2) { u32x2 o2 = {pk2(y2[0], y2[1]), pk2(y2[2], y2[3])}; ((u32x2*)(hout + (size_t)row2 * D))[lane + 64 * j] = o2; } }
            else { ((f32x4*)(fout + (size_t)row * D))[lane + 64 * j] = y; if (has2) ((f32x4*)(fout + (size_t)row2 * D))[lane + 64 * j] = y2; } }
    }
}

constexpr int KROW = 144, KBUF = 64 * KROW, VBUF = 128 * KROW;
DI void softmax_half(f32x16& s, const LAS float* btab, int k0, int q0w, int r, int hh, float cs, float& m, float& lsum, f32x16 (&O)[4]) {
    const int q = q0w + r;
    const int relmin = k0 - q0w - 31, relmax = k0 + 31 - q0w;
    float bc = 0.f, csx = cs;
    if (relmin >= 1024 || relmax <= -1024) { bc = btab[relmin >= 1024 ? 2048 : 0]; }
    else {
        if (relmin >= -1024 && relmax <= 1024) {
            const LAS float* bp = btab + (k0 - q + 1024 + 4 * hh);
#pragma unroll
            for (int i = 0; i < 16; ++i) s[i] = s[i] * cs + bp[(i & 3) + 8 * (i >> 2)];
        } else {
#pragma unroll
            for (int i = 0; i < 16; ++i) { const int rel = k0 + crow(i, hh) - q; const int i0 = min(max(rel, -1024), 1024) + 1024; s[i] = s[i] * cs + btab[i0]; }
        }
        csx = 1.0f;
    }
    float mx = s[0];
#pragma unroll
    for (int i = 1; i < 16; ++i) mx = fmaxf(mx, s[i]);
    mx = mx * csx + bc;
    mx = xhalf_max(mx);
    if (__any(mx > m + 8.0f)) {
        const float mnew = fmaxf(m, mx), alpha = __builtin_amdgcn_exp2f(m - mnew);
        m = mnew; lsum *= alpha;
#pragma unroll
        for (int db = 0; db < 4; ++db) O[db] *= alpha;
    }
    const float c2 = bc - m;
    float rs0 = 0.f, rs1 = 0.f;
#pragma unroll
    for (int i = 0; i < 16; i += 2) { s[i] = __builtin_amdgcn_exp2f(s[i] * csx + c2); s[i + 1] = __builtin_amdgcn_exp2f(s[i + 1] * csx + c2); rs0 += s[i]; rs1 += s[i + 1]; }
    lsum += rs0 + rs1;
}
constexpr int K3BUF = 64 * 128, V3BUF = 128 * 128;
DI void dstage_k(const bf16_t* kgl, LAS unsigned char* dst, int wave, int lane) {
    const int row = 8 * wave + (lane >> 3), gseg = (lane & 7) ^ ((row >> 1) & 7);
    __builtin_amdgcn_global_load_lds((const unsigned*)(kgl + (size_t)row * 256 + gseg * 8), (LAS unsigned*)(dst + wave * 1024), 16, 0, 0);
}
DI void dstage_v(const bf16_t* vgl, LAS unsigned char* dst, int wave, int lane) {
#pragma unroll
    for (int k = 0; k < 2; ++k) { const int ii = 2 * wave + k, row = 8 * ii + (lane >> 3), gseg = (lane & 7) ^ ((row >> 1) & 7);
        __builtin_amdgcn_global_load_lds((const unsigned*)(vgl + (size_t)row * S + gseg * 8), (LAS unsigned*)(dst + ii * 1024), 16, 0, 0); }
}
DI void sm_max_phase(f32x16& s, const LAS float* btab, int k0, int q0w, int r, int hh, float cs, float& m, float& lsum, f32x16 (&O)[4], float& csx, float& c2) {
    const int q = q0w + r;
    const int relmin = k0 - q0w - 31, relmax = k0 + 31 - q0w;
    float bc = 0.f; csx = cs;
    if (relmin >= 1024 || relmax <= -1024) { bc = btab[relmin >= 1024 ? 2048 : 0]; }
    else {
        if (relmin >= -1024 && relmax <= 1024) {
            const LAS float* bp = btab + (k0 - q + 1024 + 4 * hh);
#pragma unroll
            for (int i = 0; i < 16; ++i) s[i] = s[i] * cs + bp[(i & 3) + 8 * (i >> 2)];
        } else {
#pragma unroll
            for (int i = 0; i < 16; ++i) { const int rel = k0 + crow(i, hh) - q; const int i0 = min(max(rel, -1024), 1024) + 1024; s[i] = s[i] * cs + btab[i0]; }
        }
        csx = 1.0f;
    }
    float mx = s[0];
#pragma unroll
    for (int i = 1; i < 16; ++i) mx = fmaxf(mx, s[i]);
    mx = mx * csx + bc;
    mx = xhalf_max(mx);
    if (__any(mx > m + 8.0f)) {
        const float mnew = fmaxf(m, mx), alpha = __builtin_amdgcn_exp2f(m - mnew);
        m = mnew; lsum *= alpha;
#pragma unroll
        for (int db = 0; db < 4; ++db) O[db] *= alpha;
    }
    c2 = bc - m;
}
#define DF_EXP2(i0) do { s[i0] = __builtin_amdgcn_exp2f(s[i0] * csx + c2); s[(i0) + 1] = __builtin_amdgcn_exp2f(s[(i0) + 1] * csx + c2); rs0 += s[i0]; rs1 += s[(i0) + 1]; } while (0)
#define DF_FENCE __builtin_amdgcn_sched_barrier(0)
DI void diff_flash2(const bf16_t* proj, const bf16_t* vtc, int h, int c, int q0w, LAS unsigned char* lds, const LAS float* btab, f32x16 (&O)[4]) {
    int tid = tidx(); asm volatile("" : "+v"(tid)); const int lane = tid & 63, r = lane & 31, hh = lane >> 5, wave = __builtin_amdgcn_readfirstlane(tid >> 6);
    constexpr int NT = S / 64;
    bf16x8 qf[4];
    { const bf16_t* qp = proj + PIDX(q0w + r, C_CQKV + h * 128 + c * 64 + 8 * hh);
#pragma unroll
      for (int ks = 0; ks < 4; ++ks) qf[ks] = *(const bf16x8*)(qp + 16 * ks); }
#pragma unroll
    for (int db = 0; db < 4; ++db)
#pragma unroll
        for (int i = 0; i < 16; ++i) O[db][i] = 0.f;
    float m = -1e30f, lsum = 0.f;
    const float cs = 0.125f * LOG2E;
    const bf16_t* kg = proj + PIDX(0, C_CQKV + 1024 + h * 128 + c * 64);
    const bf16_t* vg = vtc + (size_t)(h * 128) * S;
    LAS unsigned char* Kb = lds; LAS unsigned char* Vb = lds + 3 * K3BUF;
    __syncthreads();
    dstage_k(kg, Kb, wave, lane); dstage_v(vg, Vb, wave, lane); dstage_k(kg + (size_t)64 * 256, Kb + K3BUF, wave, lane);
    asm volatile("s_waitcnt vmcnt(0)" ::: "memory");
    __syncthreads();
    const int swz = (r >> 1) & 7, rowoff = r * 128;
    int kso[4];
#pragma unroll
    for (int ks = 0; ks < 4; ++ks) kso[ks] = rowoff + (((2 * ks + hh) ^ swz) << 4);
    bf16x8 kf[4], vf[8];
    f32x16 s, sn;
#pragma unroll
    for (int i = 0; i < 16; ++i) s[i] = 0.f;
#pragma unroll
    for (int ks = 0; ks < 4; ++ks) { kf[ks] = *(const LAS bf16x8*)(Kb + kso[ks]); }
#pragma unroll
    for (int ks = 0; ks < 4; ++ks) s = MFMA32(kf[ks], qf[ks], s);
    int kc = 0, kn = K3BUF, kw = 2 * K3BUF;
#pragma unroll 1
    for (int t = 0; t < NT; ++t) {
        if (t + 2 < NT) dstage_k(kg + (size_t)(t + 2) * 64 * 256, Kb + kw, wave, lane);
        if (t + 1 < NT) dstage_v(vg + (t + 1) * 64, Vb + ((t + 1) & 1) * V3BUF, wave, lane);
        const LAS unsigned char* vb_ = Vb + (t & 1) * V3BUF;
#pragma unroll
        for (int half = 0; half < 2; ++half) {
#pragma unroll
            for (int ss = 0; ss < 2; ++ss) { const int vs = rowoff + (((4 * half + 2 * ss + hh) ^ swz) << 4);
#pragma unroll
                for (int db = 0; db < 4; ++db) vf[ss * 4 + db] = *(const LAS bf16x8*)(vb_ + vs + (32 * db) * 128); }
            const bool have_next = (half == 0) || (t + 1 < NT);
            { const LAS unsigned char* kbase = (half == 0) ? (Kb + kc + 32 * 128) : (Kb + kn);
              if (have_next) {
#pragma unroll
                  for (int ks = 0; ks < 4; ++ks) kf[ks] = *(const LAS bf16x8*)(kbase + kso[ks]); } }
            float csx, c2;
            sm_max_phase(s, btab, t * 64 + 32 * half, q0w, r, hh, cs, m, lsum, O, csx, c2);
            float rs0 = 0.f, rs1 = 0.f;
#pragma unroll
            for (int i = 0; i < 16; ++i) sn[i] = 0.f;
            DF_FENCE;
            sn = MFMA32(kf[0], qf[0], sn); DF_EXP2(0); DF_FENCE;
            sn = MFMA32(kf[1], qf[1], sn); DF_EXP2(2); DF_FENCE;
            sn = MFMA32(kf[2], qf[2], sn); DF_EXP2(4); DF_FENCE;
            sn = MFMA32(kf[3], qf[3], sn); DF_EXP2(6); DF_FENCE;
            const bf16x8 pf0 = pack8(s, 0);
            O[0] = MFMA32(vf[0], pf0, O[0]); DF_EXP2(8); DF_FENCE;
            O[1] = MFMA32(vf[1], pf0, O[1]); DF_EXP2(10); DF_FENCE;
            O[2] = MFMA32(vf[2], pf0, O[2]); DF_EXP2(12); DF_FENCE;
            O[3] = MFMA32(vf[3], pf0, O[3]); DF_EXP2(14); DF_FENCE;
            const bf16x8 pf1 = pack8(s, 1);
            O[0] = MFMA32(vf[4], pf1, O[0]); O[1] = MFMA32(vf[5], pf1, O[1]); O[2] = MFMA32(vf[6], pf1, O[2]); O[3] = MFMA32(vf[7], pf1, O[3]);
            lsum += rs0 + rs1;
            s = sn;
        }
        asm volatile("s_waitcnt vmcnt(0)" ::: "memory");
        __syncthreads();
        const int tmp = kc; kc = kn; kn = kw; kw = tmp;
    }
    const float lt = lsum + __shfl_xor(lsum, 32), inv = 1.0f / lt;
#pragma unroll
    for (int db = 0; db < 4; ++db) O[db] *= inv;
}
#undef DF_EXP2
#undef DF_FENCE
DI void diffattn_item(const Params& p, int l, int item, LAS unsigned char* lds) {
    int tid = tidx(); asm volatile("" : "+v"(tid)); const int wave = __builtin_amdgcn_readfirstlane(tid >> 6), lane = tid & 63, r = lane & 31, hh = lane >> 5;
    const int qt = item >> 3, h = item & 7, q0w = qt * 256 + wave * 32;
    LAS float* btab = (LAS float*)(lds + LDS_MAIN);
    const float* bias = (const float*)(p.ws + WS_BIAS) + (24 + h) * 2049;
    for (int i = tid; i < 2049; i += NTHR) btab[i] = bias[i];
    const float* dl = p.in[I_DLAM] + l * 256;
    float d01 = 0.f, d23 = 0.f;
    for (int i = 0; i < 64; ++i) { d01 += dl[i] * dl[64 + i]; d23 += dl[128 + i] * dl[192 + i]; }
    const float lam_init = 0.8f - 0.6f * expf(-0.3f * (float)l);
    const float lam = expf(d01) - expf(d23) + lam_init;
    const bf16_t* proj = (const bf16_t*)(p.ws + WS_PROJ); const bf16_t* vtc = (const bf16_t*)(p.ws + WS_VTC);
    f32x16 O0[4];
    const int q = q0w + r;
    float* ctmp = (float*)(p.ws + WS_CTMP) + (size_t)q * 1024 + h * 128 + 4 * hh;
    diff_flash2(proj, vtc, h, 0, q0w, lds, btab, O0);
#pragma unroll
    for (int db = 0; db < 4; ++db)
#pragma unroll
        for (int i4 = 0; i4 < 4; ++i4) { f32x4 o = {O0[db][4 * i4], O0[db][4 * i4 + 1], O0[db][4 * i4 + 2], O0[db][4 * i4 + 3]}; *(f32x4*)(ctmp + 32 * db + 8 * i4) = o; }
    diff_flash2(proj, vtc, h, 1, q0w, lds, btab, O0);
    float ss = 0.f;
#pragma unroll
    for (int db = 0; db < 4; ++db)
#pragma unroll
        for (int i4 = 0; i4 < 4; ++i4) { const f32x4 o0 = *(const f32x4*)(ctmp + 32 * db + 8 * i4);
#pragma unroll
            for (int e = 0; e < 4; ++e) { const float o = o0[e] - lam * O0[db][4 * i4 + e]; O0[db][4 * i4 + e] = o; ss += o * o; } }
    ss += __shfl_xor(ss, 32);
    const float rn = rsqrtf(ss * (1.0f / 128.0f) + 1e-6f) * (1.0f - lam_init);
    const float* dg = p.in[I_DG] + l * 128;
    bf16_t* cout = (bf16_t*)(p.ws + WS_BR) + (size_t)2 * S * 1024;
#pragma unroll
    for (int db = 0; db < 4; ++db)
#pragma unroll
        for (int i4 = 0; i4 < 4; ++i4) {
            const int d0 = 32 * db + 8 * i4 + 4 * hh;
            const f32x4 g4 = *(const f32x4*)(dg + d0);
            const u32x2 gt = *(const u32x2*)(proj + PIDX(q, C_CGATE + h * 128 + d0));
            const float y0 = O0[db][4 * i4 + 0] * rn * g4[0] * silu_f(bflo(gt[0])), y1 = O0[db][4 * i4 + 1] * rn * g4[1] * silu_f(bfhi(gt[0]));
            const float y2 = O0[db][4 * i4 + 2] * rn * g4[2] * silu_f(bflo(gt[1])), y3 = O0[db][4 * i4 + 3] * rn * g4[3] * silu_f(bfhi(gt[1]));
            u32x2 o = {pk2(y0, y1), pk2(y2, y3)};
            *(u32x2*)(cout + (size_t)q * 1024 + h * 128 + d0) = o;
        }
    __syncthreads();
}

DI void mixA_wave_item(const Params& p, int wi, int lane, const LAS float* tb) {
    asm volatile("" : "+v"(lane));
    const int g = wi >> 11, rem = wi & 2047, h = rem >> 8, qb = rem & 255;
    const int sh = 2 * g, n = S >> sh, nbq = 256 >> sh, res = qb / nbq, m0 = (qb % nbq) * 32;
    const int r = lane & 31, hh = lane >> 5;
    const bf16_t* proj = (const bf16_t*)(p.ws + WS_PROJ);
    const int qpos = ((m0 + r) << sh) + res;
    bf16x8 qf[8];
    { const bf16_t* qp = proj + PIDX(qpos, g * 3072 + h * 128 + 8 * hh);
#pragma unroll
      for (int ks = 0; ks < 8; ++ks) qf[ks] = *(const bf16x8*)(qp + 16 * ks); }
    f32x16 O[4];
#pragma unroll
    for (int db = 0; db < 4; ++db)
#pragma unroll
        for (int i = 0; i < 16; ++i) O[db][i] = 0.f;
    float m = -1e30f, lsum = 0.f;
    const float cs = 0.08838834764831845f * LOG2E;
    const LAS float* tbl = tb + 31 - r + 4 * hh;
    const bf16_t* vt = (const bf16_t*)(p.ws + WS_VTA) + (size_t)((g * 8 + h) * 128) * S + res * n;
    bf16x8 kf[8];
    { const int mk0r = m0 - 64; const int mk0 = (mk0r >= 0 && mk0r < n) ? mk0r : m0;
      const bf16_t* kp = proj + PIDX(((mk0 + r) << sh) + res, g * 3072 + 1024 + h * 128 + 8 * hh);
#pragma unroll
      for (int ks = 0; ks < 8; ++ks) kf[ks] = *(const bf16x8*)(kp + 16 * ks); }
#pragma unroll 1
    for (int kb = 0; kb < 5; ++kb) {
        const int mk0r = m0 - 64 + 32 * kb;
        const bool blk_ok = (mk0r >= 0) && (mk0r < n);
        const int mk0 = blk_ok ? mk0r : m0;
        bf16x8 vfr[2][4];
#pragma unroll
        for (int sidx = 0; sidx < 2; ++sidx)
#pragma unroll
            for (int db = 0; db < 4; ++db) {
                const bf16_t* vp = vt + (size_t)(32 * db + r) * S + mk0 + 16 * sidx + 4 * hh;
                const s16x4 lo = *(const s16x4*)vp, hi = *(const s16x4*)(vp + 8);
                vfr[sidx][db] = __builtin_shufflevector(lo, hi, 0, 1, 2, 3, 4, 5, 6, 7);
            }
        __builtin_amdgcn_sched_barrier(0);
        f32x16 s;
#pragma unroll
        for (int i = 0; i < 16; ++i) s[i] = 0.f;
#pragma unroll
        for (int ks = 0; ks < 8; ++ks) s = MFMA32(kf[ks], qf[ks], s);
        if (kb < 4) {
            const int nk0r = m0 - 64 + 32 * (kb + 1); const int nk0 = (nk0r >= 0 && nk0r < n) ? nk0r : m0;
            const bf16_t* kp = proj + PIDX(((nk0 + r) << sh) + res, g * 3072 + 1024 + h * 128 + 8 * hh);
#pragma unroll
            for (int ks = 0; ks < 8; ++ks) kf[ks] = *(const bf16x8*)(kp + 16 * ks);
        }
        __builtin_amdgcn_sched_barrier(0);
        float mx = -INFINITY;
#pragma unroll
        for (int i = 0; i < 16; ++i) { const int rel = mk0r + crow(i, hh) - (m0 + r); const bool valid = blk_ok && (rel <= 64) && (rel >= -64);
            const float bv = tbl[32 * kb + (i & 3) + 8 * (i >> 2)];
            const float v = valid ? (s[i] * cs + bv) : -INFINITY; s[i] = v; mx = fmaxf(mx, v); }
        mx = xhalf_max(mx);
        const float mnew = fmaxf(m, mx), alpha = __builtin_amdgcn_exp2f(m - mnew);
        m = mnew;
        float rs = 0.f;
#pragma unroll
        for (int i = 0; i < 16; ++i) { s[i] = __builtin_amdgcn_exp2f(s[i] - mnew); rs += s[i]; }
        lsum = lsum * alpha + rs;
#pragma unroll
        for (int db = 0; db < 4; ++db) O[db] *= alpha;
#pragma unroll
        for (int sidx = 0; sidx < 2; ++sidx) {
            const bf16x8 pf = pack8(s, sidx);
#pragma unroll
            for (int db = 0; db < 4; ++db) O[db] = MFMA32(vfr[sidx][db], pf, O[db]);
        }
    }
    const float lt = lsum + __shfl_xor(lsum, 32), inv = 1.0f / lt;
    float* oa = (float*)(p.ws + WS_OA) + ((size_t)g * S + qpos) * 1024 + h * 128;
#pragma unroll
    for (int db = 0; db < 4; ++db)
#pragma unroll
        for (int i4 = 0; i4 < 4; ++i4) {
            const int d0 = 32 * db + 8 * i4 + 4 * hh;
            f32x4 o = {O[db][4 * i4] * inv, O[db][4 * i4 + 1] * inv, O[db][4 * i4 + 2] * inv, O[db][4 * i4 + 3] * inv};
            *(f32x4*)(oa + d0) = o;
        }
    if (hh == 0) ((float*)(p.ws + WS_LSEA))[((size_t)g * S + qpos) * 8 + h] = m + __log2f(lt);
}

DI void phase_post(const Params& p, LAS unsigned char* lds) {
    const int tid = tidx();
    const bf16_t* proj = (const bf16_t*)(p.ws + WS_PROJ);
    bf16_t* aout = (bf16_t*)(p.ws + WS_BR); bf16_t* bout = aout + (size_t)S * 1024;
    const float* oa = (const float*)(p.ws + WS_OA); const float* lse = (const float*)(p.ws + WS_LSEA);
    for (int idx0 = blockIdx.x * NTHR + tid; idx0 < S * 256; idx0 += 4 * gridDim.x * NTHR) {
        float l0[4], l1[4], l2[4]; f32x4 o0[4], o1[4], o2[4]; u32x2 gt[4];
#pragma unroll
        for (int u = 0; u < 4; ++u) { const int idx = idx0 + u * gridDim.x * NTHR; const int pos = idx >> 8, c4 = idx & 255, h = c4 >> 5, col = c4 * 4;
            l0[u] = lse[((size_t)0 * S + pos) * 8 + h]; l1[u] = lse[((size_t)1 * S + pos) * 8 + h]; l2[u] = lse[((size_t)2 * S + pos) * 8 + h];
            o0[u] = *(const f32x4*)(oa + ((size_t)0 * S + pos) * 1024 + col); o1[u] = *(const f32x4*)(oa + ((size_t)1 * S + pos) * 1024 + col); o2[u] = *(const f32x4*)(oa + ((size_t)2 * S + pos) * 1024 + col);
            gt[u] = *(const u32x2*)(proj + PIDX(pos, C_AGATE + col)); }
#pragma unroll
        for (int u = 0; u < 4; ++u) { const int idx = idx0 + u * gridDim.x * NTHR; const int pos = idx >> 8, c4 = idx & 255, col = c4 * 4;
            const float mx = fmaxf(l0[u], fmaxf(l1[u], l2[u]));
            const float w0 = __builtin_amdgcn_exp2f(l0[u] - mx), w1 = __builtin_amdgcn_exp2f(l1[u] - mx), w2 = __builtin_amdgcn_exp2f(l2[u] - mx);
            const float inv = __builtin_amdgcn_rcpf(w0 + w1 + w2);
            const f32x4 o = (o0[u] * w0 + o1[u] * w1 + o2[u] * w2) * inv;
            u32x2 ov = {pk2(o[0] * silu_f(bflo(gt[u][0])), o[1] * silu_f(bfhi(gt[u][0]))), pk2(o[2] * silu_f(bflo(gt[u][1])), o[3] * silu_f(bfhi(gt[u][1])))};
            *(u32x2*)(aout + (size_t)pos * 1024 + col) = ov; }
    }
    LAS float* tile = (LAS float*)lds;
    const float* z2t = (const float*)(p.ws + WS_Z2T);
    for (int it0 = blockIdx.x * 4; it0 < 128 * 16; it0 += gridDim.x * 4) {
        __syncthreads();
        f32x4 v[4][2];
#pragma unroll
        for (int u = 0; u < 4; ++u) { const int it = it0 + u, t0 = (it >> 4) * 64, c0 = (it & 15) * 64;
#pragma unroll
            for (int k = 0; k < 2; ++k) { const int e = tid + NTHR * k; const int ci = e >> 4, t4 = (e & 15) * 4; v[u][k] = *(const f32x4*)(z2t + (size_t)(c0 + ci) * S + t0 + t4); } }
#pragma unroll
        for (int u = 0; u < 4; ++u)
#pragma unroll
            for (int k = 0; k < 2; ++k) { const int e = tid + NTHR * k; const int ci = e >> 4, t4 = (e & 15) * 4; LAS float* d = tile + u * 4160 + ci * 65 + t4;
                d[0] = v[u][k][0]; d[1] = v[u][k][1]; d[2] = v[u][k][2]; d[3] = v[u][k][3]; }
        __syncthreads();
        u32x2 gt[4][2];
#pragma unroll
        for (int u = 0; u < 4; ++u) { const int it = it0 + u, t0 = (it >> 4) * 64, c0 = (it & 15) * 64;
#pragma unroll
            for (int k = 0; k < 2; ++k) { const int e = tid + NTHR * k; const int ti = e >> 4, cc = (e & 15) * 4; gt[u][k] = *(const u32x2*)(proj + PIDX(t0 + ti, C_BGATE + c0 + cc)); } }
#pragma unroll
        for (int u = 0; u < 4; ++u) { const int it = it0 + u, t0 = (it >> 4) * 64, c0 = (it & 15) * 64;
#pragma unroll
            for (int k = 0; k < 2; ++k) { const int e = tid + NTHR * k; const int ti = e >> 4, cc = (e & 15) * 4; const LAS float* sp = tile + u * 4160 + cc * 65 + ti;
                const float y0 = sp[0] * silu_f(bflo(gt[u][k][0])), y1 = sp[65] * silu_f(bfhi(gt[u][k][0]));
                const float y2 = sp[130] * silu_f(bflo(gt[u][k][1])), y3 = sp[195] * silu_f(bfhi(gt[u][k][1]));
                u32x2 ov = {pk2(y0, y1), pk2(y2, y3)};
                *(u32x2*)(bout + (size_t)(t0 + ti) * 1024 + c0 + cc) = ov; } }
    }
    __syncthreads();
}

#ifndef REP_GEMMIN
#define REP_GEMMIN 1
#endif
#ifndef REP_DIFF
#define REP_DIFF 1
#endif
#ifndef REP_HYENA
#define REP_HYENA 1
#endif
#ifndef REP_MIXA
#define REP_MIXA 1
#endif
#ifndef REP_PRO
#define REP_PRO 1
#endif
#ifndef REP_SPEC
#define REP_SPEC 1
#endif
#ifndef REP_MISC
#define REP_MISC 1
#endif
#ifndef REP_PROJ
#define REP_PROJ 1
#endif
constexpr int NPH = 3 + 6 * DEPTH + 1;
typedef const Params __attribute__((address_space(4)))* ParamsK;
DI Params ldp(ParamsK pc) {
    asm volatile("" : "+s"(pc));
    Params q;
#pragma unroll
    for (int i = 0; i < 18; ++i) q.in[i] = pc->in[i];
    q.out = pc->out; q.ws = pc->ws; q.ph_lo = pc->ph_lo; q.ph_hi = pc->ph_hi;
    return q;
}
DI void run_phase(ParamsK pc, int ph, LAS unsigned char* lds) {
    if (ph == 0) { for (int rep = 0; rep < REP_PRO; ++rep) { const Params p = ldp(pc); phase_prologue(p, lds); __syncthreads(); } return; }
    if (ph == 1) { const Params p = ldp(pc); phase_tgen(p); return; }
    if (ph == 2) { for (int rep = 0; rep < REP_SPEC; ++rep) { const Params p = ldp(pc); for (int it = blockIdx.x; it < DEPTH * 2 * 256; it += gridDim.x) spectra_item(p, it, lds); } return; }
    if (ph == NPH - 1) { const Params p = ldp(pc); phase_rmsnorm((const float*)(p.ws + WS_X), p.in[I_FINALG], nullptr, p.out); return; }
    const int l = (ph - 3) / 6, sp = (ph - 3) % 6;
    if (sp == 0) { for (int rep = 0; rep < REP_MISC; ++rep) { const Params p = ldp(pc); phase_rmsnorm((l == 0) ? p.in[I_X] : (const float*)(p.ws + WS_X), p.in[I_NORMG] + l * D, (bf16_t*)(p.ws + WS_H), nullptr); } return; }
    if (sp == 1) {
        const Params p = ldp(pc);
        pg8::Gemm g{(const bf16_t*)(p.ws + WS_H), (const bf16_t*)(p.ws + WS_WIN) + (size_t)l * NIN * D, S, NIN, D};
        pg8::StaticOrder so; so.init(S, NIN, gridDim.x, blockIdx.x);
        EpiIn e{(bf16_t*)(p.ws + WS_PROJ), (bf16_t*)(p.ws + WS_VTA), (bf16_t*)(p.ws + WS_VTC), (float*)(p.ws + WS_BINT), lds + 131072};
#pragma unroll 1
        for (int rep = 0; rep < REP_GEMMIN; ++rep) { pg8::gemm_phase(lds, g, so, e); __syncthreads(); }
        return;
    }
    if (sp == 2) {
#pragma unroll 1
        for (int it = blockIdx.x; it < 256 + 256 + 768; it += gridDim.x) {
            int l2 = l; asm volatile("" : "+s"(l2));
            const Params p = ldp(pc);
            if (it < 256) { for (int rep = 0; rep < REP_DIFF; ++rep) diffattn_item(p, l2, it, lds); }
            else if (it < 512) { for (int rep = 0; rep < REP_HYENA; ++rep) hyena_item(p, l2, it - 256, lds); }
            else {
                const int tid2 = tidx(), wi0 = (it - 512) * NWAVES, g = wi0 >> 11, h = (wi0 & 2047) >> 8;
                LAS float* tb = (LAS float*)lds;
                __syncthreads();
                if (tid2 < 192) { const int rel = tid2 - 95; float v = 0.f;
                    if (rel >= -64 && rel <= 64) v = ((const float*)(p.ws + WS_BIAS))[(g * 8 + h) * 2049 + min(max(rel << (2 * g), -1024), 1024) + 1024];
                    tb[tid2] = v; }
                __syncthreads();
                for (int rep = 0; rep < REP_MIXA; ++rep) mixA_wave_item(p, wi0 + (tid2 >> 6), tid2 & 63, tb);
            }
        }
        return;
    }
    if (sp == 3) { for (int rep = 0; rep < REP_MISC; ++rep) { const Params p = ldp(pc); phase_post(p, lds); } return; }
    if (sp == 4) {
#pragma unroll 1
        for (int rep = 0; rep < REP_PROJ; ++rep) {
            const Params p = ldp(pc);
            pg8::Gemm g{(const bf16_t*)(p.ws + WS_BR), (const bf16_t*)(p.ws + WS_WPR) + (size_t)(l * 3) * D * 1024, 3 * S, 3 * D, 1024};
            ProjOrder po; po.so.init(S, D, gridDim.x, blockIdx.x);
            EpiProj e{(const bf16_t*)(p.ws + WS_PROJ), p.in[I_MERGEB] + (size_t)l * 3 * D, (float*)(p.ws + WS_YF), (bf16_t*)(p.ws + WS_YB)};
            pg8::gemm_phase(lds, g, po, e);
            __syncthreads();
        }
        return;
    }
    {
        const Params p = ldp(pc);
        pg8::Gemm g{(const bf16_t*)(p.ws + WS_YB), (const bf16_t*)(p.ws + WS_WOUT) + (size_t)l * D * D, S, D, D};
        pg8::StaticOrder so; so.init(S, D, gridDim.x, blockIdx.x);
        EpiOut e{(l == 0) ? p.in[I_X] : (const float*)(p.ws + WS_X), (float*)(p.ws + WS_X)};
#pragma unroll 1
        for (int rep = 0; rep < ((l == 0) ? REP_MISC : 1); ++rep) { pg8::gemm_phase(lds, g, so, e); __syncthreads(); }
    }
}


#define XB_TMO      128
#define XB_XCNT(j)  (256  + 64 * (j))
#define XB_XSUB(j)  (1280 + 64 * (j))
#define XB_XGEN(j)  (2304 + 64 * (j))
#define XB_TOP      3328
#define XB_TOPGEN   3392
#define XCD_BAR_WORDS 3456
#define XB_SPIN_CAP (1u << 18)
DI unsigned xb_ld(unsigned* p)              { return __hip_atomic_load(p, __ATOMIC_RELAXED, __HIP_MEMORY_SCOPE_AGENT); }
DI unsigned xb_add(unsigned* p, unsigned v) { return __hip_atomic_fetch_add(p, v, __ATOMIC_RELAXED, __HIP_MEMORY_SCOPE_AGENT); }
DI unsigned xb_xcc_id() { return (unsigned)__builtin_amdgcn_s_getreg((3 << 11) | 20) & 0xFu; }
#define XB_SPIN(cond, bar) do { unsigned _sp = 0; while (cond) { __builtin_amdgcn_s_sleep(1); \
    if ((++_sp & 255u) == 0u) { if (xb_ld(&(bar)[XB_TMO])) break; if (_sp > XB_SPIN_CAP) { atomicAdd(&(bar)[XB_TMO], 1u); break; } } } } while (0)
struct XcdBarrier { unsigned* bar; unsigned x; volatile LAS unsigned* st; };
DI XcdBarrier xcd_barrier_post(unsigned* bar, volatile LAS unsigned* st) {
    XcdBarrier b; b.bar = bar; b.x = xb_xcc_id(); b.st = st;
    if (threadIdx.x == 0) (void)xb_add(&bar[XB_XCNT(b.x)], 1u);
    return b;
}
DI void xcd_barrier_complete(unsigned* bar, unsigned x, unsigned& nloc, unsigned& nx) {
    const unsigned G = gridDim.x * gridDim.y * gridDim.z;
    unsigned sum, cnt, mine, sp = 0u;
    for (;;) {
        sum = 0u; cnt = 0u; mine = 0u;
#pragma unroll
        for (unsigned j = 0; j < 16; ++j) { const unsigned c = xb_ld(&bar[XB_XCNT(j)]); sum += c; cnt += (c > 0u) ? 1u : 0u; mine = (j == x) ? c : mine; }
        if (sum == G) break;
        __builtin_amdgcn_s_sleep(1);
        if ((++sp & 255u) == 0u) { if (xb_ld(&bar[XB_TMO])) break; if (sp > XB_SPIN_CAP) { atomicAdd(&bar[XB_TMO], 1u); break; } }
    }
    nloc = mine > 0u ? mine : 1u; nx = cnt > 0u ? cnt : 1u;
}
DI void xcd_barrier(const XcdBarrier& b) {
    asm volatile("s_waitcnt vmcnt(0)" ::: "memory");
    __syncthreads();
    if (threadIdx.x == 0) {
        unsigned* bar = b.bar;
        __builtin_amdgcn_s_waitcnt(0);
        unsigned nloc = b.st[0], nx = b.st[1];
        if (nloc == 0u) { xcd_barrier_complete(bar, b.x, nloc, nx); b.st[0] = nloc; b.st[1] = nx; }
        const unsigned old = xb_add(&bar[XB_XSUB(b.x)], 1u);
        const unsigned gen = old / nloc;
        if (old + 1u == (gen + 1u) * nloc) {
            __builtin_amdgcn_fence(__ATOMIC_RELEASE, "agent");
            asm volatile("s_waitcnt vmcnt(0)" ::: "memory");
            const unsigned og = xb_add(&bar[XB_TOP], 1u);
            const unsigned tg = og / nx;
            if (og + 1u == (tg + 1u) * nx) xb_add(&bar[XB_TOPGEN], 1u);
            else XB_SPIN(xb_ld(&bar[XB_TOPGEN]) == tg, bar);
            __builtin_amdgcn_fence(__ATOMIC_ACQUIRE, "agent");
            xb_add(&bar[XB_XGEN(b.x)], 1u);
            asm volatile("s_waitcnt vmcnt(0)" ::: "memory");
        } else {
            XB_SPIN(xb_ld(&bar[XB_XGEN(b.x)]) == gen, bar);
            __builtin_amdgcn_fence(__ATOMIC_ACQUIRE, "agent");
            asm volatile("s_waitcnt vmcnt(0)" ::: "memory");
        }
    }
    __syncthreads();
}

__global__ void __launch_bounds__(512, 2) mega_kernel(Params p) {
#if defined(__HIP_DEVICE_COMPILE__)
    extern __shared__ __attribute__((aligned(16))) unsigned char shm[];
    LAS unsigned char* lds = (LAS unsigned char*)shm;
    cg::grid_group grid = cg::this_grid();
    const int ph_lo = p.ph_lo, ph_hi = p.ph_hi;
    volatile LAS unsigned* st = (volatile LAS unsigned*)(lds + LDS_BYTES - 16);
    if (threadIdx.x == 0) { st[0] = 0u; st[1] = 0u; }
    __syncthreads();
    const XcdBarrier xb = xcd_barrier_post((unsigned*)(p.ws + WS_BAR), st);
#pragma unroll 1
    for (int ph = ph_lo; ph < ph_hi; ++ph) {
        ParamsK pc = (ParamsK)__builtin_amdgcn_kernarg_segment_ptr();
        run_phase(pc, ph, lds);
        if (ph + 1 < ph_hi) { if (ph == ph_lo) grid.sync(); else xcd_barrier(xb); }
    }
#endif
}

#ifndef N_LAUNCH_MODE
#define N_LAUNCH_MODE 1
#endif
extern "C" void kernel_launch(void* const* d_in, const int* in_sizes, int n_in, void* d_out, int out_size, void* d_ws, size_t ws_size, hipStream_t stream) {
    static int grid = 0;
    if (grid == 0) {
        int dev = 0, cus = 0;
        if (hipGetDevice(&dev) != hipSuccess || hipDeviceGetAttribute(&cus, hipDeviceAttributeMultiprocessorCount, dev) != hipSuccess) { fprintf(stderr, "kernel_launch: device query failed\n"); grid = -1; return; }
        if (hipFuncSetAttribute((const void*)mega_kernel, hipFuncAttributeMaxDynamicSharedMemorySize, LDS_BYTES) != hipSuccess) { fprintf(stderr, "kernel_launch: hipFuncSetAttribute failed\n"); grid = -1; return; }
        int per_cu = 0;
        if (hipOccupancyMaxActiveBlocksPerMultiprocessor(&per_cu, (const void*)mega_kernel, NTHR, LDS_BYTES) != hipSuccess || per_cu < 1) { fprintf(stderr, "kernel_launch: occupancy query says %d\n", per_cu); (void)hipGetLastError(); }
        if (n_in != 18 || ws_size < WS_END) { fprintf(stderr, "kernel_launch: n_in %d ws %zu (need %zu)\n", n_in, ws_size, (size_t)WS_END); grid = -1; return; }
        grid = cus;
    }
    if (grid < 0) return;
    Params p{};
    for (int i = 0; i < 18; ++i) p.in[i] = (const float*)d_in[i];
    p.out = (float*)d_out; p.ws = (unsigned char*)d_ws;
    if (hipMemsetAsync((unsigned char*)d_ws + WS_BAR, 0, 16384, stream) != hipSuccess) { fprintf(stderr, "kernel_launch: memset of barrier words failed\n"); return; }
#if N_LAUNCH_MODE == 1
    p.ph_lo = 0; p.ph_hi = NPH;
    void* args[] = {&p};
    hipError_t e = hipLaunchCooperativeKernel((const void*)mega_kernel, dim3(grid), dim3(NTHR), args, LDS_BYTES, stream);
    if (e != hipSuccess) fprintf(stderr, "cooperative launch failed: %s (grid %d)\n", hipGetErrorString(e), grid);
#else
    for (int ph = 0; ph < NPH; ++ph) {
        p.ph_lo = ph; p.ph_hi = ph + 1;
        hipLaunchKernelGGL(mega_kernel, dim3(grid), dim3(NTHR), LDS_BYTES, stream, p);
    }
#endif
}
```

```cpp
#include <hip/hip_runtime.h>
#include <hip/hip_cooperative_groups.h>
#include <cstdio>
namespace cg = cooperative_groups;
#define DI __device__ __forceinline__
#define LAS __attribute__((address_space(3)))
typedef unsigned short bf16_t;
typedef short bf16x8 __attribute__((ext_vector_type(8)));
typedef short s16x4 __attribute__((ext_vector_type(4)));
typedef float f32x4 __attribute__((ext_vector_type(4)));
typedef float f32x16 __attribute__((ext_vector_type(16)));
typedef float f32x2 __attribute__((ext_vector_type(2)));
typedef float cf __attribute__((ext_vector_type(2)));
typedef __bf16 bf16x2n __attribute__((ext_vector_type(2)));
typedef unsigned u32x2 __attribute__((ext_vector_type(2)));
typedef unsigned u32x4 __attribute__((ext_vector_type(4)));

DI unsigned pk2(float lo, float hi) { f32x2 v = {lo, hi}; return __builtin_bit_cast(unsigned, __builtin_convertvector(v, bf16x2n)); }
DI float bflo(unsigned u) { return __uint_as_float(u << 16); }
DI float bfhi(unsigned u) { return __uint_as_float(u & 0xffff0000u); }
DI float silu_f(float x) { return x * __builtin_amdgcn_rcpf(1.0f + __expf(-x)); }
DI float sigm_f(float x) { return __builtin_amdgcn_rcpf(1.0f + __expf(-x)); }

DI int tidx() { int t = threadIdx.x; asm volatile("" : "+v"(t)); return t; }

constexpr int S = 8192, D = 2048, NIN = 24576, DEPTH = 4;
constexpr int C_AGATE = 9216, C_BIN = 10240, C_BGATE = 13312, C_CQKV = 14336, C_CGATE = 17408, C_MERGE = 18432;
constexpr float LOG2E = 1.4426950408889634f;
constexpr int NTHR = 512, NWAVES = 8;
constexpr int LDS_MAIN = 143360, LDS_AUX = 16384, LDS_BYTES = LDS_MAIN + LDS_AUX;

constexpr size_t WS_WIN  = 0;
constexpr size_t WS_WPR  = WS_WIN  + (size_t)DEPTH * NIN * D * 2;
constexpr size_t WS_WOUT = WS_WPR  + (size_t)DEPTH * 3 * D * 1024 * 2;
constexpr size_t WS_SPEC = WS_WOUT + (size_t)DEPTH * D * D * 2;
constexpr size_t WS_HID2 = WS_SPEC + (size_t)DEPTH * 2 * 512 * 8208 * 16;
constexpr size_t WS_BIAS = WS_HID2 + (size_t)DEPTH * S * 64 * 4;
constexpr size_t WS_X    = WS_BIAS + 524288;
constexpr size_t WS_H    = WS_X    + (size_t)S * D * 4;
constexpr size_t WS_PROJ = WS_H    + (size_t)S * D * 2;
constexpr size_t WS_BINT = WS_PROJ + (size_t)S * NIN * 2;
constexpr size_t WS_VTA  = WS_BINT + (size_t)3072 * S * 4;
constexpr size_t WS_VTC  = WS_VTA  + (size_t)3 * 1024 * S * 2;
constexpr size_t WS_OA   = WS_VTC  + (size_t)1024 * S * 2;
constexpr size_t WS_LSEA = WS_OA   + (size_t)3 * S * 1024 * 4;
constexpr size_t WS_Z2T  = WS_LSEA + (size_t)3 * S * 8 * 4;
constexpr size_t WS_BR   = WS_Z2T  + (size_t)1024 * S * 4;
constexpr size_t WS_YF   = WS_BR   + (size_t)3 * S * 1024 * 2;
constexpr size_t WS_YB   = WS_YF   + (size_t)S * D * 4;
constexpr size_t WS_CTMP = WS_YB   + (size_t)S * D * 2;
constexpr size_t WS_BAR  = WS_CTMP + (size_t)S * 1024 * 4;
constexpr size_t WS_TT   = WS_BAR + 16384;
constexpr size_t WS_END  = WS_TT + (size_t)DEPTH * 4096 * S * 4;

DI size_t PIDX(int row, int col) { return ((size_t)(col >> 8) * S + row) * 256 + (col & 255); }

struct Params {
    const float* in[18];
    float* out;
    unsigned char* ws;
    int ph_lo, ph_hi;
};
enum { I_X = 0, I_NORMG, I_FINALG, I_WIN, I_MERGEB, I_RELB, I_HYCONV, I_HYW1, I_HYB1, I_HYFREQ, I_HYW2, I_HYB2, I_HYW3, I_HYSKIP, I_DLAM, I_DG, I_WPROJ, I_WOUT };

namespace pg8 {
constexpr int BM = 256, BK = 64, HALF = 128, HTB = HALF * BK * 2, NXCD = 8, WGM = 8;
DI int lds_byte(int r, int c) { const int st = (r >> 4) * 2 + (c >> 5), rr = r & 15, cc = c & 31, ob = rr * 64 + cc * 2; return st * 1024 + (ob ^ (((ob >> 9) & 1) << 5)); }
DI void stage_rc(int b, int& R, int& C) { const int st = b / 1024, sb = b % 1024, swz = sb ^ (((sb >> 9) & 1) << 5); R = (st >> 1) * 16 + swz / 64; C = (st & 1) * 32 + (swz % 64) / 2; }
DI int perm32(int rho) { const int n = rho >> 4, i = rho & 15; return 8 * (i >> 2) + 4 * n + (i & 3); }
struct Unit { int pm, pn; };
struct Gemm { const bf16_t* A; const bf16_t* Bt; int M, N, K; };
struct StaticOrder {
    int nM, nN, nwg, G, c;
    DI void init(int M, int N, int G_, int c_) { nM = M / BM; nN = N / BM; nwg = nM * nN; G = G_; c = c_; }
    DI bool next(int i, Unit& u) const {
        const long L = (long)i * G + c; if (L >= nwg) return false;
        int wgid = (int)L; { const int q = nwg / NXCD, r = nwg % NXCD, xcd = wgid % NXCD, off = wgid / NXCD; wgid = (xcd < r ? xcd * (q + 1) : r * (q + 1) + (xcd - r) * q) + off; }
        const int nig = WGM * nN, gid = wgid / nig, fm = gid * WGM, gsz = (nM - fm) < WGM ? (nM - fm) : WGM;
        u.pm = fm + ((wgid % nig) % gsz); u.pn = (wgid % nig) / gsz; return true;
    }
};
template <class Epi, class Sched>
DI void gemm_phase(LAS unsigned char* lds, const Gemm g, const Sched& S, const Epi& E) {
    const int tid = tidx(), wid = __builtin_amdgcn_readfirstlane(tid >> 6), lane = tid & 63, wr = wid >> 2, wc = wid & 3, fr = lane & 15, fq = lane >> 4;
    const int K = g.K, nt = K / BK;
    unsigned voffA[2], voffB[2];
#pragma unroll
    for (int i = 0; i < 2; ++i) { int R, C; stage_rc(tid * 16 + i * 8192, R, C); const int Rb = Epi::PERM ? ((R & ~31) + perm32(R & 31)) : R; voffA[i] = (unsigned)(R * K + C) * 2u; voffB[i] = (unsigned)(Rb * K + C) * 2u; }
    const size_t kstep = (size_t)(BK * 2);
    const size_t hstep = (size_t)HALF * K * 2;
    const size_t tstep = 2 * hstep;
    const unsigned ldsw = (unsigned)wid * 1024u;
    const int aoff = lds_byte(wr * 64 + fr, fq * 8), boff = lds_byte(wc * 32 + fr, fq * 8);
#define PG8_SA(b, h) (((b) * 2 + (h)) * HTB)
#define PG8_SB(b, h) ((4 + (b) * 2 + (h)) * HTB)
#define PG8_STAGE(bufoff, gbase, voff) do { _Pragma("unroll") for (int _i = 0; _i < 2; ++_i) \
        __builtin_amdgcn_global_load_lds((const unsigned*)((const char*)(gbase) + (voff)[_i]), (LAS unsigned*)(lds + (bufoff) + ldsw + _i * 8192), 16, 0, 0); } while (0)
#define PG8_LDA(dst, b, h) do { _Pragma("unroll") for (int m = 0; m < 4; ++m) _Pragma("unroll") for (int k = 0; k < 2; ++k) dst[m][k] = *(const LAS bf16x8*)(lds + PG8_SA(b, h) + aoff + m * 2048 + k * 1024); } while (0)
#define PG8_LDB(dst, b, h) do { _Pragma("unroll") for (int n = 0; n < 2; ++n) _Pragma("unroll") for (int k = 0; k < 2; ++k) dst[n][k] = *(const LAS bf16x8*)(lds + PG8_SB(b, h) + boff + n * 2048 + k * 1024); } while (0)
#define PG8_MMA(ai, bj, At, Bt) do { __builtin_amdgcn_s_setprio(1); _Pragma("unroll") for (int m = 0; m < 4; ++m) _Pragma("unroll") for (int n = 0; n < 2; ++n) _Pragma("unroll") for (int k = 0; k < 2; ++k) \
        acc[ai][bj][m][n] = __builtin_amdgcn_mfma_f32_16x16x32_bf16(Bt[n][k], At[m][k], acc[ai][bj][m][n], 0, 0, 0); __builtin_amdgcn_s_setprio(0); } while (0)
#define PG8_WAIT_V(n) asm volatile("s_waitcnt vmcnt(" #n ")" ::: "memory")
#define PG8_WAIT_L(n) asm volatile("s_waitcnt lgkmcnt(" #n ")" ::: "memory")
#define PG8_BAR __builtin_amdgcn_s_barrier()
#define PG8_SCHED __builtin_amdgcn_sched_barrier(0)
    Unit cur, nxt; int ui = 0;
    if (!S.next(0, cur)) return;
    f32x4 acc[2][2][4][2];
#pragma unroll
    for (int a = 0; a < 2; ++a)
#pragma unroll
        for (int b = 0; b < 2; ++b)
#pragma unroll
            for (int m = 0; m < 4; ++m)
#pragma unroll
                for (int n = 0; n < 2; ++n) acc[a][b][m][n] = (f32x4){0.f, 0.f, 0.f, 0.f};
    bf16x8 At[4][2], B0[2][2], B1[2][2];
    const char* cA = (const char*)g.A + (size_t)cur.pm * tstep; const char* cB = (const char*)g.Bt + (size_t)cur.pn * tstep;
    PG8_STAGE(PG8_SB(0, 0), cB, voffB); PG8_STAGE(PG8_SA(0, 0), cA, voffA); PG8_STAGE(PG8_SB(0, 1), cB + hstep, voffB); PG8_STAGE(PG8_SA(0, 1), cA + hstep, voffA);
    if (wr == 1) PG8_BAR;
    PG8_WAIT_V(4); PG8_BAR;
    PG8_STAGE(PG8_SB(1, 0), cB + kstep, voffB); PG8_STAGE(PG8_SA(1, 0), cA + kstep, voffA); PG8_STAGE(PG8_SB(1, 1), cB + hstep + kstep, voffB);
    PG8_WAIT_V(6); PG8_BAR;
    for (;;) {
        const bool has_next = S.next(ui + 1, nxt);
        const char* nA = has_next ? (const char*)g.A + (size_t)nxt.pm * tstep : cA; const char* nB = has_next ? (const char*)g.Bt + (size_t)nxt.pn * tstep : cB;
        for (int t = 0; t < nt; t += 2) {
            const bool last = (t == nt - 2);
            const char* a1 = cA + (size_t)(t + 1) * kstep;
            const char* a2 = last ? nA : cA + (size_t)(t + 2) * kstep; const char* b2 = last ? nB : cB + (size_t)(t + 2) * kstep;
            const char* a3 = a2 + kstep; const char* b3 = b2 + kstep;
            PG8_LDB(B0, 0, 0); PG8_SCHED; PG8_LDA(At, 0, 0); PG8_STAGE(PG8_SA(1, 1), a1 + hstep, voffA);
            PG8_WAIT_L(8); PG8_BAR; PG8_WAIT_L(0); PG8_MMA(0, 0, At, B0); PG8_BAR; PG8_SCHED;
            PG8_LDB(B1, 0, 1); PG8_STAGE(PG8_SB(0, 0), b2, voffB);
            PG8_BAR; PG8_WAIT_L(0); PG8_MMA(0, 1, At, B1); PG8_BAR;
            PG8_LDA(At, 0, 1); PG8_STAGE(PG8_SA(0, 0), a2, voffA);
            PG8_BAR; PG8_WAIT_L(0); PG8_MMA(1, 0, At, B0); PG8_BAR; PG8_SCHED;
            PG8_STAGE(PG8_SB(0, 1), b2 + hstep, voffB);
            PG8_WAIT_V(6); PG8_BAR; PG8_MMA(1, 1, At, B1); PG8_BAR;
            PG8_LDB(B0, 1, 0); PG8_SCHED; PG8_LDA(At, 1, 0); PG8_STAGE(PG8_SA(0, 1), a2 + hstep, voffA);
            PG8_WAIT_L(8); PG8_BAR; PG8_WAIT_L(0); PG8_MMA(0, 0, At, B0); PG8_BAR; PG8_SCHED;
            PG8_LDB(B1, 1, 1); PG8_STAGE(PG8_SB(1, 0), b3, voffB);
            PG8_BAR; PG8_WAIT_L(0); PG8_MMA(0, 1, At, B1); PG8_BAR;
            PG8_LDA(At, 1, 1); PG8_STAGE(PG8_SA(1, 0), a3, voffA);
            PG8_BAR; PG8_WAIT_L(0); PG8_MMA(1, 0, At, B0); PG8_BAR; PG8_SCHED;
            PG8_STAGE(PG8_SB(1, 1), b3 + hstep, voffB);
            PG8_WAIT_V(6); PG8_BAR; PG8_MMA(1, 1, At, B1); PG8_BAR;
        }
        const bool keep = E(acc, cur, wr, wc, fr, fq);
        if (!has_next) break;
        if (!keep)
#pragma unroll
        for (int a = 0; a < 2; ++a)
#pragma unroll
            for (int b = 0; b < 2; ++b)
#pragma unroll
                for (int m = 0; m < 4; ++m)
#pragma unroll
                    for (int n = 0; n < 2; ++n) acc[a][b][m][n] = (f32x4){0.f, 0.f, 0.f, 0.f};
        cur = nxt; cA = nA; cB = nB; ++ui;
    }
    PG8_WAIT_V(0);
    if (wr == 0) PG8_BAR;
    PG8_BAR;
#undef PG8_SA
#undef PG8_SB
#undef PG8_STAGE
#undef PG8_LDA
#undef PG8_LDB
#undef PG8_MMA
#undef PG8_WAIT_V
#undef PG8_WAIT_L
#undef PG8_BAR
#undef PG8_SCHED
}
}

struct EpiIn {
    static constexpr bool PERM = true;
    bf16_t* proj; bf16_t* vta; bf16_t* vtc; float* bint; LAS unsigned char* tlds;
    DI bool operator()(const f32x4 (&acc)[2][2][4][2], const pg8::Unit& u, int wr, int wc, int fr, int fq) const { store(acc, u, wr, wc, fr, fq); return false; }
    DI void store(const f32x4 (&acc)[2][2][4][2], const pg8::Unit& u, int wr, int wc, int fr, int fq) const {
        const int colt = u.pn * 256;
        int kind = 0;
        if (colt < C_AGATE) { if ((colt % 3072) >= 2048) kind = 1; }
        else if (colt >= C_BIN && colt < C_BGATE) kind = 2;
        else if (colt >= C_CQKV + 2048 && colt < C_CGATE) kind = 3;
        const int row0 = u.pm * 256 + wr * 64 + fr, col0 = colt + wc * 32 + 8 * fq;
        if (kind == 0) {
#pragma unroll
            for (int ai = 0; ai < 2; ++ai)
#pragma unroll
                for (int m = 0; m < 4; ++m) { bf16_t* rp = proj + PIDX(row0 + ai * 128 + m * 16, col0);
#pragma unroll
                    for (int bj = 0; bj < 2; ++bj) { const f32x4 a = acc[ai][bj][m][0], b = acc[ai][bj][m][1];
                        u32x4 o = {pk2(a[0], a[1]), pk2(a[2], a[3]), pk2(b[0], b[1]), pk2(b[2], b[3])}; *(u32x4*)(rp + bj * 128) = o; } }
        } else if (kind == 1 && colt >= 2 * 3072) {
            bf16_t* base = vta + (ptrdiff_t)(2 * 1024 - 2 * 3072 - 2048) * (ptrdiff_t)S;
#pragma unroll
            for (int ai = 0; ai < 2; ++ai) { const int prow = fr * (S >> 4) + ((u.pm * 256 + ai * 128 + wr * 64) >> 4);
#pragma unroll
                for (int bj = 0; bj < 2; ++bj)
#pragma unroll
                    for (int n = 0; n < 2; ++n)
#pragma unroll
                        for (int e = 0; e < 4; ++e) { u32x2 o = {pk2(acc[ai][bj][0][n][e], acc[ai][bj][1][n][e]), pk2(acc[ai][bj][2][n][e], acc[ai][bj][3][n][e])};
                            *(u32x2*)(base + (ptrdiff_t)(col0 + bj * 128 + n * 4 + e) * (ptrdiff_t)S + prow) = o; } }
        } else {
            const int lane = fr + 16 * fq, wave = wr * 4 + wc;
            LAS float* tl = (LAS float*)(tlds + wave * 2304);
            const int cl = lane >> 1, hs = lane & 1;
            const int colg = colt + wc * 32 + cl;
#pragma unroll
            for (int ai = 0; ai < 2; ++ai)
#pragma unroll
                for (int bj = 0; bj < 2; ++bj)
#pragma unroll
                    for (int m = 0; m < 4; ++m) {
                        const int rowb = u.pm * 256 + ai * 128 + wr * 64 + m * 16;
#pragma unroll
                        for (int n = 0; n < 2; ++n)
#pragma unroll
                            for (int e = 0; e < 4; ++e) tl[(8 * fq + 4 * n + e) * 17 + fr] = acc[ai][bj][m][n][e];
                        __builtin_amdgcn_wave_barrier();
                        const LAS float* tc = tl + cl * 17;
                        const int col = colg + bj * 128;
                        if (kind == 2) {
                            f32x4 o0 = {tc[8 * hs], tc[8 * hs + 1], tc[8 * hs + 2], tc[8 * hs + 3]}, o1 = {tc[8 * hs + 4], tc[8 * hs + 5], tc[8 * hs + 6], tc[8 * hs + 7]};
                            float* bp = bint + (size_t)(col - C_BIN) * S + rowb + 8 * hs;
                            *(f32x4*)bp = o0; *(f32x4*)(bp + 4) = o1;
                        } else if (kind == 3) {
                            u32x4 o = {pk2(tc[4 * hs], tc[4 * hs + 1]), pk2(tc[4 * hs + 2], tc[4 * hs + 3]), pk2(tc[8 + 4 * hs], tc[9 + 4 * hs]), pk2(tc[10 + 4 * hs], tc[11 + 4 * hs])};
                            *(u32x4*)(vtc + (size_t)(col - (C_CQKV + 2048)) * S + rowb + 8 * hs) = o;
                        } else if (colt < 3072) {
                            u32x4 o = {pk2(tc[8 * hs], tc[8 * hs + 1]), pk2(tc[8 * hs + 2], tc[8 * hs + 3]), pk2(tc[8 * hs + 4], tc[8 * hs + 5]), pk2(tc[8 * hs + 6], tc[8 * hs + 7])};
                            *(u32x4*)(vta + (size_t)(col - 2048) * S + rowb + 8 * hs) = o;
                        } else {
#pragma unroll
                            for (int k = 0; k < 2; ++k) { const int res = 2 * hs + k;
                                u32x2 o = {pk2(tc[res], tc[res + 4]), pk2(tc[res + 8], tc[res + 12])};
                                *(u32x2*)(vta + (size_t)(1024 + col - 3072 - 2048) * S + res * (S >> 2) + (rowb >> 2)) = o; }
                        }
                        __builtin_amdgcn_wave_barrier();
                    }
        }
    }
};
struct ProjOrder {
    pg8::StaticOrder so;
    DI bool next(int i, pg8::Unit& u) const { pg8::Unit b; if (!so.next(i / 3, b)) return false; const int nb = i % 3; u.pm = b.pm + 32 * nb; u.pn = b.pn + 8 * nb; return true; }
};
struct EpiProj {   static constexpr bool PERM = false;
    const bf16_t* proj; const float* mb; bf16_t* yb;
    DI bool operator()(f32x4 (&acc)[2][2][4][2], const pg8::Unit& u, int wr, int wc, int fr, int fq) const {
        const int nb = u.pm >> 5, nn = nb < 2 ? nb + 1 : nb;
        const int row0 = (u.pm & 31) * 256 + wr * 64 + fr, col0 = (u.pn & 7) * 256 + wc * 32 + 4 * fq;
        f32x4 bc[2][2], bn[2][2];
#pragma unroll
        for (int bj = 0; bj < 2; ++bj)
#pragma unroll
            for (int n = 0; n < 2; ++n) { bc[bj][n] = *(const f32x4*)(mb + nb * D + col0 + bj * 128 + n * 16); bn[bj][n] = *(const f32x4*)(mb + nn * D + col0 + bj * 128 + n * 16); }
#pragma unroll
        for (int ai = 0; ai < 2; ++ai)
#pragma unroll
            for (int mp = 0; mp < 2; ++mp) {
                u32x2 gc[2][2][2], gn[2][2][2];
#pragma unroll
                for (int mi = 0; mi < 2; ++mi) { const int row = row0 + ai * 128 + (2 * mp + mi) * 16;
#pragma unroll
                    for (int bj = 0; bj < 2; ++bj)
#pragma unroll
                        for (int n = 0; n < 2; ++n) { const int col = col0 + bj * 128 + n * 16;
                            gc[mi][bj][n] = *(const u32x2*)(proj + PIDX(row, C_MERGE + nb * D + col));
                            gn[mi][bj][n] = *(const u32x2*)(proj + PIDX(row, C_MERGE + nn * D + col)); } }
#pragma unroll
                for (int mi = 0; mi < 2; ++mi) { const int m = 2 * mp + mi; const int row = row0 + ai * 128 + m * 16;
#pragma unroll
                    for (int bj = 0; bj < 2; ++bj)
#pragma unroll
                        for (int n = 0; n < 2; ++n) { const int col = col0 + bj * 128 + n * 16;
                            const u32x2 c2 = gc[mi][bj][n], n2 = gn[mi][bj][n]; const f32x4 cb = bc[bj][n], nbv = bn[bj][n];
                            const float xc[4] = {bflo(c2[0]) + cb[0], bfhi(c2[0]) + cb[1], bflo(c2[1]) + cb[2], bfhi(c2[1]) + cb[3]};
                            const float xn[4] = {bflo(n2[0]) + nbv[0], bfhi(n2[0]) + nbv[1], bflo(n2[1]) + nbv[2], bfhi(n2[1]) + nbv[3]};
                            if (nb < 2) {
#pragma unroll
                                for (int e = 0; e < 4; ++e) acc[ai][bj][m][n][e] *= (1.0f + __expf(-xn[e])) * __builtin_amdgcn_rcpf(1.0f + __expf(-xc[e]));
                            } else {
                                const f32x4 a = acc[ai][bj][m][n];
                                u32x2 o = {pk2(a[0] * sigm_f(xc[0]), a[1] * sigm_f(xc[1])), pk2(a[2] * sigm_f(xc[2]), a[3] * sigm_f(xc[3]))};
                                *(u32x2*)(yb + (size_t)row * D + col) = o;
                            } } }
            }
        return nb < 2;
    }
};
struct EpiOut {   static constexpr bool PERM = false;
    const float* xold; float* xnew;
    DI bool operator()(const f32x4 (&acc)[2][2][4][2], const pg8::Unit& u, int wr, int wc, int fr, int fq) const { store(acc, u, wr, wc, fr, fq); return false; }
    DI void store(const f32x4 (&acc)[2][2][4][2], const pg8::Unit& u, int wr, int wc, int fr, int fq) const {
        const int row0 = u.pm * 256 + wr * 64 + fr, col0 = u.pn * 256 + wc * 32 + 4 * fq;
#pragma unroll
        for (int ai = 0; ai < 2; ++ai)
#pragma unroll
            for (int mp = 0; mp < 2; ++mp) {
                f32x4 xv[2][2][2];
#pragma unroll
                for (int mi = 0; mi < 2; ++mi)
#pragma unroll
                    for (int bj = 0; bj < 2; ++bj)
#pragma unroll
                        for (int n = 0; n < 2; ++n) xv[mi][bj][n] = *(const f32x4*)(xold + (size_t)(row0 + ai * 128 + (2 * mp + mi) * 16) * D + col0 + bj * 128 + n * 16);
#pragma unroll
                for (int mi = 0; mi < 2; ++mi)
#pragma unroll
                    for (int bj = 0; bj < 2; ++bj)
#pragma unroll
                        for (int n = 0; n < 2; ++n) *(f32x4*)(xnew + (size_t)(row0 + ai * 128 + (2 * mp + mi) * 16) * D + col0 + bj * 128 + n * 16) = xv[mi][bj][n] + acc[ai][bj][2 * mp + mi][n];
            }
    }
};
DI float wave_sum(float v) {
#pragma unroll
    for (int o = 1; o < 64; o <<= 1) v += __shfl_xor(v, o);
    return v;
}
typedef unsigned u32x2v __attribute__((ext_vector_type(2)));
DI float xhalf_max(float x) {
    const unsigned u = __float_as_uint(x);
    const u32x2v rr = __builtin_amdgcn_permlane32_swap(u, u, false, false);
    return fmaxf(__uint_as_float(rr[0]), __uint_as_float(rr[1]));
}
DI int crow(int reg, int h) { return (reg & 3) + 8 * (reg >> 2) + 4 * h; }
DI bf16x8 pack8(const f32x16& x, const int s) {
    u32x4 p;
    p[0] = pk2(x[8 * s + 0], x[8 * s + 1]); p[1] = pk2(x[8 * s + 2], x[8 * s + 3]);
    p[2] = pk2(x[8 * s + 4], x[8 * s + 5]); p[3] = pk2(x[8 * s + 6], x[8 * s + 7]);
    return __builtin_bit_cast(bf16x8, p);
}
#define MFMA32(a, b, c) __builtin_amdgcn_mfma_f32_32x32x16_bf16((a), (b), (c), 0, 0, 0)

DI void transpose_item(const float* Wsrc, int K, int N, bf16_t* WT, LAS float* scr, int item, int lane) {
    const int nblk = N / 64, kb = item / nblk, nb = item % nblk, k0 = 64 * kb, n0 = 64 * nb;
    const int lr = lane >> 4, lc = (lane & 15) * 4;
    f32x4 v[16];
#pragma unroll
    for (int i = 0; i < 16; ++i) v[i] = *(const f32x4*)(Wsrc + (size_t)(k0 + 4 * i + lr) * N + n0 + lc);
#pragma unroll
    for (int i = 0; i < 16; ++i) { LAS float* d = scr + (4 * i + lr) * 65 + lc; d[0] = v[i][0]; d[1] = v[i][1]; d[2] = v[i][2]; d[3] = v[i][3]; }
    __builtin_amdgcn_wave_barrier();
    const int c = lane & 7;
#pragma unroll
    for (int j = 0; j < 8; ++j) { const int n = (lane >> 3) + 8 * j; const LAS float* s = scr + (8 * c) * 65 + n;
        u32x4 o; o[0] = pk2(s[0 * 65], s[1 * 65]); o[1] = pk2(s[2 * 65], s[3 * 65]); o[2] = pk2(s[4 * 65], s[5 * 65]); o[3] = pk2(s[6 * 65], s[7 * 65]);
        *(u32x4*)(WT + (size_t)(n0 + n) * K + k0 + 8 * c) = o; }
    __builtin_amdgcn_wave_barrier();
}
DI int t5_bucket(int rel) {
    const int ret = rel > 0 ? 16 : 0; const int n = rel < 0 ? -rel : rel;
    const float nf = (float)(n > 1 ? n : 1);
    int large = 8 + (int)(logf(nf / 8.0f) / 4.852030263919617f * 8.0f);
    large = large < 15 ? large : 15;
    return ret + (n < 8 ? n : large);
}
DI void phase_prologue(const Params& p, LAS unsigned char* lds) {
    const int tid = tidx(), wave = tid >> 6, lane = tid & 63;
    const int gw = blockIdx.x * NWAVES + wave, NGW = gridDim.x * NWAVES;
    LAS float* scr = (LAS float*)(lds + wave * 16640);
    bf16_t* win_t = (bf16_t*)(p.ws + WS_WIN); bf16_t* wpr_t = (bf16_t*)(p.ws + WS_WPR); bf16_t* wout_t = (bf16_t*)(p.ws + WS_WOUT);
    constexpr int IT_IN = (D / 64) * (NIN / 64), IT_PR = (1024 / 64) * (D / 64), IT_OUT = (D / 64) * (D / 64);
    constexpr int TOT = DEPTH * IT_IN + DEPTH * 3 * IT_PR + DEPTH * IT_OUT;
    for (int it = gw; it < TOT; it += NGW) {
        int r = it;
        if (r < DEPTH * IT_IN) { const int l = r / IT_IN; transpose_item(p.in[I_WIN] + (size_t)l * D * NIN, D, NIN, win_t + (size_t)l * NIN * D, scr, r % IT_IN, lane); continue; }
        r -= DEPTH * IT_IN;
        if (r < DEPTH * 3 * IT_PR) { const int l = r / IT_PR; transpose_item(p.in[I_WPROJ] + (size_t)l * 1024 * D, 1024, D, wpr_t + (size_t)l * D * 1024, scr, r % IT_PR, lane); continue; }
        r -= DEPTH * 3 * IT_PR;
        { const int l = r / IT_OUT; transpose_item(p.in[I_WOUT] + (size_t)l * D * D, D, D, wout_t + (size_t)l * D * D, scr, r % IT_OUT, lane); }
    }
    float* bias = (float*)(p.ws + WS_BIAS);
    for (int i = blockIdx.x * NTHR + tid; i < 32 * 2049; i += gridDim.x * NTHR) {
        const int hd = i / 2049, rel = (i % 2049) - 1024;
        bias[i] = p.in[I_RELB][t5_bucket(rel) * 32 + hd] * LOG2E;
    }
    __syncthreads();
    LAS float* zemb = (LAS float*)lds;
    LAS float* h1 = (LAS float*)(lds + 2048);
    float* hid2 = (float*)(p.ws + WS_HID2);
    for (int rb = blockIdx.x; rb < S / 8; rb += gridDim.x) {
        const int rl = tid >> 6, j = tid & 63, i = rb * 8 + rl;
        if (j < 33) {
            float z;
            if (j == 0) z = (float)i / 8191.0f;
            else { const int k = (j - 1) & 15; const float fb = 1e-4f + (float)k * ((15.0f - 1e-4f) / 15.0f); const float w = 6.283185307179586f * (float)i / 8192.0f; const float a = fb * w; z = (j <= 16) ? cosf(a) : -sinf(a); }
            zemb[rl * 36 + j] = z;
        }
        __syncthreads();
        for (int l = 0; l < DEPTH; ++l) {
            float a1 = p.in[I_HYB1][l * 64 + j];
            for (int e = 0; e < 33; ++e) a1 += zemb[rl * 36 + e] * p.in[I_HYW1][(l * 33 + e) * 64 + j];
            h1[rl * 64 + j] = sinf(p.in[I_HYFREQ][(l * 2 + 0) * 64 + j] * a1);
            __syncthreads();
            float a2 = p.in[I_HYB2][l * 64 + j];
            for (int e = 0; e < 64; ++e) a2 += h1[rl * 64 + e] * p.in[I_HYW2][(l * 64 + e) * 64 + j];
            hid2[((size_t)l * S + i) * 64 + j] = sinf(p.in[I_HYFREQ][(l * 2 + 1) * 64 + j] * a2);
            __syncthreads();
        }
    }
}


DI void split8(const f32x4 a, const f32x4 b, bf16x8& hi, bf16x8& lo) {
    u32x4 h, l2;
    h[0] = pk2(a[0], a[1]); h[1] = pk2(a[2], a[3]); h[2] = pk2(b[0], b[1]); h[3] = pk2(b[2], b[3]);
    l2[0] = pk2(a[0] - bflo(h[0]), a[1] - bfhi(h[0])); l2[1] = pk2(a[2] - bflo(h[1]), a[3] - bfhi(h[1]));
    l2[2] = pk2(b[0] - bflo(h[2]), b[1] - bfhi(h[2])); l2[3] = pk2(b[2] - bflo(h[3]), b[3] - bfhi(h[3]));
    hi = __builtin_bit_cast(bf16x8, h); lo = __builtin_bit_cast(bf16x8, l2);
}
DI void phase_tgen(const Params& p) {
    const int tid = tidx(), wave = tid >> 6, lane = tid & 63, r = lane & 31, hh = lane >> 5;
    float* tt = (float*)(p.ws + WS_TT);
    for (int it = blockIdx.x * NWAVES + wave; it < DEPTH * 128 * 4; it += gridDim.x * NWAVES) {
        const int l = it >> 9, cb = (it >> 2) & 127, rc = it & 3;
        const float* w3 = p.in[I_HYW3] + (size_t)l * 64 * 4096 + cb * 32 + r;
        bf16x8 ahi[4], alo[4];
#pragma unroll
        for (int ks = 0; ks < 4; ++ks) {
            f32x4 a, b;
#pragma unroll
            for (int j = 0; j < 4; ++j) { a[j] = w3[(size_t)(16 * ks + 8 * hh + j) * 4096]; b[j] = w3[(size_t)(16 * ks + 8 * hh + 4 + j) * 4096]; }
            split8(a, b, ahi[ks], alo[ks]);
        }
        const float* hid2 = (const float*)(p.ws + WS_HID2) + (size_t)l * S * 64;
        f32x4 ha[4], hb[4];
        { const float* hr = hid2 + (size_t)(rc * 2048 + r) * 64 + 8 * hh;
#pragma unroll
          for (int ks = 0; ks < 4; ++ks) { ha[ks] = *(const f32x4*)(hr + 16 * ks); hb[ks] = *(const f32x4*)(hr + 16 * ks + 4); } }
#pragma unroll 1
        for (int rb = 0; rb < 64; ++rb) {
            const int i0 = rc * 2048 + rb * 32;
            bf16x8 bhi[4], blo[4];
#pragma unroll
            for (int ks = 0; ks < 4; ++ks) split8(ha[ks], hb[ks], bhi[ks], blo[ks]);
            if (rb + 1 < 64) { const float* hr = hid2 + (size_t)(i0 + 32 + r) * 64 + 8 * hh;
#pragma unroll
                for (int ks = 0; ks < 4; ++ks) { ha[ks] = *(const f32x4*)(hr + 16 * ks); hb[ks] = *(const f32x4*)(hr + 16 * ks + 4); } }
            f32x16 acc;
#pragma unroll
            for (int i = 0; i < 16; ++i) acc[i] = 0.f;
#pragma unroll
            for (int ks = 0; ks < 4; ++ks) { acc = MFMA32(ahi[ks], bhi[ks], acc); acc = MFMA32(ahi[ks], blo[ks], acc); acc = MFMA32(alo[ks], bhi[ks], acc); }
            float* tp = tt + ((size_t)l * 4096 + cb * 32) * S + i0 + r;
#pragma unroll
            for (int reg = 0; reg < 16; ++reg) tp[(size_t)crow(reg, hh) * S] = acc[reg];
        }
    }
}

#define XI(i) ((i) + ((i) >> 4) + ((i) >> 8))
DI cf cmul(cf a, cf b) {
    cf t, r;
    asm("v_pk_mul_f32 %0, %1, %2 op_sel:[0,0] op_sel_hi:[0,1]" : "=v"(t) : "v"(a), "v"(b));
    asm("v_pk_fma_f32 %0, %1, %2, %3 op_sel:[1,1,0] op_sel_hi:[1,0,1] neg_lo:[0,1,0]" : "=v"(r) : "v"(a), "v"(b), "v"(t));
    return r;
}
DI cf twid(float frac) { float c = __builtin_amdgcn_cosf(frac), s = __builtin_amdgcn_sinf(frac); asm volatile("s_nop 1" : "+v"(c), "+v"(s)); return (cf){c, -s}; }
DI cf twidc(float frac) { float c = __builtin_amdgcn_cosf(frac), s = __builtin_amdgcn_sinf(frac); asm volatile("s_nop 1" : "+v"(c), "+v"(s)); return (cf){c, s}; }
DI void fwd4(cf& a0, cf& a1, cf& a2, cf& a3) {
    const cf s02 = a0 + a2, d02 = a0 - a2, s13 = a1 + a3, d13 = a1 - a3;
    a0 = s02 + s13; a2 = s02 - s13;
    a1 = (cf){d02.x + d13.y, d02.y - d13.x};
    a3 = (cf){d02.x - d13.y, d02.y + d13.x};
}
DI void inv4(cf& b0, cf& b1, cf& b2, cf& b3) {
    const cf s02 = b0 + b2, d02 = b0 - b2, s13 = b1 + b3, d13 = b1 - b3;
    b0 = s02 + s13; b2 = s02 - s13;
    b1 = (cf){d02.x - d13.y, d02.y + d13.x};
    b3 = (cf){d02.x + d13.y, d02.y - d13.x};
}
template <int LOGM> DI void fwd_r4_pass(LAS cf* X, int tid) {
    asm volatile("" : "+v"(tid));
    constexpr int M = 1 << LOGM, q = M >> 2;
#pragma unroll 2
    for (int t = tid; t < 4096; t += NTHR) {
        const int j = t & (q - 1), base = (t >> (LOGM - 2)) * M + j;
        constexpr int QP = (q >= 256) ? (q + (q >> 4) + (q >> 8)) : ((q == 16) ? 17 : 1);
        LAS cf* xp = X + XI(base);
        cf a0 = xp[0], a1 = xp[QP], a2 = xp[2 * QP], a3 = xp[3 * QP];
        fwd4(a0, a1, a2, a3);
        const cf w1 = twid((float)j * (1.0f / M)), w2 = cmul(w1, w1), w3 = cmul(w2, w1);
        xp[0] = a0; xp[QP] = cmul(a1, w1); xp[2 * QP] = cmul(a2, w2); xp[3 * QP] = cmul(a3, w3);
    }
}
template <int LOGM> DI void inv_r4_pass(LAS cf* X, int tid) {
    asm volatile("" : "+v"(tid));
    constexpr int M = 1 << LOGM, q = M >> 2;
#pragma unroll 2
    for (int t = tid; t < 4096; t += NTHR) {
        const int j = t & (q - 1), base = (t >> (LOGM - 2)) * M + j;
        const cf w1 = twidc((float)j * (1.0f / M)), w2 = cmul(w1, w1), w3 = cmul(w2, w1);
        constexpr int QP = (q >= 256) ? (q + (q >> 4) + (q >> 8)) : ((q == 16) ? 17 : 1);
        LAS cf* xp = X + XI(base);
        cf b0 = xp[0], b1 = cmul(xp[QP], w1), b2 = cmul(xp[2 * QP], w2), b3 = cmul(xp[3 * QP], w3);
        inv4(b0, b1, b2, b3);
        xp[0] = b0; xp[QP] = b1; xp[2 * QP] = b2; xp[3 * QP] = b3;
    }
}
template <int LOGM> DI void fwd16(cf (&v)[16], int j) {
    constexpr int M = 1 << LOGM, q = M >> 4;
#pragma unroll
    for (int n = 0; n < 4; ++n) {
        fwd4(v[n], v[n + 4], v[n + 8], v[n + 12]);
        const cf w1 = twid((float)(j + n * q) * (1.0f / M)), w2 = cmul(w1, w1), w3 = cmul(w2, w1);
        v[n + 4] = cmul(v[n + 4], w1); v[n + 8] = cmul(v[n + 8], w2); v[n + 12] = cmul(v[n + 12], w3);
    }
    const cf u1 = twid((float)j * (4.0f / M)), u2 = cmul(u1, u1), u3 = cmul(u2, u1);
#pragma unroll
    for (int m = 0; m < 4; ++m) {
        fwd4(v[4 * m], v[4 * m + 1], v[4 * m + 2], v[4 * m + 3]);
        v[4 * m + 1] = cmul(v[4 * m + 1], u1); v[4 * m + 2] = cmul(v[4 * m + 2], u2); v[4 * m + 3] = cmul(v[4 * m + 3], u3);
    }
}
template <int LOGM> DI void inv16(cf (&v)[16], int j) {
    constexpr int M = 1 << LOGM, q = M >> 4;
    const cf u1 = twidc((float)j * (4.0f / M)), u2 = cmul(u1, u1), u3 = cmul(u2, u1);
#pragma unroll
    for (int m = 0; m < 4; ++m) {
        v[4 * m + 1] = cmul(v[4 * m + 1], u1); v[4 * m + 2] = cmul(v[4 * m + 2], u2); v[4 * m + 3] = cmul(v[4 * m + 3], u3);
        inv4(v[4 * m], v[4 * m + 1], v[4 * m + 2], v[4 * m + 3]);
    }
#pragma unroll
    for (int n = 0; n < 4; ++n) {
        const cf w1 = twidc((float)(j + n * q) * (1.0f / M)), w2 = cmul(w1, w1), w3 = cmul(w2, w1);
        v[n + 4] = cmul(v[n + 4], w1); v[n + 8] = cmul(v[n + 8], w2); v[n + 12] = cmul(v[n + 12], w3);
        inv4(v[n], v[n + 4], v[n + 8], v[n + 12]);
    }
}
template <int LOGM> DI void fwd_r16_pass(LAS cf* X, int tid) {
    asm volatile("" : "+v"(tid));
    constexpr int M = 1 << LOGM, q = M >> 4;
#pragma unroll 1
    for (int t = tid; t < 1024; t += NTHR) {
        const int j = t & (q - 1), base = (t >> (LOGM - 4)) * M + j;
        constexpr int QP = (q >= 256) ? (q + (q >> 4) + (q >> 8)) : ((q == 16) ? 17 : 1);
        LAS cf* xp = X + XI(base);
        cf v[16];
#pragma unroll
        for (int n = 0; n < 16; ++n) v[n] = xp[n * QP];
        fwd16<LOGM>(v, j);
#pragma unroll
        for (int n = 0; n < 16; ++n) xp[n * QP] = v[n];
    }
}
template <int LOGM> DI void inv_r16_pass(LAS cf* X, int tid) {
    asm volatile("" : "+v"(tid));
    constexpr int M = 1 << LOGM, q = M >> 4;
#pragma unroll 1
    for (int t = tid; t < 1024; t += NTHR) {
        const int j = t & (q - 1), base = (t >> (LOGM - 4)) * M + j;
        constexpr int QP = (q >= 256) ? (q + (q >> 4) + (q >> 8)) : ((q == 16) ? 17 : 1);
        LAS cf* xp = X + XI(base);
        cf v[16];
#pragma unroll
        for (int n = 0; n < 16; ++n) v[n] = xp[n * QP];
        inv16<LOGM>(v, j);
#pragma unroll
        for (int n = 0; n < 16; ++n) xp[n * QP] = v[n];
    }
}
DI int rev4(int pp) { const unsigned br = __brev((unsigned)pp) >> 18; return (int)(((br & 0x2AAAu) >> 1) | ((br & 0x1555u) << 1)); }
DI void fft_forward(LAS cf* X, int tid) {
    fwd_r4_pass<14>(X, tid); __syncthreads();
    fwd_r16_pass<12>(X, tid); __syncthreads();
    fwd_r16_pass<8>(X, tid); __syncthreads();
    fwd_r16_pass<4>(X, tid); __syncthreads();
}
constexpr int SPEC_STRIDE = 8208;
DI void fft_conv(LAS cf* X, const f32x4* spec, int tid) {
    fft_forward(X, tid);
#pragma unroll 8
    for (int r = 0; r < 16; ++r) {
        const int k = tid + NTHR * r; const int pp = rev4(k);
        const f32x4 sp = spec[k]; const cf P = (cf){sp[0], sp[1]}, Mq = (cf){sp[2], sp[3]};
        const cf z = X[XI(pp)];
        if (k == 0) { X[XI(pp)] = cmul(z, P) + cmul((cf){z.x, -z.y}, Mq); }
        else { const int pm = rev4(16384 - k); const cf zm = X[XI(pm)];
            const cf y = cmul(z, P) + cmul((cf){zm.x, -zm.y}, Mq);
            const cf t = cmul((cf){zm.x, -zm.y}, P) + cmul(z, Mq);
            X[XI(pp)] = y; X[XI(pm)] = (cf){t.x, -t.y}; }
    }
    if (tid == 0) { const int pp = rev4(8192); const f32x4 sp = spec[8192]; const cf z = X[XI(pp)]; X[XI(pp)] = cmul(z, (cf){sp[0], sp[1]}) + cmul((cf){z.x, -z.y}, (cf){sp[2], sp[3]}); }
    __syncthreads();
    inv_r16_pass<4>(X, tid); __syncthreads();
    inv_r16_pass<8>(X, tid); __syncthreads();
    inv_r16_pass<12>(X, tid); __syncthreads();
    inv_r4_pass<14>(X, tid); __syncthreads();
}


typedef _Float16 hc __attribute__((ext_vector_type(2)));
DI hc hcmul(hc a, hc b) { hc t, r;
    asm("v_pk_mul_f16 %0, %1, %2 op_sel:[0,0] op_sel_hi:[0,1]" : "=v"(t) : "v"(a), "v"(b));
    asm("v_pk_fma_f16 %0, %1, %2, %3 op_sel:[1,1,0] op_sel_hi:[1,0,1] neg_lo:[0,1,0]" : "=v"(r) : "v"(a), "v"(b), "v"(t)); return r; }
DI hc hadd_mi(hc a, hc b) { hc r; asm("v_pk_add_f16 %0, %1, %2 op_sel:[0,1] op_sel_hi:[1,0] neg_hi:[0,1]" : "=v"(r) : "v"(a), "v"(b)); return r; }
DI hc hadd_pi(hc a, hc b) { hc r; asm("v_pk_add_f16 %0, %1, %2 op_sel:[0,1] op_sel_hi:[1,0] neg_lo:[0,1]" : "=v"(r) : "v"(a), "v"(b)); return r; }
DI hc htwid(float frac) { float c = __builtin_amdgcn_cosf(frac), s = __builtin_amdgcn_sinf(frac); asm volatile("s_nop 1" : "+v"(c), "+v"(s)); return (hc){(_Float16)c, (_Float16)(-s)}; }
DI hc htwidc(float frac) { float c = __builtin_amdgcn_cosf(frac), s = __builtin_amdgcn_sinf(frac); asm volatile("s_nop 1" : "+v"(c), "+v"(s)); return (hc){(_Float16)c, (_Float16)s}; }
DI void hfwd4(hc& a0, hc& a1, hc& a2, hc& a3) {
    const hc s02 = a0 + a2, d02 = a0 - a2, s13 = a1 + a3, d13 = a1 - a3;
    a0 = s02 + s13; a2 = s02 - s13; a1 = hadd_mi(d02, d13); a3 = hadd_pi(d02, d13);
}
DI void hinv4(hc& b0, hc& b1, hc& b2, hc& b3) {
    const hc s02 = b0 + b2, d02 = b0 - b2, s13 = b1 + b3, d13 = b1 - b3;
    b0 = s02 + s13; b2 = s02 - s13; b1 = hadd_pi(d02, d13); b3 = hadd_mi(d02, d13);
}
template <int LOGM> DI void hfwd_r4_pass(LAS hc* X, int tid) {
    asm volatile("" : "+v"(tid));
    constexpr int M = 1 << LOGM, q = M >> 2;
#pragma unroll 8
    for (int t = tid; t < 4096; t += NTHR) {
        const int j = t & (q - 1), base = (t >> (LOGM - 2)) * M + j;
        constexpr int QP = (q >= 256) ? (q + (q >> 4) + (q >> 8)) : ((q == 16) ? 17 : 1);
        LAS hc* xp = X + XI(base);
        hc a0 = xp[0], a1 = xp[QP], a2 = xp[2 * QP], a3 = xp[3 * QP];
        hfwd4(a0, a1, a2, a3);
        const hc w1 = htwid((float)j * (1.0f / M)), w2 = hcmul(w1, w1), w3 = hcmul(w2, w1);
        xp[0] = a0; xp[QP] = hcmul(a1, w1); xp[2 * QP] = hcmul(a2, w2); xp[3 * QP] = hcmul(a3, w3);
    }
}
template <int LOGM> DI void hinv_r4_pass(LAS hc* X, int tid) {
    asm volatile("" : "+v"(tid));
    constexpr int M = 1 << LOGM, q = M >> 2;
#pragma unroll 8
    for (int t = tid; t < 4096; t += NTHR) {
        const int j = t & (q - 1), base = (t >> (LOGM - 2)) * M + j;
        const hc w1 = htwidc((float)j * (1.0f / M)), w2 = hcmul(w1, w1), w3 = hcmul(w2, w1);
        constexpr int QP = (q >= 256) ? (q + (q >> 4) + (q >> 8)) : ((q == 16) ? 17 : 1);
        LAS hc* xp = X + XI(base);
        hc b0 = xp[0], b1 = hcmul(xp[QP], w1), b2 = hcmul(xp[2 * QP], w2), b3 = hcmul(xp[3 * QP], w3);
        hinv4(b0, b1, b2, b3);
        xp[0] = b0; xp[QP] = b1; xp[2 * QP] = b2; xp[3 * QP] = b3;
    }
}
template <int LOGM> DI void hfwd16(hc (&v)[16], int j) {
    constexpr int M = 1 << LOGM, q = M >> 4;
#pragma unroll
    for (int n = 0; n < 4; ++n) {
        hfwd4(v[n], v[n + 4], v[n + 8], v[n + 12]);
        const hc w1 = htwid((float)(j + n * q) * (1.0f / M)), w2 = hcmul(w1, w1), w3 = hcmul(w2, w1);
        v[n + 4] = hcmul(v[n + 4], w1); v[n + 8] = hcmul(v[n + 8], w2); v[n + 12] = hcmul(v[n + 12], w3);
    }
    const hc u1 = htwid((float)j * (4.0f / M)), u2 = hcmul(u1, u1), u3 = hcmul(u2, u1);
#pragma unroll
    for (int m = 0; m < 4; ++m) {
        hfwd4(v[4 * m], v[4 * m + 1], v[4 * m + 2], v[4 * m + 3]);
        v[4 * m + 1] = hcmul(v[4 * m + 1], u1); v[4 * m + 2] = hcmul(v[4 * m + 2], u2); v[4 * m + 3] = hcmul(v[4 * m + 3], u3);
    }
}
template <int LOGM> DI void hinv16(hc (&v)[16], int j) {
    constexpr int M = 1 << LOGM, q = M >> 4;
    const hc u1 = htwidc((float)j * (4.0f / M)), u2 = hcmul(u1, u1), u3 = hcmul(u2, u1);
#pragma unroll
    for (int m = 0; m < 4; ++m) {
        v[4 * m + 1] = hcmul(v[4 * m + 1], u1); v[4 * m + 2] = hcmul(v[4 * m + 2], u2); v[4 * m + 3] = hcmul(v[4 * m + 3], u3);
        hinv4(v[4 * m], v[4 * m + 1], v[4 * m + 2], v[4 * m + 3]);
    }
#pragma unroll
    for (int n = 0; n < 4; ++n) {
        const hc w1 = htwidc((float)(j + n * q) * (1.0f / M)), w2 = hcmul(w1, w1), w3 = hcmul(w2, w1);
        v[n + 4] = hcmul(v[n + 4], w1); v[n + 8] = hcmul(v[n + 8], w2); v[n + 12] = hcmul(v[n + 12], w3);
        hinv4(v[n], v[n + 4], v[n + 8], v[n + 12]);
    }
}
template <int LOGM, bool FWD> DI void h_r16_pass(LAS hc* X, int tid) {
    asm volatile("" : "+v"(tid));
    constexpr int M = 1 << LOGM, q = M >> 4;
#pragma unroll
    for (int t = tid; t < 1024; t += NTHR) {
        const int j = t & (q - 1), base = (t >> (LOGM - 4)) * M + j;
        constexpr int QP = (q >= 256) ? (q + (q >> 4) + (q >> 8)) : ((q == 16) ? 17 : 1);
        LAS hc* xp = X + XI(base);
        hc v[16];
#pragma unroll
        for (int n = 0; n < 16; ++n) v[n] = xp[n * QP];
        if (FWD) hfwd16<LOGM>(v, j); else hinv16<LOGM>(v, j);
#pragma unroll
        for (int n = 0; n < 16; ++n) xp[n * QP] = v[n];
    }
}
DI void fft_conv_h(LAS hc* X, const f32x4* spec, int tid) {
    hfwd_r4_pass<14>(X, tid); __syncthreads();
    h_r16_pass<12, true>(X, tid); __syncthreads();
    h_r16_pass<8, true>(X, tid); __syncthreads();
    h_r16_pass<4, true>(X, tid); __syncthreads();
#pragma unroll 8
    for (int r = 0; r < 16; ++r) {
        const int k = tid + NTHR * r; const int pp = rev4(k);
        const f32x4 sp = spec[k]; const cf P = (cf){sp[0], sp[1]} * 256.0f, Mq = (cf){sp[2], sp[3]} * 256.0f;
        const hc zh = X[XI(pp)]; const cf z = (cf){(float)zh.x, (float)zh.y};
        if (k == 0) { const cf y = cmul(z, P) + cmul((cf){z.x, -z.y}, Mq); X[XI(pp)] = (hc){(_Float16)y.x, (_Float16)y.y}; }
        else { const int pm = rev4(16384 - k); const hc zmh = X[XI(pm)]; const cf zm = (cf){(float)zmh.x, (float)zmh.y};
            const cf y = cmul(z, P) + cmul((cf){zm.x, -zm.y}, Mq);
            const cf t = cmul((cf){zm.x, -zm.y}, P) + cmul(z, Mq);
            X[XI(pp)] = (hc){(_Float16)y.x, (_Float16)y.y}; X[XI(pm)] = (hc){(_Float16)t.x, (_Float16)(-t.y)}; }
    }
    if (tid == 0) { const int pp = rev4(8192); const f32x4 sp = spec[8192]; const hc zh = X[XI(pp)]; const cf z = (cf){(float)zh.x, (float)zh.y};
        const cf y = (cmul(z, (cf){sp[0], sp[1]}) + cmul((cf){z.x, -z.y}, (cf){sp[2], sp[3]})) * 256.0f; X[XI(pp)] = (hc){(_Float16)y.x, (_Float16)y.y}; }
    __syncthreads();
    h_r16_pass<4, false>(X, tid); __syncthreads();
    h_r16_pass<8, false>(X, tid); __syncthreads();
    h_r16_pass<12, false>(X, tid); __syncthreads();
    hinv_r4_pass<14>(X, tid); __syncthreads();
}

template <int LOGM> DI void hfwd_r4_pass2(LAS hc* X0, LAS hc* X1, int tid) {
    asm volatile("" : "+v"(tid));
    constexpr int M = 1 << LOGM, q = M >> 2;
#pragma unroll 4
    for (int t = tid; t < 4096; t += NTHR) {
        const int j = t & (q - 1), base = (t >> (LOGM - 2)) * M + j;
        constexpr int QP = (q >= 256) ? (q + (q >> 4) + (q >> 8)) : ((q == 16) ? 17 : 1);
        const int xo = XI(base);
        LAS hc* xp = X0 + xo; LAS hc* yp = X1 + xo;
        hc a0 = xp[0], a1 = xp[QP], a2 = xp[2 * QP], a3 = xp[3 * QP], b0 = yp[0], b1 = yp[QP], b2 = yp[2 * QP], b3 = yp[3 * QP];
        hfwd4(a0, a1, a2, a3); hfwd4(b0, b1, b2, b3);
        const hc w1 = htwid((float)j * (1.0f / M)), w2 = hcmul(w1, w1), w3 = hcmul(w2, w1);
        xp[0] = a0; xp[QP] = hcmul(a1, w1); xp[2 * QP] = hcmul(a2, w2); xp[3 * QP] = hcmul(a3, w3);
        yp[0] = b0; yp[QP] = hcmul(b1, w1); yp[2 * QP] = hcmul(b2, w2); yp[3 * QP] = hcmul(b3, w3);
    }
}
template <int LOGM> DI void hinv_r4_pass2(LAS hc* X0, LAS hc* X1, int tid) {
    asm volatile("" : "+v"(tid));
    constexpr int M = 1 << LOGM, q = M >> 2;
#pragma unroll 4
    for (int t = tid; t < 4096; t += NTHR) {
        const int j = t & (q - 1), base = (t >> (LOGM - 2)) * M + j;
        const hc w1 = htwidc((float)j * (1.0f / M)), w2 = hcmul(w1, w1), w3 = hcmul(w2, w1);
        constexpr int QP = (q >= 256) ? (q + (q >> 4) + (q >> 8)) : ((q == 16) ? 17 : 1);
        const int xo = XI(base);
        LAS hc* xp = X0 + xo; LAS hc* yp = X1 + xo;
        hc a0 = xp[0], a1 = hcmul(xp[QP], w1), a2 = hcmul(xp[2 * QP], w2), a3 = hcmul(xp[3 * QP], w3);
        hc b0 = yp[0], b1 = hcmul(yp[QP], w1), b2 = hcmul(yp[2 * QP], w2), b3 = hcmul(yp[3 * QP], w3);
        hinv4(a0, a1, a2, a3); hinv4(b0, b1, b2, b3);
        xp[0] = a0; xp[QP] = a1; xp[2 * QP] = a2; xp[3 * QP] = a3;
        yp[0] = b0; yp[QP] = b1; yp[2 * QP] = b2; yp[3 * QP] = b3;
    }
}
template <int LOGM> DI void hfwd16x2(hc (&v)[16], hc (&u)[16], int j) {
    constexpr int M = 1 << LOGM, q = M >> 4;
#pragma unroll
    for (int n = 0; n < 4; ++n) {
        hfwd4(v[n], v[n + 4], v[n + 8], v[n + 12]); hfwd4(u[n], u[n + 4], u[n + 8], u[n + 12]);
        const hc w1 = htwid((float)(j + n * q) * (1.0f / M)), w2 = hcmul(w1, w1), w3 = hcmul(w2, w1);
        v[n + 4] = hcmul(v[n + 4], w1); v[n + 8] = hcmul(v[n + 8], w2); v[n + 12] = hcmul(v[n + 12], w3);
        u[n + 4] = hcmul(u[n + 4], w1); u[n + 8] = hcmul(u[n + 8], w2); u[n + 12] = hcmul(u[n + 12], w3);
    }
    const hc u1 = htwid((float)j * (4.0f / M)), u2 = hcmul(u1, u1), u3 = hcmul(u2, u1);
#pragma unroll
    for (int m = 0; m < 4; ++m) {
        hfwd4(v[4 * m], v[4 * m + 1], v[4 * m + 2], v[4 * m + 3]); hfwd4(u[4 * m], u[4 * m + 1], u[4 * m + 2], u[4 * m + 3]);
        v[4 * m + 1] = hcmul(v[4 * m + 1], u1); v[4 * m + 2] = hcmul(v[4 * m + 2], u2); v[4 * m + 3] = hcmul(v[4 * m + 3], u3);
        u[4 * m + 1] = hcmul(u[4 * m + 1], u1); u[4 * m + 2] = hcmul(u[4 * m + 2], u2); u[4 * m + 3] = hcmul(u[4 * m + 3], u3);
    }
}
template <int LOGM> DI void hinv16x2(hc (&v)[16], hc (&u)[16], int j) {
    constexpr int M = 1 << LOGM, q = M >> 4;
    const hc u1 = htwidc((float)j * (4.0f / M)), u2 = hcmul(u1, u1), u3 = hcmul(u2, u1);
#pragma unroll
    for (int m = 0; m < 4; ++m) {
        v[4 * m + 1] = hcmul(v[4 * m + 1], u1); v[4 * m + 2] = hcmul(v[4 * m + 2], u2); v[4 * m + 3] = hcmul(v[4 * m + 3], u3);
        u[4 * m + 1] = hcmul(u[4 * m + 1], u1); u[4 * m + 2] = hcmul(u[4 * m + 2], u2); u[4 * m + 3] = hcmul(u[4 * m + 3], u3);
        hinv4(v[4 * m], v[4 * m + 1], v[4 * m + 2], v[4 * m + 3]); hinv4(u[4 * m], u[4 * m + 1], u[4 * m + 2], u[4 * m + 3]);
    }
#pragma unroll
    for (int n = 0; n < 4; ++n) {
        const hc w1 = htwidc((float)(j + n * q) * (1.0f / M)), w2 = hcmul(w1, w1), w3 = hcmul(w2, w1);
        v[n + 4] = hcmul(v[n + 4], w1); v[n + 8] = hcmul(v[n + 8], w2); v[n + 12] = hcmul(v[n + 12], w3);
        u[n + 4] = hcmul(u[n + 4], w1); u[n + 8] = hcmul(u[n + 8], w2); u[n + 12] = hcmul(u[n + 12], w3);
        hinv4(v[n], v[n + 4], v[n + 8], v[n + 12]); hinv4(u[n], u[n + 4], u[n + 8], u[n + 12]);
    }
}
template <int LOGM, bool FWD> DI void h_r16_pass2(LAS hc* X0, LAS hc* X1, int tid) {
    asm volatile("" : "+v"(tid));
    constexpr int M = 1 << LOGM, q = M >> 4;
#pragma unroll 1
    for (int t = tid; t < 1024; t += NTHR) {
        const int j = t & (q - 1), base = (t >> (LOGM - 4)) * M + j;
        constexpr int QP = (q >= 256) ? (q + (q >> 4) + (q >> 8)) : ((q == 16) ? 17 : 1);
        const int xo = XI(base);
        LAS hc* xp = X0 + xo; LAS hc* yp = X1 + xo;
        hc v[16], u[16];
#pragma unroll
        for (int n = 0; n < 16; ++n) { v[n] = xp[n * QP]; u[n] = yp[n * QP]; }
        if (FWD) hfwd16x2<LOGM>(v, u, j); else hinv16x2<LOGM>(v, u, j);
#pragma unroll
        for (int n = 0; n < 16; ++n) { xp[n * QP] = v[n]; yp[n * QP] = u[n]; }
    }
}
DI void pw_h(LAS hc* X, const f32x4* spec, int tid) {
#pragma unroll 8
    for (int r = 0; r < 16; ++r) {
        const int k = tid + NTHR * r; const int pp = rev4(k);
        const f32x4 sp = spec[k]; const cf P = (cf){sp[0], sp[1]} * 256.0f, Mq = (cf){sp[2], sp[3]} * 256.0f;
        const hc zh = X[XI(pp)]; const cf z = (cf){(float)zh.x, (float)zh.y};
        if (k == 0) { const cf y = cmul(z, P) + cmul((cf){z.x, -z.y}, Mq); X[XI(pp)] = (hc){(_Float16)y.x, (_Float16)y.y}; }
        else { const int pm = rev4(16384 - k); const hc zmh = X[XI(pm)]; const cf zm = (cf){(float)zmh.x, (float)zmh.y};
            const cf y = cmul(z, P) + cmul((cf){zm.x, -zm.y}, Mq);
            const cf t = cmul((cf){zm.x, -zm.y}, P) + cmul(z, Mq);
            X[XI(pp)] = (hc){(_Float16)y.x, (_Float16)y.y}; X[XI(pm)] = (hc){(_Float16)t.x, (_Float16)(-t.y)}; }
    }
    if (tid == 0) { const int pp = rev4(8192); const f32x4 sp = spec[8192]; const hc zh = X[XI(pp)]; const cf z = (cf){(float)zh.x, (float)zh.y};
        const cf y = (cmul(z, (cf){sp[0], sp[1]}) + cmul((cf){z.x, -z.y}, (cf){sp[2], sp[3]})) * 256.0f; X[XI(pp)] = (hc){(_Float16)y.x, (_Float16)y.y}; }
}
DI void fft_conv_h2(LAS hc* X0, LAS hc* X1, const f32x4* spec0, const f32x4* spec1, int tid) {
    hfwd_r4_pass2<14>(X0, X1, tid); __syncthreads();
    h_r16_pass2<12, true>(X0, X1, tid); __syncthreads();
    h_r16_pass2<8, true>(X0, X1, tid); __syncthreads();
    h_r16_pass2<4, true>(X0, X1, tid); __syncthreads();
    pw_h(X0, spec0, tid); pw_h(X1, spec1, tid);
    __syncthreads();
    h_r16_pass2<4, false>(X0, X1, tid); __syncthreads();
    h_r16_pass2<8, false>(X0, X1, tid); __syncthreads();
    h_r16_pass2<12, false>(X0, X1, tid); __syncthreads();
    hinv_r4_pass2<14>(X0, X1, tid); __syncthreads();
}

DI void spectra_item(const Params& p, int ditem, LAS unsigned char* lds) {
    int tid = tidx(); asm volatile("" : "+v"(tid));
    const int l = ditem >> 9, o = (ditem >> 8) & 1, d = ditem & 255, a = 4 * d;
    LAS hc* X0 = (LAS hc*)lds; LAS hc* X1 = X0 + 17472;
    const float mind = -3.0701134573253943f, maxd = -15.350567286626972f;
    float dec[4], sk[4];
#pragma unroll
    for (int c = 0; c < 4; ++c) { dec[c] = fabsf(mind + (float)(a + c) * ((maxd - mind) / 1023.0f)); sk[c] = p.in[I_HYSKIP][(l * 2 + o) * 1024 + a + c]; }
    const float* tf = (const float*)(p.ws + WS_TT) + ((size_t)l * 4096 + (o * 2 + 0) * 1024 + a) * S;
    const float* tb = (const float*)(p.ws + WS_TT) + ((size_t)l * 4096 + (o * 2 + 1) * 1024 + a) * S;
#pragma unroll 8
    for (int rr = 0; rr < 16; ++rr) {
        const int i = tid + NTHR * rr;
        const float ti = (float)i / 8191.0f;
        float f[4], b[4];
#pragma unroll
        for (int c = 0; c < 4; ++c) { const float e = __expf(-ti * dec[c]) * 256.0f; f[c] = tf[(size_t)c * S + i] * e; b[c] = tb[(size_t)c * S + i] * e; }
        if (i == 0) {
            X0[XI(0)] = (hc){(_Float16)(f[0] + b[0] + sk[0] * 256.0f), (_Float16)(f[1] + b[1] + sk[1] * 256.0f)}; X1[XI(0)] = (hc){(_Float16)(f[2] + b[2] + sk[2] * 256.0f), (_Float16)(f[3] + b[3] + sk[3] * 256.0f)};
            X0[XI(8192)] = (hc){(_Float16)0.f, (_Float16)0.f}; X1[XI(8192)] = (hc){(_Float16)0.f, (_Float16)0.f};
        } else {
            X0[XI(i)] = (hc){(_Float16)f[0], (_Float16)f[1]}; X1[XI(i)] = (hc){(_Float16)f[2], (_Float16)f[3]};
            X0[XI(16384 - i)] = (hc){(_Float16)b[0], (_Float16)b[1]}; X1[XI(16384 - i)] = (hc){(_Float16)b[2], (_Float16)b[3]};
        }
    }
    __syncthreads();
    hfwd_r4_pass2<14>(X0, X1, tid); __syncthreads();
    h_r16_pass2<12, true>(X0, X1, tid); __syncthreads();
    h_r16_pass2<8, true>(X0, X1, tid); __syncthreads();
    h_r16_pass2<4, true>(X0, X1, tid); __syncthreads();
    const float sc = 0.5f / 16384.0f / 256.0f;
#pragma unroll
    for (int half = 0; half < 2; ++half) {
        LAS hc* X = half ? X1 : X0;
        f32x4* spec = (f32x4*)(p.ws + WS_SPEC) + (size_t)((l * 2 + o) * 512 + 2 * d + half) * SPEC_STRIDE;
        for (int r = 0; r < 17; ++r) {
            const int k = tid + NTHR * r; if (k > 8192) break;
            const hc Fh = X[XI(rev4(k))], Fmh = X[XI(rev4((16384 - k) & 16383))]; const cf F = (cf){(float)Fh.x, (float)Fh.y}, Fm = (cf){(float)Fmh.x, (float)Fmh.y};
            const cf Fc = (cf){Fm.x, -Fm.y};
            const cf Ha = (F + Fc) * 0.5f, tt = (F - Fc) * 0.5f; const cf Hb = (cf){tt.y, -tt.x};
            const cf P = (Ha + Hb) * sc, Mq = (Ha - Hb) * sc;
            spec[k] = (f32x4){P.x, P.y, Mq.x, Mq.y};
        }
    }
    __syncthreads();
}

DI float conv3(const float* row, int t, float w0, float w1, float w2) {
    const float c = row[t]; float pv = row[t > 0 ? t - 1 : 0], nx = row[t < S - 1 ? t + 1 : S - 1];
    pv = t > 0 ? pv : 0.f; nx = t < S - 1 ? nx : 0.f;
    return w0 * pv + w1 * c + w2 * nx;
}
DI void hyena_item(const Params& p, int l, int dpr, LAS unsigned char* lds) {
    int tid = tidx(); asm volatile("" : "+v"(tid)); const int a = 4 * dpr;
    LAS hc* X0 = (LAS hc*)lds; LAS hc* X1 = X0 + 17472;
    const float* bint = (const float*)(p.ws + WS_BINT);
    const float* cw = p.in[I_HYCONV] + (size_t)l * 3 * 3072;
    const f32x4* spec = (const f32x4*)(p.ws + WS_SPEC);
    const hc hzero = (hc){(_Float16)0.f, (_Float16)0.f};
    float w[4][3];
#pragma unroll
    for (int c = 0; c < 4; ++c)
#pragma unroll
        for (int k = 0; k < 3; ++k) w[c][k] = cw[k * 3072 + 0 * 1024 + a + c];
#pragma unroll 4
    for (int r = 0; r < 16; ++r) { const int t = tid + NTHR * r;
        float v[4];
#pragma unroll
        for (int c = 0; c < 4; ++c) v[c] = conv3(bint + (size_t)(a + c) * S, t, w[c][0], w[c][1], w[c][2]) * 0.25f;
        X0[XI(t)] = (hc){(_Float16)v[0], (_Float16)v[1]}; X1[XI(t)] = (hc){(_Float16)v[2], (_Float16)v[3]};
        X0[XI(t + 8192)] = hzero; X1[XI(t + 8192)] = hzero; }
    __syncthreads();
    fft_conv_h2(X0, X1, spec + (size_t)((l * 2 + 0) * 512 + 2 * dpr) * SPEC_STRIDE, spec + (size_t)((l * 2 + 0) * 512 + 2 * dpr + 1) * SPEC_STRIDE, tid);
#pragma unroll
    for (int c = 0; c < 4; ++c)
#pragma unroll
        for (int k = 0; k < 3; ++k) w[c][k] = cw[k * 3072 + 1 * 1024 + a + c];
#pragma unroll 4
    for (int r = 0; r < 16; ++r) { const int t = tid + NTHR * r; const hc y0 = X0[XI(t)], y1 = X1[XI(t)];
        const float yv[4] = {(float)y0.x, (float)y0.y, (float)y1.x, (float)y1.y};
        float z[4];
#pragma unroll
        for (int c = 0; c < 4; ++c) z[c] = yv[c] * (1.0f / 64.0f) * conv3(bint + (size_t)(1024 + a + c) * S, t, w[c][0], w[c][1], w[c][2]) * 0.25f;
        X0[XI(t)] = (hc){(_Float16)z[0], (_Float16)z[1]}; X1[XI(t)] = (hc){(_Float16)z[2], (_Float16)z[3]};
        X0[XI(t + 8192)] = hzero; X1[XI(t + 8192)] = hzero; }
    __syncthreads();
    fft_conv_h2(X0, X1, spec + (size_t)((l * 2 + 1) * 512 + 2 * dpr) * SPEC_STRIDE, spec + (size_t)((l * 2 + 1) * 512 + 2 * dpr + 1) * SPEC_STRIDE, tid);
#pragma unroll
    for (int c = 0; c < 4; ++c)
#pragma unroll
        for (int k = 0; k < 3; ++k) w[c][k] = cw[k * 3072 + 2 * 1024 + a + c];
    float* z2t = (float*)(p.ws + WS_Z2T);
#pragma unroll 4
    for (int r = 0; r < 16; ++r) { const int t = tid + NTHR * r; const hc y0 = X0[XI(t)], y1 = X1[XI(t)];
        const float yv[4] = {(float)y0.x, (float)y0.y, (float)y1.x, (float)y1.y};
#pragma unroll
        for (int c = 0; c < 4; ++c) z2t[(size_t)(a + c) * S + t] = yv[c] * (1.0f / 64.0f) * conv3(bint + (size_t)(2048 + a + c) * S, t, w[c][0], w[c][1], w[c][2]); }
    __syncthreads();
}
DI void phase_rmsnorm(const float* x, const float* g, bf16_t* hout, float* fout) {
    const int tid = tidx(), wave = tid >> 6, lane = tid & 63;
    const int gw = blockIdx.x * NWAVES + wave, ngw = gridDim.x * NWAVES;
    for (int row = gw; row < S; row += 2 * ngw) {
        const int row2 = row + ngw;
        const bool has2 = row2 < S;
        const f32x4* xr = (const f32x4*)(x + (size_t)row * D) + lane;
        const f32x4* xr2 = (const f32x4*)(x + (size_t)(has2 ? row2 : row) * D) + lane;
        f32x4 v[8], v2[8]; float s = 0.f, s2 = 0.f;
#pragma unroll
        for (int j = 0; j < 8; ++j) { v[j] = xr[64 * j]; v2[j] = xr2[64 * j]; }
#pragma unroll
        for (int j = 0; j < 8; ++j) { s += (v[j][0] * v[j][0] + v[j][1] * v[j][1]) + (v[j][2] * v[j][2] + v[j][3] * v[j][3]); s2 += (v2[j][0] * v2[j][0] + v2[j][1] * v2[j][1]) + (v2[j][2] * v2[j][2] + v2[j][3] * v2[j][3]); }
        const float rstd = rsqrtf(wave_sum(s) * (1.0f / D) + 1e-6f), rstd2 = rsqrtf(wave_sum(s2) * (1.0f / D) + 1e-6f);
#pragma unroll
        for (int j = 0; j < 8; ++j) { const f32x4 gg = ((const f32x4*)g)[lane + 64 * j]; const f32x4 y = v[j] * rstd * gg, y2 = v2[j] * rstd2 * gg;
            if (hout) { u32x2 o = {pk2(y[0], y[1]), pk2(y[2], y[3])}; ((u32x2*)(hout + (size_t)row * D))[lane + 64 * j] = o;
                if (has2) { u32x2 o2 = {pk2(y2[0], y2[1]), pk2(y2[2], y2[3])}; ((u32x2*)(hout + (size_t)row2 * D))[lane + 64 * j] = o2; } }
            else { ((f32x4*)(fout + (size_t)row * D))[lane + 64 * j] = y; if (has2) ((f32x4*)(fout + (size_t)row2 * D))[lane + 64 * j] = y2; } }
    }
}

constexpr int KROW = 144, KBUF = 64 * KROW, VBUF = 128 * KROW;
DI void softmax_half(f32x16& s, const LAS float* btab, int k0, int q0w, int r, int hh, float cs, float& m, float& lsum, f32x16 (&O)[4]) {
    const int q = q0w + r;
    const int relmin = k0 - q0w - 31, relmax = k0 + 31 - q0w;
    float bc = 0.f, csx = cs;
    if (relmin >= 1024 || relmax <= -1024) { bc = btab[relmin >= 1024 ? 2048 : 0]; }
    else {
        if (relmin >= -1024 && relmax <= 1024) {
            const LAS float* bp = btab + (k0 - q + 1024 + 4 * hh);
#pragma unroll
            for (int i = 0; i < 16; ++i) s[i] = s[i] * cs + bp[(i & 3) + 8 * (i >> 2)];
        } else {
#pragma unroll
            for (int i = 0; i < 16; ++i) { const int rel = k0 + crow(i, hh) - q; const int i0 = min(max(rel, -1024), 1024) + 1024; s[i] = s[i] * cs + btab[i0]; }
        }
        csx = 1.0f;
    }
    float mx = s[0];
#pragma unroll
    for (int i = 1; i < 16; ++i) mx = fmaxf(mx, s[i]);
    mx = mx * csx + bc;
    mx = xhalf_max(mx);
    if (__any(mx > m + 8.0f)) {
        const float mnew = fmaxf(m, mx), alpha = __builtin_amdgcn_exp2f(m - mnew);
        m = mnew; lsum *= alpha;
#pragma unroll
        for (int db = 0; db < 4; ++db) O[db] *= alpha;
    }
    const float c2 = bc - m;
    float rs0 = 0.f, rs1 = 0.f;
#pragma unroll
    for (int i = 0; i < 16; i += 2) { s[i] = __builtin_amdgcn_exp2f(s[i] * csx + c2); s[i + 1] = __builtin_amdgcn_exp2f(s[i + 1] * csx + c2); rs0 += s[i]; rs1 += s[i + 1]; }
    lsum += rs0 + rs1;
}
constexpr int K3BUF = 64 * 128, V3BUF = 128 * 128;
DI void dstage_k(const bf16_t* kgl, LAS unsigned char* dst, int wave, int lane) {
    const int row = 8 * wave + (lane >> 3), gseg = (lane & 7) ^ ((row >> 1) & 7);
    __builtin_amdgcn_global_load_lds((const unsigned*)(kgl + (size_t)row * 256 + gseg * 8), (LAS unsigned*)(dst + wave * 1024), 16, 0, 0);
}
DI void dstage_v(const bf16_t* vgl, LAS unsigned char* dst, int wave, int lane) {
#pragma unroll
    for (int k = 0; k < 2; ++k) { const int ii = 2 * wave + k, row = 8 * ii + (lane >> 3), gseg = (lane & 7) ^ ((row >> 1) & 7);
        __builtin_amdgcn_global_load_lds((const unsigned*)(vgl + (size_t)row * S + gseg * 8), (LAS unsigned*)(dst + ii * 1024), 16, 0, 0); }
}
DI void sm_max_phase(f32x16& s, const LAS float* btab, int k0, int q0w, int r, int hh, float cs, float& m, float& lsum, f32x16 (&O)[4], float& csx, float& c2) {
    const int q = q0w + r;
    const int relmin = k0 - q0w - 31, relmax = k0 + 31 - q0w;
    float bc = 0.f; csx = cs;
    if (relmin >= 1024 || relmax <= -1024) { bc = btab[relmin >= 1024 ? 2048 : 0]; }
    else {
        if (relmin >= -1024 && relmax <= 1024) {
            const LAS float* bp = btab + (k0 - q + 1024 + 4 * hh);
#pragma unroll
            for (int i = 0; i < 16; ++i) s[i] = s[i] * cs + bp[(i & 3) + 8 * (i >> 2)];
        } else {
#pragma unroll
            for (int i = 0; i < 16; ++i) { const int rel = k0 + crow(i, hh) - q; const int i0 = min(max(rel, -1024), 1024) + 1024; s[i] = s[i] * cs + btab[i0]; }
        }
        csx = 1.0f;
    }
    float mx = s[0];
#pragma unroll
    for (int i = 1; i < 16; ++i) mx = fmaxf(mx, s[i]);
    mx = mx * csx + bc;
    mx = xhalf_max(mx);
    if (__any(mx > m + 8.0f)) {
        const float mnew = fmaxf(m, mx), alpha = __builtin_amdgcn_exp2f(m - mnew);
        m = mnew; lsum *= alpha;
#pragma unroll
        for (int db = 0; db < 4; ++db) O[db] *= alpha;
    }
    c2 = bc - m;
}
#define DF_EXP2(i0) do { s[i0] = __builtin_amdgcn_exp2f(s[i0] * csx + c2); s[(i0) + 1] = __builtin_amdgcn_exp2f(s[(i0) + 1] * csx + c2); rs0 += s[i0]; rs1 += s[(i0) + 1]; } while (0)
#define DF_FENCE __builtin_amdgcn_sched_barrier(0)
DI void diff_flash2(const bf16_t* proj, const bf16_t* vtc, int h, int c, int q0w, LAS unsigned char* lds, const LAS float* btab, f32x16 (&O)[4]) {
    int tid = tidx(); asm volatile("" : "+v"(tid)); const int lane = tid & 63, r = lane & 31, hh = lane >> 5, wave = __builtin_amdgcn_readfirstlane(tid >> 6);
    constexpr int NT = S / 64;
    bf16x8 qf[4];
    { const bf16_t* qp = proj + PIDX(q0w + r, C_CQKV + h * 128 + c * 64 + 8 * hh);
#pragma unroll
      for (int ks = 0; ks < 4; ++ks) qf[ks] = *(const bf16x8*)(qp + 16 * ks); }
#pragma unroll
    for (int db = 0; db < 4; ++db)
#pragma unroll
        for (int i = 0; i < 16; ++i) O[db][i] = 0.f;
    float m = -1e30f, lsum = 0.f;
    const float cs = 0.125f * LOG2E;
    const bf16_t* kg = proj + PIDX(0, C_CQKV + 1024 + h * 128 + c * 64);
    const bf16_t* vg = vtc + (size_t)(h * 128) * S;
    LAS unsigned char* Kb = lds; LAS unsigned char* Vb = lds + 3 * K3BUF;
    __syncthreads();
    dstage_k(kg, Kb, wave, lane); dstage_v(vg, Vb, wave, lane); dstage_k(kg + (size_t)64 * 256, Kb + K3BUF, wave, lane);
    asm volatile("s_waitcnt vmcnt(0)" ::: "memory");
    __syncthreads();
    const int swz = (r >> 1) & 7, rowoff = r * 128;
    int kso[4];
#pragma unroll
    for (int ks = 0; ks < 4; ++ks) kso[ks] = rowoff + (((2 * ks + hh) ^ swz) << 4);
    bf16x8 kf[4], vf[8];
    f32x16 s, sn;
#pragma unroll
    for (int i = 0; i < 16; ++i) s[i] = 0.f;
#pragma unroll
    for (int ks = 0; ks < 4; ++ks) { kf[ks] = *(const LAS bf16x8*)(Kb + kso[ks]); }
#pragma unroll
    for (int ks = 0; ks < 4; ++ks) s = MFMA32(kf[ks], qf[ks], s);
    int kc = 0, kn = K3BUF, kw = 2 * K3BUF;
#pragma unroll 1
    for (int t = 0; t < NT; ++t) {
        if (t + 2 < NT) dstage_k(kg + (size_t)(t + 2) * 64 * 256, Kb + kw, wave, lane);
        if (t + 1 < NT) dstage_v(vg + (t + 1) * 64, Vb + ((t + 1) & 1) * V3BUF, wave, lane);
        const LAS unsigned char* vb_ = Vb + (t & 1) * V3BUF;
#pragma unroll
        for (int half = 0; half < 2; ++half) {
#pragma unroll
            for (int ss = 0; ss < 2; ++ss) { const int vs = rowoff + (((4 * half + 2 * ss + hh) ^ swz) << 4);
#pragma unroll
                for (int db = 0; db < 4; ++db) vf[ss * 4 + db] = *(const LAS bf16x8*)(vb_ + vs + (32 * db) * 128); }
            const bool have_next = (half == 0) || (t + 1 < NT);
            { const LAS unsigned char* kbase = (half == 0) ? (Kb + kc + 32 * 128) : (Kb + kn);
              if (have_next) {
#pragma unroll
                  for (int ks = 0; ks < 4; ++ks) kf[ks] = *(const LAS bf16x8*)(kbase + kso[ks]); } }
            float csx, c2;
            sm_max_phase(s, btab, t * 64 + 32 * half, q0w, r, hh, cs, m, lsum, O, csx, c2);
            float rs0 = 0.f, rs1 = 0.f;
#pragma unroll
            for (int i = 0; i < 16; ++i) sn[i] = 0.f;
            DF_FENCE;
            sn = MFMA32(kf[0], qf[0], sn); DF_EXP2(0); DF_FENCE;
            sn = MFMA32(kf[1], qf[1], sn); DF_EXP2(2); DF_FENCE;
            sn = MFMA32(kf[2], qf[2], sn); DF_EXP2(4); DF_FENCE;
            sn = MFMA32(kf[3], qf[3], sn); DF_EXP2(6); DF_FENCE;
            const bf16x8 pf0 = pack8(s, 0);
            O[0] = MFMA32(vf[0], pf0, O[0]); DF_EXP2(8); DF_FENCE;
            O[1] = MFMA32(vf[1], pf0, O[1]); DF_EXP2(10); DF_FENCE;
            O[2] = MFMA32(vf[2], pf0, O[2]); DF_EXP2(12); DF_FENCE;
            O[3] = MFMA32(vf[3], pf0, O[3]); DF_EXP2(14); DF_FENCE;
            const bf16x8 pf1 = pack8(s, 1);
            O[0] = MFMA32(vf[4], pf1, O[0]); O[1] = MFMA32(vf[5], pf1, O[1]); O[2] = MFMA32(vf[6], pf1, O[2]); O[3] = MFMA32(vf[7], pf1, O[3]);
            lsum += rs0 + rs1;
            s = sn;
        }
        asm volatile("s_waitcnt vmcnt(0)" ::: "memory");
        __syncthreads();
        const int tmp = kc; kc = kn; kn = kw; kw = tmp;
    }
    const float lt = lsum + __shfl_xor(lsum, 32), inv = 1.0f / lt;
#pragma unroll
    for (int db = 0; db < 4; ++db) O[db] *= inv;
}
#undef DF_EXP2
#undef DF_FENCE
DI void diffattn_item(const Params& p, int l, int item, LAS unsigned char* lds) {
    int tid = tidx(); asm volatile("" : "+v"(tid)); const int wave = __builtin_amdgcn_readfirstlane(tid >> 6), lane = tid & 63, r = lane & 31, hh = lane >> 5;
    const int qt = item >> 3, h = item & 7, q0w = qt * 256 + wave * 32;
    LAS float* btab = (LAS float*)(lds + LDS_MAIN);
    const float* bias = (const float*)(p.ws + WS_BIAS) + (24 + h) * 2049;
    for (int i = tid; i < 2049; i += NTHR) btab[i] = bias[i];
    const float* dl = p.in[I_DLAM] + l * 256;
    float d01 = 0.f, d23 = 0.f;
    for (int i = 0; i < 64; ++i) { d01 += dl[i] * dl[64 + i]; d23 += dl[128 + i] * dl[192 + i]; }
    const float lam_init = 0.8f - 0.6f * expf(-0.3f * (float)l);
    const float lam = expf(d01) - expf(d23) + lam_init;
    const bf16_t* proj = (const bf16_t*)(p.ws + WS_PROJ); const bf16_t* vtc = (const bf16_t*)(p.ws + WS_VTC);
    f32x16 O0[4];
    const int q = q0w + r;
    float* ctmp = (float*)(p.ws + WS_CTMP) + (size_t)q * 1024 + h * 128 + 4 * hh;
    diff_flash2(proj, vtc, h, 0, q0w, lds, btab, O0);
#pragma unroll
    for (int db = 0; db < 4; ++db)
#pragma unroll
        for (int i4 = 0; i4 < 4; ++i4) { f32x4 o = {O0[db][4 * i4], O0[db][4 * i4 + 1], O0[db][4 * i4 + 2], O0[db][4 * i4 + 3]}; *(f32x4*)(ctmp + 32 * db + 8 * i4) = o; }
    diff_flash2(proj, vtc, h, 1, q0w, lds, btab, O0);
    float ss = 0.f;
#pragma unroll
    for (int db = 0; db < 4; ++db)
#pragma unroll
        for (int i4 = 0; i4 < 4; ++i4) { const f32x4 o0 = *(const f32x4*)(ctmp + 32 * db + 8 * i4);
#pragma unroll
            for (int e = 0; e < 4; ++e) { const float o = o0[e] - lam * O0[db][4 * i4 + e]; O0[db][4 * i4 + e] = o; ss += o * o; } }
    ss += __shfl_xor(ss, 32);
    const float rn = rsqrtf(ss * (1.0f / 128.0f) + 1e-6f) * (1.0f - lam_init);
    const float* dg = p.in[I_DG] + l * 128;
    bf16_t* cout = (bf16_t*)(p.ws + WS_BR) + (size_t)2 * S * 1024;
#pragma unroll
    for (int db = 0; db < 4; ++db)
#pragma unroll
        for (int i4 = 0; i4 < 4; ++i4) {
            const int d0 = 32 * db + 8 * i4 + 4 * hh;
            const f32x4 g4 = *(const f32x4*)(dg + d0);
            const u32x2 gt = *(const u32x2*)(proj + PIDX(q, C_CGATE + h * 128 + d0));
            const float y0 = O0[db][4 * i4 + 0] * rn * g4[0] * silu_f(bflo(gt[0])), y1 = O0[db][4 * i4 + 1] * rn * g4[1] * silu_f(bfhi(gt[0]));
            const float y2 = O0[db][4 * i4 + 2] * rn * g4[2] * silu_f(bflo(gt[1])), y3 = O0[db][4 * i4 + 3] * rn * g4[3] * silu_f(bfhi(gt[1]));
            u32x2 o = {pk2(y0, y1), pk2(y2, y3)};
            *(u32x2*)(cout + (size_t)q * 1024 + h * 128 + d0) = o;
        }
    __syncthreads();
}

DI void mixA_wave_item(const Params& p, int wi, int lane, const LAS float* tb) {
    asm volatile("" : "+v"(lane));
    const int g = wi >> 11, rem = wi & 2047, h = rem >> 8, qb = rem & 255;
    const int sh = 2 * g, n = S >> sh, nbq = 256 >> sh, res = qb / nbq, m0 = (qb % nbq) * 32;
    const int r = lane & 31, hh = lane >> 5;
    const bf16_t* proj = (const bf16_t*)(p.ws + WS_PROJ);
    const int qpos = ((m0 + r) << sh) + res;
    bf16x8 qf[8];
    { const bf16_t* qp = proj + PIDX(qpos, g * 3072 + h * 128 + 8 * hh);
#pragma unroll
      for (int ks = 0; ks < 8; ++ks) qf[ks] = *(const bf16x8*)(qp + 16 * ks); }
    f32x16 O[4];
#pragma unroll
    for (int db = 0; db < 4; ++db)
#pragma unroll
        for (int i = 0; i < 16; ++i) O[db][i] = 0.f;
    float m = -1e30f, lsum = 0.f;
    const float cs = 0.08838834764831845f * LOG2E;
    const LAS float* tbl = tb + 31 - r + 4 * hh;
    const bf16_t* vt = (const bf16_t*)(p.ws + WS_VTA) + (size_t)((g * 8 + h) * 128) * S + res * n;
    bf16x8 kf[8];
    { const int mk0r = m0 - 64; const int mk0 = (mk0r >= 0 && mk0r < n) ? mk0r : m0;
      const bf16_t* kp = proj + PIDX(((mk0 + r) << sh) + res, g * 3072 + 1024 + h * 128 + 8 * hh);
#pragma unroll
      for (int ks = 0; ks < 8; ++ks) kf[ks] = *(const bf16x8*)(kp + 16 * ks); }
#pragma unroll 1
    for (int kb = 0; kb < 5; ++kb) {
        const int mk0r = m0 - 64 + 32 * kb;
        const bool blk_ok = (mk0r >= 0) && (mk0r < n);
        const int mk0 = blk_ok ? mk0r : m0;
        bf16x8 vfr[2][4];
#pragma unroll
        for (int sidx = 0; sidx < 2; ++sidx)
#pragma unroll
            for (int db = 0; db < 4; ++db) {
                const bf16_t* vp = vt + (size_t)(32 * db + r) * S + mk0 + 16 * sidx + 4 * hh;
                const s16x4 lo = *(const s16x4*)vp, hi = *(const s16x4*)(vp + 8);
                vfr[sidx][db] = __builtin_shufflevector(lo, hi, 0, 1, 2, 3, 4, 5, 6, 7);
            }
        __builtin_amdgcn_sched_barrier(0);
        f32x16 s;
#pragma unroll
        for (int i = 0; i < 16; ++i) s[i] = 0.f;
#pragma unroll
        for (int ks = 0; ks < 8; ++ks) s = MFMA32(kf[ks], qf[ks], s);
        if (kb < 4) {
            const int nk0r = m0 - 64 + 32 * (kb + 1); const int nk0 = (nk0r >= 0 && nk0r < n) ? nk0r : m0;
            const bf16_t* kp = proj + PIDX(((nk0 + r) << sh) + res, g * 3072 + 1024 + h * 128 + 8 * hh);
#pragma unroll
            for (int ks = 0; ks < 8; ++ks) kf[ks] = *(const bf16x8*)(kp + 16 * ks);
        }
        __builtin_amdgcn_sched_barrier(0);
        float mx = -INFINITY;
#pragma unroll
        for (int i = 0; i < 16; ++i) { const int rel = mk0r + crow(i, hh) - (m0 + r); const bool valid = blk_ok && (rel <= 64) && (rel >= -64);
            const float bv = tbl[32 * kb + (i & 3) + 8 * (i >> 2)];
            const float v = valid ? (s[i] * cs + bv) : -INFINITY; s[i] = v; mx = fmaxf(mx, v); }
        mx = xhalf_max(mx);
        const float mnew = fmaxf(m, mx), alpha = __builtin_amdgcn_exp2f(m - mnew);
        m = mnew;
        float rs = 0.f;
#pragma unroll
        for (int i = 0; i < 16; ++i) { s[i] = __builtin_amdgcn_exp2f(s[i] - mnew); rs += s[i]; }
        lsum = lsum * alpha + rs;
#pragma unroll
        for (int db = 0; db < 4; ++db) O[db] *= alpha;
#pragma unroll
        for (int sidx = 0; sidx < 2; ++sidx) {
            const bf16x8 pf = pack8(s, sidx);
#pragma unroll
            for (int db = 0; db < 4; ++db) O[db] = MFMA32(vfr[sidx][db], pf, O[db]);
        }
    }
    const float lt = lsum + __shfl_xor(lsum, 32), inv = 1.0f / lt;
    float* oa = (float*)(p.ws + WS_OA) + ((size_t)g * S + qpos) * 1024 + h * 128;
#pragma unroll
    for (int db = 0; db < 4; ++db)
#pragma unroll
        for (int i4 = 0; i4 < 4; ++i4) {
            const int d0 = 32 * db + 8 * i4 + 4 * hh;
            f32x4 o = {O[db][4 * i4] * inv, O[db][4 * i4 + 1] * inv, O[db][4 * i4 + 2] * inv, O[db][4 * i4 + 3] * inv};
            *(f32x4*)(oa + d0) = o;
        }
    if (hh == 0) ((float*)(p.ws + WS_LSEA))[((size_t)g * S + qpos) * 8 + h] = m + __log2f(lt);
}

DI void phase_post(const Params& p, LAS unsigned char* lds) {
    const int tid = tidx();
    const bf16_t* proj = (const bf16_t*)(p.ws + WS_PROJ);
    bf16_t* aout = (bf16_t*)(p.ws + WS_BR); bf16_t* bout = aout + (size_t)S * 1024;
    const float* oa = (const float*)(p.ws + WS_OA); const float* lse = (const float*)(p.ws + WS_LSEA);
    for (int idx0 = blockIdx.x * NTHR + tid; idx0 < S * 256; idx0 += 4 * gridDim.x * NTHR) {
        float l0[4], l1[4], l2[4]; f32x4 o0[4], o1[4], o2[4]; u32x2 gt[4];
#pragma unroll
        for (int u = 0; u < 4; ++u) { const int idx = idx0 + u * gridDim.x * NTHR; const int pos = idx >> 8, c4 = idx & 255, h = c4 >> 5, col = c4 * 4;
            l0[u] = lse[((size_t)0 * S + pos) * 8 + h]; l1[u] = lse[((size_t)1 * S + pos) * 8 + h]; l2[u] = lse[((size_t)2 * S + pos) * 8 + h];
            o0[u] = *(const f32x4*)(oa + ((size_t)0 * S + pos) * 1024 + col); o1[u] = *(const f32x4*)(oa + ((size_t)1 * S + pos) * 1024 + col); o2[u] = *(const f32x4*)(oa + ((size_t)2 * S + pos) * 1024 + col);
            gt[u] = *(const u32x2*)(proj + PIDX(pos, C_AGATE + col)); }
#pragma unroll
        for (int u = 0; u < 4; ++u) { const int idx = idx0 + u * gridDim.x * NTHR; const int pos = idx >> 8, c4 = idx & 255, col = c4 * 4;
            const float mx = fmaxf(l0[u], fmaxf(l1[u], l2[u]));
            const float w0 = __builtin_amdgcn_exp2f(l0[u] - mx), w1 = __builtin_amdgcn_exp2f(l1[u] - mx), w2 = __builtin_amdgcn_exp2f(l2[u] - mx);
            const float inv = __builtin_amdgcn_rcpf(w0 + w1 + w2);
            const f32x4 o = (o0[u] * w0 + o1[u] * w1 + o2[u] * w2) * inv;
            u32x2 ov = {pk2(o[0] * silu_f(bflo(gt[u][0])), o[1] * silu_f(bfhi(gt[u][0]))), pk2(o[2] * silu_f(bflo(gt[u][1])), o[3] * silu_f(bfhi(gt[u][1])))};
            *(u32x2*)(aout + (size_t)pos * 1024 + col) = ov; }
    }
    LAS float* tile = (LAS float*)lds;
    const float* z2t = (const float*)(p.ws + WS_Z2T);
    for (int it0 = blockIdx.x * 4; it0 < 128 * 16; it0 += gridDim.x * 4) {
        __syncthreads();
        f32x4 v[4][2];
#pragma unroll
        for (int u = 0; u < 4; ++u) { const int it = it0 + u, t0 = (it >> 4) * 64, c0 = (it & 15) * 64;
#pragma unroll
            for (int k = 0; k < 2; ++k) { const int e = tid + NTHR * k; const int ci = e >> 4, t4 = (e & 15) * 4; v[u][k] = *(const f32x4*)(z2t + (size_t)(c0 + ci) * S + t0 + t4); } }
#pragma unroll
        for (int u = 0; u < 4; ++u)
#pragma unroll
            for (int k = 0; k < 2; ++k) { const int e = tid + NTHR * k; const int ci = e >> 4, t4 = (e & 15) * 4; LAS float* d = tile + u * 4160 + ci * 65 + t4;
                d[0] = v[u][k][0]; d[1] = v[u][k][1]; d[2] = v[u][k][2]; d[3] = v[u][k][3]; }
        __syncthreads();
        u32x2 gt[4][2];
#pragma unroll
        for (int u = 0; u < 4; ++u) { const int it = it0 + u, t0 = (it >> 4) * 64, c0 = (it & 15) * 64;
#pragma unroll
            for (int k = 0; k < 2; ++k) { const int e = tid + NTHR * k; const int ti = e >> 4, cc = (e & 15) * 4; gt[u][k] = *(const u32x2*)(proj + PIDX(t0 + ti, C_BGATE + c0 + cc)); } }
#pragma unroll
        for (int u = 0; u < 4; ++u) { const int it = it0 + u, t0 = (it >> 4) * 64, c0 = (it & 15) * 64;
#pragma unroll
            for (int k = 0; k < 2; ++k) { const int e = tid + NTHR * k; const int ti = e >> 4, cc = (e & 15) * 4; const LAS float* sp = tile + u * 4160 + cc * 65 + ti;
                const float y0 = sp[0] * silu_f(bflo(gt[u][k][0])), y1 = sp[65] * silu_f(bfhi(gt[u][k][0]));
                const float y2 = sp[130] * silu_f(bflo(gt[u][k][1])), y3 = sp[195] * silu_f(bfhi(gt[u][k][1]));
                u32x2 ov = {pk2(y0, y1), pk2(y2, y3)};
                *(u32x2*)(bout + (size_t)(t0 + ti) * 1024 + c0 + cc) = ov; } }
    }
    __syncthreads();
}

#ifndef REP_GEMMIN
#define REP_GEMMIN 1
#endif
#ifndef REP_DIFF
#define REP_DIFF 1
#endif
#ifndef REP_HYENA
#define REP_HYENA 1
#endif
#ifndef REP_MIXA
#define REP_MIXA 1
#endif
#ifndef REP_PRO
#define REP_PRO 1
#endif
#ifndef REP_SPEC
#define REP_SPEC 1
#endif
#ifndef REP_MISC
#define REP_MISC 1
#endif
#ifndef REP_PROJ
#define REP_PROJ 1
#endif
constexpr int NPH = 3 + 6 * DEPTH + 1;
typedef const Params __attribute__((address_space(4)))* ParamsK;
DI Params ldp(ParamsK pc) {
    asm volatile("" : "+s"(pc));
    Params q;
#pragma unroll
    for (int i = 0; i < 18; ++i) q.in[i] = pc->in[i];
    q.out = pc->out; q.ws = pc->ws; q.ph_lo = pc->ph_lo; q.ph_hi = pc->ph_hi;
    return q;
}
DI void run_phase(ParamsK pc, int ph, LAS unsigned char* lds) {
    if (ph == 0) { for (int rep = 0; rep < REP_PRO; ++rep) { const Params p = ldp(pc); phase_prologue(p, lds); __syncthreads(); } return; }
    if (ph == 1) { const Params p = ldp(pc); phase_tgen(p); return; }
    if (ph == 2) { for (int rep = 0; rep < REP_SPEC; ++rep) { const Params p = ldp(pc); for (int it = blockIdx.x; it < DEPTH * 2 * 256; it += gridDim.x) spectra_item(p, it, lds); } return; }
    if (ph == NPH - 1) { const Params p = ldp(pc); phase_rmsnorm((const float*)(p.ws + WS_X), p.in[I_FINALG], nullptr, p.out); return; }
    const int l = (ph - 3) / 6, sp = (ph - 3) % 6;
    if (sp == 0) { for (int rep = 0; rep < REP_MISC; ++rep) { const Params p = ldp(pc); phase_rmsnorm((l == 0) ? p.in[I_X] : (const float*)(p.ws + WS_X), p.in[I_NORMG] + l * D, (bf16_t*)(p.ws + WS_H), nullptr); } return; }
    if (sp == 1) {
        const Params p = ldp(pc);
        pg8::Gemm g{(const bf16_t*)(p.ws + WS_H), (const bf16_t*)(p.ws + WS_WIN) + (size_t)l * NIN * D, S, NIN, D};
        pg8::StaticOrder so; so.init(S, NIN, gridDim.x, blockIdx.x);
        EpiIn e{(bf16_t*)(p.ws + WS_PROJ), (bf16_t*)(p.ws + WS_VTA), (bf16_t*)(p.ws + WS_VTC), (float*)(p.ws + WS_BINT), lds + 131072};
#pragma unroll 1
        for (int rep = 0; rep < REP_GEMMIN; ++rep) { pg8::gemm_phase(lds, g, so, e); __syncthreads(); }
        return;
    }
    if (sp == 2) {
#pragma unroll 1
        for (int it = blockIdx.x; it < 256 + 256 + 768; it += gridDim.x) {
            int l2 = l; asm volatile("" : "+s"(l2));
            const Params p = ldp(pc);
            if (it < 256) { for (int rep = 0; rep < REP_DIFF; ++rep) diffattn_item(p, l2, it, lds); }
            else if (it < 512) { for (int rep = 0; rep < REP_HYENA; ++rep) hyena_item(p, l2, it - 256, lds); }
            else {
                const int tid2 = tidx(), wi0 = (it - 512) * NWAVES, g = wi0 >> 11, h = (wi0 & 2047) >> 8;
                LAS float* tb = (LAS float*)lds;
                __syncthreads();
                if (tid2 < 192) { const int rel = tid2 - 95; float v = 0.f;
                    if (rel >= -64 && rel <= 64) v = ((const float*)(p.ws + WS_BIAS))[(g * 8 + h) * 2049 + min(max(rel << (2 * g), -1024), 1024) + 1024];
                    tb[tid2] = v; }
                __syncthreads();
                for (int rep = 0; rep < REP_MIXA; ++rep) mixA_wave_item(p, wi0 + (tid2 >> 6), tid2 & 63, tb);
            }
        }
        return;
    }
    if (sp == 3) { for (int rep = 0; rep < REP_MISC; ++rep) { const Params p = ldp(pc); phase_post(p, lds); } return; }
    if (sp == 4) {
#pragma unroll 1
        for (int rep = 0; rep < REP_PROJ; ++rep) {
            const Params p = ldp(pc);
            pg8::Gemm g{(const bf16_t*)(p.ws + WS_BR), (const bf16_t*)(p.ws + WS_WPR) + (size_t)(l * 3) * D * 1024, 3 * S, 3 * D, 1024};
            ProjOrder po; po.so.init(S, D, gridDim.x, blockIdx.x);
            EpiProj e{(const bf16_t*)(p.ws + WS_PROJ), p.in[I_MERGEB] + (size_t)l * 3 * D, (bf16_t*)(p.ws + WS_YB)};
            pg8::gemm_phase(lds, g, po, e);
            __syncthreads();
        }
        return;
    }
    {
        const Params p = ldp(pc);
        pg8::Gemm g{(const bf16_t*)(p.ws + WS_YB), (const bf16_t*)(p.ws + WS_WOUT) + (size_t)l * D * D, S, D, D};
        pg8::StaticOrder so; so.init(S, D, gridDim.x, blockIdx.x);
        EpiOut e{(l == 0) ? p.in[I_X] : (const float*)(p.ws + WS_X), (float*)(p.ws + WS_X)};
#pragma unroll 1
        for (int rep = 0; rep < ((l == 0) ? REP_MISC : 1); ++rep) { pg8::gemm_phase(lds, g, so, e); __syncthreads(); }
    }
}


#define XB_TMO      128
#define XB_XCNT(j)  (256  + 64 * (j))
#define XB_XSUB(j)  (1280 + 64 * (j))
#define XB_XGEN(j)  (2304 + 64 * (j))
#define XB_TOP      3328
#define XB_TOPGEN   3392
#define XCD_BAR_WORDS 3456
#define XB_SPIN_CAP (1u << 18)
DI unsigned xb_ld(unsigned* p)              { return __hip_atomic_load(p, __ATOMIC_RELAXED, __HIP_MEMORY_SCOPE_AGENT); }
DI unsigned xb_add(unsigned* p, unsigned v) { return __hip_atomic_fetch_add(p, v, __ATOMIC_RELAXED, __HIP_MEMORY_SCOPE_AGENT); }
DI unsigned xb_xcc_id() { return (unsigned)__builtin_amdgcn_s_getreg((3 << 11) | 20) & 0xFu; }
#define XB_SPIN(cond, bar) do { unsigned _sp = 0; while (cond) { __builtin_amdgcn_s_sleep(1); \
    if ((++_sp & 255u) == 0u) { if (xb_ld(&(bar)[XB_TMO])) break; if (_sp > XB_SPIN_CAP) { atomicAdd(&(bar)[XB_TMO], 1u); break; } } } } while (0)
struct XcdBarrier { unsigned* bar; unsigned x; volatile LAS unsigned* st; };
DI XcdBarrier xcd_barrier_post(unsigned* bar, volatile LAS unsigned* st) {
    XcdBarrier b; b.bar = bar; b.x = xb_xcc_id(); b.st = st;
    if (threadIdx.x == 0) (void)xb_add(&bar[XB_XCNT(b.x)], 1u);
    return b;
}
DI void xcd_barrier_complete(unsigned* bar, unsigned x, unsigned& nloc, unsigned& nx) {
    const unsigned G = gridDim.x * gridDim.y * gridDim.z;
    unsigned sum, cnt, mine, sp = 0u;
    for (;;) {
        sum = 0u; cnt = 0u; mine = 0u;
#pragma unroll
        for (unsigned j = 0; j < 16; ++j) { const unsigned c = xb_ld(&bar[XB_XCNT(j)]); sum += c; cnt += (c > 0u) ? 1u : 0u; mine = (j == x) ? c : mine; }
        if (sum == G) break;
        __builtin_amdgcn_s_sleep(1);
        if ((++sp & 255u) == 0u) { if (xb_ld(&bar[XB_TMO])) break; if (sp > XB_SPIN_CAP) { atomicAdd(&bar[XB_TMO], 1u); break; } }
    }
    nloc = mine > 0u ? mine : 1u; nx = cnt > 0u ? cnt : 1u;
}
DI void xcd_barrier(const XcdBarrier& b) {
    asm volatile("s_waitcnt vmcnt(0)" ::: "memory");
    __syncthreads();
    if (threadIdx.x == 0) {
        unsigned* bar = b.bar;
        __builtin_amdgcn_s_waitcnt(0);
        unsigned nloc = b.st[0], nx = b.st[1];
        if (nloc == 0u) { xcd_barrier_complete(bar, b.x, nloc, nx); b.st[0] = nloc; b.st[1] = nx; }
        const unsigned old = xb_add(&bar[XB_XSUB(b.x)], 1u);
        const unsigned gen = old / nloc;
        if (old + 1u == (gen + 1u) * nloc) {
            __builtin_amdgcn_fence(__ATOMIC_RELEASE, "agent");
            asm volatile("s_waitcnt vmcnt(0)" ::: "memory");
            const unsigned og = xb_add(&bar[XB_TOP], 1u);
            const unsigned tg = og / nx;
            if (og + 1u == (tg + 1u) * nx) xb_add(&bar[XB_TOPGEN], 1u);
            else XB_SPIN(xb_ld(&bar[XB_TOPGEN]) == tg, bar);
            __builtin_amdgcn_fence(__ATOMIC_ACQUIRE, "agent");
            xb_add(&bar[XB_XGEN(b.x)], 1u);
            asm volatile("s_waitcnt vmcnt(0)" ::: "memory");
        } else {
            XB_SPIN(xb_ld(&bar[XB_XGEN(b.x)]) == gen, bar);
            __builtin_amdgcn_fence(__ATOMIC_ACQUIRE, "agent");
            asm volatile("s_waitcnt vmcnt(0)" ::: "memory");
        }
    }
    __syncthreads();
}

__global__ void __launch_bounds__(512, 2) mega_kernel(Params p) {
#if defined(__HIP_DEVICE_COMPILE__)
    extern __shared__ __attribute__((aligned(16))) unsigned char shm[];
    LAS unsigned char* lds = (LAS unsigned char*)shm;
    cg::grid_group grid = cg::this_grid();
    const int ph_lo = p.ph_lo, ph_hi = p.ph_hi;
    volatile LAS unsigned* st = (volatile LAS unsigned*)(lds + LDS_BYTES - 16);
    if (threadIdx.x == 0) { st[0] = 0u; st[1] = 0u; }
    __syncthreads();
    const XcdBarrier xb = xcd_barrier_post((unsigned*)(p.ws + WS_BAR), st);
#pragma unroll 1
    for (int ph = ph_lo; ph < ph_hi; ++ph) {
        ParamsK pc = (ParamsK)__builtin_amdgcn_kernarg_segment_ptr();
        run_phase(pc, ph, lds);
        if (ph + 1 < ph_hi) { if (ph == ph_lo) grid.sync(); else xcd_barrier(xb); }
    }
#endif
}

#ifndef N_LAUNCH_MODE
#define N_LAUNCH_MODE 1
#endif
extern "C" void kernel_launch(void* const* d_in, const int* in_sizes, int n_in, void* d_out, int out_size, void* d_ws, size_t ws_size, hipStream_t stream) {
    static int grid = 0;
    if (grid == 0) {
        int dev = 0, cus = 0;
        if (hipGetDevice(&dev) != hipSuccess || hipDeviceGetAttribute(&cus, hipDeviceAttributeMultiprocessorCount, dev) != hipSuccess) { fprintf(stderr, "kernel_launch: device query failed\n"); grid = -1; return; }
        if (hipFuncSetAttribute((const void*)mega_kernel, hipFuncAttributeMaxDynamicSharedMemorySize, LDS_BYTES) != hipSuccess) { fprintf(stderr, "kernel_launch: hipFuncSetAttribute failed\n"); grid = -1; return; }
        int per_cu = 0;
        if (hipOccupancyMaxActiveBlocksPerMultiprocessor(&per_cu, (const void*)mega_kernel, NTHR, LDS_BYTES) != hipSuccess || per_cu < 1) { fprintf(stderr, "kernel_launch: occupancy query says %d\n", per_cu); (void)hipGetLastError(); }
        if (n_in != 18 || ws_size < WS_END) { fprintf(stderr, "kernel_launch: n_in %d ws %zu (need %zu)\n", n_in, ws_size, (size_t)WS_END); grid = -1; return; }
        grid = cus;
    }
    if (grid < 0) return;
    Params p{};
    for (int i = 0; i < 18; ++i) p.in[i] = (const float*)d_in[i];
    p.out = (float*)d_out; p.ws = (unsigned char*)d_ws;
    if (hipMemsetAsync((unsigned char*)d_ws + WS_BAR, 0, 16384, stream) != hipSuccess) { fprintf(stderr, "kernel_launch: memset of barrier words failed\n"); return; }
#if N_LAUNCH_MODE == 1
    p.ph_lo = 0; p.ph_hi = NPH;
    void* args[] = {&p};
    hipError_t e = hipLaunchCooperativeKernel((const void*)mega_kernel, dim3(grid), dim3(NTHR), args, LDS_BYTES, stream);
    if (e != hipSuccess) fprintf(stderr, "cooperative launch failed: %s (grid %d)\n", hipGetErrorString(e), grid);
#else
    for (int ph = 0; ph < NPH; ++ph) {
        p.ph_lo = ph; p.ph_hi = ph + 1;
        hipLaunchKernelGGL(mega_kernel, dim3(grid), dim3(NTHR), LDS_BYTES, stream, p);
    }
#endif
}
```

```cpp
#include <hip/hip_runtime.h>
#include <hip/hip_cooperative_groups.h>
#include <cstdio>
namespace cg = cooperative_groups;
#define DI __device__ __forceinline__
#define LAS __attribute__((address_space(3)))
typedef unsigned short bf16_t;
typedef short bf16x8 __attribute__((ext_vector_type(8)));
typedef short s16x4 __attribute__((ext_vector_type(4)));
typedef float f32x4 __attribute__((ext_vector_type(4)));
typedef float f32x16 __attribute__((ext_vector_type(16)));
typedef float f32x2 __attribute__((ext_vector_type(2)));
typedef float cf __attribute__((ext_vector_type(2)));
typedef __bf16 bf16x2n __attribute__((ext_vector_type(2)));
typedef unsigned u32x2 __attribute__((ext_vector_type(2)));
typedef unsigned u32x4 __attribute__((ext_vector_type(4)));

DI unsigned pk2(float lo, float hi) { f32x2 v = {lo, hi}; return __builtin_bit_cast(unsigned, __builtin_convertvector(v, bf16x2n)); }
DI float bflo(unsigned u) { return __uint_as_float(u << 16); }
DI float bfhi(unsigned u) { return __uint_as_float(u & 0xffff0000u); }
DI float silu_f(float x) { return x * __builtin_amdgcn_rcpf(1.0f + __expf(-x)); }
DI float sigm_f(float x) { return __builtin_amdgcn_rcpf(1.0f + __expf(-x)); }

DI int tidx() { int t = threadIdx.x; asm volatile("" : "+v"(t)); return t; }

constexpr int S = 8192, D = 2048, NIN = 24576, DEPTH = 4;
constexpr int C_AGATE = 9216, C_BIN = 10240, C_BGATE = 13312, C_CQKV = 14336, C_CGATE = 17408, C_MERGE = 18432;
constexpr float LOG2E = 1.4426950408889634f;
constexpr int NTHR = 512, NWAVES = 8;
constexpr int LDS_MAIN = 143360, LDS_AUX = 16384, LDS_BYTES = LDS_MAIN + LDS_AUX;

constexpr size_t WS_WIN  = 0;
constexpr size_t WS_WPR  = WS_WIN  + (size_t)DEPTH * NIN * D * 2;
constexpr size_t WS_WOUT = WS_WPR  + (size_t)DEPTH * 3 * D * 1024 * 2;
constexpr size_t WS_SPEC = WS_WOUT + (size_t)DEPTH * D * D * 2;
constexpr size_t WS_HID2 = WS_SPEC + (size_t)DEPTH * 2 * 512 * 8208 * 16;
constexpr size_t WS_BIAS = WS_HID2 + (size_t)DEPTH * S * 64 * 4;
constexpr size_t WS_X    = WS_BIAS + 524288;
constexpr size_t WS_H    = WS_X    + (size_t)S * D * 4;
constexpr size_t WS_PROJ = WS_H    + (size_t)S * D * 2;
constexpr size_t WS_BINT = WS_PROJ + (size_t)S * NIN * 2;
constexpr size_t WS_VTA  = WS_BINT + (size_t)3072 * S * 4;
constexpr size_t WS_VTC  = WS_VTA  + (size_t)3 * 1024 * S * 2;
constexpr size_t WS_OA   = WS_VTC  + (size_t)1024 * S * 2;
constexpr size_t WS_LSEA = WS_OA   + (size_t)3 * S * 1024 * 4;
constexpr size_t WS_Z2T  = WS_LSEA + (size_t)3 * S * 8 * 4;
constexpr size_t WS_BR   = WS_Z2T  + (size_t)1024 * S * 4;
constexpr size_t WS_YF   = WS_BR   + (size_t)3 * S * 1024 * 2;
constexpr size_t WS_YB   = WS_YF   + (size_t)S * D * 4;
constexpr size_t WS_CTMP = WS_YB   + (size_t)S * D * 2;
constexpr size_t WS_BAR  = WS_CTMP + (size_t)S * 1024 * 4;
constexpr size_t WS_TT   = WS_BAR + 16384;
constexpr size_t WS_END  = WS_TT + (size_t)DEPTH * 4096 * S * 4;

DI size_t PIDX(int row, int col) { return ((size_t)(col >> 8) * S + row) * 256 + (col & 255); }

struct Params {
    const float* in[18];
    float* out;
    unsigned char* ws;
    int ph_lo, ph_hi;
};
enum { I_X = 0, I_NORMG, I_FINALG, I_WIN, I_MERGEB, I_RELB, I_HYCONV, I_HYW1, I_HYB1, I_HYFREQ, I_HYW2, I_HYB2, I_HYW3, I_HYSKIP, I_DLAM, I_DG, I_WPROJ, I_WOUT };

namespace pg8 {
constexpr int BM = 256, BK = 64, HALF = 128, HTB = HALF * BK * 2, NXCD = 8, WGM = 8;
DI int lds_byte(int r, int c) { const int st = (r >> 4) * 2 + (c >> 5), rr = r & 15, cc = c & 31, ob = rr * 64 + cc * 2; return st * 1024 + (ob ^ (((ob >> 9) & 1) << 5)); }
DI void stage_rc(int b, int& R, int& C) { const int st = b / 1024, sb = b % 1024, swz = sb ^ (((sb >> 9) & 1) << 5); R = (st >> 1) * 16 + swz / 64; C = (st & 1) * 32 + (swz % 64) / 2; }
DI int perm32(int rho) { const int n = rho >> 4, i = rho & 15; return 8 * (i >> 2) + 4 * n + (i & 3); }
struct Unit { int pm, pn; };
struct Gemm { const bf16_t* A; const bf16_t* Bt; int M, N, K; };
struct StaticOrder {
    int nM, nN, nwg, G, c;
    DI void init(int M, int N, int G_, int c_) { nM = M / BM; nN = N / BM; nwg = nM * nN; G = G_; c = c_; }
    DI bool next(int i, Unit& u) const {
        const long L = (long)i * G + c; if (L >= nwg) return false;
        int wgid = (int)L; { const int q = nwg / NXCD, r = nwg % NXCD, xcd = wgid % NXCD, off = wgid / NXCD; wgid = (xcd < r ? xcd * (q + 1) : r * (q + 1) + (xcd - r) * q) + off; }
        const int nig = WGM * nN, gid = wgid / nig, fm = gid * WGM, gsz = (nM - fm) < WGM ? (nM - fm) : WGM;
        u.pm = fm + ((wgid % nig) % gsz); u.pn = (wgid % nig) / gsz; return true;
    }
};
template <class Epi, class Sched>
DI void gemm_phase(LAS unsigned char* lds, const Gemm g, const Sched& S, const Epi& E) {
    const int tid = tidx(), wid = __builtin_amdgcn_readfirstlane(tid >> 6), lane = tid & 63, wr = wid >> 2, wc = wid & 3, fr = lane & 15, fq = lane >> 4;
    const int K = g.K, nt = K / BK;
    unsigned voffA[2], voffB[2];
#pragma unroll
    for (int i = 0; i < 2; ++i) { int R, C; stage_rc(tid * 16 + i * 8192, R, C); const int Rb = Epi::PERM ? ((R & ~31) + perm32(R & 31)) : R; voffA[i] = (unsigned)(R * K + C) * 2u; voffB[i] = (unsigned)(Rb * K + C) * 2u; }
    const size_t kstep = (size_t)(BK * 2);
    const size_t hstep = (size_t)HALF * K * 2;
    const size_t tstep = 2 * hstep;
    const unsigned ldsw = (unsigned)wid * 1024u;
    const int aoff = lds_byte(wr * 64 + fr, fq * 8), boff = lds_byte(wc * 32 + fr, fq * 8);
#define PG8_SA(b, h) (((b) * 2 + (h)) * HTB)
#define PG8_SB(b, h) ((4 + (b) * 2 + (h)) * HTB)
#define PG8_STAGE(bufoff, gbase, voff) do { _Pragma("unroll") for (int _i = 0; _i < 2; ++_i) \
        __builtin_amdgcn_global_load_lds((const unsigned*)((const char*)(gbase) + (voff)[_i]), (LAS unsigned*)(lds + (bufoff) + ldsw + _i * 8192), 16, 0, 0); } while (0)
#define PG8_LDA(dst, b, h) do { _Pragma("unroll") for (int m = 0; m < 4; ++m) _Pragma("unroll") for (int k = 0; k < 2; ++k) dst[m][k] = *(const LAS bf16x8*)(lds + PG8_SA(b, h) + aoff + m * 2048 + k * 1024); } while (0)
#define PG8_LDB(dst, b, h) do { _Pragma("unroll") for (int n = 0; n < 2; ++n) _Pragma("unroll") for (int k = 0; k < 2; ++k) dst[n][k] = *(const LAS bf16x8*)(lds + PG8_SB(b, h) + boff + n * 2048 + k * 1024); } while (0)
#define PG8_MMA(ai, bj, At, Bt) do { __builtin_amdgcn_s_setprio(1); _Pragma("unroll") for (int m = 0; m < 4; ++m) _Pragma("unroll") for (int n = 0; n < 2; ++n) _Pragma("unroll") for (int k = 0; k < 2; ++k) \
        acc[ai][bj][m][n] = __builtin_amdgcn_mfma_f32_16x16x32_bf16(Bt[n][k], At[m][k], acc[ai][bj][m][n], 0, 0, 0); __builtin_amdgcn_s_setprio(0); } while (0)
#define PG8_WAIT_V(n) asm volatile("s_waitcnt vmcnt(" #n ")" ::: "memory")
#define PG8_WAIT_L(n) asm volatile("s_waitcnt lgkmcnt(" #n ")" ::: "memory")
#define PG8_BAR __builtin_amdgcn_s_barrier()
#define PG8_SCHED __builtin_amdgcn_sched_barrier(0)
    Unit cur, nxt; int ui = 0;
    if (!S.next(0, cur)) return;
    f32x4 acc[2][2][4][2];
#pragma unroll
    for (int a = 0; a < 2; ++a)
#pragma unroll
        for (int b = 0; b < 2; ++b)
#pragma unroll
            for (int m = 0; m < 4; ++m)
#pragma unroll
                for (int n = 0; n < 2; ++n) acc[a][b][m][n] = (f32x4){0.f, 0.f, 0.f, 0.f};
    bf16x8 At[4][2], B0[2][2], B1[2][2];
    const char* cA = (const char*)g.A + (size_t)cur.pm * tstep; const char* cB = (const char*)g.Bt + (size_t)cur.pn * tstep;
    PG8_STAGE(PG8_SB(0, 0), cB, voffB); PG8_STAGE(PG8_SA(0, 0), cA, voffA); PG8_STAGE(PG8_SB(0, 1), cB + hstep, voffB); PG8_STAGE(PG8_SA(0, 1), cA + hstep, voffA);
    if (wr == 1) PG8_BAR;
    PG8_WAIT_V(4); PG8_BAR;
    PG8_STAGE(PG8_SB(1, 0), cB + kstep, voffB); PG8_STAGE(PG8_SA(1, 0), cA + kstep, voffA); PG8_STAGE(PG8_SB(1, 1), cB + hstep + kstep, voffB);
    PG8_WAIT_V(6); PG8_BAR;
    for (;;) {
        const bool has_next = S.next(ui + 1, nxt);
        const char* nA = has_next ? (const char*)g.A + (size_t)nxt.pm * tstep : cA; const char* nB = has_next ? (const char*)g.Bt + (size_t)nxt.pn * tstep : cB;
        for (int t = 0; t < nt; t += 2) {
            const bool last = (t == nt - 2);
            const char* a1 = cA + (size_t)(t + 1) * kstep;
            const char* a2 = last ? nA : cA + (size_t)(t + 2) * kstep; const char* b2 = last ? nB : cB + (size_t)(t + 2) * kstep;
            const char* a3 = a2 + kstep; const char* b3 = b2 + kstep;
            PG8_LDB(B0, 0, 0); PG8_SCHED; PG8_LDA(At, 0, 0); PG8_STAGE(PG8_SA(1, 1), a1 + hstep, voffA);
            PG8_WAIT_L(8); PG8_BAR; PG8_WAIT_L(0); PG8_MMA(0, 0, At, B0); PG8_BAR; PG8_SCHED;
            PG8_LDB(B1, 0, 1); PG8_STAGE(PG8_SB(0, 0), b2, voffB);
            PG8_BAR; PG8_WAIT_L(0); PG8_MMA(0, 1, At, B1); PG8_BAR;
            PG8_LDA(At, 0, 1); PG8_STAGE(PG8_SA(0, 0), a2, voffA);
            PG8_BAR; PG8_WAIT_L(0); PG8_MMA(1, 0, At, B0); PG8_BAR; PG8_SCHED;
            PG8_STAGE(PG8_SB(0, 1), b2 + hstep, voffB);
            PG8_WAIT_V(6); PG8_BAR; PG8_MMA(1, 1, At, B1); PG8_BAR;
            PG8_LDB(B0, 1, 0); PG8_SCHED; PG8_LDA(At, 1, 0); PG8_STAGE(PG8_SA(0, 1), a2 + hstep, voffA);
            PG8_WAIT_L(8); PG8_BAR; PG8_WAIT_L(0); PG8_MMA(0, 0, At, B0); PG8_BAR; PG8_SCHED;
            PG8_LDB(B1, 1, 1); PG8_STAGE(PG8_SB(1, 0), b3, voffB);
            PG8_BAR; PG8_WAIT_L(0); PG8_MMA(0, 1, At, B1); PG8_BAR;
            PG8_LDA(At, 1, 1); PG8_STAGE(PG8_SA(1, 0), a3, voffA);
            PG8_BAR; PG8_WAIT_L(0); PG8_MMA(1, 0, At, B0); PG8_BAR; PG8_SCHED;
            PG8_STAGE(PG8_SB(1, 1), b3 + hstep, voffB);
            PG8_WAIT_V(6); PG8_BAR; PG8_MMA(1, 1, At, B1); PG8_BAR;
        }
        const bool keep = E(acc, cur, wr, wc, fr, fq);
        if (!has_next) break;
        if (!keep)
#pragma unroll
        for (int a = 0; a < 2; ++a)
#pragma unroll
            for (int b = 0; b < 2; ++b)
#pragma unroll
                for (int m = 0; m < 4; ++m)
#pragma unroll
                    for (int n = 0; n < 2; ++n) acc[a][b][m][n] = (f32x4){0.f, 0.f, 0.f, 0.f};
        cur = nxt; cA = nA; cB = nB; ++ui;
    }
    PG8_WAIT_V(0);
    if (wr == 0) PG8_BAR;
    PG8_BAR;
#undef PG8_SA
#undef PG8_SB
#undef PG8_STAGE
#undef PG8_LDA
#undef PG8_LDB
#undef PG8_MMA
#undef PG8_WAIT_V
#undef PG8_WAIT_L
#undef PG8_BAR
#undef PG8_SCHED
}
}

struct EpiIn {
    static constexpr bool PERM = true;
    bf16_t* proj; bf16_t* vta; bf16_t* vtc; float* bint; LAS unsigned char* tlds;
    DI bool operator()(const f32x4 (&acc)[2][2][4][2], const pg8::Unit& u, int wr, int wc, int fr, int fq) const { store(acc, u, wr, wc, fr, fq); return false; }
    DI void store(const f32x4 (&acc)[2][2][4][2], const pg8::Unit& u, int wr, int wc, int fr, int fq) const {
        const int colt = u.pn * 256;
        int kind = 0;
        if (colt < C_AGATE) { if ((colt % 3072) >= 2048) kind = 1; }
        else if (colt >= C_BIN && colt < C_BGATE) kind = 2;
        else if (colt >= C_CQKV + 2048 && colt < C_CGATE) kind = 3;
        const int row0 = u.pm * 256 + wr * 64 + fr, col0 = colt + wc * 32 + 8 * fq;
        if (kind == 0) {
#pragma unroll
            for (int ai = 0; ai < 2; ++ai)
#pragma unroll
                for (int m = 0; m < 4; ++m) { bf16_t* rp = proj + PIDX(row0 + ai * 128 + m * 16, col0);
#pragma unroll
                    for (int bj = 0; bj < 2; ++bj) { const f32x4 a = acc[ai][bj][m][0], b = acc[ai][bj][m][1];
                        u32x4 o = {pk2(a[0], a[1]), pk2(a[2], a[3]), pk2(b[0], b[1]), pk2(b[2], b[3])}; *(u32x4*)(rp + bj * 128) = o; } }
        } else if (kind == 1 && colt >= 2 * 3072) {
            bf16_t* base = vta + (ptrdiff_t)(2 * 1024 - 2 * 3072 - 2048) * (ptrdiff_t)S;
#pragma unroll
            for (int ai = 0; ai < 2; ++ai) { const int prow = fr * (S >> 4) + ((u.pm * 256 + ai * 128 + wr * 64) >> 4);
#pragma unroll
                for (int bj = 0; bj < 2; ++bj)
#pragma unroll
                    for (int n = 0; n < 2; ++n)
#pragma unroll
                        for (int e = 0; e < 4; ++e) { u32x2 o = {pk2(acc[ai][bj][0][n][e], acc[ai][bj][1][n][e]), pk2(acc[ai][bj][2][n][e], acc[ai][bj][3][n][e])};
                            *(u32x2*)(base + (ptrdiff_t)(col0 + bj * 128 + n * 4 + e) * (ptrdiff_t)S + prow) = o; } }
        } else {
            const int lane = fr + 16 * fq, wave = wr * 4 + wc;
            LAS float* tl = (LAS float*)(tlds + wave * 2304);
            const int cl = lane >> 1, hs = lane & 1;
            const int colg = colt + wc * 32 + cl;
#pragma unroll
            for (int ai = 0; ai < 2; ++ai)
#pragma unroll
                for (int bj = 0; bj < 2; ++bj)
#pragma unroll
                    for (int m = 0; m < 4; ++m) {
                        const int rowb = u.pm * 256 + ai * 128 + wr * 64 + m * 16;
#pragma unroll
                        for (int n = 0; n < 2; ++n)
#pragma unroll
                            for (int e = 0; e < 4; ++e) tl[(8 * fq + 4 * n + e) * 17 + fr] = acc[ai][bj][m][n][e];
                        __builtin_amdgcn_wave_barrier();
                        const LAS float* tc = tl + cl * 17;
                        const int col = colg + bj * 128;
                        if (kind == 2) {
                            f32x4 o0 = {tc[8 * hs], tc[8 * hs + 1], tc[8 * hs + 2], tc[8 * hs + 3]}, o1 = {tc[8 * hs + 4], tc[8 * hs + 5], tc[8 * hs + 6], tc[8 * hs + 7]};
                            float* bp = bint + (size_t)(col - C_BIN) * S + rowb + 8 * hs;
                            *(f32x4*)bp = o0; *(f32x4*)(bp + 4) = o1;
                        } else if (kind == 3) {
                            u32x4 o = {pk2(tc[4 * hs], tc[4 * hs + 1]), pk2(tc[4 * hs + 2], tc[4 * hs + 3]), pk2(tc[8 + 4 * hs], tc[9 + 4 * hs]), pk2(tc[10 + 4 * hs], tc[11 + 4 * hs])};
                            *(u32x4*)(vtc + (size_t)(col - (C_CQKV + 2048)) * S + rowb + 8 * hs) = o;
                        } else if (colt < 3072) {
                            u32x4 o = {pk2(tc[8 * hs], tc[8 * hs + 1]), pk2(tc[8 * hs + 2], tc[8 * hs + 3]), pk2(tc[8 * hs + 4], tc[8 * hs + 5]), pk2(tc[8 * hs + 6], tc[8 * hs + 7])};
                            *(u32x4*)(vta + (size_t)(col - 2048) * S + rowb + 8 * hs) = o;
                        } else {
#pragma unroll
                            for (int k = 0; k < 2; ++k) { const int res = 2 * hs + k;
                                u32x2 o = {pk2(tc[res], tc[res + 4]), pk2(tc[res + 8], tc[res + 12])};
                                *(u32x2*)(vta + (size_t)(1024 + col - 3072 - 2048) * S + res * (S >> 2) + (rowb >> 2)) = o; }
                        }
                        __builtin_amdgcn_wave_barrier();
                    }
        }
    }
};
struct ProjOrder {
    pg8::StaticOrder so;
    DI bool next(int i, pg8::Unit& u) const { pg8::Unit b; if (!so.next(i / 3, b)) return false; const int nb = i % 3; u.pm = b.pm + 32 * nb; u.pn = b.pn + 8 * nb; return true; }
};
struct EpiProj {   static constexpr bool PERM = false;
    const bf16_t* proj; const float* mb; bf16_t* yb;
    DI bool operator()(f32x4 (&acc)[2][2][4][2], const pg8::Unit& u, int wr, int wc, int fr, int fq) const {
        const int nb = u.pm >> 5, nn = nb < 2 ? nb + 1 : nb;
        const int row0 = (u.pm & 31) * 256 + wr * 64 + fr, col0 = (u.pn & 7) * 256 + wc * 32 + 4 * fq;
        f32x4 bc[2][2], bn[2][2];
#pragma unroll
        for (int bj = 0; bj < 2; ++bj)
#pragma unroll
            for (int n = 0; n < 2; ++n) { bc[bj][n] = *(const f32x4*)(mb + nb * D + col0 + bj * 128 + n * 16); bn[bj][n] = *(const f32x4*)(mb + nn * D + col0 + bj * 128 + n * 16); }
#pragma unroll
        for (int ai = 0; ai < 2; ++ai)
#pragma unroll
            for (int mp = 0; mp < 2; ++mp) {
                u32x2 gc[2][2][2], gn[2][2][2];
#pragma unroll
                for (int mi = 0; mi < 2; ++mi) { const int row = row0 + ai * 128 + (2 * mp + mi) * 16;
#pragma unroll
                    for (int bj = 0; bj < 2; ++bj)
#pragma unroll
                        for (int n = 0; n < 2; ++n) { const int col = col0 + bj * 128 + n * 16;
                            gc[mi][bj][n] = *(const u32x2*)(proj + PIDX(row, C_MERGE + nb * D + col));
                            gn[mi][bj][n] = *(const u32x2*)(proj + PIDX(row, C_MERGE + nn * D + col)); } }
#pragma unroll
                for (int mi = 0; mi < 2; ++mi) { const int m = 2 * mp + mi; const int row = row0 + ai * 128 + m * 16;
#pragma unroll
                    for (int bj = 0; bj < 2; ++bj)
#pragma unroll
                        for (int n = 0; n < 2; ++n) { const int col = col0 + bj * 128 + n * 16;
                            const u32x2 c2 = gc[mi][bj][n], n2 = gn[mi][bj][n]; const f32x4 cb = bc[bj][n], nbv = bn[bj][n];
                            const float xc[4] = {bflo(c2[0]) + cb[0], bfhi(c2[0]) + cb[1], bflo(c2[1]) + cb[2], bfhi(c2[1]) + cb[3]};
                            const float xn[4] = {bflo(n2[0]) + nbv[0], bfhi(n2[0]) + nbv[1], bflo(n2[1]) + nbv[2], bfhi(n2[1]) + nbv[3]};
                            if (nb < 2) {
#pragma unroll
                                for (int e = 0; e < 4; ++e) acc[ai][bj][m][n][e] *= (1.0f + __expf(-xn[e])) * __builtin_amdgcn_rcpf(1.0f + __expf(-xc[e]));
                            } else {
                                const f32x4 a = acc[ai][bj][m][n];
                                u32x2 o = {pk2(a[0] * sigm_f(xc[0]), a[1] * sigm_f(xc[1])), pk2(a[2] * sigm_f(xc[2]), a[3] * sigm_f(xc[3]))};
                                *(u32x2*)(yb + (size_t)row * D + col) = o;
                            } } }
            }
        return nb < 2;
    }
};
struct EpiOut {   static constexpr bool PERM = false;
    const float* xold; float* xnew;
    DI bool operator()(const f32x4 (&acc)[2][2][4][2], const pg8::Unit& u, int wr, int wc, int fr, int fq) const { store(acc, u, wr, wc, fr, fq); return false; }
    DI void store(const f32x4 (&acc)[2][2][4][2], const pg8::Unit& u, int wr, int wc, int fr, int fq) const {
        const int row0 = u.pm * 256 + wr * 64 + fr, col0 = u.pn * 256 + wc * 32 + 4 * fq;
#pragma unroll
        for (int ai = 0; ai < 2; ++ai)
#pragma unroll
            for (int mp = 0; mp < 2; ++mp) {
                f32x4 xv[2][2][2];
#pragma unroll
                for (int mi = 0; mi < 2; ++mi)
#pragma unroll
                    for (int bj = 0; bj < 2; ++bj)
#pragma unroll
                        for (int n = 0; n < 2; ++n) xv[mi][bj][n] = *(const f32x4*)(xold + (size_t)(row0 + ai * 128 + (2 * mp + mi) * 16) * D + col0 + bj * 128 + n * 16);
#pragma unroll
                for (int mi = 0; mi < 2; ++mi)
#pragma unroll
                    for (int bj = 0; bj < 2; ++bj)
#pragma unroll
                        for (int n = 0; n < 2; ++n) *(f32x4*)(xnew + (size_t)(row0 + ai * 128 + (2 * mp + mi) * 16) * D + col0 + bj * 128 + n * 16) = xv[mi][bj][n] + acc[ai][bj][2 * mp + mi][n];
            }
    }
};
DI float wave_sum(float v) {
#pragma unroll
    for (int o = 1; o < 64; o <<= 1) v += __shfl_xor(v, o);
    return v;
}
typedef unsigned u32x2v __attribute__((ext_vector_type(2)));
DI float xhalf_max(float x) {
    const unsigned u = __float_as_uint(x);
    const u32x2v rr = __builtin_amdgcn_permlane32_swap(u, u, false, false);
    return fmaxf(__uint_as_float(rr[0]), __uint_as_float(rr[1]));
}
DI int crow(int reg, int h) { return (reg & 3) + 8 * (reg >> 2) + 4 * h; }
DI bf16x8 pack8(const f32x16& x, const int s) {
    u32x4 p;
    p[0] = pk2(x[8 * s + 0], x[8 * s + 1]); p[1] = pk2(x[8 * s + 2], x[8 * s + 3]);
    p[2] = pk2(x[8 * s + 4], x[8 * s + 5]); p[3] = pk2(x[8 * s + 6], x[8 * s + 7]);
    return __builtin_bit_cast(bf16x8, p);
}
#define MFMA32(a, b, c) __builtin_amdgcn_mfma_f32_32x32x16_bf16((a), (b), (c), 0, 0, 0)

DI void transpose_item(const float* Wsrc, int K, int N, bf16_t* WT, LAS float* scr, int item, int lane) {
    const int nblk = N / 64, kb = item / nblk, nb = item % nblk, k0 = 64 * kb, n0 = 64 * nb;
    const int lr = lane >> 4, lc = (lane & 15) * 4;
    f32x4 v[16];
#pragma unroll
    for (int i = 0; i < 16; ++i) v[i] = *(const f32x4*)(Wsrc + (size_t)(k0 + 4 * i + lr) * N + n0 + lc);
#pragma unroll
    for (int i = 0; i < 16; ++i) { LAS float* d = scr + (4 * i + lr) * 65 + lc; d[0] = v[i][0]; d[1] = v[i][1]; d[2] = v[i][2]; d[3] = v[i][3]; }
    __builtin_amdgcn_wave_barrier();
    const int c = lane & 7;
#pragma unroll
    for (int j = 0; j < 8; ++j) { const int n = (lane >> 3) + 8 * j; const LAS float* s = scr + (8 * c) * 65 + n;
        u32x4 o; o[0] = pk2(s[0 * 65], s[1 * 65]); o[1] = pk2(s[2 * 65], s[3 * 65]); o[2] = pk2(s[4 * 65], s[5 * 65]); o[3] = pk2(s[6 * 65], s[7 * 65]);
        *(u32x4*)(WT + (size_t)(n0 + n) * K + k0 + 8 * c) = o; }
    __builtin_amdgcn_wave_barrier();
}
DI int t5_bucket(int rel) {
    const int ret = rel > 0 ? 16 : 0; const int n = rel < 0 ? -rel : rel;
    const float nf = (float)(n > 1 ? n : 1);
    int large = 8 + (int)(logf(nf / 8.0f) / 4.852030263919617f * 8.0f);
    large = large < 15 ? large : 15;
    return ret + (n < 8 ? n : large);
}
DI void phase_convert(const Params& p, LAS unsigned char* lds) {
    const int tid = tidx(), wave = tid >> 6, lane = tid & 63;
    const int gw = blockIdx.x * NWAVES + wave, NGW = gridDim.x * NWAVES;
    LAS float* scr = (LAS float*)(lds + wave * 16640);
    bf16_t* win_t = (bf16_t*)(p.ws + WS_WIN); bf16_t* wpr_t = (bf16_t*)(p.ws + WS_WPR); bf16_t* wout_t = (bf16_t*)(p.ws + WS_WOUT);
    constexpr int IT_IN = (D / 64) * (NIN / 64), IT_PR = (1024 / 64) * (D / 64), IT_OUT = (D / 64) * (D / 64);
    constexpr int TOT = DEPTH * IT_IN + DEPTH * 3 * IT_PR + DEPTH * IT_OUT;
    for (int it = gw; it < TOT; it += NGW) {
        int r = it;
        if (r < DEPTH * IT_IN) { const int l = r / IT_IN; transpose_item(p.in[I_WIN] + (size_t)l * D * NIN, D, NIN, win_t + (size_t)l * NIN * D, scr, r % IT_IN, lane); continue; }
        r -= DEPTH * IT_IN;
        if (r < DEPTH * 3 * IT_PR) { const int l = r / IT_PR; transpose_item(p.in[I_WPROJ] + (size_t)l * 1024 * D, 1024, D, wpr_t + (size_t)l * D * 1024, scr, r % IT_PR, lane); continue; }
        r -= DEPTH * 3 * IT_PR;
        { const int l = r / IT_OUT; transpose_item(p.in[I_WOUT] + (size_t)l * D * D, D, D, wout_t + (size_t)l * D * D, scr, r % IT_OUT, lane); }
    }
}
DI void phase_prologue(const Params& p, LAS unsigned char* lds) {
    const int tid = tidx();
    float* bias = (float*)(p.ws + WS_BIAS);
    for (int i = blockIdx.x * NTHR + tid; i < 32 * 2049; i += gridDim.x * NTHR) {
        const int hd = i / 2049, rel = (i % 2049) - 1024;
        bias[i] = p.in[I_RELB][t5_bucket(rel) * 32 + hd] * LOG2E;
    }
    __syncthreads();
    LAS float* zemb = (LAS float*)lds;
    LAS float* h1 = (LAS float*)(lds + 2048);
    float* hid2 = (float*)(p.ws + WS_HID2);
    for (int rb = blockIdx.x; rb < S / 8; rb += gridDim.x) {
        const int rl = tid >> 6, j = tid & 63, i = rb * 8 + rl;
        if (j < 33) {
            float z;
            if (j == 0) z = (float)i / 8191.0f;
            else { const int k = (j - 1) & 15; const float fb = 1e-4f + (float)k * ((15.0f - 1e-4f) / 15.0f); const float w = 6.283185307179586f * (float)i / 8192.0f; const float a = fb * w; z = (j <= 16) ? cosf(a) : -sinf(a); }
            zemb[rl * 36 + j] = z;
        }
        __syncthreads();
        for (int l = 0; l < DEPTH; ++l) {
            float a1 = p.in[I_HYB1][l * 64 + j];
            for (int e = 0; e < 33; ++e) a1 += zemb[rl * 36 + e] * p.in[I_HYW1][(l * 33 + e) * 64 + j];
            h1[rl * 64 + j] = sinf(p.in[I_HYFREQ][(l * 2 + 0) * 64 + j] * a1);
            __syncthreads();
            float a2 = p.in[I_HYB2][l * 64 + j];
            for (int e = 0; e < 64; ++e) a2 += h1[rl * 64 + e] * p.in[I_HYW2][(l * 64 + e) * 64 + j];
            hid2[((size_t)l * S + i) * 64 + j] = sinf(p.in[I_HYFREQ][(l * 2 + 1) * 64 + j] * a2);
            __syncthreads();
        }
    }
}


DI void split8(const f32x4 a, const f32x4 b, bf16x8& hi, bf16x8& lo) {
    u32x4 h, l2;
    h[0] = pk2(a[0], a[1]); h[1] = pk2(a[2], a[3]); h[2] = pk2(b[0], b[1]); h[3] = pk2(b[2], b[3]);
    l2[0] = pk2(a[0] - bflo(h[0]), a[1] - bfhi(h[0])); l2[1] = pk2(a[2] - bflo(h[1]), a[3] - bfhi(h[1]));
    l2[2] = pk2(b[0] - bflo(h[2]), b[1] - bfhi(h[2])); l2[3] = pk2(b[2] - bflo(h[3]), b[3] - bfhi(h[3]));
    hi = __builtin_bit_cast(bf16x8, h); lo = __builtin_bit_cast(bf16x8, l2);
}
DI void phase_tgen(const Params& p) {
    const int tid = tidx(), wave = tid >> 6, lane = tid & 63, r = lane & 31, hh = lane >> 5;
    float* tt = (float*)(p.ws + WS_TT);
    for (int it = blockIdx.x * NWAVES + wave; it < DEPTH * 128 * 4; it += gridDim.x * NWAVES) {
        const int l = it >> 9, cb = (it >> 2) & 127, rc = it & 3;
        const float* w3 = p.in[I_HYW3] + (size_t)l * 64 * 4096 + cb * 32 + r;
        bf16x8 ahi[4], alo[4];
#pragma unroll
        for (int ks = 0; ks < 4; ++ks) {
            f32x4 a, b;
#pragma unroll
            for (int j = 0; j < 4; ++j) { a[j] = w3[(size_t)(16 * ks + 8 * hh + j) * 4096]; b[j] = w3[(size_t)(16 * ks + 8 * hh + 4 + j) * 4096]; }
            split8(a, b, ahi[ks], alo[ks]);
        }
        const float* hid2 = (const float*)(p.ws + WS_HID2) + (size_t)l * S * 64;
        f32x4 ha[4], hb[4];
        { const float* hr = hid2 + (size_t)(rc * 2048 + r) * 64 + 8 * hh;
#pragma unroll
          for (int ks = 0; ks < 4; ++ks) { ha[ks] = *(const f32x4*)(hr + 16 * ks); hb[ks] = *(const f32x4*)(hr + 16 * ks + 4); } }
#pragma unroll 1
        for (int rb = 0; rb < 64; ++rb) {
            const int i0 = rc * 2048 + rb * 32;
            bf16x8 bhi[4], blo[4];
#pragma unroll
            for (int ks = 0; ks < 4; ++ks) split8(ha[ks], hb[ks], bhi[ks], blo[ks]);
            if (rb + 1 < 64) { const float* hr = hid2 + (size_t)(i0 + 32 + r) * 64 + 8 * hh;
#pragma unroll
                for (int ks = 0; ks < 4; ++ks) { ha[ks] = *(const f32x4*)(hr + 16 * ks); hb[ks] = *(const f32x4*)(hr + 16 * ks + 4); } }
            f32x16 acc;
#pragma unroll
            for (int i = 0; i < 16; ++i) acc[i] = 0.f;
#pragma unroll
            for (int ks = 0; ks < 4; ++ks) { acc = MFMA32(ahi[ks], bhi[ks], acc); acc = MFMA32(ahi[ks], blo[ks], acc); acc = MFMA32(alo[ks], bhi[ks], acc); }
            float* tp = tt + ((size_t)l * 4096 + cb * 32) * S + i0 + r;
#pragma unroll
            for (int reg = 0; reg < 16; ++reg) tp[(size_t)crow(reg, hh) * S] = acc[reg];
        }
    }
}

#define XI(i) ((i) + ((i) >> 4) + ((i) >> 8))
DI cf cmul(cf a, cf b) {
    cf t, r;
    asm("v_pk_mul_f32 %0, %1, %2 op_sel:[0,0] op_sel_hi:[0,1]" : "=v"(t) : "v"(a), "v"(b));
    asm("v_pk_fma_f32 %0, %1, %2, %3 op_sel:[1,1,0] op_sel_hi:[1,0,1] neg_lo:[0,1,0]" : "=v"(r) : "v"(a), "v"(b), "v"(t));
    return r;
}
DI cf twid(float frac) { float c = __builtin_amdgcn_cosf(frac), s = __builtin_amdgcn_sinf(frac); asm volatile("s_nop 1" : "+v"(c), "+v"(s)); return (cf){c, -s}; }
DI cf twidc(float frac) { float c = __builtin_amdgcn_cosf(frac), s = __builtin_amdgcn_sinf(frac); asm volatile("s_nop 1" : "+v"(c), "+v"(s)); return (cf){c, s}; }
DI void fwd4(cf& a0, cf& a1, cf& a2, cf& a3) {
    const cf s02 = a0 + a2, d02 = a0 - a2, s13 = a1 + a3, d13 = a1 - a3;
    a0 = s02 + s13; a2 = s02 - s13;
    a1 = (cf){d02.x + d13.y, d02.y - d13.x};
    a3 = (cf){d02.x - d13.y, d02.y + d13.x};
}
DI void inv4(cf& b0, cf& b1, cf& b2, cf& b3) {
    const cf s02 = b0 + b2, d02 = b0 - b2, s13 = b1 + b3, d13 = b1 - b3;
    b0 = s02 + s13; b2 = s02 - s13;
    b1 = (cf){d02.x - d13.y, d02.y + d13.x};
    b3 = (cf){d02.x + d13.y, d02.y - d13.x};
}
template <int LOGM> DI void fwd_r4_pass(LAS cf* X, int tid) {
    asm volatile("" : "+v"(tid));
    constexpr int M = 1 << LOGM, q = M >> 2;
#pragma unroll 2
    for (int t = tid; t < 4096; t += NTHR) {
        const int j = t & (q - 1), base = (t >> (LOGM - 2)) * M + j;
        constexpr int QP = (q >= 256) ? (q + (q >> 4) + (q >> 8)) : ((q == 16) ? 17 : 1);
        LAS cf* xp = X + XI(base);
        cf a0 = xp[0], a1 = xp[QP], a2 = xp[2 * QP], a3 = xp[3 * QP];
        fwd4(a0, a1, a2, a3);
        const cf w1 = twid((float)j * (1.0f / M)), w2 = cmul(w1, w1), w3 = cmul(w2, w1);
        xp[0] = a0; xp[QP] = cmul(a1, w1); xp[2 * QP] = cmul(a2, w2); xp[3 * QP] = cmul(a3, w3);
    }
}
template <int LOGM> DI void inv_r4_pass(LAS cf* X, int tid) {
    asm volatile("" : "+v"(tid));
    constexpr int M = 1 << LOGM, q = M >> 2;
#pragma unroll 2
    for (int t = tid; t < 4096; t += NTHR) {
        const int j = t & (q - 1), base = (t >> (LOGM - 2)) * M + j;
        const cf w1 = twidc((float)j * (1.0f / M)), w2 = cmul(w1, w1), w3 = cmul(w2, w1);
        constexpr int QP = (q >= 256) ? (q + (q >> 4) + (q >> 8)) : ((q == 16) ? 17 : 1);
        LAS cf* xp = X + XI(base);
        cf b0 = xp[0], b1 = cmul(xp[QP], w1), b2 = cmul(xp[2 * QP], w2), b3 = cmul(xp[3 * QP], w3);
        inv4(b0, b1, b2, b3);
        xp[0] = b0; xp[QP] = b1; xp[2 * QP] = b2; xp[3 * QP] = b3;
    }
}
template <int LOGM> DI void fwd16(cf (&v)[16], int j) {
    constexpr int M = 1 << LOGM, q = M >> 4;
#pragma unroll
    for (int n = 0; n < 4; ++n) {
        fwd4(v[n], v[n + 4], v[n + 8], v[n + 12]);
        const cf w1 = twid((float)(j + n * q) * (1.0f / M)), w2 = cmul(w1, w1), w3 = cmul(w2, w1);
        v[n + 4] = cmul(v[n + 4], w1); v[n + 8] = cmul(v[n + 8], w2); v[n + 12] = cmul(v[n + 12], w3);
    }
    const cf u1 = twid((float)j * (4.0f / M)), u2 = cmul(u1, u1), u3 = cmul(u2, u1);
#pragma unroll
    for (int m = 0; m < 4; ++m) {
        fwd4(v[4 * m], v[4 * m + 1], v[4 * m + 2], v[4 * m + 3]);
        v[4 * m + 1] = cmul(v[4 * m + 1], u1); v[4 * m + 2] = cmul(v[4 * m + 2], u2); v[4 * m + 3] = cmul(v[4 * m + 3], u3);
    }
}
template <int LOGM> DI void inv16(cf (&v)[16], int j) {
    constexpr int M = 1 << LOGM, q = M >> 4;
    const cf u1 = twidc((float)j * (4.0f / M)), u2 = cmul(u1, u1), u3 = cmul(u2, u1);
#pragma unroll
    for (int m = 0; m < 4; ++m) {
        v[4 * m + 1] = cmul(v[4 * m + 1], u1); v[4 * m + 2] = cmul(v[4 * m + 2], u2); v[4 * m + 3] = cmul(v[4 * m + 3], u3);
        inv4(v[4 * m], v[4 * m + 1], v[4 * m + 2], v[4 * m + 3]);
    }
#pragma unroll
    for (int n = 0; n < 4; ++n) {
        const cf w1 = twidc((float)(j + n * q) * (1.0f / M)), w2 = cmul(w1, w1), w3 = cmul(w2, w1);
        v[n + 4] = cmul(v[n + 4], w1); v[n + 8] = cmul(v[n + 8], w2); v[n + 12] = cmul(v[n + 12], w3);
        inv4(v[n], v[n + 4], v[n + 8], v[n + 12]);
    }
}
template <int LOGM> DI void fwd_r16_pass(LAS cf* X, int tid) {
    asm volatile("" : "+v"(tid));
    constexpr int M = 1 << LOGM, q = M >> 4;
#pragma unroll 1
    for (int t = tid; t < 1024; t += NTHR) {
        const int j = t & (q - 1), base = (t >> (LOGM - 4)) * M + j;
        constexpr int QP = (q >= 256) ? (q + (q >> 4) + (q >> 8)) : ((q == 16) ? 17 : 1);
        LAS cf* xp = X + XI(base);
        cf v[16];
#pragma unroll
        for (int n = 0; n < 16; ++n) v[n] = xp[n * QP];
        fwd16<LOGM>(v, j);
#pragma unroll
        for (int n = 0; n < 16; ++n) xp[n * QP] = v[n];
    }
}
template <int LOGM> DI void inv_r16_pass(LAS cf* X, int tid) {
    asm volatile("" : "+v"(tid));
    constexpr int M = 1 << LOGM, q = M >> 4;
#pragma unroll 1
    for (int t = tid; t < 1024; t += NTHR) {
        const int j = t & (q - 1), base = (t >> (LOGM - 4)) * M + j;
        constexpr int QP = (q >= 256) ? (q + (q >> 4) + (q >> 8)) : ((q == 16) ? 17 : 1);
        LAS cf* xp = X + XI(base);
        cf v[16];
#pragma unroll
        for (int n = 0; n < 16; ++n) v[n] = xp[n * QP];
        inv16<LOGM>(v, j);
#pragma unroll
        for (int n = 0; n < 16; ++n) xp[n * QP] = v[n];
    }
}
DI int rev4(int pp) { const unsigned br = __brev((unsigned)pp) >> 18; return (int)(((br & 0x2AAAu) >> 1) | ((br & 0x1555u) << 1)); }
DI void fft_forward(LAS cf* X, int tid) {
    fwd_r4_pass<14>(X, tid); __syncthreads();
    fwd_r16_pass<12>(X, tid); __syncthreads();
    fwd_r16_pass<8>(X, tid); __syncthreads();
    fwd_r16_pass<4>(X, tid); __syncthreads();
}
constexpr int SPEC_STRIDE = 8208;
DI void fft_conv(LAS cf* X, const f32x4* spec, int tid) {
    fft_forward(X, tid);
#pragma unroll 8
    for (int r = 0; r < 16; ++r) {
        const int k = tid + NTHR * r; const int pp = rev4(k);
        const f32x4 sp = spec[k]; const cf P = (cf){sp[0], sp[1]}, Mq = (cf){sp[2], sp[3]};
        const cf z = X[XI(pp)];
        if (k == 0) { X[XI(pp)] = cmul(z, P) + cmul((cf){z.x, -z.y}, Mq); }
        else { const int pm = rev4(16384 - k); const cf zm = X[XI(pm)];
            const cf y = cmul(z, P) + cmul((cf){zm.x, -zm.y}, Mq);
            const cf t = cmul((cf){zm.x, -zm.y}, P) + cmul(z, Mq);
            X[XI(pp)] = y; X[XI(pm)] = (cf){t.x, -t.y}; }
    }
    if (tid == 0) { const int pp = rev4(8192); const f32x4 sp = spec[8192]; const cf z = X[XI(pp)]; X[XI(pp)] = cmul(z, (cf){sp[0], sp[1]}) + cmul((cf){z.x, -z.y}, (cf){sp[2], sp[3]}); }
    __syncthreads();
    inv_r16_pass<4>(X, tid); __syncthreads();
    inv_r16_pass<8>(X, tid); __syncthreads();
    inv_r16_pass<12>(X, tid); __syncthreads();
    inv_r4_pass<14>(X, tid); __syncthreads();
}


typedef _Float16 hc __attribute__((ext_vector_type(2)));
DI hc hcmul(hc a, hc b) { hc t, r;
    asm("v_pk_mul_f16 %0, %1, %2 op_sel:[0,0] op_sel_hi:[0,1]" : "=v"(t) : "v"(a), "v"(b));
    asm("v_pk_fma_f16 %0, %1, %2, %3 op_sel:[1,1,0] op_sel_hi:[1,0,1] neg_lo:[0,1,0]" : "=v"(r) : "v"(a), "v"(b), "v"(t)); return r; }
DI hc hadd_mi(hc a, hc b) { hc r; asm("v_pk_add_f16 %0, %1, %2 op_sel:[0,1] op_sel_hi:[1,0] neg_hi:[0,1]" : "=v"(r) : "v"(a), "v"(b)); return r; }
DI hc hadd_pi(hc a, hc b) { hc r; asm("v_pk_add_f16 %0, %1, %2 op_sel:[0,1] op_sel_hi:[1,0] neg_lo:[0,1]" : "=v"(r) : "v"(a), "v"(b)); return r; }
DI hc htwid(float frac) { float c = __builtin_amdgcn_cosf(frac), s = __builtin_amdgcn_sinf(frac); asm volatile("s_nop 1" : "+v"(c), "+v"(s)); return (hc){(_Float16)c, (_Float16)(-s)}; }
DI hc htwidc(float frac) { float c = __builtin_amdgcn_cosf(frac), s = __builtin_amdgcn_sinf(frac); asm volatile("s_nop 1" : "+v"(c), "+v"(s)); return (hc){(_Float16)c, (_Float16)s}; }
DI void hfwd4(hc& a0, hc& a1, hc& a2, hc& a3) {
    const hc s02 = a0 + a2, d02 = a0 - a2, s13 = a1 + a3, d13 = a1 - a3;
    a0 = s02 + s13; a2 = s02 - s13; a1 = hadd_mi(d02, d13); a3 = hadd_pi(d02, d13);
}
DI void hinv4(hc& b0, hc& b1, hc& b2, hc& b3) {
    const hc s02 = b0 + b2, d02 = b0 - b2, s13 = b1 + b3, d13 = b1 - b3;
    b0 = s02 + s13; b2 = s02 - s13; b1 = hadd_pi(d02, d13); b3 = hadd_mi(d02, d13);
}
template <int LOGM> DI void hfwd_r4_pass(LAS hc* X, int tid) {
    asm volatile("" : "+v"(tid));
    constexpr int M = 1 << LOGM, q = M >> 2;
#pragma unroll 8
    for (int t = tid; t < 4096; t += NTHR) {
        const int j = t & (q - 1), base = (t >> (LOGM - 2)) * M + j;
        constexpr int QP = (q >= 256) ? (q + (q >> 4) + (q >> 8)) : ((q == 16) ? 17 : 1);
        LAS hc* xp = X + XI(base);
        hc a0 = xp[0], a1 = xp[QP], a2 = xp[2 * QP], a3 = xp[3 * QP];
        hfwd4(a0, a1, a2, a3);
        const hc w1 = htwid((float)j * (1.0f / M)), w2 = hcmul(w1, w1), w3 = hcmul(w2, w1);
        xp[0] = a0; xp[QP] = hcmul(a1, w1); xp[2 * QP] = hcmul(a2, w2); xp[3 * QP] = hcmul(a3, w3);
    }
}
template <int LOGM> DI void hinv_r4_pass(LAS hc* X, int tid) {
    asm volatile("" : "+v"(tid));
    constexpr int M = 1 << LOGM, q = M >> 2;
#pragma unroll 8
    for (int t = tid; t < 4096; t += NTHR) {
        const int j = t & (q - 1), base = (t >> (LOGM - 2)) * M + j;
        const hc w1 = htwidc((float)j * (1.0f / M)), w2 = hcmul(w1, w1), w3 = hcmul(w2, w1);
        constexpr int QP = (q >= 256) ? (q + (q >> 4) + (q >> 8)) : ((q == 16) ? 17 : 1);
        LAS hc* xp = X + XI(base);
        hc b0 = xp[0], b1 = hcmul(xp[QP], w1), b2 = hcmul(xp[2 * QP], w2), b3 = hcmul(xp[3 * QP], w3);
        hinv4(b0, b1, b2, b3);
        xp[0] = b0; xp[QP] = b1; xp[2 * QP] = b2; xp[3 * QP] = b3;
    }
}
template <int LOGM> DI void hfwd16(hc (&v)[16], int j) {
    constexpr int M = 1 << LOGM, q = M >> 4;
#pragma unroll
    for (int n = 0; n < 4; ++n) {
        hfwd4(v[n], v[n + 4], v[n + 8], v[n + 12]);
        const hc w1 = htwid((float)(j + n * q) * (1.0f / M)), w2 = hcmul(w1, w1), w3 = hcmul(w2, w1);
        v[n + 4] = hcmul(v[n + 4], w1); v[n + 8] = hcmul(v[n + 8], w2); v[n + 12] = hcmul(v[n + 12], w3);
    }
    const hc u1 = htwid((float)j * (4.0f / M)), u2 = hcmul(u1, u1), u3 = hcmul(u2, u1);
#pragma unroll
    for (int m = 0; m < 4; ++m) {
        hfwd4(v[4 * m], v[4 * m + 1], v[4 * m + 2], v[4 * m + 3]);
        v[4 * m + 1] = hcmul(v[4 * m + 1], u1); v[4 * m + 2] = hcmul(v[4 * m + 2], u2); v[4 * m + 3] = hcmul(v[4 * m + 3], u3);
    }
}
template <int LOGM> DI void hinv16(hc (&v)[16], int j) {
    constexpr int M = 1 << LOGM, q = M >> 4;
    const hc u1 = htwidc((float)j * (4.0f / M)), u2 = hcmul(u1, u1), u3 = hcmul(u2, u1);
#pragma unroll
    for (int m = 0; m < 4; ++m) {
        v[4 * m + 1] = hcmul(v[4 * m + 1], u1); v[4 * m + 2] = hcmul(v[4 * m + 2], u2); v[4 * m + 3] = hcmul(v[4 * m + 3], u3);
        hinv4(v[4 * m], v[4 * m + 1], v[4 * m + 2], v[4 * m + 3]);
    }
#pragma unroll
    for (int n = 0; n < 4; ++n) {
        const hc w1 = htwidc((float)(j + n * q) * (1.0f / M)), w2 = hcmul(w1, w1), w3 = hcmul(w2, w1);
        v[n + 4] = hcmul(v[n + 4], w1); v[n + 8] = hcmul(v[n + 8], w2); v[n + 12] = hcmul(v[n + 12], w3);
        hinv4(v[n], v[n + 4], v[n + 8], v[n + 12]);
    }
}
template <int LOGM, bool FWD> DI void h_r16_pass(LAS hc* X, int tid) {
    asm volatile("" : "+v"(tid));
    constexpr int M = 1 << LOGM, q = M >> 4;
#pragma unroll
    for (int t = tid; t < 1024; t += NTHR) {
        const int j = t & (q - 1), base = (t >> (LOGM - 4)) * M + j;
        constexpr int QP = (q >= 256) ? (q + (q >> 4) + (q >> 8)) : ((q == 16) ? 17 : 1);
        LAS hc* xp = X + XI(base);
        hc v[16];
#pragma unroll
        for (int n = 0; n < 16; ++n) v[n] = xp[n * QP];
        if (FWD) hfwd16<LOGM>(v, j); else hinv16<LOGM>(v, j);
#pragma unroll
        for (int n = 0; n < 16; ++n) xp[n * QP] = v[n];
    }
}
DI void fft_conv_h(LAS hc* X, const f32x4* spec, int tid) {
    hfwd_r4_pass<14>(X, tid); __syncthreads();
    h_r16_pass<12, true>(X, tid); __syncthreads();
    h_r16_pass<8, true>(X, tid); __syncthreads();
    h_r16_pass<4, true>(X, tid); __syncthreads();
#pragma unroll 8
    for (int r = 0; r < 16; ++r) {
        const int k = tid + NTHR * r; const int pp = rev4(k);
        const f32x4 sp = spec[k]; const cf P = (cf){sp[0], sp[1]} * 256.0f, Mq = (cf){sp[2], sp[3]} * 256.0f;
        const hc zh = X[XI(pp)]; const cf z = (cf){(float)zh.x, (float)zh.y};
        if (k == 0) { const cf y = cmul(z, P) + cmul((cf){z.x, -z.y}, Mq); X[XI(pp)] = (hc){(_Float16)y.x, (_Float16)y.y}; }
        else { const int pm = rev4(16384 - k); const hc zmh = X[XI(pm)]; const cf zm = (cf){(float)zmh.x, (float)zmh.y};
            const cf y = cmul(z, P) + cmul((cf){zm.x, -zm.y}, Mq);
            const cf t = cmul((cf){zm.x, -zm.y}, P) + cmul(z, Mq);
            X[XI(pp)] = (hc){(_Float16)y.x, (_Float16)y.y}; X[XI(pm)] = (hc){(_Float16)t.x, (_Float16)(-t.y)}; }
    }
    if (tid == 0) { const int pp = rev4(8192); const f32x4 sp = spec[8192]; const hc zh = X[XI(pp)]; const cf z = (cf){(float)zh.x, (float)zh.y};
        const cf y = (cmul(z, (cf){sp[0], sp[1]}) + cmul((cf){z.x, -z.y}, (cf){sp[2], sp[3]})) * 256.0f; X[XI(pp)] = (hc){(_Float16)y.x, (_Float16)y.y}; }
    __syncthreads();
    h_r16_pass<4, false>(X, tid); __syncthreads();
    h_r16_pass<8, false>(X, tid); __syncthreads();
    h_r16_pass<12, false>(X, tid); __syncthreads();
    hinv_r4_pass<14>(X, tid); __syncthreads();
}

template <int LOGM> DI void hfwd_r4_pass2(LAS hc* X0, LAS hc* X1, int tid) {
    asm volatile("" : "+v"(tid));
    constexpr int M = 1 << LOGM, q = M >> 2;
#pragma unroll 4
    for (int t = tid; t < 4096; t += NTHR) {
        const int j = t & (q - 1), base = (t >> (LOGM - 2)) * M + j;
        constexpr int QP = (q >= 256) ? (q + (q >> 4) + (q >> 8)) : ((q == 16) ? 17 : 1);
        const int xo = XI(base);
        LAS hc* xp = X0 + xo; LAS hc* yp = X1 + xo;
        hc a0 = xp[0], a1 = xp[QP], a2 = xp[2 * QP], a3 = xp[3 * QP], b0 = yp[0], b1 = yp[QP], b2 = yp[2 * QP], b3 = yp[3 * QP];
        hfwd4(a0, a1, a2, a3); hfwd4(b0, b1, b2, b3);
        const hc w1 = htwid((float)j * (1.0f / M)), w2 = hcmul(w1, w1), w3 = hcmul(w2, w1);
        xp[0] = a0; xp[QP] = hcmul(a1, w1); xp[2 * QP] = hcmul(a2, w2); xp[3 * QP] = hcmul(a3, w3);
        yp[0] = b0; yp[QP] = hcmul(b1, w1); yp[2 * QP] = hcmul(b2, w2); yp[3 * QP] = hcmul(b3, w3);
    }
}
template <int LOGM> DI void hinv_r4_pass2(LAS hc* X0, LAS hc* X1, int tid) {
    asm volatile("" : "+v"(tid));
    constexpr int M = 1 << LOGM, q = M >> 2;
#pragma unroll 4
    for (int t = tid; t < 4096; t += NTHR) {
        const int j = t & (q - 1), base = (t >> (LOGM - 2)) * M + j;
        const hc w1 = htwidc((float)j * (1.0f / M)), w2 = hcmul(w1, w1), w3 = hcmul(w2, w1);
        constexpr int QP = (q >= 256) ? (q + (q >> 4) + (q >> 8)) : ((q == 16) ? 17 : 1);
        const int xo = XI(base);
        LAS hc* xp = X0 + xo; LAS hc* yp = X1 + xo;
        hc a0 = xp[0], a1 = hcmul(xp[QP], w1), a2 = hcmul(xp[2 * QP], w2), a3 = hcmul(xp[3 * QP], w3);
        hc b0 = yp[0], b1 = hcmul(yp[QP], w1), b2 = hcmul(yp[2 * QP], w2), b3 = hcmul(yp[3 * QP], w3);
        hinv4(a0, a1, a2, a3); hinv4(b0, b1, b2, b3);
        xp[0] = a0; xp[QP] = a1; xp[2 * QP] = a2; xp[3 * QP] = a3;
        yp[0] = b0; yp[QP] = b1; yp[2 * QP] = b2; yp[3 * QP] = b3;
    }
}
template <int LOGM> DI void hfwd16x2(hc (&v)[16], hc (&u)[16], int j) {
    constexpr int M = 1 << LOGM, q = M >> 4;
#pragma unroll
    for (int n = 0; n < 4; ++n) {
        hfwd4(v[n], v[n + 4], v[n + 8], v[n + 12]); hfwd4(u[n], u[n + 4], u[n + 8], u[n + 12]);
        const hc w1 = htwid((float)(j + n * q) * (1.0f / M)), w2 = hcmul(w1, w1), w3 = hcmul(w2, w1);
        v[n + 4] = hcmul(v[n + 4], w1); v[n + 8] = hcmul(v[n + 8], w2); v[n + 12] = hcmul(v[n + 12], w3);
        u[n + 4] = hcmul(u[n + 4], w1); u[n + 8] = hcmul(u[n + 8], w2); u[n + 12] = hcmul(u[n + 12], w3);
    }
    const hc u1 = htwid((float)j * (4.0f / M)), u2 = hcmul(u1, u1), u3 = hcmul(u2, u1);
#pragma unroll
    for (int m = 0; m < 4; ++m) {
        hfwd4(v[4 * m], v[4 * m + 1], v[4 * m + 2], v[4 * m + 3]); hfwd4(u[4 * m], u[4 * m + 1], u[4 * m + 2], u[4 * m + 3]);
        v[4 * m + 1] = hcmul(v[4 * m + 1], u1); v[4 * m + 2] = hcmul(v[4 * m + 2], u2); v[4 * m + 3] = hcmul(v[4 * m + 3], u3);
        u[4 * m + 1] = hcmul(u[4 * m + 1], u1); u[4 * m + 2] = hcmul(u[4 * m + 2], u2); u[4 * m + 3] = hcmul(u[4 * m + 3], u3);
    }
}
template <int LOGM> DI void hinv16x2(hc (&v)[16], hc (&u)[16], int j) {
    constexpr int M = 1 << LOGM, q = M >> 4;
    const hc u1 = htwidc((float)j * (4.0f / M)), u2 = hcmul(u1, u1), u3 = hcmul(u2, u1);
#pragma unroll
    for (int m = 0; m < 4; ++m) {
        v[4 * m + 1] = hcmul(v[4 * m + 1], u1); v[4 * m + 2] = hcmul(v[4 * m + 2], u2); v[4 * m + 3] = hcmul(v[4 * m + 3], u3);
        u[4 * m + 1] = hcmul(u[4 * m + 1], u1); u[4 * m + 2] = hcmul(u[4 * m + 2], u2); u[4 * m + 3] = hcmul(u[4 * m + 3], u3);
        hinv4(v[4 * m], v[4 * m + 1], v[4 * m + 2], v[4 * m + 3]); hinv4(u[4 * m], u[4 * m + 1], u[4 * m + 2], u[4 * m + 3]);
    }
#pragma unroll
    for (int n = 0; n < 4; ++n) {
        const hc w1 = htwidc((float)(j + n * q) * (1.0f / M)), w2 = hcmul(w1, w1), w3 = hcmul(w2, w1);
        v[n + 4] = hcmul(v[n + 4], w1); v[n + 8] = hcmul(v[n + 8], w2); v[n + 12] = hcmul(v[n + 12], w3);
        u[n + 4] = hcmul(u[n + 4], w1); u[n + 8] = hcmul(u[n + 8], w2); u[n + 12] = hcmul(u[n + 12], w3);
        hinv4(v[n], v[n + 4], v[n + 8], v[n + 12]); hinv4(u[n], u[n + 4], u[n + 8], u[n + 12]);
    }
}
template <int LOGM, bool FWD> DI void h_r16_pass2(LAS hc* X0, LAS hc* X1, int tid) {
    asm volatile("" : "+v"(tid));
    constexpr int M = 1 << LOGM, q = M >> 4;
#pragma unroll 1
    for (int t = tid; t < 1024; t += NTHR) {
        const int j = t & (q - 1), base = (t >> (LOGM - 4)) * M + j;
        constexpr int QP = (q >= 256) ? (q + (q >> 4) + (q >> 8)) : ((q == 16) ? 17 : 1);
        const int xo = XI(base);
        LAS hc* xp = X0 + xo; LAS hc* yp = X1 + xo;
        hc v[16], u[16];
#pragma unroll
        for (int n = 0; n < 16; ++n) { v[n] = xp[n * QP]; u[n] = yp[n * QP]; }
        if (FWD) hfwd16x2<LOGM>(v, u, j); else hinv16x2<LOGM>(v, u, j);
#pragma unroll
        for (int n = 0; n < 16; ++n) { xp[n * QP] = v[n]; yp[n * QP] = u[n]; }
    }
}
DI void pw_h(LAS hc* X, const f32x4* spec, int tid) {
#pragma unroll 8
    for (int r = 0; r < 16; ++r) {
        const int k = tid + NTHR * r; const int pp = rev4(k);
        const f32x4 sp = spec[k]; const cf P = (cf){sp[0], sp[1]} * 256.0f, Mq = (cf){sp[2], sp[3]} * 256.0f;
        const hc zh = X[XI(pp)]; const cf z = (cf){(float)zh.x, (float)zh.y};
        if (k == 0) { const cf y = cmul(z, P) + cmul((cf){z.x, -z.y}, Mq); X[XI(pp)] = (hc){(_Float16)y.x, (_Float16)y.y}; }
        else { const int pm = rev4(16384 - k); const hc zmh = X[XI(pm)]; const cf zm = (cf){(float)zmh.x, (float)zmh.y};
            const cf y = cmul(z, P) + cmul((cf){zm.x, -zm.y}, Mq);
            const cf t = cmul((cf){zm.x, -zm.y}, P) + cmul(z, Mq);
            X[XI(pp)] = (hc){(_Float16)y.x, (_Float16)y.y}; X[XI(pm)] = (hc){(_Float16)t.x, (_Float16)(-t.y)}; }
    }
    if (tid == 0) { const int pp = rev4(8192); const f32x4 sp = spec[8192]; const hc zh = X[XI(pp)]; const cf z = (cf){(float)zh.x, (float)zh.y};
        const cf y = (cmul(z, (cf){sp[0], sp[1]}) + cmul((cf){z.x, -z.y}, (cf){sp[2], sp[3]})) * 256.0f; X[XI(pp)] = (hc){(_Float16)y.x, (_Float16)y.y}; }
}
DI void fft_conv_h2(LAS hc* X0, LAS hc* X1, const f32x4* spec0, const f32x4* spec1, int tid) {
    hfwd_r4_pass2<14>(X0, X1, tid); __syncthreads();
    h_r16_pass2<12, true>(X0, X1, tid); __syncthreads();
    h_r16_pass2<8, true>(X0, X1, tid); __syncthreads();
    h_r16_pass2<4, true>(X0, X1, tid); __syncthreads();
    pw_h(X0, spec0, tid); pw_h(X1, spec1, tid);
    __syncthreads();
    h_r16_pass2<4, false>(X0, X1, tid); __syncthreads();
    h_r16_pass2<8, false>(X0, X1, tid); __syncthreads();
    h_r16_pass2<12, false>(X0, X1, tid); __syncthreads();
    hinv_r4_pass2<14>(X0, X1, tid); __syncthreads();
}

DI void spectra_item(const Params& p, int ditem, LAS unsigned char* lds) {
    int tid = tidx(); asm volatile("" : "+v"(tid));
    const int l = ditem >> 9, o = (ditem >> 8) & 1, d = ditem & 255, a = 4 * d;
    LAS hc* X0 = (LAS hc*)lds; LAS hc* X1 = X0 + 17472;
    const float mind = -3.0701134573253943f, maxd = -15.350567286626972f;
    float dec[4], sk[4];
#pragma unroll
    for (int c = 0; c < 4; ++c) { dec[c] = fabsf(mind + (float)(a + c) * ((maxd - mind) / 1023.0f)); sk[c] = p.in[I_HYSKIP][(l * 2 + o) * 1024 + a + c]; }
    const float* tf = (const float*)(p.ws + WS_TT) + ((size_t)l * 4096 + (o * 2 + 0) * 1024 + a) * S;
    const float* tb = (const float*)(p.ws + WS_TT) + ((size_t)l * 4096 + (o * 2 + 1) * 1024 + a) * S;
#pragma unroll 8
    for (int rr = 0; rr < 16; ++rr) {
        const int i = tid + NTHR * rr;
        const float ti = (float)i / 8191.0f;
        float f[4], b[4];
#pragma unroll
        for (int c = 0; c < 4; ++c) { const float e = __expf(-ti * dec[c]) * 256.0f; f[c] = tf[(size_t)c * S + i] * e; b[c] = tb[(size_t)c * S + i] * e; }
        if (i == 0) {
            X0[XI(0)] = (hc){(_Float16)(f[0] + b[0] + sk[0] * 256.0f), (_Float16)(f[1] + b[1] + sk[1] * 256.0f)}; X1[XI(0)] = (hc){(_Float16)(f[2] + b[2] + sk[2] * 256.0f), (_Float16)(f[3] + b[3] + sk[3] * 256.0f)};
            X0[XI(8192)] = (hc){(_Float16)0.f, (_Float16)0.f}; X1[XI(8192)] = (hc){(_Float16)0.f, (_Float16)0.f};
        } else {
            X0[XI(i)] = (hc){(_Float16)f[0], (_Float16)f[1]}; X1[XI(i)] = (hc){(_Float16)f[2], (_Float16)f[3]};
            X0[XI(16384 - i)] = (hc){(_Float16)b[0], (_Float16)b[1]}; X1[XI(16384 - i)] = (hc){(_Float16)b[2], (_Float16)b[3]};
        }
    }
    __syncthreads();
    hfwd_r4_pass2<14>(X0, X1, tid); __syncthreads();
    h_r16_pass2<12, true>(X0, X1, tid); __syncthreads();
    h_r16_pass2<8, true>(X0, X1, tid); __syncthreads();
    h_r16_pass2<4, true>(X0, X1, tid); __syncthreads();
    const float sc = 0.5f / 16384.0f / 256.0f;
#pragma unroll
    for (int half = 0; half < 2; ++half) {
        LAS hc* X = half ? X1 : X0;
        f32x4* spec = (f32x4*)(p.ws + WS_SPEC) + (size_t)((l * 2 + o) * 512 + 2 * d + half) * SPEC_STRIDE;
        for (int r = 0; r < 17; ++r) {
            const int k = tid + NTHR * r; if (k > 8192) break;
            const hc Fh = X[XI(rev4(k))], Fmh = X[XI(rev4((16384 - k) & 16383))]; const cf F = (cf){(float)Fh.x, (float)Fh.y}, Fm = (cf){(float)Fmh.x, (float)Fmh.y};
            const cf Fc = (cf){Fm.x, -Fm.y};
            const cf Ha = (F + Fc) * 0.5f, tt = (F - Fc) * 0.5f; const cf Hb = (cf){tt.y, -tt.x};
            const cf P = (Ha + Hb) * sc, Mq = (Ha - Hb) * sc;
            spec[k] = (f32x4){P.x, P.y, Mq.x, Mq.y};
        }
    }
    __syncthreads();
}

DI float conv3(const float* row, int t, float w0, float w1, float w2) {
    const float c = row[t]; float pv = row[t > 0 ? t - 1 : 0], nx = row[t < S - 1 ? t + 1 : S - 1];
    pv = t > 0 ? pv : 0.f; nx = t < S - 1 ? nx : 0.f;
    return w0 * pv + w1 * c + w2 * nx;
}
DI void hyena_item(const Params& p, int l, int dpr, LAS unsigned char* lds) {
    int tid = tidx(); asm volatile("" : "+v"(tid)); const int a = 4 * dpr;
    LAS hc* X0 = (LAS hc*)lds; LAS hc* X1 = X0 + 17472;
    const float* bint = (const float*)(p.ws + WS_BINT);
    const float* cw = p.in[I_HYCONV] + (size_t)l * 3 * 3072;
    const f32x4* spec = (const f32x4*)(p.ws + WS_SPEC);
    const hc hzero = (hc){(_Float16)0.f, (_Float16)0.f};
    float w[4][3];
#pragma unroll
    for (int c = 0; c < 4; ++c)
#pragma unroll
        for (int k = 0; k < 3; ++k) w[c][k] = cw[k * 3072 + 0 * 1024 + a + c];
#pragma unroll 4
    for (int r = 0; r < 16; ++r) { const int t = tid + NTHR * r;
        float v[4];
#pragma unroll
        for (int c = 0; c < 4; ++c) v[c] = conv3(bint + (size_t)(a + c) * S, t, w[c][0], w[c][1], w[c][2]) * 0.25f;
        X0[XI(t)] = (hc){(_Float16)v[0], (_Float16)v[1]}; X1[XI(t)] = (hc){(_Float16)v[2], (_Float16)v[3]};
        X0[XI(t + 8192)] = hzero; X1[XI(t + 8192)] = hzero; }
    __syncthreads();
    fft_conv_h2(X0, X1, spec + (size_t)((l * 2 + 0) * 512 + 2 * dpr) * SPEC_STRIDE, spec + (size_t)((l * 2 + 0) * 512 + 2 * dpr + 1) * SPEC_STRIDE, tid);
#pragma unroll
    for (int c = 0; c < 4; ++c)
#pragma unroll
        for (int k = 0; k < 3; ++k) w[c][k] = cw[k * 3072 + 1 * 1024 + a + c];
#pragma unroll 4
    for (int r = 0; r < 16; ++r) { const int t = tid + NTHR * r; const hc y0 = X0[XI(t)], y1 = X1[XI(t)];
        const float yv[4] = {(float)y0.x, (float)y0.y, (float)y1.x, (float)y1.y};
        float z[4];
#pragma unroll
        for (int c = 0; c < 4; ++c) z[c] = yv[c] * (1.0f / 64.0f) * conv3(bint + (size_t)(1024 + a + c) * S, t, w[c][0], w[c][1], w[c][2]) * 0.25f;
        X0[XI(t)] = (hc){(_Float16)z[0], (_Float16)z[1]}; X1[XI(t)] = (hc){(_Float16)z[2], (_Float16)z[3]};
        X0[XI(t + 8192)] = hzero; X1[XI(t + 8192)] = hzero; }
    __syncthreads();
    fft_conv_h2(X0, X1, spec + (size_t)((l * 2 + 1) * 512 + 2 * dpr) * SPEC_STRIDE, spec + (size_t)((l * 2 + 1) * 512 + 2 * dpr + 1) * SPEC_STRIDE, tid);
#pragma unroll
    for (int c = 0; c < 4; ++c)
#pragma unroll
        for (int k = 0; k < 3; ++k) w[c][k] = cw[k * 3072 + 2 * 1024 + a + c];
    float* z2t = (float*)(p.ws + WS_Z2T);
#pragma unroll 4
    for (int r = 0; r < 16; ++r) { const int t = tid + NTHR * r; const hc y0 = X0[XI(t)], y1 = X1[XI(t)];
        const float yv[4] = {(float)y0.x, (float)y0.y, (float)y1.x, (float)y1.y};
#pragma unroll
        for (int c = 0; c < 4; ++c) z2t[(size_t)(a + c) * S + t] = yv[c] * (1.0f / 64.0f) * conv3(bint + (size_t)(2048 + a + c) * S, t, w[c][0], w[c][1], w[c][2]); }
    __syncthreads();
}
DI void phase_rmsnorm(const float* x, const float* g, bf16_t* hout, float* fout) {
    const int tid = tidx(), wave = tid >> 6, lane = tid & 63;
    const int gw = blockIdx.x * NWAVES + wave, ngw = gridDim.x * NWAVES;
    for (int row = gw; row < S; row += 2 * ngw) {
        const int row2 = row + ngw;
        const bool has2 = row2 < S;
        const f32x4* xr = (const f32x4*)(x + (size_t)row * D) + lane;
        const f32x4* xr2 = (const f32x4*)(x + (size_t)(has2 ? row2 : row) * D) + lane;
        f32x4 v[8], v2[8]; float s = 0.f, s2 = 0.f;
#pragma unroll
        for (int j = 0; j < 8; ++j) { v[j] = xr[64 * j]; v2[j] = xr2[64 * j]; }
#pragma unroll
        for (int j = 0; j < 8; ++j) { s += (v[j][0] * v[j][0] + v[j][1] * v[j][1]) + (v[j][2] * v[j][2] + v[j][3] * v[j][3]); s2 += (v2[j][0] * v2[j][0] + v2[j][1] * v2[j][1]) + (v2[j][2] * v2[j][2] + v2[j][3] * v2[j][3]); }
        const float rstd = rsqrtf(wave_sum(s) * (1.0f / D) + 1e-6f), rstd2 = rsqrtf(wave_sum(s2) * (1.0f / D) + 1e-6f);
#pragma unroll
        for (int j = 0; j < 8; ++j) { const f32x4 gg = ((const f32x4*)g)[lane + 64 * j]; const f32x4 y = v[j] * rstd * gg, y2 = v2[j] * rstd2 * gg;
            if (hout) { u32x2 o = {pk2(y[0], y[1]), pk2(y[2], y[3])}; ((u32x2*)(hout + (size_t)row * D))[lane + 64 * j] = o;
                if (has2) { u32x2 o2 = {pk2(y2[0], y2[1]), pk2(y2[2], y2[3])}; ((u32x2*)(hout + (size_t)row2 * D))[lane + 64 * j] = o2; } }
            else { ((f32x4*)(fout + (size_t)row * D))[lane + 64 * j] = y; if (has2) ((f32x4*)(fout + (size_t)row2 * D))[lane + 64 * j] = y2; } }
    }
}

constexpr int KROW = 144, KBUF = 64 * KROW, VBUF = 128 * KROW;
DI void softmax_half(f32x16& s, const LAS float* btab, int k0, int q0w, int r, int hh, float cs, float& m, float& lsum, f32x16 (&O)[4]) {
    const int q = q0w + r;
    const int relmin = k0 - q0w - 31, relmax = k0 + 31 - q0w;
    float bc = 0.f, csx = cs;
    if (relmin >= 1024 || relmax <= -1024) { bc = btab[relmin >= 1024 ? 2048 : 0]; }
    else {
        if (relmin >= -1024 && relmax <= 1024) {
            const LAS float* bp = btab + (k0 - q + 1024 + 4 * hh);
#pragma unroll
            for (int i = 0; i < 16; ++i) s[i] = s[i] * cs + bp[(i & 3) + 8 * (i >> 2)];
        } else {
#pragma unroll
            for (int i = 0; i < 16; ++i) { const int rel = k0 + crow(i, hh) - q; const int i0 = min(max(rel, -1024), 1024) + 1024; s[i] = s[i] * cs + btab[i0]; }
        }
        csx = 1.0f;
    }
    float mx = s[0];
#pragma unroll
    for (int i = 1; i < 16; ++i) mx = fmaxf(mx, s[i]);
    mx = mx * csx + bc;
    mx = xhalf_max(mx);
    if (__any(mx > m + 8.0f)) {
        const float mnew = fmaxf(m, mx), alpha = __builtin_amdgcn_exp2f(m - mnew);
        m = mnew; lsum *= alpha;
#pragma unroll
        for (int db = 0; db < 4; ++db) O[db] *= alpha;
    }
    const float c2 = bc - m;
    float rs0 = 0.f, rs1 = 0.f;
#pragma unroll
    for (int i = 0; i < 16; i += 2) { s[i] = __builtin_amdgcn_exp2f(s[i] * csx + c2); s[i + 1] = __builtin_amdgcn_exp2f(s[i + 1] * csx + c2); rs0 += s[i]; rs1 += s[i + 1]; }
    lsum += rs0 + rs1;
}
constexpr int K3BUF = 64 * 128, V3BUF = 128 * 128;
DI void dstage_k(const bf16_t* kgl, LAS unsigned char* dst, int wave, int lane) {
    const int row = 8 * wave + (lane >> 3), gseg = (lane & 7) ^ ((row >> 1) & 7);
    __builtin_amdgcn_global_load_lds((const unsigned*)(kgl + (size_t)row * 256 + gseg * 8), (LAS unsigned*)(dst + wave * 1024), 16, 0, 0);
}
DI void dstage_v(const bf16_t* vgl, LAS unsigned char* dst, int wave, int lane) {
#pragma unroll
    for (int k = 0; k < 2; ++k) { const int ii = 2 * wave + k, row = 8 * ii + (lane >> 3), gseg = (lane & 7) ^ ((row >> 1) & 7);
        __builtin_amdgcn_global_load_lds((const unsigned*)(vgl + (size_t)row * S + gseg * 8), (LAS unsigned*)(dst + ii * 1024), 16, 0, 0); }
}
DI void sm_max_phase(f32x16& s, const LAS float* btab, int k0, int q0w, int r, int hh, float cs, float& m, float& lsum, f32x16 (&O)[4], float& csx, float& c2) {
    const int q = q0w + r;
    const int relmin = k0 - q0w - 31, relmax = k0 + 31 - q0w;
    float bc = 0.f; csx = cs;
    if (relmin >= 1024 || relmax <= -1024) { bc = btab[relmin >= 1024 ? 2048 : 0]; }
    else {
        if (relmin >= -1024 && relmax <= 1024) {
            const LAS float* bp = btab + (k0 - q + 1024 + 4 * hh);
#pragma unroll
            for (int i = 0; i < 16; ++i) s[i] = s[i] * cs + bp[(i & 3) + 8 * (i >> 2)];
        } else {
#pragma unroll
            for (int i = 0; i < 16; ++i) { const int rel = k0 + crow(i, hh) - q; const int i0 = min(max(rel, -1024), 1024) + 1024; s[i] = s[i] * cs + btab[i0]; }
        }
        csx = 1.0f;
    }
    float mx = s[0];
#pragma unroll
    for (int i = 1; i < 16; ++i) mx = fmaxf(mx, s[i]);
    mx = mx * csx + bc;
    mx = xhalf_max(mx);
    if (__any(mx > m + 8.0f)) {
        const float mnew = fmaxf(m, mx), alpha = __builtin_amdgcn_exp2f(m - mnew);
        m = mnew; lsum *= alpha;
#pragma unroll
        for (int db = 0; db < 4; ++db) O[db] *= alpha;
    }
    c2 = bc - m;
}
#define DF_EXP2(i0) do { s[i0] = __builtin_amdgcn_exp2f(s[i0] * csx + c2); s[(i0) + 1] = __builtin_amdgcn_exp2f(s[(i0) + 1] * csx + c2); rs0 += s[i0]; rs1 += s[(i0) + 1]; } while (0)
#define DF_FENCE __builtin_amdgcn_sched_barrier(0)
DI void diff_flash2(const bf16_t* proj, const bf16_t* vtc, int h, int c, int q0w, LAS unsigned char* lds, const LAS float* btab, f32x16 (&O)[4]) {
    int tid = tidx(); asm volatile("" : "+v"(tid)); const int lane = tid & 63, r = lane & 31, hh = lane >> 5, wave = __builtin_amdgcn_readfirstlane(tid >> 6);
    constexpr int NT = S / 64;
    bf16x8 qf[4];
    { const bf16_t* qp = proj + PIDX(q0w + r, C_CQKV + h * 128 + c * 64 + 8 * hh);
#pragma unroll
      for (int ks = 0; ks < 4; ++ks) qf[ks] = *(const bf16x8*)(qp + 16 * ks); }
#pragma unroll
    for (int db = 0; db < 4; ++db)
#pragma unroll
        for (int i = 0; i < 16; ++i) O[db][i] = 0.f;
    float m = -1e30f, lsum = 0.f;
    const float cs = 0.125f * LOG2E;
    const bf16_t* kg = proj + PIDX(0, C_CQKV + 1024 + h * 128 + c * 64);
    const bf16_t* vg = vtc + (size_t)(h * 128) * S;
    LAS unsigned char* Kb = lds; LAS unsigned char* Vb = lds + 3 * K3BUF;
    __syncthreads();
    dstage_k(kg, Kb, wave, lane); dstage_v(vg, Vb, wave, lane); dstage_k(kg + (size_t)64 * 256, Kb + K3BUF, wave, lane);
    asm volatile("s_waitcnt vmcnt(0)" ::: "memory");
    __syncthreads();
    const int swz = (r >> 1) & 7, rowoff = r * 128;
    int kso[4];
#pragma unroll
    for (int ks = 0; ks < 4; ++ks) kso[ks] = rowoff + (((2 * ks + hh) ^ swz) << 4);
    bf16x8 kf[4], vf[8];
    f32x16 s, sn;
#pragma unroll
    for (int i = 0; i < 16; ++i) s[i] = 0.f;
#pragma unroll
    for (int ks = 0; ks < 4; ++ks) { kf[ks] = *(const LAS bf16x8*)(Kb + kso[ks]); }
#pragma unroll
    for (int ks = 0; ks < 4; ++ks) s = MFMA32(kf[ks], qf[ks], s);
    int kc = 0, kn = K3BUF, kw = 2 * K3BUF;
#pragma unroll 1
    for (int t = 0; t < NT; ++t) {
        if (t + 2 < NT) dstage_k(kg + (size_t)(t + 2) * 64 * 256, Kb + kw, wave, lane);
        if (t + 1 < NT) dstage_v(vg + (t + 1) * 64, Vb + ((t + 1) & 1) * V3BUF, wave, lane);
        const LAS unsigned char* vb_ = Vb + (t & 1) * V3BUF;
#pragma unroll
        for (int half = 0; half < 2; ++half) {
#pragma unroll
            for (int ss = 0; ss < 2; ++ss) { const int vs = rowoff + (((4 * half + 2 * ss + hh) ^ swz) << 4);
#pragma unroll
                for (int db = 0; db < 4; ++db) vf[ss * 4 + db] = *(const LAS bf16x8*)(vb_ + vs + (32 * db) * 128); }
            const bool have_next = (half == 0) || (t + 1 < NT);
            { const LAS unsigned char* kbase = (half == 0) ? (Kb + kc + 32 * 128) : (Kb + kn);
              if (have_next) {
#pragma unroll
                  for (int ks = 0; ks < 4; ++ks) kf[ks] = *(const LAS bf16x8*)(kbase + kso[ks]); } }
            float csx, c2;
            sm_max_phase(s, btab, t * 64 + 32 * half, q0w, r, hh, cs, m, lsum, O, csx, c2);
            float rs0 = 0.f, rs1 = 0.f;
#pragma unroll
            for (int i = 0; i < 16; ++i) sn[i] = 0.f;
            DF_FENCE;
            sn = MFMA32(kf[0], qf[0], sn); DF_EXP2(0); DF_FENCE;
            sn = MFMA32(kf[1], qf[1], sn); DF_EXP2(2); DF_FENCE;
            sn = MFMA32(kf[2], qf[2], sn); DF_EXP2(4); DF_FENCE;
            sn = MFMA32(kf[3], qf[3], sn); DF_EXP2(6); DF_FENCE;
            const bf16x8 pf0 = pack8(s, 0);
            O[0] = MFMA32(vf[0], pf0, O[0]); DF_EXP2(8); DF_FENCE;
            O[1] = MFMA32(vf[1], pf0, O[1]); DF_EXP2(10); DF_FENCE;
            O[2] = MFMA32(vf[2], pf0, O[2]); DF_EXP2(12); DF_FENCE;
            O[3] = MFMA32(vf[3], pf0, O[3]); DF_EXP2(14); DF_FENCE;
            const bf16x8 pf1 = pack8(s, 1);
            O[0] = MFMA32(vf[4], pf1, O[0]); O[1] = MFMA32(vf[5], pf1, O[1]); O[2] = MFMA32(vf[6], pf1, O[2]); O[3] = MFMA32(vf[7], pf1, O[3]);
            lsum += rs0 + rs1;
            s = sn;
        }
        asm volatile("s_waitcnt vmcnt(0)" ::: "memory");
        __syncthreads();
        const int tmp = kc; kc = kn; kn = kw; kw = tmp;
    }
    const float lt = lsum + __shfl_xor(lsum, 32), inv = 1.0f / lt;
#pragma unroll
    for (int db = 0; db < 4; ++db) O[db] *= inv;
}
#undef DF_EXP2
#undef DF_FENCE
DI void diffattn_item(const Params& p, int l, int item, LAS unsigned char* lds) {
    int tid = tidx(); asm volatile("" : "+v"(tid)); const int wave = __builtin_amdgcn_readfirstlane(tid >> 6), lane = tid & 63, r = lane & 31, hh = lane >> 5;
    const int qt = item >> 3, h = item & 7, q0w = qt * 256 + wave * 32;
    LAS float* btab = (LAS float*)(lds + LDS_MAIN);
    const float* bias = (const float*)(p.ws + WS_BIAS) + (24 + h) * 2049;
    for (int i = tid; i < 2049; i += NTHR) btab[i] = bias[i];
    const float* dl = p.in[I_DLAM] + l * 256;
    float d01 = 0.f, d23 = 0.f;
    for (int i = 0; i < 64; ++i) { d01 += dl[i] * dl[64 + i]; d23 += dl[128 + i] * dl[192 + i]; }
    const float lam_init = 0.8f - 0.6f * expf(-0.3f * (float)l);
    const float lam = expf(d01) - expf(d23) + lam_init;
    const bf16_t* proj = (const bf16_t*)(p.ws + WS_PROJ); const bf16_t* vtc = (const bf16_t*)(p.ws + WS_VTC);
    f32x16 O0[4];
    const int q = q0w + r;
    float* ctmp = (float*)(p.ws + WS_CTMP) + (size_t)q * 1024 + h * 128 + 4 * hh;
    diff_flash2(proj, vtc, h, 0, q0w, lds, btab, O0);
#pragma unroll
    for (int db = 0; db < 4; ++db)
#pragma unroll
        for (int i4 = 0; i4 < 4; ++i4) { f32x4 o = {O0[db][4 * i4], O0[db][4 * i4 + 1], O0[db][4 * i4 + 2], O0[db][4 * i4 + 3]}; *(f32x4*)(ctmp + 32 * db + 8 * i4) = o; }
    diff_flash2(proj, vtc, h, 1, q0w, lds, btab, O0);
    float ss = 0.f;
#pragma unroll
    for (int db = 0; db < 4; ++db)
#pragma unroll
        for (int i4 = 0; i4 < 4; ++i4) { const f32x4 o0 = *(const f32x4*)(ctmp + 32 * db + 8 * i4);
#pragma unroll
            for (int e = 0; e < 4; ++e) { const float o = o0[e] - lam * O0[db][4 * i4 + e]; O0[db][4 * i4 + e] = o; ss += o * o; } }
    ss += __shfl_xor(ss, 32);
    const float rn = rsqrtf(ss * (1.0f / 128.0f) + 1e-6f) * (1.0f - lam_init);
    const float* dg = p.in[I_DG] + l * 128;
    bf16_t* cout = (bf16_t*)(p.ws + WS_BR) + (size_t)2 * S * 1024;
#pragma unroll
    for (int db = 0; db < 4; ++db)
#pragma unroll
        for (int i4 = 0; i4 < 4; ++i4) {
            const int d0 = 32 * db + 8 * i4 + 4 * hh;
            const f32x4 g4 = *(const f32x4*)(dg + d0);
            const u32x2 gt = *(const u32x2*)(proj + PIDX(q, C_CGATE + h * 128 + d0));
            const float y0 = O0[db][4 * i4 + 0] * rn * g4[0] * silu_f(bflo(gt[0])), y1 = O0[db][4 * i4 + 1] * rn * g4[1] * silu_f(bfhi(gt[0]));
            const float y2 = O0[db][4 * i4 + 2] * rn * g4[2] * silu_f(bflo(gt[1])), y3 = O0[db][4 * i4 + 3] * rn * g4[3] * silu_f(bfhi(gt[1]));
            u32x2 o = {pk2(y0, y1), pk2(y2, y3)};
            *(u32x2*)(cout + (size_t)q * 1024 + h * 128 + d0) = o;
        }
    __syncthreads();
}

DI void mixA_wave_item(const Params& p, int wi, int lane, const LAS float* tb) {
    asm volatile("" : "+v"(lane));
    const int g = wi >> 11, rem = wi & 2047, h = rem >> 8, qb = rem & 255;
    const int sh = 2 * g, n = S >> sh, nbq = 256 >> sh, res = qb / nbq, m0 = (qb % nbq) * 32;
    const int r = lane & 31, hh = lane >> 5;
    const bf16_t* proj = (const bf16_t*)(p.ws + WS_PROJ);
    const int qpos = ((m0 + r) << sh) + res;
    bf16x8 qf[8];
    { const bf16_t* qp = proj + PIDX(qpos, g * 3072 + h * 128 + 8 * hh);
#pragma unroll
      for (int ks = 0; ks < 8; ++ks) qf[ks] = *(const bf16x8*)(qp + 16 * ks); }
    f32x16 O[4];
#pragma unroll
    for (int db = 0; db < 4; ++db)
#pragma unroll
        for (int i = 0; i < 16; ++i) O[db][i] = 0.f;
    float m = -1e30f, lsum = 0.f;
    const float cs = 0.08838834764831845f * LOG2E;
    const LAS float* tbl = tb + 31 - r + 4 * hh;
    const bf16_t* vt = (const bf16_t*)(p.ws + WS_VTA) + (size_t)((g * 8 + h) * 128) * S + res * n;
    bf16x8 kf[8];
    { const int mk0r = m0 - 64; const int mk0 = (mk0r >= 0 && mk0r < n) ? mk0r : m0;
      const bf16_t* kp = proj + PIDX(((mk0 + r) << sh) + res, g * 3072 + 1024 + h * 128 + 8 * hh);
#pragma unroll
      for (int ks = 0; ks < 8; ++ks) kf[ks] = *(const bf16x8*)(kp + 16 * ks); }
#pragma unroll 1
    for (int kb = 0; kb < 5; ++kb) {
        const int mk0r = m0 - 64 + 32 * kb;
        const bool blk_ok = (mk0r >= 0) && (mk0r < n);
        const int mk0 = blk_ok ? mk0r : m0;
        bf16x8 vfr[2][4];
#pragma unroll
        for (int sidx = 0; sidx < 2; ++sidx)
#pragma unroll
            for (int db = 0; db < 4; ++db) {
                const bf16_t* vp = vt + (size_t)(32 * db + r) * S + mk0 + 16 * sidx + 4 * hh;
                const s16x4 lo = *(const s16x4*)vp, hi = *(const s16x4*)(vp + 8);
                vfr[sidx][db] = __builtin_shufflevector(lo, hi, 0, 1, 2, 3, 4, 5, 6, 7);
            }
        __builtin_amdgcn_sched_barrier(0);
        f32x16 s;
#pragma unroll
        for (int i = 0; i < 16; ++i) s[i] = 0.f;
#pragma unroll
        for (int ks = 0; ks < 8; ++ks) s = MFMA32(kf[ks], qf[ks], s);
        if (kb < 4) {
            const int nk0r = m0 - 64 + 32 * (kb + 1); const int nk0 = (nk0r >= 0 && nk0r < n) ? nk0r : m0;
            const bf16_t* kp = proj + PIDX(((nk0 + r) << sh) + res, g * 3072 + 1024 + h * 128 + 8 * hh);
#pragma unroll
            for (int ks = 0; ks < 8; ++ks) kf[ks] = *(const bf16x8*)(kp + 16 * ks);
        }
        __builtin_amdgcn_sched_barrier(0);
        float mx = -INFINITY;
#pragma unroll
        for (int i = 0; i < 16; ++i) { const int rel = mk0r + crow(i, hh) - (m0 + r); const bool valid = blk_ok && (rel <= 64) && (rel >= -64);
            const float bv = tbl[32 * kb + (i & 3) + 8 * (i >> 2)];
            const float v = valid ? (s[i] * cs + bv) : -INFINITY; s[i] = v; mx = fmaxf(mx, v); }
        mx = xhalf_max(mx);
        const float mnew = fmaxf(m, mx), alpha = __builtin_amdgcn_exp2f(m - mnew);
        m = mnew;
        float rs = 0.f;
#pragma unroll
        for (int i = 0; i < 16; ++i) { s[i] = __builtin_amdgcn_exp2f(s[i] - mnew); rs += s[i]; }
        lsum = lsum * alpha + rs;
#pragma unroll
        for (int db = 0; db < 4; ++db) O[db] *= alpha;
#pragma unroll
        for (int sidx = 0; sidx < 2; ++sidx) {
            const bf16x8 pf = pack8(s, sidx);
#pragma unroll
            for (int db = 0; db < 4; ++db) O[db] = MFMA32(vfr[sidx][db], pf, O[db]);
        }
    }
    const float lt = lsum + __shfl_xor(lsum, 32), inv = 1.0f / lt;
    float* oa = (float*)(p.ws + WS_OA) + ((size_t)g * S + qpos) * 1024 + h * 128;
#pragma unroll
    for (int db = 0; db < 4; ++db)
#pragma unroll
        for (int i4 = 0; i4 < 4; ++i4) {
            const int d0 = 32 * db + 8 * i4 + 4 * hh;
            f32x4 o = {O[db][4 * i4] * inv, O[db][4 * i4 + 1] * inv, O[db][4 * i4 + 2] * inv, O[db][4 * i4 + 3] * inv};
            *(f32x4*)(oa + d0) = o;
        }
    if (hh == 0) ((float*)(p.ws + WS_LSEA))[((size_t)g * S + qpos) * 8 + h] = m + __log2f(lt);
}

DI void phase_post(const Params& p, LAS unsigned char* lds) {
    const int tid = tidx();
    const bf16_t* proj = (const bf16_t*)(p.ws + WS_PROJ);
    bf16_t* aout = (bf16_t*)(p.ws + WS_BR); bf16_t* bout = aout + (size_t)S * 1024;
    const float* oa = (const float*)(p.ws + WS_OA); const float* lse = (const float*)(p.ws + WS_LSEA);
    for (int idx0 = blockIdx.x * NTHR + tid; idx0 < S * 256; idx0 += 4 * gridDim.x * NTHR) {
        float l0[4], l1[4], l2[4]; f32x4 o0[4], o1[4], o2[4]; u32x2 gt[4];
#pragma unroll
        for (int u = 0; u < 4; ++u) { const int idx = idx0 + u * gridDim.x * NTHR; const int pos = idx >> 8, c4 = idx & 255, h = c4 >> 5, col = c4 * 4;
            l0[u] = lse[((size_t)0 * S + pos) * 8 + h]; l1[u] = lse[((size_t)1 * S + pos) * 8 + h]; l2[u] = lse[((size_t)2 * S + pos) * 8 + h];
            o0[u] = *(const f32x4*)(oa + ((size_t)0 * S + pos) * 1024 + col); o1[u] = *(const f32x4*)(oa + ((size_t)1 * S + pos) * 1024 + col); o2[u] = *(const f32x4*)(oa + ((size_t)2 * S + pos) * 1024 + col);
            gt[u] = *(const u32x2*)(proj + PIDX(pos, C_AGATE + col)); }
#pragma unroll
        for (int u = 0; u < 4; ++u) { const int idx = idx0 + u * gridDim.x * NTHR; const int pos = idx >> 8, c4 = idx & 255, col = c4 * 4;
            const float mx = fmaxf(l0[u], fmaxf(l1[u], l2[u]));
            const float w0 = __builtin_amdgcn_exp2f(l0[u] - mx), w1 = __builtin_amdgcn_exp2f(l1[u] - mx), w2 = __builtin_amdgcn_exp2f(l2[u] - mx);
            const float inv = __builtin_amdgcn_rcpf(w0 + w1 + w2);
            const f32x4 o = (o0[u] * w0 + o1[u] * w1 + o2[u] * w2) * inv;
            u32x2 ov = {pk2(o[0] * silu_f(bflo(gt[u][0])), o[1] * silu_f(bfhi(gt[u][0]))), pk2(o[2] * silu_f(bflo(gt[u][1])), o[3] * silu_f(bfhi(gt[u][1])))};
            *(u32x2*)(aout + (size_t)pos * 1024 + col) = ov; }
    }
    LAS float* tile = (LAS float*)lds;
    const float* z2t = (const float*)(p.ws + WS_Z2T);
    for (int it0 = blockIdx.x * 4; it0 < 128 * 16; it0 += gridDim.x * 4) {
        __syncthreads();
        f32x4 v[4][2];
#pragma unroll
        for (int u = 0; u < 4; ++u) { const int it = it0 + u, t0 = (it >> 4) * 64, c0 = (it & 15) * 64;
#pragma unroll
            for (int k = 0; k < 2; ++k) { const int e = tid + NTHR * k; const int ci = e >> 4, t4 = (e & 15) * 4; v[u][k] = *(const f32x4*)(z2t + (size_t)(c0 + ci) * S + t0 + t4); } }
#pragma unroll
        for (int u = 0; u < 4; ++u)
#pragma unroll
            for (int k = 0; k < 2; ++k) { const int e = tid + NTHR * k; const int ci = e >> 4, t4 = (e & 15) * 4; LAS float* d = tile + u * 4160 + ci * 65 + t4;
                d[0] = v[u][k][0]; d[1] = v[u][k][1]; d[2] = v[u][k][2]; d[3] = v[u][k][3]; }
        __syncthreads();
        u32x2 gt[4][2];
#pragma unroll
        for (int u = 0; u < 4; ++u) { const int it = it0 + u, t0 = (it >> 4) * 64, c0 = (it & 15) * 64;
#pragma unroll
            for (int k = 0; k < 2; ++k) { const int e = tid + NTHR * k; const int ti = e >> 4, cc = (e & 15) * 4; gt[u][k] = *(const u32x2*)(proj + PIDX(t0 + ti, C_BGATE + c0 + cc)); } }
#pragma unroll
        for (int u = 0; u < 4; ++u) { const int it = it0 + u, t0 = (it >> 4) * 64, c0 = (it & 15) * 64;
#pragma unroll
            for (int k = 0; k < 2; ++k) { const int e = tid + NTHR * k; const int ti = e >> 4, cc = (e & 15) * 4; const LAS float* sp = tile + u * 4160 + cc * 65 + ti;
                const float y0 = sp[0] * silu_f(bflo(gt[u][k][0])), y1 = sp[65] * silu_f(bfhi(gt[u][k][0]));
                const float y2 = sp[130] * silu_f(bflo(gt[u][k][1])), y3 = sp[195] * silu_f(bfhi(gt[u][k][1]));
                u32x2 ov = {pk2(y0, y1), pk2(y2, y3)};
                *(u32x2*)(bout + (size_t)(t0 + ti) * 1024 + c0 + cc) = ov; } }
    }
    __syncthreads();
}

#ifndef REP_GEMMIN
#define REP_GEMMIN 1
#endif
#ifndef REP_DIFF
#define REP_DIFF 1
#endif
#ifndef REP_HYENA
#define REP_HYENA 1
#endif
#ifndef REP_MIXA
#define REP_MIXA 1
#endif
#ifndef REP_PRO
#define REP_PRO 1
#endif
#ifndef REP_SPEC
#define REP_SPEC 1
#endif
#ifndef REP_MISC
#define REP_MISC 1
#endif
#ifndef REP_PROJ
#define REP_PROJ 1
#endif
constexpr int NPH = 3 + 6 * DEPTH + 1;
typedef const Params __attribute__((address_space(4)))* ParamsK;
DI Params ldp(ParamsK pc) {
    asm volatile("" : "+s"(pc));
    Params q;
#pragma unroll
    for (int i = 0; i < 18; ++i) q.in[i] = pc->in[i];
    q.out = pc->out; q.ws = pc->ws; q.ph_lo = pc->ph_lo; q.ph_hi = pc->ph_hi;
    return q;
}
DI void run_phase(ParamsK pc, int ph, LAS unsigned char* lds) {
    if (ph == 0) { for (int rep = 0; rep < REP_PRO; ++rep) { const Params p = ldp(pc); phase_prologue(p, lds); __syncthreads(); } return; }
    if (ph == 1) {
        const Params p = ldp(pc);
        const bool conv_first = (__builtin_amdgcn_readfirstlane(tidx() >> 6) & 1) != 0;
        if (conv_first) { phase_convert(p, lds); phase_tgen(p); } else { phase_tgen(p); phase_convert(p, lds); }
        return;
    }
    if (ph == 2) { for (int rep = 0; rep < REP_SPEC; ++rep) { const Params p = ldp(pc); for (int it = blockIdx.x; it < DEPTH * 2 * 256; it += gridDim.x) spectra_item(p, it, lds); } return; }
    if (ph == NPH - 1) { const Params p = ldp(pc); phase_rmsnorm((const float*)(p.ws + WS_X), p.in[I_FINALG], nullptr, p.out); return; }
    const int l = (ph - 3) / 6, sp = (ph - 3) % 6;
    if (sp == 0) { for (int rep = 0; rep < REP_MISC; ++rep) { const Params p = ldp(pc); phase_rmsnorm((l == 0) ? p.in[I_X] : (const float*)(p.ws + WS_X), p.in[I_NORMG] + l * D, (bf16_t*)(p.ws + WS_H), nullptr); } return; }
    if (sp == 1) {
        const Params p = ldp(pc);
        pg8::Gemm g{(const bf16_t*)(p.ws + WS_H), (const bf16_t*)(p.ws + WS_WIN) + (size_t)l * NIN * D, S, NIN, D};
        pg8::StaticOrder so; so.init(S, NIN, gridDim.x, blockIdx.x);
        EpiIn e{(bf16_t*)(p.ws + WS_PROJ), (bf16_t*)(p.ws + WS_VTA), (bf16_t*)(p.ws + WS_VTC), (float*)(p.ws + WS_BINT), lds + 131072};
#pragma unroll 1
        for (int rep = 0; rep < REP_GEMMIN; ++rep) { pg8::gemm_phase(lds, g, so, e); __syncthreads(); }
        return;
    }
    if (sp == 2) {
#pragma unroll 1
        for (int it = blockIdx.x; it < 256 + 256 + 768; it += gridDim.x) {
            int l2 = l; asm volatile("" : "+s"(l2));
            const Params p = ldp(pc);
            if (it < 256) { for (int rep = 0; rep < REP_DIFF; ++rep) diffattn_item(p, l2, it, lds); }
            else if (it < 512) { for (int rep = 0; rep < REP_HYENA; ++rep) hyena_item(p, l2, it - 256, lds); }
            else {
                const int tid2 = tidx(), wi0 = (it - 512) * NWAVES, g = wi0 >> 11, h = (wi0 & 2047) >> 8;
                LAS float* tb = (LAS float*)lds;
                __syncthreads();
                if (tid2 < 192) { const int rel = tid2 - 95; float v = 0.f;
                    if (rel >= -64 && rel <= 64) v = ((const float*)(p.ws + WS_BIAS))[(g * 8 + h) * 2049 + min(max(rel << (2 * g), -1024), 1024) + 1024];
                    tb[tid2] = v; }
                __syncthreads();
                for (int rep = 0; rep < REP_MIXA; ++rep) mixA_wave_item(p, wi0 + (tid2 >> 6), tid2 & 63, tb);
            }
        }
        return;
    }
    if (sp == 3) { for (int rep = 0; rep < REP_MISC; ++rep) { const Params p = ldp(pc); phase_post(p, lds); } return; }
    if (sp == 4) {
#pragma unroll 1
        for (int rep = 0; rep < REP_PROJ; ++rep) {
            const Params p = ldp(pc);
            pg8::Gemm g{(const bf16_t*)(p.ws + WS_BR), (const bf16_t*)(p.ws + WS_WPR) + (size_t)(l * 3) * D * 1024, 3 * S, 3 * D, 1024};
            ProjOrder po; po.so.init(S, D, gridDim.x, blockIdx.x);
            EpiProj e{(const bf16_t*)(p.ws + WS_PROJ), p.in[I_MERGEB] + (size_t)l * 3 * D, (bf16_t*)(p.ws + WS_YB)};
            pg8::gemm_phase(lds, g, po, e);
            __syncthreads();
        }
        return;
    }
    {
        const Params p = ldp(pc);
        pg8::Gemm g{(const bf16_t*)(p.ws + WS_YB), (const bf16_t*)(p.ws + WS_WOUT) + (size_t)l * D * D, S, D, D};
        pg8::StaticOrder so; so.init(S, D, gridDim.x, blockIdx.x);
        EpiOut e{(l == 0) ? p.in[I_X] : (const float*)(p.ws + WS_X), (float*)(p.ws + WS_X)};
#pragma unroll 1
        for (int rep = 0; rep < ((l == 0) ? REP_MISC : 1); ++rep) { pg8::gemm_phase(lds, g, so, e); __syncthreads(); }
    }
}


#define XB_TMO      128
#define XB_XCNT(j)  (256  + 64 * (j))
#define XB_XSUB(j)  (1280 + 64 * (j))
#define XB_XGEN(j)  (2304 + 64 * (j))
#define XB_TOP      3328
#define XB_TOPGEN   3392
#define XCD_BAR_WORDS 3456
#define XB_SPIN_CAP (1u << 18)
DI unsigned xb_ld(unsigned* p)              { return __hip_atomic_load(p, __ATOMIC_RELAXED, __HIP_MEMORY_SCOPE_AGENT); }
DI unsigned xb_add(unsigned* p, unsigned v) { return __hip_atomic_fetch_add(p, v, __ATOMIC_RELAXED, __HIP_MEMORY_SCOPE_AGENT); }
DI unsigned xb_xcc_id() { return (unsigned)__builtin_amdgcn_s_getreg((3 << 11) | 20) & 0xFu; }
#define XB_SPIN(cond, bar) do { unsigned _sp = 0; while (cond) { __builtin_amdgcn_s_sleep(1); \
    if ((++_sp & 255u) == 0u) { if (xb_ld(&(bar)[XB_TMO])) break; if (_sp > XB_SPIN_CAP) { atomicAdd(&(bar)[XB_TMO], 1u); break; } } } } while (0)
struct XcdBarrier { unsigned* bar; unsigned x; volatile LAS unsigned* st; };
DI XcdBarrier xcd_barrier_post(unsigned* bar, volatile LAS unsigned* st) {
    XcdBarrier b; b.bar = bar; b.x = xb_xcc_id(); b.st = st;
    if (threadIdx.x == 0) (void)xb_add(&bar[XB_XCNT(b.x)], 1u);
    return b;
}
DI void xcd_barrier_complete(unsigned* bar, unsigned x, unsigned& nloc, unsigned& nx) {
    const unsigned G = gridDim.x * gridDim.y * gridDim.z;
    unsigned sum, cnt, mine, sp = 0u;
    for (;;) {
        sum = 0u; cnt = 0u; mine = 0u;
#pragma unroll
        for (unsigned j = 0; j < 16; ++j) { const unsigned c = xb_ld(&bar[XB_XCNT(j)]); sum += c; cnt += (c > 0u) ? 1u : 0u; mine = (j == x) ? c : mine; }
        if (sum == G) break;
        __builtin_amdgcn_s_sleep(1);
        if ((++sp & 255u) == 0u) { if (xb_ld(&bar[XB_TMO])) break; if (sp > XB_SPIN_CAP) { atomicAdd(&bar[XB_TMO], 1u); break; } }
    }
    nloc = mine > 0u ? mine : 1u; nx = cnt > 0u ? cnt : 1u;
}
DI void xcd_barrier(const XcdBarrier& b) {
    asm volatile("s_waitcnt vmcnt(0)" ::: "memory");
    __syncthreads();
    if (threadIdx.x == 0) {
        unsigned* bar = b.bar;
        __builtin_amdgcn_s_waitcnt(0);
        unsigned nloc = b.st[0], nx = b.st[1];
        if (nloc == 0u) { xcd_barrier_complete(bar, b.x, nloc, nx); b.st[0] = nloc; b.st[1] = nx; }
        const unsigned old = xb_add(&bar[XB_XSUB(b.x)], 1u);
        const unsigned gen = old / nloc;
        if (old + 1u == (gen + 1u) * nloc) {
            __builtin_amdgcn_fence(__ATOMIC_RELEASE, "agent");
            asm volatile("s_waitcnt vmcnt(0)" ::: "memory");
            const unsigned og = xb_add(&bar[XB_TOP], 1u);
            const unsigned tg = og / nx;
            if (og + 1u == (tg + 1u) * nx) xb_add(&bar[XB_TOPGEN], 1u);
            else XB_SPIN(xb_ld(&bar[XB_TOPGEN]) == tg, bar);
            __builtin_amdgcn_fence(__ATOMIC_ACQUIRE, "agent");
            xb_add(&bar[XB_XGEN(b.x)], 1u);
            asm volatile("s_waitcnt vmcnt(0)" ::: "memory");
        } else {
            XB_SPIN(xb_ld(&bar[XB_XGEN(b.x)]) == gen, bar);
            __builtin_amdgcn_fence(__ATOMIC_ACQUIRE, "agent");
            asm volatile("s_waitcnt vmcnt(0)" ::: "memory");
        }
    }
    __syncthreads();
}

__global__ void __launch_bounds__(512, 2) mega_kernel(Params p) {
#if defined(__HIP_DEVICE_COMPILE__)
    extern __shared__ __attribute__((aligned(16))) unsigned char shm[];
    LAS unsigned char* lds = (LAS unsigned char*)shm;
    cg::grid_group grid = cg::this_grid();
    const int ph_lo = p.ph_lo, ph_hi = p.ph_hi;
    volatile LAS unsigned* st = (volatile LAS unsigned*)(lds + LDS_BYTES - 16);
    if (threadIdx.x == 0) { st[0] = 0u; st[1] = 0u; }
    __syncthreads();
    const XcdBarrier xb = xcd_barrier_post((unsigned*)(p.ws + WS_BAR), st);
#pragma unroll 1
    for (int ph = ph_lo; ph < ph_hi; ++ph) {
        ParamsK pc = (ParamsK)__builtin_amdgcn_kernarg_segment_ptr();
        run_phase(pc, ph, lds);
        if (ph + 1 < ph_hi) { if (ph == ph_lo) grid.sync(); else xcd_barrier(xb); }
    }
#endif
}

#ifndef N_LAUNCH_MODE
#define N_LAUNCH_MODE 1
#endif
extern "C" void kernel_launch(void* const* d_in, const int* in_sizes, int n_in, void* d_out, int out_size, void* d_ws, size_t ws_size, hipStream_t stream) {
    static int grid = 0;
    if (grid == 0) {
        int dev = 0, cus = 0;
        if (hipGetDevice(&dev) != hipSuccess || hipDeviceGetAttribute(&cus, hipDeviceAttributeMultiprocessorCount, dev) != hipSuccess) { fprintf(stderr, "kernel_launch: device query failed\n"); grid = -1; return; }
        if (hipFuncSetAttribute((const void*)mega_kernel, hipFuncAttributeMaxDynamicSharedMemorySize, LDS_BYTES) != hipSuccess) { fprintf(stderr, "kernel_launch: hipFuncSetAttribute failed\n"); grid = -1; return; }
        int per_cu = 0;
        if (hipOccupancyMaxActiveBlocksPerMultiprocessor(&per_cu, (const void*)mega_kernel, NTHR, LDS_BYTES) != hipSuccess || per_cu < 1) { fprintf(stderr, "kernel_launch: occupancy query says %d\n", per_cu); (void)hipGetLastError(); }
        if (n_in != 18 || ws_size < WS_END) { fprintf(stderr, "kernel_launch: n_in %d ws %zu (need %zu)\n", n_in, ws_size, (size_t)WS_END); grid = -1; return; }
        grid = cus;
    }
    if (grid < 0) return;
    Params p{};
    for (int i = 0; i < 18; ++i) p.in[i] = (const float*)d_in[i];
    p.out = (float*)d_out; p.ws = (unsigned char*)d_ws;
    if (hipMemsetAsync((unsigned char*)d_ws + WS_BAR, 0, 16384, stream) != hipSuccess) { fprintf(stderr, "kernel_launch: memset of barrier words failed\n"); return; }
#if N_LAUNCH_MODE == 1
    p.ph_lo = 0; p.ph_hi = NPH;
    void* args[] = {&p};
    hipError_t e = hipLaunchCooperativeKernel((const void*)mega_kernel, dim3(grid), dim3(NTHR), args, LDS_BYTES, stream);
    if (e != hipSuccess) fprintf(stderr, "cooperative launch failed: %s (grid %d)\n", hipGetErrorString(e), grid);
#else
    for (int ph = 0; ph < NPH; ++ph) {
        p.ph_lo = ph; p.ph_hi = ph + 1;
        hipLaunchKernelGGL(mega_kernel, dim3(grid), dim3(NTHR), LDS_BYTES, stream, p);
    }
#endif
}
```

```cpp
#include <hip/hip_runtime.h>
#include <hip/hip_cooperative_groups.h>
#include <cstdio>
namespace cg = cooperative_groups;
#define DI __device__ __forceinline__
#define LAS __attribute__((address_space(3)))
typedef unsigned short bf16_t;
typedef short bf16x8 __attribute__((ext_vector_type(8)));
typedef short s16x4 __attribute__((ext_vector_type(4)));
typedef float f32x4 __attribute__((ext_vector_type(4)));
typedef float f32x16 __attribute__((ext_vector_type(16)));
typedef float f32x2 __attribute__((ext_vector_type(2)));
typedef float cf __attribute__((ext_vector_type(2)));
typedef __bf16 bf16x2n __attribute__((ext_vector_type(2)));
typedef unsigned u32x2 __attribute__((ext_vector_type(2)));
typedef unsigned u32x4 __attribute__((ext_vector_type(4)));

DI unsigned pk2(float lo, float hi) { f32x2 v = {lo, hi}; return __builtin_bit_cast(unsigned, __builtin_convertvector(v, bf16x2n)); }
DI float bflo(unsigned u) { return __uint_as_float(u << 16); }
DI float bfhi(unsigned u) { return __uint_as_float(u & 0xffff0000u); }
DI float silu_f(float x) { return x * __builtin_amdgcn_rcpf(1.0f + __expf(-x)); }
DI float sigm_f(float x) { return __builtin_amdgcn_rcpf(1.0f + __expf(-x)); }

DI int tidx() { int t = threadIdx.x; asm volatile("" : "+v"(t)); return t; }

constexpr int S = 8192, D = 2048, NIN = 24576, DEPTH = 4;
constexpr int C_AGATE = 9216, C_BIN = 10240, C_BGATE = 13312, C_CQKV = 14336, C_CGATE = 17408, C_MERGE = 18432;
constexpr float LOG2E = 1.4426950408889634f;
constexpr int NTHR = 512, NWAVES = 8;
constexpr int LDS_MAIN = 143360, LDS_AUX = 16384, LDS_BYTES = LDS_MAIN + LDS_AUX;

constexpr size_t WS_WIN  = 0;
constexpr size_t WS_WPR  = WS_WIN  + (size_t)DEPTH * NIN * D * 2;
constexpr size_t WS_WOUT = WS_WPR  + (size_t)DEPTH * 3 * D * 1024 * 2;
constexpr size_t WS_SPEC = WS_WOUT + (size_t)DEPTH * D * D * 2;
constexpr size_t WS_HID2 = WS_SPEC + (size_t)DEPTH * 2 * 512 * 8208 * 16;
constexpr size_t WS_BIAS = WS_HID2 + (size_t)DEPTH * S * 64 * 4;
constexpr size_t WS_X    = WS_BIAS + 524288;
constexpr size_t WS_H    = WS_X    + (size_t)S * D * 4;
constexpr size_t WS_PROJ = WS_H    + (size_t)S * D * 2;
constexpr size_t WS_BINT = WS_PROJ + (size_t)S * NIN * 2;
constexpr size_t WS_VTA  = WS_BINT + (size_t)3072 * S * 4;
constexpr size_t WS_VTC  = WS_VTA  + (size_t)3 * 1024 * S * 2;
constexpr size_t WS_OA   = WS_VTC  + (size_t)1024 * S * 2;
constexpr size_t WS_LSEA = WS_OA   + (size_t)3 * S * 1024 * 4;
constexpr size_t WS_Z2T  = WS_LSEA + (size_t)3 * S * 8 * 4;
constexpr size_t WS_BR   = WS_Z2T  + (size_t)1024 * S * 4;
constexpr size_t WS_YF   = WS_BR   + (size_t)3 * S * 1024 * 2;
constexpr size_t WS_YB   = WS_YF   + (size_t)S * D * 4;
constexpr size_t WS_CTMP = WS_YB   + (size_t)S * D * 2;
constexpr size_t WS_BAR  = WS_CTMP + (size_t)S * 1024 * 4;
constexpr size_t WS_TT   = WS_BAR + 16384;
constexpr size_t WS_END  = WS_TT + (size_t)DEPTH * 4096 * S * 4;

DI size_t PIDX(int row, int col) { return ((size_t)(col >> 8) * S + row) * 256 + (col & 255); }

struct Params {
    const float* in[18];
    float* out;
    unsigned char* ws;
    int ph_lo, ph_hi;
};
enum { I_X = 0, I_NORMG, I_FINALG, I_WIN, I_MERGEB, I_RELB, I_HYCONV, I_HYW1, I_HYB1, I_HYFREQ, I_HYW2, I_HYB2, I_HYW3, I_HYSKIP, I_DLAM, I_DG, I_WPROJ, I_WOUT };

namespace pg8 {
constexpr int BM = 256, BK = 64, HALF = 128, HTB = HALF * BK * 2, NXCD = 8, WGM = 4;
DI int lds_byte(int r, int c) { const int st = (r >> 4) * 2 + (c >> 5), rr = r & 15, cc = c & 31, ob = rr * 64 + cc * 2; return st * 1024 + (ob ^ (((ob >> 9) & 1) << 5)); }
DI void stage_rc(int b, int& R, int& C) { const int st = b / 1024, sb = b % 1024, swz = sb ^ (((sb >> 9) & 1) << 5); R = (st >> 1) * 16 + swz / 64; C = (st & 1) * 32 + (swz % 64) / 2; }
DI int perm32(int rho) { const int n = rho >> 4, i = rho & 15; return 8 * (i >> 2) + 4 * n + (i & 3); }
struct Unit { int pm, pn; };
struct Gemm { const bf16_t* A; const bf16_t* Bt; int M, N, K; };
struct StaticOrder {
    int nM, nN, nwg, G, c;
    DI void init(int M, int N, int G_, int c_) { nM = M / BM; nN = N / BM; nwg = nM * nN; G = G_; c = c_; }
    DI bool next(int i, Unit& u) const {
        const long L = (long)i * G + c; if (L >= nwg) return false;
        int wgid = (int)L; { const int q = nwg / NXCD, r = nwg % NXCD, xcd = wgid % NXCD, off = wgid / NXCD; wgid = (xcd < r ? xcd * (q + 1) : r * (q + 1) + (xcd - r) * q) + off; }
        const int nig = WGM * nN, gid = wgid / nig, fm = gid * WGM, gsz = (nM - fm) < WGM ? (nM - fm) : WGM;
        u.pm = fm + ((wgid % nig) % gsz); u.pn = (wgid % nig) / gsz; return true;
    }
};
template <class Epi, class Sched>
DI void gemm_phase(LAS unsigned char* lds, const Gemm g, const Sched& S, const Epi& E) {
    const int tid = tidx(), wid = __builtin_amdgcn_readfirstlane(tid >> 6), lane = tid & 63, wr = wid >> 2, wc = wid & 3, fr = lane & 15, fq = lane >> 4;
    const int K = g.K, nt = K / BK;
    unsigned voffA[2], voffB[2];
#pragma unroll
    for (int i = 0; i < 2; ++i) { int R, C; stage_rc(tid * 16 + i * 8192, R, C); const int Rb = Epi::PERM ? ((R & ~31) + perm32(R & 31)) : R; voffA[i] = (unsigned)(R * K + C) * 2u; voffB[i] = (unsigned)(Rb * K + C) * 2u; }
    const size_t kstep = (size_t)(BK * 2);
    const size_t hstep = (size_t)HALF * K * 2;
    const size_t tstep = 2 * hstep;
    const unsigned ldsw = (unsigned)wid * 1024u;
    const int aoff = lds_byte(wr * 64 + fr, fq * 8), boff = lds_byte(wc * 32 + fr, fq * 8);
#define PG8_SA(b, h) (((b) * 2 + (h)) * HTB)
#define PG8_SB(b, h) ((4 + (b) * 2 + (h)) * HTB)
#define PG8_STAGE(bufoff, gbase, voff) do { _Pragma("unroll") for (int _i = 0; _i < 2; ++_i) \
        __builtin_amdgcn_global_load_lds((const unsigned*)((const char*)(gbase) + (voff)[_i]), (LAS unsigned*)(lds + (bufoff) + ldsw + _i * 8192), 16, 0, 0); } while (0)
#define PG8_LDA(dst, b, h) do { _Pragma("unroll") for (int m = 0; m < 4; ++m) _Pragma("unroll") for (int k = 0; k < 2; ++k) dst[m][k] = *(const LAS bf16x8*)(lds + PG8_SA(b, h) + aoff + m * 2048 + k * 1024); } while (0)
#define PG8_LDB(dst, b, h) do { _Pragma("unroll") for (int n = 0; n < 2; ++n) _Pragma("unroll") for (int k = 0; k < 2; ++k) dst[n][k] = *(const LAS bf16x8*)(lds + PG8_SB(b, h) + boff + n * 2048 + k * 1024); } while (0)
#define PG8_MMA(ai, bj, At, Bt) do { __builtin_amdgcn_s_setprio(1); _Pragma("unroll") for (int m = 0; m < 4; ++m) _Pragma("unroll") for (int n = 0; n < 2; ++n) _Pragma("unroll") for (int k = 0; k < 2; ++k) \
        acc[ai][bj][m][n] = __builtin_amdgcn_mfma_f32_16x16x32_bf16(Bt[n][k], At[m][k], acc[ai][bj][m][n], 0, 0, 0); __builtin_amdgcn_s_setprio(0); } while (0)
#define PG8_WAIT_V(n) asm volatile("s_waitcnt vmcnt(" #n ")" ::: "memory")
#define PG8_WAIT_L(n) asm volatile("s_waitcnt lgkmcnt(" #n ")" ::: "memory")
#define PG8_BAR __builtin_amdgcn_s_barrier()
#define PG8_SCHED __builtin_amdgcn_sched_barrier(0)
    Unit cur, nxt; int ui = 0;
    if (!S.next(0, cur)) return;
    f32x4 acc[2][2][4][2];
#pragma unroll
    for (int a = 0; a < 2; ++a)
#pragma unroll
        for (int b = 0; b < 2; ++b)
#pragma unroll
            for (int m = 0; m < 4; ++m)
#pragma unroll
                for (int n = 0; n < 2; ++n) acc[a][b][m][n] = (f32x4){0.f, 0.f, 0.f, 0.f};
    bf16x8 At[4][2], B0[2][2], B1[2][2];
    const char* cA = (const char*)g.A + (size_t)cur.pm * tstep; const char* cB = (const char*)g.Bt + (size_t)cur.pn * tstep;
    PG8_STAGE(PG8_SB(0, 0), cB, voffB); PG8_STAGE(PG8_SA(0, 0), cA, voffA); PG8_STAGE(PG8_SB(0, 1), cB + hstep, voffB); PG8_STAGE(PG8_SA(0, 1), cA + hstep, voffA);
    if (wr == 1) PG8_BAR;
    PG8_WAIT_V(4); PG8_BAR;
    PG8_STAGE(PG8_SB(1, 0), cB + kstep, voffB); PG8_STAGE(PG8_SA(1, 0), cA + kstep, voffA); PG8_STAGE(PG8_SB(1, 1), cB + hstep + kstep, voffB);
    PG8_WAIT_V(6); PG8_BAR;
    for (;;) {
        const bool has_next = S.next(ui + 1, nxt);
        const char* nA = has_next ? (const char*)g.A + (size_t)nxt.pm * tstep : cA; const char* nB = has_next ? (const char*)g.Bt + (size_t)nxt.pn * tstep : cB;
        for (int t = 0; t < nt; t += 2) {
            const bool last = (t == nt - 2);
            const char* a1 = cA + (size_t)(t + 1) * kstep;
            const char* a2 = last ? nA : cA + (size_t)(t + 2) * kstep; const char* b2 = last ? nB : cB + (size_t)(t + 2) * kstep;
            const char* a3 = a2 + kstep; const char* b3 = b2 + kstep;
            PG8_LDB(B0, 0, 0); PG8_SCHED; PG8_LDA(At, 0, 0); PG8_STAGE(PG8_SA(1, 1), a1 + hstep, voffA);
            PG8_WAIT_L(8); PG8_BAR; PG8_WAIT_L(0); PG8_MMA(0, 0, At, B0); PG8_BAR; PG8_SCHED;
            PG8_LDB(B1, 0, 1); PG8_STAGE(PG8_SB(0, 0), b2, voffB);
            PG8_BAR; PG8_WAIT_L(0); PG8_MMA(0, 1, At, B1); PG8_BAR;
            PG8_LDA(At, 0, 1); PG8_STAGE(PG8_SA(0, 0), a2, voffA);
            PG8_BAR; PG8_WAIT_L(0); PG8_MMA(1, 0, At, B0); PG8_BAR; PG8_SCHED;
            PG8_STAGE(PG8_SB(0, 1), b2 + hstep, voffB);
            PG8_WAIT_V(6); PG8_BAR; PG8_MMA(1, 1, At, B1); PG8_BAR;
            PG8_LDB(B0, 1, 0); PG8_SCHED; PG8_LDA(At, 1, 0); PG8_STAGE(PG8_SA(0, 1), a2 + hstep, voffA);
            PG8_WAIT_L(8); PG8_BAR; PG8_WAIT_L(0); PG8_MMA(0, 0, At, B0); PG8_BAR; PG8_SCHED;
            PG8_LDB(B1, 1, 1); PG8_STAGE(PG8_SB(1, 0), b3, voffB);
            PG8_BAR; PG8_WAIT_L(0); PG8_MMA(0, 1, At, B1); PG8_BAR;
            PG8_LDA(At, 1, 1); PG8_STAGE(PG8_SA(1, 0), a3, voffA);
            PG8_BAR; PG8_WAIT_L(0); PG8_MMA(1, 0, At, B0); PG8_BAR; PG8_SCHED;
            PG8_STAGE(PG8_SB(1, 1), b3 + hstep, voffB);
            PG8_WAIT_V(6); PG8_BAR; PG8_MMA(1, 1, At, B1); PG8_BAR;
        }
        const bool keep = E(acc, cur, wr, wc, fr, fq);
        if (!has_next) break;
        if (!keep)
#pragma unroll
        for (int a = 0; a < 2; ++a)
#pragma unroll
            for (int b = 0; b < 2; ++b)
#pragma unroll
                for (int m = 0; m < 4; ++m)
#pragma unroll
                    for (int n = 0; n < 2; ++n) acc[a][b][m][n] = (f32x4){0.f, 0.f, 0.f, 0.f};
        cur = nxt; cA = nA; cB = nB; ++ui;
    }
    PG8_WAIT_V(0);
    if (wr == 0) PG8_BAR;
    PG8_BAR;
#undef PG8_SA
#undef PG8_SB
#undef PG8_STAGE
#undef PG8_LDA
#undef PG8_LDB
#undef PG8_MMA
#undef PG8_WAIT_V
#undef PG8_WAIT_L
#undef PG8_BAR
#undef PG8_SCHED
}
}

struct EpiIn {
    static constexpr bool PERM = true;
    bf16_t* proj; bf16_t* vta; bf16_t* vtc; float* bint; LAS unsigned char* tlds;
    DI bool operator()(const f32x4 (&acc)[2][2][4][2], const pg8::Unit& u, int wr, int wc, int fr, int fq) const { store(acc, u, wr, wc, fr, fq); return false; }
    DI void store(const f32x4 (&acc)[2][2][4][2], const pg8::Unit& u, int wr, int wc, int fr, int fq) const {
        const int colt = u.pn * 256;
        int kind = 0;
        if (colt < C_AGATE) { if ((colt % 3072) >= 2048) kind = 1; }
        else if (colt >= C_BIN && colt < C_BGATE) kind = 2;
        else if (colt >= C_CQKV + 2048 && colt < C_CGATE) kind = 3;
        const int row0 = u.pm * 256 + wr * 64 + fr, col0 = colt + wc * 32 + 8 * fq;
        if (kind == 0) {
#pragma unroll
            for (int ai = 0; ai < 2; ++ai)
#pragma unroll
                for (int m = 0; m < 4; ++m) { bf16_t* rp = proj + PIDX(row0 + ai * 128 + m * 16, col0);
#pragma unroll
                    for (int bj = 0; bj < 2; ++bj) { const f32x4 a = acc[ai][bj][m][0], b = acc[ai][bj][m][1];
                        u32x4 o = {pk2(a[0], a[1]), pk2(a[2], a[3]), pk2(b[0], b[1]), pk2(b[2], b[3])}; *(u32x4*)(rp + bj * 128) = o; } }
        } else if (kind == 1 && colt >= 2 * 3072) {
            bf16_t* base = vta + (ptrdiff_t)(2 * 1024 - 2 * 3072 - 2048) * (ptrdiff_t)S;
#pragma unroll
            for (int ai = 0; ai < 2; ++ai) { const int prow = fr * (S >> 4) + ((u.pm * 256 + ai * 128 + wr * 64) >> 4);
#pragma unroll
                for (int bj = 0; bj < 2; ++bj)
#pragma unroll
                    for (int n = 0; n < 2; ++n)
#pragma unroll
                        for (int e = 0; e < 4; ++e) { u32x2 o = {pk2(acc[ai][bj][0][n][e], acc[ai][bj][1][n][e]), pk2(acc[ai][bj][2][n][e], acc[ai][bj][3][n][e])};
                            *(u32x2*)(base + (ptrdiff_t)(col0 + bj * 128 + n * 4 + e) * (ptrdiff_t)S + prow) = o; } }
        } else {
            const int lane = fr + 16 * fq, wave = wr * 4 + wc;
            LAS float* tl = (LAS float*)(tlds + wave * 2304);
            const int cl = lane >> 1, hs = lane & 1;
            const int colg = colt + wc * 32 + cl;
#pragma unroll
            for (int ai = 0; ai < 2; ++ai)
#pragma unroll
                for (int bj = 0; bj < 2; ++bj)
#pragma unroll
                    for (int m = 0; m < 4; ++m) {
                        const int rowb = u.pm * 256 + ai * 128 + wr * 64 + m * 16;
#pragma unroll
                        for (int n = 0; n < 2; ++n)
#pragma unroll
                            for (int e = 0; e < 4; ++e) tl[(8 * fq + 4 * n + e) * 17 + fr] = acc[ai][bj][m][n][e];
                        __builtin_amdgcn_wave_barrier();
                        const LAS float* tc = tl + cl * 17;
                        const int col = colg + bj * 128;
                        if (kind == 2) {
                            f32x4 o0 = {tc[8 * hs], tc[8 * hs + 1], tc[8 * hs + 2], tc[8 * hs + 3]}, o1 = {tc[8 * hs + 4], tc[8 * hs + 5], tc[8 * hs + 6], tc[8 * hs + 7]};
                            float* bp = bint + (size_t)(col - C_BIN) * S + rowb + 8 * hs;
                            *(f32x4*)bp = o0; *(f32x4*)(bp + 4) = o1;
                        } else if (kind == 3) {
                            u32x4 o = {pk2(tc[4 * hs], tc[4 * hs + 1]), pk2(tc[4 * hs + 2], tc[4 * hs + 3]), pk2(tc[8 + 4 * hs], tc[9 + 4 * hs]), pk2(tc[10 + 4 * hs], tc[11 + 4 * hs])};
                            *(u32x4*)(vtc + (size_t)(col - (C_CQKV + 2048)) * S + rowb + 8 * hs) = o;
                        } else if (colt < 3072) {
                            u32x4 o = {pk2(tc[8 * hs], tc[8 * hs + 1]), pk2(tc[8 * hs + 2], tc[8 * hs + 3]), pk2(tc[8 * hs + 4], tc[8 * hs + 5]), pk2(tc[8 * hs + 6], tc[8 * hs + 7])};
                            *(u32x4*)(vta + (size_t)(col - 2048) * S + rowb + 8 * hs) = o;
                        } else {
#pragma unroll
                            for (int k = 0; k < 2; ++k) { const int res = 2 * hs + k;
                                u32x2 o = {pk2(tc[res], tc[res + 4]), pk2(tc[res + 8], tc[res + 12])};
                                *(u32x2*)(vta + (size_t)(1024 + col - 3072 - 2048) * S + res * (S >> 2) + (rowb >> 2)) = o; }
                        }
                        __builtin_amdgcn_wave_barrier();
                    }
        }
    }
};
struct ProjOrder {
    pg8::StaticOrder so;
    DI bool next(int i, pg8::Unit& u) const { pg8::Unit b; if (!so.next(i / 3, b)) return false; const int nb = i % 3; u.pm = b.pm + 32 * nb; u.pn = b.pn + 8 * nb; return true; }
};
struct EpiProj {   static constexpr bool PERM = false;
    const bf16_t* proj; const float* mb; bf16_t* yb;
    DI bool operator()(f32x4 (&acc)[2][2][4][2], const pg8::Unit& u, int wr, int wc, int fr, int fq) const {
        const int nb = u.pm >> 5, nn = nb < 2 ? nb + 1 : nb;
        const int row0 = (u.pm & 31) * 256 + wr * 64 + fr, col0 = (u.pn & 7) * 256 + wc * 32 + 4 * fq;
        f32x4 bc[2][2], bn[2][2];
#pragma unroll
        for (int bj = 0; bj < 2; ++bj)
#pragma unroll
            for (int n = 0; n < 2; ++n) { bc[bj][n] = *(const f32x4*)(mb + nb * D + col0 + bj * 128 + n * 16); bn[bj][n] = *(const f32x4*)(mb + nn * D + col0 + bj * 128 + n * 16); }
#pragma unroll
        for (int ai = 0; ai < 2; ++ai)
#pragma unroll
            for (int mp = 0; mp < 2; ++mp) {
                u32x2 gc[2][2][2], gn[2][2][2];
#pragma unroll
                for (int mi = 0; mi < 2; ++mi) { const int row = row0 + ai * 128 + (2 * mp + mi) * 16;
#pragma unroll
                    for (int bj = 0; bj < 2; ++bj)
#pragma unroll
                        for (int n = 0; n < 2; ++n) { const int col = col0 + bj * 128 + n * 16;
                            gc[mi][bj][n] = *(const u32x2*)(proj + PIDX(row, C_MERGE + nb * D + col));
                            gn[mi][bj][n] = *(const u32x2*)(proj + PIDX(row, C_MERGE + nn * D + col)); } }
#pragma unroll
                for (int mi = 0; mi < 2; ++mi) { const int m = 2 * mp + mi; const int row = row0 + ai * 128 + m * 16;
#pragma unroll
                    for (int bj = 0; bj < 2; ++bj)
#pragma unroll
                        for (int n = 0; n < 2; ++n) { const int col = col0 + bj * 128 + n * 16;
                            const u32x2 c2 = gc[mi][bj][n], n2 = gn[mi][bj][n]; const f32x4 cb = bc[bj][n], nbv = bn[bj][n];
                            const float xc[4] = {bflo(c2[0]) + cb[0], bfhi(c2[0]) + cb[1], bflo(c2[1]) + cb[2], bfhi(c2[1]) + cb[3]};
                            const float xn[4] = {bflo(n2[0]) + nbv[0], bfhi(n2[0]) + nbv[1], bflo(n2[1]) + nbv[2], bfhi(n2[1]) + nbv[3]};
                            if (nb < 2) {
#pragma unroll
                                for (int e = 0; e < 4; ++e) acc[ai][bj][m][n][e] *= (1.0f + __expf(-xn[e])) * __builtin_amdgcn_rcpf(1.0f + __expf(-xc[e]));
                            } else {
                                const f32x4 a = acc[ai][bj][m][n];
                                u32x2 o = {pk2(a[0] * sigm_f(xc[0]), a[1] * sigm_f(xc[1])), pk2(a[2] * sigm_f(xc[2]), a[3] * sigm_f(xc[3]))};
                                *(u32x2*)(yb + (size_t)row * D + col) = o;
                            } } }
            }
        return nb < 2;
    }
};
struct EpiOut {   static constexpr bool PERM = false;
    const float* xold; float* xnew;
    DI bool operator()(const f32x4 (&acc)[2][2][4][2], const pg8::Unit& u, int wr, int wc, int fr, int fq) const { store(acc, u, wr, wc, fr, fq); return false; }
    DI void store(const f32x4 (&acc)[2][2][4][2], const pg8::Unit& u, int wr, int wc, int fr, int fq) const {
        const int row0 = u.pm * 256 + wr * 64 + fr, col0 = u.pn * 256 + wc * 32 + 4 * fq;
#pragma unroll
        for (int ai = 0; ai < 2; ++ai)
#pragma unroll
            for (int mp = 0; mp < 2; ++mp) {
                f32x4 xv[2][2][2];
#pragma unroll
                for (int mi = 0; mi < 2; ++mi)
#pragma unroll
                    for (int bj = 0; bj < 2; ++bj)
#pragma unroll
                        for (int n = 0; n < 2; ++n) xv[mi][bj][n] = *(const f32x4*)(xold + (size_t)(row0 + ai * 128 + (2 * mp + mi) * 16) * D + col0 + bj * 128 + n * 16);
#pragma unroll
                for (int mi = 0; mi < 2; ++mi)
#pragma unroll
                    for (int bj = 0; bj < 2; ++bj)
#pragma unroll
                        for (int n = 0; n < 2; ++n) *(f32x4*)(xnew + (size_t)(row0 + ai * 128 + (2 * mp + mi) * 16) * D + col0 + bj * 128 + n * 16) = xv[mi][bj][n] + acc[ai][bj][2 * mp + mi][n];
            }
    }
};
DI float wave_sum(float v) {
#pragma unroll
    for (int o = 1; o < 64; o <<= 1) v += __shfl_xor(v, o);
    return v;
}
typedef unsigned u32x2v __attribute__((ext_vector_type(2)));
DI float xhalf_max(float x) {
    const unsigned u = __float_as_uint(x);
    const u32x2v rr = __builtin_amdgcn_permlane32_swap(u, u, false, false);
    return fmaxf(__uint_as_float(rr[0]), __uint_as_float(rr[1]));
}
DI int crow(int reg, int h) { return (reg & 3) + 8 * (reg >> 2) + 4 * h; }
DI bf16x8 pack8(const f32x16& x, const int s) {
    u32x4 p;
    p[0] = pk2(x[8 * s + 0], x[8 * s + 1]); p[1] = pk2(x[8 * s + 2], x[8 * s + 3]);
    p[2] = pk2(x[8 * s + 4], x[8 * s + 5]); p[3] = pk2(x[8 * s + 6], x[8 * s + 7]);
    return __builtin_bit_cast(bf16x8, p);
}
#define MFMA32(a, b, c) __builtin_amdgcn_mfma_f32_32x32x16_bf16((a), (b), (c), 0, 0, 0)

DI void transpose_item(const float* Wsrc, int K, int N, bf16_t* WT, LAS float* scr, int item, int lane) {
    const int nblk = N / 64, kb = item / nblk, nb = item % nblk, k0 = 64 * kb, n0 = 64 * nb;
    const int lr = lane >> 4, lc = (lane & 15) * 4;
    f32x4 v[16];
#pragma unroll
    for (int i = 0; i < 16; ++i) v[i] = *(const f32x4*)(Wsrc + (size_t)(k0 + 4 * i + lr) * N + n0 + lc);
#pragma unroll
    for (int i = 0; i < 16; ++i) { LAS float* d = scr + (4 * i + lr) * 65 + lc; d[0] = v[i][0]; d[1] = v[i][1]; d[2] = v[i][2]; d[3] = v[i][3]; }
    __builtin_amdgcn_wave_barrier();
    const int c = lane & 7;
#pragma unroll
    for (int j = 0; j < 8; ++j) { const int n = (lane >> 3) + 8 * j; const LAS float* s = scr + (8 * c) * 65 + n;
        u32x4 o; o[0] = pk2(s[0 * 65], s[1 * 65]); o[1] = pk2(s[2 * 65], s[3 * 65]); o[2] = pk2(s[4 * 65], s[5 * 65]); o[3] = pk2(s[6 * 65], s[7 * 65]);
        *(u32x4*)(WT + (size_t)(n0 + n) * K + k0 + 8 * c) = o; }
    __builtin_amdgcn_wave_barrier();
}
DI int t5_bucket(int rel) {
    const int ret = rel > 0 ? 16 : 0; const int n = rel < 0 ? -rel : rel;
    const float nf = (float)(n > 1 ? n : 1);
    int large = 8 + (int)(logf(nf / 8.0f) / 4.852030263919617f * 8.0f);
    large = large < 15 ? large : 15;
    return ret + (n < 8 ? n : large);
}
DI void phase_convert(const Params& p, LAS unsigned char* lds) {
    const int tid = tidx(), wave = tid >> 6, lane = tid & 63;
    const int gw = blockIdx.x * NWAVES + wave, NGW = gridDim.x * NWAVES;
    LAS float* scr = (LAS float*)(lds + wave * 16640);
    bf16_t* win_t = (bf16_t*)(p.ws + WS_WIN); bf16_t* wpr_t = (bf16_t*)(p.ws + WS_WPR); bf16_t* wout_t = (bf16_t*)(p.ws + WS_WOUT);
    constexpr int IT_IN = (D / 64) * (NIN / 64), IT_PR = (1024 / 64) * (D / 64), IT_OUT = (D / 64) * (D / 64);
    constexpr int TOT = DEPTH * IT_IN + DEPTH * 3 * IT_PR + DEPTH * IT_OUT;
    for (int it = gw; it < TOT; it += NGW) {
        int r = it;
        if (r < DEPTH * IT_IN) { const int l = r / IT_IN; transpose_item(p.in[I_WIN] + (size_t)l * D * NIN, D, NIN, win_t + (size_t)l * NIN * D, scr, r % IT_IN, lane); continue; }
        r -= DEPTH * IT_IN;
        if (r < DEPTH * 3 * IT_PR) { const int l = r / IT_PR; transpose_item(p.in[I_WPROJ] + (size_t)l * 1024 * D, 1024, D, wpr_t + (size_t)l * D * 1024, scr, r % IT_PR, lane); continue; }
        r -= DEPTH * 3 * IT_PR;
        { const int l = r / IT_OUT; transpose_item(p.in[I_WOUT] + (size_t)l * D * D, D, D, wout_t + (size_t)l * D * D, scr, r % IT_OUT, lane); }
    }
}
DI void phase_prologue(const Params& p, LAS unsigned char* lds) {
    const int tid = tidx();
    float* bias = (float*)(p.ws + WS_BIAS);
    for (int i = blockIdx.x * NTHR + tid; i < 32 * 2049; i += gridDim.x * NTHR) {
        const int hd = i / 2049, rel = (i % 2049) - 1024;
        bias[i] = p.in[I_RELB][t5_bucket(rel) * 32 + hd] * LOG2E;
    }
    __syncthreads();
    LAS float* zemb = (LAS float*)lds;
    LAS float* h1 = (LAS float*)(lds + 2048);
    float* hid2 = (float*)(p.ws + WS_HID2);
    for (int rb = blockIdx.x; rb < S / 8; rb += gridDim.x) {
        const int rl = tid >> 6, j = tid & 63, i = rb * 8 + rl;
        if (j < 33) {
            float z;
            if (j == 0) z = (float)i / 8191.0f;
            else { const int k = (j - 1) & 15; const float fb = 1e-4f + (float)k * ((15.0f - 1e-4f) / 15.0f); const float w = 6.283185307179586f * (float)i / 8192.0f; const float a = fb * w; z = (j <= 16) ? cosf(a) : -sinf(a); }
            zemb[rl * 36 + j] = z;
        }
        __syncthreads();
        for (int l = 0; l < DEPTH; ++l) {
            float a1 = p.in[I_HYB1][l * 64 + j];
            for (int e = 0; e < 33; ++e) a1 += zemb[rl * 36 + e] * p.in[I_HYW1][(l * 33 + e) * 64 + j];
            h1[rl * 64 + j] = sinf(p.in[I_HYFREQ][(l * 2 + 0) * 64 + j] * a1);
            __syncthreads();
            float a2 = p.in[I_HYB2][l * 64 + j];
            for (int e = 0; e < 64; ++e) a2 += h1[rl * 64 + e] * p.in[I_HYW2][(l * 64 + e) * 64 + j];
            hid2[((size_t)l * S + i) * 64 + j] = sinf(p.in[I_HYFREQ][(l * 2 + 1) * 64 + j] * a2);
            __syncthreads();
        }
    }
}


DI void split8(const f32x4 a, const f32x4 b, bf16x8& hi, bf16x8& lo) {
    u32x4 h, l2;
    h[0] = pk2(a[0], a[1]); h[1] = pk2(a[2], a[3]); h[2] = pk2(b[0], b[1]); h[3] = pk2(b[2], b[3]);
    l2[0] = pk2(a[0] - bflo(h[0]), a[1] - bfhi(h[0])); l2[1] = pk2(a[2] - bflo(h[1]), a[3] - bfhi(h[1]));
    l2[2] = pk2(b[0] - bflo(h[2]), b[1] - bfhi(h[2])); l2[3] = pk2(b[2] - bflo(h[3]), b[3] - bfhi(h[3]));
    hi = __builtin_bit_cast(bf16x8, h); lo = __builtin_bit_cast(bf16x8, l2);
}
DI void phase_tgen(const Params& p) {
    const int tid = tidx(), wave = tid >> 6, lane = tid & 63, r = lane & 31, hh = lane >> 5;
    float* tt = (float*)(p.ws + WS_TT);
    for (int it = blockIdx.x * NWAVES + wave; it < DEPTH * 128 * 4; it += gridDim.x * NWAVES) {
        const int l = it >> 9, cb = (it >> 2) & 127, rc = it & 3;
        const float* w3 = p.in[I_HYW3] + (size_t)l * 64 * 4096 + cb * 32 + r;
        bf16x8 ahi[4], alo[4];
#pragma unroll
        for (int ks = 0; ks < 4; ++ks) {
            f32x4 a, b;
#pragma unroll
            for (int j = 0; j < 4; ++j) { a[j] = w3[(size_t)(16 * ks + 8 * hh + j) * 4096]; b[j] = w3[(size_t)(16 * ks + 8 * hh + 4 + j) * 4096]; }
            split8(a, b, ahi[ks], alo[ks]);
        }
        const float* hid2 = (const float*)(p.ws + WS_HID2) + (size_t)l * S * 64;
        f32x4 ha[4], hb[4];
        { const float* hr = hid2 + (size_t)(rc * 2048 + r) * 64 + 8 * hh;
#pragma unroll
          for (int ks = 0; ks < 4; ++ks) { ha[ks] = *(const f32x4*)(hr + 16 * ks); hb[ks] = *(const f32x4*)(hr + 16 * ks + 4); } }
#pragma unroll 1
        for (int rb = 0; rb < 64; ++rb) {
            const int i0 = rc * 2048 + rb * 32;
            bf16x8 bhi[4], blo[4];
#pragma unroll
            for (int ks = 0; ks < 4; ++ks) split8(ha[ks], hb[ks], bhi[ks], blo[ks]);
            if (rb + 1 < 64) { const float* hr = hid2 + (size_t)(i0 + 32 + r) * 64 + 8 * hh;
#pragma unroll
                for (int ks = 0; ks < 4; ++ks) { ha[ks] = *(const f32x4*)(hr + 16 * ks); hb[ks] = *(const f32x4*)(hr + 16 * ks + 4); } }
            f32x16 acc;
#pragma unroll
            for (int i = 0; i < 16; ++i) acc[i] = 0.f;
#pragma unroll
            for (int ks = 0; ks < 4; ++ks) { acc = MFMA32(ahi[ks], bhi[ks], acc); acc = MFMA32(ahi[ks], blo[ks], acc); acc = MFMA32(alo[ks], bhi[ks], acc); }
            float* tp = tt + ((size_t)l * 4096 + cb * 32) * S + i0 + r;
#pragma unroll
            for (int reg = 0; reg < 16; ++reg) tp[(size_t)crow(reg, hh) * S] = acc[reg];
        }
    }
}

#define XI(i) ((i) + ((i) >> 4) + ((i) >> 8))
DI cf cmul(cf a, cf b) {
    cf t, r;
    asm("v_pk_mul_f32 %0, %1, %2 op_sel:[0,0] op_sel_hi:[0,1]" : "=v"(t) : "v"(a), "v"(b));
    asm("v_pk_fma_f32 %0, %1, %2, %3 op_sel:[1,1,0] op_sel_hi:[1,0,1] neg_lo:[0,1,0]" : "=v"(r) : "v"(a), "v"(b), "v"(t));
    return r;
}
DI cf twid(float frac) { float c = __builtin_amdgcn_cosf(frac), s = __builtin_amdgcn_sinf(frac); asm volatile("s_nop 1" : "+v"(c), "+v"(s)); return (cf){c, -s}; }
DI cf twidc(float frac) { float c = __builtin_amdgcn_cosf(frac), s = __builtin_amdgcn_sinf(frac); asm volatile("s_nop 1" : "+v"(c), "+v"(s)); return (cf){c, s}; }
DI void fwd4(cf& a0, cf& a1, cf& a2, cf& a3) {
    const cf s02 = a0 + a2, d02 = a0 - a2, s13 = a1 + a3, d13 = a1 - a3;
    a0 = s02 + s13; a2 = s02 - s13;
    a1 = (cf){d02.x + d13.y, d02.y - d13.x};
    a3 = (cf){d02.x - d13.y, d02.y + d13.x};
}
DI void inv4(cf& b0, cf& b1, cf& b2, cf& b3) {
    const cf s02 = b0 + b2, d02 = b0 - b2, s13 = b1 + b3, d13 = b1 - b3;
    b0 = s02 + s13; b2 = s02 - s13;
    b1 = (cf){d02.x - d13.y, d02.y + d13.x};
    b3 = (cf){d02.x + d13.y, d02.y - d13.x};
}
template <int LOGM> DI void fwd_r4_pass(LAS cf* X, int tid) {
    asm volatile("" : "+v"(tid));
    constexpr int M = 1 << LOGM, q = M >> 2;
#pragma unroll 2
    for (int t = tid; t < 4096; t += NTHR) {
        const int j = t & (q - 1), base = (t >> (LOGM - 2)) * M + j;
        constexpr int QP = (q >= 256) ? (q + (q >> 4) + (q >> 8)) : ((q == 16) ? 17 : 1);
        LAS cf* xp = X + XI(base);
        cf a0 = xp[0], a1 = xp[QP], a2 = xp[2 * QP], a3 = xp[3 * QP];
        fwd4(a0, a1, a2, a3);
        const cf w1 = twid((float)j * (1.0f / M)), w2 = cmul(w1, w1), w3 = cmul(w2, w1);
        xp[0] = a0; xp[QP] = cmul(a1, w1); xp[2 * QP] = cmul(a2, w2); xp[3 * QP] = cmul(a3, w3);
    }
}
template <int LOGM> DI void inv_r4_pass(LAS cf* X, int tid) {
    asm volatile("" : "+v"(tid));
    constexpr int M = 1 << LOGM, q = M >> 2;
#pragma unroll 2
    for (int t = tid; t < 4096; t += NTHR) {
        const int j = t & (q - 1), base = (t >> (LOGM - 2)) * M + j;
        const cf w1 = twidc((float)j * (1.0f / M)), w2 = cmul(w1, w1), w3 = cmul(w2, w1);
        constexpr int QP = (q >= 256) ? (q + (q >> 4) + (q >> 8)) : ((q == 16) ? 17 : 1);
        LAS cf* xp = X + XI(base);
        cf b0 = xp[0], b1 = cmul(xp[QP], w1), b2 = cmul(xp[2 * QP], w2), b3 = cmul(xp[3 * QP], w3);
        inv4(b0, b1, b2, b3);
        xp[0] = b0; xp[QP] = b1; xp[2 * QP] = b2; xp[3 * QP] = b3;
    }
}
template <int LOGM> DI void fwd16(cf (&v)[16], int j) {
    constexpr int M = 1 << LOGM, q = M >> 4;
#pragma unroll
    for (int n = 0; n < 4; ++n) {
        fwd4(v[n], v[n + 4], v[n + 8], v[n + 12]);
        const cf w1 = twid((float)(j + n * q) * (1.0f / M)), w2 = cmul(w1, w1), w3 = cmul(w2, w1);
        v[n + 4] = cmul(v[n + 4], w1); v[n + 8] = cmul(v[n + 8], w2); v[n + 12] = cmul(v[n + 12], w3);
    }
    const cf u1 = twid((float)j * (4.0f / M)), u2 = cmul(u1, u1), u3 = cmul(u2, u1);
#pragma unroll
    for (int m = 0; m < 4; ++m) {
        fwd4(v[4 * m], v[4 * m + 1], v[4 * m + 2], v[4 * m + 3]);
        v[4 * m + 1] = cmul(v[4 * m + 1], u1); v[4 * m + 2] = cmul(v[4 * m + 2], u2); v[4 * m + 3] = cmul(v[4 * m + 3], u3);
    }
}
template <int LOGM> DI void inv16(cf (&v)[16], int j) {
    constexpr int M = 1 << LOGM, q = M >> 4;
    const cf u1 = twidc((float)j * (4.0f / M)), u2 = cmul(u1, u1), u3 = cmul(u2, u1);
#pragma unroll
    for (int m = 0; m < 4; ++m) {
        v[4 * m + 1] = cmul(v[4 * m + 1], u1); v[4 * m + 2] = cmul(v[4 * m + 2], u2); v[4 * m + 3] = cmul(v[4 * m + 3], u3);
        inv4(v[4 * m], v[4 * m + 1], v[4 * m + 2], v[4 * m + 3]);
    }
#pragma unroll
    for (int n = 0; n < 4; ++n) {
        const cf w1 = twidc((float)(j + n * q) * (1.0f / M)), w2 = cmul(w1, w1), w3 = cmul(w2, w1);
        v[n + 4] = cmul(v[n + 4], w1); v[n + 8] = cmul(v[n + 8], w2); v[n + 12] = cmul(v[n + 12], w3);
        inv4(v[n], v[n + 4], v[n + 8], v[n + 12]);
    }
}
template <int LOGM> DI void fwd_r16_pass(LAS cf* X, int tid) {
    asm volatile("" : "+v"(tid));
    constexpr int M = 1 << LOGM, q = M >> 4;
#pragma unroll 1
    for (int t = tid; t < 1024; t += NTHR) {
        const int j = t & (q - 1), base = (t >> (LOGM - 4)) * M + j;
        constexpr int QP = (q >= 256) ? (q + (q >> 4) + (q >> 8)) : ((q == 16) ? 17 : 1);
        LAS cf* xp = X + XI(base);
        cf v[16];
#pragma unroll
        for (int n = 0; n < 16; ++n) v[n] = xp[n * QP];
        fwd16<LOGM>(v, j);
#pragma unroll
        for (int n = 0; n < 16; ++n) xp[n * QP] = v[n];
    }
}
template <int LOGM> DI void inv_r16_pass(LAS cf* X, int tid) {
    asm volatile("" : "+v"(tid));
    constexpr int M = 1 << LOGM, q = M >> 4;
#pragma unroll 1
    for (int t = tid; t < 1024; t += NTHR) {
        const int j = t & (q - 1), base = (t >> (LOGM - 4)) * M + j;
        constexpr int QP = (q >= 256) ? (q + (q >> 4) + (q >> 8)) : ((q == 16) ? 17 : 1);
        LAS cf* xp = X + XI(base);
        cf v[16];
#pragma unroll
        for (int n = 0; n < 16; ++n) v[n] = xp[n * QP];
        inv16<LOGM>(v, j);
#pragma unroll
        for (int n = 0; n < 16; ++n) xp[n * QP] = v[n];
    }
}
DI int rev4(int pp) { const unsigned br = __brev((unsigned)pp) >> 18; return (int)(((br & 0x2AAAu) >> 1) | ((br & 0x1555u) << 1)); }
DI void fft_forward(LAS cf* X, int tid) {
    fwd_r4_pass<14>(X, tid); __syncthreads();
    fwd_r16_pass<12>(X, tid); __syncthreads();
    fwd_r16_pass<8>(X, tid); __syncthreads();
    fwd_r16_pass<4>(X, tid); __syncthreads();
}
constexpr int SPEC_STRIDE = 8208;
DI void fft_conv(LAS cf* X, const f32x4* spec, int tid) {
    fft_forward(X, tid);
#pragma unroll 8
    for (int r = 0; r < 16; ++r) {
        const int k = tid + NTHR * r; const int pp = rev4(k);
        const f32x4 sp = spec[k]; const cf P = (cf){sp[0], sp[1]}, Mq = (cf){sp[2], sp[3]};
        const cf z = X[XI(pp)];
        if (k == 0) { X[XI(pp)] = cmul(z, P) + cmul((cf){z.x, -z.y}, Mq); }
        else { const int pm = rev4(16384 - k); const cf zm = X[XI(pm)];
            const cf y = cmul(z, P) + cmul((cf){zm.x, -zm.y}, Mq);
            const cf t = cmul((cf){zm.x, -zm.y}, P) + cmul(z, Mq);
            X[XI(pp)] = y; X[XI(pm)] = (cf){t.x, -t.y}; }
    }
    if (tid == 0) { const int pp = rev4(8192); const f32x4 sp = spec[8192]; const cf z = X[XI(pp)]; X[XI(pp)] = cmul(z, (cf){sp[0], sp[1]}) + cmul((cf){z.x, -z.y}, (cf){sp[2], sp[3]}); }
    __syncthreads();
    inv_r16_pass<4>(X, tid); __syncthreads();
    inv_r16_pass<8>(X, tid); __syncthreads();
    inv_r16_pass<12>(X, tid); __syncthreads();
    inv_r4_pass<14>(X, tid); __syncthreads();
}


typedef _Float16 hc __attribute__((ext_vector_type(2)));
DI hc hcmul(hc a, hc b) { hc t, r;
    asm("v_pk_mul_f16 %0, %1, %2 op_sel:[0,0] op_sel_hi:[0,1]" : "=v"(t) : "v"(a), "v"(b));
    asm("v_pk_fma_f16 %0, %1, %2, %3 op_sel:[1,1,0] op_sel_hi:[1,0,1] neg_lo:[0,1,0]" : "=v"(r) : "v"(a), "v"(b), "v"(t)); return r; }
DI hc hadd_mi(hc a, hc b) { hc r; asm("v_pk_add_f16 %0, %1, %2 op_sel:[0,1] op_sel_hi:[1,0] neg_hi:[0,1]" : "=v"(r) : "v"(a), "v"(b)); return r; }
DI hc hadd_pi(hc a, hc b) { hc r; asm("v_pk_add_f16 %0, %1, %2 op_sel:[0,1] op_sel_hi:[1,0] neg_lo:[0,1]" : "=v"(r) : "v"(a), "v"(b)); return r; }
DI hc htwid(float frac) { float c = __builtin_amdgcn_cosf(frac), s = __builtin_amdgcn_sinf(frac); asm volatile("s_nop 1" : "+v"(c), "+v"(s)); return (hc){(_Float16)c, (_Float16)(-s)}; }
DI hc htwidc(float frac) { float c = __builtin_amdgcn_cosf(frac), s = __builtin_amdgcn_sinf(frac); asm volatile("s_nop 1" : "+v"(c), "+v"(s)); return (hc){(_Float16)c, (_Float16)s}; }
DI void hfwd4(hc& a0, hc& a1, hc& a2, hc& a3) {
    const hc s02 = a0 + a2, d02 = a0 - a2, s13 = a1 + a3, d13 = a1 - a3;
    a0 = s02 + s13; a2 = s02 - s13; a1 = hadd_mi(d02, d13); a3 = hadd_pi(d02, d13);
}
DI void hinv4(hc& b0, hc& b1, hc& b2, hc& b3) {
    const hc s02 = b0 + b2, d02 = b0 - b2, s13 = b1 + b3, d13 = b1 - b3;
    b0 = s02 + s13; b2 = s02 - s13; b1 = hadd_pi(d02, d13); b3 = hadd_mi(d02, d13);
}
template <int LOGM> DI void hfwd_r4_pass(LAS hc* X, int tid) {
    asm volatile("" : "+v"(tid));
    constexpr int M = 1 << LOGM, q = M >> 2;
#pragma unroll 8
    for (int t = tid; t < 4096; t += NTHR) {
        const int j = t & (q - 1), base = (t >> (LOGM - 2)) * M + j;
        constexpr int QP = (q >= 256) ? (q + (q >> 4) + (q >> 8)) : ((q == 16) ? 17 : 1);
        LAS hc* xp = X + XI(base);
        hc a0 = xp[0], a1 = xp[QP], a2 = xp[2 * QP], a3 = xp[3 * QP];
        hfwd4(a0, a1, a2, a3);
        const hc w1 = htwid((float)j * (1.0f / M)), w2 = hcmul(w1, w1), w3 = hcmul(w2, w1);
        xp[0] = a0; xp[QP] = hcmul(a1, w1); xp[2 * QP] = hcmul(a2, w2); xp[3 * QP] = hcmul(a3, w3);
    }
}
template <int LOGM> DI void hinv_r4_pass(LAS hc* X, int tid) {
    asm volatile("" : "+v"(tid));
    constexpr int M = 1 << LOGM, q = M >> 2;
#pragma unroll 8
    for (int t = tid; t < 4096; t += NTHR) {
        const int j = t & (q - 1), base = (t >> (LOGM - 2)) * M + j;
        const hc w1 = htwidc((float)j * (1.0f / M)), w2 = hcmul(w1, w1), w3 = hcmul(w2, w1);
        constexpr int QP = (q >= 256) ? (q + (q >> 4) + (q >> 8)) : ((q == 16) ? 17 : 1);
        LAS hc* xp = X + XI(base);
        hc b0 = xp[0], b1 = hcmul(xp[QP], w1), b2 = hcmul(xp[2 * QP], w2), b3 = hcmul(xp[3 * QP], w3);
        hinv4(b0, b1, b2, b3);
        xp[0] = b0; xp[QP] = b1; xp[2 * QP] = b2; xp[3 * QP] = b3;
    }
}
template <int LOGM> DI void hfwd16(hc (&v)[16], int j) {
    constexpr int M = 1 << LOGM, q = M >> 4;
#pragma unroll
    for (int n = 0; n < 4; ++n) {
        hfwd4(v[n], v[n + 4], v[n + 8], v[n + 12]);
        const hc w1 = htwid((float)(j + n * q) * (1.0f / M)), w2 = hcmul(w1, w1), w3 = hcmul(w2, w1);
        v[n + 4] = hcmul(v[n + 4], w1); v[n + 8] = hcmul(v[n + 8], w2); v[n + 12] = hcmul(v[n + 12], w3);
    }
    const hc u1 = htwid((float)j * (4.0f / M)), u2 = hcmul(u1, u1), u3 = hcmul(u2, u1);
#pragma unroll
    for (int m = 0; m < 4; ++m) {
        hfwd4(v[4 * m], v[4 * m + 1], v[4 * m + 2], v[4 * m + 3]);
        v[4 * m + 1] = hcmul(v[4 * m + 1], u1); v[4 * m + 2] = hcmul(v[4 * m + 2], u2); v[4 * m + 3] = hcmul(v[4 * m + 3], u3);
    }
}
template <int LOGM> DI void hinv16(hc (&v)[16], int j) {
    constexpr int M = 1 << LOGM, q = M >> 4;
    const hc u1 = htwidc((float)j * (4.0f / M)), u2 = hcmul(u1, u1), u3 = hcmul(u2, u1);
#pragma unroll
    for (int m = 0; m < 4; ++m) {
        v[4 * m + 1] = hcmul(v[4 * m + 1], u1); v[4 * m + 2] = hcmul(v[4 * m + 2], u2); v[4 * m + 3] = hcmul(v[4 * m + 3], u3);
        hinv4(v[4 * m], v[4 * m + 1], v[4 * m + 2], v[4 * m + 3]);
    }
#pragma unroll
    for (int n = 0; n < 4; ++n) {
        const hc w1 = htwidc((float)(j + n * q) * (1.0f / M)), w2 = hcmul(w1, w1), w3 = hcmul(w2, w1);
        v[n + 4] = hcmul(v[n + 4], w1); v[n + 8] = hcmul(v[n + 8], w2); v[n + 12] = hcmul(v[n + 12], w3);
        hinv4(v[n], v[n + 4], v[n + 8], v[n + 12]);
    }
}
template <int LOGM, bool FWD> DI void h_r16_pass(LAS hc* X, int tid) {
    asm volatile("" : "+v"(tid));
    constexpr int M = 1 << LOGM, q = M >> 4;
#pragma unroll
    for (int t = tid; t < 1024; t += NTHR) {
        const int j = t & (q - 1), base = (t >> (LOGM - 4)) * M + j;
        constexpr int QP = (q >= 256) ? (q + (q >> 4) + (q >> 8)) : ((q == 16) ? 17 : 1);
        LAS hc* xp = X + XI(base);
        hc v[16];
#pragma unroll
        for (int n = 0; n < 16; ++n) v[n] = xp[n * QP];
        if (FWD) hfwd16<LOGM>(v, j); else hinv16<LOGM>(v, j);
#pragma unroll
        for (int n = 0; n < 16; ++n) xp[n * QP] = v[n];
    }
}
DI void fft_conv_h(LAS hc* X, const f32x4* spec, int tid) {
    hfwd_r4_pass<14>(X, tid); __syncthreads();
    h_r16_pass<12, true>(X, tid); __syncthreads();
    h_r16_pass<8, true>(X, tid); __syncthreads();
    h_r16_pass<4, true>(X, tid); __syncthreads();
#pragma unroll 8
    for (int r = 0; r < 16; ++r) {
        const int k = tid + NTHR * r; const int pp = rev4(k);
        const f32x4 sp = spec[k]; const cf P = (cf){sp[0], sp[1]} * 256.0f, Mq = (cf){sp[2], sp[3]} * 256.0f;
        const hc zh = X[XI(pp)]; const cf z = (cf){(float)zh.x, (float)zh.y};
        if (k == 0) { const cf y = cmul(z, P) + cmul((cf){z.x, -z.y}, Mq); X[XI(pp)] = (hc){(_Float16)y.x, (_Float16)y.y}; }
        else { const int pm = rev4(16384 - k); const hc zmh = X[XI(pm)]; const cf zm = (cf){(float)zmh.x, (float)zmh.y};
            const cf y = cmul(z, P) + cmul((cf){zm.x, -zm.y}, Mq);
            const cf t = cmul((cf){zm.x, -zm.y}, P) + cmul(z, Mq);
            X[XI(pp)] = (hc){(_Float16)y.x, (_Float16)y.y}; X[XI(pm)] = (hc){(_Float16)t.x, (_Float16)(-t.y)}; }
    }
    if (tid == 0) { const int pp = rev4(8192); const f32x4 sp = spec[8192]; const hc zh = X[XI(pp)]; const cf z = (cf){(float)zh.x, (float)zh.y};
        const cf y = (cmul(z, (cf){sp[0], sp[1]}) + cmul((cf){z.x, -z.y}, (cf){sp[2], sp[3]})) * 256.0f; X[XI(pp)] = (hc){(_Float16)y.x, (_Float16)y.y}; }
    __syncthreads();
    h_r16_pass<4, false>(X, tid); __syncthreads();
    h_r16_pass<8, false>(X, tid); __syncthreads();
    h_r16_pass<12, false>(X, tid); __syncthreads();
    hinv_r4_pass<14>(X, tid); __syncthreads();
}

template <int LOGM> DI void hfwd_r4_pass2(LAS hc* X0, LAS hc* X1, int tid) {
    asm volatile("" : "+v"(tid));
    constexpr int M = 1 << LOGM, q = M >> 2;
#pragma unroll 4
    for (int t = tid; t < 4096; t += NTHR) {
        const int j = t & (q - 1), base = (t >> (LOGM - 2)) * M + j;
        constexpr int QP = (q >= 256) ? (q + (q >> 4) + (q >> 8)) : ((q == 16) ? 17 : 1);
        const int xo = XI(base);
        LAS hc* xp = X0 + xo; LAS hc* yp = X1 + xo;
        hc a0 = xp[0], a1 = xp[QP], a2 = xp[2 * QP], a3 = xp[3 * QP], b0 = yp[0], b1 = yp[QP], b2 = yp[2 * QP], b3 = yp[3 * QP];
        hfwd4(a0, a1, a2, a3); hfwd4(b0, b1, b2, b3);
        const hc w1 = htwid((float)j * (1.0f / M)), w2 = hcmul(w1, w1), w3 = hcmul(w2, w1);
        xp[0] = a0; xp[QP] = hcmul(a1, w1); xp[2 * QP] = hcmul(a2, w2); xp[3 * QP] = hcmul(a3, w3);
        yp[0] = b0; yp[QP] = hcmul(b1, w1); yp[2 * QP] = hcmul(b2, w2); yp[3 * QP] = hcmul(b3, w3);
    }
}
template <int LOGM> DI void hinv_r4_pass2(LAS hc* X0, LAS hc* X1, int tid) {
    asm volatile("" : "+v"(tid));
    constexpr int M = 1 << LOGM, q = M >> 2;
#pragma unroll 4
    for (int t = tid; t < 4096; t += NTHR) {
        const int j = t & (q - 1), base = (t >> (LOGM - 2)) * M + j;
        const hc w1 = htwidc((float)j * (1.0f / M)), w2 = hcmul(w1, w1), w3 = hcmul(w2, w1);
        constexpr int QP = (q >= 256) ? (q + (q >> 4) + (q >> 8)) : ((q == 16) ? 17 : 1);
        const int xo = XI(base);
        LAS hc* xp = X0 + xo; LAS hc* yp = X1 + xo;
        hc a0 = xp[0], a1 = hcmul(xp[QP], w1), a2 = hcmul(xp[2 * QP], w2), a3 = hcmul(xp[3 * QP], w3);
        hc b0 = yp[0], b1 = hcmul(yp[QP], w1), b2 = hcmul(yp[2 * QP], w2), b3 = hcmul(yp[3 * QP], w3);
        hinv4(a0, a1, a2, a3); hinv4(b0, b1, b2, b3);
        xp[0] = a0; xp[QP] = a1; xp[2 * QP] = a2; xp[3 * QP] = a3;
        yp[0] = b0; yp[QP] = b1; yp[2 * QP] = b2; yp[3 * QP] = b3;
    }
}
template <int LOGM> DI void hfwd16x2(hc (&v)[16], hc (&u)[16], int j) {
    constexpr int M = 1 << LOGM, q = M >> 4;
#pragma unroll
    for (int n = 0; n < 4; ++n) {
        hfwd4(v[n], v[n + 4], v[n + 8], v[n + 12]); hfwd4(u[n], u[n + 4], u[n + 8], u[n + 12]);
        const hc w1 = htwid((float)(j + n * q) * (1.0f / M)), w2 = hcmul(w1, w1), w3 = hcmul(w2, w1);
        v[n + 4] = hcmul(v[n + 4], w1); v[n + 8] = hcmul(v[n + 8], w2); v[n + 12] = hcmul(v[n + 12], w3);
        u[n + 4] = hcmul(u[n + 4], w1); u[n + 8] = hcmul(u[n + 8], w2); u[n + 12] = hcmul(u[n + 12], w3);
    }
    const hc u1 = htwid((float)j * (4.0f / M)), u2 = hcmul(u1, u1), u3 = hcmul(u2, u1);
#pragma unroll
    for (int m = 0; m < 4; ++m) {
        hfwd4(v[4 * m], v[4 * m + 1], v[4 * m + 2], v[4 * m + 3]); hfwd4(u[4 * m], u[4 * m + 1], u[4 * m + 2], u[4 * m + 3]);
        v[4 * m + 1] = hcmul(v[4 * m + 1], u1); v[4 * m + 2] = hcmul(v[4 * m + 2], u2); v[4 * m + 3] = hcmul(v[4 * m + 3], u3);
        u[4 * m + 1] = hcmul(u[4 * m + 1], u1); u[4 * m + 2] = hcmul(u[4 * m + 2], u2); u[4 * m + 3] = hcmul(u[4 * m + 3], u3);
    }
}
template <int LOGM> DI void hinv16x2(hc (&v)[16], hc (&u)[16], int j) {
    constexpr int M = 1 << LOGM, q = M >> 4;
    const hc u1 = htwidc((float)j * (4.0f / M)), u2 = hcmul(u1, u1), u3 = hcmul(u2, u1);
#pragma unroll
    for (int m = 0; m < 4; ++m) {
        v[4 * m + 1] = hcmul(v[4 * m + 1], u1); v[4 * m + 2] = hcmul(v[4 * m + 2], u2); v[4 * m + 3] = hcmul(v[4 * m + 3], u3);
        u[4 * m + 1] = hcmul(u[4 * m + 1], u1); u[4 * m + 2] = hcmul(u[4 * m + 2], u2); u[4 * m + 3] = hcmul(u[4 * m + 3], u3);
        hinv4(v[4 * m], v[4 * m + 1], v[4 * m + 2], v[4 * m + 3]); hinv4(u[4 * m], u[4 * m + 1], u[4 * m + 2], u[4 * m + 3]);
    }
#pragma unroll
    for (int n = 0; n < 4; ++n) {
        const hc w1 = htwidc((float)(j + n * q) * (1.0f / M)), w2 = hcmul(w1, w1), w3 = hcmul(w2, w1);
        v[n + 4] = hcmul(v[n + 4], w1); v[n + 8] = hcmul(v[n + 8], w2); v[n + 12] = hcmul(v[n + 12], w3);
        u[n + 4] = hcmul(u[n + 4], w1); u[n + 8] = hcmul(u[n + 8], w2); u[n + 12] = hcmul(u[n + 12], w3);
        hinv4(v[n], v[n + 4], v[n + 8], v[n + 12]); hinv4(u[n], u[n + 4], u[n + 8], u[n + 12]);
    }
}
template <int LOGM, bool FWD> DI void h_r16_pass2(LAS hc* X0, LAS hc* X1, int tid) {
    asm volatile("" : "+v"(tid));
    constexpr int M = 1 << LOGM, q = M >> 4;
#pragma unroll 1
    for (int t = tid; t < 1024; t += NTHR) {
        const int j = t & (q - 1), base = (t >> (LOGM - 4)) * M + j;
        constexpr int QP = (q >= 256) ? (q + (q >> 4) + (q >> 8)) : ((q == 16) ? 17 : 1);
        const int xo = XI(base);
        LAS hc* xp = X0 + xo; LAS hc* yp = X1 + xo;
        hc v[16], u[16];
#pragma unroll
        for (int n = 0; n < 16; ++n) { v[n] = xp[n * QP]; u[n] = yp[n * QP]; }
        if (FWD) hfwd16x2<LOGM>(v, u, j); else hinv16x2<LOGM>(v, u, j);
#pragma unroll
        for (int n = 0; n < 16; ++n) { xp[n * QP] = v[n]; yp[n * QP] = u[n]; }
    }
}
DI void pw_h(LAS hc* X, const f32x4* spec, int tid) {
#pragma unroll 8
    for (int r = 0; r < 16; ++r) {
        const int k = tid + NTHR * r; const int pp = rev4(k);
        const f32x4 sp = spec[k]; const cf P = (cf){sp[0], sp[1]} * 256.0f, Mq = (cf){sp[2], sp[3]} * 256.0f;
        const hc zh = X[XI(pp)]; const cf z = (cf){(float)zh.x, (float)zh.y};
        if (k == 0) { const cf y = cmul(z, P) + cmul((cf){z.x, -z.y}, Mq); X[XI(pp)] = (hc){(_Float16)y.x, (_Float16)y.y}; }
        else { const int pm = rev4(16384 - k); const hc zmh = X[XI(pm)]; const cf zm = (cf){(float)zmh.x, (float)zmh.y};
            const cf y = cmul(z, P) + cmul((cf){zm.x, -zm.y}, Mq);
            const cf t = cmul((cf){zm.x, -zm.y}, P) + cmul(z, Mq);
            X[XI(pp)] = (hc){(_Float16)y.x, (_Float16)y.y}; X[XI(pm)] = (hc){(_Float16)t.x, (_Float16)(-t.y)}; }
    }
    if (tid == 0) { const int pp = rev4(8192); const f32x4 sp = spec[8192]; const hc zh = X[XI(pp)]; const cf z = (cf){(float)zh.x, (float)zh.y};
        const cf y = (cmul(z, (cf){sp[0], sp[1]}) + cmul((cf){z.x, -z.y}, (cf){sp[2], sp[3]})) * 256.0f; X[XI(pp)] = (hc){(_Float16)y.x, (_Float16)y.y}; }
}
DI void fft_conv_h2(LAS hc* X0, LAS hc* X1, const f32x4* spec0, const f32x4* spec1, int tid) {
    hfwd_r4_pass2<14>(X0, X1, tid); __syncthreads();
    h_r16_pass2<12, true>(X0, X1, tid); __syncthreads();
    h_r16_pass2<8, true>(X0, X1, tid); __syncthreads();
    h_r16_pass2<4, true>(X0, X1, tid); __syncthreads();
    pw_h(X0, spec0, tid); pw_h(X1, spec1, tid);
    __syncthreads();
    h_r16_pass2<4, false>(X0, X1, tid); __syncthreads();
    h_r16_pass2<8, false>(X0, X1, tid); __syncthreads();
    h_r16_pass2<12, false>(X0, X1, tid); __syncthreads();
    hinv_r4_pass2<14>(X0, X1, tid); __syncthreads();
}

DI void spectra_item(const Params& p, int ditem, LAS unsigned char* lds) {
    int tid = tidx(); asm volatile("" : "+v"(tid));
    const int l = ditem >> 9, o = (ditem >> 8) & 1, d = ditem & 255, a = 4 * d;
    LAS hc* X0 = (LAS hc*)lds; LAS hc* X1 = X0 + 17472;
    const float mind = -3.0701134573253943f, maxd = -15.350567286626972f;
    float dec[4], sk[4];
#pragma unroll
    for (int c = 0; c < 4; ++c) { dec[c] = fabsf(mind + (float)(a + c) * ((maxd - mind) / 1023.0f)); sk[c] = p.in[I_HYSKIP][(l * 2 + o) * 1024 + a + c]; }
    const float* tf = (const float*)(p.ws + WS_TT) + ((size_t)l * 4096 + (o * 2 + 0) * 1024 + a) * S;
    const float* tb = (const float*)(p.ws + WS_TT) + ((size_t)l * 4096 + (o * 2 + 1) * 1024 + a) * S;
#pragma unroll 8
    for (int rr = 0; rr < 16; ++rr) {
        const int i = tid + NTHR * rr;
        const float ti = (float)i / 8191.0f;
        float f[4], b[4];
#pragma unroll
        for (int c = 0; c < 4; ++c) { const float e = __expf(-ti * dec[c]) * 256.0f; f[c] = tf[(size_t)c * S + i] * e; b[c] = tb[(size_t)c * S + i] * e; }
        if (i == 0) {
            X0[XI(0)] = (hc){(_Float16)(f[0] + b[0] + sk[0] * 256.0f), (_Float16)(f[1] + b[1] + sk[1] * 256.0f)}; X1[XI(0)] = (hc){(_Float16)(f[2] + b[2] + sk[2] * 256.0f), (_Float16)(f[3] + b[3] + sk[3] * 256.0f)};
            X0[XI(8192)] = (hc){(_Float16)0.f, (_Float16)0.f}; X1[XI(8192)] = (hc){(_Float16)0.f, (_Float16)0.f};
        } else {
            X0[XI(i)] = (hc){(_Float16)f[0], (_Float16)f[1]}; X1[XI(i)] = (hc){(_Float16)f[2], (_Float16)f[3]};
            X0[XI(16384 - i)] = (hc){(_Float16)b[0], (_Float16)b[1]}; X1[XI(16384 - i)] = (hc){(_Float16)b[2], (_Float16)b[3]};
        }
    }
    __syncthreads();
    hfwd_r4_pass2<14>(X0, X1, tid); __syncthreads();
    h_r16_pass2<12, true>(X0, X1, tid); __syncthreads();
    h_r16_pass2<8, true>(X0, X1, tid); __syncthreads();
    h_r16_pass2<4, true>(X0, X1, tid); __syncthreads();
    const float sc = 0.5f / 16384.0f / 256.0f;
#pragma unroll
    for (int half = 0; half < 2; ++half) {
        LAS hc* X = half ? X1 : X0;
        f32x4* spec = (f32x4*)(p.ws + WS_SPEC) + (size_t)((l * 2 + o) * 512 + 2 * d + half) * SPEC_STRIDE;
        for (int r = 0; r < 17; ++r) {
            const int k = tid + NTHR * r; if (k > 8192) break;
            const hc Fh = X[XI(rev4(k))], Fmh = X[XI(rev4((16384 - k) & 16383))]; const cf F = (cf){(float)Fh.x, (float)Fh.y}, Fm = (cf){(float)Fmh.x, (float)Fmh.y};
            const cf Fc = (cf){Fm.x, -Fm.y};
            const cf Ha = (F + Fc) * 0.5f, tt = (F - Fc) * 0.5f; const cf Hb = (cf){tt.y, -tt.x};
            const cf P = (Ha + Hb) * sc, Mq = (Ha - Hb) * sc;
            spec[k] = (f32x4){P.x, P.y, Mq.x, Mq.y};
        }
    }
    __syncthreads();
}

DI float conv3(const float* row, int t, float w0, float w1, float w2) {
    const float c = row[t]; float pv = row[t > 0 ? t - 1 : 0], nx = row[t < S - 1 ? t + 1 : S - 1];
    pv = t > 0 ? pv : 0.f; nx = t < S - 1 ? nx : 0.f;
    return w0 * pv + w1 * c + w2 * nx;
}
DI void hyena_item(const Params& p, int l, int dpr, LAS unsigned char* lds) {
    int tid = tidx(); asm volatile("" : "+v"(tid)); const int a = 4 * dpr;
    LAS hc* X0 = (LAS hc*)lds; LAS hc* X1 = X0 + 17472;
    const float* bint = (const float*)(p.ws + WS_BINT);
    const float* cw = p.in[I_HYCONV] + (size_t)l * 3 * 3072;
    const f32x4* spec = (const f32x4*)(p.ws + WS_SPEC);
    const hc hzero = (hc){(_Float16)0.f, (_Float16)0.f};
    float w[4][3];
#pragma unroll
    for (int c = 0; c < 4; ++c)
#pragma unroll
        for (int k = 0; k < 3; ++k) w[c][k] = cw[k * 3072 + 0 * 1024 + a + c];
#pragma unroll 4
    for (int r = 0; r < 16; ++r) { const int t = tid + NTHR * r;
        float v[4];
#pragma unroll
        for (int c = 0; c < 4; ++c) v[c] = conv3(bint + (size_t)(a + c) * S, t, w[c][0], w[c][1], w[c][2]) * 0.25f;
        X0[XI(t)] = (hc){(_Float16)v[0], (_Float16)v[1]}; X1[XI(t)] = (hc){(_Float16)v[2], (_Float16)v[3]};
        X0[XI(t + 8192)] = hzero; X1[XI(t + 8192)] = hzero; }
    __syncthreads();
    fft_conv_h2(X0, X1, spec + (size_t)((l * 2 + 0) * 512 + 2 * dpr) * SPEC_STRIDE, spec + (size_t)((l * 2 + 0) * 512 + 2 * dpr + 1) * SPEC_STRIDE, tid);
#pragma unroll
    for (int c = 0; c < 4; ++c)
#pragma unroll
        for (int k = 0; k < 3; ++k) w[c][k] = cw[k * 3072 + 1 * 1024 + a + c];
#pragma unroll 4
    for (int r = 0; r < 16; ++r) { const int t = tid + NTHR * r; const hc y0 = X0[XI(t)], y1 = X1[XI(t)];
        const float yv[4] = {(float)y0.x, (float)y0.y, (float)y1.x, (float)y1.y};
        float z[4];
#pragma unroll
        for (int c = 0; c < 4; ++c) z[c] = yv[c] * (1.0f / 64.0f) * conv3(bint + (size_t)(1024 + a + c) * S, t, w[c][0], w[c][1], w[c][2]) * 0.25f;
        X0[XI(t)] = (hc){(_Float16)z[0], (_Float16)z[1]}; X1[XI(t)] = (hc){(_Float16)z[2], (_Float16)z[3]};
        X0[XI(t + 8192)] = hzero; X1[XI(t + 8192)] = hzero; }
    __syncthreads();
    fft_conv_h2(X0, X1, spec + (size_t)((l * 2 + 1) * 512 + 2 * dpr) * SPEC_STRIDE, spec + (size_t)((l * 2 + 1) * 512 + 2 * dpr + 1) * SPEC_STRIDE, tid);
#pragma unroll
    for (int c = 0; c < 4; ++c)
#pragma unroll
        for (int k = 0; k < 3; ++k) w[c][k] = cw[k * 3072 + 2 * 1024 + a + c];
    float* z2t = (float*)(p.ws + WS_Z2T);
#pragma unroll 4
    for (int r = 0; r < 16; ++r) { const int t = tid + NTHR * r; const hc y0 = X0[XI(t)], y1 = X1[XI(t)];
        const float yv[4] = {(float)y0.x, (float)y0.y, (float)y1.x, (float)y1.y};
#pragma unroll
        for (int c = 0; c < 4; ++c) z2t[(size_t)(a + c) * S + t] = yv[c] * (1.0f / 64.0f) * conv3(bint + (size_t)(2048 + a + c) * S, t, w[c][0], w[c][1], w[c][2]); }
    __syncthreads();
}
DI void phase_rmsnorm(const float* x, const float* g, bf16_t* hout, float* fout) {
    const int tid = tidx(), wave = tid >> 6, lane = tid & 63;
    const int gw = blockIdx.x * NWAVES + wave, ngw = gridDim.x * NWAVES;
    for (int row = gw; row < S; row += 2 * ngw) {
        const int row2 = row + ngw;
        const bool has2 = row2 < S;
        const f32x4* xr = (const f32x4*)(x + (size_t)row * D) + lane;
        const f32x4* xr2 = (const f32x4*)(x + (size_t)(has2 ? row2 : row) * D) + lane;
        f32x4 v[8], v2[8]; float s = 0.f, s2 = 0.f;
#pragma unroll
        for (int j = 0; j < 8; ++j) { v[j] = xr[64 * j]; v2[j] = xr2[64 * j]; }
#pragma unroll
        for (int j = 0; j < 8; ++j) { s += (v[j][0] * v[j][0] + v[j][1] * v[j][1]) + (v[j][2] * v[j][2] + v[j][3] * v[j][3]); s2 += (v2[j][0] * v2[j][0] + v2[j][1] * v2[j][1]) + (v2[j][2] * v2[j][2] + v2[j][3] * v2[j][3]); }
        const float rstd = rsqrtf(wave_sum(s) * (1.0f / D) + 1e-6f), rstd2 = rsqrtf(wave_sum(s2) * (1.0f / D) + 1e-6f);
#pragma unroll
        for (int j = 0; j < 8; ++j) { const f32x4 gg = ((const f32x4*)g)[lane + 64 * j]; const f32x4 y = v[j] * rstd * gg, y2 = v2[j] * rstd2 * gg;
            if (hout) { u32x2 o = {pk2(y[0], y[1]), pk2(y[2], y[3])}; ((u32x2*)(hout + (size_t)row * D))[lane + 64 * j] = o;
                if (has2) { u32x2 o2 = {pk2(y2[0], y2[1]), pk2(y2[2], y2[3])}; ((u32x2*)(hout + (size_t)row2 * D))[lane + 64 * j] = o2; } }
            else { ((f32x4*)(fout + (size_t)row * D))[lane + 64 * j] = y; if (has2) ((f32x4*)(fout + (size_t)row2 * D))[lane + 64 * j] = y2; } }
    }
}

constexpr int KROW = 144, KBUF = 64 * KROW, VBUF = 128 * KROW;
DI void softmax_half(f32x16& s, const LAS float* btab, int k0, int q0w, int r, int hh, float cs, float& m, float& lsum, f32x16 (&O)[4]) {
    const int q = q0w + r;
    const int relmin = k0 - q0w - 31, relmax = k0 + 31 - q0w;
    float bc = 0.f, csx = cs;
    if (relmin >= 1024 || relmax <= -1024) { bc = btab[relmin >= 1024 ? 2048 : 0]; }
    else {
        if (relmin >= -1024 && relmax <= 1024) {
            const LAS float* bp = btab + (k0 - q + 1024 + 4 * hh);
#pragma unroll
            for (int i = 0; i < 16; ++i) s[i] = s[i] * cs + bp[(i & 3) + 8 * (i >> 2)];
        } else {
#pragma unroll
            for (int i = 0; i < 16; ++i) { const int rel = k0 + crow(i, hh) - q; const int i0 = min(max(rel, -1024), 1024) + 1024; s[i] = s[i] * cs + btab[i0]; }
        }
        csx = 1.0f;
    }
    float mx = s[0];
#pragma unroll
    for (int i = 1; i < 16; ++i) mx = fmaxf(mx, s[i]);
    mx = mx * csx + bc;
    mx = xhalf_max(mx);
    if (__any(mx > m + 8.0f)) {
        const float mnew = fmaxf(m, mx), alpha = __builtin_amdgcn_exp2f(m - mnew);
        m = mnew; lsum *= alpha;
#pragma unroll
        for (int db = 0; db < 4; ++db) O[db] *= alpha;
    }
    const float c2 = bc - m;
    float rs0 = 0.f, rs1 = 0.f;
#pragma unroll
    for (int i = 0; i < 16; i += 2) { s[i] = __builtin_amdgcn_exp2f(s[i] * csx + c2); s[i + 1] = __builtin_amdgcn_exp2f(s[i + 1] * csx + c2); rs0 += s[i]; rs1 += s[i + 1]; }
    lsum += rs0 + rs1;
}
constexpr int K3BUF = 64 * 128, V3BUF = 128 * 128;
DI void dstage_k(const bf16_t* kgl, LAS unsigned char* dst, int wave, int lane) {
    const int row = 8 * wave + (lane >> 3), gseg = (lane & 7) ^ ((row >> 1) & 7);
    __builtin_amdgcn_global_load_lds((const unsigned*)(kgl + (size_t)row * 256 + gseg * 8), (LAS unsigned*)(dst + wave * 1024), 16, 0, 0);
}
DI void dstage_v(const bf16_t* vgl, LAS unsigned char* dst, int wave, int lane) {
#pragma unroll
    for (int k = 0; k < 2; ++k) { const int ii = 2 * wave + k, row = 8 * ii + (lane >> 3), gseg = (lane & 7) ^ ((row >> 1) & 7);
        __builtin_amdgcn_global_load_lds((const unsigned*)(vgl + (size_t)row * S + gseg * 8), (LAS unsigned*)(dst + ii * 1024), 16, 0, 0); }
}
DI void sm_max_phase(f32x16& s, const LAS float* btab, int k0, int q0w, int r, int hh, float cs, float& m, float& lsum, f32x16 (&O)[4], float& csx, float& c2) {
    const int q = q0w + r;
    const int relmin = k0 - q0w - 31, relmax = k0 + 31 - q0w;
    float bc = 0.f; csx = cs;
    if (relmin >= 1024 || relmax <= -1024) { bc = btab[relmin >= 1024 ? 2048 : 0]; }
    else {
        if (relmin >= -1024 && relmax <= 1024) {
            const LAS float* bp = btab + (k0 - q + 1024 + 4 * hh);
#pragma unroll
            for (int i = 0; i < 16; ++i) s[i] = s[i] * cs + bp[(i & 3) + 8 * (i >> 2)];
        } else {
#pragma unroll
            for (int i = 0; i < 16; ++i) { const int rel = k0 + crow(i, hh) - q; const int i0 = min(max(rel, -1024), 1024) + 1024; s[i] = s[i] * cs + btab[i0]; }
        }
        csx = 1.0f;
    }
    float mx = s[0];
#pragma unroll
    for (int i = 1; i < 16; ++i) mx = fmaxf(mx, s[i]);
    mx = mx * csx + bc;
    mx = xhalf_max(mx);
    if (__any(mx > m + 8.0f)) {
        const float mnew = fmaxf(m, mx), alpha = __builtin_amdgcn_exp2f(m - mnew);
        m = mnew; lsum *= alpha;
#pragma unroll
        for (int db = 0; db < 4; ++db) O[db] *= alpha;
    }
    c2 = bc - m;
}
#define DF_EXP2(i0) do { s[i0] = __builtin_amdgcn_exp2f(s[i0] * csx + c2); s[(i0) + 1] = __builtin_amdgcn_exp2f(s[(i0) + 1] * csx + c2); rs0 += s[i0]; rs1 += s[(i0) + 1]; } while (0)
#define DF_FENCE __builtin_amdgcn_sched_barrier(0)
DI void diff_flash2(const bf16_t* proj, const bf16_t* vtc, int h, int c, int q0w, LAS unsigned char* lds, const LAS float* btab, f32x16 (&O)[4]) {
    int tid = tidx(); asm volatile("" : "+v"(tid)); const int lane = tid & 63, r = lane & 31, hh = lane >> 5, wave = __builtin_amdgcn_readfirstlane(tid >> 6);
    constexpr int NT = S / 64;
    bf16x8 qf[4];
    { const bf16_t* qp = proj + PIDX(q0w + r, C_CQKV + h * 128 + c * 64 + 8 * hh);
#pragma unroll
      for (int ks = 0; ks < 4; ++ks) qf[ks] = *(const bf16x8*)(qp + 16 * ks); }
#pragma unroll
    for (int db = 0; db < 4; ++db)
#pragma unroll
        for (int i = 0; i < 16; ++i) O[db][i] = 0.f;
    float m = -1e30f, lsum = 0.f;
    const float cs = 0.125f * LOG2E;
    const bf16_t* kg = proj + PIDX(0, C_CQKV + 1024 + h * 128 + c * 64);
    const bf16_t* vg = vtc + (size_t)(h * 128) * S;
    LAS unsigned char* Kb = lds; LAS unsigned char* Vb = lds + 3 * K3BUF;
    __syncthreads();
    dstage_k(kg, Kb, wave, lane); dstage_v(vg, Vb, wave, lane); dstage_k(kg + (size_t)64 * 256, Kb + K3BUF, wave, lane);
    asm volatile("s_waitcnt vmcnt(0)" ::: "memory");
    __syncthreads();
    const int swz = (r >> 1) & 7, rowoff = r * 128;
    int kso[4];
#pragma unroll
    for (int ks = 0; ks < 4; ++ks) kso[ks] = rowoff + (((2 * ks + hh) ^ swz) << 4);
    bf16x8 kf[4], vf[8];
    f32x16 s, sn;
#pragma unroll
    for (int i = 0; i < 16; ++i) s[i] = 0.f;
#pragma unroll
    for (int ks = 0; ks < 4; ++ks) { kf[ks] = *(const LAS bf16x8*)(Kb + kso[ks]); }
#pragma unroll
    for (int ks = 0; ks < 4; ++ks) s = MFMA32(kf[ks], qf[ks], s);
    int kc = 0, kn = K3BUF, kw = 2 * K3BUF;
#pragma unroll 1
    for (int t = 0; t < NT; ++t) {
        if (t + 2 < NT) dstage_k(kg + (size_t)(t + 2) * 64 * 256, Kb + kw, wave, lane);
        if (t + 1 < NT) dstage_v(vg + (t + 1) * 64, Vb + ((t + 1) & 1) * V3BUF, wave, lane);
        const LAS unsigned char* vb_ = Vb + (t & 1) * V3BUF;
#pragma unroll
        for (int half = 0; half < 2; ++half) {
#pragma unroll
            for (int ss = 0; ss < 2; ++ss) { const int vs = rowoff + (((4 * half + 2 * ss + hh) ^ swz) << 4);
#pragma unroll
                for (int db = 0; db < 4; ++db) vf[ss * 4 + db] = *(const LAS bf16x8*)(vb_ + vs + (32 * db) * 128); }
            const bool have_next = (half == 0) || (t + 1 < NT);
            { const LAS unsigned char* kbase = (half == 0) ? (Kb + kc + 32 * 128) : (Kb + kn);
              if (have_next) {
#pragma unroll
                  for (int ks = 0; ks < 4; ++ks) kf[ks] = *(const LAS bf16x8*)(kbase + kso[ks]); } }
            float csx, c2;
            sm_max_phase(s, btab, t * 64 + 32 * half, q0w, r, hh, cs, m, lsum, O, csx, c2);
            float rs0 = 0.f, rs1 = 0.f;
#pragma unroll
            for (int i = 0; i < 16; ++i) sn[i] = 0.f;
            DF_FENCE;
            sn = MFMA32(kf[0], qf[0], sn); DF_EXP2(0); DF_FENCE;
            sn = MFMA32(kf[1], qf[1], sn); DF_EXP2(2); DF_FENCE;
            sn = MFMA32(kf[2], qf[2], sn); DF_EXP2(4); DF_FENCE;
            sn = MFMA32(kf[3], qf[3], sn); DF_EXP2(6); DF_FENCE;
            const bf16x8 pf0 = pack8(s, 0);
            O[0] = MFMA32(vf[0], pf0, O[0]); DF_EXP2(8); DF_FENCE;
            O[1] = MFMA32(vf[1], pf0, O[1]); DF_EXP2(10); DF_FENCE;
            O[2] = MFMA32(vf[2], pf0, O[2]); DF_EXP2(12); DF_FENCE;
            O[3] = MFMA32(vf[3], pf0, O[3]); DF_EXP2(14); DF_FENCE;
            const bf16x8 pf1 = pack8(s, 1);
            O[0] = MFMA32(vf[4], pf1, O[0]); O[1] = MFMA32(vf[5], pf1, O[1]); O[2] = MFMA32(vf[6], pf1, O[2]); O[3] = MFMA32(vf[7], pf1, O[3]);
            lsum += rs0 + rs1;
            s = sn;
        }
        asm volatile("s_waitcnt vmcnt(0)" ::: "memory");
        __syncthreads();
        const int tmp = kc; kc = kn; kn = kw; kw = tmp;
    }
    const float lt = lsum + __shfl_xor(lsum, 32), inv = 1.0f / lt;
#pragma unroll
    for (int db = 0; db < 4; ++db) O[db] *= inv;
}
#undef DF_EXP2
#undef DF_FENCE
DI void diffattn_item(const Params& p, int l, int item, LAS unsigned char* lds) {
    int tid = tidx(); asm volatile("" : "+v"(tid)); const int wave = __builtin_amdgcn_readfirstlane(tid >> 6), lane = tid & 63, r = lane & 31, hh = lane >> 5;
    const int qt = item >> 3, h = item & 7, q0w = qt * 256 + wave * 32;
    LAS float* btab = (LAS float*)(lds + LDS_MAIN);
    const float* bias = (const float*)(p.ws + WS_BIAS) + (24 + h) * 2049;
    for (int i = tid; i < 2049; i += NTHR) btab[i] = bias[i];
    const float* dl = p.in[I_DLAM] + l * 256;
    float d01 = 0.f, d23 = 0.f;
    for (int i = 0; i < 64; ++i) { d01 += dl[i] * dl[64 + i]; d23 += dl[128 + i] * dl[192 + i]; }
    const float lam_init = 0.8f - 0.6f * expf(-0.3f * (float)l);
    const float lam = expf(d01) - expf(d23) + lam_init;
    const bf16_t* proj = (const bf16_t*)(p.ws + WS_PROJ); const bf16_t* vtc = (const bf16_t*)(p.ws + WS_VTC);
    f32x16 O0[4];
    const int q = q0w + r;
    float* ctmp = (float*)(p.ws + WS_CTMP) + (size_t)q * 1024 + h * 128 + 4 * hh;
    diff_flash2(proj, vtc, h, 0, q0w, lds, btab, O0);
#pragma unroll
    for (int db = 0; db < 4; ++db)
#pragma unroll
        for (int i4 = 0; i4 < 4; ++i4) { f32x4 o = {O0[db][4 * i4], O0[db][4 * i4 + 1], O0[db][4 * i4 + 2], O0[db][4 * i4 + 3]}; *(f32x4*)(ctmp + 32 * db + 8 * i4) = o; }
    diff_flash2(proj, vtc, h, 1, q0w, lds, btab, O0);
    float ss = 0.f;
#pragma unroll
    for (int db = 0; db < 4; ++db)
#pragma unroll
        for (int i4 = 0; i4 < 4; ++i4) { const f32x4 o0 = *(const f32x4*)(ctmp + 32 * db + 8 * i4);
#pragma unroll
            for (int e = 0; e < 4; ++e) { const float o = o0[e] - lam * O0[db][4 * i4 + e]; O0[db][4 * i4 + e] = o; ss += o * o; } }
    ss += __shfl_xor(ss, 32);
    const float rn = rsqrtf(ss * (1.0f / 128.0f) + 1e-6f) * (1.0f - lam_init);
    const float* dg = p.in[I_DG] + l * 128;
    bf16_t* cout = (bf16_t*)(p.ws + WS_BR) + (size_t)2 * S * 1024;
#pragma unroll
    for (int db = 0; db < 4; ++db)
#pragma unroll
        for (int i4 = 0; i4 < 4; ++i4) {
            const int d0 = 32 * db + 8 * i4 + 4 * hh;
            const f32x4 g4 = *(const f32x4*)(dg + d0);
            const u32x2 gt = *(const u32x2*)(proj + PIDX(q, C_CGATE + h * 128 + d0));
            const float y0 = O0[db][4 * i4 + 0] * rn * g4[0] * silu_f(bflo(gt[0])), y1 = O0[db][4 * i4 + 1] * rn * g4[1] * silu_f(bfhi(gt[0]));
            const float y2 = O0[db][4 * i4 + 2] * rn * g4[2] * silu_f(bflo(gt[1])), y3 = O0[db][4 * i4 + 3] * rn * g4[3] * silu_f(bfhi(gt[1]));
            u32x2 o = {pk2(y0, y1), pk2(y2, y3)};
            *(u32x2*)(cout + (size_t)q * 1024 + h * 128 + d0) = o;
        }
    __syncthreads();
}

DI void mixA_wave_item(const Params& p, int wi, int lane, const LAS float* tb) {
    asm volatile("" : "+v"(lane));
    const int g = wi >> 11, rem = wi & 2047, h = rem >> 8, qb = rem & 255;
    const int sh = 2 * g, n = S >> sh, nbq = 256 >> sh, res = qb / nbq, m0 = (qb % nbq) * 32;
    const int r = lane & 31, hh = lane >> 5;
    const bf16_t* proj = (const bf16_t*)(p.ws + WS_PROJ);
    const int qpos = ((m0 + r) << sh) + res;
    bf16x8 qf[8];
    { const bf16_t* qp = proj + PIDX(qpos, g * 3072 + h * 128 + 8 * hh);
#pragma unroll
      for (int ks = 0; ks < 8; ++ks) qf[ks] = *(const bf16x8*)(qp + 16 * ks); }
    f32x16 O[4];
#pragma unroll
    for (int db = 0; db < 4; ++db)
#pragma unroll
        for (int i = 0; i < 16; ++i) O[db][i] = 0.f;
    float m = -1e30f, lsum = 0.f;
    const float cs = 0.08838834764831845f * LOG2E;
    const LAS float* tbl = tb + 31 - r + 4 * hh;
    const bf16_t* vt = (const bf16_t*)(p.ws + WS_VTA) + (size_t)((g * 8 + h) * 128) * S + res * n;
    bf16x8 kf[8];
    { const int mk0r = m0 - 64; const int mk0 = (mk0r >= 0 && mk0r < n) ? mk0r : m0;
      const bf16_t* kp = proj + PIDX(((mk0 + r) << sh) + res, g * 3072 + 1024 + h * 128 + 8 * hh);
#pragma unroll
      for (int ks = 0; ks < 8; ++ks) kf[ks] = *(const bf16x8*)(kp + 16 * ks); }
#pragma unroll 1
    for (int kb = 0; kb < 5; ++kb) {
        const int mk0r = m0 - 64 + 32 * kb;
        const bool blk_ok = (mk0r >= 0) && (mk0r < n);
        const int mk0 = blk_ok ? mk0r : m0;
        bf16x8 vfr[2][4];
#pragma unroll
        for (int sidx = 0; sidx < 2; ++sidx)
#pragma unroll
            for (int db = 0; db < 4; ++db) {
                const bf16_t* vp = vt + (size_t)(32 * db + r) * S + mk0 + 16 * sidx + 4 * hh;
                const s16x4 lo = *(const s16x4*)vp, hi = *(const s16x4*)(vp + 8);
                vfr[sidx][db] = __builtin_shufflevector(lo, hi, 0, 1, 2, 3, 4, 5, 6, 7);
            }
        __builtin_amdgcn_sched_barrier(0);
        f32x16 s;
#pragma unroll
        for (int i = 0; i < 16; ++i) s[i] = 0.f;
#pragma unroll
        for (int ks = 0; ks < 8; ++ks) s = MFMA32(kf[ks], qf[ks], s);
        if (kb < 4) {
            const int nk0r = m0 - 64 + 32 * (kb + 1); const int nk0 = (nk0r >= 0 && nk0r < n) ? nk0r : m0;
            const bf16_t* kp = proj + PIDX(((nk0 + r) << sh) + res, g * 3072 + 1024 + h * 128 + 8 * hh);
#pragma unroll
            for (int ks = 0; ks < 8; ++ks) kf[ks] = *(const bf16x8*)(kp + 16 * ks);
        }
        __builtin_amdgcn_sched_barrier(0);
        float mx = -INFINITY;
#pragma unroll
        for (int i = 0; i < 16; ++i) { const int rel = mk0r + crow(i, hh) - (m0 + r); const bool valid = blk_ok && (rel <= 64) && (rel >= -64);
            const float bv = tbl[32 * kb + (i & 3) + 8 * (i >> 2)];
            const float v = valid ? (s[i] * cs + bv) : -INFINITY; s[i] = v; mx = fmaxf(mx, v); }
        mx = xhalf_max(mx);
        const float mnew = fmaxf(m, mx), alpha = __builtin_amdgcn_exp2f(m - mnew);
        m = mnew;
        float rs = 0.f;
#pragma unroll
        for (int i = 0; i < 16; ++i) { s[i] = __builtin_amdgcn_exp2f(s[i] - mnew); rs += s[i]; }
        lsum = lsum * alpha + rs;
#pragma unroll
        for (int db = 0; db < 4; ++db) O[db] *= alpha;
#pragma unroll
        for (int sidx = 0; sidx < 2; ++sidx) {
            const bf16x8 pf = pack8(s, sidx);
#pragma unroll
            for (int db = 0; db < 4; ++db) O[db] = MFMA32(vfr[sidx][db], pf, O[db]);
        }
    }
    const float lt = lsum + __shfl_xor(lsum, 32), inv = 1.0f / lt;
    float* oa = (float*)(p.ws + WS_OA) + ((size_t)g * S + qpos) * 1024 + h * 128;
#pragma unroll
    for (int db = 0; db < 4; ++db)
#pragma unroll
        for (int i4 = 0; i4 < 4; ++i4) {
            const int d0 = 32 * db + 8 * i4 + 4 * hh;
            f32x4 o = {O[db][4 * i4] * inv, O[db][4 * i4 + 1] * inv, O[db][4 * i4 + 2] * inv, O[db][4 * i4 + 3] * inv};
            *(f32x4*)(oa + d0) = o;
        }
    if (hh == 0) ((float*)(p.ws + WS_LSEA))[((size_t)g * S + qpos) * 8 + h] = m + __log2f(lt);
}

DI void phase_post(const Params& p, LAS unsigned char* lds) {
    const int tid = tidx();
    const bf16_t* proj = (const bf16_t*)(p.ws + WS_PROJ);
    bf16_t* aout = (bf16_t*)(p.ws + WS_BR); bf16_t* bout = aout + (size_t)S * 1024;
    const float* oa = (const float*)(p.ws + WS_OA); const float* lse = (const float*)(p.ws + WS_LSEA);
    for (int idx0 = blockIdx.x * NTHR + tid; idx0 < S * 256; idx0 += 4 * gridDim.x * NTHR) {
        float l0[4], l1[4], l2[4]; f32x4 o0[4], o1[4], o2[4]; u32x2 gt[4];
#pragma unroll
        for (int u = 0; u < 4; ++u) { const int idx = idx0 + u * gridDim.x * NTHR; const int pos = idx >> 8, c4 = idx & 255, h = c4 >> 5, col = c4 * 4;
            l0[u] = lse[((size_t)0 * S + pos) * 8 + h]; l1[u] = lse[((size_t)1 * S + pos) * 8 + h]; l2[u] = lse[((size_t)2 * S + pos) * 8 + h];
            o0[u] = *(const f32x4*)(oa + ((size_t)0 * S + pos) * 1024 + col); o1[u] = *(const f32x4*)(oa + ((size_t)1 * S + pos) * 1024 + col); o2[u] = *(const f32x4*)(oa + ((size_t)2 * S + pos) * 1024 + col);
            gt[u] = *(const u32x2*)(proj + PIDX(pos, C_AGATE + col)); }
#pragma unroll
        for (int u = 0; u < 4; ++u) { const int idx = idx0 + u * gridDim.x * NTHR; const int pos = idx >> 8, c4 = idx & 255, col = c4 * 4;
            const float mx = fmaxf(l0[u], fmaxf(l1[u], l2[u]));
            const float w0 = __builtin_amdgcn_exp2f(l0[u] - mx), w1 = __builtin_amdgcn_exp2f(l1[u] - mx), w2 = __builtin_amdgcn_exp2f(l2[u] - mx);
            const float inv = __builtin_amdgcn_rcpf(w0 + w1 + w2);
            const f32x4 o = (o0[u] * w0 + o1[u] * w1 + o2[u] * w2) * inv;
            u32x2 ov = {pk2(o[0] * silu_f(bflo(gt[u][0])), o[1] * silu_f(bfhi(gt[u][0]))), pk2(o[2] * silu_f(bflo(gt[u][1])), o[3] * silu_f(bfhi(gt[u][1])))};
            *(u32x2*)(aout + (size_t)pos * 1024 + col) = ov; }
    }
    LAS float* tile = (LAS float*)lds;
    const float* z2t = (const float*)(p.ws + WS_Z2T);
    for (int it0 = blockIdx.x * 4; it0 < 128 * 16; it0 += gridDim.x * 4) {
        __syncthreads();
        f32x4 v[4][2];
#pragma unroll
        for (int u = 0; u < 4; ++u) { const int it = it0 + u, t0 = (it >> 4) * 64, c0 = (it & 15) * 64;
#pragma unroll
            for (int k = 0; k < 2; ++k) { const int e = tid + NTHR * k; const int ci = e >> 4, t4 = (e & 15) * 4; v[u][k] = *(const f32x4*)(z2t + (size_t)(c0 + ci) * S + t0 + t4); } }
#pragma unroll
        for (int u = 0; u < 4; ++u)
#pragma unroll
            for (int k = 0; k < 2; ++k) { const int e = tid + NTHR * k; const int ci = e >> 4, t4 = (e & 15) * 4; LAS float* d = tile + u * 4160 + ci * 65 + t4;
                d[0] = v[u][k][0]; d[1] = v[u][k][1]; d[2] = v[u][k][2]; d[3] = v[u][k][3]; }
        __syncthreads();
        u32x2 gt[4][2];
#pragma unroll
        for (int u = 0; u < 4; ++u) { const int it = it0 + u, t0 = (it >> 4) * 64, c0 = (it & 15) * 64;
#pragma unroll
            for (int k = 0; k < 2; ++k) { const int e = tid + NTHR * k; const int ti = e >> 4, cc = (e & 15) * 4; gt[u][k] = *(const u32x2*)(proj + PIDX(t0 + ti, C_BGATE + c0 + cc)); } }
#pragma unroll
        for (int u = 0; u < 4; ++u) { const int it = it0 + u, t0 = (it >> 4) * 64, c0 = (it & 15) * 64;
#pragma unroll
            for (int k = 0; k < 2; ++k) { const int e = tid + NTHR * k; const int ti = e >> 4, cc = (e & 15) * 4; const LAS float* sp = tile + u * 4160 + cc * 65 + ti;
                const float y0 = sp[0] * silu_f(bflo(gt[u][k][0])), y1 = sp[65] * silu_f(bfhi(gt[u][k][0]));
                const float y2 = sp[130] * silu_f(bflo(gt[u][k][1])), y3 = sp[195] * silu_f(bfhi(gt[u][k][1]));
                u32x2 ov = {pk2(y0, y1), pk2(y2, y3)};
                *(u32x2*)(bout + (size_t)(t0 + ti) * 1024 + c0 + cc) = ov; } }
    }
    __syncthreads();
}

#ifndef REP_GEMMIN
#define REP_GEMMIN 1
#endif
#ifndef REP_DIFF
#define REP_DIFF 1
#endif
#ifndef REP_HYENA
#define REP_HYENA 1
#endif
#ifndef REP_MIXA
#define REP_MIXA 1
#endif
#ifndef REP_PRO
#define REP_PRO 1
#endif
#ifndef REP_SPEC
#define REP_SPEC 1
#endif
#ifndef REP_MISC
#define REP_MISC 1
#endif
#ifndef REP_PROJ
#define REP_PROJ 1
#endif
constexpr int NPH = 3 + 6 * DEPTH + 1;
typedef const Params __attribute__((address_space(4)))* ParamsK;
DI Params ldp(ParamsK pc) {
    asm volatile("" : "+s"(pc));
    Params q;
#pragma unroll
    for (int i = 0; i < 18; ++i) q.in[i] = pc->in[i];
    q.out = pc->out; q.ws = pc->ws; q.ph_lo = pc->ph_lo; q.ph_hi = pc->ph_hi;
    return q;
}
DI void run_phase(ParamsK pc, int ph, LAS unsigned char* lds) {
    if (ph == 0) { for (int rep = 0; rep < REP_PRO; ++rep) { const Params p = ldp(pc); phase_prologue(p, lds); __syncthreads(); } return; }
    if (ph == 1) {
        const Params p = ldp(pc);
        const bool conv_first = (__builtin_amdgcn_readfirstlane(tidx() >> 6) & 1) != 0;
        if (conv_first) { phase_convert(p, lds); phase_tgen(p); } else { phase_tgen(p); phase_convert(p, lds); }
        return;
    }
    if (ph == 2) { for (int rep = 0; rep < REP_SPEC; ++rep) { const Params p = ldp(pc); for (int it = blockIdx.x; it < DEPTH * 2 * 256; it += gridDim.x) spectra_item(p, it, lds); } return; }
    if (ph == NPH - 1) { const Params p = ldp(pc); phase_rmsnorm((const float*)(p.ws + WS_X), p.in[I_FINALG], nullptr, p.out); return; }
    const int l = (ph - 3) / 6, sp = (ph - 3) % 6;
    if (sp == 0) { for (int rep = 0; rep < REP_MISC; ++rep) { const Params p = ldp(pc); phase_rmsnorm((l == 0) ? p.in[I_X] : (const float*)(p.ws + WS_X), p.in[I_NORMG] + l * D, (bf16_t*)(p.ws + WS_H), nullptr); } return; }
    if (sp == 1) {
        const Params p = ldp(pc);
        pg8::Gemm g{(const bf16_t*)(p.ws + WS_H), (const bf16_t*)(p.ws + WS_WIN) + (size_t)l * NIN * D, S, NIN, D};
        pg8::StaticOrder so; so.init(S, NIN, gridDim.x, blockIdx.x);
        EpiIn e{(bf16_t*)(p.ws + WS_PROJ), (bf16_t*)(p.ws + WS_VTA), (bf16_t*)(p.ws + WS_VTC), (float*)(p.ws + WS_BINT), lds + 131072};
#pragma unroll 1
        for (int rep = 0; rep < REP_GEMMIN; ++rep) { pg8::gemm_phase(lds, g, so, e); __syncthreads(); }
        return;
    }
    if (sp == 2) {
#pragma unroll 1
        for (int it = blockIdx.x; it < 256 + 256 + 768; it += gridDim.x) {
            int l2 = l; asm volatile("" : "+s"(l2));
            const Params p = ldp(pc);
            if (it < 256) { for (int rep = 0; rep < REP_DIFF; ++rep) diffattn_item(p, l2, it, lds); }
            else if (it < 512) { for (int rep = 0; rep < REP_HYENA; ++rep) hyena_item(p, l2, it - 256, lds); }
            else {
                const int tid2 = tidx(), wi0 = (it - 512) * NWAVES, g = wi0 >> 11, h = (wi0 & 2047) >> 8;
                LAS float* tb = (LAS float*)lds;
                __syncthreads();
                if (tid2 < 192) { const int rel = tid2 - 95; float v = 0.f;
                    if (rel >= -64 && rel <= 64) v = ((const float*)(p.ws + WS_BIAS))[(g * 8 + h) * 2049 + min(max(rel << (2 * g), -1024), 1024) + 1024];
                    tb[tid2] = v; }
                __syncthreads();
                for (int rep = 0; rep < REP_MIXA; ++rep) mixA_wave_item(p, wi0 + (tid2 >> 6), tid2 & 63, tb);
            }
        }
        return;
    }
    if (sp == 3) { for (int rep = 0; rep < REP_MISC; ++rep) { const Params p = ldp(pc); phase_post(p, lds); } return; }
    if (sp == 4) {
#pragma unroll 1
        for (int rep = 0; rep < REP_PROJ; ++rep) {
            const Params p = ldp(pc);
            pg8::Gemm g{(const bf16_t*)(p.ws + WS_BR), (const bf16_t*)(p.ws + WS_WPR) + (size_t)(l * 3) * D * 1024, 3 * S, 3 * D, 1024};
            ProjOrder po; po.so.init(S, D, gridDim.x, blockIdx.x);
            EpiProj e{(const bf16_t*)(p.ws + WS_PROJ), p.in[I_MERGEB] + (size_t)l * 3 * D, (bf16_t*)(p.ws + WS_YB)};
            pg8::gemm_phase(lds, g, po, e);
            __syncthreads();
        }
        return;
    }
    {
        const Params p = ldp(pc);
        pg8::Gemm g{(const bf16_t*)(p.ws + WS_YB), (const bf16_t*)(p.ws + WS_WOUT) + (size_t)l * D * D, S, D, D};
        pg8::StaticOrder so; so.init(S, D, gridDim.x, blockIdx.x);
        EpiOut e{(l == 0) ? p.in[I_X] : (const float*)(p.ws + WS_X), (float*)(p.ws + WS_X)};
#pragma unroll 1
        for (int rep = 0; rep < ((l == 0) ? REP_MISC : 1); ++rep) { pg8::gemm_phase(lds, g, so, e); __syncthreads(); }
    }
}


#define XB_TMO      128
#define XB_XCNT(j)  (256  + 64 * (j))
#define XB_XSUB(j)  (1280 + 64 * (j))
#define XB_XGEN(j)  (2304 + 64 * (j))
#define XB_TOP      3328
#define XB_TOPGEN   3392
#define XCD_BAR_WORDS 3456
#define XB_SPIN_CAP (1u << 18)
DI unsigned xb_ld(unsigned* p)              { return __hip_atomic_load(p, __ATOMIC_RELAXED, __HIP_MEMORY_SCOPE_AGENT); }
DI unsigned xb_add(unsigned* p, unsigned v) { return __hip_atomic_fetch_add(p, v, __ATOMIC_RELAXED, __HIP_MEMORY_SCOPE_AGENT); }
DI unsigned xb_xcc_id() { return (unsigned)__builtin_amdgcn_s_getreg((3 << 11) | 20) & 0xFu; }
#define XB_SPIN(cond, bar) do { unsigned _sp = 0; while (cond) { __builtin_amdgcn_s_sleep(1); \
    if ((++_sp & 255u) == 0u) { if (xb_ld(&(bar)[XB_TMO])) break; if (_sp > XB_SPIN_CAP) { atomicAdd(&(bar)[XB_TMO], 1u); break; } } } } while (0)
struct XcdBarrier { unsigned* bar; unsigned x; volatile LAS unsigned* st; };
DI XcdBarrier xcd_barrier_post(unsigned* bar, volatile LAS unsigned* st) {
    XcdBarrier b; b.bar = bar; b.x = xb_xcc_id(); b.st = st;
    if (threadIdx.x == 0) (void)xb_add(&bar[XB_XCNT(b.x)], 1u);
    return b;
}
DI void xcd_barrier_complete(unsigned* bar, unsigned x, unsigned& nloc, unsigned& nx) {
    const unsigned G = gridDim.x * gridDim.y * gridDim.z;
    unsigned sum, cnt, mine, sp = 0u;
    for (;;) {
        sum = 0u; cnt = 0u; mine = 0u;
#pragma unroll
        for (unsigned j = 0; j < 16; ++j) { const unsigned c = xb_ld(&bar[XB_XCNT(j)]); sum += c; cnt += (c > 0u) ? 1u : 0u; mine = (j == x) ? c : mine; }
        if (sum == G) break;
        __builtin_amdgcn_s_sleep(1);
        if ((++sp & 255u) == 0u) { if (xb_ld(&bar[XB_TMO])) break; if (sp > XB_SPIN_CAP) { atomicAdd(&bar[XB_TMO], 1u); break; } }
    }
    nloc = mine > 0u ? mine : 1u; nx = cnt > 0u ? cnt : 1u;
}
DI void xcd_barrier(const XcdBarrier& b) {
    asm volatile("s_waitcnt vmcnt(0)" ::: "memory");
    __syncthreads();
    if (threadIdx.x == 0) {
        unsigned* bar = b.bar;
        __builtin_amdgcn_s_waitcnt(0);
        unsigned nloc = b.st[0], nx = b.st[1];
        if (nloc == 0u) { xcd_barrier_complete(bar, b.x, nloc, nx); b.st[0] = nloc; b.st[1] = nx; }
        const unsigned old = xb_add(&bar[XB_XSUB(b.x)], 1u);
        const unsigned gen = old / nloc;
        if (old + 1u == (gen + 1u) * nloc) {
            __builtin_amdgcn_fence(__ATOMIC_RELEASE, "agent");
            asm volatile("s_waitcnt vmcnt(0)" ::: "memory");
            const unsigned og = xb_add(&bar[XB_TOP], 1u);
            const unsigned tg = og / nx;
            if (og + 1u == (tg + 1u) * nx) xb_add(&bar[XB_TOPGEN], 1u);
            else XB_SPIN(xb_ld(&bar[XB_TOPGEN]) == tg, bar);
            __builtin_amdgcn_fence(__ATOMIC_ACQUIRE, "agent");
            xb_add(&bar[XB_XGEN(b.x)], 1u);
            asm volatile("s_waitcnt vmcnt(0)" ::: "memory");
        } else {
            XB_SPIN(xb_ld(&bar[XB_XGEN(b.x)]) == gen, bar);
            __builtin_amdgcn_fence(__ATOMIC_ACQUIRE, "agent");
            asm volatile("s_waitcnt vmcnt(0)" ::: "memory");
        }
    }
    __syncthreads();
}

__global__ void __launch_bounds__(512, 2) mega_kernel(Params p) {
#if defined(__HIP_DEVICE_COMPILE__)
    extern __shared__ __attribute__((aligned(16))) unsigned char shm[];
    LAS unsigned char* lds = (LAS unsigned char*)shm;
    cg::grid_group grid = cg::this_grid();
    const int ph_lo = p.ph_lo, ph_hi = p.ph_hi;
    volatile LAS unsigned* st = (volatile LAS unsigned*)(lds + LDS_BYTES - 16);
    if (threadIdx.x == 0) { st[0] = 0u; st[1] = 0u; }
    __syncthreads();
    const XcdBarrier xb = xcd_barrier_post((unsigned*)(p.ws + WS_BAR), st);
#pragma unroll 1
    for (int ph = ph_lo; ph < ph_hi; ++ph) {
        ParamsK pc = (ParamsK)__builtin_amdgcn_kernarg_segment_ptr();
        run_phase(pc, ph, lds);
        if (ph + 1 < ph_hi) { if (ph == ph_lo) grid.sync(); else xcd_barrier(xb); }
    }
#endif
}

#ifndef N_LAUNCH_MODE
#define N_LAUNCH_MODE 1
#endif
extern "C" void kernel_launch(void* const* d_in, const int* in_sizes, int n_in, void* d_out, int out_size, void* d_ws, size_t ws_size, hipStream_t stream) {
    static int grid = 0;
    if (grid == 0) {
        int dev = 0, cus = 0;
        if (hipGetDevice(&dev) != hipSuccess || hipDeviceGetAttribute(&cus, hipDeviceAttributeMultiprocessorCount, dev) != hipSuccess) { fprintf(stderr, "kernel_launch: device query failed\n"); grid = -1; return; }
        if (hipFuncSetAttribute((const void*)mega_kernel, hipFuncAttributeMaxDynamicSharedMemorySize, LDS_BYTES) != hipSuccess) { fprintf(stderr, "kernel_launch: hipFuncSetAttribute failed\n"); grid = -1; return; }
        int per_cu = 0;
        if (hipOccupancyMaxActiveBlocksPerMultiprocessor(&per_cu, (const void*)mega_kernel, NTHR, LDS_BYTES) != hipSuccess || per_cu < 1) { fprintf(stderr, "kernel_launch: occupancy query says %d\n", per_cu); (void)hipGetLastError(); }
        if (n_in != 18 || ws_size < WS_END) { fprintf(stderr, "kernel_launch: n_in %d ws %zu (need %zu)\n", n_in, ws_size, (size_t)WS_END); grid = -1; return; }
        grid = cus;
    }
    if (grid < 0) return;
    Params p{};
    for (int i = 0; i < 18; ++i) p.in[i] = (const float*)d_in[i];
    p.out = (float*)d_out; p.ws = (unsigned char*)d_ws;
    if (hipMemsetAsync((unsigned char*)d_ws + WS_BAR, 0, 16384, stream) != hipSuccess) { fprintf(stderr, "kernel_launch: memset of barrier words failed\n"); return; }
#if N_LAUNCH_MODE == 1
    p.ph_lo = 0; p.ph_hi = NPH;
    void* args[] = {&p};
    hipError_t e = hipLaunchCooperativeKernel((const void*)mega_kernel, dim3(grid), dim3(NTHR), args, LDS_BYTES, stream);
    if (e != hipSuccess) fprintf(stderr, "cooperative launch failed: %s (grid %d)\n", hipGetErrorString(e), grid);
#else
    for (int ph = 0; ph < NPH; ++ph) {
        p.ph_lo = ph; p.ph_hi = ph + 1;
        hipLaunchKernelGGL(mega_kernel, dim3(grid), dim3(NTHR), LDS_BYTES, stream, p);
    }
#endif
}
```
